# Optimizing an MI355X kernel written in HIP

```python
import math
import jax, jax.numpy as jnp
from jax import lax
import numpy as np

D_MODEL = 2048
BATCH = 8
SEQ = 2048
DEPTH = 1

EPS = 1e-5
SSD_HEAD_DIM = 64
SSD_HEADS = D_MODEL // SSD_HEAD_DIM
D_SSD = SSD_HEADS * SSD_HEAD_DIM
SSD_GROUPS = 4
SSD_HEADS_PER_GROUP = SSD_HEADS // SSD_GROUPS
SSD_STATE = 128
SSD_CONV = 4
SSD_CHUNK = 128
SSD_CONV_DIM = D_SSD + 2 * SSD_GROUPS * SSD_STATE
ML_HEADS = 8
ML_DV = D_MODEL // ML_HEADS
ML_DQK = ML_DV // 2
D_ML = ML_HEADS * ML_DV
ML_CHUNK = 128
D_MIX = D_SSD + D_ML
SSD_PROJ = D_SSD + SSD_CONV_DIM + SSD_HEADS
ML_PROJ = 2 * ML_HEADS * ML_DQK + 2 * D_ML + 2 * ML_HEADS
D_PROJ = SSD_PROJ + ML_PROJ
N_EXPERTS = 32
TOP_K = 4
D_FF = D_MODEL
SWIGLU_ALPHA = 1.702
SWIGLU_LIMIT = 7.0
EXPERT_BLOCK = 256

kernel_name = 'hymba_ssd_mlstm_moe_layer'


def rmsnorm(x, w):
    xf = x.astype(jnp.float32)
    y = xf * lax.rsqrt(jnp.mean(xf * xf, axis=-1, keepdims=True) + EPS)
    return y.astype(x.dtype) * w


def grouped_rmsnorm(x, w, groups):
    sh = x.shape
    xg = x.reshape(*sh[:-1], groups, sh[-1] // groups)
    xg = xg * lax.rsqrt(jnp.mean(xg * xg, axis=-1, keepdims=True) + EPS)
    return xg.reshape(sh) * w


def split_columns(x, sizes):
    out, start = [], 0
    for size in sizes:
        out.append(x[..., start:start + size])
        start += size
    return out


def causal_depthwise_conv(x, w, b):
    s = x.shape[1]
    k = w.shape[0]
    xp = jnp.pad(x, ((0, 0), (k - 1, 0), (0, 0)))
    out = b
    for j in range(k):
        out = out + xp[:, j:j + s] * w[j]
    return out


def ssd_mixer(z, xbc, dt_raw, conv_w, conv_b, dt_bias, a_log, d_skip, norm_w):
    f32 = jnp.float32
    b, s, _ = z.shape
    G, R, P, N, Q = SSD_GROUPS, SSD_HEADS_PER_GROUP, SSD_HEAD_DIM, SSD_STATE, SSD_CHUNK
    nc = s // Q
    xbc = jax.nn.silu(causal_depthwise_conv(xbc, conv_w, conv_b)).astype(f32)
    xs = xbc[..., :D_SSD].reshape(b, nc, Q, G, R, P)
    bm = xbc[..., D_SSD:D_SSD + G * N].reshape(b, nc, Q, G, N)
    cm = xbc[..., D_SSD + G * N:].reshape(b, nc, Q, G, N)
    dt = jax.nn.softplus(dt_raw.astype(f32) + dt_bias.astype(f32)).reshape(b, nc, Q, G, R)
    a = -jnp.exp(a_log.astype(f32)).reshape(G, R)
    da = (dt * a).transpose(0, 3, 4, 1, 2)
    a_cum = jnp.cumsum(da, axis=-1)
    xdt = xs * dt[..., None]
    causal = jnp.tril(jnp.ones((Q, Q), bool))
    seg = a_cum[..., :, None] - a_cum[..., None, :]
    decay_in = jnp.exp(jnp.where(causal, seg, -jnp.inf))
    cb = jnp.einsum('bclgn,bcsgn->bgcls', cm, bm)
    y_diag = jnp.einsum('bgrcls,bcsgrp->bclgrp', cb[:, :, None] * decay_in, xdt)
    decay_to_end = jnp.exp(a_cum[..., -1:] - a_cum).transpose(0, 3, 4, 1, 2)
    states = jnp.einsum('bclgn,bclgrp->bcgrpn', bm, xdt * decay_to_end[..., None])
    chunk_tot = a_cum[..., -1]
    cs = jnp.cumsum(chunk_tot, axis=-1)
    strict = jnp.tril(jnp.ones((nc, nc), bool), -1)
    decay_chunk = jnp.exp(jnp.where(strict, (cs - chunk_tot)[..., :, None] - cs[..., None, :], -jnp.inf))
    prev_states = jnp.einsum('bgrzc,bcgrpn->bzgrpn', decay_chunk, states)
    decay_from_start = jnp.exp(a_cum).transpose(0, 3, 4, 1, 2)
    y_off = jnp.einsum('bclgn,bcgrpn->bclgrp', cm, prev_states) * decay_from_start[..., None]
    y = y_diag + y_off + xs * d_skip.astype(f32).reshape(G, R)[:, :, None]
    y = y.reshape(b, s, D_SSD) * jax.nn.silu(z.astype(f32))
    y = grouped_rmsnorm(y, norm_w, SSD_GROUPS)
    return y.astype(z.dtype)


def mlstm_mixer(q_in, k_in, v_in, o_pre, i_pre, f_pre, i_bias, f_bias, norm_w):
    f32 = jnp.float32
    b, s, _ = q_in.shape
    H, L, DK, DV = ML_HEADS, ML_CHUNK, ML_DQK, ML_DV
    nc = s // L
    q = q_in.astype(f32).reshape(b, nc, L, H, DK) * (DK ** -0.5)
    k = k_in.astype(f32).reshape(b, nc, L, H, DK)
    v = v_in.astype(f32).reshape(b, nc, L, H, DV)
    log_i = (i_pre.astype(f32) + i_bias.astype(f32)).reshape(b, nc, L, H).transpose(0, 3, 1, 2)
    log_f = jax.nn.log_sigmoid(f_pre.astype(f32) + f_bias.astype(f32)).reshape(b, nc, L, H).transpose(0, 3, 1, 2)
    bcum = jnp.cumsum(log_f, axis=-1)
    btot = bcum[..., -1]
    w_end = btot[..., None] - bcum + log_i
    m_loc = jnp.max(w_end, axis=-1)
    k_end = k * jnp.exp(w_end - m_loc[..., None]).transpose(0, 2, 3, 1)[..., None]
    kv_chunk = jnp.einsum('bclhk,bclhv->bchkv', k_end, v)
    n_chunk = jnp.sum(k_end, axis=2)

    def chunk_step(carry, inp):
        c_state, n_state, m_state = carry
        kv, nk, mloc, tot = inp
        m_new = jnp.maximum(tot + m_state, mloc)
        a = jnp.exp(tot + m_state - m_new)
        g = jnp.exp(mloc - m_new)
        c_new = a[..., None, None] * c_state + g[..., None, None] * kv
        n_new = a[..., None] * n_state + g[..., None] * nk
        return (c_new, n_new, m_new), (c_state, n_state, m_state)

    init = (jnp.zeros((b, H, DK, DV), f32), jnp.zeros((b, H, DK), f32), jnp.zeros((b, H), f32))
    scan_in = (kv_chunk.transpose(1, 0, 2, 3, 4), n_chunk.transpose(1, 0, 2, 3),
               m_loc.transpose(2, 0, 1), btot.transpose(2, 0, 1))
    _, (c_prev, n_prev, m_prev) = lax.scan(chunk_step, init, scan_in)
    c_prev = c_prev.transpose(1, 0, 2, 3, 4)
    n_prev = n_prev.transpose(1, 0, 2, 3)
    m_prev = m_prev.transpose(1, 2, 0)
    causal = jnp.tril(jnp.ones((L, L), bool))
    d_log = jnp.where(causal, bcum[..., :, None] - bcum[..., None, :] + log_i[..., None, :], -jnp.inf)
    m_inter = bcum + m_prev[..., None]
    m_t = jnp.maximum(m_inter, jnp.max(d_log, axis=-1))
    s_mat = jnp.einsum('bclhk,bcshk->bhcls', q, k) * jnp.exp(d_log - m_t[..., None])
    inter_scale = jnp.exp(m_inter - m_t)
    num = (jnp.einsum('bhcls,bcshv->bclhv', s_mat, v)
           + jnp.einsum('bclhk,bchkv->bclhv', q, c_prev) * inter_scale.transpose(0, 2, 3, 1)[..., None])
    den = jnp.sum(s_mat, axis=-1) + jnp.einsum('bclhk,bchk->bhcl', q, n_prev) * inter_scale
    den = jnp.maximum(jnp.abs(den), jnp.exp(-m_t))
    h_tilde = (num / den.transpose(0, 2, 3, 1)[..., None]).reshape(b, s, D_ML)
    y = grouped_rmsnorm(h_tilde, norm_w, ML_HEADS) * jax.nn.sigmoid(o_pre.astype(f32))
    return y.astype(q_in.dtype)


def clamped_swiglu(h):
    glu = jnp.minimum(h[..., ::2], SWIGLU_LIMIT)
    lin = jnp.clip(h[..., 1::2], -SWIGLU_LIMIT, SWIGLU_LIMIT)
    return glu * jax.nn.sigmoid(SWIGLU_ALPHA * glu) * (lin + 1.0)


def moe_ffn(xn, router_w, router_b, w_gate_up, b_gate_up, w_down, b_down):
    b, s, d = xn.shape
    T = b * s
    xf = xn.reshape(T, d)
    logits = (xf @ router_w + router_b).astype(jnp.float32)
    top_vals, top_idx = lax.top_k(logits, TOP_K)
    gates = jax.nn.softmax(top_vals, axis=-1).astype(xn.dtype)
    n_assign = T * TOP_K
    flat_e = top_idx.reshape(-1).astype(jnp.int32)
    order = jnp.argsort(flat_e)
    sorted_e = flat_e[order]
    counts = jnp.zeros((N_EXPERTS,), jnp.int32).at[flat_e].add(1)
    starts = jnp.cumsum(counts) - counts
    padded = (counts + EXPERT_BLOCK - 1) // EXPERT_BLOCK * EXPERT_BLOCK
    padded_ends = jnp.cumsum(padded)
    padded_starts = padded_ends - padded
    rank = jnp.arange(n_assign, dtype=jnp.int32) - starts[sorted_e]
    dest = jnp.zeros((n_assign,), jnp.int32).at[order].set(padded_starts[sorted_e] + rank)
    n_rows = n_assign + N_EXPERTS * EXPERT_BLOCK
    n_blocks = n_rows // EXPERT_BLOCK
    row_tok = jnp.full((n_rows,), T, jnp.int32).at[dest].set(jnp.arange(n_assign, dtype=jnp.int32) // TOP_K)
    block_start = jnp.arange(n_blocks, dtype=jnp.int32) * EXPERT_BLOCK
    block_expert = jnp.minimum(jnp.searchsorted(padded_ends, block_start, side='right'), N_EXPERTS - 1)
    x_pad = jnp.concatenate([xf, jnp.zeros((1, d), xf.dtype)], axis=0)
    x_rows = x_pad[row_tok].reshape(n_blocks, EXPERT_BLOCK, d)

    def expert_block(args):
        xb, e = args
        h = xb @ w_gate_up[e] + b_gate_up[e]
        return clamped_swiglu(h) @ w_down[e] + b_down[e]

    y_rows = lax.map(expert_block, (x_rows, block_expert)).reshape(n_rows, d)
    y = jnp.sum(y_rows[dest].reshape(T, TOP_K, d) * gates[..., None], axis=1)
    return y.reshape(b, s, d)


def setup_inputs(seed: int = 0) -> dict:
    key = jax.random.key(seed)
    ks = jax.random.split(key, 24)
    f32 = jnp.float32
    L = DEPTH

    def nrm(k, shape, scale):
        return jax.random.normal(k, shape, f32) * scale

    x = jax.random.normal(ks[0], (BATCH, SEQ, D_MODEL), f32)
    norm1_w = 1.0 + nrm(ks[1], (L, D_MODEL), 0.02)
    w_in = nrm(ks[2], (L, D_MODEL, D_PROJ), D_MODEL ** -0.5)
    conv_w = nrm(ks[3], (L, SSD_CONV, SSD_CONV_DIM), SSD_CONV ** -0.5)
    conv_b = nrm(ks[4], (L, SSD_CONV_DIM), 0.02)
    dt0 = jnp.exp(jax.random.uniform(ks[5], (L, SSD_HEADS), f32, math.log(1e-3), math.log(1e-1)))
    dt_bias = dt0 + jnp.log(-jnp.expm1(-dt0))
    a_log = jnp.log(jax.random.uniform(ks[6], (L, SSD_HEADS), f32, 1.0, 16.0))
    d_skip = 1.0 + nrm(ks[7], (L, SSD_HEADS), 0.1)
    ssd_norm_w = 1.0 + nrm(ks[8], (L, D_SSD), 0.02)
    i_bias = nrm(ks[9], (L, ML_HEADS), 0.1)
    f_bias = jnp.linspace(3.0, 6.0, ML_HEADS, dtype=f32) + nrm(ks[10], (L, ML_HEADS), 0.1)
    ml_norm_w = 1.0 + nrm(ks[11], (L, D_ML), 0.02)
    w_out = nrm(ks[12], (L, D_MIX, D_MODEL), D_MIX ** -0.5)
    norm2_w = 1.0 + nrm(ks[13], (L, D_MODEL), 0.02)
    router_w = nrm(ks[14], (L, D_MODEL, N_EXPERTS), D_MODEL ** -0.5)
    router_b = nrm(ks[15], (L, N_EXPERTS), 0.01)
    w_gate_up = nrm(ks[16], (L, N_EXPERTS, D_MODEL, 2 * D_FF), D_MODEL ** -0.5)
    b_gate_up = nrm(ks[17], (L, N_EXPERTS, 2 * D_FF), 0.01)
    w_down = nrm(ks[18], (L, N_EXPERTS, D_FF, D_MODEL), D_FF ** -0.5)
    b_down = nrm(ks[19], (L, N_EXPERTS, D_MODEL), 0.01)
    final_norm_w = 1.0 + nrm(ks[20], (D_MODEL,), 0.02)
    return {'x': x, 'norm1_w': norm1_w, 'w_in': w_in, 'conv_w': conv_w, 'conv_b': conv_b,
            'dt_bias': dt_bias, 'a_log': a_log, 'd_skip': d_skip, 'ssd_norm_w': ssd_norm_w,
            'i_bias': i_bias, 'f_bias': f_bias, 'ml_norm_w': ml_norm_w, 'w_out': w_out,
            'norm2_w': norm2_w, 'router_w': router_w, 'router_b': router_b,
            'w_gate_up': w_gate_up, 'b_gate_up': b_gate_up, 'w_down': w_down, 'b_down': b_down,
            'final_norm_w': final_norm_w}


def reference(x, norm1_w, w_in, conv_w, conv_b, dt_bias, a_log, d_skip, ssd_norm_w,
              i_bias, f_bias, ml_norm_w, w_out, norm2_w, router_w, router_b,
              w_gate_up, b_gate_up, w_down, b_down, final_norm_w):
    h = x
    for l in range(DEPTH):
        n = rmsnorm(h, norm1_w[l])
        proj = n @ w_in[l]
        z, xbc, dt_raw, q, k, v, o_pre, i_pre, f_pre = split_columns(
            proj, (D_SSD, SSD_CONV_DIM, SSD_HEADS, ML_HEADS * ML_DQK, ML_HEADS * ML_DQK,
                   D_ML, D_ML, ML_HEADS, ML_HEADS))
        y_ssd = ssd_mixer(z, xbc, dt_raw, conv_w[l], conv_b[l], dt_bias[l], a_log[l],
                          d_skip[l], ssd_norm_w[l])
        y_ml = mlstm_mixer(q, k, v, o_pre, i_pre, f_pre, i_bias[l], f_bias[l], ml_norm_w[l])
        h = h + jnp.concatenate([y_ssd, y_ml], axis=-1) @ w_out[l]
        h = h + moe_ffn(rmsnorm(h, norm2_w[l]), router_w[l], router_b[l], w_gate_up[l],
                        b_gate_up[l], w_down[l], b_down[l])
    return rmsnorm(h, final_norm_w)
```

```cpp
#include <hip/hip_runtime.h>
#include <cstdio>
#include <cstdint>
namespace pg8 {
#define PG8_LAS __attribute__((address_space(3)))
typedef unsigned short bf16_t;
typedef short bf16x8 __attribute__((ext_vector_type(8)));
typedef float f32x4 __attribute__((ext_vector_type(4)));
typedef unsigned u32x4 __attribute__((ext_vector_type(4)));
constexpr int BM = 256, BK = 64, HALF = 128, HTB = HALF * BK * 2  , STAGE_BYTES = 8 * HTB, NXCD = 8, WGM = 8;

__host__ __device__ __forceinline__ int lds_byte(int r, int c) { const int st = (r >> 4) * 2 + (c >> 5), rr = r & 15, cc = c & 31, ob = rr * 64 + cc * 2; return st * 1024 + (ob ^ (((ob >> 9) & 1) << 5)); }
__host__ __device__ __forceinline__ void stage_rc(int b, int& R, int& C) { const int st = b / 1024, sb = b % 1024, swz = sb ^ (((sb >> 9) & 1) << 5); R = (st >> 1) * 16 + swz / 64; C = (st & 1) * 32 + (swz % 64) / 2; }
__host__ __device__ __forceinline__ int perm32(int rho) { const int n = rho >> 4, i = rho & 15; return 8 * (i >> 2) + 4 * n + (i & 3); }

struct Unit { int pm, pn; };
struct Gemm { const bf16_t* A; const bf16_t* Bt; int M, N, K; };

struct StaticOrder {
    int nM, nN, nwg, G, c;
    __host__ __device__ void init(int M, int N, int G_, int c_) { nM = M / BM; nN = N / BM; nwg = nM * nN; G = G_; c = c_; }
    __host__ __device__ bool next(int i, Unit& u) const {
        const long L = (long)i * G + c; if (L >= nwg) return false;
        int wgid = (int)L; { const int q = nwg / NXCD, r = nwg % NXCD, xcd = wgid % NXCD, off = wgid / NXCD; wgid = (xcd < r ? xcd * (q + 1) : r * (q + 1) + (xcd - r) * q) + off; }
        const int nig = WGM * nN, gid = wgid / nig, fm = gid * WGM, gsz = (nM - fm) < WGM ? (nM - fm) : WGM;
        u.pm = fm + ((wgid % nig) % gsz); u.pn = (wgid % nig) / gsz; return true;
    }
    __device__ __forceinline__ void a_ready(const Unit&) const {}
    __device__ __forceinline__ void done(const Unit&) const {}
};


__device__ __forceinline__ unsigned cvt_pk_bf16(float lo, float hi) { unsigned r; asm volatile("v_cvt_pk_bf16_f32 %0, %1, %2" : "=v"(r) : "v"(lo), "v"(hi)); return r; }
typedef unsigned u32x2 __attribute__((ext_vector_type(2)));

struct EpiBf16 {
    static constexpr bool PERM = true, AFTER_DRAIN = false;
    bf16_t* O; int ldc;
    __device__ __forceinline__ void operator()(const f32x4 (&acc)[2][2][4][2], const Unit& u, int wr, int wc, int fr, int fq) const {
        const int row0 = u.pm * BM + wr * 64 + fr; const int col0 = u.pn * BM + wc * 32 + 8 * fq;
#pragma unroll
        for (int ai = 0; ai < 2; ++ai)
#pragma unroll
            for (int m = 0; m < 4; ++m) { bf16_t* rowp = O + (size_t)(row0 + ai * HALF + m * 16) * ldc + col0;
#pragma unroll
                for (int bj = 0; bj < 2; ++bj) { const f32x4 v0 = acc[ai][bj][m][0], v1 = acc[ai][bj][m][1];
                    u32x4 w; w.x = cvt_pk_bf16(v0[0], v0[1]); w.y = cvt_pk_bf16(v0[2], v0[3]); w.z = cvt_pk_bf16(v1[0], v1[1]); w.w = cvt_pk_bf16(v1[2], v1[3]);
                    *(u32x4*)(rowp + bj * HALF) = w; } }
    }
};
struct EpiResF32 {
    static constexpr bool PERM = false, AFTER_DRAIN = false;
    float* C; const float* base; int ldc;
    __device__ __forceinline__ void operator()(const f32x4 (&acc)[2][2][4][2], const Unit& u, int wr, int wc, int fr, int fq) const {
        const int row0 = u.pm * BM + wr * 64 + fr, col0 = u.pn * BM + wc * 32 + 4 * fq;
#pragma unroll
        for (int ai = 0; ai < 2; ++ai)
#pragma unroll
            for (int m = 0; m < 4; ++m) { const size_t off = (size_t)(row0 + ai * HALF + m * 16) * ldc + col0;
#pragma unroll
                for (int bj = 0; bj < 2; ++bj)
#pragma unroll
                    for (int n = 0; n < 2; ++n) *(f32x4*)(C + off + bj * HALF + n * 16) = acc[ai][bj][m][n] + *(const f32x4*)(base + off + bj * HALF + n * 16); }
    }
};
__device__ __forceinline__ float swiglu1(float a, float b) {
    const float glu = fminf(a, 7.0f), lin = fminf(fmaxf(b, -7.0f), 7.0f);
    return glu * (1.0f / (1.0f + __expf(-1.702f * glu))) * (lin + 1.0f);
}
struct EpiSwiglu {
    static constexpr bool PERM = true, AFTER_DRAIN = false;
    bf16_t* O; const float* bias;
    __device__ __forceinline__ void operator()(const f32x4 (&acc)[2][2][4][2], const Unit& u, int wr, int wc, int fr, int fq) const {
        const int e = u.pn >> 4, pnl = u.pn & 15;
        const int row0 = u.pm * BM + wr * 64 + fr; const int hcol0 = pnl * BM + wc * 32 + 8 * fq;
        const float* bp = bias + (size_t)e * 4096 + hcol0;
        f32x4 bv[2][2];
#pragma unroll
        for (int bj = 0; bj < 2; ++bj)
#pragma unroll
            for (int n = 0; n < 2; ++n) bv[bj][n] = *(const f32x4*)(bp + bj * HALF + 4 * n);
#pragma unroll
        for (int ai = 0; ai < 2; ++ai)
#pragma unroll
            for (int m = 0; m < 4; ++m) { bf16_t* rowp = O + (size_t)(row0 + ai * HALF + m * 16) * 2048 + (hcol0 >> 1);
#pragma unroll
                for (int bj = 0; bj < 2; ++bj) { const f32x4 v0 = acc[ai][bj][m][0] + bv[bj][0], v1 = acc[ai][bj][m][1] + bv[bj][1];
                    u32x2 w; w.x = cvt_pk_bf16(swiglu1(v0[0], v0[1]), swiglu1(v0[2], v0[3])); w.y = cvt_pk_bf16(swiglu1(v1[0], v1[1]), swiglu1(v1[2], v1[3]));
                    *(u32x2*)(rowp + bj * 64) = w; } }
    }
};
struct EpiDown {
    static constexpr bool PERM = true, AFTER_DRAIN = false;
    bf16_t* O; const float* bias; const float* sgate;
    __device__ __forceinline__ void operator()(const f32x4 (&acc)[2][2][4][2], const Unit& u, int wr, int wc, int fr, int fq) const {
        const int e = u.pn >> 3, pnl = u.pn & 7;
        const int row0 = u.pm * BM + wr * 64 + fr; const int col0 = pnl * BM + wc * 32 + 8 * fq;
        const float* bp = bias + (size_t)e * 2048 + col0;
        f32x4 bv[2][2];
#pragma unroll
        for (int bj = 0; bj < 2; ++bj)
#pragma unroll
            for (int n = 0; n < 2; ++n) bv[bj][n] = *(const f32x4*)(bp + bj * HALF + 4 * n);
#pragma unroll
        for (int ai = 0; ai < 2; ++ai)
#pragma unroll
            for (int m = 0; m < 4; ++m) { const int row = row0 + ai * HALF + m * 16; const float gt = sgate[row]; bf16_t* rowp = O + (size_t)row * 2048 + col0;
#pragma unroll
                for (int bj = 0; bj < 2; ++bj) { const f32x4 v0 = (acc[ai][bj][m][0] + bv[bj][0]) * gt, v1 = (acc[ai][bj][m][1] + bv[bj][1]) * gt;
                    u32x4 w; w.x = cvt_pk_bf16(v0[0], v0[1]); w.y = cvt_pk_bf16(v0[2], v0[3]); w.z = cvt_pk_bf16(v1[0], v1[1]); w.w = cvt_pk_bf16(v1[2], v1[3]);
                    *(u32x4*)(rowp + bj * HALF) = w; } }
    }
};
struct MoeOrder {
    int nM, nN, nsh, nwg, G, c; const PG8_LAS unsigned char* tab;
    __device__ __forceinline__ bool next(int i, Unit& u) const {
        const long L = (long)i * G + c; if (L >= nwg) return false;
        int wgid = (int)L; { const int q = nwg / NXCD, r = nwg % NXCD, xcd = wgid % NXCD, off = wgid / NXCD; wgid = (xcd < r ? xcd * (q + 1) : r * (q + 1) + (xcd - r) * q) + off; }
        const int nig = WGM * nN, gid = wgid / nig, fm = gid * WGM, gsz = (nM - fm) < WGM ? (nM - fm) : WGM;
        const int pm = fm + ((wgid % nig) % gsz), pnl = (wgid % nig) / gsz;
        u.pm = pm; u.pn = ((int)tab[pm] << nsh) + pnl; return true;
    }
    __device__ __forceinline__ void a_ready(const Unit&) const {}
    __device__ __forceinline__ void done(const Unit&) const {}
};
template <class Epi, class Sched, bool ALIGN_EPI = false, bool SP2 = false>
__device__ __forceinline__ void gemm_phase(PG8_LAS unsigned char* lds, const Gemm g, const Sched& S, const Epi& E) {
    const int tid = threadIdx.x, wid = __builtin_amdgcn_readfirstlane(tid >> 6), lane = tid & 63, wr = wid >> 2, wc = wid & 3, fr = lane & 15, fq = lane >> 4;
    const int K = g.K, nt = K / BK;
    unsigned voffA[2], voffB[2];
#pragma unroll
    for (int i = 0; i < 2; ++i) { int R, C; stage_rc(tid * 16 + i * 8192, R, C); const int Rb = Epi::PERM ? ((R & ~31) + perm32(R & 31)) : R;
        voffA[i] = (unsigned)(R * K + C) * 2u; voffB[i] = (unsigned)(Rb * K + C) * 2u; }
    const size_t kstep = (size_t)(BK * 2);
    const size_t hstep = (size_t)HALF * K * 2;
    const size_t tstep = 2 * hstep;
    const unsigned ldsw = (unsigned)wid * 1024u;
    const int aoff = lds_byte(wr * 64 + fr, fq * 8), boff = lds_byte(wc * 32 + fr, fq * 8);
#define PG8_SA(b, h) (((b) * 2 + (h)) * HTB)
#define PG8_SB(b, h) ((4 + (b) * 2 + (h)) * HTB)
#define PG8_STAGE(bufoff, gbase, voff) do { _Pragma("unroll") for (int _i = 0; _i < 2; ++_i) \
        __builtin_amdgcn_global_load_lds((const unsigned*)((const char*)(gbase) + (voff)[_i]), (PG8_LAS unsigned*)(lds + (bufoff) + ldsw + _i * 8192), 16, 0, 0); } while (0)
#define PG8_LDA(dst, b, h) do { _Pragma("unroll") for (int m = 0; m < 4; ++m) _Pragma("unroll") for (int k = 0; k < 2; ++k) dst[m][k] = *(const PG8_LAS bf16x8*)(lds + PG8_SA(b, h) + aoff + m * 2048 + k * 1024); } while (0)
#define PG8_LDB(dst, b, h) do { _Pragma("unroll") for (int n = 0; n < 2; ++n) _Pragma("unroll") for (int k = 0; k < 2; ++k) dst[n][k] = *(const PG8_LAS bf16x8*)(lds + PG8_SB(b, h) + boff + n * 2048 + k * 1024); } while (0)
#define PG8_MMA(ai, bj, At, Bt) do { __builtin_amdgcn_s_setprio(1); _Pragma("unroll") for (int m = 0; m < 4; ++m) _Pragma("unroll") for (int n = 0; n < 2; ++n) _Pragma("unroll") for (int k = 0; k < 2; ++k) \
        acc[ai][bj][m][n] = __builtin_amdgcn_mfma_f32_16x16x32_bf16(Bt[n][k], At[m][k], acc[ai][bj][m][n], 0, 0, 0); __builtin_amdgcn_s_setprio(0); } while (0)
#define PG8_WAIT_V(n) asm volatile("s_waitcnt vmcnt(" #n ")" ::: "memory")
#define PG8_WAIT_L(n) asm volatile("s_waitcnt lgkmcnt(" #n ")" ::: "memory")
#define PG8_BAR __builtin_amdgcn_s_barrier()
#define PG8_SCHED __builtin_amdgcn_sched_barrier(0)
    Unit cur, nxt; int ui = 0;
    if (!S.next(0, cur)) return;
    f32x4 acc[2][2][4][2];
#pragma unroll
    for (int a = 0; a < 2; ++a)
#pragma unroll
        for (int b = 0; b < 2; ++b)
#pragma unroll
            for (int m = 0; m < 4; ++m)
#pragma unroll
                for (int n = 0; n < 2; ++n) acc[a][b][m][n] = (f32x4){0.f, 0.f, 0.f, 0.f};
    bf16x8 At[4][2], B0[2][2], B1[2][2];
    const char* cA = (const char*)g.A + (size_t)cur.pm * tstep; const char* cB = (const char*)g.Bt + (size_t)cur.pn * tstep;
    S.a_ready(cur);
    if constexpr (SP2) {
        PG8_STAGE(PG8_SB(0, 0), cB, voffB); PG8_STAGE(PG8_SB(0, 1), cB + hstep, voffB); PG8_STAGE(PG8_SA(0, 0), cA, voffA); PG8_STAGE(PG8_SA(0, 1), cA + hstep, voffA);
        if (wr == 1) PG8_BAR;
        PG8_WAIT_V(2); PG8_BAR;
        PG8_STAGE(PG8_SB(1, 0), cB + kstep, voffB); PG8_STAGE(PG8_SA(1, 0), cA + kstep, voffA); PG8_STAGE(PG8_SB(1, 1), cB + hstep + kstep, voffB);
        PG8_WAIT_V(6); PG8_BAR;
    } else {
        PG8_STAGE(PG8_SB(0, 0), cB, voffB); PG8_STAGE(PG8_SA(0, 0), cA, voffA); PG8_STAGE(PG8_SB(0, 1), cB + hstep, voffB); PG8_STAGE(PG8_SA(0, 1), cA + hstep, voffA);
        if (wr == 1) PG8_BAR;
        PG8_WAIT_V(4); PG8_BAR;
        PG8_STAGE(PG8_SB(1, 0), cB + kstep, voffB); PG8_STAGE(PG8_SA(1, 0), cA + kstep, voffA); PG8_STAGE(PG8_SB(1, 1), cB + hstep + kstep, voffB);
        PG8_WAIT_V(6); PG8_BAR;
    }
    for (;;) {
        const bool has_next = S.next(ui + 1, nxt);
        const char* nA = has_next ? (const char*)g.A + (size_t)nxt.pm * tstep : cA; const char* nB = has_next ? (const char*)g.Bt + (size_t)nxt.pn * tstep : cB;
        for (int t = 0; t < nt; t += 2) {
            const bool last = (t == nt - 2);
            const char* a1 = cA + (size_t)(t + 1) * kstep;
            const char* a2 = last ? nA : cA + (size_t)(t + 2) * kstep; const char* b2 = last ? nB : cB + (size_t)(t + 2) * kstep;
            const char* a3 = a2 + kstep; const char* b3 = b2 + kstep;
            if (last && has_next) S.a_ready(nxt);
            if constexpr (SP2) {
            PG8_LDB(B0, 0, 0); PG8_LDB(B1, 0, 1); PG8_SCHED; PG8_LDA(At, 0, 0); PG8_STAGE(PG8_SA(1, 1), a1 + hstep, voffA);
            PG8_WAIT_V(8); PG8_WAIT_L(0); PG8_BAR; PG8_MMA(0, 0, At, B0); PG8_MMA(0, 1, At, B1); PG8_BAR; PG8_SCHED;
            PG8_LDA(At, 0, 1); PG8_STAGE(PG8_SB(0, 0), b2, voffB); PG8_STAGE(PG8_SB(0, 1), b2 + hstep, voffB); PG8_STAGE(PG8_SA(0, 0), a2, voffA);
            PG8_WAIT_V(8); PG8_WAIT_L(0); PG8_BAR; PG8_MMA(1, 0, At, B0); PG8_MMA(1, 1, At, B1); PG8_BAR; PG8_SCHED;
            PG8_LDB(B0, 1, 0); PG8_LDB(B1, 1, 1); PG8_SCHED; PG8_LDA(At, 1, 0); PG8_STAGE(PG8_SA(0, 1), a2 + hstep, voffA);
            PG8_WAIT_V(8); PG8_WAIT_L(0); PG8_BAR; PG8_MMA(0, 0, At, B0); PG8_MMA(0, 1, At, B1); PG8_BAR; PG8_SCHED;
            PG8_LDA(At, 1, 1); PG8_STAGE(PG8_SB(1, 0), b3, voffB); PG8_STAGE(PG8_SB(1, 1), b3 + hstep, voffB); PG8_STAGE(PG8_SA(1, 0), a3, voffA);
            PG8_WAIT_V(8); PG8_WAIT_L(0); PG8_BAR; PG8_MMA(1, 0, At, B0); PG8_MMA(1, 1, At, B1); PG8_BAR; PG8_SCHED;
            } else {
            PG8_LDB(B0, 0, 0); PG8_SCHED; PG8_LDA(At, 0, 0); PG8_STAGE(PG8_SA(1, 1), a1 + hstep, voffA);
            PG8_WAIT_L(8); PG8_BAR; PG8_WAIT_L(0); PG8_MMA(0, 0, At, B0); PG8_BAR; PG8_SCHED;
            PG8_LDB(B1, 0, 1); PG8_STAGE(PG8_SB(0, 0), b2, voffB);
            PG8_BAR; PG8_WAIT_L(0); PG8_MMA(0, 1, At, B1); PG8_BAR;
            PG8_LDA(At, 0, 1); PG8_STAGE(PG8_SA(0, 0), a2, voffA);
            PG8_BAR; PG8_WAIT_L(0); PG8_MMA(1, 0, At, B0); PG8_BAR; PG8_SCHED;
            PG8_STAGE(PG8_SB(0, 1), b2 + hstep, voffB);
            PG8_WAIT_V(6); PG8_BAR; PG8_MMA(1, 1, At, B1); PG8_BAR;
            PG8_LDB(B0, 1, 0); PG8_SCHED; PG8_LDA(At, 1, 0); PG8_STAGE(PG8_SA(0, 1), a2 + hstep, voffA);
            PG8_WAIT_L(8); PG8_BAR; PG8_WAIT_L(0); PG8_MMA(0, 0, At, B0); PG8_BAR; PG8_SCHED;
            PG8_LDB(B1, 1, 1); PG8_STAGE(PG8_SB(1, 0), b3, voffB);
            PG8_BAR; PG8_WAIT_L(0); PG8_MMA(0, 1, At, B1); PG8_BAR;
            PG8_LDA(At, 1, 1); PG8_STAGE(PG8_SA(1, 0), a3, voffA);
            PG8_BAR; PG8_WAIT_L(0); PG8_MMA(1, 0, At, B0); PG8_BAR; PG8_SCHED;
            PG8_STAGE(PG8_SB(1, 1), b3 + hstep, voffB);
            PG8_WAIT_V(6); PG8_BAR; PG8_MMA(1, 1, At, B1); PG8_BAR;
            }
        }
        if constexpr (ALIGN_EPI) { if (wr == 0) PG8_BAR; }
        if constexpr (!Epi::AFTER_DRAIN) { E(acc, cur, wr, wc, fr, fq); S.done(cur); }
        if (!has_next) break;
#pragma unroll
        for (int a = 0; a < 2; ++a)
#pragma unroll
            for (int b = 0; b < 2; ++b)
#pragma unroll
                for (int m = 0; m < 4; ++m)
#pragma unroll
                    for (int n = 0; n < 2; ++n) acc[a][b][m][n] = (f32x4){0.f, 0.f, 0.f, 0.f};
        cur = nxt; cA = nA; cB = nB; ++ui;
        if constexpr (ALIGN_EPI) { if (wr == 1) PG8_BAR; }
    }
    PG8_WAIT_V(0);
    if constexpr (!ALIGN_EPI) { if (wr == 0) PG8_BAR; }
    PG8_BAR;
    if constexpr (Epi::AFTER_DRAIN) { E.fused(acc, cur, wr, wc, fr, fq, lds, wid, lane); S.done(cur); }
#undef PG8_SA
#undef PG8_SB
#undef PG8_STAGE
#undef PG8_LDA
#undef PG8_LDB
#undef PG8_MMA
#undef PG8_WAIT_V
#undef PG8_WAIT_L
#undef PG8_BAR
#undef PG8_SCHED
}
}

constexpr int NWAVES = 8;
constexpr int TT = 16384, DM = 2048, SEQ = 2048;
constexpr int NPROJ = 11264;
constexpr int PC_Z = 0, PC_XBC = 2048, PC_Q = 5120, PC_K = 6144, PC_V = 7168, PC_O = 9216;
constexpr int WIN_LD = 11312;
constexpr int NSLOT = 65536 + 32 * 256;
constexpr float EPSF = 1e-5f;
#ifndef MK_PER_PHASE
#define MK_PER_PHASE 0
#endif
constexpr int N_PHASES = 10;

constexpr size_t MiB = 1u << 20;
constexpr size_t WS_CTL = 0, CTL_ZERO_BYTES = 1 * MiB;
constexpr size_t WS_WIN = 2 * MiB, WS_WSM = 46 * MiB, WS_WRT = 47 * MiB, WS_WOUT = 48 * MiB, WS_WGU = 64 * MiB, WS_WD = 576 * MiB;
constexpr size_t WS_XN1 = 832 * MiB, WS_PROJ = 896 * MiB, WS_SMALL = 1248 * MiB, WS_SSQ = 1252 * MiB, WS_YMIX = 1256 * MiB, WS_H2 = 1384 * MiB, WS_XN2 = 1512 * MiB;
constexpr size_t WS_ROUTE = 1576 * MiB, WS_XG = 1578 * MiB, WS_ACT = 1866 * MiB, WS_YR = 2154 * MiB, WS_END = 2442 * MiB;
constexpr int CW_BAR = 4096;
constexpr int CW_CNT = 65536;

constexpr int RING_BYTES = 131072;
constexpr int LDSCTL_OFF = RING_BYTES, MISC_OFF = LDSCTL_OFF + 320;
constexpr int TAB_OFF = LDSCTL_OFF + 1024;
constexpr int LDS_BYTES = 147456;

#define GAS __attribute__((address_space(1)))
#define LAS __attribute__((address_space(3)))
typedef unsigned short bf16;
typedef unsigned v4u __attribute__((ext_vector_type(4)));
typedef unsigned v2u __attribute__((ext_vector_type(2)));
typedef float f32x4 __attribute__((ext_vector_type(4)));
typedef float f32x2 __attribute__((ext_vector_type(2)));
typedef short bf16x8 __attribute__((ext_vector_type(8)));
typedef GAS unsigned gu32;
#define RLX_AGENT __ATOMIC_RELAXED, __HIP_MEMORY_SCOPE_AGENT
#define LDS_WAIT() asm volatile("s_waitcnt lgkmcnt(0)" ::: "memory")
#define VM_WAIT() asm volatile("s_waitcnt vmcnt(0)" ::: "memory")
__device__ __forceinline__ unsigned f2bf(float f) { unsigned u = __builtin_bit_cast(unsigned, f); return (u + 0x7fffu + ((u >> 16) & 1u)) >> 16; }
__device__ __forceinline__ unsigned pk2(float lo, float hi) { return f2bf(lo) | (f2bf(hi) << 16); }
__device__ __forceinline__ float bflo(unsigned w) { return __builtin_bit_cast(float, w << 16); }
__device__ __forceinline__ float bfhi(unsigned w) { return __builtin_bit_cast(float, w & 0xffff0000u); }
__device__ __forceinline__ float wave_sum(float v) {
#pragma unroll
    for (int o = 1; o < 64; o <<= 1) v += __shfl_xor(v, o);
    return v;
}
__device__ __forceinline__ float softplusf(float x) { return x > 20.f ? x : log1pf(expf(x)); }
__device__ __forceinline__ float logsigf(float x) { return fminf(x, 0.f) - log1pf(expf(-fabsf(x))); }
__device__ __forceinline__ float siluf(float v) { return v / (1.0f + __expf(-v)); }

#define XB_TMO      128
#define XB_XCNT(j)  (256  + 64 * (j))
#define XB_XSUB(j)  (1280 + 64 * (j))
#define XB_XGEN(j)  (2304 + 64 * (j))
#define XB_TOP      3328
#define XB_TOPGEN   3392
#define XCD_BAR_WORDS 3456
#define XB_SPIN_CAP (1u << 18)

__device__ __forceinline__ unsigned xb_ld(unsigned* p)              { return __hip_atomic_load(p, __ATOMIC_RELAXED, __HIP_MEMORY_SCOPE_AGENT); }
__device__ __forceinline__ unsigned xb_add(unsigned* p, unsigned v) { return __hip_atomic_fetch_add(p, v, __ATOMIC_RELAXED, __HIP_MEMORY_SCOPE_AGENT); }
__device__ __forceinline__ unsigned xb_xcc_id() { return (unsigned)__builtin_amdgcn_s_getreg((3 << 11) | 20) & 0xFu; }
#define XB_SPIN(cond, bar) do { unsigned _sp = 0; while (cond) { __builtin_amdgcn_s_sleep(1); \
    if ((++_sp & 255u) == 0u) { if (xb_ld(&(bar)[XB_TMO])) break; if (_sp > XB_SPIN_CAP) { atomicAdd(&(bar)[XB_TMO], 1u); break; } } } } while (0)

struct XcdBarrier {
    unsigned* bar; unsigned x;
    volatile LAS unsigned* st;
};

__device__ __forceinline__ XcdBarrier xcd_barrier_post(unsigned* bar, volatile LAS unsigned* st) {
    XcdBarrier b; b.bar = bar; b.x = xb_xcc_id(); b.st = st;
    if (threadIdx.x == 0) (void)xb_add(&bar[XB_XCNT(b.x)], 1u);
    return b;
}
__device__ __forceinline__ void xcd_barrier_complete(unsigned* bar, unsigned x, unsigned& nloc, unsigned& nx) {
    const unsigned G = gridDim.x * gridDim.y * gridDim.z;
    unsigned sum, cnt, mine, sp = 0u;
    for (;;) {
        sum = 0u; cnt = 0u; mine = 0u;
#pragma unroll
        for (unsigned j = 0; j < 16; ++j) { const unsigned c = xb_ld(&bar[XB_XCNT(j)]); sum += c; cnt += (c > 0u) ? 1u : 0u; mine = (j == x) ? c : mine; }
        if (sum == G) break;
        __builtin_amdgcn_s_sleep(1);
        if ((++sp & 255u) == 0u) { if (xb_ld(&bar[XB_TMO])) break; if (sp > XB_SPIN_CAP) { atomicAdd(&bar[XB_TMO], 1u); break; } }
    }
    nloc = mine > 0u ? mine : 1u; nx = cnt > 0u ? cnt : 1u;
}

__device__ __forceinline__ void xcd_barrier(const XcdBarrier& b) {
    asm volatile("s_waitcnt vmcnt(0)" ::: "memory");
    __syncthreads();
    if (threadIdx.x == 0) {
        unsigned* bar = b.bar;
        __builtin_amdgcn_s_waitcnt(0);
        unsigned nloc = b.st[0], nx = b.st[1];
        if (nloc == 0u) { xcd_barrier_complete(bar, b.x, nloc, nx); b.st[0] = nloc; b.st[1] = nx; }
        const unsigned old = xb_add(&bar[XB_XSUB(b.x)], 1u);
        const unsigned gen = old / nloc;
        if (old + 1u == (gen + 1u) * nloc) {
            __builtin_amdgcn_fence(__ATOMIC_RELEASE, "agent");
            asm volatile("s_waitcnt vmcnt(0)" ::: "memory");
            const unsigned og = xb_add(&bar[XB_TOP], 1u);
            const unsigned tg = og / nx;
            if (og + 1u == (tg + 1u) * nx) xb_add(&bar[XB_TOPGEN], 1u);
            else XB_SPIN(xb_ld(&bar[XB_TOPGEN]) == tg, bar);
            __builtin_amdgcn_fence(__ATOMIC_ACQUIRE, "agent");
            xb_add(&bar[XB_XGEN(b.x)], 1u);
            asm volatile("s_waitcnt vmcnt(0)" ::: "memory");
        } else {
            XB_SPIN(xb_ld(&bar[XB_XGEN(b.x)]) == gen, bar);
            __builtin_amdgcn_fence(__ATOMIC_ACQUIRE, "agent");
            asm volatile("s_waitcnt vmcnt(0)" ::: "memory");
        }
    }
    __syncthreads();
}

struct Frame {
    LAS unsigned char* lds;
    volatile LAS unsigned* MISC;
    gu32* ctl;
    int tid, lane, wave, G, bid;
    const float *x, *norm1_w, *w_in, *conv_w, *conv_b, *dt_bias, *a_log, *d_skip, *ssd_norm_w, *i_bias, *f_bias, *ml_norm_w, *w_out, *norm2_w, *router_w, *router_b, *w_gate_up, *b_gate_up, *w_down, *b_down, *final_norm_w;
    float* out; unsigned char* ws;
};

__device__ __forceinline__ void p0_transpose_item(const float* W, int ldw, int K, bf16* WT, int dst_row0, int src_col0, int k0, LAS float* scr, int lane) {
#pragma unroll 8
    for (int i = 0; i < 32; ++i) { const int kk = 2 * i + (lane >> 5); scr[kk * 33 + (lane & 31)] = W[(size_t)(k0 + kk) * ldw + src_col0 + (lane & 31)]; }
    LDS_WAIT(); asm volatile("" ::: "memory");
    const int c = lane & 7;
#pragma unroll
    for (int j = 0; j < 4; ++j) { const int n = (lane >> 3) + 8 * j; const LAS float* s = scr + (8 * c) * 33 + n;
        v4u o; o.x = pk2(s[0 * 33], s[1 * 33]); o.y = pk2(s[2 * 33], s[3 * 33]); o.z = pk2(s[4 * 33], s[5 * 33]); o.w = pk2(s[6 * 33], s[7 * 33]);
        *(v4u*)(WT + (size_t)(dst_row0 + n) * K + k0 + 8 * c) = o; }
    LDS_WAIT(); asm volatile("" ::: "memory");
}
__device__ __forceinline__ void rms_row_to_bf16(const float* xrow, const float* w, bf16* orow, int lane) {
    const f32x4* xr = (const f32x4*)xrow + lane; const f32x4* wr = (const f32x4*)w + lane;
    f32x4 v[8]; float s = 0.f;
#pragma unroll
    for (int j = 0; j < 8; ++j) { v[j] = xr[64 * j]; s += (v[j].x * v[j].x + v[j].y * v[j].y) + (v[j].z * v[j].z + v[j].w * v[j].w); }
    const float rstd = 1.0f / sqrtf(wave_sum(s) * (1.0f / 2048.0f) + EPSF);
    v2u* o8 = (v2u*)orow + lane;
#pragma unroll
    for (int j = 0; j < 8; ++j) { const f32x4 ww = wr[64 * j]; v2u o; o.x = pk2(v[j].x * rstd * ww.x, v[j].y * rstd * ww.y); o.y = pk2(v[j].z * rstd * ww.z, v[j].w * rstd * ww.w); o8[64 * j] = o; }
}
__device__ __forceinline__ void phase0(Frame& F) {
    LAS float* scr = (LAS float*)(F.lds + F.wave * 16384);
    const int gw = F.bid * NWAVES + F.wave, NGW = F.G * NWAVES;
    bf16* WinT = (bf16*)(F.ws + WS_WIN); bf16* WsT = (bf16*)(F.ws + WS_WSM); float* Wrt = (float*)(F.ws + WS_WRT); bf16* WoutT = (bf16*)(F.ws + WS_WOUT);
    bf16* WguT = (bf16*)(F.ws + WS_WGU); bf16* WdT = (bf16*)(F.ws + WS_WD); bf16* XN1 = (bf16*)(F.ws + WS_XN1);
    constexpr int I_IN = 32 * 352, I_OUT = 64 * 64, I_GU = 32 * 4096, I_D = 32 * 2048, NITEMS = I_IN + I_OUT + I_GU + I_D;
    for (int it = gw; it < NITEMS; it += NGW) {
        int r = it;
        if (r < I_IN) { const int kb = r / 352, nb = r % 352, n0 = nb * 32; p0_transpose_item(F.w_in, WIN_LD, 2048, WinT, n0, n0 + (n0 >= 5120 ? 32 : 0), kb * 64, scr, F.lane); continue; } r -= I_IN;
        if (r < I_OUT) { const int kb = r >> 6, nb = r & 63; p0_transpose_item(F.w_out, 2048, 4096, WoutT, nb * 32, nb * 32, kb * 64, scr, F.lane); continue; } r -= I_OUT;
        if (r < I_GU) { const int e = r >> 12, rr = r & 4095, kb = rr >> 7, nb = rr & 127; p0_transpose_item(F.w_gate_up + (size_t)e * 2048 * 4096, 4096, 2048, WguT + (size_t)e * 4096 * 2048, nb * 32, nb * 32, kb * 64, scr, F.lane); continue; } r -= I_GU;
        { const int e = r >> 11, rr = r & 2047, kb = rr >> 6, nb = rr & 63; p0_transpose_item(F.w_down + (size_t)e * 2048 * 2048, 2048, 2048, WdT + (size_t)e * 2048 * 2048, nb * 32, nb * 32, kb * 64, scr, F.lane); }
    }
    for (int i = gw * 64 + F.lane; i < 64 * 2048; i += NGW * 64) { const int j = i >> 11, k = i & 2047;
        const int col = j < 32 ? 5120 + j : (j < 40 ? 11296 + (j - 32) : 11304 + (j - 40));
        WsT[i] = (bf16)(j < 48 ? f2bf(F.w_in[(size_t)k * WIN_LD + col]) : 0u); }
    for (int i = gw * 64 + F.lane; i < 2048 * 32; i += NGW * 64) Wrt[i] = F.norm2_w[i >> 5] * F.router_w[i];
    for (int m = gw; m < TT; m += NGW) rms_row_to_bf16(F.x + (size_t)m * DM, F.norm1_w, XN1 + (size_t)m * DM, F.lane);
}

__device__ __forceinline__ void p1_small(Frame& F) {
    const bf16* XN1 = (const bf16*)(F.ws + WS_XN1); const bf16* WsT = (const bf16*)(F.ws + WS_WSM); float* SMALL = (float*)(F.ws + WS_SMALL);
    const int gw = F.bid * NWAVES + F.wave, NGW = F.G * NWAVES, fr = F.lane & 15, fq = F.lane >> 4;
    for (int task = gw; task < TT / 16; task += NGW) {
        const int t0 = task * 16;
        f32x4 acc[4];
#pragma unroll
        for (int n = 0; n < 4; ++n) acc[n] = (f32x4){0.f, 0.f, 0.f, 0.f};
        const bf16* arow = XN1 + (size_t)(t0 + fr) * DM + 8 * fq; const bf16* brow = WsT + (size_t)fr * DM + 8 * fq;
#pragma unroll 4
        for (int ks = 0; ks < 64; ++ks) {
            const bf16x8 a = *(const bf16x8*)(arow + 32 * ks);
#pragma unroll
            for (int n = 0; n < 4; ++n) { const bf16x8 b = *(const bf16x8*)(brow + (size_t)n * 16 * DM + 32 * ks); acc[n] = __builtin_amdgcn_mfma_f32_16x16x32_bf16(a, b, acc[n], 0, 0, 0); }
        }
#pragma unroll
        for (int n = 0; n < 4; ++n)
#pragma unroll
            for (int r = 0; r < 4; ++r) SMALL[(size_t)(t0 + 4 * fq + r) * 64 + n * 16 + fr] = acc[n][r];
    }
}

__device__ __forceinline__ void unpack8(const v4u r, float (&f)[8]) { f[0] = bflo(r.x); f[1] = bfhi(r.x); f[2] = bflo(r.y); f[3] = bfhi(r.y); f[4] = bflo(r.z); f[5] = bfhi(r.z); f[6] = bflo(r.w); f[7] = bfhi(r.w); }
__device__ __forceinline__ void phase2(Frame& F) {
    const bf16* PROJ = (const bf16*)(F.ws + WS_PROJ); const float* SMALL = (const float*)(F.ws + WS_SMALL);
    bf16* YMIX = (bf16*)(F.ws + WS_YMIX); float* SSQ = (float*)(F.ws + WS_SSQ);
    const int role = F.tid >> 8, u = F.tid & 255;
    constexpr int BUF = 20736, NCH = SEQ / 16;
    LAS float* cwl = (LAS float*)(F.lds + 99328);
    for (int unit = F.bid; unit < 256; unit += F.G) {
        const int b = unit >> 5, tok0 = b * SEQ;
        const int hd = unit & 31, grp = hd >> 3;
        const int mh = (unit & 31) >> 2, vq = unit & 3;
        float ssd_a = 0.f, ssd_D = 0.f, ssd_dtb = 0.f, ml_ib = 0.f, ml_fb = 0.f;
        if (role == 0) { ssd_a = -expf(F.a_log[hd]); ssd_D = F.d_skip[hd]; ssd_dtb = F.dt_bias[hd];
            for (int ci = u; ci < 320; ci += 256) { const int cgi = ci >> 3, wi = ci & 7;
                const int ch = cgi < 8 ? hd * 64 + cgi * 8 + wi : (cgi < 24 ? 2048 + grp * 128 + (cgi - 8) * 8 + wi : 2560 + grp * 128 + (cgi - 24) * 8 + wi);
#pragma unroll
                for (int j = 0; j < 4; ++j) cwl[j * 320 + ci] = F.conv_w[j * 3072 + ch];
                cwl[4 * 320 + ci] = F.conv_b[ch]; }
        } else { ml_ib = F.i_bias[mh]; ml_fb = F.f_bias[mh]; }
        __syncthreads();
        f32x2 st[16]; float nst[8];
#pragma unroll
        for (int i = 0; i < 16; ++i) st[i] = (f32x2){0.f, 0.f};
#pragma unroll
        for (int i = 0; i < 8; ++i) nst[i] = 0.f;
        float mcar = 0.f;
        v4u raw[7]; float dtr = 0.f; v4u mq, mk, mv; float mi = 0.f, mf = 0.f;
#pragma unroll
        for (int r = 0; r < 7; ++r) raw[r] = (v4u){0u, 0u, 0u, 0u};
        mq = mk = mv = (v4u){0u, 0u, 0u, 0u};
        const int s_cg = u % 40, s_lq = u / 40;
        const int s_ch0 = s_cg < 8 ? hd * 64 + s_cg * 8 : (s_cg < 24 ? 2048 + grp * 128 + (s_cg - 8) * 8 : 2560 + grp * 128 + (s_cg - 24) * 8);
        const int pi = u >> 4, ni = u & 15;
#define P2_PREFETCH(c) do { \
        if (role == 0) { \
            if (u < 160) { _Pragma("unroll") for (int r = 0; r < 7; ++r) { const int lrow = 16 * (c) + 4 * s_lq - 3 + r; \
                raw[r] = lrow >= 0 ? *(const v4u*)(PROJ + (size_t)(tok0 + lrow) * NPROJ + PC_XBC + s_ch0) : (v4u){0u, 0u, 0u, 0u}; } } \
            else if (u < 176) dtr = SMALL[(size_t)(tok0 + 16 * (c) + (u - 160)) * 64 + hd]; \
        } else { \
            { const int l = u >> 4, k8 = u & 15; const bf16* rowp = PROJ + (size_t)(tok0 + 16 * (c) + l) * NPROJ; \
              mq = *(const v4u*)(rowp + PC_Q + mh * 128 + 8 * k8); mk = *(const v4u*)(rowp + PC_K + mh * 128 + 8 * k8); } \
            if (u < 128) { const int l = u >> 3, v8 = u & 7; mv = *(const v4u*)(PROJ + (size_t)(tok0 + 16 * (c) + l) * NPROJ + PC_V + mh * 256 + vq * 64 + 8 * v8); } \
            else if (u < 144) { const float* sp = SMALL + (size_t)(tok0 + 16 * (c) + (u - 128)) * 64; mi = sp[32 + mh]; mf = sp[40 + mh]; } \
        } } while (0)
#define P2_WRITE(bufi) do { \
        LAS float* bb = (LAS float*)(F.lds + (role * 2 + (bufi)) * BUF); \
        if (role == 0) { \
            if (u < 160) { \
                LAS float* dst = s_cg < 8 ? bb + s_cg * 8 : (s_cg < 24 ? bb + 1024 + (s_cg - 8) * 8 : bb + 3072 + (s_cg - 24) * 8); const int dstride = s_cg < 8 ? 64 : 128; \
                _Pragma("unroll") for (int d = 0; d < 4; ++d) { \
                    float wl[4], wh[4]; _Pragma("unroll") for (int j = 0; j < 4; ++j) { const f32x2 ww = *(LAS f32x2*)(cwl + j * 320 + s_cg * 8 + 2 * d); wl[j] = ww.x; wh[j] = ww.y; } \
                    const f32x2 bsv = *(LAS f32x2*)(cwl + 4 * 320 + s_cg * 8 + 2 * d); \
                    float rl[7], rh[7]; _Pragma("unroll") for (int r = 0; r < 7; ++r) { rl[r] = bflo(raw[r][d]); rh[r] = bfhi(raw[r][d]); } \
                    _Pragma("unroll") for (int li = 0; li < 4; ++li) { float vl = bsv.x, vh = bsv.y; \
                        _Pragma("unroll") for (int j = 0; j < 4; ++j) { vl += wl[j] * rl[li + j]; vh += wh[j] * rh[li + j]; } \
                        *(LAS f32x2*)(dst + (4 * s_lq + li) * dstride + 2 * d) = (f32x2){siluf(vl), siluf(vh)}; } } } \
            else if (u < 176) { const float dtv = softplusf(dtr + ssd_dtb); *(LAS f32x2*)(bb + 5120 + 2 * (u - 160)) = (f32x2){dtv, expf(dtv * ssd_a)}; } \
        } else { \
            { const int l = u >> 4, k8 = u & 15; float f[8]; unpack8(mq, f); LAS float* dp = bb + l * 128 + 8 * k8; *(LAS f32x4*)dp = (f32x4){f[0], f[1], f[2], f[3]}; *(LAS f32x4*)(dp + 4) = (f32x4){f[4], f[5], f[6], f[7]}; \
              unpack8(mk, f); dp = bb + 2048 + l * 128 + 8 * k8; *(LAS f32x4*)dp = (f32x4){f[0], f[1], f[2], f[3]}; *(LAS f32x4*)(dp + 4) = (f32x4){f[4], f[5], f[6], f[7]}; } \
            if (u < 128) { const int l = u >> 3, v8 = u & 7; float f[8]; unpack8(mv, f); LAS float* dp = bb + 4096 + l * 64 + 8 * v8; *(LAS f32x4*)dp = (f32x4){f[0], f[1], f[2], f[3]}; *(LAS f32x4*)(dp + 4) = (f32x4){f[4], f[5], f[6], f[7]}; } \
            else if (u < 144) { const int l16 = u - 128; const float li_ = mi + ml_ib, lf_ = logsigf(mf + ml_fb); \
                float Fc = lf_; _Pragma("unroll") for (int d = 1; d < 16; d <<= 1) { const float t_ = __shfl_up(Fc, d, 16); if (l16 >= d) Fc += t_; } \
                float pmx = li_ - Fc; _Pragma("unroll") for (int d = 1; d < 16; d <<= 1) { const float t_ = __shfl_up(pmx, d, 16); if (l16 >= d) pmx = fmaxf(pmx, t_); } \
                const float mt = Fc + fmaxf(mcar, pmx); float mprev = __shfl_up(mt, 1, 16); if (l16 == 0) mprev = mcar; \
                *(LAS f32x4*)(bb + 5120 + 4 * l16) = (f32x4){expf(lf_ + mprev - mt), expf(li_ - mt), expf(-mt), 0.f}; \
                mcar = __shfl(mt, 15, 16); } \
        } } while (0)
#define P2_EPILOGUE(c) do { \
        const LAS float* yb = (const LAS float*)(F.lds + 82944 + (role * 2 + ((c) & 1)) * 4096); \
        const int l = u >> 4, p4 = u & 15; const size_t t = (size_t)(tok0 + 16 * (c) + l); \
        const f32x4 y4 = *(const LAS f32x4*)(yb + l * 64 + 4 * p4); float o0, o1, o2, o3; \
        if (role == 0) { const v2u zz = *(const v2u*)(PROJ + t * NPROJ + PC_Z + hd * 64 + 4 * p4); \
            o0 = y4.x * siluf(bflo(zz.x)); o1 = y4.y * siluf(bfhi(zz.x)); o2 = y4.z * siluf(bflo(zz.y)); o3 = y4.w * siluf(bfhi(zz.y)); } \
        else { o0 = y4.x; o1 = y4.y; o2 = y4.z; o3 = y4.w; } \
        float ss = (o0 * o0 + o1 * o1) + (o2 * o2 + o3 * o3); ss += __shfl_xor(ss, 1); ss += __shfl_xor(ss, 2); ss += __shfl_xor(ss, 4); ss += __shfl_xor(ss, 8); \
        v2u ov; ov.x = pk2(o0, o1); ov.y = pk2(o2, o3); \
        if (role == 0) { if (p4 == 0) SSQ[t * 32 + hd] = ss; *(v2u*)(YMIX + t * 4096 + hd * 64 + 4 * p4) = ov; } \
        else { if (p4 == 0) SSQ[(size_t)TT * 32 + t * 32 + mh * 4 + vq] = ss; *(v2u*)(YMIX + t * 4096 + 2048 + mh * 256 + vq * 64 + 4 * p4) = ov; } \
        } while (0)
        P2_PREFETCH(0);
        P2_WRITE(0);
        __syncthreads();
        for (int c = 0; c < NCH; ++c) {
            if (c + 1 < NCH) P2_PREFETCH(c + 1);
            if (c > 0) P2_EPILOGUE(c - 1);
            const LAS float* bb = (const LAS float*)(F.lds + (role * 2 + (c & 1)) * BUF);
            LAS float* yb = (LAS float*)(F.lds + 82944 + (role * 2 + (c & 1)) * 4096);
            if (role == 0) {
                const LAS float* xs = bb; const LAS float* Bm = bb + 1024; const LAS float* Cm = bb + 3072; const LAS float* sc = bb + 5120;
#pragma unroll 1
                for (int l = 0; l < 16; ++l) {
                    const f32x4 x4 = *(const LAS f32x4*)(xs + l * 64 + 4 * pi); const f32x2 s2 = *(const LAS f32x2*)(sc + 2 * l);
                    const f32x4 b0 = *(const LAS f32x4*)(Bm + l * 128 + 8 * ni), b1 = *(const LAS f32x4*)(Bm + l * 128 + 8 * ni + 4);
                    const f32x4 c0 = *(const LAS f32x4*)(Cm + l * 128 + 8 * ni), c1 = *(const LAS f32x4*)(Cm + l * 128 + 8 * ni + 4);
                    const f32x2 bv[4] = {(f32x2){b0.x, b0.y}, (f32x2){b0.z, b0.w}, (f32x2){b1.x, b1.y}, (f32x2){b1.z, b1.w}};
                    const f32x2 cv[4] = {(f32x2){c0.x, c0.y}, (f32x2){c0.z, c0.w}, (f32x2){c1.x, c1.y}, (f32x2){c1.z, c1.w}};
                    const float xv[4] = {x4.x, x4.y, x4.z, x4.w};
                    const f32x2 dec2 = (f32x2){s2.y, s2.y};
                    float yp[4];
#pragma unroll
                    for (int i = 0; i < 4; ++i) { const float xd = xv[i] * s2.x; const f32x2 xd2 = (f32x2){xd, xd}; f32x2 a2 = (f32x2){0.f, 0.f};
#pragma unroll
                        for (int j = 0; j < 4; ++j) { st[4 * i + j] = st[4 * i + j] * dec2 + xd2 * bv[j]; a2 += cv[j] * st[4 * i + j]; }
                        yp[i] = a2.x + a2.y; }
                    const bool h8 = (ni & 8) != 0, h4 = (ni & 4) != 0;
                    float a0 = h8 ? yp[2] : yp[0], a1 = h8 ? yp[3] : yp[1]; const float s0 = h8 ? yp[0] : yp[2], s1 = h8 ? yp[1] : yp[3];
                    a0 += __shfl_xor(s0, 8); a1 += __shfl_xor(s1, 8);
                    float r0 = h4 ? a1 : a0; const float q0 = h4 ? a0 : a1; r0 += __shfl_xor(q0, 4);
                    r0 += __shfl_xor(r0, 2); r0 += __shfl_xor(r0, 1);
                    const int ii = (h8 ? 2 : 0) + (h4 ? 1 : 0);
                    const float xsel = h8 ? (h4 ? xv[3] : xv[2]) : (h4 ? xv[1] : xv[0]);
                    if ((ni & 3) == 0) yb[l * 64 + 4 * pi + ii] = r0 + ssd_D * xsel;
                }
            } else {
                const LAS float* qm = bb; const LAS float* km = bb + 2048; const LAS float* vm = bb + 4096; const LAS float* sc = bb + 5120;
#pragma unroll 1
                for (int l = 0; l < 16; ++l) {
                    const f32x4 k0 = *(const LAS f32x4*)(km + l * 128 + 8 * ni), k1 = *(const LAS f32x4*)(km + l * 128 + 8 * ni + 4);
                    const f32x4 q0 = *(const LAS f32x4*)(qm + l * 128 + 8 * ni), q1 = *(const LAS f32x4*)(qm + l * 128 + 8 * ni + 4);
                    const f32x4 v4 = *(const LAS f32x4*)(vm + l * 64 + 4 * pi); const f32x4 s4 = *(const LAS f32x4*)(sc + 4 * l);
                    const float kv[8] = {k0.x, k0.y, k0.z, k0.w, k1.x, k1.y, k1.z, k1.w}; const float qv[8] = {q0.x, q0.y, q0.z, q0.w, q1.x, q1.y, q1.z, q1.w};
                    const f32x2 a2 = (f32x2){s4.x, s4.x}; const f32x2 gv0 = (f32x2){s4.y * v4.x, s4.y * v4.y}, gv1 = (f32x2){s4.y * v4.z, s4.y * v4.w};
                    f32x2 n0 = (f32x2){0.f, 0.f}, n1 = (f32x2){0.f, 0.f}; float dn = 0.f;
#pragma unroll
                    for (int i = 0; i < 8; ++i) { const f32x2 k2 = (f32x2){kv[i], kv[i]}, q2 = (f32x2){qv[i], qv[i]};
                        st[2 * i] = st[2 * i] * a2 + k2 * gv0; st[2 * i + 1] = st[2 * i + 1] * a2 + k2 * gv1; nst[i] = nst[i] * s4.x + s4.y * kv[i];
                        n0 += q2 * st[2 * i]; n1 += q2 * st[2 * i + 1]; dn += qv[i] * nst[i]; }
                    const float yp[4] = {n0.x, n0.y, n1.x, n1.y};
                    const bool h8 = (ni & 8) != 0, h4 = (ni & 4) != 0;
                    float a0 = h8 ? yp[2] : yp[0], a1 = h8 ? yp[3] : yp[1]; const float s0 = h8 ? yp[0] : yp[2], s1 = h8 ? yp[1] : yp[3];
                    a0 += __shfl_xor(s0, 8); a1 += __shfl_xor(s1, 8);
                    float r0 = h4 ? a1 : a0; const float q0_ = h4 ? a0 : a1; r0 += __shfl_xor(q0_, 4);
                    r0 += __shfl_xor(r0, 2); r0 += __shfl_xor(r0, 1);
                    dn += __shfl_xor(dn, 8); dn += __shfl_xor(dn, 4); dn += __shfl_xor(dn, 2); dn += __shfl_xor(dn, 1);
                    const int ii = (h8 ? 2 : 0) + (h4 ? 1 : 0);
                    const float qs = 0.08838834764831845f;
                    const float den = fmaxf(fabsf(dn * qs), s4.z);
                    if ((ni & 3) == 0) yb[l * 64 + 4 * pi + ii] = (r0 * qs) / den;
                }
            }
            if (c + 1 < NCH) P2_WRITE((c + 1) & 1);
            __syncthreads();
        }
        P2_EPILOGUE(NCH - 1);
        __syncthreads();
#undef P2_PREFETCH
#undef P2_WRITE
#undef P2_EPILOGUE
    }
}

__device__ __forceinline__ void phase3(Frame& F) {
    const bf16* PROJ = (const bf16*)(F.ws + WS_PROJ); bf16* YMIX = (bf16*)(F.ws + WS_YMIX); const float* SSQ = (const float*)(F.ws + WS_SSQ);
    const int gw = F.bid * NWAVES + F.wave, NGW = F.G * NWAVES;
    for (int t = gw; t < TT; t += NGW) {
        bf16* yrow = YMIX + (size_t)t * 4096;
#pragma unroll
        for (int j = 0; j < 8; ++j) {
            const int c0 = (j * 64 + F.lane) * 8;
            float y[8]; unpack8(*(const v4u*)(yrow + c0), y);
            float o[8];
            if (j < 4) {
                const int g = c0 >> 9; const f32x4 s0 = *(const f32x4*)(SSQ + (size_t)t * 32 + g * 8), s1 = *(const f32x4*)(SSQ + (size_t)t * 32 + g * 8 + 4);
                const float ms = ((s0.x + s0.y) + (s0.z + s0.w) + (s1.x + s1.y) + (s1.z + s1.w)) * (1.0f / 512.0f);
                const float rs = 1.0f / sqrtf(ms + EPSF);
                const f32x4 w0 = *(const f32x4*)(F.ssd_norm_w + c0), w1 = *(const f32x4*)(F.ssd_norm_w + c0 + 4);
                o[0] = y[0] * rs * w0.x; o[1] = y[1] * rs * w0.y; o[2] = y[2] * rs * w0.z; o[3] = y[3] * rs * w0.w;
                o[4] = y[4] * rs * w1.x; o[5] = y[5] * rs * w1.y; o[6] = y[6] * rs * w1.z; o[7] = y[7] * rs * w1.w;
            } else {
                const int cc = c0 - 2048, h = cc >> 8; const f32x4 s0 = *(const f32x4*)(SSQ + (size_t)TT * 32 + (size_t)t * 32 + h * 4);
                const float ms = ((s0.x + s0.y) + (s0.z + s0.w)) * (1.0f / 256.0f);
                const float rs = 1.0f / sqrtf(ms + EPSF);
                const f32x4 w0 = *(const f32x4*)(F.ml_norm_w + cc), w1 = *(const f32x4*)(F.ml_norm_w + cc + 4);
                float og[8]; unpack8(*(const v4u*)(PROJ + (size_t)t * NPROJ + PC_O + cc), og);
                const float wv[8] = {w0.x, w0.y, w0.z, w0.w, w1.x, w1.y, w1.z, w1.w};
#pragma unroll
                for (int i = 0; i < 8; ++i) o[i] = y[i] * rs * wv[i] * (1.0f / (1.0f + __expf(-og[i])));
            }
            v4u ov; ov.x = pk2(o[0], o[1]); ov.y = pk2(o[2], o[3]); ov.z = pk2(o[4], o[5]); ov.w = pk2(o[6], o[7]);
            *(v4u*)(yrow + c0) = ov;
        }
    }
}

__device__ __forceinline__ void phase5(Frame& F) {
    const float* H2 = (const float*)(F.ws + WS_H2); const float* Wrt = (const float*)(F.ws + WS_WRT); bf16* XN2 = (bf16*)(F.ws + WS_XN2);
    int* EIDX = (int*)(F.ws + WS_ROUTE); int* RANK = EIDX + TT * 4; float* GATE = (float*)(RANK + TT * 4);
    LAS float* xT = (LAS float*)(F.lds + F.wave * 8192); LAS float* lg = (LAS float*)(F.lds + 65536 + F.wave * 1024);
    LAS int* cntl = (LAS int*)(F.lds + 73728); LAS int* baseg = cntl + 32;
    const int gw = F.bid * NWAVES + F.wave, NGW = F.G * NWAVES, ntask = TT / 8, iters = (ntask + NGW - 1) / NGW;
    for (int itx = 0; itx < iters; ++itx) {
        const int task = itx * NGW + gw; const bool valid = task < ntask; const int t0 = task * 8;
        if (F.tid < 32) cntl[F.tid] = 0;
        __syncthreads();
        float rstd[8]; int me[4] = {0, 0, 0, 0}, mr[4] = {0, 0, 0, 0}; float mg[4] = {0.f, 0.f, 0.f, 0.f};
#pragma unroll
        for (int k = 0; k < 8; ++k) rstd[k] = 0.f;
        if (valid) {
            float acc[8], ssq[8];
#pragma unroll
            for (int k = 0; k < 8; ++k) { acc[k] = 0.f; ssq[k] = 0.f; }
            const int e = F.lane & 31, dh = F.lane >> 5;
            for (int dc = 0; dc < 8; ++dc) {
#pragma unroll
                for (int jj = 0; jj < 4; ++jj) { float xv[8];
#pragma unroll
                    for (int k = 0; k < 8; ++k) { xv[k] = H2[(size_t)(t0 + k) * DM + dc * 256 + jj * 64 + F.lane]; ssq[k] += xv[k] * xv[k]; }
                    LAS float* dp = xT + (jj * 64 + F.lane) * 8; *(LAS f32x4*)dp = (f32x4){xv[0], xv[1], xv[2], xv[3]}; *(LAS f32x4*)(dp + 4) = (f32x4){xv[4], xv[5], xv[6], xv[7]}; }
                LDS_WAIT(); asm volatile("" ::: "memory");
                const float* wp = Wrt + (size_t)(dc * 256 + dh * 128) * 32 + e; const LAS float* xp = xT + dh * 128 * 8;
#pragma unroll 4
                for (int i = 0; i < 128; ++i) { const float w = wp[i * 32]; const f32x4 xa = *(const LAS f32x4*)(xp + i * 8), xb = *(const LAS f32x4*)(xp + i * 8 + 4);
                    acc[0] += w * xa.x; acc[1] += w * xa.y; acc[2] += w * xa.z; acc[3] += w * xa.w; acc[4] += w * xb.x; acc[5] += w * xb.y; acc[6] += w * xb.z; acc[7] += w * xb.w; }
                LDS_WAIT(); asm volatile("" ::: "memory");
            }
            const float rb = F.router_b[e];
#pragma unroll
            for (int k = 0; k < 8; ++k) { rstd[k] = 1.0f / sqrtf(wave_sum(ssq[k]) * (1.0f / 2048.0f) + EPSF);
                const float v = (acc[k] + __shfl_xor(acc[k], 32)) * rstd[k] + rb; if (F.lane < 32) lg[k * 32 + e] = v; }
            LDS_WAIT(); asm volatile("" ::: "memory");
            if (F.lane < 8) {
                const LAS float* lp = lg + F.lane * 32; float bv[4]; int bi[4] = {-1, -1, -1, -1};
#pragma unroll
                for (int p = 0; p < 4; ++p) { float best = -3.0e38f; int bidx = 0;
                    for (int q = 0; q < 32; ++q) { const float v = lp[q]; const bool taken = (q == bi[0]) | (q == bi[1]) | (q == bi[2]) | (q == bi[3]); if (!taken && v > best) { best = v; bidx = q; } }
                    bv[p] = best; bi[p] = bidx; }
                const float p1 = expf(bv[1] - bv[0]), p2 = expf(bv[2] - bv[0]), p3 = expf(bv[3] - bv[0]); const float inv = 1.0f / (1.0f + p1 + p2 + p3);
                mg[0] = inv; mg[1] = p1 * inv; mg[2] = p2 * inv; mg[3] = p3 * inv;
#pragma unroll
                for (int p = 0; p < 4; ++p) { me[p] = bi[p]; mr[p] = __hip_atomic_fetch_add(cntl + bi[p], 1, __ATOMIC_RELAXED, __HIP_MEMORY_SCOPE_WORKGROUP); }
            }
        }
        __syncthreads();
        if (F.tid < 32) { const int c = cntl[F.tid]; int gb = 0; if (c > 0) gb = (int)__hip_atomic_fetch_add((unsigned*)(F.ctl + CW_CNT + 64 * F.tid), (unsigned)c, RLX_AGENT); baseg[F.tid] = gb; }
        __syncthreads();
        if (valid) {
            if (F.lane < 8) { const size_t t = (size_t)(t0 + F.lane);
#pragma unroll
                for (int p = 0; p < 4; ++p) { EIDX[t * 4 + p] = me[p]; RANK[t * 4 + p] = baseg[me[p]] + mr[p]; GATE[t * 4 + p] = mg[p]; } }
#pragma unroll
            for (int k = 0; k < 8; ++k) { const f32x4* xr = (const f32x4*)(H2 + (size_t)(t0 + k) * DM) + F.lane; const f32x4* wr = (const f32x4*)F.norm2_w + F.lane; v2u* o8 = (v2u*)(XN2 + (size_t)(t0 + k) * DM) + F.lane;
#pragma unroll
                for (int j = 0; j < 8; ++j) { const f32x4 v = xr[64 * j], ww = wr[64 * j]; v2u o; o.x = pk2(v.x * rstd[k] * ww.x, v.y * rstd[k] * ww.y); o.y = pk2(v.z * rstd[k] * ww.z, v.w * rstd[k] * ww.w); o8[64 * j] = o; } }
        }
        __syncthreads();
    }
}
__device__ __forceinline__ void phase5b(Frame& F) {
    const bf16* XN2 = (const bf16*)(F.ws + WS_XN2); bf16* XG = (bf16*)(F.ws + WS_XG);
    const int* EIDX = (const int*)(F.ws + WS_ROUTE); const int* RANK = EIDX + TT * 4; const float* GATE = (const float*)(RANK + TT * 4); int* SLOT = (int*)(GATE + TT * 4); float* SGATE = (float*)(SLOT + TT * 4);
    LAS int* sbase = (LAS int*)(F.lds); LAS int* spad = sbase + 32;
    if (F.tid < 32) { const int c = (int)__hip_atomic_load((unsigned*)(F.ctl + CW_CNT + 64 * F.tid), RLX_AGENT); spad[F.tid] = (c + 255) & ~255; }
    __syncthreads();
    if (F.tid == 0) { int a = 0; for (int e = 0; e < 32; ++e) { sbase[e] = a; a += spad[e]; } }
    __syncthreads();
    const int gw = F.bid * NWAVES + F.wave, NGW = F.G * NWAVES;
    for (int task = gw; task < TT / 8; task += NGW) {
#pragma unroll 2
        for (int k = 0; k < 8; ++k) { const size_t t = (size_t)task * 8 + k;
            int slot = 0;
            if (F.lane < 4) { const int e = EIDX[t * 4 + F.lane]; slot = sbase[e] + RANK[t * 4 + F.lane]; SLOT[t * 4 + F.lane] = slot; SGATE[slot] = GATE[t * 4 + F.lane]; }
            const int s0 = __shfl(slot, 0), s1 = __shfl(slot, 1), s2 = __shfl(slot, 2), s3 = __shfl(slot, 3);
            const v4u* src = (const v4u*)(XN2 + t * DM) + F.lane; v4u d[4];
#pragma unroll
            for (int j = 0; j < 4; ++j) d[j] = src[64 * j];
            v4u* d0 = (v4u*)(XG + (size_t)s0 * DM) + F.lane; v4u* d1 = (v4u*)(XG + (size_t)s1 * DM) + F.lane; v4u* d2 = (v4u*)(XG + (size_t)s2 * DM) + F.lane; v4u* d3 = (v4u*)(XG + (size_t)s3 * DM) + F.lane;
#pragma unroll
            for (int j = 0; j < 4; ++j) { d0[64 * j] = d[j]; d1[64 * j] = d[j]; d2[64 * j] = d[j]; d3[64 * j] = d[j]; }
        }
    }
}
__device__ __forceinline__ int build_moe_tab(Frame& F) {
    LAS unsigned char* tab = (LAS unsigned char*)(F.lds + TAB_OFF); LAS int* tinfo = (LAS int*)(F.lds + TAB_OFF + 320);
    if (F.tid < 32) { const int c = (int)__hip_atomic_load((unsigned*)(F.ctl + CW_CNT + 64 * F.tid), RLX_AGENT); tinfo[4 + F.tid] = (c + 255) >> 8; }
    __syncthreads();
    if (F.tid == 0) { int a = 0; for (int e = 0; e < 32; ++e) { const int n = tinfo[4 + e]; for (int j = 0; j < n; ++j) tab[a + j] = (unsigned char)e; a += n; } tinfo[0] = a; }
    __syncthreads();
    return tinfo[0];
}
__device__ __forceinline__ void phase8(Frame& F) {
    const float* H2 = (const float*)(F.ws + WS_H2); const bf16* YR = (const bf16*)(F.ws + WS_YR);
    const int* SLOT = (const int*)(F.ws + WS_ROUTE) + TT * 12;
    const int gw = F.bid * NWAVES + F.wave, NGW = F.G * NWAVES;
    for (int t = gw; t < TT; t += NGW) {
        int slot = 0; if (F.lane < 4) slot = SLOT[(size_t)t * 4 + F.lane];
        int sl[4]; sl[0] = __shfl(slot, 0); sl[1] = __shfl(slot, 1); sl[2] = __shfl(slot, 2); sl[3] = __shfl(slot, 3);
        float v[4][8]; float ss = 0.f;
#pragma unroll
        for (int j = 0; j < 4; ++j) { const int pz = F.lane + 64 * j; const f32x4 a = *(const f32x4*)(H2 + (size_t)t * DM + 8 * pz), b = *(const f32x4*)(H2 + (size_t)t * DM + 8 * pz + 4);
            v[j][0] = a.x; v[j][1] = a.y; v[j][2] = a.z; v[j][3] = a.w; v[j][4] = b.x; v[j][5] = b.y; v[j][6] = b.z; v[j][7] = b.w; }
#pragma unroll
        for (int k = 0; k < 4; ++k)
#pragma unroll
            for (int j = 0; j < 4; ++j) { float f[8]; unpack8(*((const v4u*)(YR + (size_t)sl[k] * DM) + F.lane + 64 * j), f);
#pragma unroll
                for (int i = 0; i < 8; ++i) v[j][i] += f[i]; }
#pragma unroll
        for (int j = 0; j < 4; ++j)
#pragma unroll
            for (int i = 0; i < 8; ++i) ss += v[j][i] * v[j][i];
        const float rstd = 1.0f / sqrtf(wave_sum(ss) * (1.0f / 2048.0f) + EPSF);
#pragma unroll
        for (int j = 0; j < 4; ++j) { const int pz = F.lane + 64 * j; const f32x4 w0 = *(const f32x4*)(F.final_norm_w + 8 * pz), w1 = *(const f32x4*)(F.final_norm_w + 8 * pz + 4);
            *(f32x4*)(F.out + (size_t)t * DM + 8 * pz) = (f32x4){v[j][0] * rstd * w0.x, v[j][1] * rstd * w0.y, v[j][2] * rstd * w0.z, v[j][3] * rstd * w0.w};
            *(f32x4*)(F.out + (size_t)t * DM + 8 * pz + 4) = (f32x4){v[j][4] * rstd * w1.x, v[j][5] * rstd * w1.y, v[j][6] * rstd * w1.z, v[j][7] * rstd * w1.w}; }
    }
}

struct Args { const float* in[21]; float* out; unsigned char* ws; int ph_lo, ph_hi, li, pad; };
__global__ void __launch_bounds__(NWAVES * 64, 2) hymba_fwd(Args args) {
    extern __shared__ __attribute__((aligned(16))) unsigned char lds[];
    Frame F;
    F.lds = (LAS unsigned char*)lds; F.MISC = (volatile LAS unsigned*)(F.lds + MISC_OFF);
    F.tid = threadIdx.x; F.lane = F.tid & 63; F.wave = __builtin_amdgcn_readfirstlane(F.tid >> 6); F.G = gridDim.x; F.bid = blockIdx.x;
    F.ws = args.ws; F.ctl = (gu32*)(args.ws + WS_CTL); F.out = args.out;
    F.x = args.in[0]; F.norm1_w = args.in[1]; F.w_in = args.in[2]; F.conv_w = args.in[3]; F.conv_b = args.in[4]; F.dt_bias = args.in[5]; F.a_log = args.in[6]; F.d_skip = args.in[7]; F.ssd_norm_w = args.in[8];
    F.i_bias = args.in[9]; F.f_bias = args.in[10]; F.ml_norm_w = args.in[11]; F.w_out = args.in[12]; F.norm2_w = args.in[13]; F.router_w = args.in[14]; F.router_b = args.in[15];
    F.w_gate_up = args.in[16]; F.b_gate_up = args.in[17]; F.w_down = args.in[18]; F.b_down = args.in[19]; F.final_norm_w = args.in[20];
    for (int u = F.tid; u < (LDS_BYTES - LDSCTL_OFF) / 4; u += NWAVES * 64) ((LAS unsigned*)(F.lds + LDSCTL_OFF))[u] = 0u;
    __syncthreads();
    XcdBarrier bar; bar.bar = (unsigned*)(F.ctl + CW_BAR) + args.li * XCD_BAR_WORDS; bar.x = 0; bar.st = nullptr;
    const bool use_bar = (args.ph_hi - args.ph_lo) > 1;
    if (use_bar) bar = xcd_barrier_post((unsigned*)(F.ctl + CW_BAR) + args.li * XCD_BAR_WORDS, F.MISC + 8);
    const int lo = args.ph_lo, hi = args.ph_hi;
#ifndef PHASE_MASK
#define PHASE_MASK 0x3ff
#endif
#define IN(k) (((PHASE_MASK >> (k)) & 1) && lo <= (k) && (k) < hi)
#define SEAM(k) do { if (IN(k) && IN((k) + 1)) xcd_barrier(bar); } while (0)
    if (IN(0)) { phase0(F); } SEAM(0);
    if (IN(1)) {
        pg8::Gemm g{(const pg8::bf16_t*)(F.ws + WS_XN1), (const pg8::bf16_t*)(F.ws + WS_WIN), TT, NPROJ, DM}; pg8::StaticOrder S; S.init(TT, NPROJ, F.G, F.bid);
        pg8::EpiBf16 E{(pg8::bf16_t*)(F.ws + WS_PROJ), NPROJ};
        pg8::gemm_phase<pg8::EpiBf16, pg8::StaticOrder, true, true>(F.lds, g, S, E);
        p1_small(F);
    } SEAM(1);
    if (IN(2)) { phase2(F); } SEAM(2);
    if (IN(3)) { phase3(F); } SEAM(3);
    if (IN(4)) {
        pg8::Gemm g{(const pg8::bf16_t*)(F.ws + WS_YMIX), (const pg8::bf16_t*)(F.ws + WS_WOUT), TT, DM, 4096}; pg8::StaticOrder S; S.init(TT, DM, F.G, F.bid);
        pg8::EpiResF32 E{(float*)(F.ws + WS_H2), F.x, DM};
        pg8::gemm_phase<pg8::EpiResF32, pg8::StaticOrder, true, true>(F.lds, g, S, E);
    } SEAM(4);
    if (IN(5)) { phase5(F); } SEAM(5);
    if (IN(6)) { phase5b(F); } SEAM(6);
    if (IN(7)) {
        const int nM = build_moe_tab(F);
        pg8::Gemm g{(const pg8::bf16_t*)(F.ws + WS_XG), (const pg8::bf16_t*)(F.ws + WS_WGU), nM * 256, 4096, DM};
        pg8::MoeOrder S{nM, 16, 4, nM * 16, F.G, F.bid, (const PG8_LAS unsigned char*)(F.lds + TAB_OFF)};
        pg8::EpiSwiglu E{(pg8::bf16_t*)(F.ws + WS_ACT), F.b_gate_up};
        pg8::gemm_phase<pg8::EpiSwiglu, pg8::MoeOrder, true, true>(F.lds, g, S, E);
    } SEAM(7);
    if (IN(8)) {
        const int nM = build_moe_tab(F);
        pg8::Gemm g{(const pg8::bf16_t*)(F.ws + WS_ACT), (const pg8::bf16_t*)(F.ws + WS_WD), nM * 256, 2048, DM};
        pg8::MoeOrder S{nM, 8, 3, nM * 8, F.G, F.bid, (const PG8_LAS unsigned char*)(F.lds + TAB_OFF)};
        pg8::EpiDown E{(pg8::bf16_t*)(F.ws + WS_YR), F.b_down, (const float*)((const int*)(F.ws + WS_ROUTE) + TT * 16)};
        pg8::gemm_phase<pg8::EpiDown, pg8::MoeOrder, true, true>(F.lds, g, S, E);
    } SEAM(8);
    if (IN(9)) { phase8(F); }
#undef IN
#undef SEAM
}

extern "C" void kernel_launch(void* const* d_in, const int* in_sizes, int n_in, void* d_out, int out_size, void* d_ws, size_t ws_size, hipStream_t stream) {
    static int grid = 0;
    if (grid == 0) {
        if (n_in != 21 || out_size != TT * DM || ws_size < WS_END) { fprintf(stderr, "kernel_launch: unexpected problem (n_in %d, out %d, ws %zu); nothing launched\n", n_in, out_size, ws_size); grid = -1; return; }
        int dev = 0, cus = 0, per_cu = 0;
        if (hipGetDevice(&dev) != hipSuccess || hipDeviceGetAttribute(&cus, hipDeviceAttributeMultiprocessorCount, dev) != hipSuccess) { grid = -1; return; }
        if (hipFuncSetAttribute((const void*)hymba_fwd, hipFuncAttributeMaxDynamicSharedMemorySize, LDS_BYTES) != hipSuccess) { fprintf(stderr, "kernel_launch: hipFuncSetAttribute failed\n"); grid = -1; return; }
        if (hipOccupancyMaxActiveBlocksPerMultiprocessor(&per_cu, (const void*)hymba_fwd, NWAVES * 64, LDS_BYTES) != hipSuccess || per_cu < 1) { fprintf(stderr, "kernel_launch: occupancy query says %d blocks per CU\n", per_cu); }
        (void)hipGetLastError();
        grid = cus;
    }
    if (grid < 0) return;
    (void)hipMemsetAsync((char*)d_ws + WS_CTL, 0, CTL_ZERO_BYTES, stream);
    Args a{};
    for (int i = 0; i < 21; ++i) a.in[i] = (const float*)d_in[i];
    a.out = (float*)d_out; a.ws = (unsigned char*)d_ws; a.pad = 0;
#if MK_PER_PHASE
    for (int li = 0; li < N_PHASES; ++li) { a.ph_lo = li; a.ph_hi = li + 1; a.li = li; hipLaunchKernelGGL(hymba_fwd, dim3(grid), dim3(NWAVES * 64), LDS_BYTES, stream, a); }
#else
    a.ph_lo = 0; a.ph_hi = N_PHASES; a.li = 0;
    hipLaunchKernelGGL(hymba_fwd, dim3(grid), dim3(NWAVES * 64), LDS_BYTES, stream, a);
#endif
}
```

```cpp
#include <hip/hip_runtime.h>
#include <cstdio>
#include <cstdint>
namespace pg8 {
#define PG8_LAS __attribute__((address_space(3)))
typedef unsigned short bf16_t;
typedef short bf16x8 __attribute__((ext_vector_type(8)));
typedef float f32x4 __attribute__((ext_vector_type(4)));
typedef unsigned u32x4 __attribute__((ext_vector_type(4)));
constexpr int BM = 256, BK = 64, HALF = 128, HTB = HALF * BK * 2  , STAGE_BYTES = 8 * HTB, NXCD = 8, WGM = 8;

__host__ __device__ __forceinline__ int lds_byte(int r, int c) { const int st = (r >> 4) * 2 + (c >> 5), rr = r & 15, cc = c & 31, ob = rr * 64 + cc * 2; return st * 1024 + (ob ^ (((ob >> 9) & 1) << 5)); }
__host__ __device__ __forceinline__ void stage_rc(int b, int& R, int& C) { const int st = b / 1024, sb = b % 1024, swz = sb ^ (((sb >> 9) & 1) << 5); R = (st >> 1) * 16 + swz / 64; C = (st & 1) * 32 + (swz % 64) / 2; }
__host__ __device__ __forceinline__ int perm32(int rho) { const int n = rho >> 4, i = rho & 15; return 8 * (i >> 2) + 4 * n + (i & 3); }

struct Unit { int pm, pn; };
struct Gemm { const bf16_t* A; const bf16_t* Bt; int M, N, K; };

struct StaticOrder {
    int nM, nN, nwg, G, c;
    __host__ __device__ void init(int M, int N, int G_, int c_) { nM = M / BM; nN = N / BM; nwg = nM * nN; G = G_; c = c_; }
    __host__ __device__ bool next(int i, Unit& u) const {
        const long L = (long)i * G + c; if (L >= nwg) return false;
        int wgid = (int)L; { const int q = nwg / NXCD, r = nwg % NXCD, xcd = wgid % NXCD, off = wgid / NXCD; wgid = (xcd < r ? xcd * (q + 1) : r * (q + 1) + (xcd - r) * q) + off; }
        const int nig = WGM * nN, gid = wgid / nig, fm = gid * WGM, gsz = (nM - fm) < WGM ? (nM - fm) : WGM;
        u.pm = fm + ((wgid % nig) % gsz); u.pn = (wgid % nig) / gsz; return true;
    }
    __device__ __forceinline__ void a_ready(const Unit&) const {}
    __device__ __forceinline__ void done(const Unit&) const {}
};


__device__ __forceinline__ unsigned cvt_pk_bf16(float lo, float hi) { unsigned r; asm volatile("v_cvt_pk_bf16_f32 %0, %1, %2" : "=v"(r) : "v"(lo), "v"(hi)); return r; }
typedef unsigned u32x2 __attribute__((ext_vector_type(2)));

struct EpiBf16 {
    static constexpr bool PERM = true, AFTER_DRAIN = false;
    bf16_t* O; int ldc;
    __device__ __forceinline__ void operator()(const f32x4 (&acc)[2][2][4][2], const Unit& u, int wr, int wc, int fr, int fq) const {
        const int row0 = u.pm * BM + wr * 64 + fr; const int col0 = u.pn * BM + wc * 32 + 8 * fq;
#pragma unroll
        for (int ai = 0; ai < 2; ++ai)
#pragma unroll
            for (int m = 0; m < 4; ++m) { bf16_t* rowp = O + (size_t)(row0 + ai * HALF + m * 16) * ldc + col0;
#pragma unroll
                for (int bj = 0; bj < 2; ++bj) { const f32x4 v0 = acc[ai][bj][m][0], v1 = acc[ai][bj][m][1];
                    u32x4 w; w.x = cvt_pk_bf16(v0[0], v0[1]); w.y = cvt_pk_bf16(v0[2], v0[3]); w.z = cvt_pk_bf16(v1[0], v1[1]); w.w = cvt_pk_bf16(v1[2], v1[3]);
                    *(u32x4*)(rowp + bj * HALF) = w; } }
    }
};
struct EpiResF32 {
    static constexpr bool PERM = false, AFTER_DRAIN = false;
    float* C; const float* base; int ldc;
    __device__ __forceinline__ void operator()(const f32x4 (&acc)[2][2][4][2], const Unit& u, int wr, int wc, int fr, int fq) const {
        const int row0 = u.pm * BM + wr * 64 + fr, col0 = u.pn * BM + wc * 32 + 4 * fq;
#pragma unroll
        for (int ai = 0; ai < 2; ++ai)
#pragma unroll
            for (int m = 0; m < 4; ++m) { const size_t off = (size_t)(row0 + ai * HALF + m * 16) * ldc + col0;
#pragma unroll
                for (int bj = 0; bj < 2; ++bj)
#pragma unroll
                    for (int n = 0; n < 2; ++n) *(f32x4*)(C + off + bj * HALF + n * 16) = acc[ai][bj][m][n] + *(const f32x4*)(base + off + bj * HALF + n * 16); }
    }
};
__device__ __forceinline__ float swiglu1(float a, float b) {
    const float glu = fminf(a, 7.0f), lin = fminf(fmaxf(b, -7.0f), 7.0f);
    return glu * (1.0f / (1.0f + __expf(-1.702f * glu))) * (lin + 1.0f);
}
struct EpiSwiglu {
    static constexpr bool PERM = true, AFTER_DRAIN = false;
    bf16_t* O; const float* bias;
    __device__ __forceinline__ void operator()(const f32x4 (&acc)[2][2][4][2], const Unit& u, int wr, int wc, int fr, int fq) const {
        const int e = u.pn >> 4, pnl = u.pn & 15;
        const int row0 = u.pm * BM + wr * 64 + fr; const int hcol0 = pnl * BM + wc * 32 + 8 * fq;
        const float* bp = bias + (size_t)e * 4096 + hcol0;
        f32x4 bv[2][2];
#pragma unroll
        for (int bj = 0; bj < 2; ++bj)
#pragma unroll
            for (int n = 0; n < 2; ++n) bv[bj][n] = *(const f32x4*)(bp + bj * HALF + 4 * n);
#pragma unroll
        for (int ai = 0; ai < 2; ++ai)
#pragma unroll
            for (int m = 0; m < 4; ++m) { bf16_t* rowp = O + (size_t)(row0 + ai * HALF + m * 16) * 2048 + (hcol0 >> 1);
#pragma unroll
                for (int bj = 0; bj < 2; ++bj) { const f32x4 v0 = acc[ai][bj][m][0] + bv[bj][0], v1 = acc[ai][bj][m][1] + bv[bj][1];
                    u32x2 w; w.x = cvt_pk_bf16(swiglu1(v0[0], v0[1]), swiglu1(v0[2], v0[3])); w.y = cvt_pk_bf16(swiglu1(v1[0], v1[1]), swiglu1(v1[2], v1[3]));
                    *(u32x2*)(rowp + bj * 64) = w; } }
    }
};
struct EpiDown {
    static constexpr bool PERM = true, AFTER_DRAIN = false;
    bf16_t* O; const float* bias; const float* sgate;
    __device__ __forceinline__ void operator()(const f32x4 (&acc)[2][2][4][2], const Unit& u, int wr, int wc, int fr, int fq) const {
        const int e = u.pn >> 3, pnl = u.pn & 7;
        const int row0 = u.pm * BM + wr * 64 + fr; const int col0 = pnl * BM + wc * 32 + 8 * fq;
        const float* bp = bias + (size_t)e * 2048 + col0;
        f32x4 bv[2][2];
#pragma unroll
        for (int bj = 0; bj < 2; ++bj)
#pragma unroll
            for (int n = 0; n < 2; ++n) bv[bj][n] = *(const f32x4*)(bp + bj * HALF + 4 * n);
#pragma unroll
        for (int ai = 0; ai < 2; ++ai)
#pragma unroll
            for (int m = 0; m < 4; ++m) { const int row = row0 + ai * HALF + m * 16; const float gt = sgate[row]; bf16_t* rowp = O + (size_t)row * 2048 + col0;
#pragma unroll
                for (int bj = 0; bj < 2; ++bj) { const f32x4 v0 = (acc[ai][bj][m][0] + bv[bj][0]) * gt, v1 = (acc[ai][bj][m][1] + bv[bj][1]) * gt;
                    u32x4 w; w.x = cvt_pk_bf16(v0[0], v0[1]); w.y = cvt_pk_bf16(v0[2], v0[3]); w.z = cvt_pk_bf16(v1[0], v1[1]); w.w = cvt_pk_bf16(v1[2], v1[3]);
                    *(u32x4*)(rowp + bj * HALF) = w; } }
    }
};
struct MoeOrder {
    int nM, nN, nsh, nwg, G, c; const PG8_LAS unsigned char* tab;
    __device__ __forceinline__ bool next(int i, Unit& u) const {
        const long L = (long)i * G + c; if (L >= nwg) return false;
        int wgid = (int)L; { const int q = nwg / NXCD, r = nwg % NXCD, xcd = wgid % NXCD, off = wgid / NXCD; wgid = (xcd < r ? xcd * (q + 1) : r * (q + 1) + (xcd - r) * q) + off; }
        const int nig = WGM * nN, gid = wgid / nig, fm = gid * WGM, gsz = (nM - fm) < WGM ? (nM - fm) : WGM;
        const int pm = fm + ((wgid % nig) % gsz), pnl = (wgid % nig) / gsz;
        u.pm = pm; u.pn = ((int)tab[pm] << nsh) + pnl; return true;
    }
    __device__ __forceinline__ void a_ready(const Unit&) const {}
    __device__ __forceinline__ void done(const Unit&) const {}
};
template <class Epi, class Sched, bool ALIGN_EPI = false, bool SP2 = false>
__device__ __forceinline__ void gemm_phase(PG8_LAS unsigned char* lds, const Gemm g, const Sched& S, const Epi& E) {
    const int tid = threadIdx.x, wid = __builtin_amdgcn_readfirstlane(tid >> 6), lane = tid & 63, wr = wid >> 2, wc = wid & 3, fr = lane & 15, fq = lane >> 4;
    const int K = g.K, nt = K / BK;
    unsigned voffA[2], voffB[2];
#pragma unroll
    for (int i = 0; i < 2; ++i) { int R, C; stage_rc(tid * 16 + i * 8192, R, C); const int Rb = Epi::PERM ? ((R & ~31) + perm32(R & 31)) : R;
        voffA[i] = (unsigned)(R * K + C) * 2u; voffB[i] = (unsigned)(Rb * K + C) * 2u; }
    const size_t kstep = (size_t)(BK * 2);
    const size_t hstep = (size_t)HALF * K * 2;
    const size_t tstep = 2 * hstep;
    const unsigned ldsw = (unsigned)wid * 1024u;
    const int aoff = lds_byte(wr * 64 + fr, fq * 8), boff = lds_byte(wc * 32 + fr, fq * 8);
#define PG8_SA(b, h) (((b) * 2 + (h)) * HTB)
#define PG8_SB(b, h) ((4 + (b) * 2 + (h)) * HTB)
#define PG8_STAGE(bufoff, gbase, voff) do { _Pragma("unroll") for (int _i = 0; _i < 2; ++_i) \
        __builtin_amdgcn_global_load_lds((const unsigned*)((const char*)(gbase) + (voff)[_i]), (PG8_LAS unsigned*)(lds + (bufoff) + ldsw + _i * 8192), 16, 0, 0); } while (0)
#define PG8_LDA(dst, b, h) do { _Pragma("unroll") for (int m = 0; m < 4; ++m) _Pragma("unroll") for (int k = 0; k < 2; ++k) dst[m][k] = *(const PG8_LAS bf16x8*)(lds + PG8_SA(b, h) + aoff + m * 2048 + k * 1024); } while (0)
#define PG8_LDB(dst, b, h) do { _Pragma("unroll") for (int n = 0; n < 2; ++n) _Pragma("unroll") for (int k = 0; k < 2; ++k) dst[n][k] = *(const PG8_LAS bf16x8*)(lds + PG8_SB(b, h) + boff + n * 2048 + k * 1024); } while (0)
#define PG8_MMA(ai, bj, At, Bt) do { __builtin_amdgcn_s_setprio(1); _Pragma("unroll") for (int m = 0; m < 4; ++m) _Pragma("unroll") for (int n = 0; n < 2; ++n) _Pragma("unroll") for (int k = 0; k < 2; ++k) \
        acc[ai][bj][m][n] = __builtin_amdgcn_mfma_f32_16x16x32_bf16(Bt[n][k], At[m][k], acc[ai][bj][m][n], 0, 0, 0); __builtin_amdgcn_s_setprio(0); } while (0)
#define PG8_WAIT_V(n) asm volatile("s_waitcnt vmcnt(" #n ")" ::: "memory")
#define PG8_WAIT_L(n) asm volatile("s_waitcnt lgkmcnt(" #n ")" ::: "memory")
#define PG8_BAR __builtin_amdgcn_s_barrier()
#define PG8_SCHED __builtin_amdgcn_sched_barrier(0)
    Unit cur, nxt; int ui = 0;
    if (!S.next(0, cur)) return;
    f32x4 acc[2][2][4][2];
#pragma unroll
    for (int a = 0; a < 2; ++a)
#pragma unroll
        for (int b = 0; b < 2; ++b)
#pragma unroll
            for (int m = 0; m < 4; ++m)
#pragma unroll
                for (int n = 0; n < 2; ++n) acc[a][b][m][n] = (f32x4){0.f, 0.f, 0.f, 0.f};
    bf16x8 At[4][2], B0[2][2], B1[2][2];
    const char* cA = (const char*)g.A + (size_t)cur.pm * tstep; const char* cB = (const char*)g.Bt + (size_t)cur.pn * tstep;
    S.a_ready(cur);
    if constexpr (SP2) {
        PG8_STAGE(PG8_SB(0, 0), cB, voffB); PG8_STAGE(PG8_SB(0, 1), cB + hstep, voffB); PG8_STAGE(PG8_SA(0, 0), cA, voffA); PG8_STAGE(PG8_SA(0, 1), cA + hstep, voffA);
        if (wr == 1) PG8_BAR;
        PG8_WAIT_V(2); PG8_BAR;
        PG8_STAGE(PG8_SB(1, 0), cB + kstep, voffB); PG8_STAGE(PG8_SA(1, 0), cA + kstep, voffA); PG8_STAGE(PG8_SB(1, 1), cB + hstep + kstep, voffB);
        PG8_WAIT_V(6); PG8_BAR;
    } else {
        PG8_STAGE(PG8_SB(0, 0), cB, voffB); PG8_STAGE(PG8_SA(0, 0), cA, voffA); PG8_STAGE(PG8_SB(0, 1), cB + hstep, voffB); PG8_STAGE(PG8_SA(0, 1), cA + hstep, voffA);
        if (wr == 1) PG8_BAR;
        PG8_WAIT_V(4); PG8_BAR;
        PG8_STAGE(PG8_SB(1, 0), cB + kstep, voffB); PG8_STAGE(PG8_SA(1, 0), cA + kstep, voffA); PG8_STAGE(PG8_SB(1, 1), cB + hstep + kstep, voffB);
        PG8_WAIT_V(6); PG8_BAR;
    }
    for (;;) {
        const bool has_next = S.next(ui + 1, nxt);
        const char* nA = has_next ? (const char*)g.A + (size_t)nxt.pm * tstep : cA; const char* nB = has_next ? (const char*)g.Bt + (size_t)nxt.pn * tstep : cB;
        for (int t = 0; t < nt; t += 2) {
            const bool last = (t == nt - 2);
            const char* a1 = cA + (size_t)(t + 1) * kstep;
            const char* a2 = last ? nA : cA + (size_t)(t + 2) * kstep; const char* b2 = last ? nB : cB + (size_t)(t + 2) * kstep;
            const char* a3 = a2 + kstep; const char* b3 = b2 + kstep;
            if (last && has_next) S.a_ready(nxt);
            if constexpr (SP2) {
            PG8_LDB(B0, 0, 0); PG8_LDB(B1, 0, 1); PG8_SCHED; PG8_LDA(At, 0, 0); PG8_STAGE(PG8_SA(1, 1), a1 + hstep, voffA);
            PG8_WAIT_V(8); PG8_WAIT_L(0); PG8_BAR; PG8_MMA(0, 0, At, B0); PG8_MMA(0, 1, At, B1); PG8_BAR; PG8_SCHED;
            PG8_LDA(At, 0, 1); PG8_STAGE(PG8_SB(0, 0), b2, voffB); PG8_STAGE(PG8_SB(0, 1), b2 + hstep, voffB); PG8_STAGE(PG8_SA(0, 0), a2, voffA);
            PG8_WAIT_V(8); PG8_WAIT_L(0); PG8_BAR; PG8_MMA(1, 0, At, B0); PG8_MMA(1, 1, At, B1); PG8_BAR; PG8_SCHED;
            PG8_LDB(B0, 1, 0); PG8_LDB(B1, 1, 1); PG8_SCHED; PG8_LDA(At, 1, 0); PG8_STAGE(PG8_SA(0, 1), a2 + hstep, voffA);
            PG8_WAIT_V(8); PG8_WAIT_L(0); PG8_BAR; PG8_MMA(0, 0, At, B0); PG8_MMA(0, 1, At, B1); PG8_BAR; PG8_SCHED;
            PG8_LDA(At, 1, 1); PG8_STAGE(PG8_SB(1, 0), b3, voffB); PG8_STAGE(PG8_SB(1, 1), b3 + hstep, voffB); PG8_STAGE(PG8_SA(1, 0), a3, voffA);
            PG8_WAIT_V(8); PG8_WAIT_L(0); PG8_BAR; PG8_MMA(1, 0, At, B0); PG8_MMA(1, 1, At, B1); PG8_BAR; PG8_SCHED;
            } else {
            PG8_LDB(B0, 0, 0); PG8_SCHED; PG8_LDA(At, 0, 0); PG8_STAGE(PG8_SA(1, 1), a1 + hstep, voffA);
            PG8_WAIT_L(8); PG8_BAR; PG8_WAIT_L(0); PG8_MMA(0, 0, At, B0); PG8_BAR; PG8_SCHED;
            PG8_LDB(B1, 0, 1); PG8_STAGE(PG8_SB(0, 0), b2, voffB);
            PG8_BAR; PG8_WAIT_L(0); PG8_MMA(0, 1, At, B1); PG8_BAR;
            PG8_LDA(At, 0, 1); PG8_STAGE(PG8_SA(0, 0), a2, voffA);
            PG8_BAR; PG8_WAIT_L(0); PG8_MMA(1, 0, At, B0); PG8_BAR; PG8_SCHED;
            PG8_STAGE(PG8_SB(0, 1), b2 + hstep, voffB);
            PG8_WAIT_V(6); PG8_BAR; PG8_MMA(1, 1, At, B1); PG8_BAR;
            PG8_LDB(B0, 1, 0); PG8_SCHED; PG8_LDA(At, 1, 0); PG8_STAGE(PG8_SA(0, 1), a2 + hstep, voffA);
            PG8_WAIT_L(8); PG8_BAR; PG8_WAIT_L(0); PG8_MMA(0, 0, At, B0); PG8_BAR; PG8_SCHED;
            PG8_LDB(B1, 1, 1); PG8_STAGE(PG8_SB(1, 0), b3, voffB);
            PG8_BAR; PG8_WAIT_L(0); PG8_MMA(0, 1, At, B1); PG8_BAR;
            PG8_LDA(At, 1, 1); PG8_STAGE(PG8_SA(1, 0), a3, voffA);
            PG8_BAR; PG8_WAIT_L(0); PG8_MMA(1, 0, At, B0); PG8_BAR; PG8_SCHED;
            PG8_STAGE(PG8_SB(1, 1), b3 + hstep, voffB);
            PG8_WAIT_V(6); PG8_BAR; PG8_MMA(1, 1, At, B1); PG8_BAR;
            }
        }
        if constexpr (ALIGN_EPI) { if (wr == 0) PG8_BAR; }
        if constexpr (!Epi::AFTER_DRAIN) { E(acc, cur, wr, wc, fr, fq); S.done(cur); }
        if (!has_next) break;
#pragma unroll
        for (int a = 0; a < 2; ++a)
#pragma unroll
            for (int b = 0; b < 2; ++b)
#pragma unroll
                for (int m = 0; m < 4; ++m)
#pragma unroll
                    for (int n = 0; n < 2; ++n) acc[a][b][m][n] = (f32x4){0.f, 0.f, 0.f, 0.f};
        cur = nxt; cA = nA; cB = nB; ++ui;
        if constexpr (ALIGN_EPI) { if (wr == 1) PG8_BAR; }
    }
    PG8_WAIT_V(0);
    if constexpr (!ALIGN_EPI) { if (wr == 0) PG8_BAR; }
    PG8_BAR;
    if constexpr (Epi::AFTER_DRAIN) { E.fused(acc, cur, wr, wc, fr, fq, lds, wid, lane); S.done(cur); }
#undef PG8_SA
#undef PG8_SB
#undef PG8_STAGE
#undef PG8_LDA
#undef PG8_LDB
#undef PG8_MMA
#undef PG8_WAIT_V
#undef PG8_WAIT_L
#undef PG8_BAR
#undef PG8_SCHED
}
}

constexpr int NWAVES = 8;
constexpr int TT = 16384, DM = 2048, SEQ = 2048;
constexpr int NPROJ = 11264;
constexpr int PC_Z = 0, PC_XBC = 2048, PC_Q = 5120, PC_K = 6144, PC_V = 7168, PC_O = 9216;
constexpr int WIN_LD = 11312;
constexpr int NSLOT = 65536 + 32 * 256;
constexpr float EPSF = 1e-5f;
#ifndef HSYNC_ON
#define HSYNC_ON 1
#endif
#define HWAIT() do { if (HSYNC_ON) asm volatile("s_waitcnt vmcnt(0) lgkmcnt(0)\n\ts_nop 15\n\ts_nop 15" ::: "memory"); } while (0)
#define HSYNC() do { if (HSYNC_ON) { ; __syncthreads(); } } while (0)
#ifndef MK_PER_PHASE
#define MK_PER_PHASE 0
#endif
constexpr int N_PHASES = 11;

constexpr size_t MiB = 1u << 20;
constexpr size_t WS_CTL = 0, CTL_ZERO_BYTES = 1 * MiB;
constexpr size_t WS_WIN = 2 * MiB, WS_WSM = 46 * MiB, WS_WRT = 47 * MiB, WS_WOUT = 48 * MiB, WS_WGU = 64 * MiB, WS_WD = 576 * MiB;
constexpr size_t WS_XN1 = 832 * MiB, WS_PROJ = 896 * MiB, WS_SMALL = 1248 * MiB, WS_SSQ = 1252 * MiB, WS_YMIX = 1256 * MiB, WS_H2 = 1384 * MiB, WS_XN2 = 1512 * MiB;
constexpr size_t WS_ROUTE = 1576 * MiB, WS_XG = 1578 * MiB, WS_ACT = 1866 * MiB, WS_YR = 2154 * MiB, WS_XC = 2442 * MiB, WS_END = 2538 * MiB;
constexpr int CW_BAR = 4096;
constexpr int CW_CNT = 65536;

constexpr int RING_BYTES = 131072;
constexpr int LDS_BYTES = 147456;
constexpr int LDSCTL_OFF = LDS_BYTES - 576, MISC_OFF = LDSCTL_OFF;
constexpr int TAB_OFF = LDSCTL_OFF + 64;

#define GAS __attribute__((address_space(1)))
#define LAS __attribute__((address_space(3)))
typedef unsigned short bf16;
typedef unsigned v4u __attribute__((ext_vector_type(4)));
typedef unsigned v2u __attribute__((ext_vector_type(2)));
typedef float f32x4 __attribute__((ext_vector_type(4)));
typedef float f32x2 __attribute__((ext_vector_type(2)));
typedef short bf16x8 __attribute__((ext_vector_type(8)));
typedef GAS unsigned gu32;
#define RLX_AGENT __ATOMIC_RELAXED, __HIP_MEMORY_SCOPE_AGENT
#define LDS_WAIT() asm volatile("s_waitcnt lgkmcnt(0)" ::: "memory")
#define VM_WAIT() asm volatile("s_waitcnt vmcnt(0)" ::: "memory")
__device__ __forceinline__ unsigned f2bf(float f) { unsigned u = __builtin_bit_cast(unsigned, f); return (u + 0x7fffu + ((u >> 16) & 1u)) >> 16; }
__device__ __forceinline__ unsigned pk2(float lo, float hi) { return f2bf(lo) | (f2bf(hi) << 16); }
__device__ __forceinline__ float bflo(unsigned w) { return __builtin_bit_cast(float, w << 16); }
__device__ __forceinline__ float bfhi(unsigned w) { return __builtin_bit_cast(float, w & 0xffff0000u); }
__device__ __forceinline__ float wave_sum(float v) {
#pragma unroll
    for (int o = 1; o < 64; o <<= 1) v += __shfl_xor(v, o);
    return v;
}
__device__ __forceinline__ float softplusf(float x) { return x > 20.f ? x : log1pf(expf(x)); }
__device__ __forceinline__ float logsigf(float x) { return fminf(x, 0.f) - log1pf(expf(-fabsf(x))); }
__device__ __forceinline__ float siluf(float v) { return v / (1.0f + __expf(-v)); }

#define XB_TMO      128
#define XB_XCNT(j)  (256  + 64 * (j))
#define XB_XSUB(j)  (1280 + 64 * (j))
#define XB_XGEN(j)  (2304 + 64 * (j))
#define XB_TOP      3328
#define XB_TOPGEN   3392
#define XCD_BAR_WORDS 3456
#define XB_SPIN_CAP (1u << 18)

__device__ __forceinline__ unsigned xb_ld(unsigned* p)              { return __hip_atomic_load(p, __ATOMIC_RELAXED, __HIP_MEMORY_SCOPE_AGENT); }
__device__ __forceinline__ unsigned xb_add(unsigned* p, unsigned v) { return __hip_atomic_fetch_add(p, v, __ATOMIC_RELAXED, __HIP_MEMORY_SCOPE_AGENT); }
__device__ __forceinline__ unsigned xb_xcc_id() { return (unsigned)__builtin_amdgcn_s_getreg((3 << 11) | 20) & 0xFu; }
#define XB_SPIN(cond, bar) do { unsigned _sp = 0; while (cond) { __builtin_amdgcn_s_sleep(1); \
    if ((++_sp & 255u) == 0u) { if (xb_ld(&(bar)[XB_TMO])) break; if (_sp > XB_SPIN_CAP) { atomicAdd(&(bar)[XB_TMO], 1u); break; } } } } while (0)

struct XcdBarrier {
    unsigned* bar; unsigned x;
    volatile LAS unsigned* st;
};

__device__ __forceinline__ XcdBarrier xcd_barrier_post(unsigned* bar, volatile LAS unsigned* st) {
    XcdBarrier b; b.bar = bar; b.x = xb_xcc_id(); b.st = st;
    if (threadIdx.x == 0) (void)xb_add(&bar[XB_XCNT(b.x)], 1u);
    return b;
}
__device__ __forceinline__ void xcd_barrier_complete(unsigned* bar, unsigned x, unsigned& nloc, unsigned& nx) {
    const unsigned G = gridDim.x * gridDim.y * gridDim.z;
    unsigned sum, cnt, mine, sp = 0u;
    for (;;) {
        sum = 0u; cnt = 0u; mine = 0u;
#pragma unroll
        for (unsigned j = 0; j < 16; ++j) { const unsigned c = xb_ld(&bar[XB_XCNT(j)]); sum += c; cnt += (c > 0u) ? 1u : 0u; mine = (j == x) ? c : mine; }
        if (sum == G) break;
        __builtin_amdgcn_s_sleep(1);
        if ((++sp & 255u) == 0u) { if (xb_ld(&bar[XB_TMO])) break; if (sp > XB_SPIN_CAP) { atomicAdd(&bar[XB_TMO], 1u); break; } }
    }
    nloc = mine > 0u ? mine : 1u; nx = cnt > 0u ? cnt : 1u;
}

__device__ __forceinline__ void xcd_barrier(const XcdBarrier& b) {
    asm volatile("s_waitcnt vmcnt(0)" ::: "memory");
    __syncthreads();
    if (threadIdx.x == 0) {
        unsigned* bar = b.bar;
        __builtin_amdgcn_s_waitcnt(0);
        unsigned nloc = b.st[0], nx = b.st[1];
        if (nloc == 0u) { xcd_barrier_complete(bar, b.x, nloc, nx); b.st[0] = nloc; b.st[1] = nx; }
        const unsigned old = xb_add(&bar[XB_XSUB(b.x)], 1u);
        const unsigned gen = old / nloc;
        if (old + 1u == (gen + 1u) * nloc) {
            __builtin_amdgcn_fence(__ATOMIC_RELEASE, "agent");
            asm volatile("s_waitcnt vmcnt(0)" ::: "memory");
            const unsigned og = xb_add(&bar[XB_TOP], 1u);
            const unsigned tg = og / nx;
            if (og + 1u == (tg + 1u) * nx) xb_add(&bar[XB_TOPGEN], 1u);
            else XB_SPIN(xb_ld(&bar[XB_TOPGEN]) == tg, bar);
            __builtin_amdgcn_fence(__ATOMIC_ACQUIRE, "agent");
            xb_add(&bar[XB_XGEN(b.x)], 1u);
            asm volatile("s_waitcnt vmcnt(0)" ::: "memory");
        } else {
            XB_SPIN(xb_ld(&bar[XB_XGEN(b.x)]) == gen, bar);
            __builtin_amdgcn_fence(__ATOMIC_ACQUIRE, "agent");
            asm volatile("s_waitcnt vmcnt(0)" ::: "memory");
        }
    }
    __syncthreads();
}

struct Frame {
    LAS unsigned char* lds;
    volatile LAS unsigned* MISC;
    gu32* ctl;
    int tid, lane, wave, G, bid;
    const float *x, *norm1_w, *w_in, *conv_w, *conv_b, *dt_bias, *a_log, *d_skip, *ssd_norm_w, *i_bias, *f_bias, *ml_norm_w, *w_out, *norm2_w, *router_w, *router_b, *w_gate_up, *b_gate_up, *w_down, *b_down, *final_norm_w;
    float* out; unsigned char* ws;
};

__device__ __forceinline__ void p0_transpose_item(const float* W, int ldw, int K, bf16* WT, int dst_row0, int src_col0, int k0, LAS float* scr, int lane) {
#pragma unroll 8
    for (int i = 0; i < 32; ++i) { const int kk = 2 * i + (lane >> 5); scr[kk * 33 + (lane & 31)] = W[(size_t)(k0 + kk) * ldw + src_col0 + (lane & 31)]; }
    LDS_WAIT(); asm volatile("" ::: "memory");
    const int c = lane & 7;
#pragma unroll
    for (int j = 0; j < 4; ++j) { const int n = (lane >> 3) + 8 * j; const LAS float* s = scr + (8 * c) * 33 + n;
        v4u o; o.x = pk2(s[0 * 33], s[1 * 33]); o.y = pk2(s[2 * 33], s[3 * 33]); o.z = pk2(s[4 * 33], s[5 * 33]); o.w = pk2(s[6 * 33], s[7 * 33]);
        *(v4u*)(WT + (size_t)(dst_row0 + n) * K + k0 + 8 * c) = o; }
    LDS_WAIT(); asm volatile("" ::: "memory");
}
__device__ __forceinline__ void rms_row_to_bf16(const float* xrow, const float* w, bf16* orow, int lane) {
    const f32x4* xr = (const f32x4*)xrow + lane; const f32x4* wr = (const f32x4*)w + lane;
    f32x4 v[8]; float s = 0.f;
#pragma unroll
    for (int j = 0; j < 8; ++j) { v[j] = xr[64 * j]; s += (v[j].x * v[j].x + v[j].y * v[j].y) + (v[j].z * v[j].z + v[j].w * v[j].w); }
    const float rstd = 1.0f / sqrtf(wave_sum(s) * (1.0f / 2048.0f) + EPSF);
    v2u* o8 = (v2u*)orow + lane;
#pragma unroll
    for (int j = 0; j < 8; ++j) { const f32x4 ww = wr[64 * j]; v2u o; o.x = pk2(v[j].x * rstd * ww.x, v[j].y * rstd * ww.y); o.y = pk2(v[j].z * rstd * ww.z, v[j].w * rstd * ww.w); o8[64 * j] = o; }
}
__device__ __forceinline__ void phase0(Frame& F) {
    LAS float* scr = (LAS float*)(F.lds + F.wave * 16384);
    const int gw = F.bid * NWAVES + F.wave, NGW = F.G * NWAVES;
    bf16* WinT = (bf16*)(F.ws + WS_WIN); bf16* WsT = (bf16*)(F.ws + WS_WSM); float* Wrt = (float*)(F.ws + WS_WRT); bf16* WoutT = (bf16*)(F.ws + WS_WOUT);
    bf16* WguT = (bf16*)(F.ws + WS_WGU); bf16* WdT = (bf16*)(F.ws + WS_WD); bf16* XN1 = (bf16*)(F.ws + WS_XN1);
    constexpr int I_IN = 32 * 352, I_OUT = 64 * 64, I_GU = 32 * 4096, I_D = 32 * 2048, NITEMS = I_IN + I_OUT + I_GU + I_D;
    for (int it = gw; it < NITEMS; it += NGW) {
        int r = it;
        if (r < I_IN) { const int kb = r / 352, nb = r % 352, n0 = nb * 32; p0_transpose_item(F.w_in, WIN_LD, 2048, WinT, n0, n0 + (n0 >= 5120 ? 32 : 0), kb * 64, scr, F.lane); continue; } r -= I_IN;
        if (r < I_OUT) { const int kb = r >> 6, nb = r & 63; p0_transpose_item(F.w_out, 2048, 4096, WoutT, nb * 32, nb * 32, kb * 64, scr, F.lane); continue; } r -= I_OUT;
        if (r < I_GU) { const int e = r >> 12, rr = r & 4095, kb = rr >> 7, nb = rr & 127; p0_transpose_item(F.w_gate_up + (size_t)e * 2048 * 4096, 4096, 2048, WguT + (size_t)e * 4096 * 2048, nb * 32, nb * 32, kb * 64, scr, F.lane); continue; } r -= I_GU;
        { const int e = r >> 11, rr = r & 2047, kb = rr >> 6, nb = rr & 63; p0_transpose_item(F.w_down + (size_t)e * 2048 * 2048, 2048, 2048, WdT + (size_t)e * 2048 * 2048, nb * 32, nb * 32, kb * 64, scr, F.lane); }
    }
    for (int i = gw * 64 + F.lane; i < 64 * 2048; i += NGW * 64) { const int j = i >> 11, k = i & 2047;
        const int col = j < 32 ? 5120 + j : (j < 40 ? 11296 + (j - 32) : 11304 + (j - 40));
        WsT[i] = (bf16)(j < 48 ? f2bf(F.w_in[(size_t)k * WIN_LD + col]) : 0u); }
    for (int i = gw * 64 + F.lane; i < 2048 * 32; i += NGW * 64) Wrt[i] = F.norm2_w[i >> 5] * F.router_w[i];
    for (int m = gw; m < TT; m += NGW) rms_row_to_bf16(F.x + (size_t)m * DM, F.norm1_w, XN1 + (size_t)m * DM, F.lane);
}

__device__ __forceinline__ void p1_small(Frame& F) {
    const bf16* XN1 = (const bf16*)(F.ws + WS_XN1); const bf16* WsT = (const bf16*)(F.ws + WS_WSM); float* SMALL = (float*)(F.ws + WS_SMALL);
    const int gw = F.bid * NWAVES + F.wave, NGW = F.G * NWAVES, fr = F.lane & 15, fq = F.lane >> 4;
    for (int task = gw; task < TT / 16; task += NGW) {
        const int t0 = task * 16;
        f32x4 acc[4];
#pragma unroll
        for (int n = 0; n < 4; ++n) acc[n] = (f32x4){0.f, 0.f, 0.f, 0.f};
        const bf16* arow = XN1 + (size_t)(t0 + fr) * DM + 8 * fq; const bf16* brow = WsT + (size_t)fr * DM + 8 * fq;
#pragma unroll 4
        for (int ks = 0; ks < 64; ++ks) {
            const bf16x8 a = *(const bf16x8*)(arow + 32 * ks);
#pragma unroll
            for (int n = 0; n < 4; ++n) { const bf16x8 b = *(const bf16x8*)(brow + (size_t)n * 16 * DM + 32 * ks); acc[n] = __builtin_amdgcn_mfma_f32_16x16x32_bf16(a, b, acc[n], 0, 0, 0); }
        }
#pragma unroll
        for (int n = 0; n < 4; ++n)
#pragma unroll
            for (int r = 0; r < 4; ++r) SMALL[(size_t)(t0 + 4 * fq + r) * 64 + n * 16 + fr] = acc[n][r];
    }
}

__device__ __forceinline__ void unpack8(const v4u r, float (&f)[8]) { f[0] = bflo(r.x); f[1] = bfhi(r.x); f[2] = bflo(r.y); f[3] = bfhi(r.y); f[4] = bflo(r.z); f[5] = bfhi(r.z); f[6] = bflo(r.w); f[7] = bfhi(r.w); }

__device__ __forceinline__ void phase_conv(Frame& F) {
    const bf16* PROJ = (const bf16*)(F.ws + WS_PROJ); bf16* XC = (bf16*)(F.ws + WS_XC);
    constexpr int TB = 32, NCG = 384, NIT = (TT / TB) * NCG;
    for (int it = F.bid * (NWAVES * 64) + F.tid; it < NIT; it += F.G * NWAVES * 64) {
        const int cg = it % NCG, tb = it / NCG, ch = cg * 8, t0 = tb * TB; const bool seq0 = (t0 % SEQ) == 0;
        float w[4][8], bs[8];
#pragma unroll
        for (int j = 0; j < 4; ++j) { const f32x4 a = *(const f32x4*)(F.conv_w + j * 3072 + ch), b = *(const f32x4*)(F.conv_w + j * 3072 + ch + 4);
            w[j][0] = a.x; w[j][1] = a.y; w[j][2] = a.z; w[j][3] = a.w; w[j][4] = b.x; w[j][5] = b.y; w[j][6] = b.z; w[j][7] = b.w; }
        { const f32x4 a = *(const f32x4*)(F.conv_b + ch), b = *(const f32x4*)(F.conv_b + ch + 4); bs[0] = a.x; bs[1] = a.y; bs[2] = a.z; bs[3] = a.w; bs[4] = b.x; bs[5] = b.y; bs[6] = b.z; bs[7] = b.w; }
        const bf16* src = PROJ + (size_t)t0 * NPROJ + PC_XBC + ch;
        float r0[8], r1[8], r2[8], r3[8];
        if (seq0) {
#pragma unroll
            for (int i = 0; i < 8; ++i) { r0[i] = 0.f; r1[i] = 0.f; r2[i] = 0.f; }
        } else { unpack8(*(const v4u*)(src - 3 * (size_t)NPROJ), r0); unpack8(*(const v4u*)(src - 2 * (size_t)NPROJ), r1); unpack8(*(const v4u*)(src - (size_t)NPROJ), r2); }
#pragma unroll 4
        for (int l = 0; l < TB; ++l) {
            unpack8(*(const v4u*)(src + (size_t)l * NPROJ), r3);
            float o[8];
#pragma unroll
            for (int i = 0; i < 8; ++i) { const float v = bs[i] + w[0][i] * r0[i] + w[1][i] * r1[i] + w[2][i] * r2[i] + w[3][i] * r3[i]; o[i] = siluf(v); r0[i] = r1[i]; r1[i] = r2[i]; r2[i] = r3[i]; }
            v4u ov; ov.x = pk2(o[0], o[1]); ov.y = pk2(o[2], o[3]); ov.z = pk2(o[4], o[5]); ov.w = pk2(o[6], o[7]);
            *(v4u*)(XC + (size_t)(t0 + l) * 3072 + ch) = ov;
        }
    }
}

constexpr int MX_PITCH = 272;
static_assert(true, "");
constexpr int MX_QM = 0, MX_KM = 34816, MX_KW = 69632, MX_VT = 104448, MX_SI = 121856, MX_VEC = 139264, MX_VECB = 3072, MX_NVEC = MX_VEC + 2 * MX_VECB, MX_SCAL = MX_NVEC + 512, MX_END = MX_SCAL + 64;
__device__ __forceinline__ unsigned cvt_pk_bf16_nop(float lo, float hi) { unsigned r; asm volatile("v_cvt_pk_bf16_f32 %0, %1, %2\n\ts_nop 1" : "=v"(r) : "v"(lo), "v"(hi)); return r; }
__device__ __forceinline__ bf16x8 lds_frag(const LAS unsigned char* img, int row, int kbyte) { return *(const LAS bf16x8*)(img + row * MX_PITCH + kbyte); }
static_assert(MX_END <= LDSCTL_OFF, "mixer LDS map");
template <bool ML> __device__ __forceinline__ void mixer_unit(Frame& F, int unit) {
    const bf16* PROJ = (const bf16*)(F.ws + WS_PROJ); const bf16* XC = (const bf16*)(F.ws + WS_XC); const float* SMALL = (const float*)(F.ws + WS_SMALL);
    bf16* YMIX = (bf16*)(F.ws + WS_YMIX); float* SSQ = (float*)(F.ws + WS_SSQ);
    const int w = F.wave, fr = F.lane & 15, fq = F.lane >> 4, tid = F.tid;
    const int b = unit >> 5, tok0 = b * SEQ, hd = unit & 31, grp = hd >> 3, mh = (unit & 31) >> 2, vq = unit & 3;
    const float qs = 0.08838834764831845f;
    LAS unsigned char* QM = F.lds + MX_QM; LAS unsigned char* KM = F.lds + MX_KM; LAS unsigned char* KW = F.lds + MX_KW; LAS unsigned char* VT = F.lds + MX_VT; LAS unsigned char* SI = F.lds + MX_SI;
    LAS float* exch = (LAS float*)(F.lds + MX_VEC + (w >> 2) * MX_VECB + 1024) + (w & 3) * 32;
    LAS float* nvec = (LAS float*)(F.lds + MX_NVEC); LAS float* scal = (LAS float*)(F.lds + MX_SCAL);
    const bf16* qsrc; const bf16* ksrc; const bf16* vsrc; int ld;
    if (ML) { qsrc = PROJ + PC_Q + mh * 128; ksrc = PROJ + PC_K + mh * 128; vsrc = PROJ + PC_V + mh * 256 + vq * 64; ld = NPROJ; }
    else { qsrc = XC + 2560 + grp * 128; ksrc = XC + 2048 + grp * 128; vsrc = XC + hd * 64; ld = 3072; }
    const float c_a = ML ? 0.f : -expf(F.a_log[hd]), c_dtb = ML ? 0.f : F.dt_bias[hd], c_D = ML ? 0.f : F.d_skip[hd], c_ib = ML ? F.i_bias[mh] : 0.f, c_fb = ML ? F.f_bias[mh] : 0.f;
    float mprev = 0.f;
    f32x4 sacc[4]; float nreg = 0.f;
#pragma unroll
    for (int j = 0; j < 4; ++j) sacc[j] = (f32x4){0.f, 0.f, 0.f, 0.f};
    v4u pq[4], pk[4], pv[2];
#define MX_SCAN(c) do { if (w == 0) { \
        LAS float* vb = (LAS float*)(F.lds + MX_VEC + ((c) & 1) * MX_VECB); const int l0 = 2 * F.lane; const size_t tt = (size_t)(tok0 + 128 * (c) + l0); \
        if (!ML) { const float d0 = softplusf(SMALL[tt * 64 + hd] + c_dtb), d1 = softplusf(SMALL[(tt + 1) * 64 + hd] + c_dtb); \
            const float x0 = d0 * c_a, x1 = d1 * c_a; float incl = x0 + x1; \
            _Pragma("unroll") for (int d = 1; d < 64; d <<= 1) { const float t_ = __shfl_up(incl, d); if (F.lane >= d) incl += t_; } \
            const float cum1 = incl, cum0 = incl - x1, tot = __shfl(incl, 63); \
            *(LAS f32x2*)(vb + l0) = (f32x2){-cum0, -cum1}; *(LAS f32x2*)(vb + 128 + l0) = (f32x2){-cum0, -cum1}; *(LAS f32x2*)(vb + 256 + l0) = (f32x2){d0, d1}; \
            *(LAS f32x2*)(vb + 384 + l0) = (f32x2){expf(cum0), expf(cum1)}; *(LAS f32x2*)(vb + 512 + l0) = (f32x2){d0 * expf(tot - cum0), d1 * expf(tot - cum1)}; \
            if (F.lane == 0) { scal[2 * ((c) & 1)] = expf(tot); scal[2 * ((c) & 1) + 1] = 1.0f; } \
        } else { const float li0 = SMALL[tt * 64 + 32 + mh] + c_ib, li1 = SMALL[(tt + 1) * 64 + 32 + mh] + c_ib; \
            const float x0 = logsigf(SMALL[tt * 64 + 40 + mh] + c_fb), x1 = logsigf(SMALL[(tt + 1) * 64 + 40 + mh] + c_fb); float incl = x0 + x1; \
            _Pragma("unroll") for (int d = 1; d < 64; d <<= 1) { const float t_ = __shfl_up(incl, d); if (F.lane >= d) incl += t_; } \
            const float cum1 = incl, cum0 = incl - x1, btot = __shfl(incl, 63); \
            const float dd0 = li0 - cum0, dd1 = li1 - cum1; float im = fmaxf(dd0, dd1); \
            _Pragma("unroll") for (int d = 1; d < 64; d <<= 1) { const float t_ = __shfl_up(im, d); if (F.lane >= d) im = fmaxf(im, t_); } \
            float pm = __shfl_up(im, 1); if (F.lane == 0) pm = -3.0e38f; const float pmax0 = fmaxf(pm, dd0), pmax1 = im, pm127 = __shfl(im, 63); \
            const float M0 = fmaxf(mprev, pmax0), M1 = fmaxf(mprev, pmax1); \
            *(LAS f32x2*)(vb + l0) = (f32x2){dd0, dd1}; *(LAS f32x2*)(vb + 128 + l0) = (f32x2){M0, M1}; \
            *(LAS f32x2*)(vb + 384 + l0) = (f32x2){qs * expf(mprev - M0), qs * expf(mprev - M1)}; *(LAS f32x2*)(vb + 512 + l0) = (f32x2){expf(dd0 - pm127), expf(dd1 - pm127)}; \
            *(LAS f32x2*)(vb + 640 + l0) = (f32x2){expf(-(cum0 + M0)), expf(-(cum1 + M1))}; \
            const float mloc = btot + pm127, mnew = fmaxf(btot + mprev, mloc); \
            if (F.lane == 0) { scal[2 * ((c) & 1)] = expf(btot + mprev - mnew); scal[2 * ((c) & 1) + 1] = expf(mloc - mnew); } \
            mprev = mnew; } } } while (0)
#define MX_PREFETCH(c) do { const size_t tb_ = (size_t)(tok0 + 128 * (c)); \
        _Pragma("unroll") for (int i = 0; i < 2; ++i) { const int pid = tid + 512 * i, a2 = pid >> 4, k8 = pid & 15; \
            pq[2 * i] = *(const v4u*)(qsrc + (tb_ + 2 * a2) * ld + 8 * k8); pq[2 * i + 1] = *(const v4u*)(qsrc + (tb_ + 2 * a2 + 1) * ld + 8 * k8); \
            pk[2 * i] = *(const v4u*)(ksrc + (tb_ + 2 * a2) * ld + 8 * k8); pk[2 * i + 1] = *(const v4u*)(ksrc + (tb_ + 2 * a2 + 1) * ld + 8 * k8); } \
        { const int a2 = tid >> 3, v8 = tid & 7; pv[0] = *(const v4u*)(vsrc + (tb_ + 2 * a2) * ld + 8 * v8); pv[1] = *(const v4u*)(vsrc + (tb_ + 2 * a2 + 1) * ld + 8 * v8); } } while (0)
#define MX_WRITE(c) do { const LAS float* vb = (const LAS float*)(F.lds + MX_VEC + ((c) & 1) * MX_VECB); \
        _Pragma("unroll") for (int i = 0; i < 2; ++i) { const int pid = tid + 512 * i, a2 = pid >> 4, k8 = pid & 15, l = 2 * a2; \
            *(LAS v4u*)(QM + l * MX_PITCH + 16 * k8) = pq[2 * i]; *(LAS v4u*)(QM + (l + 1) * MX_PITCH + 16 * k8) = pq[2 * i + 1]; \
            *(LAS v4u*)(KM + l * MX_PITCH + 16 * k8) = pk[2 * i]; *(LAS v4u*)(KM + (l + 1) * MX_PITCH + 16 * k8) = pk[2 * i + 1]; \
            float f0[8], f1[8]; unpack8(pk[2 * i], f0); unpack8(pk[2 * i + 1], f1); const f32x2 wl = *(const LAS f32x2*)(vb + 512 + l); \
            _Pragma("unroll") for (int e = 0; e < 8; ++e) *(LAS unsigned*)(KW + (8 * k8 + e) * MX_PITCH + 2 * l) = pk2(f0[e] * wl.x, f1[e] * wl.y); } \
        { const int a2 = tid >> 3, v8 = tid & 7, l = 2 * a2; const v4u r0 = pv[0], r1 = pv[1]; LAS unsigned char* vp_ = VT + (8 * v8) * MX_PITCH + 2 * l; \
            *(LAS unsigned*)(vp_ + 0 * MX_PITCH) = (r0.x & 0xffffu) | (r1.x << 16); *(LAS unsigned*)(vp_ + 1 * MX_PITCH) = (r0.x >> 16) | (r1.x & 0xffff0000u); \
            *(LAS unsigned*)(vp_ + 2 * MX_PITCH) = (r0.y & 0xffffu) | (r1.y << 16); *(LAS unsigned*)(vp_ + 3 * MX_PITCH) = (r0.y >> 16) | (r1.y & 0xffff0000u); \
            *(LAS unsigned*)(vp_ + 4 * MX_PITCH) = (r0.z & 0xffffu) | (r1.z << 16); *(LAS unsigned*)(vp_ + 5 * MX_PITCH) = (r0.z >> 16) | (r1.z & 0xffff0000u); \
            *(LAS unsigned*)(vp_ + 6 * MX_PITCH) = (r0.w & 0xffffu) | (r1.w << 16); *(LAS unsigned*)(vp_ + 7 * MX_PITCH) = (r0.w >> 16) | (r1.w & 0xffff0000u); } \
        _Pragma("unroll") for (int j = 0; j < 4; ++j) { v2u sv; sv.x = pk2(sacc[j][0], sacc[j][1]); sv.y = pk2(sacc[j][2], sacc[j][3]); *(LAS v2u*)(SI + (16 * j + fr) * MX_PITCH + (16 * w + 4 * fq) * 2) = sv; } \
        if (ML && fq == 0) nvec[16 * w + fr] = nreg; } while (0)
    MX_SCAN(0);
    MX_PREFETCH(0);
    __syncthreads();
    MX_WRITE(0);
    __syncthreads();
    for (int c = 0; c < SEQ / 128; ++c) {
        const LAS float* vb = (const LAS float*)(F.lds + MX_VEC + (c & 1) * MX_VECB);
        const bool more = (c + 1 < SEQ / 128);
        if (more) { MX_PREFETCH(c + 1); }
        const size_t trow0 = (size_t)(tok0 + 128 * c + 16 * w + 4 * fq);
        unsigned short zr[4][4];
        if (!ML) {
#pragma unroll
            for (int r = 0; r < 4; ++r)
#pragma unroll
                for (int j = 0; j < 4; ++j) zr[r][j] = PROJ[(trow0 + r) * NPROJ + PC_Z + hd * 64 + 16 * j + fr];
        }
        bf16x8 qf[4];
#pragma unroll
        for (int ks = 0; ks < 4; ++ks) qf[ks] = lds_frag(QM, 16 * w + fr, 64 * ks + 16 * fq);
        const float mlv = vb[128 + 16 * w + fr];
        float dsum = 0.f;
        f32x4 y1[4], y2[4];
#pragma unroll
        for (int j = 0; j < 4; ++j) { y1[j] = (f32x4){0.f, 0.f, 0.f, 0.f}; y2[j] = (f32x4){0.f, 0.f, 0.f, 0.f}; }
#pragma unroll 1
        for (int k2 = 0; 2 * k2 <= w; ++k2) {
            unsigned pw[4];
#pragma unroll
            for (int h = 0; h < 2; ++h) {
                const int si = 2 * k2 + h;
                f32x4 acc = (f32x4){0.f, 0.f, 0.f, 0.f};
#pragma unroll
                for (int ks = 0; ks < 4; ++ks) acc = __builtin_amdgcn_mfma_f32_16x16x32_bf16(lds_frag(KM, 16 * si + fr, 64 * ks + 16 * fq), qf[ks], acc, 0, 0, 0);
                const f32x4 e4 = *(const LAS f32x4*)(vb + 16 * si + 4 * fq); f32x4 x4 = (f32x4){qs, qs, qs, qs}; if (!ML) x4 = *(const LAS f32x4*)(vb + 256 + 16 * si + 4 * fq);
                float p[4];
#pragma unroll
                for (int r = 0; r < 4; ++r) { const float v = acc[r] * __expf(e4[r] - mlv) * x4[r]; const bool ok = (si < w) || (si == w && 4 * fq + r <= fr); p[r] = ok ? v : 0.f; }
                if (ML) dsum += (p[0] + p[1]) + (p[2] + p[3]);
                pw[2 * h] = cvt_pk_bf16_nop(p[0], p[1]); pw[2 * h + 1] = cvt_pk_bf16_nop(p[2], p[3]);
            }
            ;
            const v4u pwv = (v4u){pw[0], pw[1], pw[2], pw[3]}; const bf16x8 pf = __builtin_bit_cast(bf16x8, pwv);
#pragma unroll
            for (int j = 0; j < 4; ++j) { const LAS unsigned char* vp = VT + (16 * j + fr) * MX_PITCH + (32 * k2 + 4 * fq) * 2;
                const v2u lo = *(const LAS v2u*)vp, hi = *(const LAS v2u*)(vp + 32); const v4u vw = (v4u){lo.x, lo.y, hi.x, hi.y};
                y1[j] = __builtin_amdgcn_mfma_f32_16x16x32_bf16(pf, __builtin_bit_cast(bf16x8, vw), y1[j], 0, 0, 0); }
            ;
        }
        ;
        __builtin_amdgcn_sched_barrier(0);
#pragma unroll
        for (int ks = 0; ks < 4; ++ks)
#pragma unroll
            for (int j = 0; j < 4; ++j) y2[j] = __builtin_amdgcn_mfma_f32_16x16x32_bf16(qf[ks], lds_frag(SI, 16 * j + fr, 64 * ks + 16 * fq), y2[j], 0, 0, 0);
        ;
        __builtin_amdgcn_sched_barrier(0);
        if (ML) {
            dsum += __shfl_xor(dsum, 16); dsum += __shfl_xor(dsum, 32);
            float d2 = 0.f;
#pragma unroll
            for (int ks = 0; ks < 4; ++ks) { float qv[8]; unpack8(__builtin_bit_cast(v4u, qf[ks]), qv); const f32x4 n0 = *(const LAS f32x4*)(nvec + 32 * ks + 8 * fq), n1 = *(const LAS f32x4*)(nvec + 32 * ks + 8 * fq + 4);
                d2 += qv[0] * n0.x + qv[1] * n0.y + qv[2] * n0.z + qv[3] * n0.w + qv[4] * n1.x + qv[5] * n1.y + qv[6] * n1.z + qv[7] * n1.w; }
            d2 += __shfl_xor(d2, 16); d2 += __shfl_xor(d2, 32);
            if (fq == 0) { exch[fr] = dsum; exch[16 + fr] = d2; }
        }
        ;
        __builtin_amdgcn_sched_barrier(0);
        f32x4 tmp[4];
#pragma unroll
        for (int j = 0; j < 4; ++j) tmp[j] = (f32x4){0.f, 0.f, 0.f, 0.f};
        float nsum = 0.f;
#pragma unroll
        for (int ks = 0; ks < 4; ++ks) { const bf16x8 kf = lds_frag(KW, 16 * w + fr, 64 * ks + 16 * fq);
            if (ML) { float kv[8]; unpack8(__builtin_bit_cast(v4u, kf), kv); nsum += ((kv[0] + kv[1]) + (kv[2] + kv[3])) + ((kv[4] + kv[5]) + (kv[6] + kv[7])); }
#pragma unroll
            for (int j = 0; j < 4; ++j) tmp[j] = __builtin_amdgcn_mfma_f32_16x16x32_bf16(kf, lds_frag(VT, 16 * j + fr, 64 * ks + 16 * fq), tmp[j], 0, 0, 0); }
        const float sa = scal[2 * (c & 1)], sg = scal[2 * (c & 1) + 1];
#pragma unroll
        for (int j = 0; j < 4; ++j) sacc[j] = sacc[j] * sa + tmp[j] * sg;
        if (ML) { nsum += __shfl_xor(nsum, 16); nsum += __shfl_xor(nsum, 32); nreg = nreg * sa + nsum * sg; }
        ;
        __builtin_amdgcn_sched_barrier(0);
        const f32x4 rs4 = *(const LAS f32x4*)(vb + 384 + 16 * w + 4 * fq);
        float yo[4][4];
        if (ML) { const f32x4 fl4 = *(const LAS f32x4*)(vb + 640 + 16 * w + 4 * fq); const f32x4 dA = *(const LAS f32x4*)(exch + 4 * fq), dB = *(const LAS f32x4*)(exch + 16 + 4 * fq);
#pragma unroll
            for (int r = 0; r < 4; ++r) { const float den = fmaxf(fabsf(dA[r] + rs4[r] * dB[r]), fl4[r]); const float inv = 1.0f / den;
#pragma unroll
                for (int j = 0; j < 4; ++j) yo[r][j] = (y1[j][r] + rs4[r] * y2[j][r]) * inv; }
        } else {
#pragma unroll
            for (int j = 0; j < 4; ++j) { const v2u xw = *(const LAS v2u*)(VT + (16 * j + fr) * MX_PITCH + (16 * w + 4 * fq) * 2); const float xs[4] = {bflo(xw.x), bfhi(xw.x), bflo(xw.y), bfhi(xw.y)};
#pragma unroll
                for (int r = 0; r < 4; ++r) { const float zz = __builtin_bit_cast(float, (unsigned)zr[r][j] << 16); yo[r][j] = (y1[j][r] + rs4[r] * y2[j][r] + c_D * xs[r]) * siluf(zz); } }
        }
        bf16* yrow = YMIX + trow0 * 4096 + (ML ? 2048 + mh * 256 + vq * 64 : hd * 64) + fr;
#pragma unroll
        for (int r = 0; r < 4; ++r) { float ss = (yo[r][0] * yo[r][0] + yo[r][1] * yo[r][1]) + (yo[r][2] * yo[r][2] + yo[r][3] * yo[r][3]);
            ss += __shfl_xor(ss, 1); ss += __shfl_xor(ss, 2); ss += __shfl_xor(ss, 4); ss += __shfl_xor(ss, 8);
            if (fr == 0) SSQ[(ML ? (size_t)TT * 32 : 0) + (trow0 + r) * 32 + (ML ? mh * 4 + vq : hd)] = ss;
#pragma unroll
            for (int j = 0; j < 4; ++j) yrow[(size_t)r * 4096 + 16 * j] = (bf16)f2bf(yo[r][j]); }
        __syncthreads();
        if (more) { MX_SCAN(c + 1); }
        __syncthreads();
        if (more) { MX_WRITE(c + 1); }
        __syncthreads();
    }
#undef MX_SCAN
#undef MX_PREFETCH
#undef MX_WRITE
}
__device__ __forceinline__ void phase_mixer(Frame& F) {
    for (int unit = F.bid; unit < 256; unit += F.G) { mixer_unit<false>(F, unit); mixer_unit<true>(F, unit); }
}

__device__ __forceinline__ void phase3(Frame& F) {
    const bf16* PROJ = (const bf16*)(F.ws + WS_PROJ); bf16* YMIX = (bf16*)(F.ws + WS_YMIX); const float* SSQ = (const float*)(F.ws + WS_SSQ);
    const int gw = F.bid * NWAVES + F.wave, NGW = F.G * NWAVES;
    for (int t = gw; t < TT; t += NGW) {
        bf16* yrow = YMIX + (size_t)t * 4096;
#pragma unroll
        for (int j = 0; j < 8; ++j) {
            const int c0 = (j * 64 + F.lane) * 8;
            float y[8]; unpack8(*(const v4u*)(yrow + c0), y);
            float o[8];
            if (j < 4) {
                const int g = c0 >> 9; const f32x4 s0 = *(const f32x4*)(SSQ + (size_t)t * 32 + g * 8), s1 = *(const f32x4*)(SSQ + (size_t)t * 32 + g * 8 + 4);
                const float ms = ((s0.x + s0.y) + (s0.z + s0.w) + (s1.x + s1.y) + (s1.z + s1.w)) * (1.0f / 512.0f);
                const float rs = 1.0f / sqrtf(ms + EPSF);
                const f32x4 w0 = *(const f32x4*)(F.ssd_norm_w + c0), w1 = *(const f32x4*)(F.ssd_norm_w + c0 + 4);
                o[0] = y[0] * rs * w0.x; o[1] = y[1] * rs * w0.y; o[2] = y[2] * rs * w0.z; o[3] = y[3] * rs * w0.w;
                o[4] = y[4] * rs * w1.x; o[5] = y[5] * rs * w1.y; o[6] = y[6] * rs * w1.z; o[7] = y[7] * rs * w1.w;
            } else {
                const int cc = c0 - 2048, h = cc >> 8; const f32x4 s0 = *(const f32x4*)(SSQ + (size_t)TT * 32 + (size_t)t * 32 + h * 4);
                const float ms = ((s0.x + s0.y) + (s0.z + s0.w)) * (1.0f / 256.0f);
                const float rs = 1.0f / sqrtf(ms + EPSF);
                const f32x4 w0 = *(const f32x4*)(F.ml_norm_w + cc), w1 = *(const f32x4*)(F.ml_norm_w + cc + 4);
                float og[8]; unpack8(*(const v4u*)(PROJ + (size_t)t * NPROJ + PC_O + cc), og);
                const float wv[8] = {w0.x, w0.y, w0.z, w0.w, w1.x, w1.y, w1.z, w1.w};
#pragma unroll
                for (int i = 0; i < 8; ++i) o[i] = y[i] * rs * wv[i] * (1.0f / (1.0f + __expf(-og[i])));
            }
            v4u ov; ov.x = pk2(o[0], o[1]); ov.y = pk2(o[2], o[3]); ov.z = pk2(o[4], o[5]); ov.w = pk2(o[6], o[7]);
            *(v4u*)(yrow + c0) = ov;
        }
    }
}

__device__ __forceinline__ void phase5(Frame& F) {
    const float* H2 = (const float*)(F.ws + WS_H2); const float* Wrt = (const float*)(F.ws + WS_WRT); bf16* XN2 = (bf16*)(F.ws + WS_XN2);
    int* EIDX = (int*)(F.ws + WS_ROUTE); int* RANK = EIDX + TT * 4; float* GATE = (float*)(RANK + TT * 4);
    LAS float* xT = (LAS float*)(F.lds + F.wave * 8192); LAS float* lg = (LAS float*)(F.lds + 65536 + F.wave * 1024);
    LAS int* cntl = (LAS int*)(F.lds + 73728); LAS int* baseg = cntl + 32;
    const int gw = F.bid * NWAVES + F.wave, NGW = F.G * NWAVES, ntask = TT / 8, iters = (ntask + NGW - 1) / NGW;
    for (int itx = 0; itx < iters; ++itx) {
        const int task = itx * NGW + gw; const bool valid = task < ntask; const int t0 = task * 8;
        if (F.tid < 32) cntl[F.tid] = 0;
        __syncthreads();
        float rstd[8]; int me[4] = {0, 0, 0, 0}, mr[4] = {0, 0, 0, 0}; float mg[4] = {0.f, 0.f, 0.f, 0.f};
#pragma unroll
        for (int k = 0; k < 8; ++k) rstd[k] = 0.f;
        if (valid) {
            float acc[8], ssq[8];
#pragma unroll
            for (int k = 0; k < 8; ++k) { acc[k] = 0.f; ssq[k] = 0.f; }
            const int e = F.lane & 31, dh = F.lane >> 5;
            for (int dc = 0; dc < 8; ++dc) {
#pragma unroll
                for (int jj = 0; jj < 4; ++jj) { float xv[8];
#pragma unroll
                    for (int k = 0; k < 8; ++k) { xv[k] = H2[(size_t)(t0 + k) * DM + dc * 256 + jj * 64 + F.lane]; ssq[k] += xv[k] * xv[k]; }
                    LAS float* dp = xT + (jj * 64 + F.lane) * 8; *(LAS f32x4*)dp = (f32x4){xv[0], xv[1], xv[2], xv[3]}; *(LAS f32x4*)(dp + 4) = (f32x4){xv[4], xv[5], xv[6], xv[7]}; }
                LDS_WAIT(); asm volatile("" ::: "memory");
                const float* wp = Wrt + (size_t)(dc * 256 + dh * 128) * 32 + e; const LAS float* xp = xT + dh * 128 * 8;
#pragma unroll 4
                for (int i = 0; i < 128; ++i) { const float w = wp[i * 32]; const f32x4 xa = *(const LAS f32x4*)(xp + i * 8), xb = *(const LAS f32x4*)(xp + i * 8 + 4);
                    acc[0] += w * xa.x; acc[1] += w * xa.y; acc[2] += w * xa.z; acc[3] += w * xa.w; acc[4] += w * xb.x; acc[5] += w * xb.y; acc[6] += w * xb.z; acc[7] += w * xb.w; }
                LDS_WAIT(); asm volatile("" ::: "memory");
            }
            const float rb = F.router_b[e];
#pragma unroll
            for (int k = 0; k < 8; ++k) { rstd[k] = 1.0f / sqrtf(wave_sum(ssq[k]) * (1.0f / 2048.0f) + EPSF);
                const float v = (acc[k] + __shfl_xor(acc[k], 32)) * rstd[k] + rb; if (F.lane < 32) lg[k * 32 + e] = v; }
            LDS_WAIT(); asm volatile("" ::: "memory");
            if (F.lane < 8) {
                const LAS float* lp = lg + F.lane * 32; float bv[4]; int bi[4] = {-1, -1, -1, -1};
#pragma unroll
                for (int p = 0; p < 4; ++p) { float best = -3.0e38f; int bidx = 0;
                    for (int q = 0; q < 32; ++q) { const float v = lp[q]; const bool taken = (q == bi[0]) | (q == bi[1]) | (q == bi[2]) | (q == bi[3]); if (!taken && v > best) { best = v; bidx = q; } }
                    bv[p] = best; bi[p] = bidx; }
                const float p1 = expf(bv[1] - bv[0]), p2 = expf(bv[2] - bv[0]), p3 = expf(bv[3] - bv[0]); const float inv = 1.0f / (1.0f + p1 + p2 + p3);
                mg[0] = inv; mg[1] = p1 * inv; mg[2] = p2 * inv; mg[3] = p3 * inv;
#pragma unroll
                for (int p = 0; p < 4; ++p) { me[p] = bi[p]; mr[p] = __hip_atomic_fetch_add(cntl + bi[p], 1, __ATOMIC_RELAXED, __HIP_MEMORY_SCOPE_WORKGROUP); }
            }
        }
        __syncthreads();
        if (F.tid < 32) { const int c = cntl[F.tid]; int gb = 0; if (c > 0) gb = (int)__hip_atomic_fetch_add((unsigned*)(F.ctl + CW_CNT + 64 * F.tid), (unsigned)c, RLX_AGENT); baseg[F.tid] = gb; }
        __syncthreads();
        if (valid) {
            if (F.lane < 8) { const size_t t = (size_t)(t0 + F.lane);
#pragma unroll
                for (int p = 0; p < 4; ++p) { EIDX[t * 4 + p] = me[p]; RANK[t * 4 + p] = baseg[me[p]] + mr[p]; GATE[t * 4 + p] = mg[p]; } }
#pragma unroll
            for (int k = 0; k < 8; ++k) { const f32x4* xr = (const f32x4*)(H2 + (size_t)(t0 + k) * DM) + F.lane; const f32x4* wr = (const f32x4*)F.norm2_w + F.lane; v2u* o8 = (v2u*)(XN2 + (size_t)(t0 + k) * DM) + F.lane;
#pragma unroll
                for (int j = 0; j < 8; ++j) { const f32x4 v = xr[64 * j], ww = wr[64 * j]; v2u o; o.x = pk2(v.x * rstd[k] * ww.x, v.y * rstd[k] * ww.y); o.y = pk2(v.z * rstd[k] * ww.z, v.w * rstd[k] * ww.w); o8[64 * j] = o; } }
        }
        __syncthreads();
    }
}
__device__ __forceinline__ void phase5b(Frame& F) {
    const bf16* XN2 = (const bf16*)(F.ws + WS_XN2); bf16* XG = (bf16*)(F.ws + WS_XG);
    const int* EIDX = (const int*)(F.ws + WS_ROUTE); const int* RANK = EIDX + TT * 4; const float* GATE = (const float*)(RANK + TT * 4); int* SLOT = (int*)(GATE + TT * 4); float* SGATE = (float*)(SLOT + TT * 4);
    LAS int* sbase = (LAS int*)(F.lds); LAS int* spad = sbase + 32;
    if (F.tid < 32) { const int c = (int)__hip_atomic_load((unsigned*)(F.ctl + CW_CNT + 64 * F.tid), RLX_AGENT); spad[F.tid] = (c + 255) & ~255; }
    __syncthreads();
    if (F.tid == 0) { int a = 0; for (int e = 0; e < 32; ++e) { sbase[e] = a; a += spad[e]; } }
    __syncthreads();
    const int gw = F.bid * NWAVES + F.wave, NGW = F.G * NWAVES;
    for (int task = gw; task < TT / 8; task += NGW) {
#pragma unroll 2
        for (int k = 0; k < 8; ++k) { const size_t t = (size_t)task * 8 + k;
            int slot = 0;
            if (F.lane < 4) { const int e = EIDX[t * 4 + F.lane]; slot = sbase[e] + RANK[t * 4 + F.lane]; SLOT[t * 4 + F.lane] = slot; SGATE[slot] = GATE[t * 4 + F.lane]; }
            const int s0 = __shfl(slot, 0), s1 = __shfl(slot, 1), s2 = __shfl(slot, 2), s3 = __shfl(slot, 3);
            const v4u* src = (const v4u*)(XN2 + t * DM) + F.lane; v4u d[4];
#pragma unroll
            for (int j = 0; j < 4; ++j) d[j] = src[64 * j];
            v4u* d0 = (v4u*)(XG + (size_t)s0 * DM) + F.lane; v4u* d1 = (v4u*)(XG + (size_t)s1 * DM) + F.lane; v4u* d2 = (v4u*)(XG + (size_t)s2 * DM) + F.lane; v4u* d3 = (v4u*)(XG + (size_t)s3 * DM) + F.lane;
#pragma unroll
            for (int j = 0; j < 4; ++j) { d0[64 * j] = d[j]; d1[64 * j] = d[j]; d2[64 * j] = d[j]; d3[64 * j] = d[j]; }
        }
    }
}
__device__ __forceinline__ int build_moe_tab(Frame& F) {
    LAS unsigned char* tab = (LAS unsigned char*)(F.lds + TAB_OFF); LAS int* tinfo = (LAS int*)(F.lds + TAB_OFF + 320);
    if (F.tid < 32) { const int c = (int)__hip_atomic_load((unsigned*)(F.ctl + CW_CNT + 64 * F.tid), RLX_AGENT); tinfo[4 + F.tid] = (c + 255) >> 8; }
    __syncthreads();
    if (F.tid == 0) { int a = 0; for (int e = 0; e < 32; ++e) { const int n = tinfo[4 + e]; for (int j = 0; j < n; ++j) tab[a + j] = (unsigned char)e; a += n; } tinfo[0] = a; }
    __syncthreads();
    return tinfo[0];
}
__device__ __forceinline__ void phase8(Frame& F) {
    const float* H2 = (const float*)(F.ws + WS_H2); const bf16* YR = (const bf16*)(F.ws + WS_YR);
    const int* SLOT = (const int*)(F.ws + WS_ROUTE) + TT * 12;
    const int gw = F.bid * NWAVES + F.wave, NGW = F.G * NWAVES;
    for (int t = gw; t < TT; t += NGW) {
        int slot = 0; if (F.lane < 4) slot = SLOT[(size_t)t * 4 + F.lane];
        int sl[4]; sl[0] = __shfl(slot, 0); sl[1] = __shfl(slot, 1); sl[2] = __shfl(slot, 2); sl[3] = __shfl(slot, 3);
        float v[4][8]; float ss = 0.f;
#pragma unroll
        for (int j = 0; j < 4; ++j) { const int pz = F.lane + 64 * j; const f32x4 a = *(const f32x4*)(H2 + (size_t)t * DM + 8 * pz), b = *(const f32x4*)(H2 + (size_t)t * DM + 8 * pz + 4);
            v[j][0] = a.x; v[j][1] = a.y; v[j][2] = a.z; v[j][3] = a.w; v[j][4] = b.x; v[j][5] = b.y; v[j][6] = b.z; v[j][7] = b.w; }
#pragma unroll
        for (int k = 0; k < 4; ++k)
#pragma unroll
            for (int j = 0; j < 4; ++j) { float f[8]; unpack8(*((const v4u*)(YR + (size_t)sl[k] * DM) + F.lane + 64 * j), f);
#pragma unroll
                for (int i = 0; i < 8; ++i) v[j][i] += f[i]; }
#pragma unroll
        for (int j = 0; j < 4; ++j)
#pragma unroll
            for (int i = 0; i < 8; ++i) ss += v[j][i] * v[j][i];
        const float rstd = 1.0f / sqrtf(wave_sum(ss) * (1.0f / 2048.0f) + EPSF);
#pragma unroll
        for (int j = 0; j < 4; ++j) { const int pz = F.lane + 64 * j; const f32x4 w0 = *(const f32x4*)(F.final_norm_w + 8 * pz), w1 = *(const f32x4*)(F.final_norm_w + 8 * pz + 4);
            *(f32x4*)(F.out + (size_t)t * DM + 8 * pz) = (f32x4){v[j][0] * rstd * w0.x, v[j][1] * rstd * w0.y, v[j][2] * rstd * w0.z, v[j][3] * rstd * w0.w};
            *(f32x4*)(F.out + (size_t)t * DM + 8 * pz + 4) = (f32x4){v[j][4] * rstd * w1.x, v[j][5] * rstd * w1.y, v[j][6] * rstd * w1.z, v[j][7] * rstd * w1.w}; }
    }
}

struct Args { const float* in[21]; float* out; unsigned char* ws; int ph_lo, ph_hi, li, pad; };
__global__ void __launch_bounds__(NWAVES * 64, 2) hymba_fwd(Args args) {
    extern __shared__ __attribute__((aligned(16))) unsigned char lds[];
    Frame F;
    F.lds = (LAS unsigned char*)lds; F.MISC = (volatile LAS unsigned*)(F.lds + MISC_OFF);
    F.tid = threadIdx.x; F.lane = F.tid & 63; F.wave = __builtin_amdgcn_readfirstlane(F.tid >> 6); F.G = gridDim.x; F.bid = blockIdx.x;
    F.ws = args.ws; F.ctl = (gu32*)(args.ws + WS_CTL); F.out = args.out;
    F.x = args.in[0]; F.norm1_w = args.in[1]; F.w_in = args.in[2]; F.conv_w = args.in[3]; F.conv_b = args.in[4]; F.dt_bias = args.in[5]; F.a_log = args.in[6]; F.d_skip = args.in[7]; F.ssd_norm_w = args.in[8];
    F.i_bias = args.in[9]; F.f_bias = args.in[10]; F.ml_norm_w = args.in[11]; F.w_out = args.in[12]; F.norm2_w = args.in[13]; F.router_w = args.in[14]; F.router_b = args.in[15];
    F.w_gate_up = args.in[16]; F.b_gate_up = args.in[17]; F.w_down = args.in[18]; F.b_down = args.in[19]; F.final_norm_w = args.in[20];
    for (int u = F.tid; u < (LDS_BYTES - LDSCTL_OFF) / 4; u += NWAVES * 64) ((LAS unsigned*)(F.lds + LDSCTL_OFF))[u] = 0u;
    __syncthreads();
    XcdBarrier bar; bar.bar = (unsigned*)(F.ctl + CW_BAR) + args.li * XCD_BAR_WORDS; bar.x = 0; bar.st = nullptr;
    const bool use_bar = (args.ph_hi - args.ph_lo) > 1;
    if (use_bar) bar = xcd_barrier_post((unsigned*)(F.ctl + CW_BAR) + args.li * XCD_BAR_WORDS, F.MISC + 8);
    const int lo = args.ph_lo, hi = args.ph_hi;
#ifndef PHASE_MASK
#define PHASE_MASK 0x7ff
#endif
#define IN(k) (((PHASE_MASK >> (k)) & 1) && lo <= (k) && (k) < hi)
#define SEAM(k) do { if (IN(k) && IN((k) + 1)) xcd_barrier(bar); } while (0)
    if (IN(0)) { phase0(F); } SEAM(0);
    if (IN(1)) {
        pg8::Gemm g{(const pg8::bf16_t*)(F.ws + WS_XN1), (const pg8::bf16_t*)(F.ws + WS_WIN), TT, NPROJ, DM}; pg8::StaticOrder S; S.init(TT, NPROJ, F.G, F.bid);
        pg8::EpiBf16 E{(pg8::bf16_t*)(F.ws + WS_PROJ), NPROJ};
        pg8::gemm_phase<pg8::EpiBf16, pg8::StaticOrder, true, true>(F.lds, g, S, E);
        p1_small(F);
    } SEAM(1);
    if (IN(2)) { phase_conv(F); } SEAM(2);
    if (IN(3)) { phase_mixer(F); } SEAM(3);
    if (IN(4)) { phase3(F); } SEAM(4);
    if (IN(5)) {
        pg8::Gemm g{(const pg8::bf16_t*)(F.ws + WS_YMIX), (const pg8::bf16_t*)(F.ws + WS_WOUT), TT, DM, 4096}; pg8::StaticOrder S; S.init(TT, DM, F.G, F.bid);
        pg8::EpiResF32 E{(float*)(F.ws + WS_H2), F.x, DM};
        pg8::gemm_phase<pg8::EpiResF32, pg8::StaticOrder, true, true>(F.lds, g, S, E);
    } SEAM(5);
    if (IN(6)) { phase5(F); } SEAM(6);
    if (IN(7)) { phase5b(F); } SEAM(7);
    if (IN(8)) {
        const int nM = build_moe_tab(F);
        pg8::Gemm g{(const pg8::bf16_t*)(F.ws + WS_XG), (const pg8::bf16_t*)(F.ws + WS_WGU), nM * 256, 4096, DM};
        pg8::MoeOrder S{nM, 16, 4, nM * 16, F.G, F.bid, (const PG8_LAS unsigned char*)(F.lds + TAB_OFF)};
        pg8::EpiSwiglu E{(pg8::bf16_t*)(F.ws + WS_ACT), F.b_gate_up};
        pg8::gemm_phase<pg8::EpiSwiglu, pg8::MoeOrder, true, true>(F.lds, g, S, E);
    } SEAM(8);
    if (IN(9)) {
        const int nM = build_moe_tab(F);
        pg8::Gemm g{(const pg8::bf16_t*)(F.ws + WS_ACT), (const pg8::bf16_t*)(F.ws + WS_WD), nM * 256, 2048, DM};
        pg8::MoeOrder S{nM, 8, 3, nM * 8, F.G, F.bid, (const PG8_LAS unsigned char*)(F.lds + TAB_OFF)};
        pg8::EpiDown E{(pg8::bf16_t*)(F.ws + WS_YR), F.b_down, (const float*)((const int*)(F.ws + WS_ROUTE) + TT * 16)};
        pg8::gemm_phase<pg8::EpiDown, pg8::MoeOrder, true, true>(F.lds, g, S, E);
    } SEAM(9);
    if (IN(10)) { phase8(F); }
#undef IN
#undef SEAM
}

extern "C" void kernel_launch(void* const* d_in, const int* in_sizes, int n_in, void* d_out, int out_size, void* d_ws, size_t ws_size, hipStream_t stream) {
    static int grid = 0;
    if (grid == 0) {
        if (n_in != 21 || out_size != TT * DM || ws_size < WS_END) { fprintf(stderr, "kernel_launch: unexpected problem (n_in %d, out %d, ws %zu); nothing launched\n", n_in, out_size, ws_size); grid = -1; return; }
        int dev = 0, cus = 0, per_cu = 0;
        if (hipGetDevice(&dev) != hipSuccess || hipDeviceGetAttribute(&cus, hipDeviceAttributeMultiprocessorCount, dev) != hipSuccess) { grid = -1; return; }
        if (hipFuncSetAttribute((const void*)hymba_fwd, hipFuncAttributeMaxDynamicSharedMemorySize, LDS_BYTES) != hipSuccess) { fprintf(stderr, "kernel_launch: hipFuncSetAttribute failed\n"); grid = -1; return; }
        if (hipOccupancyMaxActiveBlocksPerMultiprocessor(&per_cu, (const void*)hymba_fwd, NWAVES * 64, LDS_BYTES) != hipSuccess || per_cu < 1) { fprintf(stderr, "kernel_launch: occupancy query says %d blocks per CU\n", per_cu); }
        (void)hipGetLastError();
        grid = cus;
    }
    if (grid < 0) return;
    (void)hipMemsetAsync((char*)d_ws + WS_CTL, 0, CTL_ZERO_BYTES, stream);
    Args a{};
    for (int i = 0; i < 21; ++i) a.in[i] = (const float*)d_in[i];
    a.out = (float*)d_out; a.ws = (unsigned char*)d_ws; a.pad = 0;
#if MK_PER_PHASE
    for (int li = 0; li < N_PHASES; ++li) { a.ph_lo = li; a.ph_hi = li + 1; a.li = li; hipLaunchKernelGGL(hymba_fwd, dim3(grid), dim3(NWAVES * 64), LDS_BYTES, stream, a); }
#else
    a.ph_lo = 0; a.ph_hi = N_PHASES; a.li = 0;
    hipLaunchKernelGGL(hymba_fwd, dim3(grid), dim3(NWAVES * 64), LDS_BYTES, stream, a);
#endif
}
```

```cpp
#include <hip/hip_runtime.h>
#include <cstdio>
#include <cstdint>
namespace pg8 {
#define PG8_LAS __attribute__((address_space(3)))
typedef unsigned short bf16_t;
typedef short bf16x8 __attribute__((ext_vector_type(8)));
typedef float f32x4 __attribute__((ext_vector_type(4)));
typedef unsigned u32x4 __attribute__((ext_vector_type(4)));
constexpr int BM = 256, BK = 64, HALF = 128, HTB = HALF * BK * 2  , STAGE_BYTES = 8 * HTB, NXCD = 8, WGM = 8;

__host__ __device__ __forceinline__ int lds_byte(int r, int c) { const int st = (r >> 4) * 2 + (c >> 5), rr = r & 15, cc = c & 31, ob = rr * 64 + cc * 2; return st * 1024 + (ob ^ (((ob >> 9) & 1) << 5)); }
__host__ __device__ __forceinline__ void stage_rc(int b, int& R, int& C) { const int st = b / 1024, sb = b % 1024, swz = sb ^ (((sb >> 9) & 1) << 5); R = (st >> 1) * 16 + swz / 64; C = (st & 1) * 32 + (swz % 64) / 2; }
__host__ __device__ __forceinline__ int perm32(int rho) { const int n = rho >> 4, i = rho & 15; return 8 * (i >> 2) + 4 * n + (i & 3); }

struct Unit { int pm, pn; };
struct Gemm { const bf16_t* A; const bf16_t* Bt; int M, N, K; };

struct StaticOrder {
    int nM, nN, nwg, G, c;
    __host__ __device__ void init(int M, int N, int G_, int c_) { nM = M / BM; nN = N / BM; nwg = nM * nN; G = G_; c = c_; }
    __host__ __device__ bool next(int i, Unit& u) const {
        const long L = (long)i * G + c; if (L >= nwg) return false;
        int wgid = (int)L; { const int q = nwg / NXCD, r = nwg % NXCD, xcd = wgid % NXCD, off = wgid / NXCD; wgid = (xcd < r ? xcd * (q + 1) : r * (q + 1) + (xcd - r) * q) + off; }
        const int nig = WGM * nN, gid = wgid / nig, fm = gid * WGM, gsz = (nM - fm) < WGM ? (nM - fm) : WGM;
        u.pm = fm + ((wgid % nig) % gsz); u.pn = (wgid % nig) / gsz; return true;
    }
    __device__ __forceinline__ void a_ready(const Unit&) const {}
    __device__ __forceinline__ void done(const Unit&) const {}
};


__device__ __forceinline__ unsigned cvt_pk_bf16(float lo, float hi) { unsigned r; asm volatile("v_cvt_pk_bf16_f32 %0, %1, %2" : "=v"(r) : "v"(lo), "v"(hi)); return r; }
typedef unsigned u32x2 __attribute__((ext_vector_type(2)));

struct EpiBf16 {
    static constexpr bool PERM = true, AFTER_DRAIN = false;
    bf16_t* O; int ldc;
    __device__ __forceinline__ void operator()(const f32x4 (&acc)[2][2][4][2], const Unit& u, int wr, int wc, int fr, int fq) const {
        const int row0 = u.pm * BM + wr * 64 + fr; const int col0 = u.pn * BM + wc * 32 + 8 * fq;
#pragma unroll
        for (int ai = 0; ai < 2; ++ai)
#pragma unroll
            for (int m = 0; m < 4; ++m) { bf16_t* rowp = O + (size_t)(row0 + ai * HALF + m * 16) * ldc + col0;
#pragma unroll
                for (int bj = 0; bj < 2; ++bj) { const f32x4 v0 = acc[ai][bj][m][0], v1 = acc[ai][bj][m][1];
                    u32x4 w; w.x = cvt_pk_bf16(v0[0], v0[1]); w.y = cvt_pk_bf16(v0[2], v0[3]); w.z = cvt_pk_bf16(v1[0], v1[1]); w.w = cvt_pk_bf16(v1[2], v1[3]);
                    *(u32x4*)(rowp + bj * HALF) = w; } }
    }
};
struct EpiResF32 {
    static constexpr bool PERM = false, AFTER_DRAIN = false;
    float* C; const float* base; int ldc;
    __device__ __forceinline__ void operator()(const f32x4 (&acc)[2][2][4][2], const Unit& u, int wr, int wc, int fr, int fq) const {
        const int row0 = u.pm * BM + wr * 64 + fr, col0 = u.pn * BM + wc * 32 + 4 * fq;
#pragma unroll
        for (int ai = 0; ai < 2; ++ai)
#pragma unroll
            for (int m = 0; m < 4; ++m) { const size_t off = (size_t)(row0 + ai * HALF + m * 16) * ldc + col0;
#pragma unroll
                for (int bj = 0; bj < 2; ++bj)
#pragma unroll
                    for (int n = 0; n < 2; ++n) *(f32x4*)(C + off + bj * HALF + n * 16) = acc[ai][bj][m][n] + *(const f32x4*)(base + off + bj * HALF + n * 16); }
    }
};
__device__ __forceinline__ float swiglu1(float a, float b) {
    const float glu = fminf(a, 7.0f), lin = fminf(fmaxf(b, -7.0f), 7.0f);
    return glu * (1.0f / (1.0f + __expf(-1.702f * glu))) * (lin + 1.0f);
}
struct EpiSwiglu {
    static constexpr bool PERM = true, AFTER_DRAIN = false;
    unsigned char* O; const float* bias;
    __device__ __forceinline__ void operator()(const f32x4 (&acc)[2][2][4][2], const Unit& u, int wr, int wc, int fr, int fq) const {
        const int e = u.pn >> 4, pnl = u.pn & 15;
        const int row0 = u.pm * BM + wr * 64 + fr; const int hcol0 = pnl * BM + wc * 32 + 8 * fq;
        const float* bp = bias + (size_t)e * 4096 + hcol0;
        f32x4 bv[2][2];
#pragma unroll
        for (int bj = 0; bj < 2; ++bj)
#pragma unroll
            for (int n = 0; n < 2; ++n) bv[bj][n] = *(const f32x4*)(bp + bj * HALF + 4 * n);
#pragma unroll
        for (int ai = 0; ai < 2; ++ai)
#pragma unroll
            for (int m = 0; m < 4; ++m) { unsigned char* rowp = O + (size_t)(row0 + ai * HALF + m * 16) * 2048 + (hcol0 >> 1);
#pragma unroll
                for (int bj = 0; bj < 2; ++bj) { const f32x4 v0 = acc[ai][bj][m][0] + bv[bj][0], v1 = acc[ai][bj][m][1] + bv[bj][1];
                    int w = __builtin_amdgcn_cvt_pk_fp8_f32(swiglu1(v0[0], v0[1]), swiglu1(v0[2], v0[3]), 0, false);
                    w = __builtin_amdgcn_cvt_pk_fp8_f32(swiglu1(v1[0], v1[1]), swiglu1(v1[2], v1[3]), w, true);
                    *(int*)(rowp + bj * 64) = w; } }
    }
};
struct EpiDown {
    static constexpr bool PERM = true, AFTER_DRAIN = false;
    bf16_t* O; const float* bias; const float* sgate;
    __device__ __forceinline__ void operator()(const f32x4 (&acc)[2][2][4][2], const Unit& u, int wr, int wc, int fr, int fq) const {
        const int e = u.pn >> 3, pnl = u.pn & 7;
        const int row0 = u.pm * BM + wr * 64 + fr; const int col0 = pnl * BM + wc * 32 + 8 * fq;
        const float* bp = bias + (size_t)e * 2048 + col0;
        f32x4 bv[2][2];
#pragma unroll
        for (int bj = 0; bj < 2; ++bj)
#pragma unroll
            for (int n = 0; n < 2; ++n) bv[bj][n] = *(const f32x4*)(bp + bj * HALF + 4 * n);
#pragma unroll
        for (int ai = 0; ai < 2; ++ai)
#pragma unroll
            for (int m = 0; m < 4; ++m) { const int row = row0 + ai * HALF + m * 16; const float gt = sgate[row]; bf16_t* rowp = O + (size_t)row * 2048 + col0;
#pragma unroll
                for (int bj = 0; bj < 2; ++bj) { const f32x4 v0 = (acc[ai][bj][m][0] + bv[bj][0]) * gt, v1 = (acc[ai][bj][m][1] + bv[bj][1]) * gt;
                    u32x4 w; w.x = cvt_pk_bf16(v0[0], v0[1]); w.y = cvt_pk_bf16(v0[2], v0[3]); w.z = cvt_pk_bf16(v1[0], v1[1]); w.w = cvt_pk_bf16(v1[2], v1[3]);
                    *(u32x4*)(rowp + bj * HALF) = w; } }
    }
};
struct MoeOrder {
    int nM, nN, nsh, nwg, G, c; const PG8_LAS unsigned char* tab;
    __device__ __forceinline__ bool next(int i, Unit& u) const {
        const long L = (long)i * G + c; if (L >= nwg) return false;
        int wgid = (int)L; { const int q = nwg / NXCD, r = nwg % NXCD, xcd = wgid % NXCD, off = wgid / NXCD; wgid = (xcd < r ? xcd * (q + 1) : r * (q + 1) + (xcd - r) * q) + off; }
        const int nig = WGM * nN, gid = wgid / nig, fm = gid * WGM, gsz = (nM - fm) < WGM ? (nM - fm) : WGM;
        const int pm = fm + ((wgid % nig) % gsz), pnl = (wgid % nig) / gsz;
        u.pm = pm; u.pn = ((int)tab[pm] << nsh) + pnl; return true;
    }
    __device__ __forceinline__ void a_ready(const Unit&) const {}
    __device__ __forceinline__ void done(const Unit&) const {}
};
typedef int v8i32 __attribute__((ext_vector_type(8)));
__device__ __forceinline__ v8i32 pg8_cat(const bf16x8 lo, const bf16x8 hi) { typedef int v4i32 __attribute__((ext_vector_type(4))); const v4i32 a = __builtin_bit_cast(v4i32, lo), b = __builtin_bit_cast(v4i32, hi); return __builtin_shufflevector(a, b, 0, 1, 2, 3, 4, 5, 6, 7); }
template <class Epi, class Sched, bool ALIGN_EPI = false, bool SP2 = false, bool F8 = false>
__device__ __forceinline__ void gemm_phase(PG8_LAS unsigned char* lds, const Gemm g, const Sched& S, const Epi& E) {
    const int tid = threadIdx.x, wid = __builtin_amdgcn_readfirstlane(tid >> 6), lane = tid & 63, wr = wid >> 2, wc = wid & 3, fr = lane & 15, fq = lane >> 4;
    const int K = g.K, KB = F8 ? K : 2 * K, nt = KB / 128;
    unsigned voffA[2], voffB[2];
#pragma unroll
    for (int i = 0; i < 2; ++i) { int R, C; stage_rc(tid * 16 + i * 8192, R, C); const int Rb = Epi::PERM ? ((R & ~31) + perm32(R & 31)) : R;
        voffA[i] = (unsigned)(R * KB + C * 2); voffB[i] = (unsigned)(Rb * KB + C * 2); }
    const size_t kstep = (size_t)(BK * 2);
    const size_t hstep = (size_t)HALF * KB;
    const size_t tstep = 2 * hstep;
    const unsigned ldsw = (unsigned)wid * 1024u;
    int aoffk[2], boffk[2];
#pragma unroll
    for (int h = 0; h < 2; ++h) { aoffk[h] = F8 ? lds_byte(wr * 64 + fr, (2 * (fq & 1) + h) * 8) + (fq >> 1) * 1024 : lds_byte(wr * 64 + fr, fq * 8) + h * 1024;
        boffk[h] = F8 ? lds_byte(wc * 32 + fr, (2 * (fq & 1) + h) * 8) + (fq >> 1) * 1024 : lds_byte(wc * 32 + fr, fq * 8) + h * 1024; }
#define PG8_SA(b, h) (((b) * 2 + (h)) * HTB)
#define PG8_SB(b, h) ((4 + (b) * 2 + (h)) * HTB)
#define PG8_STAGE(bufoff, gbase, voff) do { _Pragma("unroll") for (int _i = 0; _i < 2; ++_i) \
        __builtin_amdgcn_global_load_lds((const unsigned*)((const char*)(gbase) + (voff)[_i]), (PG8_LAS unsigned*)(lds + (bufoff) + ldsw + _i * 8192), 16, 0, 0); } while (0)
#define PG8_LDA(dst, b, h) do { if constexpr (F8) { _Pragma("unroll") for (int m = 0; m < 4; ++m) dst##8[m] = pg8_cat(*(const PG8_LAS bf16x8*)(lds + PG8_SA(b, h) + aoffk[0] + m * 2048), *(const PG8_LAS bf16x8*)(lds + PG8_SA(b, h) + aoffk[1] + m * 2048)); } \
        else { _Pragma("unroll") for (int m = 0; m < 4; ++m) _Pragma("unroll") for (int k = 0; k < 2; ++k) dst[m][k] = *(const PG8_LAS bf16x8*)(lds + PG8_SA(b, h) + aoffk[k] + m * 2048); } } while (0)
#define PG8_LDB(dst, b, h) do { if constexpr (F8) { _Pragma("unroll") for (int n = 0; n < 2; ++n) dst##8[n] = pg8_cat(*(const PG8_LAS bf16x8*)(lds + PG8_SB(b, h) + boffk[0] + n * 2048), *(const PG8_LAS bf16x8*)(lds + PG8_SB(b, h) + boffk[1] + n * 2048)); } \
        else { _Pragma("unroll") for (int n = 0; n < 2; ++n) _Pragma("unroll") for (int k = 0; k < 2; ++k) dst[n][k] = *(const PG8_LAS bf16x8*)(lds + PG8_SB(b, h) + boffk[k] + n * 2048); } } while (0)
#define PG8_MMA(ai, bj, At, Bt) do { __builtin_amdgcn_s_setprio(1); \
        if constexpr (F8) { _Pragma("unroll") for (int m = 0; m < 4; ++m) _Pragma("unroll") for (int n = 0; n < 2; ++n) \
            asm volatile("v_mfma_scale_f32_16x16x128_f8f6f4 %0, %1, %2, %0, %3, %4 op_sel_hi:[0,0,0]" : "+v"(acc[ai][bj][m][n]) : "v"(Bt##8[n]), "v"(At##8[m]), "v"(sc_w), "v"(sc_a)); } \
        else { _Pragma("unroll") for (int m = 0; m < 4; ++m) _Pragma("unroll") for (int n = 0; n < 2; ++n) _Pragma("unroll") for (int k = 0; k < 2; ++k) \
            acc[ai][bj][m][n] = __builtin_amdgcn_mfma_f32_16x16x32_bf16(Bt[n][k], At[m][k], acc[ai][bj][m][n], 0, 0, 0); } \
        __builtin_amdgcn_s_setprio(0); } while (0)
#define PG8_WAIT_V(n) asm volatile("s_waitcnt vmcnt(" #n ")" ::: "memory")
#define PG8_WAIT_L(n) asm volatile("s_waitcnt lgkmcnt(" #n ")" ::: "memory")
#define PG8_BAR __builtin_amdgcn_s_barrier()
#define PG8_SCHED __builtin_amdgcn_sched_barrier(0)
    Unit cur, nxt; int ui = 0;
    if (!S.next(0, cur)) return;
    f32x4 acc[2][2][4][2];
#pragma unroll
    for (int a = 0; a < 2; ++a)
#pragma unroll
        for (int b = 0; b < 2; ++b)
#pragma unroll
            for (int m = 0; m < 4; ++m)
#pragma unroll
                for (int n = 0; n < 2; ++n) acc[a][b][m][n] = (f32x4){0.f, 0.f, 0.f, 0.f};
    const int sc_w = 0x79797979, sc_a = 0x7f7f7f7f;
    bf16x8 At[4][2], B0[2][2], B1[2][2]; v8i32 At8[4], B08[2], B18[2];
    const char* cA = (const char*)g.A + (size_t)cur.pm * tstep; const char* cB = (const char*)g.Bt + (size_t)cur.pn * tstep;
    S.a_ready(cur);
    if constexpr (SP2) {
        PG8_STAGE(PG8_SB(0, 0), cB, voffB); PG8_STAGE(PG8_SB(0, 1), cB + hstep, voffB); PG8_STAGE(PG8_SA(0, 0), cA, voffA); PG8_STAGE(PG8_SA(0, 1), cA + hstep, voffA);
        if (wr == 1) PG8_BAR;
        PG8_WAIT_V(2); PG8_BAR;
        PG8_STAGE(PG8_SB(1, 0), cB + kstep, voffB); PG8_STAGE(PG8_SA(1, 0), cA + kstep, voffA); PG8_STAGE(PG8_SB(1, 1), cB + hstep + kstep, voffB);
        PG8_WAIT_V(6); PG8_BAR;
    } else {
        PG8_STAGE(PG8_SB(0, 0), cB, voffB); PG8_STAGE(PG8_SA(0, 0), cA, voffA); PG8_STAGE(PG8_SB(0, 1), cB + hstep, voffB); PG8_STAGE(PG8_SA(0, 1), cA + hstep, voffA);
        if (wr == 1) PG8_BAR;
        PG8_WAIT_V(4); PG8_BAR;
        PG8_STAGE(PG8_SB(1, 0), cB + kstep, voffB); PG8_STAGE(PG8_SA(1, 0), cA + kstep, voffA); PG8_STAGE(PG8_SB(1, 1), cB + hstep + kstep, voffB);
        PG8_WAIT_V(6); PG8_BAR;
    }
    for (;;) {
        const bool has_next = S.next(ui + 1, nxt);
        const char* nA = has_next ? (const char*)g.A + (size_t)nxt.pm * tstep : cA; const char* nB = has_next ? (const char*)g.Bt + (size_t)nxt.pn * tstep : cB;
        for (int t = 0; t < nt; t += 2) {
            const bool last = (t == nt - 2);
            const char* a1 = cA + (size_t)(t + 1) * kstep;
            const char* a2 = last ? nA : cA + (size_t)(t + 2) * kstep; const char* b2 = last ? nB : cB + (size_t)(t + 2) * kstep;
            const char* a3 = a2 + kstep; const char* b3 = b2 + kstep;
            if (last && has_next) S.a_ready(nxt);
            if constexpr (SP2) {
            PG8_LDB(B0, 0, 0); PG8_LDB(B1, 0, 1); PG8_SCHED; PG8_LDA(At, 0, 0); PG8_STAGE(PG8_SA(1, 1), a1 + hstep, voffA);
            PG8_WAIT_V(8); PG8_WAIT_L(0); PG8_BAR; PG8_MMA(0, 0, At, B0); PG8_MMA(0, 1, At, B1); PG8_BAR; PG8_SCHED;
            PG8_LDA(At, 0, 1); PG8_STAGE(PG8_SB(0, 0), b2, voffB); PG8_STAGE(PG8_SB(0, 1), b2 + hstep, voffB); PG8_STAGE(PG8_SA(0, 0), a2, voffA);
            PG8_WAIT_V(8); PG8_WAIT_L(0); PG8_BAR; PG8_MMA(1, 0, At, B0); PG8_MMA(1, 1, At, B1); PG8_BAR; PG8_SCHED;
            PG8_LDB(B0, 1, 0); PG8_LDB(B1, 1, 1); PG8_SCHED; PG8_LDA(At, 1, 0); PG8_STAGE(PG8_SA(0, 1), a2 + hstep, voffA);
            PG8_WAIT_V(8); PG8_WAIT_L(0); PG8_BAR; PG8_MMA(0, 0, At, B0); PG8_MMA(0, 1, At, B1); PG8_BAR; PG8_SCHED;
            PG8_LDA(At, 1, 1); PG8_STAGE(PG8_SB(1, 0), b3, voffB); PG8_STAGE(PG8_SB(1, 1), b3 + hstep, voffB); PG8_STAGE(PG8_SA(1, 0), a3, voffA);
            PG8_WAIT_V(8); PG8_WAIT_L(0); PG8_BAR; PG8_MMA(1, 0, At, B0); PG8_MMA(1, 1, At, B1); PG8_BAR; PG8_SCHED;
            } else {
            PG8_LDB(B0, 0, 0); PG8_SCHED; PG8_LDA(At, 0, 0); PG8_STAGE(PG8_SA(1, 1), a1 + hstep, voffA);
            PG8_WAIT_L(8); PG8_BAR; PG8_WAIT_L(0); PG8_MMA(0, 0, At, B0); PG8_BAR; PG8_SCHED;
            PG8_LDB(B1, 0, 1); PG8_STAGE(PG8_SB(0, 0), b2, voffB);
            PG8_BAR; PG8_WAIT_L(0); PG8_MMA(0, 1, At, B1); PG8_BAR;
            PG8_LDA(At, 0, 1); PG8_STAGE(PG8_SA(0, 0), a2, voffA);
            PG8_BAR; PG8_WAIT_L(0); PG8_MMA(1, 0, At, B0); PG8_BAR; PG8_SCHED;
            PG8_STAGE(PG8_SB(0, 1), b2 + hstep, voffB);
            PG8_WAIT_V(6); PG8_BAR; PG8_MMA(1, 1, At, B1); PG8_BAR;
            PG8_LDB(B0, 1, 0); PG8_SCHED; PG8_LDA(At, 1, 0); PG8_STAGE(PG8_SA(0, 1), a2 + hstep, voffA);
            PG8_WAIT_L(8); PG8_BAR; PG8_WAIT_L(0); PG8_MMA(0, 0, At, B0); PG8_BAR; PG8_SCHED;
            PG8_LDB(B1, 1, 1); PG8_STAGE(PG8_SB(1, 0), b3, voffB);
            PG8_BAR; PG8_WAIT_L(0); PG8_MMA(0, 1, At, B1); PG8_BAR;
            PG8_LDA(At, 1, 1); PG8_STAGE(PG8_SA(1, 0), a3, voffA);
            PG8_BAR; PG8_WAIT_L(0); PG8_MMA(1, 0, At, B0); PG8_BAR; PG8_SCHED;
            PG8_STAGE(PG8_SB(1, 1), b3 + hstep, voffB);
            PG8_WAIT_V(6); PG8_BAR; PG8_MMA(1, 1, At, B1); PG8_BAR;
            }
        }
        if constexpr (ALIGN_EPI) { if (wr == 0) PG8_BAR; }
        if constexpr (F8) asm volatile("s_nop 15\n\ts_nop 15" ::: "memory");
        if constexpr (!Epi::AFTER_DRAIN) { E(acc, cur, wr, wc, fr, fq); S.done(cur); }
        if (!has_next) break;
#pragma unroll
        for (int a = 0; a < 2; ++a)
#pragma unroll
            for (int b = 0; b < 2; ++b)
#pragma unroll
                for (int m = 0; m < 4; ++m)
#pragma unroll
                    for (int n = 0; n < 2; ++n) acc[a][b][m][n] = (f32x4){0.f, 0.f, 0.f, 0.f};
        cur = nxt; cA = nA; cB = nB; ++ui;
        if constexpr (ALIGN_EPI) { if (wr == 1) PG8_BAR; }
    }
    PG8_WAIT_V(0);
    if constexpr (!ALIGN_EPI) { if (wr == 0) PG8_BAR; }
    PG8_BAR;
    if constexpr (Epi::AFTER_DRAIN) { E.fused(acc, cur, wr, wc, fr, fq, lds, wid, lane); S.done(cur); }
#undef PG8_SA
#undef PG8_SB
#undef PG8_STAGE
#undef PG8_LDA
#undef PG8_LDB
#undef PG8_MMA
#undef PG8_WAIT_V
#undef PG8_WAIT_L
#undef PG8_BAR
#undef PG8_SCHED
}
}

constexpr int NWAVES = 8;
constexpr int TT = 16384, DM = 2048, SEQ = 2048;
constexpr int NPROJ = 11264;
constexpr int PC_Z = 0, PC_XBC = 2048, PC_Q = 5120, PC_K = 6144, PC_V = 7168, PC_O = 9216;
constexpr int WIN_LD = 11312;
constexpr int NSLOT = 65536 + 32 * 256;
constexpr float EPSF = 1e-5f;
#ifndef HSYNC_ON
#define HSYNC_ON 0
#endif
#define HWAIT() do { if (HSYNC_ON) asm volatile("s_waitcnt vmcnt(0) lgkmcnt(0)\n\ts_nop 15\n\ts_nop 15" ::: "memory"); } while (0)
#define HSYNC() do { if (HSYNC_ON) { HWAIT(); __syncthreads(); } } while (0)
#ifndef MK_PER_PHASE
#define MK_PER_PHASE 0
#endif
constexpr int N_PHASES = 11;

constexpr size_t MiB = 1u << 20;
constexpr size_t WS_CTL = 0, CTL_ZERO_BYTES = 1 * MiB;
constexpr size_t WS_WIN = 2 * MiB, WS_WSM = 46 * MiB, WS_WRT = 47 * MiB, WS_WOUT = 48 * MiB, WS_WGU = 64 * MiB, WS_WD = 576 * MiB;
constexpr size_t WS_XN1 = 832 * MiB, WS_PROJ = 896 * MiB, WS_SMALL = 1248 * MiB, WS_SSQ = 1252 * MiB, WS_YMIX = 1256 * MiB, WS_H2 = 1384 * MiB, WS_XN2 = 1512 * MiB;
constexpr size_t WS_ROUTE = 1576 * MiB, WS_XG = 1578 * MiB, WS_ACT = 1866 * MiB, WS_YR = 2154 * MiB, WS_XC = 2442 * MiB, WS_END = 2538 * MiB;
constexpr int CW_BAR = 4096;
constexpr int CW_CNT = 65536;

constexpr int RING_BYTES = 131072;
constexpr int LDS_BYTES = 147456;
constexpr int LDSCTL_OFF = LDS_BYTES - 576, MISC_OFF = LDSCTL_OFF;
constexpr int TAB_OFF = LDSCTL_OFF + 64;

#define GAS __attribute__((address_space(1)))
#define LAS __attribute__((address_space(3)))
typedef unsigned short bf16;
typedef unsigned v4u __attribute__((ext_vector_type(4)));
typedef unsigned v2u __attribute__((ext_vector_type(2)));
typedef float f32x4 __attribute__((ext_vector_type(4)));
typedef float f32x2 __attribute__((ext_vector_type(2)));
typedef short bf16x8 __attribute__((ext_vector_type(8)));
typedef GAS unsigned gu32;
#define RLX_AGENT __ATOMIC_RELAXED, __HIP_MEMORY_SCOPE_AGENT
#define LDS_WAIT() asm volatile("s_waitcnt lgkmcnt(0)" ::: "memory")
#define VM_WAIT() asm volatile("s_waitcnt vmcnt(0)" ::: "memory")
__device__ __forceinline__ unsigned f2bf(float f) { unsigned u = __builtin_bit_cast(unsigned, f); return (u + 0x7fffu + ((u >> 16) & 1u)) >> 16; }
__device__ __forceinline__ unsigned pk2(float lo, float hi) { return f2bf(lo) | (f2bf(hi) << 16); }
__device__ __forceinline__ float bflo(unsigned w) { return __builtin_bit_cast(float, w << 16); }
__device__ __forceinline__ float bfhi(unsigned w) { return __builtin_bit_cast(float, w & 0xffff0000u); }
__device__ __forceinline__ float wave_sum(float v) {
#pragma unroll
    for (int o = 1; o < 64; o <<= 1) v += __shfl_xor(v, o);
    return v;
}
__device__ __forceinline__ float softplusf(float x) { return x > 20.f ? x : log1pf(expf(x)); }
__device__ __forceinline__ float logsigf(float x) { return fminf(x, 0.f) - log1pf(expf(-fabsf(x))); }
__device__ __forceinline__ float siluf(float v) { return v / (1.0f + __expf(-v)); }

#define XB_TMO      128
#define XB_XCNT(j)  (256  + 64 * (j))
#define XB_XSUB(j)  (1280 + 64 * (j))
#define XB_XGEN(j)  (2304 + 64 * (j))
#define XB_TOP      3328
#define XB_TOPGEN   3392
#define XCD_BAR_WORDS 3456
#define XB_SPIN_CAP (1u << 18)

__device__ __forceinline__ unsigned xb_ld(unsigned* p)              { return __hip_atomic_load(p, __ATOMIC_RELAXED, __HIP_MEMORY_SCOPE_AGENT); }
__device__ __forceinline__ unsigned xb_add(unsigned* p, unsigned v) { return __hip_atomic_fetch_add(p, v, __ATOMIC_RELAXED, __HIP_MEMORY_SCOPE_AGENT); }
__device__ __forceinline__ unsigned xb_xcc_id() { return (unsigned)__builtin_amdgcn_s_getreg((3 << 11) | 20) & 0xFu; }
#define XB_SPIN(cond, bar) do { unsigned _sp = 0; while (cond) { __builtin_amdgcn_s_sleep(1); \
    if ((++_sp & 255u) == 0u) { if (xb_ld(&(bar)[XB_TMO])) break; if (_sp > XB_SPIN_CAP) { atomicAdd(&(bar)[XB_TMO], 1u); break; } } } } while (0)

struct XcdBarrier {
    unsigned* bar; unsigned x;
    volatile LAS unsigned* st;
};

__device__ __forceinline__ XcdBarrier xcd_barrier_post(unsigned* bar, volatile LAS unsigned* st) {
    XcdBarrier b; b.bar = bar; b.x = xb_xcc_id(); b.st = st;
    if (threadIdx.x == 0) (void)xb_add(&bar[XB_XCNT(b.x)], 1u);
    return b;
}
__device__ __forceinline__ void xcd_barrier_complete(unsigned* bar, unsigned x, unsigned& nloc, unsigned& nx) {
    const unsigned G = gridDim.x * gridDim.y * gridDim.z;
    unsigned sum, cnt, mine, sp = 0u;
    for (;;) {
        sum = 0u; cnt = 0u; mine = 0u;
#pragma unroll
        for (unsigned j = 0; j < 16; ++j) { const unsigned c = xb_ld(&bar[XB_XCNT(j)]); sum += c; cnt += (c > 0u) ? 1u : 0u; mine = (j == x) ? c : mine; }
        if (sum == G) break;
        __builtin_amdgcn_s_sleep(1);
        if ((++sp & 255u) == 0u) { if (xb_ld(&bar[XB_TMO])) break; if (sp > XB_SPIN_CAP) { atomicAdd(&bar[XB_TMO], 1u); break; } }
    }
    nloc = mine > 0u ? mine : 1u; nx = cnt > 0u ? cnt : 1u;
}

__device__ __forceinline__ void xcd_barrier(const XcdBarrier& b) {
    asm volatile("s_waitcnt vmcnt(0)" ::: "memory");
    __syncthreads();
    if (threadIdx.x == 0) {
        unsigned* bar = b.bar;
        __builtin_amdgcn_s_waitcnt(0);
        unsigned nloc = b.st[0], nx = b.st[1];
        if (nloc == 0u) { xcd_barrier_complete(bar, b.x, nloc, nx); b.st[0] = nloc; b.st[1] = nx; }
        const unsigned old = xb_add(&bar[XB_XSUB(b.x)], 1u);
        const unsigned gen = old / nloc;
        if (old + 1u == (gen + 1u) * nloc) {
            __builtin_amdgcn_fence(__ATOMIC_RELEASE, "agent");
            asm volatile("s_waitcnt vmcnt(0)" ::: "memory");
            const unsigned og = xb_add(&bar[XB_TOP], 1u);
            const unsigned tg = og / nx;
            if (og + 1u == (tg + 1u) * nx) xb_add(&bar[XB_TOPGEN], 1u);
            else XB_SPIN(xb_ld(&bar[XB_TOPGEN]) == tg, bar);
            __builtin_amdgcn_fence(__ATOMIC_ACQUIRE, "agent");
            xb_add(&bar[XB_XGEN(b.x)], 1u);
            asm volatile("s_waitcnt vmcnt(0)" ::: "memory");
        } else {
            XB_SPIN(xb_ld(&bar[XB_XGEN(b.x)]) == gen, bar);
            __builtin_amdgcn_fence(__ATOMIC_ACQUIRE, "agent");
            asm volatile("s_waitcnt vmcnt(0)" ::: "memory");
        }
    }
    __syncthreads();
}

struct Frame {
    LAS unsigned char* lds;
    volatile LAS unsigned* MISC;
    gu32* ctl;
    int tid, lane, wave, G, bid;
    const float *x, *norm1_w, *w_in, *conv_w, *conv_b, *dt_bias, *a_log, *d_skip, *ssd_norm_w, *i_bias, *f_bias, *ml_norm_w, *w_out, *norm2_w, *router_w, *router_b, *w_gate_up, *b_gate_up, *w_down, *b_down, *final_norm_w;
    float* out; unsigned char* ws;
};

__device__ __forceinline__ void p0_transpose_item(const float* W, int ldw, int K, bf16* WT, int dst_row0, int src_col0, int k0, LAS float* scr, int lane) {
#pragma unroll 8
    for (int i = 0; i < 32; ++i) { const int kk = 2 * i + (lane >> 5); scr[kk * 33 + (lane & 31)] = W[(size_t)(k0 + kk) * ldw + src_col0 + (lane & 31)]; }
    LDS_WAIT(); asm volatile("" ::: "memory");
    const int c = lane & 7;
#pragma unroll
    for (int j = 0; j < 4; ++j) { const int n = (lane >> 3) + 8 * j; const LAS float* s = scr + (8 * c) * 33 + n;
        v4u o; o.x = pk2(s[0 * 33], s[1 * 33]); o.y = pk2(s[2 * 33], s[3 * 33]); o.z = pk2(s[4 * 33], s[5 * 33]); o.w = pk2(s[6 * 33], s[7 * 33]);
        *(v4u*)(WT + (size_t)(dst_row0 + n) * K + k0 + 8 * c) = o; }
    LDS_WAIT(); asm volatile("" ::: "memory");
}
__device__ __forceinline__ void p0_transpose_item_f8(const float* W, int ldw, int K, unsigned char* WT, int dst_row0, int src_col0, int k0, LAS float* scr, int lane) {
#pragma unroll 8
    for (int i = 0; i < 32; ++i) { const int kk = 2 * i + (lane >> 5); scr[kk * 33 + (lane & 31)] = W[(size_t)(k0 + kk) * ldw + src_col0 + (lane & 31)] * 64.0f; }
    LDS_WAIT(); asm volatile("" ::: "memory");
    const int c = lane & 3;
#pragma unroll
    for (int j = 0; j < 2; ++j) { const int n = (lane >> 2) + 16 * j; const LAS float* s = scr + (16 * c) * 33 + n; int o[4];
#pragma unroll
        for (int q = 0; q < 4; ++q) { int w = __builtin_amdgcn_cvt_pk_fp8_f32(s[(4 * q) * 33], s[(4 * q + 1) * 33], 0, false); o[q] = __builtin_amdgcn_cvt_pk_fp8_f32(s[(4 * q + 2) * 33], s[(4 * q + 3) * 33], w, true); }
        *(v4u*)(WT + (size_t)(dst_row0 + n) * K + k0 + 16 * c) = (v4u){(unsigned)o[0], (unsigned)o[1], (unsigned)o[2], (unsigned)o[3]}; }
    LDS_WAIT(); asm volatile("" ::: "memory");
}
__device__ __forceinline__ void rms_row_to_bf16(const float* xrow, const float* w, bf16* orow, int lane) {
    const f32x4* xr = (const f32x4*)xrow + lane; const f32x4* wr = (const f32x4*)w + lane;
    f32x4 v[8]; float s = 0.f;
#pragma unroll
    for (int j = 0; j < 8; ++j) { v[j] = xr[64 * j]; s += (v[j].x * v[j].x + v[j].y * v[j].y) + (v[j].z * v[j].z + v[j].w * v[j].w); }
    const float rstd = 1.0f / sqrtf(wave_sum(s) * (1.0f / 2048.0f) + EPSF);
    v2u* o8 = (v2u*)orow + lane;
#pragma unroll
    for (int j = 0; j < 8; ++j) { const f32x4 ww = wr[64 * j]; v2u o; o.x = pk2(v[j].x * rstd * ww.x, v[j].y * rstd * ww.y); o.y = pk2(v[j].z * rstd * ww.z, v[j].w * rstd * ww.w); o8[64 * j] = o; }
}
__device__ __forceinline__ void phase0(Frame& F) {
    LAS float* scr = (LAS float*)(F.lds + F.wave * 16384);
    const int gw = F.bid * NWAVES + F.wave, NGW = F.G * NWAVES;
    bf16* WinT = (bf16*)(F.ws + WS_WIN); bf16* WsT = (bf16*)(F.ws + WS_WSM); float* Wrt = (float*)(F.ws + WS_WRT); bf16* WoutT = (bf16*)(F.ws + WS_WOUT);
    bf16* WguT = (bf16*)(F.ws + WS_WGU); bf16* WdT = (bf16*)(F.ws + WS_WD); bf16* XN1 = (bf16*)(F.ws + WS_XN1);
    constexpr int I_IN = 32 * 352, I_OUT = 64 * 64, I_GU = 32 * 4096, I_D = 32 * 2048, NITEMS = I_IN + I_OUT + I_GU + I_D;
    for (int it = gw; it < NITEMS; it += NGW) {
        int r = it;
        if (r < I_IN) { const int kb = r / 352, nb = r % 352, n0 = nb * 32; p0_transpose_item(F.w_in, WIN_LD, 2048, WinT, n0, n0 + (n0 >= 5120 ? 32 : 0), kb * 64, scr, F.lane); continue; } r -= I_IN;
        if (r < I_OUT) { const int kb = r >> 6, nb = r & 63; p0_transpose_item(F.w_out, 2048, 4096, WoutT, nb * 32, nb * 32, kb * 64, scr, F.lane); continue; } r -= I_OUT;
        if (r < I_GU) { const int e = r >> 12, rr = r & 4095, kb = rr >> 7, nb = rr & 127; p0_transpose_item_f8(F.w_gate_up + (size_t)e * 2048 * 4096, 4096, 2048, (unsigned char*)WguT + (size_t)e * 4096 * 2048, nb * 32, nb * 32, kb * 64, scr, F.lane); continue; } r -= I_GU;
        { const int e = r >> 11, rr = r & 2047, kb = rr >> 6, nb = rr & 63; p0_transpose_item_f8(F.w_down + (size_t)e * 2048 * 2048, 2048, 2048, (unsigned char*)WdT + (size_t)e * 2048 * 2048, nb * 32, nb * 32, kb * 64, scr, F.lane); }
    }
    for (int i = gw * 64 + F.lane; i < 64 * 2048; i += NGW * 64) { const int j = i >> 11, k = i & 2047;
        const int col = j < 32 ? 5120 + j : (j < 40 ? 11296 + (j - 32) : 11304 + (j - 40));
        WsT[i] = (bf16)(j < 48 ? f2bf(F.w_in[(size_t)k * WIN_LD + col]) : 0u); }
    for (int i = gw * 64 + F.lane; i < 2048 * 32; i += NGW * 64) Wrt[i] = F.norm2_w[i >> 5] * F.router_w[i];
    for (int m = gw; m < TT; m += NGW) rms_row_to_bf16(F.x + (size_t)m * DM, F.norm1_w, XN1 + (size_t)m * DM, F.lane);
}

__device__ __forceinline__ void p1_small(Frame& F) {
    const bf16* XN1 = (const bf16*)(F.ws + WS_XN1); const bf16* WsT = (const bf16*)(F.ws + WS_WSM); float* SMALL = (float*)(F.ws + WS_SMALL);
    const int gw = F.bid * NWAVES + F.wave, NGW = F.G * NWAVES, fr = F.lane & 15, fq = F.lane >> 4;
    for (int task = gw; task < TT / 16; task += NGW) {
        const int t0 = task * 16;
        f32x4 acc[4];
#pragma unroll
        for (int n = 0; n < 4; ++n) acc[n] = (f32x4){0.f, 0.f, 0.f, 0.f};
        const bf16* arow = XN1 + (size_t)(t0 + fr) * DM + 8 * fq; const bf16* brow = WsT + (size_t)fr * DM + 8 * fq;
#pragma unroll 4
        for (int ks = 0; ks < 64; ++ks) {
            const bf16x8 a = *(const bf16x8*)(arow + 32 * ks);
#pragma unroll
            for (int n = 0; n < 4; ++n) { const bf16x8 b = *(const bf16x8*)(brow + (size_t)n * 16 * DM + 32 * ks); acc[n] = __builtin_amdgcn_mfma_f32_16x16x32_bf16(a, b, acc[n], 0, 0, 0); }
        }
#pragma unroll
        for (int n = 0; n < 4; ++n)
#pragma unroll
            for (int r = 0; r < 4; ++r) SMALL[(size_t)(t0 + 4 * fq + r) * 64 + n * 16 + fr] = acc[n][r];
    }
}

__device__ __forceinline__ void unpack8(const v4u r, float (&f)[8]) { f[0] = bflo(r.x); f[1] = bfhi(r.x); f[2] = bflo(r.y); f[3] = bfhi(r.y); f[4] = bflo(r.z); f[5] = bfhi(r.z); f[6] = bflo(r.w); f[7] = bfhi(r.w); }

__device__ __forceinline__ void phase_conv(Frame& F) {
    const bf16* PROJ = (const bf16*)(F.ws + WS_PROJ); bf16* XC = (bf16*)(F.ws + WS_XC);
    constexpr int TB = 32, NCG = 384, NIT = (TT / TB) * NCG;
    for (int it = F.bid * (NWAVES * 64) + F.tid; it < NIT; it += F.G * NWAVES * 64) {
        const int cg = it % NCG, tb = it / NCG, ch = cg * 8, t0 = tb * TB; const bool seq0 = (t0 % SEQ) == 0;
        float w[4][8], bs[8];
#pragma unroll
        for (int j = 0; j < 4; ++j) { const f32x4 a = *(const f32x4*)(F.conv_w + j * 3072 + ch), b = *(const f32x4*)(F.conv_w + j * 3072 + ch + 4);
            w[j][0] = a.x; w[j][1] = a.y; w[j][2] = a.z; w[j][3] = a.w; w[j][4] = b.x; w[j][5] = b.y; w[j][6] = b.z; w[j][7] = b.w; }
        { const f32x4 a = *(const f32x4*)(F.conv_b + ch), b = *(const f32x4*)(F.conv_b + ch + 4); bs[0] = a.x; bs[1] = a.y; bs[2] = a.z; bs[3] = a.w; bs[4] = b.x; bs[5] = b.y; bs[6] = b.z; bs[7] = b.w; }
        const bf16* src = PROJ + (size_t)t0 * NPROJ + PC_XBC + ch;
        float r0[8], r1[8], r2[8], r3[8];
        if (seq0) {
#pragma unroll
            for (int i = 0; i < 8; ++i) { r0[i] = 0.f; r1[i] = 0.f; r2[i] = 0.f; }
        } else { unpack8(*(const v4u*)(src - 3 * (size_t)NPROJ), r0); unpack8(*(const v4u*)(src - 2 * (size_t)NPROJ), r1); unpack8(*(const v4u*)(src - (size_t)NPROJ), r2); }
#pragma unroll 4
        for (int l = 0; l < TB; ++l) {
            unpack8(*(const v4u*)(src + (size_t)l * NPROJ), r3);
            float o[8];
#pragma unroll
            for (int i = 0; i < 8; ++i) { const float v = bs[i] + w[0][i] * r0[i] + w[1][i] * r1[i] + w[2][i] * r2[i] + w[3][i] * r3[i]; o[i] = siluf(v); r0[i] = r1[i]; r1[i] = r2[i]; r2[i] = r3[i]; }
            v4u ov; ov.x = pk2(o[0], o[1]); ov.y = pk2(o[2], o[3]); ov.z = pk2(o[4], o[5]); ov.w = pk2(o[6], o[7]);
            *(v4u*)(XC + (size_t)(t0 + l) * 3072 + ch) = ov;
        }
    }
}

constexpr int MX_PITCH = 272;
static_assert(true, "");
constexpr int MX_QM = 0, MX_KM = 34816, MX_KW = 69632, MX_VT = 104448, MX_SI = 121856, MX_VEC = 139264, MX_VECB = 3072, MX_NVEC = MX_VEC + 2 * MX_VECB, MX_SCAL = MX_NVEC + 512, MX_END = MX_SCAL + 64;
__device__ __forceinline__ unsigned cvt_pk_bf16_nop(float lo, float hi) { unsigned r; asm volatile("v_cvt_pk_bf16_f32 %0, %1, %2\n\ts_nop 1" : "=v"(r) : "v"(lo), "v"(hi)); return r; }
__device__ __forceinline__ bf16x8 lds_frag(const LAS unsigned char* img, int row, int kbyte) { return *(const LAS bf16x8*)(img + row * MX_PITCH + kbyte); }
static_assert(MX_END <= LDSCTL_OFF, "mixer LDS map");
template <bool ML> __device__ __forceinline__ void mixer_unit(Frame& F, int unit) {
    const bf16* PROJ = (const bf16*)(F.ws + WS_PROJ); const bf16* XC = (const bf16*)(F.ws + WS_XC); const float* SMALL = (const float*)(F.ws + WS_SMALL);
    bf16* YMIX = (bf16*)(F.ws + WS_YMIX); float* SSQ = (float*)(F.ws + WS_SSQ);
    const int w = F.wave, fr = F.lane & 15, fq = F.lane >> 4, tid = F.tid;
    const int b = unit >> 5, tok0 = b * SEQ, hd = unit & 31, grp = hd >> 3, mh = (unit & 31) >> 2, vq = unit & 3;
    const float qs = 0.08838834764831845f;
    LAS unsigned char* QM = F.lds + MX_QM; LAS unsigned char* KM = F.lds + MX_KM; LAS unsigned char* KW = F.lds + MX_KW; LAS unsigned char* VT = F.lds + MX_VT; LAS unsigned char* SI = F.lds + MX_SI;
    LAS float* exch = (LAS float*)(F.lds + MX_VEC + (w >> 2) * MX_VECB + 1024) + (w & 3) * 32;
    LAS float* nvec = (LAS float*)(F.lds + MX_NVEC); LAS float* scal = (LAS float*)(F.lds + MX_SCAL);
    const bf16* qsrc; const bf16* ksrc; const bf16* vsrc; int ld;
    if (ML) { qsrc = PROJ + PC_Q + mh * 128; ksrc = PROJ + PC_K + mh * 128; vsrc = PROJ + PC_V + mh * 256 + vq * 64; ld = NPROJ; }
    else { qsrc = XC + 2560 + grp * 128; ksrc = XC + 2048 + grp * 128; vsrc = XC + hd * 64; ld = 3072; }
    const float c_a = ML ? 0.f : -expf(F.a_log[hd]), c_dtb = ML ? 0.f : F.dt_bias[hd], c_D = ML ? 0.f : F.d_skip[hd], c_ib = ML ? F.i_bias[mh] : 0.f, c_fb = ML ? F.f_bias[mh] : 0.f;
    float mprev = 0.f;
    f32x4 sacc[4]; float nreg = 0.f;
#pragma unroll
    for (int j = 0; j < 4; ++j) sacc[j] = (f32x4){0.f, 0.f, 0.f, 0.f};
    v4u pq[4], pk[4], pv[2];
    float vA0 = 0.f, vA1 = 0.f, vB0 = 0.f, vB1 = 0.f, vC0 = 0.f, vC1 = 0.f, vD0 = 0.f, vD1 = 0.f, vE0 = 0.f, vE1 = 0.f, vG0 = 0.f, vG1 = 0.f, vSA = 0.f, vSG = 0.f;
#define MX_SCAN_A(c) do { if (w == 0) { \
        const int l0 = 2 * F.lane; const size_t tt = (size_t)(tok0 + 128 * (c) + l0); \
        if (!ML) { const float d0 = softplusf(SMALL[tt * 64 + hd] + c_dtb), d1 = softplusf(SMALL[(tt + 1) * 64 + hd] + c_dtb); \
            const float x0 = d0 * c_a, x1 = d1 * c_a; float incl = x0 + x1; \
            _Pragma("unroll") for (int d = 1; d < 64; d <<= 1) { const float t_ = __shfl_up(incl, d); if (F.lane >= d) incl += t_; } \
            const float cum1 = incl, cum0 = incl - x1, tot = __shfl(incl, 63); \
            vA0 = -cum0; vA1 = -cum1; vB0 = -cum0; vB1 = -cum1; vC0 = d0; vC1 = d1; vD0 = expf(cum0); vD1 = expf(cum1); vE0 = d0 * expf(tot - cum0); vE1 = d1 * expf(tot - cum1); vSA = expf(tot); vSG = 1.0f; \
        } else { const float li0 = SMALL[tt * 64 + 32 + mh] + c_ib, li1 = SMALL[(tt + 1) * 64 + 32 + mh] + c_ib; \
            const float x0 = logsigf(SMALL[tt * 64 + 40 + mh] + c_fb), x1 = logsigf(SMALL[(tt + 1) * 64 + 40 + mh] + c_fb); float incl = x0 + x1; \
            _Pragma("unroll") for (int d = 1; d < 64; d <<= 1) { const float t_ = __shfl_up(incl, d); if (F.lane >= d) incl += t_; } \
            const float cum1 = incl, cum0 = incl - x1, btot = __shfl(incl, 63); \
            const float dd0 = li0 - cum0, dd1 = li1 - cum1; float im = fmaxf(dd0, dd1); \
            _Pragma("unroll") for (int d = 1; d < 64; d <<= 1) { const float t_ = __shfl_up(im, d); if (F.lane >= d) im = fmaxf(im, t_); } \
            float pm = __shfl_up(im, 1); if (F.lane == 0) pm = -3.0e38f; const float pmax0 = fmaxf(pm, dd0), pmax1 = im, pm127 = __shfl(im, 63); \
            const float M0 = fmaxf(mprev, pmax0), M1 = fmaxf(mprev, pmax1); \
            vA0 = dd0; vA1 = dd1; vB0 = M0; vB1 = M1; vD0 = qs * expf(mprev - M0); vD1 = qs * expf(mprev - M1); vE0 = expf(dd0 - pm127); vE1 = expf(dd1 - pm127); vG0 = expf(-(cum0 + M0)); vG1 = expf(-(cum1 + M1)); \
            const float mloc = btot + pm127, mnew = fmaxf(btot + mprev, mloc); \
            vSA = expf(btot + mprev - mnew); vSG = expf(mloc - mnew); mprev = mnew; } } } while (0)
#define MX_SCAN_B(c) do { if (w == 0) { \
        LAS float* vb = (LAS float*)(F.lds + MX_VEC + ((c) & 1) * MX_VECB); const int l0 = 2 * F.lane; \
        *(LAS f32x2*)(vb + l0) = (f32x2){vA0, vA1}; *(LAS f32x2*)(vb + 128 + l0) = (f32x2){vB0, vB1}; if (!ML) *(LAS f32x2*)(vb + 256 + l0) = (f32x2){vC0, vC1}; \
        *(LAS f32x2*)(vb + 384 + l0) = (f32x2){vD0, vD1}; *(LAS f32x2*)(vb + 512 + l0) = (f32x2){vE0, vE1}; if (ML) *(LAS f32x2*)(vb + 640 + l0) = (f32x2){vG0, vG1}; \
        if (F.lane == 0) { scal[2 * ((c) & 1)] = vSA; scal[2 * ((c) & 1) + 1] = vSG; } } } while (0)
#define MX_SCAN(c) do { MX_SCAN_A(c); MX_SCAN_B(c); } while (0)
#define MX_PREFETCH(c) do { const size_t tb_ = (size_t)(tok0 + 128 * (c)); \
        _Pragma("unroll") for (int i = 0; i < 2; ++i) { const int pid = tid + 512 * i, a2 = pid >> 4, k8 = pid & 15; \
            pq[2 * i] = *(const v4u*)(qsrc + (tb_ + 2 * a2) * ld + 8 * k8); pq[2 * i + 1] = *(const v4u*)(qsrc + (tb_ + 2 * a2 + 1) * ld + 8 * k8); \
            pk[2 * i] = *(const v4u*)(ksrc + (tb_ + 2 * a2) * ld + 8 * k8); pk[2 * i + 1] = *(const v4u*)(ksrc + (tb_ + 2 * a2 + 1) * ld + 8 * k8); } \
        { const int a2 = tid >> 3, v8 = tid & 7; pv[0] = *(const v4u*)(vsrc + (tb_ + 2 * a2) * ld + 8 * v8); pv[1] = *(const v4u*)(vsrc + (tb_ + 2 * a2 + 1) * ld + 8 * v8); } } while (0)
#define MX_WRITE(c) do { const LAS float* vb = (const LAS float*)(F.lds + MX_VEC + ((c) & 1) * MX_VECB); \
        _Pragma("unroll") for (int i = 0; i < 2; ++i) { const int pid = tid + 512 * i, a2 = pid >> 4, k8 = pid & 15, l = 2 * a2; \
            *(LAS v4u*)(QM + l * MX_PITCH + 16 * k8) = pq[2 * i]; *(LAS v4u*)(QM + (l + 1) * MX_PITCH + 16 * k8) = pq[2 * i + 1]; \
            *(LAS v4u*)(KM + l * MX_PITCH + 16 * k8) = pk[2 * i]; *(LAS v4u*)(KM + (l + 1) * MX_PITCH + 16 * k8) = pk[2 * i + 1]; \
            float f0[8], f1[8]; unpack8(pk[2 * i], f0); unpack8(pk[2 * i + 1], f1); const f32x2 wl = *(const LAS f32x2*)(vb + 512 + l); \
            _Pragma("unroll") for (int e = 0; e < 8; ++e) *(LAS unsigned*)(KW + (8 * k8 + e) * MX_PITCH + 2 * l) = pk2(f0[e] * wl.x, f1[e] * wl.y); } \
        { const int a2 = tid >> 3, v8 = tid & 7, l = 2 * a2; const v4u r0 = pv[0], r1 = pv[1]; LAS unsigned char* vp_ = VT + (8 * v8) * MX_PITCH + 2 * l; \
            *(LAS unsigned*)(vp_ + 0 * MX_PITCH) = (r0.x & 0xffffu) | (r1.x << 16); *(LAS unsigned*)(vp_ + 1 * MX_PITCH) = (r0.x >> 16) | (r1.x & 0xffff0000u); \
            *(LAS unsigned*)(vp_ + 2 * MX_PITCH) = (r0.y & 0xffffu) | (r1.y << 16); *(LAS unsigned*)(vp_ + 3 * MX_PITCH) = (r0.y >> 16) | (r1.y & 0xffff0000u); \
            *(LAS unsigned*)(vp_ + 4 * MX_PITCH) = (r0.z & 0xffffu) | (r1.z << 16); *(LAS unsigned*)(vp_ + 5 * MX_PITCH) = (r0.z >> 16) | (r1.z & 0xffff0000u); \
            *(LAS unsigned*)(vp_ + 6 * MX_PITCH) = (r0.w & 0xffffu) | (r1.w << 16); *(LAS unsigned*)(vp_ + 7 * MX_PITCH) = (r0.w >> 16) | (r1.w & 0xffff0000u); } \
        _Pragma("unroll") for (int j = 0; j < 4; ++j) { v2u sv; sv.x = pk2(sacc[j][0], sacc[j][1]); sv.y = pk2(sacc[j][2], sacc[j][3]); *(LAS v2u*)(SI + (16 * j + fr) * MX_PITCH + (16 * w + 4 * fq) * 2) = sv; } \
        if (ML && fq == 0) nvec[16 * w + fr] = nreg; } while (0)
    MX_SCAN(0);
    MX_PREFETCH(0);
    __syncthreads();
    MX_WRITE(0);
    __syncthreads();
    for (int c = 0; c < SEQ / 128; ++c) {
        const LAS float* vb = (const LAS float*)(F.lds + MX_VEC + (c & 1) * MX_VECB);
        const bool more = (c + 1 < SEQ / 128);
        if (more) { MX_PREFETCH(c + 1); }
        const size_t trow0 = (size_t)(tok0 + 128 * c + 16 * w + 4 * fq);
        unsigned short zr[4][4];
        if (!ML) {
#pragma unroll
            for (int r = 0; r < 4; ++r)
#pragma unroll
                for (int j = 0; j < 4; ++j) zr[r][j] = PROJ[(trow0 + r) * NPROJ + PC_Z + hd * 64 + 16 * j + fr];
        }
        bf16x8 qf[4];
#pragma unroll
        for (int ks = 0; ks < 4; ++ks) qf[ks] = lds_frag(QM, 16 * w + fr, 64 * ks + 16 * fq);
        const float mlv = vb[128 + 16 * w + fr];
        float dsum = 0.f;
        f32x4 y1[4], y2[4];
#pragma unroll
        for (int j = 0; j < 4; ++j) { y1[j] = (f32x4){0.f, 0.f, 0.f, 0.f}; y2[j] = (f32x4){0.f, 0.f, 0.f, 0.f}; }
#pragma unroll 1
        for (int k2 = 0; 2 * k2 <= w; ++k2) {
            unsigned pw[4];
#pragma unroll
            for (int h = 0; h < 2; ++h) {
                const int si = 2 * k2 + h;
                f32x4 acc = (f32x4){0.f, 0.f, 0.f, 0.f};
#pragma unroll
                for (int ks = 0; ks < 4; ++ks) acc = __builtin_amdgcn_mfma_f32_16x16x32_bf16(lds_frag(KM, 16 * si + fr, 64 * ks + 16 * fq), qf[ks], acc, 0, 0, 0);
                const f32x4 e4 = *(const LAS f32x4*)(vb + 16 * si + 4 * fq); f32x4 x4 = (f32x4){qs, qs, qs, qs}; if (!ML) x4 = *(const LAS f32x4*)(vb + 256 + 16 * si + 4 * fq);
                float p[4];
#pragma unroll
                for (int r = 0; r < 4; ++r) { const float v = acc[r] * __expf(e4[r] - mlv) * x4[r]; const bool ok = (si < w) || (si == w && 4 * fq + r <= fr); p[r] = ok ? v : 0.f; }
                if (ML) dsum += (p[0] + p[1]) + (p[2] + p[3]);
                pw[2 * h] = cvt_pk_bf16_nop(p[0], p[1]); pw[2 * h + 1] = cvt_pk_bf16_nop(p[2], p[3]);
            }
            HWAIT();
            const v4u pwv = (v4u){pw[0], pw[1], pw[2], pw[3]}; const bf16x8 pf = __builtin_bit_cast(bf16x8, pwv);
#pragma unroll
            for (int j = 0; j < 4; ++j) { const LAS unsigned char* vp = VT + (16 * j + fr) * MX_PITCH + (32 * k2 + 4 * fq) * 2;
                const v2u lo = *(const LAS v2u*)vp, hi = *(const LAS v2u*)(vp + 32); const v4u vw = (v4u){lo.x, lo.y, hi.x, hi.y};
                y1[j] = __builtin_amdgcn_mfma_f32_16x16x32_bf16(pf, __builtin_bit_cast(bf16x8, vw), y1[j], 0, 0, 0); }
            HWAIT();
        }
        HSYNC();
        __builtin_amdgcn_sched_barrier(0);
#pragma unroll
        for (int ks = 0; ks < 4; ++ks)
#pragma unroll
            for (int j = 0; j < 4; ++j) y2[j] = __builtin_amdgcn_mfma_f32_16x16x32_bf16(qf[ks], lds_frag(SI, 16 * j + fr, 64 * ks + 16 * fq), y2[j], 0, 0, 0);
        HSYNC();
        __builtin_amdgcn_sched_barrier(0);
        if (ML) {
            dsum += __shfl_xor(dsum, 16); dsum += __shfl_xor(dsum, 32);
            float d2 = 0.f;
#pragma unroll
            for (int ks = 0; ks < 4; ++ks) { float qv[8]; unpack8(__builtin_bit_cast(v4u, qf[ks]), qv); const f32x4 n0 = *(const LAS f32x4*)(nvec + 32 * ks + 8 * fq), n1 = *(const LAS f32x4*)(nvec + 32 * ks + 8 * fq + 4);
                d2 += qv[0] * n0.x + qv[1] * n0.y + qv[2] * n0.z + qv[3] * n0.w + qv[4] * n1.x + qv[5] * n1.y + qv[6] * n1.z + qv[7] * n1.w; }
            d2 += __shfl_xor(d2, 16); d2 += __shfl_xor(d2, 32);
            if (fq == 0) { exch[fr] = dsum; exch[16 + fr] = d2; }
        }
        HSYNC();
        __builtin_amdgcn_sched_barrier(0);
        f32x4 tmp[4];
#pragma unroll
        for (int j = 0; j < 4; ++j) tmp[j] = (f32x4){0.f, 0.f, 0.f, 0.f};
        float nsum = 0.f;
#pragma unroll
        for (int ks = 0; ks < 4; ++ks) { const bf16x8 kf = lds_frag(KW, 16 * w + fr, 64 * ks + 16 * fq);
            if (ML) { float kv[8]; unpack8(__builtin_bit_cast(v4u, kf), kv); nsum += ((kv[0] + kv[1]) + (kv[2] + kv[3])) + ((kv[4] + kv[5]) + (kv[6] + kv[7])); }
#pragma unroll
            for (int j = 0; j < 4; ++j) tmp[j] = __builtin_amdgcn_mfma_f32_16x16x32_bf16(kf, lds_frag(VT, 16 * j + fr, 64 * ks + 16 * fq), tmp[j], 0, 0, 0); }
        const float sa = scal[2 * (c & 1)], sg = scal[2 * (c & 1) + 1];
#pragma unroll
        for (int j = 0; j < 4; ++j) sacc[j] = sacc[j] * sa + tmp[j] * sg;
        if (ML) { nsum += __shfl_xor(nsum, 16); nsum += __shfl_xor(nsum, 32); nreg = nreg * sa + nsum * sg; }
        HSYNC();
        __builtin_amdgcn_sched_barrier(0);
        const f32x4 rs4 = *(const LAS f32x4*)(vb + 384 + 16 * w + 4 * fq);
        float yo[4][4];
        if (ML) { const f32x4 fl4 = *(const LAS f32x4*)(vb + 640 + 16 * w + 4 * fq); const f32x4 dA = *(const LAS f32x4*)(exch + 4 * fq), dB = *(const LAS f32x4*)(exch + 16 + 4 * fq);
#pragma unroll
            for (int r = 0; r < 4; ++r) { const float den = fmaxf(fabsf(dA[r] + rs4[r] * dB[r]), fl4[r]); const float inv = 1.0f / den;
#pragma unroll
                for (int j = 0; j < 4; ++j) yo[r][j] = (y1[j][r] + rs4[r] * y2[j][r]) * inv; }
        } else {
#pragma unroll
            for (int j = 0; j < 4; ++j) { const v2u xw = *(const LAS v2u*)(VT + (16 * j + fr) * MX_PITCH + (16 * w + 4 * fq) * 2); const float xs[4] = {bflo(xw.x), bfhi(xw.x), bflo(xw.y), bfhi(xw.y)};
#pragma unroll
                for (int r = 0; r < 4; ++r) { const float zz = __builtin_bit_cast(float, (unsigned)zr[r][j] << 16); yo[r][j] = (y1[j][r] + rs4[r] * y2[j][r] + c_D * xs[r]) * siluf(zz); } }
        }
        bf16* yrow = YMIX + trow0 * 4096 + (ML ? 2048 + mh * 256 + vq * 64 : hd * 64) + fr;
#pragma unroll
        for (int r = 0; r < 4; ++r) { float ss = (yo[r][0] * yo[r][0] + yo[r][1] * yo[r][1]) + (yo[r][2] * yo[r][2] + yo[r][3] * yo[r][3]);
            ss += __shfl_xor(ss, 1); ss += __shfl_xor(ss, 2); ss += __shfl_xor(ss, 4); ss += __shfl_xor(ss, 8);
            if (fr == 0) SSQ[(ML ? (size_t)TT * 32 : 0) + (trow0 + r) * 32 + (ML ? mh * 4 + vq : hd)] = ss;
#pragma unroll
            for (int j = 0; j < 4; ++j) yrow[(size_t)r * 4096 + 16 * j] = (bf16)f2bf(yo[r][j]); }
        if (more) { MX_SCAN_A(c + 1); }
        __syncthreads();
        if (more) { MX_SCAN_B(c + 1); }
        __syncthreads();
        if (more) { MX_WRITE(c + 1); }
        __syncthreads();
    }
#undef MX_SCAN
#undef MX_SCAN_A
#undef MX_SCAN_B
#undef MX_PREFETCH
#undef MX_WRITE
}
__device__ __forceinline__ void phase_mixer(Frame& F) {
    for (int unit = F.bid; unit < 256; unit += F.G) { mixer_unit<false>(F, unit); mixer_unit<true>(F, unit); }
}

__device__ __forceinline__ void phase3(Frame& F) {
    const bf16* PROJ = (const bf16*)(F.ws + WS_PROJ); bf16* YMIX = (bf16*)(F.ws + WS_YMIX); const float* SSQ = (const float*)(F.ws + WS_SSQ);
    const int gw = F.bid * NWAVES + F.wave, NGW = F.G * NWAVES;
    for (int t = gw; t < TT; t += NGW) {
        bf16* yrow = YMIX + (size_t)t * 4096;
#pragma unroll
        for (int j = 0; j < 8; ++j) {
            const int c0 = (j * 64 + F.lane) * 8;
            float y[8]; unpack8(*(const v4u*)(yrow + c0), y);
            float o[8];
            if (j < 4) {
                const int g = c0 >> 9; const f32x4 s0 = *(const f32x4*)(SSQ + (size_t)t * 32 + g * 8), s1 = *(const f32x4*)(SSQ + (size_t)t * 32 + g * 8 + 4);
                const float ms = ((s0.x + s0.y) + (s0.z + s0.w) + (s1.x + s1.y) + (s1.z + s1.w)) * (1.0f / 512.0f);
                const float rs = 1.0f / sqrtf(ms + EPSF);
                const f32x4 w0 = *(const f32x4*)(F.ssd_norm_w + c0), w1 = *(const f32x4*)(F.ssd_norm_w + c0 + 4);
                o[0] = y[0] * rs * w0.x; o[1] = y[1] * rs * w0.y; o[2] = y[2] * rs * w0.z; o[3] = y[3] * rs * w0.w;
                o[4] = y[4] * rs * w1.x; o[5] = y[5] * rs * w1.y; o[6] = y[6] * rs * w1.z; o[7] = y[7] * rs * w1.w;
            } else {
                const int cc = c0 - 2048, h = cc >> 8; const f32x4 s0 = *(const f32x4*)(SSQ + (size_t)TT * 32 + (size_t)t * 32 + h * 4);
                const float ms = ((s0.x + s0.y) + (s0.z + s0.w)) * (1.0f / 256.0f);
                const float rs = 1.0f / sqrtf(ms + EPSF);
                const f32x4 w0 = *(const f32x4*)(F.ml_norm_w + cc), w1 = *(const f32x4*)(F.ml_norm_w + cc + 4);
                float og[8]; unpack8(*(const v4u*)(PROJ + (size_t)t * NPROJ + PC_O + cc), og);
                const float wv[8] = {w0.x, w0.y, w0.z, w0.w, w1.x, w1.y, w1.z, w1.w};
#pragma unroll
                for (int i = 0; i < 8; ++i) o[i] = y[i] * rs * wv[i] * (1.0f / (1.0f + __expf(-og[i])));
            }
            v4u ov; ov.x = pk2(o[0], o[1]); ov.y = pk2(o[2], o[3]); ov.z = pk2(o[4], o[5]); ov.w = pk2(o[6], o[7]);
            *(v4u*)(yrow + c0) = ov;
        }
    }
}

__device__ __forceinline__ void phase5(Frame& F) {
    const float* H2 = (const float*)(F.ws + WS_H2); const float* Wrt = (const float*)(F.ws + WS_WRT); bf16* XN2 = (bf16*)(F.ws + WS_XN2);
    int* EIDX = (int*)(F.ws + WS_ROUTE); int* RANK = EIDX + TT * 4; float* GATE = (float*)(RANK + TT * 4);
    LAS float* xT = (LAS float*)(F.lds + F.wave * 8192); LAS float* lg = (LAS float*)(F.lds + 65536 + F.wave * 1024);
    LAS int* cntl = (LAS int*)(F.lds + 73728); LAS int* baseg = cntl + 32;
    const int gw = F.bid * NWAVES + F.wave, NGW = F.G * NWAVES, ntask = TT / 8, iters = (ntask + NGW - 1) / NGW;
    for (int itx = 0; itx < iters; ++itx) {
        const int task = itx * NGW + gw; const bool valid = task < ntask; const int t0 = task * 8;
        if (F.tid < 32) cntl[F.tid] = 0;
        __syncthreads();
        float rstd[8]; int me[4] = {0, 0, 0, 0}, mr[4] = {0, 0, 0, 0}; float mg[4] = {0.f, 0.f, 0.f, 0.f};
#pragma unroll
        for (int k = 0; k < 8; ++k) rstd[k] = 0.f;
        if (valid) {
            float acc[8], ssq[8];
#pragma unroll
            for (int k = 0; k < 8; ++k) { acc[k] = 0.f; ssq[k] = 0.f; }
            const int e = F.lane & 31, dh = F.lane >> 5;
            for (int dc = 0; dc < 8; ++dc) {
#pragma unroll
                for (int jj = 0; jj < 4; ++jj) { float xv[8];
#pragma unroll
                    for (int k = 0; k < 8; ++k) { xv[k] = H2[(size_t)(t0 + k) * DM + dc * 256 + jj * 64 + F.lane]; ssq[k] += xv[k] * xv[k]; }
                    LAS float* dp = xT + (jj * 64 + F.lane) * 8; *(LAS f32x4*)dp = (f32x4){xv[0], xv[1], xv[2], xv[3]}; *(LAS f32x4*)(dp + 4) = (f32x4){xv[4], xv[5], xv[6], xv[7]}; }
                LDS_WAIT(); asm volatile("" ::: "memory");
                const float* wp = Wrt + (size_t)(dc * 256 + dh * 128) * 32 + e; const LAS float* xp = xT + dh * 128 * 8;
#pragma unroll 4
                for (int i = 0; i < 128; ++i) { const float w = wp[i * 32]; const f32x4 xa = *(const LAS f32x4*)(xp + i * 8), xb = *(const LAS f32x4*)(xp + i * 8 + 4);
                    acc[0] += w * xa.x; acc[1] += w * xa.y; acc[2] += w * xa.z; acc[3] += w * xa.w; acc[4] += w * xb.x; acc[5] += w * xb.y; acc[6] += w * xb.z; acc[7] += w * xb.w; }
                LDS_WAIT(); asm volatile("" ::: "memory");
            }
            const float rb = F.router_b[e];
#pragma unroll
            for (int k = 0; k < 8; ++k) { rstd[k] = 1.0f / sqrtf(wave_sum(ssq[k]) * (1.0f / 2048.0f) + EPSF);
                const float v = (acc[k] + __shfl_xor(acc[k], 32)) * rstd[k] + rb; if (F.lane < 32) lg[k * 32 + e] = v; }
            LDS_WAIT(); asm volatile("" ::: "memory");
            if (F.lane < 8) {
                const LAS float* lp = lg + F.lane * 32; float bv[4]; int bi[4] = {-1, -1, -1, -1};
#pragma unroll
                for (int p = 0; p < 4; ++p) { float best = -3.0e38f; int bidx = 0;
                    for (int q = 0; q < 32; ++q) { const float v = lp[q]; const bool taken = (q == bi[0]) | (q == bi[1]) | (q == bi[2]) | (q == bi[3]); if (!taken && v > best) { best = v; bidx = q; } }
                    bv[p] = best; bi[p] = bidx; }
                const float p1 = expf(bv[1] - bv[0]), p2 = expf(bv[2] - bv[0]), p3 = expf(bv[3] - bv[0]); const float inv = 1.0f / (1.0f + p1 + p2 + p3);
                mg[0] = inv; mg[1] = p1 * inv; mg[2] = p2 * inv; mg[3] = p3 * inv;
#pragma unroll
                for (int p = 0; p < 4; ++p) { me[p] = bi[p]; mr[p] = __hip_atomic_fetch_add(cntl + bi[p], 1, __ATOMIC_RELAXED, __HIP_MEMORY_SCOPE_WORKGROUP); }
            }
        }
        __syncthreads();
        if (F.tid < 32) { const int c = cntl[F.tid]; int gb = 0; if (c > 0) gb = (int)__hip_atomic_fetch_add((unsigned*)(F.ctl + CW_CNT + 64 * F.tid), (unsigned)c, RLX_AGENT); baseg[F.tid] = gb; }
        __syncthreads();
        if (valid) {
            if (F.lane < 8) { const size_t t = (size_t)(t0 + F.lane);
#pragma unroll
                for (int p = 0; p < 4; ++p) { EIDX[t * 4 + p] = me[p]; RANK[t * 4 + p] = baseg[me[p]] + mr[p]; GATE[t * 4 + p] = mg[p]; } }
#pragma unroll
            for (int k = 0; k < 8; ++k) { const f32x4* xr = (const f32x4*)(H2 + (size_t)(t0 + k) * DM) + F.lane; const f32x4* wr = (const f32x4*)F.norm2_w + F.lane; int* o4 = (int*)((unsigned char*)XN2 + (size_t)(t0 + k) * DM) + F.lane;
#pragma unroll
                for (int j = 0; j < 8; ++j) { const f32x4 v = xr[64 * j], ww = wr[64 * j]; int o = __builtin_amdgcn_cvt_pk_fp8_f32(v.x * rstd[k] * ww.x, v.y * rstd[k] * ww.y, 0, false); o = __builtin_amdgcn_cvt_pk_fp8_f32(v.z * rstd[k] * ww.z, v.w * rstd[k] * ww.w, o, true); o4[64 * j] = o; } }
        }
        __syncthreads();
    }
}
__device__ __forceinline__ void phase5b(Frame& F) {
    const bf16* XN2 = (const bf16*)(F.ws + WS_XN2); bf16* XG = (bf16*)(F.ws + WS_XG);
    const int* EIDX = (const int*)(F.ws + WS_ROUTE); const int* RANK = EIDX + TT * 4; const float* GATE = (const float*)(RANK + TT * 4); int* SLOT = (int*)(GATE + TT * 4); float* SGATE = (float*)(SLOT + TT * 4);
    LAS int* sbase = (LAS int*)(F.lds); LAS int* spad = sbase + 32;
    if (F.tid < 32) { const int c = (int)__hip_atomic_load((unsigned*)(F.ctl + CW_CNT + 64 * F.tid), RLX_AGENT); spad[F.tid] = (c + 255) & ~255; }
    __syncthreads();
    if (F.tid == 0) { int a = 0; for (int e = 0; e < 32; ++e) { sbase[e] = a; a += spad[e]; } }
    __syncthreads();
    const int gw = F.bid * NWAVES + F.wave, NGW = F.G * NWAVES;
    for (int task = gw; task < TT / 8; task += NGW) {
#pragma unroll 2
        for (int k = 0; k < 8; ++k) { const size_t t = (size_t)task * 8 + k;
            int slot = 0;
            if (F.lane < 4) { const int e = EIDX[t * 4 + F.lane]; slot = sbase[e] + RANK[t * 4 + F.lane]; SLOT[t * 4 + F.lane] = slot; SGATE[slot] = GATE[t * 4 + F.lane]; }
            const int s0 = __shfl(slot, 0), s1 = __shfl(slot, 1), s2 = __shfl(slot, 2), s3 = __shfl(slot, 3);
            const v4u* src = (const v4u*)((const unsigned char*)XN2 + t * DM) + F.lane; v4u d[2];
#pragma unroll
            for (int j = 0; j < 2; ++j) d[j] = src[64 * j];
            v4u* d0 = (v4u*)((unsigned char*)XG + (size_t)s0 * DM) + F.lane; v4u* d1 = (v4u*)((unsigned char*)XG + (size_t)s1 * DM) + F.lane; v4u* d2 = (v4u*)((unsigned char*)XG + (size_t)s2 * DM) + F.lane; v4u* d3 = (v4u*)((unsigned char*)XG + (size_t)s3 * DM) + F.lane;
#pragma unroll
            for (int j = 0; j < 2; ++j) { d0[64 * j] = d[j]; d1[64 * j] = d[j]; d2[64 * j] = d[j]; d3[64 * j] = d[j]; }
        }
    }
}
__device__ __forceinline__ int build_moe_tab(Frame& F) {
    LAS unsigned char* tab = (LAS unsigned char*)(F.lds + TAB_OFF); LAS int* tinfo = (LAS int*)(F.lds + TAB_OFF + 320);
    if (F.tid < 32) { const int c = (int)__hip_atomic_load((unsigned*)(F.ctl + CW_CNT + 64 * F.tid), RLX_AGENT); tinfo[4 + F.tid] = (c + 255) >> 8; }
    __syncthreads();
    if (F.tid == 0) { int a = 0; for (int e = 0; e < 32; ++e) { const int n = tinfo[4 + e]; for (int j = 0; j < n; ++j) tab[a + j] = (unsigned char)e; a += n; } tinfo[0] = a; }
    __syncthreads();
    return tinfo[0];
}
__device__ __forceinline__ void phase8(Frame& F) {
    const float* H2 = (const float*)(F.ws + WS_H2); const bf16* YR = (const bf16*)(F.ws + WS_YR);
    const int* SLOT = (const int*)(F.ws + WS_ROUTE) + TT * 12;
    const int gw = F.bid * NWAVES + F.wave, NGW = F.G * NWAVES;
    for (int t = gw; t < TT; t += NGW) {
        int slot = 0; if (F.lane < 4) slot = SLOT[(size_t)t * 4 + F.lane];
        int sl[4]; sl[0] = __shfl(slot, 0); sl[1] = __shfl(slot, 1); sl[2] = __shfl(slot, 2); sl[3] = __shfl(slot, 3);
        float v[4][8]; float ss = 0.f;
#pragma unroll
        for (int j = 0; j < 4; ++j) { const int pz = F.lane + 64 * j; const f32x4 a = *(const f32x4*)(H2 + (size_t)t * DM + 8 * pz), b = *(const f32x4*)(H2 + (size_t)t * DM + 8 * pz + 4);
            v[j][0] = a.x; v[j][1] = a.y; v[j][2] = a.z; v[j][3] = a.w; v[j][4] = b.x; v[j][5] = b.y; v[j][6] = b.z; v[j][7] = b.w; }
#pragma unroll
        for (int k = 0; k < 4; ++k)
#pragma unroll
            for (int j = 0; j < 4; ++j) { float f[8]; unpack8(*((const v4u*)(YR + (size_t)sl[k] * DM) + F.lane + 64 * j), f);
#pragma unroll
                for (int i = 0; i < 8; ++i) v[j][i] += f[i]; }
#pragma unroll
        for (int j = 0; j < 4; ++j)
#pragma unroll
            for (int i = 0; i < 8; ++i) ss += v[j][i] * v[j][i];
        const float rstd = 1.0f / sqrtf(wave_sum(ss) * (1.0f / 2048.0f) + EPSF);
#pragma unroll
        for (int j = 0; j < 4; ++j) { const int pz = F.lane + 64 * j; const f32x4 w0 = *(const f32x4*)(F.final_norm_w + 8 * pz), w1 = *(const f32x4*)(F.final_norm_w + 8 * pz + 4);
            *(f32x4*)(F.out + (size_t)t * DM + 8 * pz) = (f32x4){v[j][0] * rstd * w0.x, v[j][1] * rstd * w0.y, v[j][2] * rstd * w0.z, v[j][3] * rstd * w0.w};
            *(f32x4*)(F.out + (size_t)t * DM + 8 * pz + 4) = (f32x4){v[j][4] * rstd * w1.x, v[j][5] * rstd * w1.y, v[j][6] * rstd * w1.z, v[j][7] * rstd * w1.w}; }
    }
}

struct Args { const float* in[21]; float* out; unsigned char* ws; int ph_lo, ph_hi, li, pad; };
__global__ void __launch_bounds__(NWAVES * 64, 2) hymba_fwd(Args args) {
    extern __shared__ __attribute__((aligned(16))) unsigned char lds[];
    Frame F;
    F.lds = (LAS unsigned char*)lds; F.MISC = (volatile LAS unsigned*)(F.lds + MISC_OFF);
    F.tid = threadIdx.x; F.lane = F.tid & 63; F.wave = __builtin_amdgcn_readfirstlane(F.tid >> 6); F.G = gridDim.x; F.bid = blockIdx.x;
    F.ws = args.ws; F.ctl = (gu32*)(args.ws + WS_CTL); F.out = args.out;
    F.x = args.in[0]; F.norm1_w = args.in[1]; F.w_in = args.in[2]; F.conv_w = args.in[3]; F.conv_b = args.in[4]; F.dt_bias = args.in[5]; F.a_log = args.in[6]; F.d_skip = args.in[7]; F.ssd_norm_w = args.in[8];
    F.i_bias = args.in[9]; F.f_bias = args.in[10]; F.ml_norm_w = args.in[11]; F.w_out = args.in[12]; F.norm2_w = args.in[13]; F.router_w = args.in[14]; F.router_b = args.in[15];
    F.w_gate_up = args.in[16]; F.b_gate_up = args.in[17]; F.w_down = args.in[18]; F.b_down = args.in[19]; F.final_norm_w = args.in[20];
    for (int u = F.tid; u < (LDS_BYTES - LDSCTL_OFF) / 4; u += NWAVES * 64) ((LAS unsigned*)(F.lds + LDSCTL_OFF))[u] = 0u;
    __syncthreads();
    XcdBarrier bar; bar.bar = (unsigned*)(F.ctl + CW_BAR) + args.li * XCD_BAR_WORDS; bar.x = 0; bar.st = nullptr;
    const bool use_bar = (args.ph_hi - args.ph_lo) > 1;
    if (use_bar) bar = xcd_barrier_post((unsigned*)(F.ctl + CW_BAR) + args.li * XCD_BAR_WORDS, F.MISC + 8);
    const int lo = args.ph_lo, hi = args.ph_hi;
#ifndef PHASE_MASK
#define PHASE_MASK 0x7ff
#endif
#define IN(k) (((PHASE_MASK >> (k)) & 1) && lo <= (k) && (k) < hi)
#define SEAM(k) do { if (IN(k) && IN((k) + 1)) xcd_barrier(bar); } while (0)
    if (IN(0)) { phase0(F); } SEAM(0);
    if (IN(1)) {
        pg8::Gemm g{(const pg8::bf16_t*)(F.ws + WS_XN1), (const pg8::bf16_t*)(F.ws + WS_WIN), TT, NPROJ, DM}; pg8::StaticOrder S; S.init(TT, NPROJ, F.G, F.bid);
        pg8::EpiBf16 E{(pg8::bf16_t*)(F.ws + WS_PROJ), NPROJ};
        pg8::gemm_phase<pg8::EpiBf16, pg8::StaticOrder, true, true>(F.lds, g, S, E);
        p1_small(F);
    } SEAM(1);
    if (IN(2)) { phase_conv(F); } SEAM(2);
    if (IN(3)) { phase_mixer(F); } SEAM(3);
    if (IN(4)) { phase3(F); } SEAM(4);
    if (IN(5)) {
        pg8::Gemm g{(const pg8::bf16_t*)(F.ws + WS_YMIX), (const pg8::bf16_t*)(F.ws + WS_WOUT), TT, DM, 4096}; pg8::StaticOrder S; S.init(TT, DM, F.G, F.bid);
        pg8::EpiResF32 E{(float*)(F.ws + WS_H2), F.x, DM};
        pg8::gemm_phase<pg8::EpiResF32, pg8::StaticOrder, true, true>(F.lds, g, S, E);
    } SEAM(5);
    if (IN(6)) { phase5(F); } SEAM(6);
    if (IN(7)) { phase5b(F); } SEAM(7);
    if (IN(8)) {
        const int nM = build_moe_tab(F);
        pg8::Gemm g{(const pg8::bf16_t*)(F.ws + WS_XG), (const pg8::bf16_t*)(F.ws + WS_WGU), nM * 256, 4096, DM};
        pg8::MoeOrder S{nM, 16, 4, nM * 16, F.G, F.bid, (const PG8_LAS unsigned char*)(F.lds + TAB_OFF)};
        pg8::EpiSwiglu E{(unsigned char*)(F.ws + WS_ACT), F.b_gate_up};
        pg8::gemm_phase<pg8::EpiSwiglu, pg8::MoeOrder, true, true, true>(F.lds, g, S, E);
    } SEAM(8);
    if (IN(9)) {
        const int nM = build_moe_tab(F);
        pg8::Gemm g{(const pg8::bf16_t*)(F.ws + WS_ACT), (const pg8::bf16_t*)(F.ws + WS_WD), nM * 256, 2048, DM};
        pg8::MoeOrder S{nM, 8, 3, nM * 8, F.G, F.bid, (const PG8_LAS unsigned char*)(F.lds + TAB_OFF)};
        pg8::EpiDown E{(pg8::bf16_t*)(F.ws + WS_YR), F.b_down, (const float*)((const int*)(F.ws + WS_ROUTE) + TT * 16)};
        pg8::gemm_phase<pg8::EpiDown, pg8::MoeOrder, true, true, true>(F.lds, g, S, E);
    } SEAM(9);
    if (IN(10)) { phase8(F); }
#undef IN
#undef SEAM
}

extern "C" void kernel_launch(void* const* d_in, const int* in_sizes, int n_in, void* d_out, int out_size, void* d_ws, size_t ws_size, hipStream_t stream) {
    static int grid = 0;
    if (grid == 0) {
        if (n_in != 21 || out_size != TT * DM || ws_size < WS_END) { fprintf(stderr, "kernel_launch: unexpected problem (n_in %d, out %d, ws %zu); nothing launched\n", n_in, out_size, ws_size); grid = -1; return; }
        int dev = 0, cus = 0, per_cu = 0;
        if (hipGetDevice(&dev) != hipSuccess || hipDeviceGetAttribute(&cus, hipDeviceAttributeMultiprocessorCount, dev) != hipSuccess) { grid = -1; return; }
        if (hipFuncSetAttribute((const void*)hymba_fwd, hipFuncAttributeMaxDynamicSharedMemorySize, LDS_BYTES) != hipSuccess) { fprintf(stderr, "kernel_launch: hipFuncSetAttribute failed\n"); grid = -1; return; }
        if (hipOccupancyMaxActiveBlocksPerMultiprocessor(&per_cu, (const void*)hymba_fwd, NWAVES * 64, LDS_BYTES) != hipSuccess || per_cu < 1) { fprintf(stderr, "kernel_launch: occupancy query says %d blocks per CU\n", per_cu); }
        (void)hipGetLastError();
        grid = cus;
    }
    if (grid < 0) return;
    (void)hipMemsetAsync((char*)d_ws + WS_CTL, 0, CTL_ZERO_BYTES, stream);
    Args a{};
    for (int i = 0; i < 21; ++i) a.in[i] = (const float*)d_in[i];
    a.out = (float*)d_out; a.ws = (unsigned char*)d_ws; a.pad = 0;
#if MK_PER_PHASE
    for (int li = 0; li < N_PHASES; ++li) { a.ph_lo = li; a.ph_hi = li + 1; a.li = li; hipLaunchKernelGGL(hymba_fwd, dim3(grid), dim3(NWAVES * 64), LDS_BYTES, stream, a); }
#else
    a.ph_lo = 0; a.ph_hi = N_PHASES; a.li = 0;
    hipLaunchKernelGGL(hymba_fwd, dim3(grid), dim3(NWAVES * 64), LDS_BYTES, stream, a);
#endif
}
```

```cpp
#include <hip/hip_runtime.h>
#include <cstdio>
#include <cstdint>
namespace pg8 {
#define PG8_LAS __attribute__((address_space(3)))
typedef unsigned short bf16_t;
typedef short bf16x8 __attribute__((ext_vector_type(8)));
typedef float f32x4 __attribute__((ext_vector_type(4)));
typedef unsigned u32x4 __attribute__((ext_vector_type(4)));
constexpr int BM = 256, BK = 64, HALF = 128, HTB = HALF * BK * 2  , STAGE_BYTES = 8 * HTB, NXCD = 8, WGM = 8;

__host__ __device__ __forceinline__ int lds_byte(int r, int c) { const int st = (r >> 4) * 2 + (c >> 5), rr = r & 15, cc = c & 31, ob = rr * 64 + cc * 2; return st * 1024 + (ob ^ (((ob >> 9) & 1) << 5)); }
__host__ __device__ __forceinline__ void stage_rc(int b, int& R, int& C) { const int st = b / 1024, sb = b % 1024, swz = sb ^ (((sb >> 9) & 1) << 5); R = (st >> 1) * 16 + swz / 64; C = (st & 1) * 32 + (swz % 64) / 2; }
__host__ __device__ __forceinline__ int perm32(int rho) { const int n = rho >> 4, i = rho & 15; return 8 * (i >> 2) + 4 * n + (i & 3); }

struct Unit { int pm, pn; };
struct Gemm { const bf16_t* A; const bf16_t* Bt; int M, N, K; };

struct StaticOrder {
    int nM, nN, nwg, G, c;
    __host__ __device__ void init(int M, int N, int G_, int c_) { nM = M / BM; nN = N / BM; nwg = nM * nN; G = G_; c = c_; }
    __host__ __device__ bool next(int i, Unit& u) const {
        const long L = (long)i * G + c; if (L >= nwg) return false;
        int wgid = (int)L; { const int q = nwg / NXCD, r = nwg % NXCD, xcd = wgid % NXCD, off = wgid / NXCD; wgid = (xcd < r ? xcd * (q + 1) : r * (q + 1) + (xcd - r) * q) + off; }
        const int nig = WGM * nN, gid = wgid / nig, fm = gid * WGM, gsz = (nM - fm) < WGM ? (nM - fm) : WGM;
        u.pm = fm + ((wgid % nig) % gsz); u.pn = (wgid % nig) / gsz; return true;
    }
    __device__ __forceinline__ void a_ready(const Unit&) const {}
    __device__ __forceinline__ void done(const Unit&) const {}
};


__device__ __forceinline__ unsigned cvt_pk_bf16(float lo, float hi) { unsigned r; asm volatile("v_cvt_pk_bf16_f32 %0, %1, %2" : "=v"(r) : "v"(lo), "v"(hi)); return r; }
typedef unsigned u32x2 __attribute__((ext_vector_type(2)));

struct EpiBf16 {
    static constexpr bool PERM = true, AFTER_DRAIN = false;
    bf16_t* O; int ldc;
    __device__ __forceinline__ void operator()(const f32x4 (&acc)[2][2][4][2], const Unit& u, int wr, int wc, int fr, int fq) const {
        const int row0 = u.pm * BM + wr * 64 + fr; const int col0 = u.pn * BM + wc * 32 + 8 * fq;
#pragma unroll
        for (int ai = 0; ai < 2; ++ai)
#pragma unroll
            for (int m = 0; m < 4; ++m) { bf16_t* rowp = O + (size_t)(row0 + ai * HALF + m * 16) * ldc + col0;
#pragma unroll
                for (int bj = 0; bj < 2; ++bj) { const f32x4 v0 = acc[ai][bj][m][0], v1 = acc[ai][bj][m][1];
                    u32x4 w; w.x = cvt_pk_bf16(v0[0], v0[1]); w.y = cvt_pk_bf16(v0[2], v0[3]); w.z = cvt_pk_bf16(v1[0], v1[1]); w.w = cvt_pk_bf16(v1[2], v1[3]);
                    *(u32x4*)(rowp + bj * HALF) = w; } }
    }
};
struct EpiResF32 {
    static constexpr bool PERM = false, AFTER_DRAIN = false;
    float* C; const float* base; int ldc;
    __device__ __forceinline__ void operator()(const f32x4 (&acc)[2][2][4][2], const Unit& u, int wr, int wc, int fr, int fq) const {
        const int row0 = u.pm * BM + wr * 64 + fr, col0 = u.pn * BM + wc * 32 + 4 * fq;
#pragma unroll
        for (int ai = 0; ai < 2; ++ai)
#pragma unroll
            for (int m = 0; m < 4; ++m) { const size_t off = (size_t)(row0 + ai * HALF + m * 16) * ldc + col0;
#pragma unroll
                for (int bj = 0; bj < 2; ++bj)
#pragma unroll
                    for (int n = 0; n < 2; ++n) *(f32x4*)(C + off + bj * HALF + n * 16) = acc[ai][bj][m][n] + *(const f32x4*)(base + off + bj * HALF + n * 16); }
    }
};
__device__ __forceinline__ float swiglu1(float a, float b) {
    const float glu = fminf(a, 7.0f), lin = fminf(fmaxf(b, -7.0f), 7.0f);
    return glu * (1.0f / (1.0f + __expf(-1.702f * glu))) * (lin + 1.0f);
}
struct EpiSwiglu {
    static constexpr bool PERM = true, AFTER_DRAIN = false;
    unsigned char* O; const float* bias;
    __device__ __forceinline__ void operator()(const f32x4 (&acc)[2][2][4][2], const Unit& u, int wr, int wc, int fr, int fq) const {
        const int e = u.pn >> 4, pnl = u.pn & 15;
        const int row0 = u.pm * BM + wr * 64 + fr; const int hcol0 = pnl * BM + wc * 32 + 8 * fq;
        const float* bp = bias + (size_t)e * 4096 + hcol0;
        f32x4 bv[2][2];
#pragma unroll
        for (int bj = 0; bj < 2; ++bj)
#pragma unroll
            for (int n = 0; n < 2; ++n) bv[bj][n] = *(const f32x4*)(bp + bj * HALF + 4 * n);
#pragma unroll
        for (int ai = 0; ai < 2; ++ai)
#pragma unroll
            for (int m = 0; m < 4; ++m) { unsigned char* rowp = O + (size_t)(row0 + ai * HALF + m * 16) * 2048 + (hcol0 >> 1);
#pragma unroll
                for (int bj = 0; bj < 2; ++bj) { const f32x4 v0 = acc[ai][bj][m][0] + bv[bj][0], v1 = acc[ai][bj][m][1] + bv[bj][1];
                    int w = __builtin_amdgcn_cvt_pk_fp8_f32(swiglu1(v0[0], v0[1]), swiglu1(v0[2], v0[3]), 0, false);
                    w = __builtin_amdgcn_cvt_pk_fp8_f32(swiglu1(v1[0], v1[1]), swiglu1(v1[2], v1[3]), w, true);
                    *(int*)(rowp + bj * 64) = w; } }
    }
};
struct EpiDown {
    static constexpr bool PERM = true, AFTER_DRAIN = false;
    bf16_t* O; const float* bias; const float* sgate;
    __device__ __forceinline__ void operator()(const f32x4 (&acc)[2][2][4][2], const Unit& u, int wr, int wc, int fr, int fq) const {
        const int e = u.pn >> 3, pnl = u.pn & 7;
        const int row0 = u.pm * BM + wr * 64 + fr; const int col0 = pnl * BM + wc * 32 + 8 * fq;
        const float* bp = bias + (size_t)e * 2048 + col0;
        f32x4 bv[2][2];
#pragma unroll
        for (int bj = 0; bj < 2; ++bj)
#pragma unroll
            for (int n = 0; n < 2; ++n) bv[bj][n] = *(const f32x4*)(bp + bj * HALF + 4 * n);
#pragma unroll
        for (int ai = 0; ai < 2; ++ai)
#pragma unroll
            for (int m = 0; m < 4; ++m) { const int row = row0 + ai * HALF + m * 16; const float gt = sgate[row]; bf16_t* rowp = O + (size_t)row * 2048 + col0;
#pragma unroll
                for (int bj = 0; bj < 2; ++bj) { const f32x4 v0 = (acc[ai][bj][m][0] + bv[bj][0]) * gt, v1 = (acc[ai][bj][m][1] + bv[bj][1]) * gt;
                    u32x4 w; w.x = cvt_pk_bf16(v0[0], v0[1]); w.y = cvt_pk_bf16(v0[2], v0[3]); w.z = cvt_pk_bf16(v1[0], v1[1]); w.w = cvt_pk_bf16(v1[2], v1[3]);
                    *(u32x4*)(rowp + bj * HALF) = w; } }
    }
};
struct MoeOrder {
    int nM, nN, nsh, nwg, G, c; const PG8_LAS unsigned char* tab;
    __device__ __forceinline__ bool next(int i, Unit& u) const {
        const long L = (long)i * G + c; if (L >= nwg) return false;
        int wgid = (int)L; { const int q = nwg / NXCD, r = nwg % NXCD, xcd = wgid % NXCD, off = wgid / NXCD; wgid = (xcd < r ? xcd * (q + 1) : r * (q + 1) + (xcd - r) * q) + off; }
        const int nig = WGM * nN, gid = wgid / nig, fm = gid * WGM, gsz = (nM - fm) < WGM ? (nM - fm) : WGM;
        const int pm = fm + ((wgid % nig) % gsz), pnl = (wgid % nig) / gsz;
        u.pm = pm; u.pn = ((int)tab[pm] << nsh) + pnl; return true;
    }
    __device__ __forceinline__ void a_ready(const Unit&) const {}
    __device__ __forceinline__ void done(const Unit&) const {}
};
typedef int v8i32 __attribute__((ext_vector_type(8)));
__device__ __forceinline__ v8i32 pg8_cat(const bf16x8 lo, const bf16x8 hi) { typedef int v4i32 __attribute__((ext_vector_type(4))); const v4i32 a = __builtin_bit_cast(v4i32, lo), b = __builtin_bit_cast(v4i32, hi); return __builtin_shufflevector(a, b, 0, 1, 2, 3, 4, 5, 6, 7); }
template <class Epi, class Sched, bool ALIGN_EPI = false, bool SP2 = false, bool F8 = false>
__device__ __forceinline__ void gemm_phase(PG8_LAS unsigned char* lds, const Gemm g, const Sched& S, const Epi& E) {
    const int tid = threadIdx.x, wid = __builtin_amdgcn_readfirstlane(tid >> 6), lane = tid & 63, wr = wid >> 2, wc = wid & 3, fr = lane & 15, fq = lane >> 4;
    const int K = g.K, KB = F8 ? K : 2 * K, nt = KB / 128;
    unsigned voffA[2], voffB[2];
#pragma unroll
    for (int i = 0; i < 2; ++i) { int R, C; stage_rc(tid * 16 + i * 8192, R, C); const int Rb = Epi::PERM ? ((R & ~31) + perm32(R & 31)) : R;
        voffA[i] = (unsigned)(R * KB + C * 2); voffB[i] = (unsigned)(Rb * KB + C * 2); }
    const size_t kstep = (size_t)(BK * 2);
    const size_t hstep = (size_t)HALF * KB;
    const size_t tstep = 2 * hstep;
    const unsigned ldsw = (unsigned)wid * 1024u;
    int aoffk[2], boffk[2];
#pragma unroll
    for (int h = 0; h < 2; ++h) { aoffk[h] = F8 ? lds_byte(wr * 64 + fr, (2 * (fq & 1) + h) * 8) + (fq >> 1) * 1024 : lds_byte(wr * 64 + fr, fq * 8) + h * 1024;
        boffk[h] = F8 ? lds_byte(wc * 32 + fr, (2 * (fq & 1) + h) * 8) + (fq >> 1) * 1024 : lds_byte(wc * 32 + fr, fq * 8) + h * 1024; }
#define PG8_SA(b, h) (((b) * 2 + (h)) * HTB)
#define PG8_SB(b, h) ((4 + (b) * 2 + (h)) * HTB)
#define PG8_STAGE(bufoff, gbase, voff) do { _Pragma("unroll") for (int _i = 0; _i < 2; ++_i) \
        __builtin_amdgcn_global_load_lds((const unsigned*)((const char*)(gbase) + (voff)[_i]), (PG8_LAS unsigned*)(lds + (bufoff) + ldsw + _i * 8192), 16, 0, 0); } while (0)
#define PG8_LDA(dst, b, h) do { if constexpr (F8) { _Pragma("unroll") for (int m = 0; m < 4; ++m) dst##8[m] = pg8_cat(*(const PG8_LAS bf16x8*)(lds + PG8_SA(b, h) + aoffk[0] + m * 2048), *(const PG8_LAS bf16x8*)(lds + PG8_SA(b, h) + aoffk[1] + m * 2048)); } \
        else { _Pragma("unroll") for (int m = 0; m < 4; ++m) _Pragma("unroll") for (int k = 0; k < 2; ++k) dst[m][k] = *(const PG8_LAS bf16x8*)(lds + PG8_SA(b, h) + aoffk[k] + m * 2048); } } while (0)
#define PG8_LDB(dst, b, h) do { if constexpr (F8) { _Pragma("unroll") for (int n = 0; n < 2; ++n) dst##8[n] = pg8_cat(*(const PG8_LAS bf16x8*)(lds + PG8_SB(b, h) + boffk[0] + n * 2048), *(const PG8_LAS bf16x8*)(lds + PG8_SB(b, h) + boffk[1] + n * 2048)); } \
        else { _Pragma("unroll") for (int n = 0; n < 2; ++n) _Pragma("unroll") for (int k = 0; k < 2; ++k) dst[n][k] = *(const PG8_LAS bf16x8*)(lds + PG8_SB(b, h) + boffk[k] + n * 2048); } } while (0)
#define PG8_MMA(ai, bj, At, Bt) do { __builtin_amdgcn_s_setprio(1); \
        if constexpr (F8) { _Pragma("unroll") for (int m = 0; m < 4; ++m) _Pragma("unroll") for (int n = 0; n < 2; ++n) \
            asm volatile("v_mfma_scale_f32_16x16x128_f8f6f4 %0, %1, %2, %0, %3, %4 op_sel_hi:[0,0,0]" : "+v"(acc[ai][bj][m][n]) : "v"(Bt##8[n]), "v"(At##8[m]), "v"(sc_w), "v"(sc_a)); } \
        else { _Pragma("unroll") for (int m = 0; m < 4; ++m) _Pragma("unroll") for (int n = 0; n < 2; ++n) _Pragma("unroll") for (int k = 0; k < 2; ++k) \
            acc[ai][bj][m][n] = __builtin_amdgcn_mfma_f32_16x16x32_bf16(Bt[n][k], At[m][k], acc[ai][bj][m][n], 0, 0, 0); } \
        __builtin_amdgcn_s_setprio(0); } while (0)
#define PG8_WAIT_V(n) asm volatile("s_waitcnt vmcnt(" #n ")" ::: "memory")
#define PG8_WAIT_L(n) asm volatile("s_waitcnt lgkmcnt(" #n ")" ::: "memory")
#define PG8_BAR __builtin_amdgcn_s_barrier()
#define PG8_SCHED __builtin_amdgcn_sched_barrier(0)
    Unit cur, nxt; int ui = 0;
    if (!S.next(0, cur)) return;
    f32x4 acc[2][2][4][2];
#pragma unroll
    for (int a = 0; a < 2; ++a)
#pragma unroll
        for (int b = 0; b < 2; ++b)
#pragma unroll
            for (int m = 0; m < 4; ++m)
#pragma unroll
                for (int n = 0; n < 2; ++n) acc[a][b][m][n] = (f32x4){0.f, 0.f, 0.f, 0.f};
    const int sc_w = 0x79797979, sc_a = 0x7f7f7f7f;
    bf16x8 At[4][2], B0[2][2], B1[2][2]; v8i32 At8[4], B08[2], B18[2];
    const char* cA = (const char*)g.A + (size_t)cur.pm * tstep; const char* cB = (const char*)g.Bt + (size_t)cur.pn * tstep;
    S.a_ready(cur);
    if constexpr (SP2) {
        PG8_STAGE(PG8_SB(0, 0), cB, voffB); PG8_STAGE(PG8_SB(0, 1), cB + hstep, voffB); PG8_STAGE(PG8_SA(0, 0), cA, voffA); PG8_STAGE(PG8_SA(0, 1), cA + hstep, voffA);
        if (wr == 1) PG8_BAR;
        PG8_WAIT_V(2); PG8_BAR;
        PG8_STAGE(PG8_SB(1, 0), cB + kstep, voffB); PG8_STAGE(PG8_SA(1, 0), cA + kstep, voffA); PG8_STAGE(PG8_SB(1, 1), cB + hstep + kstep, voffB);
        PG8_WAIT_V(6); PG8_BAR;
    } else {
        PG8_STAGE(PG8_SB(0, 0), cB, voffB); PG8_STAGE(PG8_SA(0, 0), cA, voffA); PG8_STAGE(PG8_SB(0, 1), cB + hstep, voffB); PG8_STAGE(PG8_SA(0, 1), cA + hstep, voffA);
        if (wr == 1) PG8_BAR;
        PG8_WAIT_V(4); PG8_BAR;
        PG8_STAGE(PG8_SB(1, 0), cB + kstep, voffB); PG8_STAGE(PG8_SA(1, 0), cA + kstep, voffA); PG8_STAGE(PG8_SB(1, 1), cB + hstep + kstep, voffB);
        PG8_WAIT_V(6); PG8_BAR;
    }
    for (;;) {
        const bool has_next = S.next(ui + 1, nxt);
        const char* nA = has_next ? (const char*)g.A + (size_t)nxt.pm * tstep : cA; const char* nB = has_next ? (const char*)g.Bt + (size_t)nxt.pn * tstep : cB;
        for (int t = 0; t < nt; t += 2) {
            const bool last = (t == nt - 2);
            const char* a1 = cA + (size_t)(t + 1) * kstep;
            const char* a2 = last ? nA : cA + (size_t)(t + 2) * kstep; const char* b2 = last ? nB : cB + (size_t)(t + 2) * kstep;
            const char* a3 = a2 + kstep; const char* b3 = b2 + kstep;
            if (last && has_next) S.a_ready(nxt);
            if constexpr (SP2) {
            PG8_LDB(B0, 0, 0); PG8_LDB(B1, 0, 1); PG8_SCHED; PG8_LDA(At, 0, 0); PG8_STAGE(PG8_SA(1, 1), a1 + hstep, voffA);
            PG8_WAIT_V(8); PG8_WAIT_L(0); PG8_BAR; PG8_MMA(0, 0, At, B0); PG8_MMA(0, 1, At, B1); PG8_BAR; PG8_SCHED;
            PG8_LDA(At, 0, 1); PG8_STAGE(PG8_SB(0, 0), b2, voffB); PG8_STAGE(PG8_SB(0, 1), b2 + hstep, voffB); PG8_STAGE(PG8_SA(0, 0), a2, voffA);
            PG8_WAIT_V(8); PG8_WAIT_L(0); PG8_BAR; PG8_MMA(1, 0, At, B0); PG8_MMA(1, 1, At, B1); PG8_BAR; PG8_SCHED;
            PG8_LDB(B0, 1, 0); PG8_LDB(B1, 1, 1); PG8_SCHED; PG8_LDA(At, 1, 0); PG8_STAGE(PG8_SA(0, 1), a2 + hstep, voffA);
            PG8_WAIT_V(8); PG8_WAIT_L(0); PG8_BAR; PG8_MMA(0, 0, At, B0); PG8_MMA(0, 1, At, B1); PG8_BAR; PG8_SCHED;
            PG8_LDA(At, 1, 1); PG8_STAGE(PG8_SB(1, 0), b3, voffB); PG8_STAGE(PG8_SB(1, 1), b3 + hstep, voffB); PG8_STAGE(PG8_SA(1, 0), a3, voffA);
            PG8_WAIT_V(8); PG8_WAIT_L(0); PG8_BAR; PG8_MMA(1, 0, At, B0); PG8_MMA(1, 1, At, B1); PG8_BAR; PG8_SCHED;
            } else {
            PG8_LDB(B0, 0, 0); PG8_SCHED; PG8_LDA(At, 0, 0); PG8_STAGE(PG8_SA(1, 1), a1 + hstep, voffA);
            PG8_WAIT_L(8); PG8_BAR; PG8_WAIT_L(0); PG8_MMA(0, 0, At, B0); PG8_BAR; PG8_SCHED;
            PG8_LDB(B1, 0, 1); PG8_STAGE(PG8_SB(0, 0), b2, voffB);
            PG8_BAR; PG8_WAIT_L(0); PG8_MMA(0, 1, At, B1); PG8_BAR;
            PG8_LDA(At, 0, 1); PG8_STAGE(PG8_SA(0, 0), a2, voffA);
            PG8_BAR; PG8_WAIT_L(0); PG8_MMA(1, 0, At, B0); PG8_BAR; PG8_SCHED;
            PG8_STAGE(PG8_SB(0, 1), b2 + hstep, voffB);
            PG8_WAIT_V(6); PG8_BAR; PG8_MMA(1, 1, At, B1); PG8_BAR;
            PG8_LDB(B0, 1, 0); PG8_SCHED; PG8_LDA(At, 1, 0); PG8_STAGE(PG8_SA(0, 1), a2 + hstep, voffA);
            PG8_WAIT_L(8); PG8_BAR; PG8_WAIT_L(0); PG8_MMA(0, 0, At, B0); PG8_BAR; PG8_SCHED;
            PG8_LDB(B1, 1, 1); PG8_STAGE(PG8_SB(1, 0), b3, voffB);
            PG8_BAR; PG8_WAIT_L(0); PG8_MMA(0, 1, At, B1); PG8_BAR;
            PG8_LDA(At, 1, 1); PG8_STAGE(PG8_SA(1, 0), a3, voffA);
            PG8_BAR; PG8_WAIT_L(0); PG8_MMA(1, 0, At, B0); PG8_BAR; PG8_SCHED;
            PG8_STAGE(PG8_SB(1, 1), b3 + hstep, voffB);
            PG8_WAIT_V(6); PG8_BAR; PG8_MMA(1, 1, At, B1); PG8_BAR;
            }
        }
        if constexpr (ALIGN_EPI) { if (wr == 0) PG8_BAR; }
        if constexpr (F8) asm volatile("s_nop 15\n\ts_nop 15" ::: "memory");
        if constexpr (!Epi::AFTER_DRAIN) { E(acc, cur, wr, wc, fr, fq); S.done(cur); }
        if (!has_next) break;
#pragma unroll
        for (int a = 0; a < 2; ++a)
#pragma unroll
            for (int b = 0; b < 2; ++b)
#pragma unroll
                for (int m = 0; m < 4; ++m)
#pragma unroll
                    for (int n = 0; n < 2; ++n) acc[a][b][m][n] = (f32x4){0.f, 0.f, 0.f, 0.f};
        cur = nxt; cA = nA; cB = nB; ++ui;
        if constexpr (ALIGN_EPI) { if (wr == 1) PG8_BAR; }
    }
    PG8_WAIT_V(0);
    if constexpr (!ALIGN_EPI) { if (wr == 0) PG8_BAR; }
    PG8_BAR;
    if constexpr (Epi::AFTER_DRAIN) { E.fused(acc, cur, wr, wc, fr, fq, lds, wid, lane); S.done(cur); }
#undef PG8_SA
#undef PG8_SB
#undef PG8_STAGE
#undef PG8_LDA
#undef PG8_LDB
#undef PG8_MMA
#undef PG8_WAIT_V
#undef PG8_WAIT_L
#undef PG8_BAR
#undef PG8_SCHED
}
}

constexpr int NWAVES = 8;
constexpr int TT = 16384, DM = 2048, SEQ = 2048;
constexpr int NPROJ = 11264;
constexpr int PC_Z = 0, PC_XBC = 2048, PC_Q = 5120, PC_K = 6144, PC_V = 7168, PC_O = 9216;
constexpr int WIN_LD = 11312;
constexpr int NSLOT = 65536 + 32 * 256;
constexpr float EPSF = 1e-5f;
#ifndef HSYNC_ON
#define HSYNC_ON 0
#endif
#define HWAIT() do { if (HSYNC_ON) asm volatile("s_waitcnt vmcnt(0) lgkmcnt(0)\n\ts_nop 15\n\ts_nop 15" ::: "memory"); } while (0)
#define HSYNC() do { if (HSYNC_ON) { HWAIT(); __syncthreads(); } } while (0)
#ifndef MK_PER_PHASE
#define MK_PER_PHASE 0
#endif
constexpr int N_PHASES = 11;

constexpr size_t MiB = 1u << 20;
constexpr size_t WS_CTL = 0, CTL_ZERO_BYTES = 1 * MiB;
constexpr size_t WS_WIN = 2 * MiB, WS_WSM = 46 * MiB, WS_WRT = 47 * MiB, WS_WOUT = 48 * MiB, WS_WGU = 64 * MiB, WS_WD = 576 * MiB;
constexpr size_t WS_XN1 = 832 * MiB, WS_PROJ = 896 * MiB, WS_SMALL = 1248 * MiB, WS_SSQ = 1252 * MiB, WS_YMIX = 1256 * MiB, WS_H2 = 1384 * MiB, WS_XN2 = 1512 * MiB;
constexpr size_t WS_ROUTE = 1576 * MiB, WS_XG = 1578 * MiB, WS_ACT = 1866 * MiB, WS_YR = 2154 * MiB, WS_XC = 2442 * MiB, WS_END = 2538 * MiB;
constexpr int CW_BAR = 4096;
constexpr int CW_CNT = 65536;

constexpr int RING_BYTES = 131072;
constexpr int LDS_BYTES = 147456;
constexpr int LDSCTL_OFF = LDS_BYTES - 576, MISC_OFF = LDSCTL_OFF;
constexpr int TAB_OFF = LDSCTL_OFF + 64;

#define GAS __attribute__((address_space(1)))
#define LAS __attribute__((address_space(3)))
typedef unsigned short bf16;
typedef unsigned v4u __attribute__((ext_vector_type(4)));
typedef unsigned v2u __attribute__((ext_vector_type(2)));
typedef float f32x4 __attribute__((ext_vector_type(4)));
typedef float f32x2 __attribute__((ext_vector_type(2)));
typedef short bf16x8 __attribute__((ext_vector_type(8)));
typedef GAS unsigned gu32;
#define RLX_AGENT __ATOMIC_RELAXED, __HIP_MEMORY_SCOPE_AGENT
#define LDS_WAIT() asm volatile("s_waitcnt lgkmcnt(0)" ::: "memory")
#define VM_WAIT() asm volatile("s_waitcnt vmcnt(0)" ::: "memory")
__device__ __forceinline__ unsigned f2bf(float f) { unsigned u = __builtin_bit_cast(unsigned, f); return (u + 0x7fffu + ((u >> 16) & 1u)) >> 16; }
__device__ __forceinline__ unsigned pk2(float lo, float hi) { return f2bf(lo) | (f2bf(hi) << 16); }
__device__ __forceinline__ float bflo(unsigned w) { return __builtin_bit_cast(float, w << 16); }
__device__ __forceinline__ float bfhi(unsigned w) { return __builtin_bit_cast(float, w & 0xffff0000u); }
__device__ __forceinline__ float wave_sum(float v) {
#pragma unroll
    for (int o = 1; o < 64; o <<= 1) v += __shfl_xor(v, o);
    return v;
}
__device__ __forceinline__ float softplusf(float x) { return x > 20.f ? x : log1pf(expf(x)); }
__device__ __forceinline__ float logsigf(float x) { return fminf(x, 0.f) - log1pf(expf(-fabsf(x))); }
__device__ __forceinline__ float siluf(float v) { return v / (1.0f + __expf(-v)); }

#define XB_TMO      128
#define XB_XCNT(j)  (256  + 64 * (j))
#define XB_XSUB(j)  (1280 + 64 * (j))
#define XB_XGEN(j)  (2304 + 64 * (j))
#define XB_TOP      3328
#define XB_TOPGEN   3392
#define XCD_BAR_WORDS 3456
#define XB_SPIN_CAP (1u << 18)

__device__ __forceinline__ unsigned xb_ld(unsigned* p)              { return __hip_atomic_load(p, __ATOMIC_RELAXED, __HIP_MEMORY_SCOPE_AGENT); }
__device__ __forceinline__ unsigned xb_add(unsigned* p, unsigned v) { return __hip_atomic_fetch_add(p, v, __ATOMIC_RELAXED, __HIP_MEMORY_SCOPE_AGENT); }
__device__ __forceinline__ unsigned xb_xcc_id() { return (unsigned)__builtin_amdgcn_s_getreg((3 << 11) | 20) & 0xFu; }
#define XB_SPIN(cond, bar) do { unsigned _sp = 0; while (cond) { __builtin_amdgcn_s_sleep(1); \
    if ((++_sp & 255u) == 0u) { if (xb_ld(&(bar)[XB_TMO])) break; if (_sp > XB_SPIN_CAP) { atomicAdd(&(bar)[XB_TMO], 1u); break; } } } } while (0)

struct XcdBarrier {
    unsigned* bar; unsigned x;
    volatile LAS unsigned* st;
};

__device__ __forceinline__ XcdBarrier xcd_barrier_post(unsigned* bar, volatile LAS unsigned* st) {
    XcdBarrier b; b.bar = bar; b.x = xb_xcc_id(); b.st = st;
    if (threadIdx.x == 0) (void)xb_add(&bar[XB_XCNT(b.x)], 1u);
    return b;
}
__device__ __forceinline__ void xcd_barrier_complete(unsigned* bar, unsigned x, unsigned& nloc, unsigned& nx) {
    const unsigned G = gridDim.x * gridDim.y * gridDim.z;
    unsigned sum, cnt, mine, sp = 0u;
    for (;;) {
        sum = 0u; cnt = 0u; mine = 0u;
#pragma unroll
        for (unsigned j = 0; j < 16; ++j) { const unsigned c = xb_ld(&bar[XB_XCNT(j)]); sum += c; cnt += (c > 0u) ? 1u : 0u; mine = (j == x) ? c : mine; }
        if (sum == G) break;
        __builtin_amdgcn_s_sleep(1);
        if ((++sp & 255u) == 0u) { if (xb_ld(&bar[XB_TMO])) break; if (sp > XB_SPIN_CAP) { atomicAdd(&bar[XB_TMO], 1u); break; } }
    }
    nloc = mine > 0u ? mine : 1u; nx = cnt > 0u ? cnt : 1u;
}

__device__ __forceinline__ void xcd_barrier(const XcdBarrier& b) {
    asm volatile("s_waitcnt vmcnt(0)" ::: "memory");
    __syncthreads();
    if (threadIdx.x == 0) {
        unsigned* bar = b.bar;
        __builtin_amdgcn_s_waitcnt(0);
        unsigned nloc = b.st[0], nx = b.st[1];
        if (nloc == 0u) { xcd_barrier_complete(bar, b.x, nloc, nx); b.st[0] = nloc; b.st[1] = nx; }
        const unsigned old = xb_add(&bar[XB_XSUB(b.x)], 1u);
        const unsigned gen = old / nloc;
        if (old + 1u == (gen + 1u) * nloc) {
            __builtin_amdgcn_fence(__ATOMIC_RELEASE, "agent");
            asm volatile("s_waitcnt vmcnt(0)" ::: "memory");
            const unsigned og = xb_add(&bar[XB_TOP], 1u);
            const unsigned tg = og / nx;
            if (og + 1u == (tg + 1u) * nx) xb_add(&bar[XB_TOPGEN], 1u);
            else XB_SPIN(xb_ld(&bar[XB_TOPGEN]) == tg, bar);
            __builtin_amdgcn_fence(__ATOMIC_ACQUIRE, "agent");
            xb_add(&bar[XB_XGEN(b.x)], 1u);
            asm volatile("s_waitcnt vmcnt(0)" ::: "memory");
        } else {
            XB_SPIN(xb_ld(&bar[XB_XGEN(b.x)]) == gen, bar);
            __builtin_amdgcn_fence(__ATOMIC_ACQUIRE, "agent");
            asm volatile("s_waitcnt vmcnt(0)" ::: "memory");
        }
    }
    __syncthreads();
}

struct Frame {
    LAS unsigned char* lds;
    volatile LAS unsigned* MISC;
    gu32* ctl;
    int tid, lane, wave, G, bid;
    const float *x, *norm1_w, *w_in, *conv_w, *conv_b, *dt_bias, *a_log, *d_skip, *ssd_norm_w, *i_bias, *f_bias, *ml_norm_w, *w_out, *norm2_w, *router_w, *router_b, *w_gate_up, *b_gate_up, *w_down, *b_down, *final_norm_w;
    float* out; unsigned char* ws;
};

__device__ __forceinline__ void p0_transpose_item(const float* W, int ldw, int K, bf16* WT, int dst_row0, int src_col0, int k0, LAS float* scr, int lane) {
#pragma unroll 8
    for (int i = 0; i < 32; ++i) { const int kk = 2 * i + (lane >> 5); scr[kk * 33 + (lane & 31)] = W[(size_t)(k0 + kk) * ldw + src_col0 + (lane & 31)]; }
    LDS_WAIT(); asm volatile("" ::: "memory");
    const int c = lane & 7;
#pragma unroll
    for (int j = 0; j < 4; ++j) { const int n = (lane >> 3) + 8 * j; const LAS float* s = scr + (8 * c) * 33 + n;
        v4u o; o.x = pk2(s[0 * 33], s[1 * 33]); o.y = pk2(s[2 * 33], s[3 * 33]); o.z = pk2(s[4 * 33], s[5 * 33]); o.w = pk2(s[6 * 33], s[7 * 33]);
        *(v4u*)(WT + (size_t)(dst_row0 + n) * K + k0 + 8 * c) = o; }
    LDS_WAIT(); asm volatile("" ::: "memory");
}
__device__ __forceinline__ void p0_transpose_item_f8(const float* W, int ldw, int K, unsigned char* WT, int dst_row0, int src_col0, int k0, LAS float* scr, int lane) {
#pragma unroll 8
    for (int i = 0; i < 32; ++i) { const int kk = 2 * i + (lane >> 5); scr[kk * 33 + (lane & 31)] = W[(size_t)(k0 + kk) * ldw + src_col0 + (lane & 31)] * 64.0f; }
    LDS_WAIT(); asm volatile("" ::: "memory");
    const int c = lane & 3;
#pragma unroll
    for (int j = 0; j < 2; ++j) { const int n = (lane >> 2) + 16 * j; const LAS float* s = scr + (16 * c) * 33 + n; int o[4];
#pragma unroll
        for (int q = 0; q < 4; ++q) { int w = __builtin_amdgcn_cvt_pk_fp8_f32(s[(4 * q) * 33], s[(4 * q + 1) * 33], 0, false); o[q] = __builtin_amdgcn_cvt_pk_fp8_f32(s[(4 * q + 2) * 33], s[(4 * q + 3) * 33], w, true); }
        *(v4u*)(WT + (size_t)(dst_row0 + n) * K + k0 + 16 * c) = (v4u){(unsigned)o[0], (unsigned)o[1], (unsigned)o[2], (unsigned)o[3]}; }
    LDS_WAIT(); asm volatile("" ::: "memory");
}
template <bool F8> __device__ __forceinline__ void p0_transpose128(const float* W, int ldw, int K, void* WTv, int dst_row0, int src_col0, int k0, LAS float* scr, int lane) {
    const float* src = W + (size_t)(k0 + (lane >> 3)) * ldw + src_col0 + 4 * (lane & 7);
    f32x4 v[16];
#pragma unroll
    for (int i = 0; i < 16; ++i) v[i] = *(const f32x4*)(src + (size_t)(8 * i) * ldw);
#pragma unroll
    for (int i = 0; i < 16; ++i) { LAS float* d = scr + (8 * i + (lane >> 3)) * 33 + 4 * (lane & 7); d[0] = v[i].x; d[1] = v[i].y; d[2] = v[i].z; d[3] = v[i].w; }
    LDS_WAIT(); asm volatile("" ::: "memory");
    const int n = lane & 31, hf = lane >> 5; const LAS float* s = scr + (64 * hf) * 33 + n;
    if (F8) { unsigned char* dst = (unsigned char*)WTv + (size_t)(dst_row0 + n) * K + k0 + 64 * hf;
#pragma unroll
        for (int j = 0; j < 4; ++j) { int o[4];
#pragma unroll
            for (int q = 0; q < 4; ++q) { const LAS float* p = s + (16 * j + 4 * q) * 33; int w = __builtin_amdgcn_cvt_pk_fp8_f32(p[0] * 64.0f, p[33] * 64.0f, 0, false); o[q] = __builtin_amdgcn_cvt_pk_fp8_f32(p[66] * 64.0f, p[99] * 64.0f, w, true); }
            *(v4u*)(dst + 16 * j) = (v4u){(unsigned)o[0], (unsigned)o[1], (unsigned)o[2], (unsigned)o[3]}; }
    } else { bf16* dst = (bf16*)WTv + (size_t)(dst_row0 + n) * K + k0 + 64 * hf;
#pragma unroll
        for (int j = 0; j < 8; ++j) { const LAS float* p = s + (8 * j) * 33;
            *(v4u*)(dst + 8 * j) = (v4u){pk2(p[0], p[33]), pk2(p[66], p[99]), pk2(p[132], p[165]), pk2(p[198], p[231])}; }
    }
    LDS_WAIT(); asm volatile("" ::: "memory");
}
__device__ __forceinline__ void rms_row_to_bf16(const float* xrow, const float* w, bf16* orow, int lane) {
    const f32x4* xr = (const f32x4*)xrow + lane; const f32x4* wr = (const f32x4*)w + lane;
    f32x4 v[8]; float s = 0.f;
#pragma unroll
    for (int j = 0; j < 8; ++j) { v[j] = xr[64 * j]; s += (v[j].x * v[j].x + v[j].y * v[j].y) + (v[j].z * v[j].z + v[j].w * v[j].w); }
    const float rstd = 1.0f / sqrtf(wave_sum(s) * (1.0f / 2048.0f) + EPSF);
    v2u* o8 = (v2u*)orow + lane;
#pragma unroll
    for (int j = 0; j < 8; ++j) { const f32x4 ww = wr[64 * j]; v2u o; o.x = pk2(v[j].x * rstd * ww.x, v[j].y * rstd * ww.y); o.y = pk2(v[j].z * rstd * ww.z, v[j].w * rstd * ww.w); o8[64 * j] = o; }
}
__device__ __forceinline__ void phase0(Frame& F) {
    LAS float* scr = (LAS float*)(F.lds + F.wave * 16896);
    const int gw = F.bid * NWAVES + F.wave, NGW = F.G * NWAVES;
    bf16* WinT = (bf16*)(F.ws + WS_WIN); bf16* WsT = (bf16*)(F.ws + WS_WSM); float* Wrt = (float*)(F.ws + WS_WRT); bf16* WoutT = (bf16*)(F.ws + WS_WOUT);
    unsigned char* WguT = (unsigned char*)(F.ws + WS_WGU); unsigned char* WdT = (unsigned char*)(F.ws + WS_WD); bf16* XN1 = (bf16*)(F.ws + WS_XN1);
    constexpr int I_IN = 16 * 352, I_OUT = 32 * 64, I_GU = 32 * 2048, I_D = 32 * 1024, NITEMS = I_IN + I_OUT + I_GU + I_D;
    for (int it = gw; it < NITEMS; it += NGW) {
        int r = it;
        if (r < I_IN) { const int kb = r / 352, nb = r % 352, n0 = nb * 32; p0_transpose128<false>(F.w_in, WIN_LD, 2048, WinT, n0, n0 + (n0 >= 5120 ? 32 : 0), kb * 128, scr, F.lane); continue; } r -= I_IN;
        if (r < I_OUT) { const int kb = r >> 6, nb = r & 63; p0_transpose128<false>(F.w_out, 2048, 4096, WoutT, nb * 32, nb * 32, kb * 128, scr, F.lane); continue; } r -= I_OUT;
        if (r < I_GU) { const int e = r >> 11, rr = r & 2047, kb = rr >> 7, nb = rr & 127; p0_transpose128<true>(F.w_gate_up + (size_t)e * 2048 * 4096, 4096, 2048, WguT + (size_t)e * 4096 * 2048, nb * 32, nb * 32, kb * 128, scr, F.lane); continue; } r -= I_GU;
        { const int e = r >> 10, rr = r & 1023, kb = rr >> 6, nb = rr & 63; p0_transpose128<true>(F.w_down + (size_t)e * 2048 * 2048, 2048, 2048, WdT + (size_t)e * 2048 * 2048, nb * 32, nb * 32, kb * 128, scr, F.lane); }
    }
    for (int i = gw * 64 + F.lane; i < 64 * 2048; i += NGW * 64) { const int j = i >> 11, k = i & 2047;
        const int col = j < 32 ? 5120 + j : (j < 40 ? 11296 + (j - 32) : 11304 + (j - 40));
        WsT[i] = (bf16)(j < 48 ? f2bf(F.w_in[(size_t)k * WIN_LD + col]) : 0u); }
    for (int i = gw * 64 + F.lane; i < 2048 * 32; i += NGW * 64) Wrt[i] = F.norm2_w[i >> 5] * F.router_w[i];
    for (int m = gw; m < TT; m += NGW) rms_row_to_bf16(F.x + (size_t)m * DM, F.norm1_w, XN1 + (size_t)m * DM, F.lane);
}

__device__ __forceinline__ void p1_small(Frame& F) {
    const bf16* XN1 = (const bf16*)(F.ws + WS_XN1); const bf16* WsT = (const bf16*)(F.ws + WS_WSM); float* SMALL = (float*)(F.ws + WS_SMALL);
    const int gw = F.bid * NWAVES + F.wave, NGW = F.G * NWAVES, fr = F.lane & 15, fq = F.lane >> 4;
    for (int task = gw; task < TT / 16; task += NGW) {
        const int t0 = task * 16;
        f32x4 acc[4];
#pragma unroll
        for (int n = 0; n < 4; ++n) acc[n] = (f32x4){0.f, 0.f, 0.f, 0.f};
        const bf16* arow = XN1 + (size_t)(t0 + fr) * DM + 8 * fq; const bf16* brow = WsT + (size_t)fr * DM + 8 * fq;
#pragma unroll 4
        for (int ks = 0; ks < 64; ++ks) {
            const bf16x8 a = *(const bf16x8*)(arow + 32 * ks);
#pragma unroll
            for (int n = 0; n < 4; ++n) { const bf16x8 b = *(const bf16x8*)(brow + (size_t)n * 16 * DM + 32 * ks); acc[n] = __builtin_amdgcn_mfma_f32_16x16x32_bf16(a, b, acc[n], 0, 0, 0); }
        }
#pragma unroll
        for (int n = 0; n < 4; ++n)
#pragma unroll
            for (int r = 0; r < 4; ++r) SMALL[(size_t)(t0 + 4 * fq + r) * 64 + n * 16 + fr] = acc[n][r];
    }
}

__device__ __forceinline__ void unpack8(const v4u r, float (&f)[8]) { f[0] = bflo(r.x); f[1] = bfhi(r.x); f[2] = bflo(r.y); f[3] = bfhi(r.y); f[4] = bflo(r.z); f[5] = bfhi(r.z); f[6] = bflo(r.w); f[7] = bfhi(r.w); }

__device__ __forceinline__ void phase_conv(Frame& F) {
    const bf16* PROJ = (const bf16*)(F.ws + WS_PROJ); bf16* XC = (bf16*)(F.ws + WS_XC);
    constexpr int TB = 32, NCG = 384, NIT = (TT / TB) * NCG;
    for (int it = F.bid * (NWAVES * 64) + F.tid; it < NIT; it += F.G * NWAVES * 64) {
        const int cg = it % NCG, tb = it / NCG, ch = cg * 8, t0 = tb * TB; const bool seq0 = (t0 % SEQ) == 0;
        float w[4][8], bs[8];
#pragma unroll
        for (int j = 0; j < 4; ++j) { const f32x4 a = *(const f32x4*)(F.conv_w + j * 3072 + ch), b = *(const f32x4*)(F.conv_w + j * 3072 + ch + 4);
            w[j][0] = a.x; w[j][1] = a.y; w[j][2] = a.z; w[j][3] = a.w; w[j][4] = b.x; w[j][5] = b.y; w[j][6] = b.z; w[j][7] = b.w; }
        { const f32x4 a = *(const f32x4*)(F.conv_b + ch), b = *(const f32x4*)(F.conv_b + ch + 4); bs[0] = a.x; bs[1] = a.y; bs[2] = a.z; bs[3] = a.w; bs[4] = b.x; bs[5] = b.y; bs[6] = b.z; bs[7] = b.w; }
        const bf16* src = PROJ + (size_t)t0 * NPROJ + PC_XBC + ch;
        float r0[8], r1[8], r2[8], r3[8];
        if (seq0) {
#pragma unroll
            for (int i = 0; i < 8; ++i) { r0[i] = 0.f; r1[i] = 0.f; r2[i] = 0.f; }
        } else { unpack8(*(const v4u*)(src - 3 * (size_t)NPROJ), r0); unpack8(*(const v4u*)(src - 2 * (size_t)NPROJ), r1); unpack8(*(const v4u*)(src - (size_t)NPROJ), r2); }
#pragma unroll 4
        for (int l = 0; l < TB; ++l) {
            unpack8(*(const v4u*)(src + (size_t)l * NPROJ), r3);
            float o[8];
#pragma unroll
            for (int i = 0; i < 8; ++i) { const float v = bs[i] + w[0][i] * r0[i] + w[1][i] * r1[i] + w[2][i] * r2[i] + w[3][i] * r3[i]; o[i] = siluf(v); r0[i] = r1[i]; r1[i] = r2[i]; r2[i] = r3[i]; }
            v4u ov; ov.x = pk2(o[0], o[1]); ov.y = pk2(o[2], o[3]); ov.z = pk2(o[4], o[5]); ov.w = pk2(o[6], o[7]);
            *(v4u*)(XC + (size_t)(t0 + l) * 3072 + ch) = ov;
        }
    }
}

constexpr int MX_PITCH = 272;
static_assert(true, "");
constexpr int MX_QM = 0, MX_KM = 34816, MX_KW = 69632, MX_VT = 104448, MX_SI = 121856, MX_VEC = 139264, MX_VECB = 3072, MX_NVEC = MX_VEC + 2 * MX_VECB, MX_SCAL = MX_NVEC + 512, MX_END = MX_SCAL + 64;
__device__ __forceinline__ unsigned cvt_pk_bf16_nop(float lo, float hi) { unsigned r; asm volatile("v_cvt_pk_bf16_f32 %0, %1, %2\n\ts_nop 1" : "=v"(r) : "v"(lo), "v"(hi)); return r; }
__device__ __forceinline__ int mx_sw(int row, int tbyte) { return row * MX_PITCH + ((((tbyte >> 4) ^ (row >> 3)) & 15) << 4) + (tbyte & 15); }
__device__ __forceinline__ bf16x8 lds_frag(const LAS unsigned char* img, int row, int kbyte) { return *(const LAS bf16x8*)(img + row * MX_PITCH + kbyte); }
static_assert(MX_END <= LDSCTL_OFF, "mixer LDS map");
template <bool ML> __device__ __forceinline__ void mixer_unit(Frame& F, int unit) {
    const bf16* PROJ = (const bf16*)(F.ws + WS_PROJ); const bf16* XC = (const bf16*)(F.ws + WS_XC); const float* SMALL = (const float*)(F.ws + WS_SMALL);
    bf16* YMIX = (bf16*)(F.ws + WS_YMIX); float* SSQ = (float*)(F.ws + WS_SSQ);
    const int w = F.wave, fr = F.lane & 15, fq = F.lane >> 4, tid = F.tid;
    const int b = unit >> 5, tok0 = b * SEQ, hd = unit & 31, grp = hd >> 3, mh = (unit & 31) >> 2, vq = unit & 3;
    const float qs = 0.08838834764831845f;
    LAS unsigned char* QM = F.lds + MX_QM; LAS unsigned char* KM = F.lds + MX_KM; LAS unsigned char* KW = F.lds + MX_KW; LAS unsigned char* VT = F.lds + MX_VT; LAS unsigned char* SI = F.lds + MX_SI;
    LAS float* exch = (LAS float*)(F.lds + MX_VEC + (w >> 2) * MX_VECB + 1024) + (w & 3) * 32;
    LAS float* nvec = (LAS float*)(F.lds + MX_NVEC); LAS float* scal = (LAS float*)(F.lds + MX_SCAL);
    const int fr3 = fr >> 3;
    int vtb[2];
#pragma unroll
    for (int p = 0; p < 2; ++p) vtb[p] = fr * MX_PITCH + ((fq ^ ((2 * p) | fr3)) << 4);
    int vpb[2][2];
#pragma unroll
    for (int p = 0; p < 2; ++p)
#pragma unroll
        for (int h = 0; h < 2; ++h) vpb[p][h] = fr * MX_PITCH + (((((fq >> 1) | (2 * h)) ^ ((2 * p) | fr3))) << 4) + 8 * (fq & 1);
    const int kwb = (16 * w + fr) * MX_PITCH + ((fq ^ ((2 * (w & 1)) | fr3)) << 4), kwh = w >> 1;

    const bf16* qsrc; const bf16* ksrc; const bf16* vsrc; int ld;
    if (ML) { qsrc = PROJ + PC_Q + mh * 128; ksrc = PROJ + PC_K + mh * 128; vsrc = PROJ + PC_V + mh * 256 + vq * 64; ld = NPROJ; }
    else { qsrc = XC + 2560 + grp * 128; ksrc = XC + 2048 + grp * 128; vsrc = XC + hd * 64; ld = 3072; }
    const float c_a = ML ? 0.f : -expf(F.a_log[hd]), c_dtb = ML ? 0.f : F.dt_bias[hd], c_D = ML ? 0.f : F.d_skip[hd], c_ib = ML ? F.i_bias[mh] : 0.f, c_fb = ML ? F.f_bias[mh] : 0.f;
    float mprev = 0.f;
    f32x4 sacc[4]; float nreg = 0.f;
#pragma unroll
    for (int j = 0; j < 4; ++j) sacc[j] = (f32x4){0.f, 0.f, 0.f, 0.f};
    v4u pq[4], pk[4], pv[2];
    float vA0 = 0.f, vA1 = 0.f, vB0 = 0.f, vB1 = 0.f, vC0 = 0.f, vC1 = 0.f, vD0 = 0.f, vD1 = 0.f, vE0 = 0.f, vE1 = 0.f, vG0 = 0.f, vG1 = 0.f, vSA = 0.f, vSG = 0.f;
    float sl0 = 0.f, sl1 = 0.f, sl2 = 0.f, sl3 = 0.f;
#define MX_SCAN_L(c) do { if (w == 0) { const size_t tt = (size_t)(tok0 + 128 * (c) + 2 * F.lane); \
        if (!ML) { sl0 = SMALL[tt * 64 + hd]; sl1 = SMALL[(tt + 1) * 64 + hd]; } \
        else { sl0 = SMALL[tt * 64 + 32 + mh]; sl1 = SMALL[(tt + 1) * 64 + 32 + mh]; sl2 = SMALL[tt * 64 + 40 + mh]; sl3 = SMALL[(tt + 1) * 64 + 40 + mh]; } } } while (0)
#define MX_SOFTPLUS(x) ((x) > 20.f ? (x) : __logf(1.0f + __expf(x)))
#define MX_LOGSIG(x) (fminf((x), 0.f) - __logf(1.0f + __expf(-fabsf(x))))
#define MX_SCAN_A(c) do { if (w == 0) { \
        if (!ML) { const float d0 = MX_SOFTPLUS(sl0 + c_dtb), d1 = MX_SOFTPLUS(sl1 + c_dtb); \
            const float x0 = d0 * c_a, x1 = d1 * c_a; float incl = x0 + x1; \
            _Pragma("unroll") for (int d = 1; d < 64; d <<= 1) { const float t_ = __shfl_up(incl, d); if (F.lane >= d) incl += t_; } \
            const float cum1 = incl, cum0 = incl - x1, tot = __shfl(incl, 63); \
            vA0 = -cum0; vA1 = -cum1; vB0 = -cum0; vB1 = -cum1; vC0 = d0; vC1 = d1; vD0 = __expf(cum0); vD1 = __expf(cum1); vE0 = d0 * __expf(tot - cum0); vE1 = d1 * __expf(tot - cum1); vSA = __expf(tot); vSG = 1.0f; \
        } else { const float li0 = sl0 + c_ib, li1 = sl1 + c_ib; \
            const float x0 = MX_LOGSIG(sl2 + c_fb), x1 = MX_LOGSIG(sl3 + c_fb); float incl = x0 + x1; \
            _Pragma("unroll") for (int d = 1; d < 64; d <<= 1) { const float t_ = __shfl_up(incl, d); if (F.lane >= d) incl += t_; } \
            const float cum1 = incl, cum0 = incl - x1, btot = __shfl(incl, 63); \
            const float dd0 = li0 - cum0, dd1 = li1 - cum1; float im = fmaxf(dd0, dd1); \
            _Pragma("unroll") for (int d = 1; d < 64; d <<= 1) { const float t_ = __shfl_up(im, d); if (F.lane >= d) im = fmaxf(im, t_); } \
            float pm = __shfl_up(im, 1); if (F.lane == 0) pm = -3.0e38f; const float pmax0 = fmaxf(pm, dd0), pmax1 = im, pm127 = __shfl(im, 63); \
            const float M0 = fmaxf(mprev, pmax0), M1 = fmaxf(mprev, pmax1); \
            vA0 = dd0; vA1 = dd1; vB0 = M0; vB1 = M1; vD0 = qs * __expf(mprev - M0); vD1 = qs * __expf(mprev - M1); vG0 = __expf(-(cum0 + M0)); vG1 = __expf(-(cum1 + M1)); \
            const float mloc = btot + pm127, mnew = fmaxf(btot + mprev, mloc); \
            vSA = __expf(btot + mprev - mnew); vSG = __expf(mloc - mnew); vE0 = __expf(dd0 - pm127) * vSG; vE1 = __expf(dd1 - pm127) * vSG; mprev = mnew; } } } while (0)
#define MX_SCAN_B(c) do { if (w == 0) { \
        LAS float* vb = (LAS float*)(F.lds + MX_VEC + ((c) & 1) * MX_VECB); const int l0 = 2 * F.lane; \
        *(LAS f32x2*)(vb + l0) = (f32x2){vA0, vA1}; *(LAS f32x2*)(vb + 128 + l0) = (f32x2){vB0, vB1}; if (!ML) *(LAS f32x2*)(vb + 256 + l0) = (f32x2){vC0, vC1}; \
        *(LAS f32x2*)(vb + 384 + l0) = (f32x2){vD0, vD1}; *(LAS f32x2*)(vb + 512 + l0) = (f32x2){vE0, vE1}; if (ML) *(LAS f32x2*)(vb + 640 + l0) = (f32x2){vG0, vG1}; \
        if (F.lane == 0) { scal[2 * ((c) & 1)] = vSA; scal[2 * ((c) & 1) + 1] = vSG; } } } while (0)
#define MX_SCAN(c) do { MX_SCAN_L(c); MX_SCAN_A(c); MX_SCAN_B(c); } while (0)
#define MX_PREFETCH(c) do { const size_t tb_ = (size_t)(tok0 + 128 * (c)); \
        _Pragma("unroll") for (int i = 0; i < 2; ++i) { const int pid = tid + 512 * i, a2 = pid >> 4, k8 = pid & 15; \
            pq[2 * i] = *(const v4u*)(qsrc + (tb_ + 2 * a2) * ld + 8 * k8); pq[2 * i + 1] = *(const v4u*)(qsrc + (tb_ + 2 * a2 + 1) * ld + 8 * k8); \
            pk[2 * i] = *(const v4u*)(ksrc + (tb_ + 2 * a2) * ld + 8 * k8); pk[2 * i + 1] = *(const v4u*)(ksrc + (tb_ + 2 * a2 + 1) * ld + 8 * k8); } \
        { const int a2 = tid >> 3, v8 = tid & 7; pv[0] = *(const v4u*)(vsrc + (tb_ + 2 * a2) * ld + 8 * v8); pv[1] = *(const v4u*)(vsrc + (tb_ + 2 * a2 + 1) * ld + 8 * v8); } } while (0)
#define MX_WRITE(c) do { const LAS float* vb = (const LAS float*)(F.lds + MX_VEC + ((c) & 1) * MX_VECB); \
        _Pragma("unroll") for (int i = 0; i < 2; ++i) { const int pid = tid + 512 * i, a2 = pid >> 4, k8 = pid & 15, l = 2 * a2; \
            *(LAS v4u*)(QM + l * MX_PITCH + 16 * k8) = pq[2 * i]; *(LAS v4u*)(QM + (l + 1) * MX_PITCH + 16 * k8) = pq[2 * i + 1]; \
            *(LAS v4u*)(KM + l * MX_PITCH + 16 * k8) = pk[2 * i]; *(LAS v4u*)(KM + (l + 1) * MX_PITCH + 16 * k8) = pk[2 * i + 1]; \
            float f0[8], f1[8]; unpack8(pk[2 * i], f0); unpack8(pk[2 * i + 1], f1); const f32x2 wl = *(const LAS f32x2*)(vb + 512 + l); \
            _Pragma("unroll") for (int e = 0; e < 8; ++e) *(LAS unsigned*)(KW + mx_sw(8 * k8 + e, 2 * l)) = pg8::cvt_pk_bf16(f0[e] * wl.x, f1[e] * wl.y); } \
        { const int a2 = tid >> 3, v8 = tid & 7, l = 2 * a2; const v4u r0 = pv[0], r1 = pv[1]; LAS unsigned char* vp_ = VT + mx_sw(8 * v8, 2 * l); \
            *(LAS unsigned*)(vp_ + 0 * MX_PITCH) = (r0.x & 0xffffu) | (r1.x << 16); *(LAS unsigned*)(vp_ + 1 * MX_PITCH) = (r0.x >> 16) | (r1.x & 0xffff0000u); \
            *(LAS unsigned*)(vp_ + 2 * MX_PITCH) = (r0.y & 0xffffu) | (r1.y << 16); *(LAS unsigned*)(vp_ + 3 * MX_PITCH) = (r0.y >> 16) | (r1.y & 0xffff0000u); \
            *(LAS unsigned*)(vp_ + 4 * MX_PITCH) = (r0.z & 0xffffu) | (r1.z << 16); *(LAS unsigned*)(vp_ + 5 * MX_PITCH) = (r0.z >> 16) | (r1.z & 0xffff0000u); \
            *(LAS unsigned*)(vp_ + 6 * MX_PITCH) = (r0.w & 0xffffu) | (r1.w << 16); *(LAS unsigned*)(vp_ + 7 * MX_PITCH) = (r0.w >> 16) | (r1.w & 0xffff0000u); } \
        _Pragma("unroll") for (int j = 0; j < 4; ++j) { v2u sv; sv.x = pg8::cvt_pk_bf16(sacc[j][0], sacc[j][1]); sv.y = pg8::cvt_pk_bf16(sacc[j][2], sacc[j][3]); *(LAS v2u*)(SI + (16 * j + fr) * MX_PITCH + (16 * w + 4 * fq) * 2) = sv; } \
        if (ML && fq == 0) nvec[16 * w + fr] = nreg; } while (0)
    v4u zc0 = (v4u){0u, 0u, 0u, 0u}, zc1 = zc0;
    if (!ML) { const bf16* zp = PROJ + (size_t)(tok0 + 16 * w + (F.lane >> 2)) * NPROJ + PC_Z + hd * 64 + 16 * (F.lane & 3); zc0 = *(const v4u*)zp; zc1 = *(const v4u*)(zp + 8); }
    MX_SCAN(0);
    MX_PREFETCH(0);
    __syncthreads();
    MX_WRITE(0);
    __syncthreads();
    for (int c = 0; c < SEQ / 128; ++c) {
        const LAS float* vb = (const LAS float*)(F.lds + MX_VEC + (c & 1) * MX_VECB);
        const bool more = (c + 1 < SEQ / 128);
        if (more) { MX_SCAN_L(c + 1); MX_PREFETCH(c + 1); }
        bf16x8 qf[4];
#pragma unroll
        for (int ks = 0; ks < 4; ++ks) qf[ks] = lds_frag(QM, 16 * w + fr, 64 * ks + 16 * fq);
        const float mlv = vb[128 + 16 * w + fr];
        float dsum = 0.f;
        f32x4 y1[4];
#pragma unroll
        for (int j = 0; j < 4; ++j) y1[j] = (f32x4){0.f, 0.f, 0.f, 0.f};
        const f32x4 rs4 = *(const LAS f32x4*)(vb + 384 + 16 * w + 4 * fq);
#pragma unroll
        for (int ks = 0; ks < 4; ++ks) { bf16x8 sf[4];
#pragma unroll
            for (int j = 0; j < 4; ++j) sf[j] = lds_frag(SI, 16 * j + fr, 64 * ks + 16 * fq);
#pragma unroll
            for (int j = 0; j < 4; ++j) y1[j] = __builtin_amdgcn_mfma_f32_16x16x32_bf16(qf[ks], sf[j], y1[j], 0, 0, 0); }
#pragma unroll
        for (int j = 0; j < 4; ++j) y1[j] = y1[j] * rs4;
        __builtin_amdgcn_sched_barrier(0);
#pragma unroll 1
        for (int k2 = 0; 2 * k2 <= w; ++k2) {
            unsigned pw[4];
#pragma unroll
            for (int h = 0; h < 2; ++h) {
                const int si = 2 * k2 + h;
                f32x4 acc = (f32x4){0.f, 0.f, 0.f, 0.f};
#pragma unroll
                for (int ks = 0; ks < 4; ++ks) acc = __builtin_amdgcn_mfma_f32_16x16x32_bf16(lds_frag(KM, 16 * si + fr, 64 * ks + 16 * fq), qf[ks], acc, 0, 0, 0);
                const f32x4 e4 = *(const LAS f32x4*)(vb + 16 * si + 4 * fq); f32x4 x4 = (f32x4){qs, qs, qs, qs}; if (!ML) x4 = *(const LAS f32x4*)(vb + 256 + 16 * si + 4 * fq);
                float p[4];
#pragma unroll
                for (int r = 0; r < 4; ++r) { const float v = acc[r] * __expf(e4[r] - mlv) * x4[r]; const bool ok = (si < w) || (si == w && 4 * fq + r <= fr); p[r] = ok ? v : 0.f; }
                if (ML) dsum += (p[0] + p[1]) + (p[2] + p[3]);
                pw[2 * h] = cvt_pk_bf16_nop(p[0], p[1]); pw[2 * h + 1] = cvt_pk_bf16_nop(p[2], p[3]);
            }
            HWAIT();
            const v4u pwv = (v4u){pw[0], pw[1], pw[2], pw[3]}; const bf16x8 pf = __builtin_bit_cast(bf16x8, pwv);
#pragma unroll
            for (int j = 0; j < 4; ++j) { const int ho = j * 16 * MX_PITCH + ((k2 ^ (j >> 1)) << 6); const v2u lo = *(const LAS v2u*)(VT + vpb[j & 1][0] + ho), hi = *(const LAS v2u*)(VT + vpb[j & 1][1] + ho); const v4u vw = (v4u){lo.x, lo.y, hi.x, hi.y};
                y1[j] = __builtin_amdgcn_mfma_f32_16x16x32_bf16(pf, __builtin_bit_cast(bf16x8, vw), y1[j], 0, 0, 0); }
            HWAIT();
        }
        HSYNC();
        __builtin_amdgcn_sched_barrier(0);
        __builtin_amdgcn_sched_barrier(0);
        if (ML) {
            dsum += __shfl_xor(dsum, 16); dsum += __shfl_xor(dsum, 32);
            float d2 = 0.f;
#pragma unroll
            for (int ks = 0; ks < 4; ++ks) { float qv[8]; unpack8(__builtin_bit_cast(v4u, qf[ks]), qv); const f32x4 n0 = *(const LAS f32x4*)(nvec + 32 * ks + 8 * fq), n1 = *(const LAS f32x4*)(nvec + 32 * ks + 8 * fq + 4);
                d2 += qv[0] * n0.x + qv[1] * n0.y + qv[2] * n0.z + qv[3] * n0.w + qv[4] * n1.x + qv[5] * n1.y + qv[6] * n1.z + qv[7] * n1.w; }
            d2 += __shfl_xor(d2, 16); d2 += __shfl_xor(d2, 32);
            if (fq == 0) { exch[fr] = dsum; exch[16 + fr] = d2; }
        }
        HSYNC();
        __builtin_amdgcn_sched_barrier(0);
        LAS float* stg = (LAS float*)(QM + 16 * w * MX_PITCH);
        if (ML) { const f32x4 fl4 = *(const LAS f32x4*)(vb + 640 + 16 * w + 4 * fq); const f32x4 dA = *(const LAS f32x4*)(exch + 4 * fq), dB = *(const LAS f32x4*)(exch + 16 + 4 * fq);
#pragma unroll
            for (int r = 0; r < 4; ++r) { const float den = fmaxf(fabsf(dA[r] + rs4[r] * dB[r]), fl4[r]); const float inv = __builtin_amdgcn_rcpf(den);
#pragma unroll
                for (int j = 0; j < 4; ++j) stg[(4 * fq + r) * 68 + 16 * j + fr] = y1[j][r] * inv; }
        } else {
#pragma unroll
            for (int j = 0; j < 4; ++j) { const v2u xw = *(const LAS v2u*)(VT + mx_sw(16 * j + fr, 32 * w + 8 * fq)); const float xs[4] = {bflo(xw.x), bfhi(xw.x), bflo(xw.y), bfhi(xw.y)};
#pragma unroll
                for (int r = 0; r < 4; ++r) stg[(4 * fq + r) * 68 + 16 * j + fr] = y1[j][r] + c_D * xs[r]; }
        }
        {   const int erow = F.lane >> 2, ecs = F.lane & 3; const size_t trow = (size_t)(tok0 + 128 * c + 16 * w + erow);
            float yv[16];
#pragma unroll
            for (int i = 0; i < 4; ++i) { const f32x4 t4 = *(const LAS f32x4*)(stg + erow * 68 + 16 * ecs + 4 * i); yv[4 * i] = t4.x; yv[4 * i + 1] = t4.y; yv[4 * i + 2] = t4.z; yv[4 * i + 3] = t4.w; }
            if (!ML) { float zf[16]; { float t8[8]; unpack8(zc0, t8);
#pragma unroll
                    for (int i = 0; i < 8; ++i) zf[i] = t8[i]; unpack8(zc1, t8);
#pragma unroll
                    for (int i = 0; i < 8; ++i) zf[8 + i] = t8[i]; }
#pragma unroll
                for (int i = 0; i < 16; ++i) yv[i] = yv[i] * zf[i] * __builtin_amdgcn_rcpf(1.0f + __expf(-zf[i])); }
            float ss = 0.f;
#pragma unroll
            for (int i = 0; i < 16; ++i) ss += yv[i] * yv[i];
            ss += __shfl_xor(ss, 1); ss += __shfl_xor(ss, 2);
            if (ecs == 0) SSQ[(ML ? (size_t)TT * 32 : 0) + trow * 32 + (ML ? mh * 4 + vq : hd)] = ss;
            bf16* yp = YMIX + trow * 4096 + (ML ? 2048 + mh * 256 + vq * 64 : hd * 64) + 16 * ecs;
            *(v4u*)yp = (v4u){pg8::cvt_pk_bf16(yv[0], yv[1]), pg8::cvt_pk_bf16(yv[2], yv[3]), pg8::cvt_pk_bf16(yv[4], yv[5]), pg8::cvt_pk_bf16(yv[6], yv[7])};
            *(v4u*)(yp + 8) = (v4u){pg8::cvt_pk_bf16(yv[8], yv[9]), pg8::cvt_pk_bf16(yv[10], yv[11]), pg8::cvt_pk_bf16(yv[12], yv[13]), pg8::cvt_pk_bf16(yv[14], yv[15])};
            if (!ML && more) { const bf16* zp = PROJ + (size_t)(tok0 + 128 * (c + 1) + 16 * w + (F.lane >> 2)) * NPROJ + PC_Z + hd * 64 + 16 * (F.lane & 3); zc0 = *(const v4u*)zp; zc1 = *(const v4u*)(zp + 8); }
        }
        __builtin_amdgcn_sched_barrier(0);
        const float sa = scal[2 * (c & 1)];
#pragma unroll
        for (int j = 0; j < 4; ++j) sacc[j] = sacc[j] * sa;
        float nsum = 0.f;
#pragma unroll
        for (int ks = 0; ks < 4; ++ks) { const bf16x8 kf = *(const LAS bf16x8*)(KW + kwb + ((ks ^ kwh) << 6)); bf16x8 vf[4];
#pragma unroll
            for (int j = 0; j < 4; ++j) vf[j] = *(const LAS bf16x8*)(VT + vtb[j & 1] + j * 16 * MX_PITCH + ((ks ^ (j >> 1)) << 6));
            if (ML) { float kv[8]; unpack8(__builtin_bit_cast(v4u, kf), kv); nsum += ((kv[0] + kv[1]) + (kv[2] + kv[3])) + ((kv[4] + kv[5]) + (kv[6] + kv[7])); }
#pragma unroll
            for (int j = 0; j < 4; ++j) sacc[j] = __builtin_amdgcn_mfma_f32_16x16x32_bf16(kf, vf[j], sacc[j], 0, 0, 0); }
        if (ML) { nsum += __shfl_xor(nsum, 16); nsum += __shfl_xor(nsum, 32); nreg = nreg * sa + nsum; }
        if (more) { MX_SCAN_A(c + 1); }
        __syncthreads();
        if (more) { MX_SCAN_B(c + 1); }
        __syncthreads();
        if (more) { MX_WRITE(c + 1); }
        __syncthreads();
    }
#undef MX_SCAN
#undef MX_SCAN_A
#undef MX_SCAN_L
#undef MX_SOFTPLUS
#undef MX_LOGSIG
#undef MX_SCAN_B
#undef MX_PREFETCH
#undef MX_WRITE
}
__device__ __forceinline__ void phase_mixer(Frame& F) {
    for (int unit = F.bid; unit < 256; unit += F.G) { mixer_unit<false>(F, unit); mixer_unit<true>(F, unit); }
}

__device__ __forceinline__ void phase3(Frame& F) {
    const bf16* PROJ = (const bf16*)(F.ws + WS_PROJ); bf16* YMIX = (bf16*)(F.ws + WS_YMIX); const float* SSQ = (const float*)(F.ws + WS_SSQ);
    const int gw = F.bid * NWAVES + F.wave, NGW = F.G * NWAVES;
    for (int t = gw; t < TT; t += NGW) {
        bf16* yrow = YMIX + (size_t)t * 4096;
#pragma unroll
        for (int j = 0; j < 8; ++j) {
            const int c0 = (j * 64 + F.lane) * 8;
            float y[8]; unpack8(*(const v4u*)(yrow + c0), y);
            float o[8];
            if (j < 4) {
                const int g = c0 >> 9; const f32x4 s0 = *(const f32x4*)(SSQ + (size_t)t * 32 + g * 8), s1 = *(const f32x4*)(SSQ + (size_t)t * 32 + g * 8 + 4);
                const float ms = ((s0.x + s0.y) + (s0.z + s0.w) + (s1.x + s1.y) + (s1.z + s1.w)) * (1.0f / 512.0f);
                const float rs = 1.0f / sqrtf(ms + EPSF);
                const f32x4 w0 = *(const f32x4*)(F.ssd_norm_w + c0), w1 = *(const f32x4*)(F.ssd_norm_w + c0 + 4);
                o[0] = y[0] * rs * w0.x; o[1] = y[1] * rs * w0.y; o[2] = y[2] * rs * w0.z; o[3] = y[3] * rs * w0.w;
                o[4] = y[4] * rs * w1.x; o[5] = y[5] * rs * w1.y; o[6] = y[6] * rs * w1.z; o[7] = y[7] * rs * w1.w;
            } else {
                const int cc = c0 - 2048, h = cc >> 8; const f32x4 s0 = *(const f32x4*)(SSQ + (size_t)TT * 32 + (size_t)t * 32 + h * 4);
                const float ms = ((s0.x + s0.y) + (s0.z + s0.w)) * (1.0f / 256.0f);
                const float rs = 1.0f / sqrtf(ms + EPSF);
                const f32x4 w0 = *(const f32x4*)(F.ml_norm_w + cc), w1 = *(const f32x4*)(F.ml_norm_w + cc + 4);
                float og[8]; unpack8(*(const v4u*)(PROJ + (size_t)t * NPROJ + PC_O + cc), og);
                const float wv[8] = {w0.x, w0.y, w0.z, w0.w, w1.x, w1.y, w1.z, w1.w};
#pragma unroll
                for (int i = 0; i < 8; ++i) o[i] = y[i] * rs * wv[i] * (1.0f / (1.0f + __expf(-og[i])));
            }
            v4u ov; ov.x = pk2(o[0], o[1]); ov.y = pk2(o[2], o[3]); ov.z = pk2(o[4], o[5]); ov.w = pk2(o[6], o[7]);
            *(v4u*)(yrow + c0) = ov;
        }
    }
}

__device__ __forceinline__ void phase5(Frame& F) {
    const float* H2 = (const float*)(F.ws + WS_H2); const float* Wrt = (const float*)(F.ws + WS_WRT); bf16* XN2 = (bf16*)(F.ws + WS_XN2);
    int* EIDX = (int*)(F.ws + WS_ROUTE); int* RANK = EIDX + TT * 4; float* GATE = (float*)(RANK + TT * 4);
    LAS float* xT = (LAS float*)(F.lds + F.wave * 8192); LAS float* lg = (LAS float*)(F.lds + 65536 + F.wave * 1024);
    LAS int* cntl = (LAS int*)(F.lds + 73728); LAS int* baseg = cntl + 32;
    const int gw = F.bid * NWAVES + F.wave, NGW = F.G * NWAVES, ntask = TT / 8, iters = (ntask + NGW - 1) / NGW;
    for (int itx = 0; itx < iters; ++itx) {
        const int task = itx * NGW + gw; const bool valid = task < ntask; const int t0 = task * 8;
        if (F.tid < 32) cntl[F.tid] = 0;
        __syncthreads();
        float rstd[8]; int me[4] = {0, 0, 0, 0}, mr[4] = {0, 0, 0, 0}; float mg[4] = {0.f, 0.f, 0.f, 0.f};
#pragma unroll
        for (int k = 0; k < 8; ++k) rstd[k] = 0.f;
        if (valid) {
            float acc[8], ssq[8];
#pragma unroll
            for (int k = 0; k < 8; ++k) { acc[k] = 0.f; ssq[k] = 0.f; }
            const int e = F.lane & 31, dh = F.lane >> 5;
            for (int dc = 0; dc < 8; ++dc) {
#pragma unroll
                for (int jj = 0; jj < 4; ++jj) { float xv[8];
#pragma unroll
                    for (int k = 0; k < 8; ++k) { xv[k] = H2[(size_t)(t0 + k) * DM + dc * 256 + jj * 64 + F.lane]; ssq[k] += xv[k] * xv[k]; }
                    LAS float* dp = xT + (jj * 64 + F.lane) * 8; *(LAS f32x4*)dp = (f32x4){xv[0], xv[1], xv[2], xv[3]}; *(LAS f32x4*)(dp + 4) = (f32x4){xv[4], xv[5], xv[6], xv[7]}; }
                LDS_WAIT(); asm volatile("" ::: "memory");
                const float* wp = Wrt + (size_t)(dc * 256 + dh * 128) * 32 + e; const LAS float* xp = xT + dh * 128 * 8;
#pragma unroll 4
                for (int i = 0; i < 128; ++i) { const float w = wp[i * 32]; const f32x4 xa = *(const LAS f32x4*)(xp + i * 8), xb = *(const LAS f32x4*)(xp + i * 8 + 4);
                    acc[0] += w * xa.x; acc[1] += w * xa.y; acc[2] += w * xa.z; acc[3] += w * xa.w; acc[4] += w * xb.x; acc[5] += w * xb.y; acc[6] += w * xb.z; acc[7] += w * xb.w; }
                LDS_WAIT(); asm volatile("" ::: "memory");
            }
            const float rb = F.router_b[e];
#pragma unroll
            for (int k = 0; k < 8; ++k) { rstd[k] = 1.0f / sqrtf(wave_sum(ssq[k]) * (1.0f / 2048.0f) + EPSF);
                const float v = (acc[k] + __shfl_xor(acc[k], 32)) * rstd[k] + rb; if (F.lane < 32) lg[k * 32 + e] = v; }
            LDS_WAIT(); asm volatile("" ::: "memory");
            if (F.lane < 8) {
                const LAS float* lp = lg + F.lane * 32; float bv[4]; int bi[4] = {-1, -1, -1, -1};
#pragma unroll
                for (int p = 0; p < 4; ++p) { float best = -3.0e38f; int bidx = 0;
                    for (int q = 0; q < 32; ++q) { const float v = lp[q]; const bool taken = (q == bi[0]) | (q == bi[1]) | (q == bi[2]) | (q == bi[3]); if (!taken && v > best) { best = v; bidx = q; } }
                    bv[p] = best; bi[p] = bidx; }
                const float p1 = expf(bv[1] - bv[0]), p2 = expf(bv[2] - bv[0]), p3 = expf(bv[3] - bv[0]); const float inv = 1.0f / (1.0f + p1 + p2 + p3);
                mg[0] = inv; mg[1] = p1 * inv; mg[2] = p2 * inv; mg[3] = p3 * inv;
#pragma unroll
                for (int p = 0; p < 4; ++p) { me[p] = bi[p]; mr[p] = __hip_atomic_fetch_add(cntl + bi[p], 1, __ATOMIC_RELAXED, __HIP_MEMORY_SCOPE_WORKGROUP); }
            }
        }
        __syncthreads();
        if (F.tid < 32) { const int c = cntl[F.tid]; int gb = 0; if (c > 0) gb = (int)__hip_atomic_fetch_add((unsigned*)(F.ctl + CW_CNT + 64 * F.tid), (unsigned)c, RLX_AGENT); baseg[F.tid] = gb; }
        __syncthreads();
        if (valid) {
            if (F.lane < 8) { const size_t t = (size_t)(t0 + F.lane);
#pragma unroll
                for (int p = 0; p < 4; ++p) { EIDX[t * 4 + p] = me[p]; RANK[t * 4 + p] = baseg[me[p]] + mr[p]; GATE[t * 4 + p] = mg[p]; } }
#pragma unroll
            for (int k = 0; k < 8; ++k) { const f32x4* xr = (const f32x4*)(H2 + (size_t)(t0 + k) * DM) + F.lane; const f32x4* wr = (const f32x4*)F.norm2_w + F.lane; int* o4 = (int*)((unsigned char*)XN2 + (size_t)(t0 + k) * DM) + F.lane;
#pragma unroll
                for (int j = 0; j < 8; ++j) { const f32x4 v = xr[64 * j], ww = wr[64 * j]; int o = __builtin_amdgcn_cvt_pk_fp8_f32(v.x * rstd[k] * ww.x, v.y * rstd[k] * ww.y, 0, false); o = __builtin_amdgcn_cvt_pk_fp8_f32(v.z * rstd[k] * ww.z, v.w * rstd[k] * ww.w, o, true); o4[64 * j] = o; } }
        }
        __syncthreads();
    }
}
__device__ __forceinline__ void phase5b(Frame& F) {
    const bf16* XN2 = (const bf16*)(F.ws + WS_XN2); bf16* XG = (bf16*)(F.ws + WS_XG);
    const int* EIDX = (const int*)(F.ws + WS_ROUTE); const int* RANK = EIDX + TT * 4; const float* GATE = (const float*)(RANK + TT * 4); int* SLOT = (int*)(GATE + TT * 4); float* SGATE = (float*)(SLOT + TT * 4);
    LAS int* sbase = (LAS int*)(F.lds); LAS int* spad = sbase + 32;
    if (F.tid < 32) { const int c = (int)__hip_atomic_load((unsigned*)(F.ctl + CW_CNT + 64 * F.tid), RLX_AGENT); spad[F.tid] = (c + 255) & ~255; }
    __syncthreads();
    if (F.tid == 0) { int a = 0; for (int e = 0; e < 32; ++e) { sbase[e] = a; a += spad[e]; } }
    __syncthreads();
    const int gw = F.bid * NWAVES + F.wave, NGW = F.G * NWAVES;
    for (int task = gw; task < TT / 8; task += NGW) {
#pragma unroll 2
        for (int k = 0; k < 8; ++k) { const size_t t = (size_t)task * 8 + k;
            int slot = 0;
            if (F.lane < 4) { const int e = EIDX[t * 4 + F.lane]; slot = sbase[e] + RANK[t * 4 + F.lane]; SLOT[t * 4 + F.lane] = slot; SGATE[slot] = GATE[t * 4 + F.lane]; }
            const int s0 = __shfl(slot, 0), s1 = __shfl(slot, 1), s2 = __shfl(slot, 2), s3 = __shfl(slot, 3);
            const v4u* src = (const v4u*)((const unsigned char*)XN2 + t * DM) + F.lane; v4u d[2];
#pragma unroll
            for (int j = 0; j < 2; ++j) d[j] = src[64 * j];
            v4u* d0 = (v4u*)((unsigned char*)XG + (size_t)s0 * DM) + F.lane; v4u* d1 = (v4u*)((unsigned char*)XG + (size_t)s1 * DM) + F.lane; v4u* d2 = (v4u*)((unsigned char*)XG + (size_t)s2 * DM) + F.lane; v4u* d3 = (v4u*)((unsigned char*)XG + (size_t)s3 * DM) + F.lane;
#pragma unroll
            for (int j = 0; j < 2; ++j) { d0[64 * j] = d[j]; d1[64 * j] = d[j]; d2[64 * j] = d[j]; d3[64 * j] = d[j]; }
        }
    }
}
__device__ __forceinline__ int build_moe_tab(Frame& F) {
    LAS unsigned char* tab = (LAS unsigned char*)(F.lds + TAB_OFF); LAS int* tinfo = (LAS int*)(F.lds + TAB_OFF + 320);
    if (F.tid < 32) { const int c = (int)__hip_atomic_load((unsigned*)(F.ctl + CW_CNT + 64 * F.tid), RLX_AGENT); tinfo[4 + F.tid] = (c + 255) >> 8; }
    __syncthreads();
    if (F.tid == 0) { int a = 0; for (int e = 0; e < 32; ++e) { const int n = tinfo[4 + e]; for (int j = 0; j < n; ++j) tab[a + j] = (unsigned char)e; a += n; } tinfo[0] = a; }
    __syncthreads();
    return tinfo[0];
}
__device__ __forceinline__ void phase8(Frame& F) {
    const float* H2 = (const float*)(F.ws + WS_H2); const bf16* YR = (const bf16*)(F.ws + WS_YR);
    const int* SLOT = (const int*)(F.ws + WS_ROUTE) + TT * 12;
    const int gw = F.bid * NWAVES + F.wave, NGW = F.G * NWAVES;
    for (int t = gw; t < TT; t += NGW) {
        int slot = 0; if (F.lane < 4) slot = SLOT[(size_t)t * 4 + F.lane];
        int sl[4]; sl[0] = __shfl(slot, 0); sl[1] = __shfl(slot, 1); sl[2] = __shfl(slot, 2); sl[3] = __shfl(slot, 3);
        float v[4][8]; float ss = 0.f;
#pragma unroll
        for (int j = 0; j < 4; ++j) { const int pz = F.lane + 64 * j; const f32x4 a = *(const f32x4*)(H2 + (size_t)t * DM + 8 * pz), b = *(const f32x4*)(H2 + (size_t)t * DM + 8 * pz + 4);
            v[j][0] = a.x; v[j][1] = a.y; v[j][2] = a.z; v[j][3] = a.w; v[j][4] = b.x; v[j][5] = b.y; v[j][6] = b.z; v[j][7] = b.w; }
#pragma unroll
        for (int k = 0; k < 4; ++k)
#pragma unroll
            for (int j = 0; j < 4; ++j) { float f[8]; unpack8(*((const v4u*)(YR + (size_t)sl[k] * DM) + F.lane + 64 * j), f);
#pragma unroll
                for (int i = 0; i < 8; ++i) v[j][i] += f[i]; }
#pragma unroll
        for (int j = 0; j < 4; ++j)
#pragma unroll
            for (int i = 0; i < 8; ++i) ss += v[j][i] * v[j][i];
        const float rstd = 1.0f / sqrtf(wave_sum(ss) * (1.0f / 2048.0f) + EPSF);
#pragma unroll
        for (int j = 0; j < 4; ++j) { const int pz = F.lane + 64 * j; const f32x4 w0 = *(const f32x4*)(F.final_norm_w + 8 * pz), w1 = *(const f32x4*)(F.final_norm_w + 8 * pz + 4);
            *(f32x4*)(F.out + (size_t)t * DM + 8 * pz) = (f32x4){v[j][0] * rstd * w0.x, v[j][1] * rstd * w0.y, v[j][2] * rstd * w0.z, v[j][3] * rstd * w0.w};
            *(f32x4*)(F.out + (size_t)t * DM + 8 * pz + 4) = (f32x4){v[j][4] * rstd * w1.x, v[j][5] * rstd * w1.y, v[j][6] * rstd * w1.z, v[j][7] * rstd * w1.w}; }
    }
}

struct Args { const float* in[21]; float* out; unsigned char* ws; int ph_lo, ph_hi, li, pad; };
__global__ void __launch_bounds__(NWAVES * 64, 2) hymba_fwd(Args args) {
    extern __shared__ __attribute__((aligned(16))) unsigned char lds[];
    Frame F;
    F.lds = (LAS unsigned char*)lds; F.MISC = (volatile LAS unsigned*)(F.lds + MISC_OFF);
    F.tid = threadIdx.x; F.lane = F.tid & 63; F.wave = __builtin_amdgcn_readfirstlane(F.tid >> 6); F.G = gridDim.x; F.bid = blockIdx.x;
    F.ws = args.ws; F.ctl = (gu32*)(args.ws + WS_CTL); F.out = args.out;
    F.x = args.in[0]; F.norm1_w = args.in[1]; F.w_in = args.in[2]; F.conv_w = args.in[3]; F.conv_b = args.in[4]; F.dt_bias = args.in[5]; F.a_log = args.in[6]; F.d_skip = args.in[7]; F.ssd_norm_w = args.in[8];
    F.i_bias = args.in[9]; F.f_bias = args.in[10]; F.ml_norm_w = args.in[11]; F.w_out = args.in[12]; F.norm2_w = args.in[13]; F.router_w = args.in[14]; F.router_b = args.in[15];
    F.w_gate_up = args.in[16]; F.b_gate_up = args.in[17]; F.w_down = args.in[18]; F.b_down = args.in[19]; F.final_norm_w = args.in[20];
    for (int u = F.tid; u < (LDS_BYTES - LDSCTL_OFF) / 4; u += NWAVES * 64) ((LAS unsigned*)(F.lds + LDSCTL_OFF))[u] = 0u;
    __syncthreads();
    XcdBarrier bar; bar.bar = (unsigned*)(F.ctl + CW_BAR) + args.li * XCD_BAR_WORDS; bar.x = 0; bar.st = nullptr;
    const bool use_bar = (args.ph_hi - args.ph_lo) > 1;
    if (use_bar) bar = xcd_barrier_post((unsigned*)(F.ctl + CW_BAR) + args.li * XCD_BAR_WORDS, F.MISC + 8);
    const int lo = args.ph_lo, hi = args.ph_hi;
#ifndef PHASE_MASK
#define PHASE_MASK 0x7ff
#endif
#define IN(k) (((PHASE_MASK >> (k)) & 1) && lo <= (k) && (k) < hi)
#define SEAM(k) do { if (IN(k) && IN((k) + 1)) xcd_barrier(bar); } while (0)
    if (IN(0)) { phase0(F); } SEAM(0);
    if (IN(1)) {
        pg8::Gemm g{(const pg8::bf16_t*)(F.ws + WS_XN1), (const pg8::bf16_t*)(F.ws + WS_WIN), TT, NPROJ, DM}; pg8::StaticOrder S; S.init(TT, NPROJ, F.G, F.bid);
        pg8::EpiBf16 E{(pg8::bf16_t*)(F.ws + WS_PROJ), NPROJ};
        pg8::gemm_phase<pg8::EpiBf16, pg8::StaticOrder, true, true>(F.lds, g, S, E);
        p1_small(F);
    } SEAM(1);
    if (IN(2)) { phase_conv(F); } SEAM(2);
    if (IN(3)) { phase_mixer(F); } SEAM(3);
    if (IN(4)) { phase3(F); } SEAM(4);
    if (IN(5)) {
        pg8::Gemm g{(const pg8::bf16_t*)(F.ws + WS_YMIX), (const pg8::bf16_t*)(F.ws + WS_WOUT), TT, DM, 4096}; pg8::StaticOrder S; S.init(TT, DM, F.G, F.bid);
        pg8::EpiResF32 E{(float*)(F.ws + WS_H2), F.x, DM};
        pg8::gemm_phase<pg8::EpiResF32, pg8::StaticOrder, true, true>(F.lds, g, S, E);
    } SEAM(5);
    if (IN(6)) { phase5(F); } SEAM(6);
    if (IN(7)) { phase5b(F); } SEAM(7);
    if (IN(8)) {
        const int nM = build_moe_tab(F);
        pg8::Gemm g{(const pg8::bf16_t*)(F.ws + WS_XG), (const pg8::bf16_t*)(F.ws + WS_WGU), nM * 256, 4096, DM};
        pg8::MoeOrder S{nM, 16, 4, nM * 16, F.G, F.bid, (const PG8_LAS unsigned char*)(F.lds + TAB_OFF)};
        pg8::EpiSwiglu E{(unsigned char*)(F.ws + WS_ACT), F.b_gate_up};
        pg8::gemm_phase<pg8::EpiSwiglu, pg8::MoeOrder, true, true, true>(F.lds, g, S, E);
    } SEAM(8);
    if (IN(9)) {
        const int nM = build_moe_tab(F);
        pg8::Gemm g{(const pg8::bf16_t*)(F.ws + WS_ACT), (const pg8::bf16_t*)(F.ws + WS_WD), nM * 256, 2048, DM};
        pg8::MoeOrder S{nM, 8, 3, nM * 8, F.G, F.bid, (const PG8_LAS unsigned char*)(F.lds + TAB_OFF)};
        pg8::EpiDown E{(pg8::bf16_t*)(F.ws + WS_YR), F.b_down, (const float*)((const int*)(F.ws + WS_ROUTE) + TT * 16)};
        pg8::gemm_phase<pg8::EpiDown, pg8::MoeOrder, true, true, true>(F.lds, g, S, E);
    } SEAM(9);
    if (IN(10)) { phase8(F); }
#undef IN
#undef SEAM
}

extern "C" void kernel_launch(void* const* d_in, const int* in_sizes, int n_in, void* d_out, int out_size, void* d_ws, size_t ws_size, hipStream_t stream) {
    static int grid = 0;
    if (grid == 0) {
        if (n_in != 21 || out_size != TT * DM || ws_size < WS_END) { fprintf(stderr, "kernel_launch: unexpected problem (n_in %d, out %d, ws %zu); nothing launched\n", n_in, out_size, ws_size); grid = -1; return; }
        int dev = 0, cus = 0, per_cu = 0;
        if (hipGetDevice(&dev) != hipSuccess || hipDeviceGetAttribute(&cus, hipDeviceAttributeMultiprocessorCount, dev) != hipSuccess) { grid = -1; return; }
        if (hipFuncSetAttribute((const void*)hymba_fwd, hipFuncAttributeMaxDynamicSharedMemorySize, LDS_BYTES) != hipSuccess) { fprintf(stderr, "kernel_launch: hipFuncSetAttribute failed\n"); grid = -1; return; }
        if (hipOccupancyMaxActiveBlocksPerMultiprocessor(&per_cu, (const void*)hymba_fwd, NWAVES * 64, LDS_BYTES) != hipSuccess || per_cu < 1) { fprintf(stderr, "kernel_launch: occupancy query says %d blocks per CU\n", per_cu); }
        (void)hipGetLastError();
        grid = cus;
    }
    if (grid < 0) return;
    (void)hipMemsetAsync((char*)d_ws + WS_CTL, 0, CTL_ZERO_BYTES, stream);
    Args a{};
    for (int i = 0; i < 21; ++i) a.in[i] = (const float*)d_in[i];
    a.out = (float*)d_out; a.ws = (unsigned char*)d_ws; a.pad = 0;
#if MK_PER_PHASE
    for (int li = 0; li < N_PHASES; ++li) { a.ph_lo = li; a.ph_hi = li + 1; a.li = li; hipLaunchKernelGGL(hymba_fwd, dim3(grid), dim3(NWAVES * 64), LDS_BYTES, stream, a); }
#else
    a.ph_lo = 0; a.ph_hi = N_PHASES; a.li = 0;
    hipLaunchKernelGGL(hymba_fwd, dim3(grid), dim3(NWAVES * 64), LDS_BYTES, stream, a);
#endif
}
```

```cpp
#include <hip/hip_runtime.h>
#include <cstdio>
#include <cstdint>
namespace pg8 {
#define PG8_LAS __attribute__((address_space(3)))
typedef unsigned short bf16_t;
typedef short bf16x8 __attribute__((ext_vector_type(8)));
typedef float f32x4 __attribute__((ext_vector_type(4)));
typedef unsigned u32x4 __attribute__((ext_vector_type(4)));
constexpr int BM = 256, BK = 64, HALF = 128, HTB = HALF * BK * 2  , STAGE_BYTES = 8 * HTB, NXCD = 8, WGM = 8;

__host__ __device__ __forceinline__ int lds_byte(int r, int c) { const int st = (r >> 4) * 2 + (c >> 5), rr = r & 15, cc = c & 31, ob = rr * 64 + cc * 2; return st * 1024 + (ob ^ (((ob >> 9) & 1) << 5)); }
__host__ __device__ __forceinline__ void stage_rc(int b, int& R, int& C) { const int st = b / 1024, sb = b % 1024, swz = sb ^ (((sb >> 9) & 1) << 5); R = (st >> 1) * 16 + swz / 64; C = (st & 1) * 32 + (swz % 64) / 2; }
__host__ __device__ __forceinline__ int perm32(int rho) { const int n = rho >> 4, i = rho & 15; return 8 * (i >> 2) + 4 * n + (i & 3); }

struct Unit { int pm, pn; };
struct Gemm { const bf16_t* A; const bf16_t* Bt; int M, N, K; };

struct StaticOrder {
    int nM, nN, nwg, G, c;
    __host__ __device__ void init(int M, int N, int G_, int c_) { nM = M / BM; nN = N / BM; nwg = nM * nN; G = G_; c = c_; }
    __host__ __device__ bool next(int i, Unit& u) const {
        const long L = (long)i * G + c; if (L >= nwg) return false;
        int wgid = (int)L; { const int q = nwg / NXCD, r = nwg % NXCD, xcd = wgid % NXCD, off = wgid / NXCD; wgid = (xcd < r ? xcd * (q + 1) : r * (q + 1) + (xcd - r) * q) + off; }
        const int nig = WGM * nN, gid = wgid / nig, fm = gid * WGM, gsz = (nM - fm) < WGM ? (nM - fm) : WGM;
        u.pm = fm + ((wgid % nig) % gsz); u.pn = (wgid % nig) / gsz; return true;
    }
    __device__ __forceinline__ void a_ready(const Unit&) const {}
    __device__ __forceinline__ void done(const Unit&) const {}
};


__device__ __forceinline__ unsigned cvt_pk_bf16(float lo, float hi) { unsigned r; asm volatile("v_cvt_pk_bf16_f32 %0, %1, %2" : "=v"(r) : "v"(lo), "v"(hi)); return r; }
typedef unsigned u32x2 __attribute__((ext_vector_type(2)));

struct EpiBf16 {
    static constexpr bool PERM = true, AFTER_DRAIN = false;
    bf16_t* O; int ldc;
    __device__ __forceinline__ void operator()(const f32x4 (&acc)[2][2][4][2], const Unit& u, int wr, int wc, int fr, int fq) const {
        const int row0 = u.pm * BM + wr * 64 + fr; const int col0 = u.pn * BM + wc * 32 + 8 * fq;
#pragma unroll
        for (int ai = 0; ai < 2; ++ai)
#pragma unroll
            for (int m = 0; m < 4; ++m) { bf16_t* rowp = O + (size_t)(row0 + ai * HALF + m * 16) * ldc + col0;
#pragma unroll
                for (int bj = 0; bj < 2; ++bj) { const f32x4 v0 = acc[ai][bj][m][0], v1 = acc[ai][bj][m][1];
                    u32x4 w; w.x = cvt_pk_bf16(v0[0], v0[1]); w.y = cvt_pk_bf16(v0[2], v0[3]); w.z = cvt_pk_bf16(v1[0], v1[1]); w.w = cvt_pk_bf16(v1[2], v1[3]);
                    *(u32x4*)(rowp + bj * HALF) = w; } }
    }
};
struct EpiResF32 {
    static constexpr bool PERM = false, AFTER_DRAIN = false;
    float* C; const float* base; int ldc;
    __device__ __forceinline__ void operator()(const f32x4 (&acc)[2][2][4][2], const Unit& u, int wr, int wc, int fr, int fq) const {
        const int row0 = u.pm * BM + wr * 64 + fr, col0 = u.pn * BM + wc * 32 + 4 * fq;
#pragma unroll
        for (int ai = 0; ai < 2; ++ai)
#pragma unroll
            for (int m = 0; m < 4; ++m) { const size_t off = (size_t)(row0 + ai * HALF + m * 16) * ldc + col0;
#pragma unroll
                for (int bj = 0; bj < 2; ++bj)
#pragma unroll
                    for (int n = 0; n < 2; ++n) *(f32x4*)(C + off + bj * HALF + n * 16) = acc[ai][bj][m][n] + *(const f32x4*)(base + off + bj * HALF + n * 16); }
    }
};
__device__ __forceinline__ float swiglu1(float a, float b) {
    const float glu = fminf(a, 7.0f), lin = fminf(fmaxf(b, -7.0f), 7.0f);
    return glu * (1.0f / (1.0f + __expf(-1.702f * glu))) * (lin + 1.0f);
}
struct EpiSwiglu {
    static constexpr bool PERM = true, AFTER_DRAIN = false;
    unsigned char* O; const float* bias;
    __device__ __forceinline__ void operator()(const f32x4 (&acc)[2][2][4][2], const Unit& u, int wr, int wc, int fr, int fq) const {
        const int e = u.pn >> 4, pnl = u.pn & 15;
        const int row0 = u.pm * BM + wr * 64 + fr; const int hcol0 = pnl * BM + wc * 32 + 8 * fq;
        const float* bp = bias + (size_t)e * 4096 + hcol0;
        f32x4 bv[2][2];
#pragma unroll
        for (int bj = 0; bj < 2; ++bj)
#pragma unroll
            for (int n = 0; n < 2; ++n) bv[bj][n] = *(const f32x4*)(bp + bj * HALF + 4 * n);
#pragma unroll
        for (int ai = 0; ai < 2; ++ai)
#pragma unroll
            for (int m = 0; m < 4; ++m) { unsigned char* rowp = O + (size_t)(row0 + ai * HALF + m * 16) * 2048 + (hcol0 >> 1);
#pragma unroll
                for (int bj = 0; bj < 2; ++bj) { const f32x4 v0 = acc[ai][bj][m][0] + bv[bj][0], v1 = acc[ai][bj][m][1] + bv[bj][1];
                    int w = __builtin_amdgcn_cvt_pk_fp8_f32(swiglu1(v0[0], v0[1]), swiglu1(v0[2], v0[3]), 0, false);
                    w = __builtin_amdgcn_cvt_pk_fp8_f32(swiglu1(v1[0], v1[1]), swiglu1(v1[2], v1[3]), w, true);
                    *(int*)(rowp + bj * 64) = w; } }
    }
};
struct EpiDown {
    static constexpr bool PERM = true, AFTER_DRAIN = false;
    bf16_t* O; const float* bias; const float* sgate;
    __device__ __forceinline__ void operator()(const f32x4 (&acc)[2][2][4][2], const Unit& u, int wr, int wc, int fr, int fq) const {
        const int e = u.pn >> 3, pnl = u.pn & 7;
        const int row0 = u.pm * BM + wr * 64 + fr; const int col0 = pnl * BM + wc * 32 + 8 * fq;
        const float* bp = bias + (size_t)e * 2048 + col0;
        f32x4 bv[2][2];
#pragma unroll
        for (int bj = 0; bj < 2; ++bj)
#pragma unroll
            for (int n = 0; n < 2; ++n) bv[bj][n] = *(const f32x4*)(bp + bj * HALF + 4 * n);
#pragma unroll
        for (int ai = 0; ai < 2; ++ai)
#pragma unroll
            for (int m = 0; m < 4; ++m) { const int row = row0 + ai * HALF + m * 16; const float gt = sgate[row]; bf16_t* rowp = O + (size_t)row * 2048 + col0;
#pragma unroll
                for (int bj = 0; bj < 2; ++bj) { const f32x4 v0 = (acc[ai][bj][m][0] + bv[bj][0]) * gt, v1 = (acc[ai][bj][m][1] + bv[bj][1]) * gt;
                    u32x4 w; w.x = cvt_pk_bf16(v0[0], v0[1]); w.y = cvt_pk_bf16(v0[2], v0[3]); w.z = cvt_pk_bf16(v1[0], v1[1]); w.w = cvt_pk_bf16(v1[2], v1[3]);
                    *(u32x4*)(rowp + bj * HALF) = w; } }
    }
};
struct MoeOrder {
    int nM, nN, nsh, nwg, G, c; const PG8_LAS unsigned char* tab;
    __device__ __forceinline__ bool next(int i, Unit& u) const {
        const long L = (long)i * G + c; if (L >= nwg) return false;
        int wgid = (int)L; { const int q = nwg / NXCD, r = nwg % NXCD, xcd = wgid % NXCD, off = wgid / NXCD; wgid = (xcd < r ? xcd * (q + 1) : r * (q + 1) + (xcd - r) * q) + off; }
        const int nig = WGM * nN, gid = wgid / nig, fm = gid * WGM, gsz = (nM - fm) < WGM ? (nM - fm) : WGM;
        const int pm = fm + ((wgid % nig) % gsz), pnl = (wgid % nig) / gsz;
        u.pm = pm; u.pn = ((int)tab[pm] << nsh) + pnl; return true;
    }
    __device__ __forceinline__ void a_ready(const Unit&) const {}
    __device__ __forceinline__ void done(const Unit&) const {}
};
typedef int v8i32 __attribute__((ext_vector_type(8)));
__device__ __forceinline__ v8i32 pg8_cat(const bf16x8 lo, const bf16x8 hi) { typedef int v4i32 __attribute__((ext_vector_type(4))); const v4i32 a = __builtin_bit_cast(v4i32, lo), b = __builtin_bit_cast(v4i32, hi); return __builtin_shufflevector(a, b, 0, 1, 2, 3, 4, 5, 6, 7); }
template <class Epi, class Sched, bool ALIGN_EPI = false, bool SP2 = false, bool F8 = false>
__device__ __forceinline__ void gemm_phase(PG8_LAS unsigned char* lds, const Gemm g, const Sched& S, const Epi& E) {
    const int tid = threadIdx.x, wid = __builtin_amdgcn_readfirstlane(tid >> 6), lane = tid & 63, wr = wid >> 2, wc = wid & 3, fr = lane & 15, fq = lane >> 4;
    const int K = g.K, KB = F8 ? K : 2 * K, nt = KB / 128;
    unsigned voffA[2], voffB[2];
#pragma unroll
    for (int i = 0; i < 2; ++i) { int R, C; stage_rc(tid * 16 + i * 8192, R, C); const int Rb = Epi::PERM ? ((R & ~31) + perm32(R & 31)) : R;
        voffA[i] = (unsigned)(R * KB + C * 2); voffB[i] = (unsigned)(Rb * KB + C * 2); }
    const size_t kstep = (size_t)(BK * 2);
    const size_t hstep = (size_t)HALF * KB;
    const size_t tstep = 2 * hstep;
    const unsigned ldsw = (unsigned)wid * 1024u;
    int aoffk[2], boffk[2];
#pragma unroll
    for (int h = 0; h < 2; ++h) { aoffk[h] = lds_byte(wr * 64 + fr, fq * 8) + h * 1024; boffk[h] = lds_byte(wc * 32 + fr, fq * 8) + h * 1024; }
#define PG8_SA(b, h) (((b) * 2 + (h)) * HTB)
#define PG8_SB(b, h) ((4 + (b) * 2 + (h)) * HTB)
#define PG8_STAGE(bufoff, gbase, voff) do { _Pragma("unroll") for (int _i = 0; _i < 2; ++_i) \
        __builtin_amdgcn_global_load_lds((const unsigned*)((const char*)(gbase) + (voff)[_i]), (PG8_LAS unsigned*)(lds + (bufoff) + ldsw + _i * 8192), 16, 0, 0); } while (0)
#define PG8_LDA(dst, b, h) do { if constexpr (F8) { _Pragma("unroll") for (int m = 0; m < 4; ++m) dst##8[m] = pg8_cat(*(const PG8_LAS bf16x8*)(lds + PG8_SA(b, h) + aoffk[0] + m * 2048), *(const PG8_LAS bf16x8*)(lds + PG8_SA(b, h) + aoffk[1] + m * 2048)); } \
        else { _Pragma("unroll") for (int m = 0; m < 4; ++m) _Pragma("unroll") for (int k = 0; k < 2; ++k) dst[m][k] = *(const PG8_LAS bf16x8*)(lds + PG8_SA(b, h) + aoffk[k] + m * 2048); } } while (0)
#define PG8_LDB(dst, b, h) do { if constexpr (F8) { _Pragma("unroll") for (int n = 0; n < 2; ++n) dst##8[n] = pg8_cat(*(const PG8_LAS bf16x8*)(lds + PG8_SB(b, h) + boffk[0] + n * 2048), *(const PG8_LAS bf16x8*)(lds + PG8_SB(b, h) + boffk[1] + n * 2048)); } \
        else { _Pragma("unroll") for (int n = 0; n < 2; ++n) _Pragma("unroll") for (int k = 0; k < 2; ++k) dst[n][k] = *(const PG8_LAS bf16x8*)(lds + PG8_SB(b, h) + boffk[k] + n * 2048); } } while (0)
#define PG8_MMA(ai, bj, At, Bt) do { __builtin_amdgcn_s_setprio(1); \
        if constexpr (F8) { _Pragma("unroll") for (int m = 0; m < 4; ++m) _Pragma("unroll") for (int n = 0; n < 2; ++n) \
            asm volatile("v_mfma_scale_f32_16x16x128_f8f6f4 %0, %1, %2, %0, %3, %4 op_sel_hi:[0,0,0]" : "+v"(acc[ai][bj][m][n]) : "v"(Bt##8[n]), "v"(At##8[m]), "v"(sc_w), "v"(sc_a)); } \
        else { _Pragma("unroll") for (int m = 0; m < 4; ++m) _Pragma("unroll") for (int n = 0; n < 2; ++n) _Pragma("unroll") for (int k = 0; k < 2; ++k) \
            acc[ai][bj][m][n] = __builtin_amdgcn_mfma_f32_16x16x32_bf16(Bt[n][k], At[m][k], acc[ai][bj][m][n], 0, 0, 0); } \
        __builtin_amdgcn_s_setprio(0); } while (0)
#define PG8_WAIT_V(n) asm volatile("s_waitcnt vmcnt(" #n ")" ::: "memory")
#define PG8_WAIT_L(n) asm volatile("s_waitcnt lgkmcnt(" #n ")" ::: "memory")
#define PG8_BAR __builtin_amdgcn_s_barrier()
#define PG8_SCHED __builtin_amdgcn_sched_barrier(0)
    Unit cur, nxt; int ui = 0;
    if (!S.next(0, cur)) return;
    f32x4 acc[2][2][4][2];
#pragma unroll
    for (int a = 0; a < 2; ++a)
#pragma unroll
        for (int b = 0; b < 2; ++b)
#pragma unroll
            for (int m = 0; m < 4; ++m)
#pragma unroll
                for (int n = 0; n < 2; ++n) acc[a][b][m][n] = (f32x4){0.f, 0.f, 0.f, 0.f};
    const int sc_w = 0x79797979, sc_a = 0x7f7f7f7f;
    bf16x8 At[4][2], B0[2][2], B1[2][2]; v8i32 At8[4], B08[2], B18[2];
    const char* cA = (const char*)g.A + (size_t)cur.pm * tstep; const char* cB = (const char*)g.Bt + (size_t)cur.pn * tstep;
    S.a_ready(cur);
    if constexpr (SP2) {
        PG8_STAGE(PG8_SB(0, 0), cB, voffB); PG8_STAGE(PG8_SB(0, 1), cB + hstep, voffB); PG8_STAGE(PG8_SA(0, 0), cA, voffA); PG8_STAGE(PG8_SA(0, 1), cA + hstep, voffA);
        if (wr == 1) PG8_BAR;
        PG8_WAIT_V(2); PG8_BAR;
        PG8_STAGE(PG8_SB(1, 0), cB + kstep, voffB); PG8_STAGE(PG8_SA(1, 0), cA + kstep, voffA); PG8_STAGE(PG8_SB(1, 1), cB + hstep + kstep, voffB);
        PG8_WAIT_V(6); PG8_BAR;
    } else {
        PG8_STAGE(PG8_SB(0, 0), cB, voffB); PG8_STAGE(PG8_SA(0, 0), cA, voffA); PG8_STAGE(PG8_SB(0, 1), cB + hstep, voffB); PG8_STAGE(PG8_SA(0, 1), cA + hstep, voffA);
        if (wr == 1) PG8_BAR;
        PG8_WAIT_V(4); PG8_BAR;
        PG8_STAGE(PG8_SB(1, 0), cB + kstep, voffB); PG8_STAGE(PG8_SA(1, 0), cA + kstep, voffA); PG8_STAGE(PG8_SB(1, 1), cB + hstep + kstep, voffB);
        PG8_WAIT_V(6); PG8_BAR;
    }
    for (;;) {
        const bool has_next = S.next(ui + 1, nxt);
        const char* nA = has_next ? (const char*)g.A + (size_t)nxt.pm * tstep : cA; const char* nB = has_next ? (const char*)g.Bt + (size_t)nxt.pn * tstep : cB;
        for (int t = 0; t < nt; t += 2) {
            const bool last = (t == nt - 2);
            const char* a1 = cA + (size_t)(t + 1) * kstep;
            const char* a2 = last ? nA : cA + (size_t)(t + 2) * kstep; const char* b2 = last ? nB : cB + (size_t)(t + 2) * kstep;
            const char* a3 = a2 + kstep; const char* b3 = b2 + kstep;
            if (last && has_next) S.a_ready(nxt);
            if constexpr (SP2) {
            PG8_LDB(B0, 0, 0); PG8_LDB(B1, 0, 1); PG8_SCHED; PG8_LDA(At, 0, 0); PG8_STAGE(PG8_SA(1, 1), a1 + hstep, voffA);
            PG8_WAIT_V(8); PG8_WAIT_L(0); PG8_BAR; PG8_MMA(0, 0, At, B0); PG8_MMA(0, 1, At, B1); PG8_BAR; PG8_SCHED;
            PG8_LDA(At, 0, 1); PG8_STAGE(PG8_SB(0, 0), b2, voffB); PG8_STAGE(PG8_SB(0, 1), b2 + hstep, voffB); PG8_STAGE(PG8_SA(0, 0), a2, voffA);
            PG8_WAIT_V(8); PG8_WAIT_L(0); PG8_BAR; PG8_MMA(1, 0, At, B0); PG8_MMA(1, 1, At, B1); PG8_BAR; PG8_SCHED;
            PG8_LDB(B0, 1, 0); PG8_LDB(B1, 1, 1); PG8_SCHED; PG8_LDA(At, 1, 0); PG8_STAGE(PG8_SA(0, 1), a2 + hstep, voffA);
            PG8_WAIT_V(8); PG8_WAIT_L(0); PG8_BAR; PG8_MMA(0, 0, At, B0); PG8_MMA(0, 1, At, B1); PG8_BAR; PG8_SCHED;
            PG8_LDA(At, 1, 1); PG8_STAGE(PG8_SB(1, 0), b3, voffB); PG8_STAGE(PG8_SB(1, 1), b3 + hstep, voffB); PG8_STAGE(PG8_SA(1, 0), a3, voffA);
            PG8_WAIT_V(8); PG8_WAIT_L(0); PG8_BAR; PG8_MMA(1, 0, At, B0); PG8_MMA(1, 1, At, B1); PG8_BAR; PG8_SCHED;
            } else {
            PG8_LDB(B0, 0, 0); PG8_SCHED; PG8_LDA(At, 0, 0); PG8_STAGE(PG8_SA(1, 1), a1 + hstep, voffA);
            PG8_WAIT_L(8); PG8_BAR; PG8_WAIT_L(0); PG8_MMA(0, 0, At, B0); PG8_BAR; PG8_SCHED;
            PG8_LDB(B1, 0, 1); PG8_STAGE(PG8_SB(0, 0), b2, voffB);
            PG8_BAR; PG8_WAIT_L(0); PG8_MMA(0, 1, At, B1); PG8_BAR;
            PG8_LDA(At, 0, 1); PG8_STAGE(PG8_SA(0, 0), a2, voffA);
            PG8_BAR; PG8_WAIT_L(0); PG8_MMA(1, 0, At, B0); PG8_BAR; PG8_SCHED;
            PG8_STAGE(PG8_SB(0, 1), b2 + hstep, voffB);
            PG8_WAIT_V(6); PG8_BAR; PG8_MMA(1, 1, At, B1); PG8_BAR;
            PG8_LDB(B0, 1, 0); PG8_SCHED; PG8_LDA(At, 1, 0); PG8_STAGE(PG8_SA(0, 1), a2 + hstep, voffA);
            PG8_WAIT_L(8); PG8_BAR; PG8_WAIT_L(0); PG8_MMA(0, 0, At, B0); PG8_BAR; PG8_SCHED;
            PG8_LDB(B1, 1, 1); PG8_STAGE(PG8_SB(1, 0), b3, voffB);
            PG8_BAR; PG8_WAIT_L(0); PG8_MMA(0, 1, At, B1); PG8_BAR;
            PG8_LDA(At, 1, 1); PG8_STAGE(PG8_SA(1, 0), a3, voffA);
            PG8_BAR; PG8_WAIT_L(0); PG8_MMA(1, 0, At, B0); PG8_BAR; PG8_SCHED;
            PG8_STAGE(PG8_SB(1, 1), b3 + hstep, voffB);
            PG8_WAIT_V(6); PG8_BAR; PG8_MMA(1, 1, At, B1); PG8_BAR;
            }
        }
        if constexpr (ALIGN_EPI) { if (wr == 0) PG8_BAR; }
        if constexpr (F8) asm volatile("s_nop 15\n\ts_nop 15" ::: "memory");
        if constexpr (!Epi::AFTER_DRAIN) { E(acc, cur, wr, wc, fr, fq); S.done(cur); }
        if (!has_next) break;
#pragma unroll
        for (int a = 0; a < 2; ++a)
#pragma unroll
            for (int b = 0; b < 2; ++b)
#pragma unroll
                for (int m = 0; m < 4; ++m)
#pragma unroll
                    for (int n = 0; n < 2; ++n) acc[a][b][m][n] = (f32x4){0.f, 0.f, 0.f, 0.f};
        cur = nxt; cA = nA; cB = nB; ++ui;
        if constexpr (ALIGN_EPI) { if (wr == 1) PG8_BAR; }
    }
    PG8_WAIT_V(0);
    if constexpr (!ALIGN_EPI) { if (wr == 0) PG8_BAR; }
    PG8_BAR;
    if constexpr (Epi::AFTER_DRAIN) { E.fused(acc, cur, wr, wc, fr, fq, lds, wid, lane); S.done(cur); }
#undef PG8_SA
#undef PG8_SB
#undef PG8_STAGE
#undef PG8_LDA
#undef PG8_LDB
#undef PG8_MMA
#undef PG8_WAIT_V
#undef PG8_WAIT_L
#undef PG8_BAR
#undef PG8_SCHED
}
}

constexpr int NWAVES = 8;
constexpr int TT = 16384, DM = 2048, SEQ = 2048;
constexpr int NPROJ = 11264;
constexpr int PC_Z = 0, PC_XBC = 2048, PC_Q = 5120, PC_K = 6144, PC_V = 7168, PC_O = 9216;
constexpr int WIN_LD = 11312;
constexpr int NSLOT = 65536 + 32 * 256;
constexpr float EPSF = 1e-5f;
#ifndef HSYNC_ON
#define HSYNC_ON 0
#endif
#define HWAIT() do { if (HSYNC_ON) asm volatile("s_waitcnt vmcnt(0) lgkmcnt(0)\n\ts_nop 15\n\ts_nop 15" ::: "memory"); } while (0)
#define HSYNC() do { if (HSYNC_ON) { HWAIT(); __syncthreads(); } } while (0)
#ifndef MK_PER_PHASE
#define MK_PER_PHASE 0
#endif
constexpr int N_PHASES = 11;

constexpr size_t MiB = 1u << 20;
constexpr size_t WS_CTL = 0, CTL_ZERO_BYTES = 1 * MiB;
constexpr size_t WS_WIN = 2 * MiB, WS_WSM = 46 * MiB, WS_WRT = 47 * MiB, WS_WOUT = 48 * MiB, WS_WGU = 64 * MiB, WS_WD = 576 * MiB;
constexpr size_t WS_XN1 = 832 * MiB, WS_PROJ = 896 * MiB, WS_SMALL = 1248 * MiB, WS_SSQ = 1252 * MiB, WS_YMIX = 1256 * MiB, WS_H2 = 1384 * MiB, WS_XN2 = 1512 * MiB;
constexpr size_t WS_ROUTE = 1576 * MiB, WS_XG = 1578 * MiB, WS_ACT = 1866 * MiB, WS_YR = 2154 * MiB, WS_XC = 2442 * MiB, WS_END = 2538 * MiB;
constexpr int CW_BAR = 4096;
constexpr int CW_CNT = 65536;

constexpr int RING_BYTES = 131072;
constexpr int LDS_BYTES = 147456;
constexpr int LDSCTL_OFF = LDS_BYTES - 576, MISC_OFF = LDSCTL_OFF;
constexpr int TAB_OFF = LDSCTL_OFF + 64;

#define GAS __attribute__((address_space(1)))
#define LAS __attribute__((address_space(3)))
typedef unsigned short bf16;
typedef unsigned v4u __attribute__((ext_vector_type(4)));
typedef unsigned v2u __attribute__((ext_vector_type(2)));
typedef float f32x4 __attribute__((ext_vector_type(4)));
typedef float f32x2 __attribute__((ext_vector_type(2)));
typedef short bf16x8 __attribute__((ext_vector_type(8)));
typedef GAS unsigned gu32;
#define RLX_AGENT __ATOMIC_RELAXED, __HIP_MEMORY_SCOPE_AGENT
#define LDS_WAIT() asm volatile("s_waitcnt lgkmcnt(0)" ::: "memory")
#define VM_WAIT() asm volatile("s_waitcnt vmcnt(0)" ::: "memory")
__device__ __forceinline__ unsigned f2bf(float f) { unsigned u = __builtin_bit_cast(unsigned, f); return (u + 0x7fffu + ((u >> 16) & 1u)) >> 16; }
__device__ __forceinline__ unsigned pk2(float lo, float hi) { return f2bf(lo) | (f2bf(hi) << 16); }
__device__ __forceinline__ float bflo(unsigned w) { return __builtin_bit_cast(float, w << 16); }
__device__ __forceinline__ float bfhi(unsigned w) { return __builtin_bit_cast(float, w & 0xffff0000u); }
__device__ __forceinline__ float wave_sum(float v) {
#pragma unroll
    for (int o = 1; o < 64; o <<= 1) v += __shfl_xor(v, o);
    return v;
}
__device__ __forceinline__ float softplusf(float x) { return x > 20.f ? x : log1pf(expf(x)); }
__device__ __forceinline__ float logsigf(float x) { return fminf(x, 0.f) - log1pf(expf(-fabsf(x))); }
__device__ __forceinline__ float siluf(float v) { return v / (1.0f + __expf(-v)); }

#define XB_TMO      128
#define XB_XCNT(j)  (256  + 64 * (j))
#define XB_XSUB(j)  (1280 + 64 * (j))
#define XB_XGEN(j)  (2304 + 64 * (j))
#define XB_TOP      3328
#define XB_TOPGEN   3392
#define XCD_BAR_WORDS 3456
#define XB_SPIN_CAP (1u << 18)

__device__ __forceinline__ unsigned xb_ld(unsigned* p)              { return __hip_atomic_load(p, __ATOMIC_RELAXED, __HIP_MEMORY_SCOPE_AGENT); }
__device__ __forceinline__ unsigned xb_add(unsigned* p, unsigned v) { return __hip_atomic_fetch_add(p, v, __ATOMIC_RELAXED, __HIP_MEMORY_SCOPE_AGENT); }
__device__ __forceinline__ unsigned xb_xcc_id() { return (unsigned)__builtin_amdgcn_s_getreg((3 << 11) | 20) & 0xFu; }
#define XB_SPIN(cond, bar) do { unsigned _sp = 0; while (cond) { __builtin_amdgcn_s_sleep(1); \
    if ((++_sp & 255u) == 0u) { if (xb_ld(&(bar)[XB_TMO])) break; if (_sp > XB_SPIN_CAP) { atomicAdd(&(bar)[XB_TMO], 1u); break; } } } } while (0)

struct XcdBarrier {
    unsigned* bar; unsigned x;
    volatile LAS unsigned* st;
};

__device__ __forceinline__ XcdBarrier xcd_barrier_post(unsigned* bar, volatile LAS unsigned* st) {
    XcdBarrier b; b.bar = bar; b.x = xb_xcc_id(); b.st = st;
    if (threadIdx.x == 0) (void)xb_add(&bar[XB_XCNT(b.x)], 1u);
    return b;
}
__device__ __forceinline__ void xcd_barrier_complete(unsigned* bar, unsigned x, unsigned& nloc, unsigned& nx) {
    const unsigned G = gridDim.x * gridDim.y * gridDim.z;
    unsigned sum, cnt, mine, sp = 0u;
    for (;;) {
        sum = 0u; cnt = 0u; mine = 0u;
#pragma unroll
        for (unsigned j = 0; j < 16; ++j) { const unsigned c = xb_ld(&bar[XB_XCNT(j)]); sum += c; cnt += (c > 0u) ? 1u : 0u; mine = (j == x) ? c : mine; }
        if (sum == G) break;
        __builtin_amdgcn_s_sleep(1);
        if ((++sp & 255u) == 0u) { if (xb_ld(&bar[XB_TMO])) break; if (sp > XB_SPIN_CAP) { atomicAdd(&bar[XB_TMO], 1u); break; } }
    }
    nloc = mine > 0u ? mine : 1u; nx = cnt > 0u ? cnt : 1u;
}

__device__ __forceinline__ void xcd_barrier(const XcdBarrier& b) {
    asm volatile("s_waitcnt vmcnt(0)" ::: "memory");
    __syncthreads();
    if (threadIdx.x == 0) {
        unsigned* bar = b.bar;
        __builtin_amdgcn_s_waitcnt(0);
        unsigned nloc = b.st[0], nx = b.st[1];
        if (nloc == 0u) { xcd_barrier_complete(bar, b.x, nloc, nx); b.st[0] = nloc; b.st[1] = nx; }
        const unsigned old = xb_add(&bar[XB_XSUB(b.x)], 1u);
        const unsigned gen = old / nloc;
        if (old + 1u == (gen + 1u) * nloc) {
            __builtin_amdgcn_fence(__ATOMIC_RELEASE, "agent");
            asm volatile("s_waitcnt vmcnt(0)" ::: "memory");
            const unsigned og = xb_add(&bar[XB_TOP], 1u);
            const unsigned tg = og / nx;
            if (og + 1u == (tg + 1u) * nx) xb_add(&bar[XB_TOPGEN], 1u);
            else XB_SPIN(xb_ld(&bar[XB_TOPGEN]) == tg, bar);
            __builtin_amdgcn_fence(__ATOMIC_ACQUIRE, "agent");
            xb_add(&bar[XB_XGEN(b.x)], 1u);
            asm volatile("s_waitcnt vmcnt(0)" ::: "memory");
        } else {
            XB_SPIN(xb_ld(&bar[XB_XGEN(b.x)]) == gen, bar);
            __builtin_amdgcn_fence(__ATOMIC_ACQUIRE, "agent");
            asm volatile("s_waitcnt vmcnt(0)" ::: "memory");
        }
    }
    __syncthreads();
}

struct Frame {
    LAS unsigned char* lds;
    volatile LAS unsigned* MISC;
    gu32* ctl;
    int tid, lane, wave, G, bid;
    const float *x, *norm1_w, *w_in, *conv_w, *conv_b, *dt_bias, *a_log, *d_skip, *ssd_norm_w, *i_bias, *f_bias, *ml_norm_w, *w_out, *norm2_w, *router_w, *router_b, *w_gate_up, *b_gate_up, *w_down, *b_down, *final_norm_w;
    float* out; unsigned char* ws;
};

__device__ __forceinline__ void p0_transpose_item(const float* W, int ldw, int K, bf16* WT, int dst_row0, int src_col0, int k0, LAS float* scr, int lane) {
#pragma unroll 8
    for (int i = 0; i < 32; ++i) { const int kk = 2 * i + (lane >> 5); scr[kk * 33 + (lane & 31)] = W[(size_t)(k0 + kk) * ldw + src_col0 + (lane & 31)]; }
    LDS_WAIT(); asm volatile("" ::: "memory");
    const int c = lane & 7;
#pragma unroll
    for (int j = 0; j < 4; ++j) { const int n = (lane >> 3) + 8 * j; const LAS float* s = scr + (8 * c) * 33 + n;
        v4u o; o.x = pk2(s[0 * 33], s[1 * 33]); o.y = pk2(s[2 * 33], s[3 * 33]); o.z = pk2(s[4 * 33], s[5 * 33]); o.w = pk2(s[6 * 33], s[7 * 33]);
        *(v4u*)(WT + (size_t)(dst_row0 + n) * K + k0 + 8 * c) = o; }
    LDS_WAIT(); asm volatile("" ::: "memory");
}
__device__ __forceinline__ void p0_transpose_item_f8(const float* W, int ldw, int K, unsigned char* WT, int dst_row0, int src_col0, int k0, LAS float* scr, int lane) {
#pragma unroll 8
    for (int i = 0; i < 32; ++i) { const int kk = 2 * i + (lane >> 5); scr[kk * 33 + (lane & 31)] = W[(size_t)(k0 + kk) * ldw + src_col0 + (lane & 31)] * 64.0f; }
    LDS_WAIT(); asm volatile("" ::: "memory");
    const int c = lane & 3;
#pragma unroll
    for (int j = 0; j < 2; ++j) { const int n = (lane >> 2) + 16 * j; const LAS float* s = scr + (16 * c) * 33 + n; int o[4];
#pragma unroll
        for (int q = 0; q < 4; ++q) { int w = __builtin_amdgcn_cvt_pk_fp8_f32(s[(4 * q) * 33], s[(4 * q + 1) * 33], 0, false); o[q] = __builtin_amdgcn_cvt_pk_fp8_f32(s[(4 * q + 2) * 33], s[(4 * q + 3) * 33], w, true); }
        *(v4u*)(WT + (size_t)(dst_row0 + n) * K + k0 + 16 * c) = (v4u){(unsigned)o[0], (unsigned)o[1], (unsigned)o[2], (unsigned)o[3]}; }
    LDS_WAIT(); asm volatile("" ::: "memory");
}
template <bool F8> __device__ __forceinline__ void p0_transpose128(const float* W, int ldw, int K, void* WTv, int dst_row0, int src_col0, int k0, LAS float* scr, int lane) {
    const float* src = W + (size_t)(k0 + (lane >> 3)) * ldw + src_col0 + 4 * (lane & 7);
    f32x4 v[16];
#pragma unroll
    for (int i = 0; i < 16; ++i) v[i] = *(const f32x4*)(src + (size_t)(8 * i) * ldw);
#pragma unroll
    for (int i = 0; i < 16; ++i) { LAS float* d = scr + (8 * i + (lane >> 3)) * 33 + 4 * (lane & 7); d[0] = v[i].x; d[1] = v[i].y; d[2] = v[i].z; d[3] = v[i].w; }
    LDS_WAIT(); asm volatile("" ::: "memory");
    const int n = lane & 31, hf = lane >> 5; const LAS float* s = scr + (64 * hf) * 33 + n;
    if (F8) { unsigned char* dst = (unsigned char*)WTv + (size_t)(dst_row0 + n) * K + k0 + 64 * hf;
#pragma unroll
        for (int j = 0; j < 4; ++j) { int o[4];
#pragma unroll
            for (int q = 0; q < 4; ++q) { const LAS float* p = s + (16 * j + 4 * q) * 33; int w = __builtin_amdgcn_cvt_pk_fp8_f32(p[0] * 64.0f, p[33] * 64.0f, 0, false); o[q] = __builtin_amdgcn_cvt_pk_fp8_f32(p[66] * 64.0f, p[99] * 64.0f, w, true); }
            *(v4u*)(dst + 16 * j) = (v4u){(unsigned)o[0], (unsigned)o[1], (unsigned)o[2], (unsigned)o[3]}; }
    } else { bf16* dst = (bf16*)WTv + (size_t)(dst_row0 + n) * K + k0 + 64 * hf;
#pragma unroll
        for (int j = 0; j < 8; ++j) { const LAS float* p = s + (8 * j) * 33;
            *(v4u*)(dst + 8 * j) = (v4u){pk2(p[0], p[33]), pk2(p[66], p[99]), pk2(p[132], p[165]), pk2(p[198], p[231])}; }
    }
    LDS_WAIT(); asm volatile("" ::: "memory");
}
__device__ __forceinline__ void rms_row_to_bf16(const float* xrow, const float* w, bf16* orow, int lane) {
    const f32x4* xr = (const f32x4*)xrow + lane; const f32x4* wr = (const f32x4*)w + lane;
    f32x4 v[8]; float s = 0.f;
#pragma unroll
    for (int j = 0; j < 8; ++j) { v[j] = xr[64 * j]; s += (v[j].x * v[j].x + v[j].y * v[j].y) + (v[j].z * v[j].z + v[j].w * v[j].w); }
    const float rstd = 1.0f / sqrtf(wave_sum(s) * (1.0f / 2048.0f) + EPSF);
    v2u* o8 = (v2u*)orow + lane;
#pragma unroll
    for (int j = 0; j < 8; ++j) { const f32x4 ww = wr[64 * j]; v2u o; o.x = pk2(v[j].x * rstd * ww.x, v[j].y * rstd * ww.y); o.y = pk2(v[j].z * rstd * ww.z, v[j].w * rstd * ww.w); o8[64 * j] = o; }
}
__device__ __forceinline__ void phase0(Frame& F) {
    LAS float* scr = (LAS float*)(F.lds + F.wave * 16896);
    const int gw = F.bid * NWAVES + F.wave, NGW = F.G * NWAVES;
    bf16* WinT = (bf16*)(F.ws + WS_WIN); bf16* WsT = (bf16*)(F.ws + WS_WSM); float* Wrt = (float*)(F.ws + WS_WRT); bf16* WoutT = (bf16*)(F.ws + WS_WOUT);
    unsigned char* WguT = (unsigned char*)(F.ws + WS_WGU); unsigned char* WdT = (unsigned char*)(F.ws + WS_WD); bf16* XN1 = (bf16*)(F.ws + WS_XN1);
    constexpr int I_IN = 16 * 352, I_OUT = 32 * 64, I_GU = 32 * 2048, I_D = 32 * 1024, NITEMS = I_IN + I_OUT + I_GU + I_D;
    for (int it = gw; it < NITEMS; it += NGW) {
        int r = it;
        if (r < I_IN) { const int kb = r / 352, nb = r % 352, n0 = nb * 32; p0_transpose128<false>(F.w_in, WIN_LD, 2048, WinT, n0, n0 + (n0 >= 5120 ? 32 : 0), kb * 128, scr, F.lane); continue; } r -= I_IN;
        if (r < I_OUT) { const int kb = r >> 6, nb = r & 63; p0_transpose128<false>(F.w_out, 2048, 4096, WoutT, nb * 32, nb * 32, kb * 128, scr, F.lane); continue; } r -= I_OUT;
        if (r < I_GU) { const int e = r >> 11, rr = r & 2047, kb = rr >> 7, nb = rr & 127; p0_transpose128<true>(F.w_gate_up + (size_t)e * 2048 * 4096, 4096, 2048, WguT + (size_t)e * 4096 * 2048, nb * 32, nb * 32, kb * 128, scr, F.lane); continue; } r -= I_GU;
        { const int e = r >> 10, rr = r & 1023, kb = rr >> 6, nb = rr & 63; p0_transpose128<true>(F.w_down + (size_t)e * 2048 * 2048, 2048, 2048, WdT + (size_t)e * 2048 * 2048, nb * 32, nb * 32, kb * 128, scr, F.lane); }
    }
    for (int i = gw * 64 + F.lane; i < 64 * 2048; i += NGW * 64) { const int j = i >> 11, k = i & 2047;
        const int col = j < 32 ? 5120 + j : (j < 40 ? 11296 + (j - 32) : 11304 + (j - 40));
        WsT[i] = (bf16)(j < 48 ? f2bf(F.w_in[(size_t)k * WIN_LD + col]) : 0u); }
    for (int i = gw * 64 + F.lane; i < 2048 * 32; i += NGW * 64) Wrt[i] = F.norm2_w[i >> 5] * F.router_w[i];
    for (int m = gw; m < TT; m += NGW) rms_row_to_bf16(F.x + (size_t)m * DM, F.norm1_w, XN1 + (size_t)m * DM, F.lane);
}

__device__ __forceinline__ void p1_small(Frame& F) {
    const bf16* XN1 = (const bf16*)(F.ws + WS_XN1); const bf16* WsT = (const bf16*)(F.ws + WS_WSM); float* SMALL = (float*)(F.ws + WS_SMALL);
    const int gw = F.bid * NWAVES + F.wave, NGW = F.G * NWAVES, fr = F.lane & 15, fq = F.lane >> 4;
    for (int task = gw; task < TT / 16; task += NGW) {
        const int t0 = task * 16;
        f32x4 acc[4];
#pragma unroll
        for (int n = 0; n < 4; ++n) acc[n] = (f32x4){0.f, 0.f, 0.f, 0.f};
        const bf16* arow = XN1 + (size_t)(t0 + fr) * DM + 8 * fq; const bf16* brow = WsT + (size_t)fr * DM + 8 * fq;
#pragma unroll 16
        for (int ks = 0; ks < 64; ++ks) {
            const bf16x8 a = *(const bf16x8*)(arow + 32 * ks);
#pragma unroll
            for (int n = 0; n < 4; ++n) { const bf16x8 b = *(const bf16x8*)(brow + (size_t)n * 16 * DM + 32 * ks); acc[n] = __builtin_amdgcn_mfma_f32_16x16x32_bf16(a, b, acc[n], 0, 0, 0); }
        }
#pragma unroll
        for (int n = 0; n < 4; ++n)
#pragma unroll
            for (int r = 0; r < 4; ++r) SMALL[(size_t)(t0 + 4 * fq + r) * 64 + n * 16 + fr] = acc[n][r];
    }
}

__device__ __forceinline__ void unpack8(const v4u r, float (&f)[8]) { f[0] = bflo(r.x); f[1] = bfhi(r.x); f[2] = bflo(r.y); f[3] = bfhi(r.y); f[4] = bflo(r.z); f[5] = bfhi(r.z); f[6] = bflo(r.w); f[7] = bfhi(r.w); }

__device__ __forceinline__ void phase_conv(Frame& F) {
    const bf16* PROJ = (const bf16*)(F.ws + WS_PROJ); bf16* XC = (bf16*)(F.ws + WS_XC);
    constexpr int TB = 16, NCG = 384, NIT = (TT / TB) * NCG;
    for (int it = F.bid * (NWAVES * 64) + F.tid; it < NIT; it += F.G * NWAVES * 64) {
        const int cg = it % NCG, tb = it / NCG, ch = cg * 8, t0 = tb * TB; const bool seq0 = (t0 % SEQ) == 0;
        float w[4][8], bs[8];
#pragma unroll
        for (int j = 0; j < 4; ++j) { const f32x4 a = *(const f32x4*)(F.conv_w + j * 3072 + ch), b = *(const f32x4*)(F.conv_w + j * 3072 + ch + 4);
            w[j][0] = a.x; w[j][1] = a.y; w[j][2] = a.z; w[j][3] = a.w; w[j][4] = b.x; w[j][5] = b.y; w[j][6] = b.z; w[j][7] = b.w; }
        { const f32x4 a = *(const f32x4*)(F.conv_b + ch), b = *(const f32x4*)(F.conv_b + ch + 4); bs[0] = a.x; bs[1] = a.y; bs[2] = a.z; bs[3] = a.w; bs[4] = b.x; bs[5] = b.y; bs[6] = b.z; bs[7] = b.w; }
        const bf16* src = PROJ + (size_t)t0 * NPROJ + PC_XBC + ch;
        float r0[8], r1[8], r2[8], r3[8];
        if (seq0) {
#pragma unroll
            for (int i = 0; i < 8; ++i) { r0[i] = 0.f; r1[i] = 0.f; r2[i] = 0.f; }
        } else { unpack8(*(const v4u*)(src - 3 * (size_t)NPROJ), r0); unpack8(*(const v4u*)(src - 2 * (size_t)NPROJ), r1); unpack8(*(const v4u*)(src - (size_t)NPROJ), r2); }
        v4u rw[TB];
#pragma unroll
        for (int l = 0; l < TB; ++l) rw[l] = *(const v4u*)(src + (size_t)l * NPROJ);
#pragma unroll
        for (int l = 0; l < TB; ++l) {
            unpack8(rw[l], r3);
            float o[8];
#pragma unroll
            for (int i = 0; i < 8; ++i) { const float v = bs[i] + w[0][i] * r0[i] + w[1][i] * r1[i] + w[2][i] * r2[i] + w[3][i] * r3[i]; o[i] = siluf(v); r0[i] = r1[i]; r1[i] = r2[i]; r2[i] = r3[i]; }
            v4u ov; ov.x = pk2(o[0], o[1]); ov.y = pk2(o[2], o[3]); ov.z = pk2(o[4], o[5]); ov.w = pk2(o[6], o[7]);
            *(v4u*)(XC + (size_t)(t0 + l) * 3072 + ch) = ov;
        }
    }
}

constexpr int MX_PITCH = 272;
static_assert(true, "");
constexpr int MX_QM = 0, MX_KM = 34816, MX_KW = 69632, MX_VT = 104448, MX_SI = 121856, MX_VEC = 139264, MX_VECB = 3072, MX_NVEC = MX_VEC + 2 * MX_VECB, MX_SCAL = MX_NVEC + 512, MX_END = MX_SCAL + 64;
__device__ __forceinline__ unsigned cvt_pk_bf16_nop(float lo, float hi) { unsigned r; asm volatile("v_cvt_pk_bf16_f32 %0, %1, %2\n\ts_nop 1" : "=v"(r) : "v"(lo), "v"(hi)); return r; }
__device__ __forceinline__ int mx_sw(int row, int tbyte) { return row * MX_PITCH + ((((tbyte >> 4) ^ (row >> 3)) & 15) << 4) + (tbyte & 15); }
__device__ __forceinline__ bf16x8 lds_frag(const LAS unsigned char* img, int row, int kbyte) { return *(const LAS bf16x8*)(img + row * MX_PITCH + kbyte); }
static_assert(MX_END <= LDSCTL_OFF, "mixer LDS map");
template <bool ML> __device__ __forceinline__ void mixer_unit(Frame& F, int unit) {
    const bf16* PROJ = (const bf16*)(F.ws + WS_PROJ); const bf16* XC = (const bf16*)(F.ws + WS_XC); const float* SMALL = (const float*)(F.ws + WS_SMALL);
    bf16* YMIX = (bf16*)(F.ws + WS_YMIX); float* SSQ = (float*)(F.ws + WS_SSQ);
    const int w = F.wave, fr = F.lane & 15, fq = F.lane >> 4, tid = F.tid;
    const int b = unit >> 5, tok0 = b * SEQ, hd = unit & 31, grp = hd >> 3, mh = (unit & 31) >> 2, vq = unit & 3;
    const float qs = 0.08838834764831845f;
    LAS unsigned char* QM = F.lds + MX_QM; LAS unsigned char* KM = F.lds + MX_KM; LAS unsigned char* KW = F.lds + MX_KW; LAS unsigned char* VT = F.lds + MX_VT; LAS unsigned char* SI = F.lds + MX_SI;
    LAS float* exch = (LAS float*)(F.lds + MX_VEC + (w >> 2) * MX_VECB + 1024) + (w & 3) * 32;
    LAS float* nvec = (LAS float*)(F.lds + MX_NVEC); LAS float* scal = (LAS float*)(F.lds + MX_SCAL);
    const int fr3 = fr >> 3;
    int vtb[2];
#pragma unroll
    for (int p = 0; p < 2; ++p) vtb[p] = fr * MX_PITCH + ((fq ^ ((2 * p) | fr3)) << 4);
    int vpb[2][2];
#pragma unroll
    for (int p = 0; p < 2; ++p)
#pragma unroll
        for (int h = 0; h < 2; ++h) vpb[p][h] = fr * MX_PITCH + (((((fq >> 1) | (2 * h)) ^ ((2 * p) | fr3))) << 4) + 8 * (fq & 1);
    const int kwb = (16 * w + fr) * MX_PITCH + ((fq ^ ((2 * (w & 1)) | fr3)) << 4), kwh = w >> 1;

    const bf16* qsrc; const bf16* ksrc; const bf16* vsrc; int ld;
    if (ML) { qsrc = PROJ + PC_Q + mh * 128; ksrc = PROJ + PC_K + mh * 128; vsrc = PROJ + PC_V + mh * 256 + vq * 64; ld = NPROJ; }
    else { qsrc = XC + 2560 + grp * 128; ksrc = XC + 2048 + grp * 128; vsrc = XC + hd * 64; ld = 3072; }
    const float c_a = ML ? 0.f : -expf(F.a_log[hd]), c_dtb = ML ? 0.f : F.dt_bias[hd], c_D = ML ? 0.f : F.d_skip[hd], c_ib = ML ? F.i_bias[mh] : 0.f, c_fb = ML ? F.f_bias[mh] : 0.f;
    float mprev = 0.f;
    f32x4 sacc[4]; float nreg = 0.f;
#pragma unroll
    for (int j = 0; j < 4; ++j) sacc[j] = (f32x4){0.f, 0.f, 0.f, 0.f};
    v4u pq[4], pk[4], pv[2];
    float vA0 = 0.f, vA1 = 0.f, vB0 = 0.f, vB1 = 0.f, vC0 = 0.f, vC1 = 0.f, vD0 = 0.f, vD1 = 0.f, vE0 = 0.f, vE1 = 0.f, vG0 = 0.f, vG1 = 0.f, vSA = 0.f, vSG = 0.f;
    float sl0 = 0.f, sl1 = 0.f, sl2 = 0.f, sl3 = 0.f;
#define MX_SCAN_L(c) do { if (w == 0) { const size_t tt = (size_t)(tok0 + 128 * (c) + 2 * F.lane); \
        if (!ML) { sl0 = SMALL[tt * 64 + hd]; sl1 = SMALL[(tt + 1) * 64 + hd]; } \
        else { sl0 = SMALL[tt * 64 + 32 + mh]; sl1 = SMALL[(tt + 1) * 64 + 32 + mh]; sl2 = SMALL[tt * 64 + 40 + mh]; sl3 = SMALL[(tt + 1) * 64 + 40 + mh]; } } } while (0)
#define MX_SOFTPLUS(x) ((x) > 20.f ? (x) : __logf(1.0f + __expf(x)))
#define MX_LOGSIG(x) (fminf((x), 0.f) - __logf(1.0f + __expf(-fabsf(x))))
#define MX_SCAN_A(c) do { if (w == 0) { \
        if (!ML) { const float d0 = MX_SOFTPLUS(sl0 + c_dtb), d1 = MX_SOFTPLUS(sl1 + c_dtb); \
            const float x0 = d0 * c_a, x1 = d1 * c_a; float incl = x0 + x1; \
            _Pragma("unroll") for (int d = 1; d < 64; d <<= 1) { const float t_ = __shfl_up(incl, d); if (F.lane >= d) incl += t_; } \
            const float cum1 = incl, cum0 = incl - x1, tot = __shfl(incl, 63); \
            vA0 = -cum0; vA1 = -cum1; vB0 = -cum0; vB1 = -cum1; vC0 = d0; vC1 = d1; vD0 = __expf(cum0); vD1 = __expf(cum1); vE0 = d0 * __expf(tot - cum0); vE1 = d1 * __expf(tot - cum1); vSA = __expf(tot); vSG = 1.0f; \
        } else { const float li0 = sl0 + c_ib, li1 = sl1 + c_ib; \
            const float x0 = MX_LOGSIG(sl2 + c_fb), x1 = MX_LOGSIG(sl3 + c_fb); float incl = x0 + x1; \
            _Pragma("unroll") for (int d = 1; d < 64; d <<= 1) { const float t_ = __shfl_up(incl, d); if (F.lane >= d) incl += t_; } \
            const float cum1 = incl, cum0 = incl - x1, btot = __shfl(incl, 63); \
            const float dd0 = li0 - cum0, dd1 = li1 - cum1; float im = fmaxf(dd0, dd1); \
            _Pragma("unroll") for (int d = 1; d < 64; d <<= 1) { const float t_ = __shfl_up(im, d); if (F.lane >= d) im = fmaxf(im, t_); } \
            float pm = __shfl_up(im, 1); if (F.lane == 0) pm = -3.0e38f; const float pmax0 = fmaxf(pm, dd0), pmax1 = im, pm127 = __shfl(im, 63); \
            const float M0 = fmaxf(mprev, pmax0), M1 = fmaxf(mprev, pmax1); \
            vA0 = dd0; vA1 = dd1; vB0 = M0; vB1 = M1; vD0 = qs * __expf(mprev - M0); vD1 = qs * __expf(mprev - M1); vG0 = __expf(-(cum0 + M0)); vG1 = __expf(-(cum1 + M1)); \
            const float mloc = btot + pm127, mnew = fmaxf(btot + mprev, mloc); \
            vSA = __expf(btot + mprev - mnew); vSG = __expf(mloc - mnew); vE0 = __expf(dd0 - pm127) * vSG; vE1 = __expf(dd1 - pm127) * vSG; mprev = mnew; } } } while (0)
#define MX_SCAN_B(c) do { if (w == 0) { \
        LAS float* vb = (LAS float*)(F.lds + MX_VEC + ((c) & 1) * MX_VECB); const int l0 = 2 * F.lane; \
        *(LAS f32x2*)(vb + l0) = (f32x2){vA0, vA1}; *(LAS f32x2*)(vb + 128 + l0) = (f32x2){vB0, vB1}; if (!ML) *(LAS f32x2*)(vb + 256 + l0) = (f32x2){vC0, vC1}; \
        *(LAS f32x2*)(vb + 384 + l0) = (f32x2){vD0, vD1}; *(LAS f32x2*)(vb + 512 + l0) = (f32x2){vE0, vE1}; if (ML) *(LAS f32x2*)(vb + 640 + l0) = (f32x2){vG0, vG1}; \
        if (F.lane == 0) { scal[2 * ((c) & 1)] = vSA; scal[2 * ((c) & 1) + 1] = vSG; } } } while (0)
#define MX_SCAN(c) do { MX_SCAN_L(c); MX_SCAN_A(c); MX_SCAN_B(c); } while (0)
#define MX_PREFETCH(c) do { const size_t tb_ = (size_t)(tok0 + 128 * (c)); \
        _Pragma("unroll") for (int i = 0; i < 2; ++i) { const int pid = tid + 512 * i, a2 = pid >> 4, k8 = pid & 15; \
            pq[2 * i] = *(const v4u*)(qsrc + (tb_ + 2 * a2) * ld + 8 * k8); pq[2 * i + 1] = *(const v4u*)(qsrc + (tb_ + 2 * a2 + 1) * ld + 8 * k8); \
            pk[2 * i] = *(const v4u*)(ksrc + (tb_ + 2 * a2) * ld + 8 * k8); pk[2 * i + 1] = *(const v4u*)(ksrc + (tb_ + 2 * a2 + 1) * ld + 8 * k8); } \
        { const int a2 = tid >> 3, v8 = tid & 7; pv[0] = *(const v4u*)(vsrc + (tb_ + 2 * a2) * ld + 8 * v8); pv[1] = *(const v4u*)(vsrc + (tb_ + 2 * a2 + 1) * ld + 8 * v8); } } while (0)
#define MX_WRITE(c) do { const LAS float* vb = (const LAS float*)(F.lds + MX_VEC + ((c) & 1) * MX_VECB); \
        _Pragma("unroll") for (int i = 0; i < 2; ++i) { const int pid = tid + 512 * i, a2 = pid >> 4, k8 = pid & 15, l = 2 * a2; \
            *(LAS v4u*)(QM + l * MX_PITCH + 16 * k8) = pq[2 * i]; *(LAS v4u*)(QM + (l + 1) * MX_PITCH + 16 * k8) = pq[2 * i + 1]; \
            *(LAS v4u*)(KM + l * MX_PITCH + 16 * k8) = pk[2 * i]; *(LAS v4u*)(KM + (l + 1) * MX_PITCH + 16 * k8) = pk[2 * i + 1]; \
            float f0[8], f1[8]; unpack8(pk[2 * i], f0); unpack8(pk[2 * i + 1], f1); const f32x2 wl = *(const LAS f32x2*)(vb + 512 + l); \
            _Pragma("unroll") for (int e = 0; e < 8; ++e) *(LAS unsigned*)(KW + mx_sw(8 * k8 + e, 2 * l)) = pg8::cvt_pk_bf16(f0[e] * wl.x, f1[e] * wl.y); } \
        { const int a2 = tid >> 3, v8 = tid & 7, l = 2 * a2; const v4u r0 = pv[0], r1 = pv[1]; LAS unsigned char* vp_ = VT + mx_sw(8 * v8, 2 * l); \
            *(LAS unsigned*)(vp_ + 0 * MX_PITCH) = (r0.x & 0xffffu) | (r1.x << 16); *(LAS unsigned*)(vp_ + 1 * MX_PITCH) = (r0.x >> 16) | (r1.x & 0xffff0000u); \
            *(LAS unsigned*)(vp_ + 2 * MX_PITCH) = (r0.y & 0xffffu) | (r1.y << 16); *(LAS unsigned*)(vp_ + 3 * MX_PITCH) = (r0.y >> 16) | (r1.y & 0xffff0000u); \
            *(LAS unsigned*)(vp_ + 4 * MX_PITCH) = (r0.z & 0xffffu) | (r1.z << 16); *(LAS unsigned*)(vp_ + 5 * MX_PITCH) = (r0.z >> 16) | (r1.z & 0xffff0000u); \
            *(LAS unsigned*)(vp_ + 6 * MX_PITCH) = (r0.w & 0xffffu) | (r1.w << 16); *(LAS unsigned*)(vp_ + 7 * MX_PITCH) = (r0.w >> 16) | (r1.w & 0xffff0000u); } \
        _Pragma("unroll") for (int j = 0; j < 4; ++j) { v2u sv; sv.x = pg8::cvt_pk_bf16(sacc[j][0], sacc[j][1]); sv.y = pg8::cvt_pk_bf16(sacc[j][2], sacc[j][3]); *(LAS v2u*)(SI + (16 * j + fr) * MX_PITCH + (16 * w + 4 * fq) * 2) = sv; } \
        if (ML && fq == 0) nvec[16 * w + fr] = nreg; } while (0)
    v4u zc0 = (v4u){0u, 0u, 0u, 0u}, zc1 = zc0;
    if (!ML) { const bf16* zp = PROJ + (size_t)(tok0 + 16 * w + (F.lane >> 2)) * NPROJ + PC_Z + hd * 64 + 16 * (F.lane & 3); zc0 = *(const v4u*)zp; zc1 = *(const v4u*)(zp + 8); }
    MX_SCAN(0);
    MX_PREFETCH(0);
    __syncthreads();
    MX_WRITE(0);
    __syncthreads();
    for (int c = 0; c < SEQ / 128; ++c) {
        const LAS float* vb = (const LAS float*)(F.lds + MX_VEC + (c & 1) * MX_VECB);
        const bool more = (c + 1 < SEQ / 128);
        if (more) { MX_SCAN_L(c + 1); MX_PREFETCH(c + 1); }
        bf16x8 qf[4];
#pragma unroll
        for (int ks = 0; ks < 4; ++ks) qf[ks] = lds_frag(QM, 16 * w + fr, 64 * ks + 16 * fq);
        const float mlv = vb[128 + 16 * w + fr];
        float dsum = 0.f;
        f32x4 y1[4];
#pragma unroll
        for (int j = 0; j < 4; ++j) y1[j] = (f32x4){0.f, 0.f, 0.f, 0.f};
        const f32x4 rs4 = *(const LAS f32x4*)(vb + 384 + 16 * w + 4 * fq);
#pragma unroll
        for (int ks = 0; ks < 4; ++ks) { bf16x8 sf[4];
#pragma unroll
            for (int j = 0; j < 4; ++j) sf[j] = lds_frag(SI, 16 * j + fr, 64 * ks + 16 * fq);
#pragma unroll
            for (int j = 0; j < 4; ++j) y1[j] = __builtin_amdgcn_mfma_f32_16x16x32_bf16(qf[ks], sf[j], y1[j], 0, 0, 0); }
#pragma unroll
        for (int j = 0; j < 4; ++j) y1[j] = y1[j] * rs4;
        __builtin_amdgcn_sched_barrier(0);
#pragma unroll 1
        for (int k2 = 0; 2 * k2 <= w; ++k2) {
            unsigned pw[4];
#pragma unroll
            for (int h = 0; h < 2; ++h) {
                const int si = 2 * k2 + h;
                f32x4 acc = (f32x4){0.f, 0.f, 0.f, 0.f};
#pragma unroll
                for (int ks = 0; ks < 4; ++ks) acc = __builtin_amdgcn_mfma_f32_16x16x32_bf16(lds_frag(KM, 16 * si + fr, 64 * ks + 16 * fq), qf[ks], acc, 0, 0, 0);
                const f32x4 e4 = *(const LAS f32x4*)(vb + 16 * si + 4 * fq); f32x4 x4 = (f32x4){qs, qs, qs, qs}; if (!ML) x4 = *(const LAS f32x4*)(vb + 256 + 16 * si + 4 * fq);
                float p[4];
#pragma unroll
                for (int r = 0; r < 4; ++r) { const float v = acc[r] * __expf(e4[r] - mlv) * x4[r]; const bool ok = (si < w) || (si == w && 4 * fq + r <= fr); p[r] = ok ? v : 0.f; }
                if (ML) dsum += (p[0] + p[1]) + (p[2] + p[3]);
                pw[2 * h] = cvt_pk_bf16_nop(p[0], p[1]); pw[2 * h + 1] = cvt_pk_bf16_nop(p[2], p[3]);
            }
            HWAIT();
            const v4u pwv = (v4u){pw[0], pw[1], pw[2], pw[3]}; const bf16x8 pf = __builtin_bit_cast(bf16x8, pwv);
#pragma unroll
            for (int j = 0; j < 4; ++j) { const int ho = j * 16 * MX_PITCH + ((k2 ^ (j >> 1)) << 6); const v2u lo = *(const LAS v2u*)(VT + vpb[j & 1][0] + ho), hi = *(const LAS v2u*)(VT + vpb[j & 1][1] + ho); const v4u vw = (v4u){lo.x, lo.y, hi.x, hi.y};
                y1[j] = __builtin_amdgcn_mfma_f32_16x16x32_bf16(pf, __builtin_bit_cast(bf16x8, vw), y1[j], 0, 0, 0); }
            HWAIT();
        }
        HSYNC();
        __builtin_amdgcn_sched_barrier(0);
        __builtin_amdgcn_sched_barrier(0);
        if (ML) {
            dsum += __shfl_xor(dsum, 16); dsum += __shfl_xor(dsum, 32);
            float d2 = 0.f;
#pragma unroll
            for (int ks = 0; ks < 4; ++ks) { float qv[8]; unpack8(__builtin_bit_cast(v4u, qf[ks]), qv); const f32x4 n0 = *(const LAS f32x4*)(nvec + 32 * ks + 8 * fq), n1 = *(const LAS f32x4*)(nvec + 32 * ks + 8 * fq + 4);
                d2 += qv[0] * n0.x + qv[1] * n0.y + qv[2] * n0.z + qv[3] * n0.w + qv[4] * n1.x + qv[5] * n1.y + qv[6] * n1.z + qv[7] * n1.w; }
            d2 += __shfl_xor(d2, 16); d2 += __shfl_xor(d2, 32);
            if (fq == 0) { exch[fr] = dsum; exch[16 + fr] = d2; }
        }
        HSYNC();
        __builtin_amdgcn_sched_barrier(0);
        LAS float* stg = (LAS float*)(QM + 16 * w * MX_PITCH);
        if (ML) { const f32x4 fl4 = *(const LAS f32x4*)(vb + 640 + 16 * w + 4 * fq); const f32x4 dA = *(const LAS f32x4*)(exch + 4 * fq), dB = *(const LAS f32x4*)(exch + 16 + 4 * fq);
#pragma unroll
            for (int r = 0; r < 4; ++r) { const float den = fmaxf(fabsf(dA[r] + rs4[r] * dB[r]), fl4[r]); const float inv = __builtin_amdgcn_rcpf(den);
#pragma unroll
                for (int j = 0; j < 4; ++j) stg[(4 * fq + r) * 68 + 16 * j + fr] = y1[j][r] * inv; }
        } else {
#pragma unroll
            for (int j = 0; j < 4; ++j) { const v2u xw = *(const LAS v2u*)(VT + mx_sw(16 * j + fr, 32 * w + 8 * fq)); const float xs[4] = {bflo(xw.x), bfhi(xw.x), bflo(xw.y), bfhi(xw.y)};
#pragma unroll
                for (int r = 0; r < 4; ++r) stg[(4 * fq + r) * 68 + 16 * j + fr] = y1[j][r] + c_D * xs[r]; }
        }
        {   const int erow = F.lane >> 2, ecs = F.lane & 3; const size_t trow = (size_t)(tok0 + 128 * c + 16 * w + erow);
            float yv[16];
#pragma unroll
            for (int i = 0; i < 4; ++i) { const f32x4 t4 = *(const LAS f32x4*)(stg + erow * 68 + 16 * ecs + 4 * i); yv[4 * i] = t4.x; yv[4 * i + 1] = t4.y; yv[4 * i + 2] = t4.z; yv[4 * i + 3] = t4.w; }
            if (!ML) { float zf[16]; { float t8[8]; unpack8(zc0, t8);
#pragma unroll
                    for (int i = 0; i < 8; ++i) zf[i] = t8[i]; unpack8(zc1, t8);
#pragma unroll
                    for (int i = 0; i < 8; ++i) zf[8 + i] = t8[i]; }
#pragma unroll
                for (int i = 0; i < 16; ++i) yv[i] = yv[i] * zf[i] * __builtin_amdgcn_rcpf(1.0f + __expf(-zf[i])); }
            float ss = 0.f;
#pragma unroll
            for (int i = 0; i < 16; ++i) ss += yv[i] * yv[i];
            ss += __shfl_xor(ss, 1); ss += __shfl_xor(ss, 2);
            if (ecs == 0) SSQ[(ML ? (size_t)TT * 32 : 0) + trow * 32 + (ML ? mh * 4 + vq : hd)] = ss;
            bf16* yp = YMIX + trow * 4096 + (ML ? 2048 + mh * 256 + vq * 64 : hd * 64) + 16 * ecs;
            *(v4u*)yp = (v4u){pg8::cvt_pk_bf16(yv[0], yv[1]), pg8::cvt_pk_bf16(yv[2], yv[3]), pg8::cvt_pk_bf16(yv[4], yv[5]), pg8::cvt_pk_bf16(yv[6], yv[7])};
            *(v4u*)(yp + 8) = (v4u){pg8::cvt_pk_bf16(yv[8], yv[9]), pg8::cvt_pk_bf16(yv[10], yv[11]), pg8::cvt_pk_bf16(yv[12], yv[13]), pg8::cvt_pk_bf16(yv[14], yv[15])};
            if (!ML && more) { const bf16* zp = PROJ + (size_t)(tok0 + 128 * (c + 1) + 16 * w + (F.lane >> 2)) * NPROJ + PC_Z + hd * 64 + 16 * (F.lane & 3); zc0 = *(const v4u*)zp; zc1 = *(const v4u*)(zp + 8); }
        }
        __builtin_amdgcn_sched_barrier(0);
        const float sa = scal[2 * (c & 1)];
#pragma unroll
        for (int j = 0; j < 4; ++j) sacc[j] = sacc[j] * sa;
        float nsum = 0.f;
#pragma unroll
        for (int ks = 0; ks < 4; ++ks) { const bf16x8 kf = *(const LAS bf16x8*)(KW + kwb + ((ks ^ kwh) << 6)); bf16x8 vf[4];
#pragma unroll
            for (int j = 0; j < 4; ++j) vf[j] = *(const LAS bf16x8*)(VT + vtb[j & 1] + j * 16 * MX_PITCH + ((ks ^ (j >> 1)) << 6));
            if (ML) { float kv[8]; unpack8(__builtin_bit_cast(v4u, kf), kv); nsum += ((kv[0] + kv[1]) + (kv[2] + kv[3])) + ((kv[4] + kv[5]) + (kv[6] + kv[7])); }
#pragma unroll
            for (int j = 0; j < 4; ++j) sacc[j] = __builtin_amdgcn_mfma_f32_16x16x32_bf16(kf, vf[j], sacc[j], 0, 0, 0); }
        if (ML) { nsum += __shfl_xor(nsum, 16); nsum += __shfl_xor(nsum, 32); nreg = nreg * sa + nsum; }
        if (more) { MX_SCAN_A(c + 1); }
        __syncthreads();
        if (more) { MX_SCAN_B(c + 1); }
        __syncthreads();
        if (more) { MX_WRITE(c + 1); }
        __syncthreads();
    }
#undef MX_SCAN
#undef MX_SCAN_A
#undef MX_SCAN_L
#undef MX_SOFTPLUS
#undef MX_LOGSIG
#undef MX_SCAN_B
#undef MX_PREFETCH
#undef MX_WRITE
}
__device__ __forceinline__ void phase_mixer(Frame& F) {
    for (int unit = F.bid; unit < 256; unit += F.G) { mixer_unit<false>(F, unit); mixer_unit<true>(F, unit); }
}

__device__ __forceinline__ void phase3(Frame& F) {
    const bf16* PROJ = (const bf16*)(F.ws + WS_PROJ); bf16* YMIX = (bf16*)(F.ws + WS_YMIX); const float* SSQ = (const float*)(F.ws + WS_SSQ);
    const int gw = F.bid * NWAVES + F.wave, NGW = F.G * NWAVES;
    for (int t = gw; t < TT; t += NGW) {
        bf16* yrow = YMIX + (size_t)t * 4096;
#pragma unroll
        for (int j = 0; j < 8; ++j) {
            const int c0 = (j * 64 + F.lane) * 8;
            float y[8]; unpack8(*(const v4u*)(yrow + c0), y);
            float o[8];
            if (j < 4) {
                const int g = c0 >> 9; const f32x4 s0 = *(const f32x4*)(SSQ + (size_t)t * 32 + g * 8), s1 = *(const f32x4*)(SSQ + (size_t)t * 32 + g * 8 + 4);
                const float ms = ((s0.x + s0.y) + (s0.z + s0.w) + (s1.x + s1.y) + (s1.z + s1.w)) * (1.0f / 512.0f);
                const float rs = 1.0f / sqrtf(ms + EPSF);
                const f32x4 w0 = *(const f32x4*)(F.ssd_norm_w + c0), w1 = *(const f32x4*)(F.ssd_norm_w + c0 + 4);
                o[0] = y[0] * rs * w0.x; o[1] = y[1] * rs * w0.y; o[2] = y[2] * rs * w0.z; o[3] = y[3] * rs * w0.w;
                o[4] = y[4] * rs * w1.x; o[5] = y[5] * rs * w1.y; o[6] = y[6] * rs * w1.z; o[7] = y[7] * rs * w1.w;
            } else {
                const int cc = c0 - 2048, h = cc >> 8; const f32x4 s0 = *(const f32x4*)(SSQ + (size_t)TT * 32 + (size_t)t * 32 + h * 4);
                const float ms = ((s0.x + s0.y) + (s0.z + s0.w)) * (1.0f / 256.0f);
                const float rs = 1.0f / sqrtf(ms + EPSF);
                const f32x4 w0 = *(const f32x4*)(F.ml_norm_w + cc), w1 = *(const f32x4*)(F.ml_norm_w + cc + 4);
                float og[8]; unpack8(*(const v4u*)(PROJ + (size_t)t * NPROJ + PC_O + cc), og);
                const float wv[8] = {w0.x, w0.y, w0.z, w0.w, w1.x, w1.y, w1.z, w1.w};
#pragma unroll
                for (int i = 0; i < 8; ++i) o[i] = y[i] * rs * wv[i] * (1.0f / (1.0f + __expf(-og[i])));
            }
            v4u ov; ov.x = pk2(o[0], o[1]); ov.y = pk2(o[2], o[3]); ov.z = pk2(o[4], o[5]); ov.w = pk2(o[6], o[7]);
            *(v4u*)(yrow + c0) = ov;
        }
    }
}

__device__ __forceinline__ void phase5(Frame& F) {
    const float* H2 = (const float*)(F.ws + WS_H2); const float* Wrt = (const float*)(F.ws + WS_WRT); bf16* XN2 = (bf16*)(F.ws + WS_XN2);
    int* EIDX = (int*)(F.ws + WS_ROUTE); int* RANK = EIDX + TT * 4; float* GATE = (float*)(RANK + TT * 4);
    LAS float* xT = (LAS float*)(F.lds + F.wave * 8192); LAS float* lg = (LAS float*)(F.lds + 65536 + F.wave * 1024);
    LAS int* cntl = (LAS int*)(F.lds + 73728); LAS int* baseg = cntl + 32;
    const int gw = F.bid * NWAVES + F.wave, NGW = F.G * NWAVES, ntask = TT / 8, iters = (ntask + NGW - 1) / NGW;
    for (int itx = 0; itx < iters; ++itx) {
        const int task = itx * NGW + gw; const bool valid = task < ntask; const int t0 = task * 8;
        if (F.tid < 32) cntl[F.tid] = 0;
        __syncthreads();
        float rstd[8]; int me[4] = {0, 0, 0, 0}, mr[4] = {0, 0, 0, 0}; float mg[4] = {0.f, 0.f, 0.f, 0.f};
#pragma unroll
        for (int k = 0; k < 8; ++k) rstd[k] = 0.f;
        if (valid) {
            float acc[8], ssq[8];
#pragma unroll
            for (int k = 0; k < 8; ++k) { acc[k] = 0.f; ssq[k] = 0.f; }
            const int e = F.lane & 31, dh = F.lane >> 5;
            for (int dc = 0; dc < 8; ++dc) {
#pragma unroll
                for (int jj = 0; jj < 4; ++jj) { float xv[8];
#pragma unroll
                    for (int k = 0; k < 8; ++k) { xv[k] = H2[(size_t)(t0 + k) * DM + dc * 256 + jj * 64 + F.lane]; ssq[k] += xv[k] * xv[k]; }
                    LAS float* dp = xT + (jj * 64 + F.lane) * 8; *(LAS f32x4*)dp = (f32x4){xv[0], xv[1], xv[2], xv[3]}; *(LAS f32x4*)(dp + 4) = (f32x4){xv[4], xv[5], xv[6], xv[7]}; }
                LDS_WAIT(); asm volatile("" ::: "memory");
                const float* wp = Wrt + (size_t)(dc * 256 + dh * 128) * 32 + e; const LAS float* xp = xT + dh * 128 * 8;
#pragma unroll 4
                for (int i = 0; i < 128; ++i) { const float w = wp[i * 32]; const f32x4 xa = *(const LAS f32x4*)(xp + i * 8), xb = *(const LAS f32x4*)(xp + i * 8 + 4);
                    acc[0] += w * xa.x; acc[1] += w * xa.y; acc[2] += w * xa.z; acc[3] += w * xa.w; acc[4] += w * xb.x; acc[5] += w * xb.y; acc[6] += w * xb.z; acc[7] += w * xb.w; }
                LDS_WAIT(); asm volatile("" ::: "memory");
            }
            const float rb = F.router_b[e];
#pragma unroll
            for (int k = 0; k < 8; ++k) { rstd[k] = 1.0f / sqrtf(wave_sum(ssq[k]) * (1.0f / 2048.0f) + EPSF);
                const float v = (acc[k] + __shfl_xor(acc[k], 32)) * rstd[k] + rb; if (F.lane < 32) lg[k * 32 + e] = v; }
            LDS_WAIT(); asm volatile("" ::: "memory");
            if (F.lane < 8) {
                const LAS float* lp = lg + F.lane * 32; float bv[4]; int bi[4] = {-1, -1, -1, -1};
#pragma unroll
                for (int p = 0; p < 4; ++p) { float best = -3.0e38f; int bidx = 0;
                    for (int q = 0; q < 32; ++q) { const float v = lp[q]; const bool taken = (q == bi[0]) | (q == bi[1]) | (q == bi[2]) | (q == bi[3]); if (!taken && v > best) { best = v; bidx = q; } }
                    bv[p] = best; bi[p] = bidx; }
                const float p1 = expf(bv[1] - bv[0]), p2 = expf(bv[2] - bv[0]), p3 = expf(bv[3] - bv[0]); const float inv = 1.0f / (1.0f + p1 + p2 + p3);
                mg[0] = inv; mg[1] = p1 * inv; mg[2] = p2 * inv; mg[3] = p3 * inv;
#pragma unroll
                for (int p = 0; p < 4; ++p) { me[p] = bi[p]; mr[p] = __hip_atomic_fetch_add(cntl + bi[p], 1, __ATOMIC_RELAXED, __HIP_MEMORY_SCOPE_WORKGROUP); }
            }
        }
        __syncthreads();
        if (F.tid < 32) { const int c = cntl[F.tid]; int gb = 0; if (c > 0) gb = (int)__hip_atomic_fetch_add((unsigned*)(F.ctl + CW_CNT + 64 * F.tid), (unsigned)c, RLX_AGENT); baseg[F.tid] = gb; }
        __syncthreads();
        if (valid) {
            if (F.lane < 8) { const size_t t = (size_t)(t0 + F.lane);
#pragma unroll
                for (int p = 0; p < 4; ++p) { EIDX[t * 4 + p] = me[p]; RANK[t * 4 + p] = baseg[me[p]] + mr[p]; GATE[t * 4 + p] = mg[p]; } }
#pragma unroll
            for (int k = 0; k < 8; ++k) { const f32x4* xr = (const f32x4*)(H2 + (size_t)(t0 + k) * DM) + F.lane; const f32x4* wr = (const f32x4*)F.norm2_w + F.lane; int* o4 = (int*)((unsigned char*)XN2 + (size_t)(t0 + k) * DM) + F.lane;
#pragma unroll
                for (int j = 0; j < 8; ++j) { const f32x4 v = xr[64 * j], ww = wr[64 * j]; int o = __builtin_amdgcn_cvt_pk_fp8_f32(v.x * rstd[k] * ww.x, v.y * rstd[k] * ww.y, 0, false); o = __builtin_amdgcn_cvt_pk_fp8_f32(v.z * rstd[k] * ww.z, v.w * rstd[k] * ww.w, o, true); o4[64 * j] = o; } }
        }
        __syncthreads();
    }
}
__device__ __forceinline__ void phase5b(Frame& F) {
    const bf16* XN2 = (const bf16*)(F.ws + WS_XN2); bf16* XG = (bf16*)(F.ws + WS_XG);
    const int* EIDX = (const int*)(F.ws + WS_ROUTE); const int* RANK = EIDX + TT * 4; const float* GATE = (const float*)(RANK + TT * 4); int* SLOT = (int*)(GATE + TT * 4); float* SGATE = (float*)(SLOT + TT * 4);
    LAS int* sbase = (LAS int*)(F.lds); LAS int* spad = sbase + 32;
    if (F.tid < 32) { const int c = (int)__hip_atomic_load((unsigned*)(F.ctl + CW_CNT + 64 * F.tid), RLX_AGENT); spad[F.tid] = (c + 255) & ~255; }
    __syncthreads();
    if (F.tid == 0) { int a = 0; for (int e = 0; e < 32; ++e) { sbase[e] = a; a += spad[e]; } }
    __syncthreads();
    const int gw = F.bid * NWAVES + F.wave, NGW = F.G * NWAVES;
    for (int task = gw; task < TT / 8; task += NGW) {
#pragma unroll 2
        for (int k = 0; k < 8; ++k) { const size_t t = (size_t)task * 8 + k;
            int slot = 0;
            if (F.lane < 4) { const int e = EIDX[t * 4 + F.lane]; slot = sbase[e] + RANK[t * 4 + F.lane]; SLOT[t * 4 + F.lane] = slot; SGATE[slot] = GATE[t * 4 + F.lane]; }
            const int s0 = __shfl(slot, 0), s1 = __shfl(slot, 1), s2 = __shfl(slot, 2), s3 = __shfl(slot, 3);
            const v4u* src = (const v4u*)((const unsigned char*)XN2 + t * DM) + F.lane; v4u d[2];
#pragma unroll
            for (int j = 0; j < 2; ++j) d[j] = src[64 * j];
            v4u* d0 = (v4u*)((unsigned char*)XG + (size_t)s0 * DM) + F.lane; v4u* d1 = (v4u*)((unsigned char*)XG + (size_t)s1 * DM) + F.lane; v4u* d2 = (v4u*)((unsigned char*)XG + (size_t)s2 * DM) + F.lane; v4u* d3 = (v4u*)((unsigned char*)XG + (size_t)s3 * DM) + F.lane;
#pragma unroll
            for (int j = 0; j < 2; ++j) { d0[64 * j] = d[j]; d1[64 * j] = d[j]; d2[64 * j] = d[j]; d3[64 * j] = d[j]; }
        }
    }
}
__device__ __forceinline__ int build_moe_tab(Frame& F) {
    LAS unsigned char* tab = (LAS unsigned char*)(F.lds + TAB_OFF); LAS int* tinfo = (LAS int*)(F.lds + TAB_OFF + 320);
    if (F.tid < 32) { const int c = (int)__hip_atomic_load((unsigned*)(F.ctl + CW_CNT + 64 * F.tid), RLX_AGENT); tinfo[4 + F.tid] = (c + 255) >> 8; }
    __syncthreads();
    if (F.tid == 0) { int a = 0; for (int e = 0; e < 32; ++e) { const int n = tinfo[4 + e]; for (int j = 0; j < n; ++j) tab[a + j] = (unsigned char)e; a += n; } tinfo[0] = a; }
    __syncthreads();
    return tinfo[0];
}
__device__ __forceinline__ void phase8(Frame& F) {
    const float* H2 = (const float*)(F.ws + WS_H2); const bf16* YR = (const bf16*)(F.ws + WS_YR);
    const int* SLOT = (const int*)(F.ws + WS_ROUTE) + TT * 12;
    const int gw = F.bid * NWAVES + F.wave, NGW = F.G * NWAVES;
    for (int t = gw; t < TT; t += NGW) {
        int slot = 0; if (F.lane < 4) slot = SLOT[(size_t)t * 4 + F.lane];
        int sl[4]; sl[0] = __shfl(slot, 0); sl[1] = __shfl(slot, 1); sl[2] = __shfl(slot, 2); sl[3] = __shfl(slot, 3);
        float v[4][8]; float ss = 0.f;
#pragma unroll
        for (int j = 0; j < 4; ++j) { const int pz = F.lane + 64 * j; const f32x4 a = *(const f32x4*)(H2 + (size_t)t * DM + 8 * pz), b = *(const f32x4*)(H2 + (size_t)t * DM + 8 * pz + 4);
            v[j][0] = a.x; v[j][1] = a.y; v[j][2] = a.z; v[j][3] = a.w; v[j][4] = b.x; v[j][5] = b.y; v[j][6] = b.z; v[j][7] = b.w; }
#pragma unroll
        for (int k = 0; k < 4; ++k)
#pragma unroll
            for (int j = 0; j < 4; ++j) { float f[8]; unpack8(*((const v4u*)(YR + (size_t)sl[k] * DM) + F.lane + 64 * j), f);
#pragma unroll
                for (int i = 0; i < 8; ++i) v[j][i] += f[i]; }
#pragma unroll
        for (int j = 0; j < 4; ++j)
#pragma unroll
            for (int i = 0; i < 8; ++i) ss += v[j][i] * v[j][i];
        const float rstd = 1.0f / sqrtf(wave_sum(ss) * (1.0f / 2048.0f) + EPSF);
#pragma unroll
        for (int j = 0; j < 4; ++j) { const int pz = F.lane + 64 * j; const f32x4 w0 = *(const f32x4*)(F.final_norm_w + 8 * pz), w1 = *(const f32x4*)(F.final_norm_w + 8 * pz + 4);
            *(f32x4*)(F.out + (size_t)t * DM + 8 * pz) = (f32x4){v[j][0] * rstd * w0.x, v[j][1] * rstd * w0.y, v[j][2] * rstd * w0.z, v[j][3] * rstd * w0.w};
            *(f32x4*)(F.out + (size_t)t * DM + 8 * pz + 4) = (f32x4){v[j][4] * rstd * w1.x, v[j][5] * rstd * w1.y, v[j][6] * rstd * w1.z, v[j][7] * rstd * w1.w}; }
    }
}

struct Args { const float* in[21]; float* out; unsigned char* ws; int ph_lo, ph_hi, li, pad; };
__global__ void __launch_bounds__(NWAVES * 64, 2) hymba_fwd(Args args) {
    extern __shared__ __attribute__((aligned(16))) unsigned char lds[];
    Frame F;
    F.lds = (LAS unsigned char*)lds; F.MISC = (volatile LAS unsigned*)(F.lds + MISC_OFF);
    F.tid = threadIdx.x; F.lane = F.tid & 63; F.wave = __builtin_amdgcn_readfirstlane(F.tid >> 6); F.G = gridDim.x; F.bid = blockIdx.x;
    F.ws = args.ws; F.ctl = (gu32*)(args.ws + WS_CTL); F.out = args.out;
    F.x = args.in[0]; F.norm1_w = args.in[1]; F.w_in = args.in[2]; F.conv_w = args.in[3]; F.conv_b = args.in[4]; F.dt_bias = args.in[5]; F.a_log = args.in[6]; F.d_skip = args.in[7]; F.ssd_norm_w = args.in[8];
    F.i_bias = args.in[9]; F.f_bias = args.in[10]; F.ml_norm_w = args.in[11]; F.w_out = args.in[12]; F.norm2_w = args.in[13]; F.router_w = args.in[14]; F.router_b = args.in[15];
    F.w_gate_up = args.in[16]; F.b_gate_up = args.in[17]; F.w_down = args.in[18]; F.b_down = args.in[19]; F.final_norm_w = args.in[20];
    for (int u = F.tid; u < (LDS_BYTES - LDSCTL_OFF) / 4; u += NWAVES * 64) ((LAS unsigned*)(F.lds + LDSCTL_OFF))[u] = 0u;
    __syncthreads();
    XcdBarrier bar; bar.bar = (unsigned*)(F.ctl + CW_BAR) + args.li * XCD_BAR_WORDS; bar.x = 0; bar.st = nullptr;
    const bool use_bar = (args.ph_hi - args.ph_lo) > 1;
    if (use_bar) bar = xcd_barrier_post((unsigned*)(F.ctl + CW_BAR) + args.li * XCD_BAR_WORDS, F.MISC + 8);
    const int lo = args.ph_lo, hi = args.ph_hi;
#ifndef PHASE_MASK
#define PHASE_MASK 0x7ff
#endif
#define IN(k) (((PHASE_MASK >> (k)) & 1) && lo <= (k) && (k) < hi)
#define SEAM(k) do { if (IN(k) && IN((k) + 1)) xcd_barrier(bar); } while (0)
    if (IN(0)) { phase0(F); } SEAM(0);
    if (IN(1)) {
        pg8::Gemm g{(const pg8::bf16_t*)(F.ws + WS_XN1), (const pg8::bf16_t*)(F.ws + WS_WIN), TT, NPROJ, DM}; pg8::StaticOrder S; S.init(TT, NPROJ, F.G, F.bid);
        pg8::EpiBf16 E{(pg8::bf16_t*)(F.ws + WS_PROJ), NPROJ};
        pg8::gemm_phase<pg8::EpiBf16, pg8::StaticOrder, true, true>(F.lds, g, S, E);
        p1_small(F);
    } SEAM(1);
    if (IN(2)) { phase_conv(F); } SEAM(2);
    if (IN(3)) { phase_mixer(F); } SEAM(3);
    if (IN(4)) { phase3(F); } SEAM(4);
    if (IN(5)) {
        pg8::Gemm g{(const pg8::bf16_t*)(F.ws + WS_YMIX), (const pg8::bf16_t*)(F.ws + WS_WOUT), TT, DM, 4096}; pg8::StaticOrder S; S.init(TT, DM, F.G, F.bid);
        pg8::EpiResF32 E{(float*)(F.ws + WS_H2), F.x, DM};
        pg8::gemm_phase<pg8::EpiResF32, pg8::StaticOrder, true, true>(F.lds, g, S, E);
    } SEAM(5);
    if (IN(6)) { phase5(F); } SEAM(6);
    if (IN(7)) { phase5b(F); } SEAM(7);
    if (IN(8)) {
        const int nM = build_moe_tab(F);
        pg8::Gemm g{(const pg8::bf16_t*)(F.ws + WS_XG), (const pg8::bf16_t*)(F.ws + WS_WGU), nM * 256, 4096, DM};
        pg8::MoeOrder S{nM, 16, 4, nM * 16, F.G, F.bid, (const PG8_LAS unsigned char*)(F.lds + TAB_OFF)};
        pg8::EpiSwiglu E{(unsigned char*)(F.ws + WS_ACT), F.b_gate_up};
        pg8::gemm_phase<pg8::EpiSwiglu, pg8::MoeOrder, true, true, true>(F.lds, g, S, E);
    } SEAM(8);
    if (IN(9)) {
        const int nM = build_moe_tab(F);
        pg8::Gemm g{(const pg8::bf16_t*)(F.ws + WS_ACT), (const pg8::bf16_t*)(F.ws + WS_WD), nM * 256, 2048, DM};
        pg8::MoeOrder S{nM, 8, 3, nM * 8, F.G, F.bid, (const PG8_LAS unsigned char*)(F.lds + TAB_OFF)};
        pg8::EpiDown E{(pg8::bf16_t*)(F.ws + WS_YR), F.b_down, (const float*)((const int*)(F.ws + WS_ROUTE) + TT * 16)};
        pg8::gemm_phase<pg8::EpiDown, pg8::MoeOrder, true, true, true>(F.lds, g, S, E);
    } SEAM(9);
    if (IN(10)) { phase8(F); }
#undef IN
#undef SEAM
}

extern "C" void kernel_launch(void* const* d_in, const int* in_sizes, int n_in, void* d_out, int out_size, void* d_ws, size_t ws_size, hipStream_t stream) {
    static int grid = 0;
    if (grid == 0) {
        if (n_in != 21 || out_size != TT * DM || ws_size < WS_END) { fprintf(stderr, "kernel_launch: unexpected problem (n_in %d, out %d, ws %zu); nothing launched\n", n_in, out_size, ws_size); grid = -1; return; }
        int dev = 0, cus = 0, per_cu = 0;
        if (hipGetDevice(&dev) != hipSuccess || hipDeviceGetAttribute(&cus, hipDeviceAttributeMultiprocessorCount, dev) != hipSuccess) { grid = -1; return; }
        if (hipFuncSetAttribute((const void*)hymba_fwd, hipFuncAttributeMaxDynamicSharedMemorySize, LDS_BYTES) != hipSuccess) { fprintf(stderr, "kernel_launch: hipFuncSetAttribute failed\n"); grid = -1; return; }
        if (hipOccupancyMaxActiveBlocksPerMultiprocessor(&per_cu, (const void*)hymba_fwd, NWAVES * 64, LDS_BYTES) != hipSuccess || per_cu < 1) { fprintf(stderr, "kernel_launch: occupancy query says %d blocks per CU\n", per_cu); }
        (void)hipGetLastError();
        grid = cus;
    }
    if (grid < 0) return;
    (void)hipMemsetAsync((char*)d_ws + WS_CTL, 0, CTL_ZERO_BYTES, stream);
    Args a{};
    for (int i = 0; i < 21; ++i) a.in[i] = (const float*)d_in[i];
    a.out = (float*)d_out; a.ws = (unsigned char*)d_ws; a.pad = 0;
#if MK_PER_PHASE
    for (int li = 0; li < N_PHASES; ++li) { a.ph_lo = li; a.ph_hi = li + 1; a.li = li; hipLaunchKernelGGL(hymba_fwd, dim3(grid), dim3(NWAVES * 64), LDS_BYTES, stream, a); }
#else
    a.ph_lo = 0; a.ph_hi = N_PHASES; a.li = 0;
    hipLaunchKernelGGL(hymba_fwd, dim3(grid), dim3(NWAVES * 64), LDS_BYTES, stream, a);
#endif
}
```

```cpp
#include <hip/hip_runtime.h>
#include <cstdio>
#include <cstdint>
namespace pg8 {
#define PG8_LAS __attribute__((address_space(3)))
typedef unsigned short bf16_t;
typedef short bf16x8 __attribute__((ext_vector_type(8)));
typedef float f32x4 __attribute__((ext_vector_type(4)));
typedef unsigned u32x4 __attribute__((ext_vector_type(4)));
constexpr int BM = 256, BK = 64, HALF = 128, HTB = HALF * BK * 2  , STAGE_BYTES = 8 * HTB, NXCD = 8, WGM = 8;

__host__ __device__ __forceinline__ int lds_byte(int r, int c) { const int st = (r >> 4) * 2 + (c >> 5), rr = r & 15, cc = c & 31, ob = rr * 64 + cc * 2; return st * 1024 + (ob ^ (((ob >> 9) & 1) << 5)); }
__host__ __device__ __forceinline__ void stage_rc(int b, int& R, int& C) { const int st = b / 1024, sb = b % 1024, swz = sb ^ (((sb >> 9) & 1) << 5); R = (st >> 1) * 16 + swz / 64; C = (st & 1) * 32 + (swz % 64) / 2; }
__host__ __device__ __forceinline__ int perm32(int rho) { const int n = rho >> 4, i = rho & 15; return 8 * (i >> 2) + 4 * n + (i & 3); }

struct Unit { int pm, pn; };
struct Gemm { const bf16_t* A; const bf16_t* Bt; int M, N, K; };

struct StaticOrder {
    int nM, nN, nwg, G, c;
    __host__ __device__ void init(int M, int N, int G_, int c_) { nM = M / BM; nN = N / BM; nwg = nM * nN; G = G_; c = c_; }
    __host__ __device__ bool next(int i, Unit& u) const {
        const long L = (long)i * G + c; if (L >= nwg) return false;
        int wgid = (int)L; { const int q = nwg / NXCD, r = nwg % NXCD, xcd = wgid % NXCD, off = wgid / NXCD; wgid = (xcd < r ? xcd * (q + 1) : r * (q + 1) + (xcd - r) * q) + off; }
        const int nig = WGM * nN, gid = wgid / nig, fm = gid * WGM, gsz = (nM - fm) < WGM ? (nM - fm) : WGM;
        u.pm = fm + ((wgid % nig) % gsz); u.pn = (wgid % nig) / gsz; return true;
    }
    __device__ __forceinline__ void a_ready(const Unit&) const {}
    __device__ __forceinline__ void done(const Unit&) const {}
};


__device__ __forceinline__ unsigned cvt_pk_bf16(float lo, float hi) { unsigned r; asm volatile("v_cvt_pk_bf16_f32 %0, %1, %2" : "=v"(r) : "v"(lo), "v"(hi)); return r; }
typedef unsigned u32x2 __attribute__((ext_vector_type(2)));

struct EpiBf16 {
    static constexpr bool PERM = true, AFTER_DRAIN = false;
    bf16_t* O; int ldc;
    __device__ __forceinline__ void operator()(const f32x4 (&acc)[2][2][4][2], const Unit& u, int wr, int wc, int fr, int fq) const {
        const int row0 = u.pm * BM + wr * 64 + fr; const int col0 = u.pn * BM + wc * 32 + 8 * fq;
#pragma unroll
        for (int ai = 0; ai < 2; ++ai)
#pragma unroll
            for (int m = 0; m < 4; ++m) { bf16_t* rowp = O + (size_t)(row0 + ai * HALF + m * 16) * ldc + col0;
#pragma unroll
                for (int bj = 0; bj < 2; ++bj) { const f32x4 v0 = acc[ai][bj][m][0], v1 = acc[ai][bj][m][1];
                    u32x4 w; w.x = cvt_pk_bf16(v0[0], v0[1]); w.y = cvt_pk_bf16(v0[2], v0[3]); w.z = cvt_pk_bf16(v1[0], v1[1]); w.w = cvt_pk_bf16(v1[2], v1[3]);
                    *(u32x4*)(rowp + bj * HALF) = w; } }
    }
};
struct EpiResF32 {
    static constexpr bool PERM = false, AFTER_DRAIN = false;
    float* C; const float* base; int ldc;
    __device__ __forceinline__ void operator()(const f32x4 (&acc)[2][2][4][2], const Unit& u, int wr, int wc, int fr, int fq) const {
        const int row0 = u.pm * BM + wr * 64 + fr, col0 = u.pn * BM + wc * 32 + 4 * fq;
#pragma unroll
        for (int ai = 0; ai < 2; ++ai)
#pragma unroll
            for (int m = 0; m < 4; ++m) { const size_t off = (size_t)(row0 + ai * HALF + m * 16) * ldc + col0;
#pragma unroll
                for (int bj = 0; bj < 2; ++bj)
#pragma unroll
                    for (int n = 0; n < 2; ++n) *(f32x4*)(C + off + bj * HALF + n * 16) = acc[ai][bj][m][n] + *(const f32x4*)(base + off + bj * HALF + n * 16); }
    }
};
__device__ __forceinline__ float swiglu1(float a, float b) {
    const float glu = fminf(a, 7.0f), lin = fminf(fmaxf(b, -7.0f), 7.0f);
    return glu * (1.0f / (1.0f + __expf(-1.702f * glu))) * (lin + 1.0f);
}
struct EpiSwiglu {
    static constexpr bool PERM = true, AFTER_DRAIN = false;
    unsigned char* O; const float* bias;
    __device__ __forceinline__ void operator()(const f32x4 (&acc)[2][2][4][2], const Unit& u, int wr, int wc, int fr, int fq) const {
        const int e = u.pn >> 4, pnl = u.pn & 15;
        const int row0 = u.pm * BM + wr * 64 + fr; const int hcol0 = pnl * BM + wc * 32 + 8 * fq;
        const float* bp = bias + (size_t)e * 4096 + hcol0;
        f32x4 bv[2][2];
#pragma unroll
        for (int bj = 0; bj < 2; ++bj)
#pragma unroll
            for (int n = 0; n < 2; ++n) bv[bj][n] = *(const f32x4*)(bp + bj * HALF + 4 * n);
#pragma unroll
        for (int ai = 0; ai < 2; ++ai)
#pragma unroll
            for (int m = 0; m < 4; ++m) { unsigned char* rowp = O + (size_t)(row0 + ai * HALF + m * 16) * 2048 + (hcol0 >> 1);
#pragma unroll
                for (int bj = 0; bj < 2; ++bj) { const f32x4 v0 = acc[ai][bj][m][0] + bv[bj][0], v1 = acc[ai][bj][m][1] + bv[bj][1];
                    int w = __builtin_amdgcn_cvt_pk_fp8_f32(swiglu1(v0[0], v0[1]), swiglu1(v0[2], v0[3]), 0, false);
                    w = __builtin_amdgcn_cvt_pk_fp8_f32(swiglu1(v1[0], v1[1]), swiglu1(v1[2], v1[3]), w, true);
                    *(int*)(rowp + bj * 64) = w; } }
    }
};
struct EpiDown {
    static constexpr bool PERM = true, AFTER_DRAIN = false;
    bf16_t* O; const float* bias; const float* sgate;
    __device__ __forceinline__ void operator()(const f32x4 (&acc)[2][2][4][2], const Unit& u, int wr, int wc, int fr, int fq) const {
        const int e = u.pn >> 3, pnl = u.pn & 7;
        const int row0 = u.pm * BM + wr * 64 + fr; const int col0 = pnl * BM + wc * 32 + 8 * fq;
        const float* bp = bias + (size_t)e * 2048 + col0;
        f32x4 bv[2][2];
#pragma unroll
        for (int bj = 0; bj < 2; ++bj)
#pragma unroll
            for (int n = 0; n < 2; ++n) bv[bj][n] = *(const f32x4*)(bp + bj * HALF + 4 * n);
#pragma unroll
        for (int ai = 0; ai < 2; ++ai)
#pragma unroll
            for (int m = 0; m < 4; ++m) { const int row = row0 + ai * HALF + m * 16; const float gt = sgate[row]; bf16_t* rowp = O + (size_t)row * 2048 + col0;
#pragma unroll
                for (int bj = 0; bj < 2; ++bj) { const f32x4 v0 = (acc[ai][bj][m][0] + bv[bj][0]) * gt, v1 = (acc[ai][bj][m][1] + bv[bj][1]) * gt;
                    u32x4 w; w.x = cvt_pk_bf16(v0[0], v0[1]); w.y = cvt_pk_bf16(v0[2], v0[3]); w.z = cvt_pk_bf16(v1[0], v1[1]); w.w = cvt_pk_bf16(v1[2], v1[3]);
                    *(u32x4*)(rowp + bj * HALF) = w; } }
    }
};
struct MoeOrder {
    int nM, nN, nsh, nwg, G, c; const PG8_LAS unsigned char* tab;
    __device__ __forceinline__ bool next(int i, Unit& u) const {
        const long L = (long)i * G + c; if (L >= nwg) return false;
        int wgid = (int)L; { const int q = nwg / NXCD, r = nwg % NXCD, xcd = wgid % NXCD, off = wgid / NXCD; wgid = (xcd < r ? xcd * (q + 1) : r * (q + 1) + (xcd - r) * q) + off; }
        const int nig = WGM * nN, gid = wgid / nig, fm = gid * WGM, gsz = (nM - fm) < WGM ? (nM - fm) : WGM;
        const int pm = fm + ((wgid % nig) % gsz), pnl = (wgid % nig) / gsz;
        u.pm = pm; u.pn = ((int)tab[pm] << nsh) + pnl; return true;
    }
    __device__ __forceinline__ void a_ready(const Unit&) const {}
    __device__ __forceinline__ void done(const Unit&) const {}
};
typedef int v8i32 __attribute__((ext_vector_type(8)));
__device__ __forceinline__ v8i32 pg8_cat(const bf16x8 lo, const bf16x8 hi) { typedef int v4i32 __attribute__((ext_vector_type(4))); const v4i32 a = __builtin_bit_cast(v4i32, lo), b = __builtin_bit_cast(v4i32, hi); return __builtin_shufflevector(a, b, 0, 1, 2, 3, 4, 5, 6, 7); }
template <class Epi, class Sched, bool ALIGN_EPI = false, bool SP2 = false, bool F8 = false>
__device__ __forceinline__ void gemm_phase(PG8_LAS unsigned char* lds, const Gemm g, const Sched& S, const Epi& E) {
    const int tid = threadIdx.x, wid = __builtin_amdgcn_readfirstlane(tid >> 6), lane = tid & 63, wr = wid >> 2, wc = wid & 3, fr = lane & 15, fq = lane >> 4;
    const int K = g.K, KB = F8 ? K : 2 * K, nt = KB / 128;
    unsigned voffA[2], voffB[2];
#pragma unroll
    for (int i = 0; i < 2; ++i) { int R, C; stage_rc(tid * 16 + i * 8192, R, C); const int Rb = Epi::PERM ? ((R & ~31) + perm32(R & 31)) : R;
        voffA[i] = (unsigned)(R * KB + C * 2); voffB[i] = (unsigned)(Rb * KB + C * 2); }
    const size_t kstep = (size_t)(BK * 2);
    const size_t hstep = (size_t)HALF * KB;
    const size_t tstep = 2 * hstep;
    const unsigned ldsw = (unsigned)wid * 1024u;
    int aoffk[2], boffk[2];
#pragma unroll
    for (int h = 0; h < 2; ++h) { aoffk[h] = lds_byte(wr * 64 + fr, fq * 8) + h * 1024; boffk[h] = lds_byte(wc * 32 + fr, fq * 8) + h * 1024; }
#define PG8_SA(b, h) (((b) * 2 + (h)) * HTB)
#define PG8_SB(b, h) ((4 + (b) * 2 + (h)) * HTB)
#define PG8_STAGE(bufoff, gbase, voff) do { _Pragma("unroll") for (int _i = 0; _i < 2; ++_i) \
        __builtin_amdgcn_global_load_lds((const unsigned*)((const char*)(gbase) + (voff)[_i]), (PG8_LAS unsigned*)(lds + (bufoff) + ldsw + _i * 8192), 16, 0, 0); } while (0)
#define PG8_LDA(dst, b, h) do { if constexpr (F8) { _Pragma("unroll") for (int m = 0; m < 4; ++m) dst##8[m] = pg8_cat(*(const PG8_LAS bf16x8*)(lds + PG8_SA(b, h) + aoffk[0] + m * 2048), *(const PG8_LAS bf16x8*)(lds + PG8_SA(b, h) + aoffk[1] + m * 2048)); } \
        else { _Pragma("unroll") for (int m = 0; m < 4; ++m) _Pragma("unroll") for (int k = 0; k < 2; ++k) dst[m][k] = *(const PG8_LAS bf16x8*)(lds + PG8_SA(b, h) + aoffk[k] + m * 2048); } } while (0)
#define PG8_LDB(dst, b, h) do { if constexpr (F8) { _Pragma("unroll") for (int n = 0; n < 2; ++n) dst##8[n] = pg8_cat(*(const PG8_LAS bf16x8*)(lds + PG8_SB(b, h) + boffk[0] + n * 2048), *(const PG8_LAS bf16x8*)(lds + PG8_SB(b, h) + boffk[1] + n * 2048)); } \
        else { _Pragma("unroll") for (int n = 0; n < 2; ++n) _Pragma("unroll") for (int k = 0; k < 2; ++k) dst[n][k] = *(const PG8_LAS bf16x8*)(lds + PG8_SB(b, h) + boffk[k] + n * 2048); } } while (0)
#define PG8_MMA(ai, bj, At, Bt) do { __builtin_amdgcn_s_setprio(1); \
        if constexpr (F8) { _Pragma("unroll") for (int m = 0; m < 4; ++m) _Pragma("unroll") for (int n = 0; n < 2; ++n) \
            asm volatile("v_mfma_scale_f32_16x16x128_f8f6f4 %0, %1, %2, %0, %3, %4 op_sel_hi:[0,0,0]" : "+v"(acc[ai][bj][m][n]) : "v"(Bt##8[n]), "v"(At##8[m]), "v"(sc_w), "v"(sc_a)); } \
        else { _Pragma("unroll") for (int m = 0; m < 4; ++m) _Pragma("unroll") for (int n = 0; n < 2; ++n) _Pragma("unroll") for (int k = 0; k < 2; ++k) \
            acc[ai][bj][m][n] = __builtin_amdgcn_mfma_f32_16x16x32_bf16(Bt[n][k], At[m][k], acc[ai][bj][m][n], 0, 0, 0); } \
        __builtin_amdgcn_s_setprio(0); } while (0)
#define PG8_WAIT_V(n) asm volatile("s_waitcnt vmcnt(" #n ")" ::: "memory")
#define PG8_WAIT_L(n) asm volatile("s_waitcnt lgkmcnt(" #n ")" ::: "memory")
#define PG8_BAR __builtin_amdgcn_s_barrier()
#define PG8_SCHED __builtin_amdgcn_sched_barrier(0)
    Unit cur, nxt; int ui = 0;
    if (!S.next(0, cur)) return;
    f32x4 acc[2][2][4][2];
#pragma unroll
    for (int a = 0; a < 2; ++a)
#pragma unroll
        for (int b = 0; b < 2; ++b)
#pragma unroll
            for (int m = 0; m < 4; ++m)
#pragma unroll
                for (int n = 0; n < 2; ++n) acc[a][b][m][n] = (f32x4){0.f, 0.f, 0.f, 0.f};
    const int sc_w = 0x79797979, sc_a = 0x7f7f7f7f;
    bf16x8 At[4][2], B0[2][2], B1[2][2]; v8i32 At8[4], B08[2], B18[2];
    const char* cA = (const char*)g.A + (size_t)cur.pm * tstep; const char* cB = (const char*)g.Bt + (size_t)cur.pn * tstep;
    S.a_ready(cur);
    if constexpr (SP2) {
        PG8_STAGE(PG8_SB(0, 0), cB, voffB); PG8_STAGE(PG8_SB(0, 1), cB + hstep, voffB); PG8_STAGE(PG8_SA(0, 0), cA, voffA); PG8_STAGE(PG8_SA(0, 1), cA + hstep, voffA);
        if (wr == 1) PG8_BAR;
        PG8_WAIT_V(2); PG8_BAR;
        PG8_STAGE(PG8_SB(1, 0), cB + kstep, voffB); PG8_STAGE(PG8_SA(1, 0), cA + kstep, voffA); PG8_STAGE(PG8_SB(1, 1), cB + hstep + kstep, voffB);
        PG8_WAIT_V(6); PG8_BAR;
    } else {
        PG8_STAGE(PG8_SB(0, 0), cB, voffB); PG8_STAGE(PG8_SA(0, 0), cA, voffA); PG8_STAGE(PG8_SB(0, 1), cB + hstep, voffB); PG8_STAGE(PG8_SA(0, 1), cA + hstep, voffA);
        if (wr == 1) PG8_BAR;
        PG8_WAIT_V(4); PG8_BAR;
        PG8_STAGE(PG8_SB(1, 0), cB + kstep, voffB); PG8_STAGE(PG8_SA(1, 0), cA + kstep, voffA); PG8_STAGE(PG8_SB(1, 1), cB + hstep + kstep, voffB);
        PG8_WAIT_V(6); PG8_BAR;
    }
    for (;;) {
        const bool has_next = S.next(ui + 1, nxt);
        const char* nA = has_next ? (const char*)g.A + (size_t)nxt.pm * tstep : cA; const char* nB = has_next ? (const char*)g.Bt + (size_t)nxt.pn * tstep : cB;
        for (int t = 0; t < nt; t += 2) {
            const bool last = (t == nt - 2);
            const char* a1 = cA + (size_t)(t + 1) * kstep;
            const char* a2 = last ? nA : cA + (size_t)(t + 2) * kstep; const char* b2 = last ? nB : cB + (size_t)(t + 2) * kstep;
            const char* a3 = a2 + kstep; const char* b3 = b2 + kstep;
            if (last && has_next) S.a_ready(nxt);
            if constexpr (SP2) {
            PG8_LDB(B0, 0, 0); PG8_LDB(B1, 0, 1); PG8_SCHED; PG8_LDA(At, 0, 0); PG8_STAGE(PG8_SA(1, 1), a1 + hstep, voffA);
            PG8_WAIT_V(8); PG8_WAIT_L(0); PG8_BAR; PG8_MMA(0, 0, At, B0); PG8_MMA(0, 1, At, B1); PG8_BAR; PG8_SCHED;
            PG8_LDA(At, 0, 1); PG8_STAGE(PG8_SB(0, 0), b2, voffB); PG8_STAGE(PG8_SB(0, 1), b2 + hstep, voffB); PG8_STAGE(PG8_SA(0, 0), a2, voffA);
            PG8_WAIT_V(8); PG8_WAIT_L(0); PG8_BAR; PG8_MMA(1, 0, At, B0); PG8_MMA(1, 1, At, B1); PG8_BAR; PG8_SCHED;
            PG8_LDB(B0, 1, 0); PG8_LDB(B1, 1, 1); PG8_SCHED; PG8_LDA(At, 1, 0); PG8_STAGE(PG8_SA(0, 1), a2 + hstep, voffA);
            PG8_WAIT_V(8); PG8_WAIT_L(0); PG8_BAR; PG8_MMA(0, 0, At, B0); PG8_MMA(0, 1, At, B1); PG8_BAR; PG8_SCHED;
            PG8_LDA(At, 1, 1); PG8_STAGE(PG8_SB(1, 0), b3, voffB); PG8_STAGE(PG8_SB(1, 1), b3 + hstep, voffB); PG8_STAGE(PG8_SA(1, 0), a3, voffA);
            PG8_WAIT_V(8); PG8_WAIT_L(0); PG8_BAR; PG8_MMA(1, 0, At, B0); PG8_MMA(1, 1, At, B1); PG8_BAR; PG8_SCHED;
            } else {
            PG8_LDB(B0, 0, 0); PG8_SCHED; PG8_LDA(At, 0, 0); PG8_STAGE(PG8_SA(1, 1), a1 + hstep, voffA);
            PG8_WAIT_L(8); PG8_BAR; PG8_WAIT_L(0); PG8_MMA(0, 0, At, B0); PG8_BAR; PG8_SCHED;
            PG8_LDB(B1, 0, 1); PG8_STAGE(PG8_SB(0, 0), b2, voffB);
            PG8_BAR; PG8_WAIT_L(0); PG8_MMA(0, 1, At, B1); PG8_BAR;
            PG8_LDA(At, 0, 1); PG8_STAGE(PG8_SA(0, 0), a2, voffA);
            PG8_BAR; PG8_WAIT_L(0); PG8_MMA(1, 0, At, B0); PG8_BAR; PG8_SCHED;
            PG8_STAGE(PG8_SB(0, 1), b2 + hstep, voffB);
            PG8_WAIT_V(6); PG8_BAR; PG8_MMA(1, 1, At, B1); PG8_BAR;
            PG8_LDB(B0, 1, 0); PG8_SCHED; PG8_LDA(At, 1, 0); PG8_STAGE(PG8_SA(0, 1), a2 + hstep, voffA);
            PG8_WAIT_L(8); PG8_BAR; PG8_WAIT_L(0); PG8_MMA(0, 0, At, B0); PG8_BAR; PG8_SCHED;
            PG8_LDB(B1, 1, 1); PG8_STAGE(PG8_SB(1, 0), b3, voffB);
            PG8_BAR; PG8_WAIT_L(0); PG8_MMA(0, 1, At, B1); PG8_BAR;
            PG8_LDA(At, 1, 1); PG8_STAGE(PG8_SA(1, 0), a3, voffA);
            PG8_BAR; PG8_WAIT_L(0); PG8_MMA(1, 0, At, B0); PG8_BAR; PG8_SCHED;
            PG8_STAGE(PG8_SB(1, 1), b3 + hstep, voffB);
            PG8_WAIT_V(6); PG8_BAR; PG8_MMA(1, 1, At, B1); PG8_BAR;
            }
        }
        if constexpr (ALIGN_EPI) { if (wr == 0) PG8_BAR; }
        if constexpr (F8) asm volatile("s_nop 15\n\ts_nop 15" ::: "memory");
        if constexpr (!Epi::AFTER_DRAIN) { E(acc, cur, wr, wc, fr, fq); S.done(cur); }
        if (!has_next) break;
#pragma unroll
        for (int a = 0; a < 2; ++a)
#pragma unroll
            for (int b = 0; b < 2; ++b)
#pragma unroll
                for (int m = 0; m < 4; ++m)
#pragma unroll
                    for (int n = 0; n < 2; ++n) acc[a][b][m][n] = (f32x4){0.f, 0.f, 0.f, 0.f};
        cur = nxt; cA = nA; cB = nB; ++ui;
        if constexpr (ALIGN_EPI) { if (wr == 1) PG8_BAR; }
    }
    PG8_WAIT_V(0);
    if constexpr (!ALIGN_EPI) { if (wr == 0) PG8_BAR; }
    PG8_BAR;
    if constexpr (Epi::AFTER_DRAIN) { E.fused(acc, cur, wr, wc, fr, fq, lds, wid, lane); S.done(cur); }
#undef PG8_SA
#undef PG8_SB
#undef PG8_STAGE
#undef PG8_LDA
#undef PG8_LDB
#undef PG8_MMA
#undef PG8_WAIT_V
#undef PG8_WAIT_L
#undef PG8_BAR
#undef PG8_SCHED
}
}

constexpr int NWAVES = 8;
constexpr int TT = 16384, DM = 2048, SEQ = 2048;
constexpr int NPROJ = 11264;
constexpr int PC_Z = 0, PC_XBC = 2048, PC_Q = 5120, PC_K = 6144, PC_V = 7168, PC_O = 9216;
constexpr int WIN_LD = 11312;
constexpr int NSLOT = 65536 + 32 * 256;
constexpr float EPSF = 1e-5f;
#ifndef HSYNC_ON
#define HSYNC_ON 0
#endif
#define HWAIT() do { if (HSYNC_ON) asm volatile("s_waitcnt vmcnt(0) lgkmcnt(0)\n\ts_nop 15\n\ts_nop 15" ::: "memory"); } while (0)
#define HSYNC() do { if (HSYNC_ON) { HWAIT(); __syncthreads(); } } while (0)
#ifndef MK_PER_PHASE
#define MK_PER_PHASE 0
#endif
constexpr int N_PHASES = 11;

constexpr size_t MiB = 1u << 20;
constexpr size_t WS_CTL = 0, CTL_ZERO_BYTES = 1 * MiB;
constexpr size_t WS_WIN = 2 * MiB, WS_WSM = 46 * MiB, WS_WRT = 47 * MiB, WS_WOUT = 48 * MiB, WS_WGU = 64 * MiB, WS_WD = 576 * MiB;
constexpr size_t WS_XN1 = 832 * MiB, WS_PROJ = 896 * MiB, WS_SMALL = 1248 * MiB, WS_SSQ = 1252 * MiB, WS_YMIX = 1256 * MiB, WS_H2 = 1384 * MiB, WS_XN2 = 1512 * MiB;
constexpr size_t WS_ROUTE = 1576 * MiB, WS_XG = 1578 * MiB, WS_ACT = 1866 * MiB, WS_YR = 2154 * MiB, WS_XC = 2442 * MiB, WS_END = 2538 * MiB;
constexpr int CW_BAR = 4096;
constexpr int CW_CNT = 65536;

constexpr int RING_BYTES = 131072;
constexpr int LDS_BYTES = 147456;
constexpr int LDSCTL_OFF = LDS_BYTES - 576, MISC_OFF = LDSCTL_OFF;
constexpr int TAB_OFF = LDSCTL_OFF + 64;

#define GAS __attribute__((address_space(1)))
#define LAS __attribute__((address_space(3)))
typedef unsigned short bf16;
typedef unsigned v4u __attribute__((ext_vector_type(4)));
typedef unsigned v2u __attribute__((ext_vector_type(2)));
typedef float f32x4 __attribute__((ext_vector_type(4)));
typedef float f32x2 __attribute__((ext_vector_type(2)));
typedef short bf16x8 __attribute__((ext_vector_type(8)));
typedef GAS unsigned gu32;
#define RLX_AGENT __ATOMIC_RELAXED, __HIP_MEMORY_SCOPE_AGENT
#define LDS_WAIT() asm volatile("s_waitcnt lgkmcnt(0)" ::: "memory")
#define VM_WAIT() asm volatile("s_waitcnt vmcnt(0)" ::: "memory")
__device__ __forceinline__ unsigned f2bf(float f) { unsigned u = __builtin_bit_cast(unsigned, f); return (u + 0x7fffu + ((u >> 16) & 1u)) >> 16; }
__device__ __forceinline__ unsigned pk2(float lo, float hi) { return f2bf(lo) | (f2bf(hi) << 16); }
__device__ __forceinline__ float bflo(unsigned w) { return __builtin_bit_cast(float, w << 16); }
__device__ __forceinline__ float bfhi(unsigned w) { return __builtin_bit_cast(float, w & 0xffff0000u); }
__device__ __forceinline__ float wave_sum(float v) {
#pragma unroll
    for (int o = 1; o < 64; o <<= 1) v += __shfl_xor(v, o);
    return v;
}
__device__ __forceinline__ float softplusf(float x) { return x > 20.f ? x : log1pf(expf(x)); }
__device__ __forceinline__ float logsigf(float x) { return fminf(x, 0.f) - log1pf(expf(-fabsf(x))); }
__device__ __forceinline__ float siluf(float v) { return v / (1.0f + __expf(-v)); }

#define XB_TMO      128
#define XB_XCNT(j)  (256  + 64 * (j))
#define XB_XSUB(j)  (1280 + 64 * (j))
#define XB_XGEN(j)  (2304 + 64 * (j))
#define XB_TOP      3328
#define XB_TOPGEN   3392
#define XCD_BAR_WORDS 3456
#define XB_SPIN_CAP (1u << 18)

__device__ __forceinline__ unsigned xb_ld(unsigned* p)              { return __hip_atomic_load(p, __ATOMIC_RELAXED, __HIP_MEMORY_SCOPE_AGENT); }
__device__ __forceinline__ unsigned xb_add(unsigned* p, unsigned v) { return __hip_atomic_fetch_add(p, v, __ATOMIC_RELAXED, __HIP_MEMORY_SCOPE_AGENT); }
__device__ __forceinline__ unsigned xb_xcc_id() { return (unsigned)__builtin_amdgcn_s_getreg((3 << 11) | 20) & 0xFu; }
#define XB_SPIN(cond, bar) do { unsigned _sp = 0; while (cond) { __builtin_amdgcn_s_sleep(1); \
    if ((++_sp & 255u) == 0u) { if (xb_ld(&(bar)[XB_TMO])) break; if (_sp > XB_SPIN_CAP) { atomicAdd(&(bar)[XB_TMO], 1u); break; } } } } while (0)

struct XcdBarrier {
    unsigned* bar; unsigned x;
    volatile LAS unsigned* st;
};

__device__ __forceinline__ XcdBarrier xcd_barrier_post(unsigned* bar, volatile LAS unsigned* st) {
    XcdBarrier b; b.bar = bar; b.x = xb_xcc_id(); b.st = st;
    if (threadIdx.x == 0) (void)xb_add(&bar[XB_XCNT(b.x)], 1u);
    return b;
}
__device__ __forceinline__ void xcd_barrier_complete(unsigned* bar, unsigned x, unsigned& nloc, unsigned& nx) {
    const unsigned G = gridDim.x * gridDim.y * gridDim.z;
    unsigned sum, cnt, mine, sp = 0u;
    for (;;) {
        sum = 0u; cnt = 0u; mine = 0u;
#pragma unroll
        for (unsigned j = 0; j < 16; ++j) { const unsigned c = xb_ld(&bar[XB_XCNT(j)]); sum += c; cnt += (c > 0u) ? 1u : 0u; mine = (j == x) ? c : mine; }
        if (sum == G) break;
        __builtin_amdgcn_s_sleep(1);
        if ((++sp & 255u) == 0u) { if (xb_ld(&bar[XB_TMO])) break; if (sp > XB_SPIN_CAP) { atomicAdd(&bar[XB_TMO], 1u); break; } }
    }
    nloc = mine > 0u ? mine : 1u; nx = cnt > 0u ? cnt : 1u;
}

__device__ __forceinline__ void xcd_barrier(const XcdBarrier& b) {
    asm volatile("s_waitcnt vmcnt(0)" ::: "memory");
    __syncthreads();
    if (threadIdx.x == 0) {
        unsigned* bar = b.bar;
        __builtin_amdgcn_s_waitcnt(0);
        unsigned nloc = b.st[0], nx = b.st[1];
        if (nloc == 0u) { xcd_barrier_complete(bar, b.x, nloc, nx); b.st[0] = nloc; b.st[1] = nx; }
        const unsigned old = xb_add(&bar[XB_XSUB(b.x)], 1u);
        const unsigned gen = old / nloc;
        if (old + 1u == (gen + 1u) * nloc) {
            __builtin_amdgcn_fence(__ATOMIC_RELEASE, "agent");
            asm volatile("s_waitcnt vmcnt(0)" ::: "memory");
            const unsigned og = xb_add(&bar[XB_TOP], 1u);
            const unsigned tg = og / nx;
            if (og + 1u == (tg + 1u) * nx) xb_add(&bar[XB_TOPGEN], 1u);
            else XB_SPIN(xb_ld(&bar[XB_TOPGEN]) == tg, bar);
            __builtin_amdgcn_fence(__ATOMIC_ACQUIRE, "agent");
            xb_add(&bar[XB_XGEN(b.x)], 1u);
            asm volatile("s_waitcnt vmcnt(0)" ::: "memory");
        } else {
            XB_SPIN(xb_ld(&bar[XB_XGEN(b.x)]) == gen, bar);
            __builtin_amdgcn_fence(__ATOMIC_ACQUIRE, "agent");
            asm volatile("s_waitcnt vmcnt(0)" ::: "memory");
        }
    }
    __syncthreads();
}

struct Frame {
    LAS unsigned char* lds;
    volatile LAS unsigned* MISC;
    gu32* ctl;
    int tid, lane, wave, G, bid;
    const float *x, *norm1_w, *w_in, *conv_w, *conv_b, *dt_bias, *a_log, *d_skip, *ssd_norm_w, *i_bias, *f_bias, *ml_norm_w, *w_out, *norm2_w, *router_w, *router_b, *w_gate_up, *b_gate_up, *w_down, *b_down, *final_norm_w;
    float* out; unsigned char* ws;
};

__device__ __forceinline__ void p0_transpose_item(const float* W, int ldw, int K, bf16* WT, int dst_row0, int src_col0, int k0, LAS float* scr, int lane) {
#pragma unroll 8
    for (int i = 0; i < 32; ++i) { const int kk = 2 * i + (lane >> 5); scr[kk * 33 + (lane & 31)] = W[(size_t)(k0 + kk) * ldw + src_col0 + (lane & 31)]; }
    LDS_WAIT(); asm volatile("" ::: "memory");
    const int c = lane & 7;
#pragma unroll
    for (int j = 0; j < 4; ++j) { const int n = (lane >> 3) + 8 * j; const LAS float* s = scr + (8 * c) * 33 + n;
        v4u o; o.x = pk2(s[0 * 33], s[1 * 33]); o.y = pk2(s[2 * 33], s[3 * 33]); o.z = pk2(s[4 * 33], s[5 * 33]); o.w = pk2(s[6 * 33], s[7 * 33]);
        *(v4u*)(WT + (size_t)(dst_row0 + n) * K + k0 + 8 * c) = o; }
    LDS_WAIT(); asm volatile("" ::: "memory");
}
__device__ __forceinline__ void p0_transpose_item_f8(const float* W, int ldw, int K, unsigned char* WT, int dst_row0, int src_col0, int k0, LAS float* scr, int lane) {
#pragma unroll 8
    for (int i = 0; i < 32; ++i) { const int kk = 2 * i + (lane >> 5); scr[kk * 33 + (lane & 31)] = W[(size_t)(k0 + kk) * ldw + src_col0 + (lane & 31)] * 64.0f; }
    LDS_WAIT(); asm volatile("" ::: "memory");
    const int c = lane & 3;
#pragma unroll
    for (int j = 0; j < 2; ++j) { const int n = (lane >> 2) + 16 * j; const LAS float* s = scr + (16 * c) * 33 + n; int o[4];
#pragma unroll
        for (int q = 0; q < 4; ++q) { int w = __builtin_amdgcn_cvt_pk_fp8_f32(s[(4 * q) * 33], s[(4 * q + 1) * 33], 0, false); o[q] = __builtin_amdgcn_cvt_pk_fp8_f32(s[(4 * q + 2) * 33], s[(4 * q + 3) * 33], w, true); }
        *(v4u*)(WT + (size_t)(dst_row0 + n) * K + k0 + 16 * c) = (v4u){(unsigned)o[0], (unsigned)o[1], (unsigned)o[2], (unsigned)o[3]}; }
    LDS_WAIT(); asm volatile("" ::: "memory");
}
template <bool F8> __device__ __forceinline__ void p0_transpose128(const float* W, int ldw, int K, void* WTv, int dst_row0, int src_col0, int k0, LAS float* scr, int lane) {
    const float* src = W + (size_t)(k0 + (lane >> 3)) * ldw + src_col0 + 4 * (lane & 7);
    f32x4 v[16];
#pragma unroll
    for (int i = 0; i < 16; ++i) v[i] = *(const f32x4*)(src + (size_t)(8 * i) * ldw);
#pragma unroll
    for (int i = 0; i < 16; ++i) { LAS float* d = scr + (8 * i + (lane >> 3)) * 33 + 4 * (lane & 7); d[0] = v[i].x; d[1] = v[i].y; d[2] = v[i].z; d[3] = v[i].w; }
    LDS_WAIT(); asm volatile("" ::: "memory");
    const int n = lane & 31, hf = lane >> 5; const LAS float* s = scr + (64 * hf) * 33 + n;
    if (F8) { unsigned char* dst = (unsigned char*)WTv + (size_t)(dst_row0 + n) * K + k0 + 64 * hf;
#pragma unroll
        for (int j = 0; j < 4; ++j) { int o[4];
#pragma unroll
            for (int q = 0; q < 4; ++q) { const LAS float* p = s + (16 * j + 4 * q) * 33; int w = __builtin_amdgcn_cvt_pk_fp8_f32(p[0] * 64.0f, p[33] * 64.0f, 0, false); o[q] = __builtin_amdgcn_cvt_pk_fp8_f32(p[66] * 64.0f, p[99] * 64.0f, w, true); }
            *(v4u*)(dst + 16 * j) = (v4u){(unsigned)o[0], (unsigned)o[1], (unsigned)o[2], (unsigned)o[3]}; }
    } else { bf16* dst = (bf16*)WTv + (size_t)(dst_row0 + n) * K + k0 + 64 * hf;
#pragma unroll
        for (int j = 0; j < 8; ++j) { const LAS float* p = s + (8 * j) * 33;
            *(v4u*)(dst + 8 * j) = (v4u){pk2(p[0], p[33]), pk2(p[66], p[99]), pk2(p[132], p[165]), pk2(p[198], p[231])}; }
    }
    LDS_WAIT(); asm volatile("" ::: "memory");
}
__device__ __forceinline__ void rms_row_to_bf16(const float* xrow, const float* w, bf16* orow, int lane) {
    const f32x4* xr = (const f32x4*)xrow + lane; const f32x4* wr = (const f32x4*)w + lane;
    f32x4 v[8]; float s = 0.f;
#pragma unroll
    for (int j = 0; j < 8; ++j) { v[j] = xr[64 * j]; s += (v[j].x * v[j].x + v[j].y * v[j].y) + (v[j].z * v[j].z + v[j].w * v[j].w); }
    const float rstd = 1.0f / sqrtf(wave_sum(s) * (1.0f / 2048.0f) + EPSF);
    v2u* o8 = (v2u*)orow + lane;
#pragma unroll
    for (int j = 0; j < 8; ++j) { const f32x4 ww = wr[64 * j]; v2u o; o.x = pk2(v[j].x * rstd * ww.x, v[j].y * rstd * ww.y); o.y = pk2(v[j].z * rstd * ww.z, v[j].w * rstd * ww.w); o8[64 * j] = o; }
}
__device__ __forceinline__ void phase0(Frame& F) {
    LAS float* scr = (LAS float*)(F.lds + F.wave * 16896);
    const int gw = F.bid * NWAVES + F.wave, NGW = F.G * NWAVES;
    bf16* WinT = (bf16*)(F.ws + WS_WIN); bf16* WsT = (bf16*)(F.ws + WS_WSM); float* Wrt = (float*)(F.ws + WS_WRT); bf16* WoutT = (bf16*)(F.ws + WS_WOUT);
    unsigned char* WguT = (unsigned char*)(F.ws + WS_WGU); unsigned char* WdT = (unsigned char*)(F.ws + WS_WD); bf16* XN1 = (bf16*)(F.ws + WS_XN1);
    constexpr int I_IN = 16 * 352, I_OUT = 32 * 64, I_GU = 32 * 2048, I_D = 32 * 1024, NITEMS = I_IN + I_OUT + I_GU + I_D;
    for (int it = gw; it < NITEMS; it += NGW) {
        int r = it;
        if (r < I_IN) { const int kb = r / 352, nb = r % 352, n0 = nb * 32; p0_transpose128<false>(F.w_in, WIN_LD, 2048, WinT, n0, n0 + (n0 >= 5120 ? 32 : 0), kb * 128, scr, F.lane); continue; } r -= I_IN;
        if (r < I_OUT) { const int kb = r >> 6, nb = r & 63; p0_transpose128<false>(F.w_out, 2048, 4096, WoutT, nb * 32, nb * 32, kb * 128, scr, F.lane); continue; } r -= I_OUT;
        if (r < I_GU) { const int e = r >> 11, rr = r & 2047, kb = rr >> 7, nb = rr & 127; p0_transpose128<true>(F.w_gate_up + (size_t)e * 2048 * 4096, 4096, 2048, WguT + (size_t)e * 4096 * 2048, nb * 32, nb * 32, kb * 128, scr, F.lane); continue; } r -= I_GU;
        { const int e = r >> 10, rr = r & 1023, kb = rr >> 6, nb = rr & 63; p0_transpose128<true>(F.w_down + (size_t)e * 2048 * 2048, 2048, 2048, WdT + (size_t)e * 2048 * 2048, nb * 32, nb * 32, kb * 128, scr, F.lane); }
    }
    for (int i = gw * 64 + F.lane; i < 64 * 2048; i += NGW * 64) { const int j = i >> 11, k = i & 2047;
        const int col = j < 32 ? 5120 + j : (j < 40 ? 11296 + (j - 32) : 11304 + (j - 40));
        WsT[i] = (bf16)(j < 48 ? f2bf(F.w_in[(size_t)k * WIN_LD + col]) : 0u); }
    for (int i = gw * 64 + F.lane; i < 2048 * 32; i += NGW * 64) Wrt[i] = F.norm2_w[i >> 5] * F.router_w[i];
    for (int m = gw; m < TT; m += NGW) rms_row_to_bf16(F.x + (size_t)m * DM, F.norm1_w, XN1 + (size_t)m * DM, F.lane);
}

__device__ __forceinline__ void p1_small(Frame& F) {
    const bf16* XN1 = (const bf16*)(F.ws + WS_XN1); const bf16* WsT = (const bf16*)(F.ws + WS_WSM); float* SMALL = (float*)(F.ws + WS_SMALL);
    const int gw = F.bid * NWAVES + F.wave, NGW = F.G * NWAVES, fr = F.lane & 15, fq = F.lane >> 4;
    for (int task = gw; task < TT / 16; task += NGW) {
        const int t0 = task * 16;
        f32x4 acc[4];
#pragma unroll
        for (int n = 0; n < 4; ++n) acc[n] = (f32x4){0.f, 0.f, 0.f, 0.f};
        const bf16* arow = XN1 + (size_t)(t0 + fr) * DM + 8 * fq; const bf16* brow = WsT + (size_t)fr * DM + 8 * fq;
#pragma unroll 16
        for (int ks = 0; ks < 64; ++ks) {
            const bf16x8 a = *(const bf16x8*)(arow + 32 * ks);
#pragma unroll
            for (int n = 0; n < 4; ++n) { const bf16x8 b = *(const bf16x8*)(brow + (size_t)n * 16 * DM + 32 * ks); acc[n] = __builtin_amdgcn_mfma_f32_16x16x32_bf16(a, b, acc[n], 0, 0, 0); }
        }
#pragma unroll
        for (int n = 0; n < 4; ++n)
#pragma unroll
            for (int r = 0; r < 4; ++r) SMALL[(size_t)(t0 + 4 * fq + r) * 64 + n * 16 + fr] = acc[n][r];
    }
}

__device__ __forceinline__ void unpack8(const v4u r, float (&f)[8]) { f[0] = bflo(r.x); f[1] = bfhi(r.x); f[2] = bflo(r.y); f[3] = bfhi(r.y); f[4] = bflo(r.z); f[5] = bfhi(r.z); f[6] = bflo(r.w); f[7] = bfhi(r.w); }

__device__ __forceinline__ void phase_conv(Frame& F) {
    const bf16* PROJ = (const bf16*)(F.ws + WS_PROJ); bf16* XC = (bf16*)(F.ws + WS_XC);
    constexpr int TB = 16, NCG = 384, NIT = (TT / TB) * NCG;
    for (int it = F.bid * (NWAVES * 64) + F.tid; it < NIT; it += F.G * NWAVES * 64) {
        const int cg = it % NCG, tb = it / NCG, ch = cg * 8, t0 = tb * TB; const bool seq0 = (t0 % SEQ) == 0;
        float w[4][8], bs[8];
#pragma unroll
        for (int j = 0; j < 4; ++j) { const f32x4 a = *(const f32x4*)(F.conv_w + j * 3072 + ch), b = *(const f32x4*)(F.conv_w + j * 3072 + ch + 4);
            w[j][0] = a.x; w[j][1] = a.y; w[j][2] = a.z; w[j][3] = a.w; w[j][4] = b.x; w[j][5] = b.y; w[j][6] = b.z; w[j][7] = b.w; }
        { const f32x4 a = *(const f32x4*)(F.conv_b + ch), b = *(const f32x4*)(F.conv_b + ch + 4); bs[0] = a.x; bs[1] = a.y; bs[2] = a.z; bs[3] = a.w; bs[4] = b.x; bs[5] = b.y; bs[6] = b.z; bs[7] = b.w; }
        const bf16* src = PROJ + (size_t)t0 * NPROJ + PC_XBC + ch;
        float r0[8], r1[8], r2[8], r3[8];
        if (seq0) {
#pragma unroll
            for (int i = 0; i < 8; ++i) { r0[i] = 0.f; r1[i] = 0.f; r2[i] = 0.f; }
        } else { unpack8(*(const v4u*)(src - 3 * (size_t)NPROJ), r0); unpack8(*(const v4u*)(src - 2 * (size_t)NPROJ), r1); unpack8(*(const v4u*)(src - (size_t)NPROJ), r2); }
        v4u rw[TB];
#pragma unroll
        for (int l = 0; l < TB; ++l) rw[l] = *(const v4u*)(src + (size_t)l * NPROJ);
#pragma unroll
        for (int l = 0; l < TB; ++l) {
            unpack8(rw[l], r3);
            float o[8];
#pragma unroll
            for (int i = 0; i < 8; ++i) { const float v = bs[i] + w[0][i] * r0[i] + w[1][i] * r1[i] + w[2][i] * r2[i] + w[3][i] * r3[i]; o[i] = siluf(v); r0[i] = r1[i]; r1[i] = r2[i]; r2[i] = r3[i]; }
            v4u ov; ov.x = pk2(o[0], o[1]); ov.y = pk2(o[2], o[3]); ov.z = pk2(o[4], o[5]); ov.w = pk2(o[6], o[7]);
            *(v4u*)(XC + (size_t)(t0 + l) * 3072 + ch) = ov;
        }
    }
}

constexpr int MX_PITCH = 272;
static_assert(true, "");
constexpr int MX_QM = 0, MX_KM = 34816, MX_KW = 69632, MX_VT = 104448, MX_SI = 121856, MX_VEC = 139264, MX_VECB = 3072, MX_NVEC = MX_VEC + 2 * MX_VECB, MX_SCAL = MX_NVEC + 512, MX_END = MX_SCAL + 64;
__device__ __forceinline__ unsigned cvt_pk_bf16_nop(float lo, float hi) { unsigned r; asm volatile("v_cvt_pk_bf16_f32 %0, %1, %2\n\ts_nop 1" : "=v"(r) : "v"(lo), "v"(hi)); return r; }
__device__ __forceinline__ int mx_sw(int row, int tbyte) { return row * MX_PITCH + ((((tbyte >> 4) ^ (row >> 3)) & 15) << 4) + (tbyte & 15); }
__device__ __forceinline__ bf16x8 lds_frag(const LAS unsigned char* img, int row, int kbyte) { return *(const LAS bf16x8*)(img + row * MX_PITCH + kbyte); }
static_assert(MX_END <= LDSCTL_OFF, "mixer LDS map");
template <bool ML> __device__ __forceinline__ void mixer_unit(Frame& F, int unit) {
    const bf16* PROJ = (const bf16*)(F.ws + WS_PROJ); const bf16* XC = (const bf16*)(F.ws + WS_XC); const float* SMALL = (const float*)(F.ws + WS_SMALL);
    bf16* YMIX = (bf16*)(F.ws + WS_YMIX); float* SSQ = (float*)(F.ws + WS_SSQ);
    const int w = F.wave, fr = F.lane & 15, fq = F.lane >> 4, tid = F.tid;
    const int b = unit >> 5, tok0 = b * SEQ, hd = unit & 31, grp = hd >> 3, mh = (unit & 31) >> 2, vq = unit & 3;
    const float qs = 0.08838834764831845f;
    LAS unsigned char* QM = F.lds + MX_QM; LAS unsigned char* KM = F.lds + MX_KM; LAS unsigned char* KW = F.lds + MX_KW; LAS unsigned char* VT = F.lds + MX_VT; LAS unsigned char* SI = F.lds + MX_SI;
    LAS float* exch = (LAS float*)(F.lds + MX_VEC + (w >> 2) * MX_VECB + 1024) + (w & 3) * 32;
    LAS float* nvec = (LAS float*)(F.lds + MX_NVEC); LAS float* scal = (LAS float*)(F.lds + MX_SCAL);
    const int fr3 = fr >> 3;
    int vtb[2];
#pragma unroll
    for (int p = 0; p < 2; ++p) vtb[p] = fr * MX_PITCH + ((fq ^ ((2 * p) | fr3)) << 4);
    int vpb[2][2];
#pragma unroll
    for (int p = 0; p < 2; ++p)
#pragma unroll
        for (int h = 0; h < 2; ++h) vpb[p][h] = fr * MX_PITCH + (((((fq >> 1) | (2 * h)) ^ ((2 * p) | fr3))) << 4) + 8 * (fq & 1);
    const int kwb = (16 * w + fr) * MX_PITCH + ((fq ^ ((2 * (w & 1)) | fr3)) << 4), kwh = w >> 1;

    const bf16* qsrc; const bf16* ksrc; const bf16* vsrc; int ld;
    if (ML) { qsrc = PROJ + PC_Q + mh * 128; ksrc = PROJ + PC_K + mh * 128; vsrc = PROJ + PC_V + mh * 256 + vq * 64; ld = NPROJ; }
    else { qsrc = XC + 2560 + grp * 128; ksrc = XC + 2048 + grp * 128; vsrc = XC + hd * 64; ld = 3072; }
    const float c_a = ML ? 0.f : -expf(F.a_log[hd]), c_dtb = ML ? 0.f : F.dt_bias[hd], c_D = ML ? 0.f : F.d_skip[hd], c_ib = ML ? F.i_bias[mh] : 0.f, c_fb = ML ? F.f_bias[mh] : 0.f;
    float mprev = 0.f;
    f32x4 sacc[4]; float nreg = 0.f;
#pragma unroll
    for (int j = 0; j < 4; ++j) sacc[j] = (f32x4){0.f, 0.f, 0.f, 0.f};
    v4u pq[4], pk[4], pv[2];
    float vA0 = 0.f, vA1 = 0.f, vB0 = 0.f, vB1 = 0.f, vC0 = 0.f, vC1 = 0.f, vD0 = 0.f, vD1 = 0.f, vE0 = 0.f, vE1 = 0.f, vG0 = 0.f, vG1 = 0.f, vSA = 0.f, vSG = 0.f;
    float sl0 = 0.f, sl1 = 0.f, sl2 = 0.f, sl3 = 0.f;
#define MX_SCAN_L(c) do { if (w == 0) { const size_t tt = (size_t)(tok0 + 128 * (c) + 2 * F.lane); \
        if (!ML) { sl0 = SMALL[tt * 64 + hd]; sl1 = SMALL[(tt + 1) * 64 + hd]; } \
        else { sl0 = SMALL[tt * 64 + 32 + mh]; sl1 = SMALL[(tt + 1) * 64 + 32 + mh]; sl2 = SMALL[tt * 64 + 40 + mh]; sl3 = SMALL[(tt + 1) * 64 + 40 + mh]; } } } while (0)
#define MX_SOFTPLUS(x) ((x) > 20.f ? (x) : __logf(1.0f + __expf(x)))
#define MX_LOGSIG(x) (fminf((x), 0.f) - __logf(1.0f + __expf(-fabsf(x))))
#define MX_SCAN_A(c) do { if (w == 0) { \
        if (!ML) { const float d0 = MX_SOFTPLUS(sl0 + c_dtb), d1 = MX_SOFTPLUS(sl1 + c_dtb); \
            const float x0 = d0 * c_a, x1 = d1 * c_a; float incl = x0 + x1; \
            _Pragma("unroll") for (int d = 1; d < 64; d <<= 1) { const float t_ = __shfl_up(incl, d); if (F.lane >= d) incl += t_; } \
            const float cum1 = incl, cum0 = incl - x1, tot = __shfl(incl, 63); \
            vA0 = -cum0; vA1 = -cum1; vB0 = -cum0; vB1 = -cum1; vC0 = d0; vC1 = d1; vD0 = __expf(cum0); vD1 = __expf(cum1); vE0 = d0 * __expf(tot - cum0); vE1 = d1 * __expf(tot - cum1); vSA = __expf(tot); vSG = 1.0f; \
        } else { const float li0 = sl0 + c_ib, li1 = sl1 + c_ib; \
            const float x0 = MX_LOGSIG(sl2 + c_fb), x1 = MX_LOGSIG(sl3 + c_fb); float incl = x0 + x1; \
            _Pragma("unroll") for (int d = 1; d < 64; d <<= 1) { const float t_ = __shfl_up(incl, d); if (F.lane >= d) incl += t_; } \
            const float cum1 = incl, cum0 = incl - x1, btot = __shfl(incl, 63); \
            const float dd0 = li0 - cum0, dd1 = li1 - cum1; float im = fmaxf(dd0, dd1); \
            _Pragma("unroll") for (int d = 1; d < 64; d <<= 1) { const float t_ = __shfl_up(im, d); if (F.lane >= d) im = fmaxf(im, t_); } \
            float pm = __shfl_up(im, 1); if (F.lane == 0) pm = -3.0e38f; const float pmax0 = fmaxf(pm, dd0), pmax1 = im, pm127 = __shfl(im, 63); \
            const float M0 = fmaxf(mprev, pmax0), M1 = fmaxf(mprev, pmax1); \
            vA0 = dd0; vA1 = dd1; vB0 = M0; vB1 = M1; vD0 = qs * __expf(mprev - M0); vD1 = qs * __expf(mprev - M1); vG0 = __expf(-(cum0 + M0)); vG1 = __expf(-(cum1 + M1)); \
            const float mloc = btot + pm127, mnew = fmaxf(btot + mprev, mloc); \
            vSA = __expf(btot + mprev - mnew); vSG = __expf(mloc - mnew); vE0 = __expf(dd0 - pm127) * vSG; vE1 = __expf(dd1 - pm127) * vSG; mprev = mnew; } } } while (0)
#define MX_SCAN_B(c) do { if (w == 0) { \
        LAS float* vb = (LAS float*)(F.lds + MX_VEC + ((c) & 1) * MX_VECB); const int l0 = 2 * F.lane; \
        *(LAS f32x2*)(vb + l0) = (f32x2){vA0, vA1}; *(LAS f32x2*)(vb + 128 + l0) = (f32x2){vB0, vB1}; if (!ML) *(LAS f32x2*)(vb + 256 + l0) = (f32x2){vC0, vC1}; \
        *(LAS f32x2*)(vb + 384 + l0) = (f32x2){vD0, vD1}; *(LAS f32x2*)(vb + 512 + l0) = (f32x2){vE0, vE1}; if (ML) *(LAS f32x2*)(vb + 640 + l0) = (f32x2){vG0, vG1}; \
        if (F.lane == 0) { scal[2 * ((c) & 1)] = vSA; scal[2 * ((c) & 1) + 1] = vSG; } } } while (0)
#define MX_SCAN(c) do { MX_SCAN_L(c); MX_SCAN_A(c); MX_SCAN_B(c); } while (0)
#define MX_PREFETCH(c) do { const size_t tb_ = (size_t)(tok0 + 128 * (c)); \
        _Pragma("unroll") for (int i = 0; i < 2; ++i) { const int pid = tid + 512 * i, a2 = pid >> 4, k8 = pid & 15; \
            pq[2 * i] = *(const v4u*)(qsrc + (tb_ + 2 * a2) * ld + 8 * k8); pq[2 * i + 1] = *(const v4u*)(qsrc + (tb_ + 2 * a2 + 1) * ld + 8 * k8); \
            pk[2 * i] = *(const v4u*)(ksrc + (tb_ + 2 * a2) * ld + 8 * k8); pk[2 * i + 1] = *(const v4u*)(ksrc + (tb_ + 2 * a2 + 1) * ld + 8 * k8); } \
        { const int a2 = tid >> 3, v8 = tid & 7; pv[0] = *(const v4u*)(vsrc + (tb_ + 2 * a2) * ld + 8 * v8); pv[1] = *(const v4u*)(vsrc + (tb_ + 2 * a2 + 1) * ld + 8 * v8); } } while (0)
#define MX_WRITE(c) do { const LAS float* vb = (const LAS float*)(F.lds + MX_VEC + ((c) & 1) * MX_VECB); \
        _Pragma("unroll") for (int i = 0; i < 2; ++i) { const int pid = tid + 512 * i, a2 = pid >> 4, k8 = pid & 15, l = 2 * a2; \
            *(LAS v4u*)(QM + l * MX_PITCH + 16 * k8) = pq[2 * i]; *(LAS v4u*)(QM + (l + 1) * MX_PITCH + 16 * k8) = pq[2 * i + 1]; \
            *(LAS v4u*)(KM + l * MX_PITCH + 16 * k8) = pk[2 * i]; *(LAS v4u*)(KM + (l + 1) * MX_PITCH + 16 * k8) = pk[2 * i + 1]; \
            float f0[8], f1[8]; unpack8(pk[2 * i], f0); unpack8(pk[2 * i + 1], f1); const f32x2 wl = *(const LAS f32x2*)(vb + 512 + l); \
            _Pragma("unroll") for (int e = 0; e < 8; ++e) *(LAS unsigned*)(KW + mx_sw(8 * k8 + e, 2 * l)) = pg8::cvt_pk_bf16(f0[e] * wl.x, f1[e] * wl.y); } \
        { const int a2 = tid >> 3, v8 = tid & 7, l = 2 * a2; const v4u r0 = pv[0], r1 = pv[1]; LAS unsigned char* vp_ = VT + mx_sw(8 * v8, 2 * l); \
            *(LAS unsigned*)(vp_ + 0 * MX_PITCH) = (r0.x & 0xffffu) | (r1.x << 16); *(LAS unsigned*)(vp_ + 1 * MX_PITCH) = (r0.x >> 16) | (r1.x & 0xffff0000u); \
            *(LAS unsigned*)(vp_ + 2 * MX_PITCH) = (r0.y & 0xffffu) | (r1.y << 16); *(LAS unsigned*)(vp_ + 3 * MX_PITCH) = (r0.y >> 16) | (r1.y & 0xffff0000u); \
            *(LAS unsigned*)(vp_ + 4 * MX_PITCH) = (r0.z & 0xffffu) | (r1.z << 16); *(LAS unsigned*)(vp_ + 5 * MX_PITCH) = (r0.z >> 16) | (r1.z & 0xffff0000u); \
            *(LAS unsigned*)(vp_ + 6 * MX_PITCH) = (r0.w & 0xffffu) | (r1.w << 16); *(LAS unsigned*)(vp_ + 7 * MX_PITCH) = (r0.w >> 16) | (r1.w & 0xffff0000u); } \
        _Pragma("unroll") for (int j = 0; j < 4; ++j) { v2u sv; sv.x = pg8::cvt_pk_bf16(sacc[j][0], sacc[j][1]); sv.y = pg8::cvt_pk_bf16(sacc[j][2], sacc[j][3]); *(LAS v2u*)(SI + (16 * j + fr) * MX_PITCH + (16 * w + 4 * fq) * 2) = sv; } \
        if (ML && fq == 0) nvec[16 * w + fr] = nreg; } while (0)
    v4u zc0 = (v4u){0u, 0u, 0u, 0u}, zc1 = zc0;
    if (!ML) { const bf16* zp = PROJ + (size_t)(tok0 + 16 * w + (F.lane >> 2)) * NPROJ + PC_Z + hd * 64 + 16 * (F.lane & 3); zc0 = *(const v4u*)zp; zc1 = *(const v4u*)(zp + 8); }
    MX_SCAN(0);
    MX_PREFETCH(0);
    __syncthreads();
    MX_WRITE(0);
    __syncthreads();
    for (int c = 0; c < SEQ / 128; ++c) {
        const LAS float* vb = (const LAS float*)(F.lds + MX_VEC + (c & 1) * MX_VECB);
        const bool more = (c + 1 < SEQ / 128);
        if (more) { MX_SCAN_L(c + 1); MX_PREFETCH(c + 1); }
        bf16x8 qf[4];
#pragma unroll
        for (int ks = 0; ks < 4; ++ks) qf[ks] = lds_frag(QM, 16 * w + fr, 64 * ks + 16 * fq);
        const float mlv = vb[128 + 16 * w + fr];
        float dsum = 0.f;
        f32x4 y1[4];
#pragma unroll
        for (int j = 0; j < 4; ++j) y1[j] = (f32x4){0.f, 0.f, 0.f, 0.f};
        const f32x4 rs4 = *(const LAS f32x4*)(vb + 384 + 16 * w + 4 * fq);
#pragma unroll
        for (int ks = 0; ks < 4; ++ks) { bf16x8 sf[4];
#pragma unroll
            for (int j = 0; j < 4; ++j) sf[j] = lds_frag(SI, 16 * j + fr, 64 * ks + 16 * fq);
#pragma unroll
            for (int j = 0; j < 4; ++j) y1[j] = __builtin_amdgcn_mfma_f32_16x16x32_bf16(qf[ks], sf[j], y1[j], 0, 0, 0); }
#pragma unroll
        for (int j = 0; j < 4; ++j) y1[j] = y1[j] * rs4;
        __builtin_amdgcn_sched_barrier(0);
#pragma unroll 1
        for (int k2 = 0; 2 * k2 <= w; ++k2) {
            unsigned pw[4];
#pragma unroll
            for (int h = 0; h < 2; ++h) {
                const int si = 2 * k2 + h;
                f32x4 acc = (f32x4){0.f, 0.f, 0.f, 0.f};
#pragma unroll
                for (int ks = 0; ks < 4; ++ks) acc = __builtin_amdgcn_mfma_f32_16x16x32_bf16(lds_frag(KM, 16 * si + fr, 64 * ks + 16 * fq), qf[ks], acc, 0, 0, 0);
                const f32x4 e4 = *(const LAS f32x4*)(vb + 16 * si + 4 * fq); f32x4 x4 = (f32x4){qs, qs, qs, qs}; if (!ML) x4 = *(const LAS f32x4*)(vb + 256 + 16 * si + 4 * fq);
                float p[4];
#pragma unroll
                for (int r = 0; r < 4; ++r) { const float v = acc[r] * __expf(e4[r] - mlv) * x4[r]; const bool ok = (si < w) || (si == w && 4 * fq + r <= fr); p[r] = ok ? v : 0.f; }
                if (ML) dsum += (p[0] + p[1]) + (p[2] + p[3]);
                pw[2 * h] = cvt_pk_bf16_nop(p[0], p[1]); pw[2 * h + 1] = cvt_pk_bf16_nop(p[2], p[3]);
            }
            HWAIT();
            const v4u pwv = (v4u){pw[0], pw[1], pw[2], pw[3]}; const bf16x8 pf = __builtin_bit_cast(bf16x8, pwv);
#pragma unroll
            for (int j = 0; j < 4; ++j) { const int ho = j * 16 * MX_PITCH + ((k2 ^ (j >> 1)) << 6); const v2u lo = *(const LAS v2u*)(VT + vpb[j & 1][0] + ho), hi = *(const LAS v2u*)(VT + vpb[j & 1][1] + ho); const v4u vw = (v4u){lo.x, lo.y, hi.x, hi.y};
                y1[j] = __builtin_amdgcn_mfma_f32_16x16x32_bf16(pf, __builtin_bit_cast(bf16x8, vw), y1[j], 0, 0, 0); }
            HWAIT();
        }
        HSYNC();
        __builtin_amdgcn_sched_barrier(0);
        __builtin_amdgcn_sched_barrier(0);
        if (ML) {
            dsum += __shfl_xor(dsum, 16); dsum += __shfl_xor(dsum, 32);
            float d2 = 0.f;
#pragma unroll
            for (int ks = 0; ks < 4; ++ks) { float qv[8]; unpack8(__builtin_bit_cast(v4u, qf[ks]), qv); const f32x4 n0 = *(const LAS f32x4*)(nvec + 32 * ks + 8 * fq), n1 = *(const LAS f32x4*)(nvec + 32 * ks + 8 * fq + 4);
                d2 += qv[0] * n0.x + qv[1] * n0.y + qv[2] * n0.z + qv[3] * n0.w + qv[4] * n1.x + qv[5] * n1.y + qv[6] * n1.z + qv[7] * n1.w; }
            d2 += __shfl_xor(d2, 16); d2 += __shfl_xor(d2, 32);
            if (fq == 0) { exch[fr] = dsum; exch[16 + fr] = d2; }
        }
        HSYNC();
        __builtin_amdgcn_sched_barrier(0);
        LAS float* stg = (LAS float*)(QM + 16 * w * MX_PITCH);
        if (ML) { const f32x4 fl4 = *(const LAS f32x4*)(vb + 640 + 16 * w + 4 * fq); const f32x4 dA = *(const LAS f32x4*)(exch + 4 * fq), dB = *(const LAS f32x4*)(exch + 16 + 4 * fq);
#pragma unroll
            for (int r = 0; r < 4; ++r) { const float den = fmaxf(fabsf(dA[r] + rs4[r] * dB[r]), fl4[r]); const float inv = __builtin_amdgcn_rcpf(den);
#pragma unroll
                for (int j = 0; j < 4; ++j) stg[(4 * fq + r) * 68 + 16 * j + fr] = y1[j][r] * inv; }
        } else {
#pragma unroll
            for (int j = 0; j < 4; ++j) { const v2u xw = *(const LAS v2u*)(VT + mx_sw(16 * j + fr, 32 * w + 8 * fq)); const float xs[4] = {bflo(xw.x), bfhi(xw.x), bflo(xw.y), bfhi(xw.y)};
#pragma unroll
                for (int r = 0; r < 4; ++r) stg[(4 * fq + r) * 68 + 16 * j + fr] = y1[j][r] + c_D * xs[r]; }
        }
        {   const int erow = F.lane >> 2, ecs = F.lane & 3; const size_t trow = (size_t)(tok0 + 128 * c + 16 * w + erow);
            float yv[16];
#pragma unroll
            for (int i = 0; i < 4; ++i) { const f32x4 t4 = *(const LAS f32x4*)(stg + erow * 68 + 16 * ecs + 4 * i); yv[4 * i] = t4.x; yv[4 * i + 1] = t4.y; yv[4 * i + 2] = t4.z; yv[4 * i + 3] = t4.w; }
            if (!ML) { float zf[16]; { float t8[8]; unpack8(zc0, t8);
#pragma unroll
                    for (int i = 0; i < 8; ++i) zf[i] = t8[i]; unpack8(zc1, t8);
#pragma unroll
                    for (int i = 0; i < 8; ++i) zf[8 + i] = t8[i]; }
#pragma unroll
                for (int i = 0; i < 16; ++i) yv[i] = yv[i] * zf[i] * __builtin_amdgcn_rcpf(1.0f + __expf(-zf[i])); }
            float ss = 0.f;
#pragma unroll
            for (int i = 0; i < 16; ++i) ss += yv[i] * yv[i];
            ss += __shfl_xor(ss, 1); ss += __shfl_xor(ss, 2);
            if (ecs == 0) SSQ[(ML ? (size_t)TT * 32 : 0) + trow * 32 + (ML ? mh * 4 + vq : hd)] = ss;
            bf16* yp = YMIX + trow * 4096 + (ML ? 2048 + mh * 256 + vq * 64 : hd * 64) + 16 * ecs;
            *(v4u*)yp = (v4u){pg8::cvt_pk_bf16(yv[0], yv[1]), pg8::cvt_pk_bf16(yv[2], yv[3]), pg8::cvt_pk_bf16(yv[4], yv[5]), pg8::cvt_pk_bf16(yv[6], yv[7])};
            *(v4u*)(yp + 8) = (v4u){pg8::cvt_pk_bf16(yv[8], yv[9]), pg8::cvt_pk_bf16(yv[10], yv[11]), pg8::cvt_pk_bf16(yv[12], yv[13]), pg8::cvt_pk_bf16(yv[14], yv[15])};
            if (!ML && more) { const bf16* zp = PROJ + (size_t)(tok0 + 128 * (c + 1) + 16 * w + (F.lane >> 2)) * NPROJ + PC_Z + hd * 64 + 16 * (F.lane & 3); zc0 = *(const v4u*)zp; zc1 = *(const v4u*)(zp + 8); }
        }
        __builtin_amdgcn_sched_barrier(0);
        const float sa = scal[2 * (c & 1)];
#pragma unroll
        for (int j = 0; j < 4; ++j) sacc[j] = sacc[j] * sa;
        float nsum = 0.f;
#pragma unroll
        for (int ks = 0; ks < 4; ++ks) { const bf16x8 kf = *(const LAS bf16x8*)(KW + kwb + ((ks ^ kwh) << 6)); bf16x8 vf[4];
#pragma unroll
            for (int j = 0; j < 4; ++j) vf[j] = *(const LAS bf16x8*)(VT + vtb[j & 1] + j * 16 * MX_PITCH + ((ks ^ (j >> 1)) << 6));
            if (ML) { float kv[8]; unpack8(__builtin_bit_cast(v4u, kf), kv); nsum += ((kv[0] + kv[1]) + (kv[2] + kv[3])) + ((kv[4] + kv[5]) + (kv[6] + kv[7])); }
#pragma unroll
            for (int j = 0; j < 4; ++j) sacc[j] = __builtin_amdgcn_mfma_f32_16x16x32_bf16(kf, vf[j], sacc[j], 0, 0, 0); }
        if (ML) { nsum += __shfl_xor(nsum, 16); nsum += __shfl_xor(nsum, 32); nreg = nreg * sa + nsum; }
        if (more) { MX_SCAN_A(c + 1); }
        __syncthreads();
        if (more) { MX_SCAN_B(c + 1); }
        __syncthreads();
        if (more) { MX_WRITE(c + 1); }
        __syncthreads();
    }
#undef MX_SCAN
#undef MX_SCAN_A
#undef MX_SCAN_L
#undef MX_SOFTPLUS
#undef MX_LOGSIG
#undef MX_SCAN_B
#undef MX_PREFETCH
#undef MX_WRITE
}
__device__ __forceinline__ void phase_mixer(Frame& F) {
    for (int unit = F.bid; unit < 256; unit += F.G) { mixer_unit<false>(F, unit); mixer_unit<true>(F, unit); }
}

__device__ __forceinline__ void phase3(Frame& F) {
    const bf16* PROJ = (const bf16*)(F.ws + WS_PROJ); bf16* YMIX = (bf16*)(F.ws + WS_YMIX); const float* SSQ = (const float*)(F.ws + WS_SSQ);
    const int gw = F.bid * NWAVES + F.wave, NGW = F.G * NWAVES;
    for (int t = gw; t < TT; t += NGW) {
        bf16* yrow = YMIX + (size_t)t * 4096;
#pragma unroll
        for (int j = 0; j < 8; ++j) {
            const int c0 = (j * 64 + F.lane) * 8;
            float y[8]; unpack8(*(const v4u*)(yrow + c0), y);
            float o[8];
            if (j < 4) {
                const int g = c0 >> 9; const f32x4 s0 = *(const f32x4*)(SSQ + (size_t)t * 32 + g * 8), s1 = *(const f32x4*)(SSQ + (size_t)t * 32 + g * 8 + 4);
                const float ms = ((s0.x + s0.y) + (s0.z + s0.w) + (s1.x + s1.y) + (s1.z + s1.w)) * (1.0f / 512.0f);
                const float rs = 1.0f / sqrtf(ms + EPSF);
                const f32x4 w0 = *(const f32x4*)(F.ssd_norm_w + c0), w1 = *(const f32x4*)(F.ssd_norm_w + c0 + 4);
                o[0] = y[0] * rs * w0.x; o[1] = y[1] * rs * w0.y; o[2] = y[2] * rs * w0.z; o[3] = y[3] * rs * w0.w;
                o[4] = y[4] * rs * w1.x; o[5] = y[5] * rs * w1.y; o[6] = y[6] * rs * w1.z; o[7] = y[7] * rs * w1.w;
            } else {
                const int cc = c0 - 2048, h = cc >> 8; const f32x4 s0 = *(const f32x4*)(SSQ + (size_t)TT * 32 + (size_t)t * 32 + h * 4);
                const float ms = ((s0.x + s0.y) + (s0.z + s0.w)) * (1.0f / 256.0f);
                const float rs = 1.0f / sqrtf(ms + EPSF);
                const f32x4 w0 = *(const f32x4*)(F.ml_norm_w + cc), w1 = *(const f32x4*)(F.ml_norm_w + cc + 4);
                float og[8]; unpack8(*(const v4u*)(PROJ + (size_t)t * NPROJ + PC_O + cc), og);
                const float wv[8] = {w0.x, w0.y, w0.z, w0.w, w1.x, w1.y, w1.z, w1.w};
#pragma unroll
                for (int i = 0; i < 8; ++i) o[i] = y[i] * rs * wv[i] * (1.0f / (1.0f + __expf(-og[i])));
            }
            v4u ov; ov.x = pk2(o[0], o[1]); ov.y = pk2(o[2], o[3]); ov.z = pk2(o[4], o[5]); ov.w = pk2(o[6], o[7]);
            *(v4u*)(yrow + c0) = ov;
        }
    }
}

__device__ __forceinline__ void phase5(Frame& F) {
    const float* H2 = (const float*)(F.ws + WS_H2); const float* Wrt = (const float*)(F.ws + WS_WRT); bf16* XN2 = (bf16*)(F.ws + WS_XN2);
    int* EIDX = (int*)(F.ws + WS_ROUTE); int* RANK = EIDX + TT * 4; float* GATE = (float*)(RANK + TT * 4);
    LAS float* xT = (LAS float*)(F.lds + F.wave * 8192); LAS float* lg = (LAS float*)(F.lds + 65536 + F.wave * 1024);
    LAS int* cntl = (LAS int*)(F.lds + 73728); LAS int* baseg = cntl + 32;
    const int gw = F.bid * NWAVES + F.wave, NGW = F.G * NWAVES, ntask = TT / 8, iters = (ntask + NGW - 1) / NGW;
    for (int itx = 0; itx < iters; ++itx) {
        const int task = itx * NGW + gw; const bool valid = task < ntask; const int t0 = task * 8;
        if (F.tid < 32) cntl[F.tid] = 0;
        __syncthreads();
        float rstd[8]; int me[4] = {0, 0, 0, 0}, mr[4] = {0, 0, 0, 0}; float mg[4] = {0.f, 0.f, 0.f, 0.f};
#pragma unroll
        for (int k = 0; k < 8; ++k) rstd[k] = 0.f;
        float acc[8], ssq[8];
#pragma unroll
        for (int k = 0; k < 8; ++k) { acc[k] = 0.f; ssq[k] = 0.f; }
        const int e = F.lane & 31, dh = F.lane >> 5;
        LAS float* wl = (LAS float*)(F.lds + 81920);
        for (int dc = 0; dc < 8; ++dc) {
            __syncthreads();
#pragma unroll
            for (int q = 0; q < 4; ++q) ((LAS f32x4*)wl)[F.tid + 512 * q] = ((const f32x4*)(Wrt + (size_t)dc * 256 * 32))[F.tid + 512 * q];
            if (valid) {
                f32x4 xk[8];
#pragma unroll
                for (int k = 0; k < 8; ++k) { xk[k] = *(const f32x4*)(H2 + (size_t)(t0 + k) * DM + dc * 256 + 4 * F.lane); ssq[k] += (xk[k].x * xk[k].x + xk[k].y * xk[k].y) + (xk[k].z * xk[k].z + xk[k].w * xk[k].w); }
#pragma unroll
                for (int jj = 0; jj < 4; ++jj) { LAS float* dp = xT + (jj * 64 + F.lane) * 8;
                    *(LAS f32x4*)dp = (f32x4){xk[0][jj], xk[1][jj], xk[2][jj], xk[3][jj]}; *(LAS f32x4*)(dp + 4) = (f32x4){xk[4][jj], xk[5][jj], xk[6][jj], xk[7][jj]}; }
            }
            __syncthreads();
            if (valid) {
                const LAS float* xp = xT + dh * 128 * 8;
#pragma unroll 8
                for (int i = 0; i < 128; ++i) { const float w = wl[(4 * (i & 63) + 2 * dh + (i >> 6)) * 32 + e];     const f32x4 xa = *(const LAS f32x4*)(xp + i * 8), xb = *(const LAS f32x4*)(xp + i * 8 + 4);
                    acc[0] += w * xa.x; acc[1] += w * xa.y; acc[2] += w * xa.z; acc[3] += w * xa.w; acc[4] += w * xb.x; acc[5] += w * xb.y; acc[6] += w * xb.z; acc[7] += w * xb.w; }
            }
        }
        if (valid) {
            const float rb = F.router_b[e];
#pragma unroll
            for (int k = 0; k < 8; ++k) { rstd[k] = 1.0f / sqrtf(wave_sum(ssq[k]) * (1.0f / 2048.0f) + EPSF);
                const float v = (acc[k] + __shfl_xor(acc[k], 32)) * rstd[k] + rb; if (F.lane < 32) lg[k * 32 + e] = v; }
            LDS_WAIT(); asm volatile("" ::: "memory");
            if (F.lane < 8) {
                const LAS float* lp = lg + F.lane * 32; float bv[4]; int bi[4] = {-1, -1, -1, -1};
#pragma unroll
                for (int p = 0; p < 4; ++p) { float best = -3.0e38f; int bidx = 0;
                    for (int q = 0; q < 32; ++q) { const float v = lp[q]; const bool taken = (q == bi[0]) | (q == bi[1]) | (q == bi[2]) | (q == bi[3]); if (!taken && v > best) { best = v; bidx = q; } }
                    bv[p] = best; bi[p] = bidx; }
                const float p1 = expf(bv[1] - bv[0]), p2 = expf(bv[2] - bv[0]), p3 = expf(bv[3] - bv[0]); const float inv = 1.0f / (1.0f + p1 + p2 + p3);
                mg[0] = inv; mg[1] = p1 * inv; mg[2] = p2 * inv; mg[3] = p3 * inv;
#pragma unroll
                for (int p = 0; p < 4; ++p) { me[p] = bi[p]; mr[p] = __hip_atomic_fetch_add(cntl + bi[p], 1, __ATOMIC_RELAXED, __HIP_MEMORY_SCOPE_WORKGROUP); }
            }
        }
        __syncthreads();
        if (F.tid < 32) { const int c = cntl[F.tid]; int gb = 0; if (c > 0) gb = (int)__hip_atomic_fetch_add((unsigned*)(F.ctl + CW_CNT + 64 * F.tid), (unsigned)c, RLX_AGENT); baseg[F.tid] = gb; }
        __syncthreads();
        if (valid) {
            if (F.lane < 8) { const size_t t = (size_t)(t0 + F.lane);
#pragma unroll
                for (int p = 0; p < 4; ++p) { EIDX[t * 4 + p] = me[p]; RANK[t * 4 + p] = baseg[me[p]] + mr[p]; GATE[t * 4 + p] = mg[p]; } }
#pragma unroll
            for (int k = 0; k < 8; ++k) { const f32x4* xr = (const f32x4*)(H2 + (size_t)(t0 + k) * DM) + F.lane; const f32x4* wr = (const f32x4*)F.norm2_w + F.lane; int* o4 = (int*)((unsigned char*)XN2 + (size_t)(t0 + k) * DM) + F.lane;
#pragma unroll
                for (int j = 0; j < 8; ++j) { const f32x4 v = xr[64 * j], ww = wr[64 * j]; int o = __builtin_amdgcn_cvt_pk_fp8_f32(v.x * rstd[k] * ww.x, v.y * rstd[k] * ww.y, 0, false); o = __builtin_amdgcn_cvt_pk_fp8_f32(v.z * rstd[k] * ww.z, v.w * rstd[k] * ww.w, o, true); o4[64 * j] = o; } }
        }
        __syncthreads();
    }
}
__device__ __forceinline__ void phase5b(Frame& F) {
    const bf16* XN2 = (const bf16*)(F.ws + WS_XN2); bf16* XG = (bf16*)(F.ws + WS_XG);
    const int* EIDX = (const int*)(F.ws + WS_ROUTE); const int* RANK = EIDX + TT * 4; const float* GATE = (const float*)(RANK + TT * 4); int* SLOT = (int*)(GATE + TT * 4); float* SGATE = (float*)(SLOT + TT * 4);
    LAS int* sbase = (LAS int*)(F.lds); LAS int* spad = sbase + 32;
    if (F.tid < 32) { const int c = (int)__hip_atomic_load((unsigned*)(F.ctl + CW_CNT + 64 * F.tid), RLX_AGENT); spad[F.tid] = (c + 255) & ~255; }
    __syncthreads();
    if (F.tid == 0) { int a = 0; for (int e = 0; e < 32; ++e) { sbase[e] = a; a += spad[e]; } }
    __syncthreads();
    const int gw = F.bid * NWAVES + F.wave, NGW = F.G * NWAVES;
    for (int task = gw; task < TT / 8; task += NGW) {
#pragma unroll 2
        for (int k = 0; k < 8; ++k) { const size_t t = (size_t)task * 8 + k;
            int slot = 0;
            if (F.lane < 4) { const int e = EIDX[t * 4 + F.lane]; slot = sbase[e] + RANK[t * 4 + F.lane]; SLOT[t * 4 + F.lane] = slot; SGATE[slot] = GATE[t * 4 + F.lane]; }
            const int s0 = __shfl(slot, 0), s1 = __shfl(slot, 1), s2 = __shfl(slot, 2), s3 = __shfl(slot, 3);
            const v4u* src = (const v4u*)((const unsigned char*)XN2 + t * DM) + F.lane; v4u d[2];
#pragma unroll
            for (int j = 0; j < 2; ++j) d[j] = src[64 * j];
            v4u* d0 = (v4u*)((unsigned char*)XG + (size_t)s0 * DM) + F.lane; v4u* d1 = (v4u*)((unsigned char*)XG + (size_t)s1 * DM) + F.lane; v4u* d2 = (v4u*)((unsigned char*)XG + (size_t)s2 * DM) + F.lane; v4u* d3 = (v4u*)((unsigned char*)XG + (size_t)s3 * DM) + F.lane;
#pragma unroll
            for (int j = 0; j < 2; ++j) { d0[64 * j] = d[j]; d1[64 * j] = d[j]; d2[64 * j] = d[j]; d3[64 * j] = d[j]; }
        }
    }
}
__device__ __forceinline__ int build_moe_tab(Frame& F) {
    LAS unsigned char* tab = (LAS unsigned char*)(F.lds + TAB_OFF); LAS int* tinfo = (LAS int*)(F.lds + TAB_OFF + 320);
    if (F.tid < 32) { const int c = (int)__hip_atomic_load((unsigned*)(F.ctl + CW_CNT + 64 * F.tid), RLX_AGENT); tinfo[4 + F.tid] = (c + 255) >> 8; }
    __syncthreads();
    if (F.tid == 0) { int a = 0; for (int e = 0; e < 32; ++e) { const int n = tinfo[4 + e]; for (int j = 0; j < n; ++j) tab[a + j] = (unsigned char)e; a += n; } tinfo[0] = a; }
    __syncthreads();
    return tinfo[0];
}
__device__ __forceinline__ void phase8(Frame& F) {
    const float* H2 = (const float*)(F.ws + WS_H2); const bf16* YR = (const bf16*)(F.ws + WS_YR);
    const int* SLOT = (const int*)(F.ws + WS_ROUTE) + TT * 12;
    const int gw = F.bid * NWAVES + F.wave, NGW = F.G * NWAVES;
    for (int t = gw; t < TT; t += NGW) {
        int slot = 0; if (F.lane < 4) slot = SLOT[(size_t)t * 4 + F.lane];
        int sl[4]; sl[0] = __shfl(slot, 0); sl[1] = __shfl(slot, 1); sl[2] = __shfl(slot, 2); sl[3] = __shfl(slot, 3);
        float v[4][8]; float ss = 0.f;
#pragma unroll
        for (int j = 0; j < 4; ++j) { const int pz = F.lane + 64 * j; const f32x4 a = *(const f32x4*)(H2 + (size_t)t * DM + 8 * pz), b = *(const f32x4*)(H2 + (size_t)t * DM + 8 * pz + 4);
            v[j][0] = a.x; v[j][1] = a.y; v[j][2] = a.z; v[j][3] = a.w; v[j][4] = b.x; v[j][5] = b.y; v[j][6] = b.z; v[j][7] = b.w; }
#pragma unroll
        for (int k = 0; k < 4; ++k)
#pragma unroll
            for (int j = 0; j < 4; ++j) { float f[8]; unpack8(*((const v4u*)(YR + (size_t)sl[k] * DM) + F.lane + 64 * j), f);
#pragma unroll
                for (int i = 0; i < 8; ++i) v[j][i] += f[i]; }
#pragma unroll
        for (int j = 0; j < 4; ++j)
#pragma unroll
            for (int i = 0; i < 8; ++i) ss += v[j][i] * v[j][i];
        const float rstd = 1.0f / sqrtf(wave_sum(ss) * (1.0f / 2048.0f) + EPSF);
#pragma unroll
        for (int j = 0; j < 4; ++j) { const int pz = F.lane + 64 * j; const f32x4 w0 = *(const f32x4*)(F.final_norm_w + 8 * pz), w1 = *(const f32x4*)(F.final_norm_w + 8 * pz + 4);
            *(f32x4*)(F.out + (size_t)t * DM + 8 * pz) = (f32x4){v[j][0] * rstd * w0.x, v[j][1] * rstd * w0.y, v[j][2] * rstd * w0.z, v[j][3] * rstd * w0.w};
            *(f32x4*)(F.out + (size_t)t * DM + 8 * pz + 4) = (f32x4){v[j][4] * rstd * w1.x, v[j][5] * rstd * w1.y, v[j][6] * rstd * w1.z, v[j][7] * rstd * w1.w}; }
    }
}

struct Args { const float* in[21]; float* out; unsigned char* ws; int ph_lo, ph_hi, li, pad; };
__global__ void __launch_bounds__(NWAVES * 64, 2) hymba_fwd(Args args) {
    extern __shared__ __attribute__((aligned(16))) unsigned char lds[];
    Frame F;
    F.lds = (LAS unsigned char*)lds; F.MISC = (volatile LAS unsigned*)(F.lds + MISC_OFF);
    F.tid = threadIdx.x; F.lane = F.tid & 63; F.wave = __builtin_amdgcn_readfirstlane(F.tid >> 6); F.G = gridDim.x; F.bid = blockIdx.x;
    F.ws = args.ws; F.ctl = (gu32*)(args.ws + WS_CTL); F.out = args.out;
    F.x = args.in[0]; F.norm1_w = args.in[1]; F.w_in = args.in[2]; F.conv_w = args.in[3]; F.conv_b = args.in[4]; F.dt_bias = args.in[5]; F.a_log = args.in[6]; F.d_skip = args.in[7]; F.ssd_norm_w = args.in[8];
    F.i_bias = args.in[9]; F.f_bias = args.in[10]; F.ml_norm_w = args.in[11]; F.w_out = args.in[12]; F.norm2_w = args.in[13]; F.router_w = args.in[14]; F.router_b = args.in[15];
    F.w_gate_up = args.in[16]; F.b_gate_up = args.in[17]; F.w_down = args.in[18]; F.b_down = args.in[19]; F.final_norm_w = args.in[20];
    for (int u = F.tid; u < (LDS_BYTES - LDSCTL_OFF) / 4; u += NWAVES * 64) ((LAS unsigned*)(F.lds + LDSCTL_OFF))[u] = 0u;
    __syncthreads();
    XcdBarrier bar; bar.bar = (unsigned*)(F.ctl + CW_BAR) + args.li * XCD_BAR_WORDS; bar.x = 0; bar.st = nullptr;
    const bool use_bar = (args.ph_hi - args.ph_lo) > 1;
    if (use_bar) bar = xcd_barrier_post((unsigned*)(F.ctl + CW_BAR) + args.li * XCD_BAR_WORDS, F.MISC + 8);
    const int lo = args.ph_lo, hi = args.ph_hi;
#ifndef PHASE_MASK
#define PHASE_MASK 0x7ff
#endif
#define IN(k) (((PHASE_MASK >> (k)) & 1) && lo <= (k) && (k) < hi)
#define SEAM(k) do { if (IN(k) && IN((k) + 1)) xcd_barrier(bar); } while (0)
    if (IN(0)) { phase0(F); } SEAM(0);
    if (IN(1)) {
        pg8::Gemm g{(const pg8::bf16_t*)(F.ws + WS_XN1), (const pg8::bf16_t*)(F.ws + WS_WIN), TT, NPROJ, DM}; pg8::StaticOrder S; S.init(TT, NPROJ, F.G, F.bid);
        pg8::EpiBf16 E{(pg8::bf16_t*)(F.ws + WS_PROJ), NPROJ};
        pg8::gemm_phase<pg8::EpiBf16, pg8::StaticOrder, true, true>(F.lds, g, S, E);
        p1_small(F);
    } SEAM(1);
    if (IN(2)) { phase_conv(F); } SEAM(2);
    if (IN(3)) { phase_mixer(F); } SEAM(3);
    if (IN(4)) { phase3(F); } SEAM(4);
    if (IN(5)) {
        pg8::Gemm g{(const pg8::bf16_t*)(F.ws + WS_YMIX), (const pg8::bf16_t*)(F.ws + WS_WOUT), TT, DM, 4096}; pg8::StaticOrder S; S.init(TT, DM, F.G, F.bid);
        pg8::EpiResF32 E{(float*)(F.ws + WS_H2), F.x, DM};
        pg8::gemm_phase<pg8::EpiResF32, pg8::StaticOrder, true, true>(F.lds, g, S, E);
    } SEAM(5);
    if (IN(6)) { phase5(F); } SEAM(6);
    if (IN(7)) { phase5b(F); } SEAM(7);
    if (IN(8)) {
        const int nM = build_moe_tab(F);
        pg8::Gemm g{(const pg8::bf16_t*)(F.ws + WS_XG), (const pg8::bf16_t*)(F.ws + WS_WGU), nM * 256, 4096, DM};
        pg8::MoeOrder S{nM, 16, 4, nM * 16, F.G, F.bid, (const PG8_LAS unsigned char*)(F.lds + TAB_OFF)};
        pg8::EpiSwiglu E{(unsigned char*)(F.ws + WS_ACT), F.b_gate_up};
        pg8::gemm_phase<pg8::EpiSwiglu, pg8::MoeOrder, true, true, true>(F.lds, g, S, E);
    } SEAM(8);
    if (IN(9)) {
        const int nM = build_moe_tab(F);
        pg8::Gemm g{(const pg8::bf16_t*)(F.ws + WS_ACT), (const pg8::bf16_t*)(F.ws + WS_WD), nM * 256, 2048, DM};
        pg8::MoeOrder S{nM, 8, 3, nM * 8, F.G, F.bid, (const PG8_LAS unsigned char*)(F.lds + TAB_OFF)};
        pg8::EpiDown E{(pg8::bf16_t*)(F.ws + WS_YR), F.b_down, (const float*)((const int*)(F.ws + WS_ROUTE) + TT * 16)};
        pg8::gemm_phase<pg8::EpiDown, pg8::MoeOrder, true, true, true>(F.lds, g, S, E);
    } SEAM(9);
    if (IN(10)) { phase8(F); }
#undef IN
#undef SEAM
}

extern "C" void kernel_launch(void* const* d_in, const int* in_sizes, int n_in, void* d_out, int out_size, void* d_ws, size_t ws_size, hipStream_t stream) {
    static int grid = 0;
    if (grid == 0) {
        if (n_in != 21 || out_size != TT * DM || ws_size < WS_END) { fprintf(stderr, "kernel_launch: unexpected problem (n_in %d, out %d, ws %zu); nothing launched\n", n_in, out_size, ws_size); grid = -1; return; }
        int dev = 0, cus = 0, per_cu = 0;
        if (hipGetDevice(&dev) != hipSuccess || hipDeviceGetAttribute(&cus, hipDeviceAttributeMultiprocessorCount, dev) != hipSuccess) { grid = -1; return; }
        if (hipFuncSetAttribute((const void*)hymba_fwd, hipFuncAttributeMaxDynamicSharedMemorySize, LDS_BYTES) != hipSuccess) { fprintf(stderr, "kernel_launch: hipFuncSetAttribute failed\n"); grid = -1; return; }
        if (hipOccupancyMaxActiveBlocksPerMultiprocessor(&per_cu, (const void*)hymba_fwd, NWAVES * 64, LDS_BYTES) != hipSuccess || per_cu < 1) { fprintf(stderr, "kernel_launch: occupancy query says %d blocks per CU\n", per_cu); }
        (void)hipGetLastError();
        grid = cus;
    }
    if (grid < 0) return;
    (void)hipMemsetAsync((char*)d_ws + WS_CTL, 0, CTL_ZERO_BYTES, stream);
    Args a{};
    for (int i = 0; i < 21; ++i) a.in[i] = (const float*)d_in[i];
    a.out = (float*)d_out; a.ws = (unsigned char*)d_ws; a.pad = 0;
#if MK_PER_PHASE
    for (int li = 0; li < N_PHASES; ++li) { a.ph_lo = li; a.ph_hi = li + 1; a.li = li; hipLaunchKernelGGL(hymba_fwd, dim3(grid), dim3(NWAVES * 64), LDS_BYTES, stream, a); }
#else
    a.ph_lo = 0; a.ph_hi = N_PHASES; a.li = 0;
    hipLaunchKernelGGL(hymba_fwd, dim3(grid), dim3(NWAVES * 64), LDS_BYTES, stream, a);
#endif
}
```

```cpp
#include <hip/hip_runtime.h>
#include <cstdio>
#include <cstdint>
namespace pg8 {
#define PG8_LAS __attribute__((address_space(3)))
typedef unsigned short bf16_t;
typedef short bf16x8 __attribute__((ext_vector_type(8)));
typedef float f32x4 __attribute__((ext_vector_type(4)));
typedef unsigned u32x4 __attribute__((ext_vector_type(4)));
constexpr int BM = 256, BK = 64, HALF = 128, HTB = HALF * BK * 2  , STAGE_BYTES = 8 * HTB, NXCD = 8, WGM = 8;

__host__ __device__ __forceinline__ int lds_byte(int r, int c) { const int st = (r >> 4) * 2 + (c >> 5), rr = r & 15, cc = c & 31, ob = rr * 64 + cc * 2; return st * 1024 + (ob ^ (((ob >> 9) & 1) << 5)); }
__host__ __device__ __forceinline__ void stage_rc(int b, int& R, int& C) { const int st = b / 1024, sb = b % 1024, swz = sb ^ (((sb >> 9) & 1) << 5); R = (st >> 1) * 16 + swz / 64; C = (st & 1) * 32 + (swz % 64) / 2; }
__host__ __device__ __forceinline__ int perm32(int rho) { const int n = rho >> 4, i = rho & 15; return 8 * (i >> 2) + 4 * n + (i & 3); }

struct Unit { int pm, pn; };
struct Gemm { const bf16_t* A; const bf16_t* Bt; int M, N, K; };

struct StaticOrder {
    int nM, nN, nwg, G, c;
    __host__ __device__ void init(int M, int N, int G_, int c_) { nM = M / BM; nN = N / BM; nwg = nM * nN; G = G_; c = c_; }
    __host__ __device__ bool next(int i, Unit& u) const {
        const long L = (long)i * G + c; if (L >= nwg) return false;
        int wgid = (int)L; { const int q = nwg / NXCD, r = nwg % NXCD, xcd = wgid % NXCD, off = wgid / NXCD; wgid = (xcd < r ? xcd * (q + 1) : r * (q + 1) + (xcd - r) * q) + off; }
        const int nig = WGM * nN, gid = wgid / nig, fm = gid * WGM, gsz = (nM - fm) < WGM ? (nM - fm) : WGM;
        u.pm = fm + ((wgid % nig) % gsz); u.pn = (wgid % nig) / gsz; return true;
    }
    __device__ __forceinline__ void a_ready(const Unit&) const {}
    __device__ __forceinline__ void done(const Unit&) const {}
};


__device__ __forceinline__ unsigned cvt_pk_bf16(float lo, float hi) { unsigned r; asm volatile("v_cvt_pk_bf16_f32 %0, %1, %2" : "=v"(r) : "v"(lo), "v"(hi)); return r; }
typedef unsigned u32x2 __attribute__((ext_vector_type(2)));

struct EpiBf16 {
    static constexpr bool PERM = true, AFTER_DRAIN = false;
    bf16_t* O; int ldc;
    __device__ __forceinline__ void operator()(const f32x4 (&acc)[2][2][4][2], const Unit& u, int wr, int wc, int fr, int fq) const {
        const int row0 = u.pm * BM + wr * 64 + fr; const int col0 = u.pn * BM + wc * 32 + 8 * fq;
#pragma unroll
        for (int ai = 0; ai < 2; ++ai)
#pragma unroll
            for (int m = 0; m < 4; ++m) { bf16_t* rowp = O + (size_t)(row0 + ai * HALF + m * 16) * ldc + col0;
#pragma unroll
                for (int bj = 0; bj < 2; ++bj) { const f32x4 v0 = acc[ai][bj][m][0], v1 = acc[ai][bj][m][1];
                    u32x4 w; w.x = cvt_pk_bf16(v0[0], v0[1]); w.y = cvt_pk_bf16(v0[2], v0[3]); w.z = cvt_pk_bf16(v1[0], v1[1]); w.w = cvt_pk_bf16(v1[2], v1[3]);
                    *(u32x4*)(rowp + bj * HALF) = w; } }
    }
};
struct EpiResF32 {
    static constexpr bool PERM = false, AFTER_DRAIN = false;
    float* C; const float* base; int ldc;
    __device__ __forceinline__ void operator()(const f32x4 (&acc)[2][2][4][2], const Unit& u, int wr, int wc, int fr, int fq) const {
        const int row0 = u.pm * BM + wr * 64 + fr, col0 = u.pn * BM + wc * 32 + 4 * fq;
#pragma unroll
        for (int ai = 0; ai < 2; ++ai)
#pragma unroll
            for (int m = 0; m < 4; ++m) { const size_t off = (size_t)(row0 + ai * HALF + m * 16) * ldc + col0;
#pragma unroll
                for (int bj = 0; bj < 2; ++bj)
#pragma unroll
                    for (int n = 0; n < 2; ++n) *(f32x4*)(C + off + bj * HALF + n * 16) = acc[ai][bj][m][n] + *(const f32x4*)(base + off + bj * HALF + n * 16); }
    }
};
__device__ __forceinline__ float swiglu1(float a, float b) {
    const float glu = fminf(a, 7.0f), lin = fminf(fmaxf(b, -7.0f), 7.0f);
    return glu * __builtin_amdgcn_rcpf(1.0f + __expf(-1.702f * glu)) * (lin + 1.0f);
}
struct EpiSwiglu {
    static constexpr bool PERM = true, AFTER_DRAIN = false;
    unsigned char* O; const float* bias;
    __device__ __forceinline__ void operator()(const f32x4 (&acc)[2][2][4][2], const Unit& u, int wr, int wc, int fr, int fq) const {
        const int e = u.pn >> 4, pnl = u.pn & 15;
        const int row0 = u.pm * BM + wr * 64 + fr; const int hcol0 = pnl * BM + wc * 32 + 8 * fq;
        const float* bp = bias + (size_t)e * 4096 + hcol0;
        f32x4 bv[2][2];
#pragma unroll
        for (int bj = 0; bj < 2; ++bj)
#pragma unroll
            for (int n = 0; n < 2; ++n) bv[bj][n] = *(const f32x4*)(bp + bj * HALF + 4 * n);
#pragma unroll
        for (int ai = 0; ai < 2; ++ai)
#pragma unroll
            for (int m = 0; m < 4; ++m) { unsigned char* rowp = O + (size_t)(row0 + ai * HALF + m * 16) * 2048 + (hcol0 >> 1);
#pragma unroll
                for (int bj = 0; bj < 2; ++bj) { const f32x4 v0 = acc[ai][bj][m][0] + bv[bj][0], v1 = acc[ai][bj][m][1] + bv[bj][1];
                    int w = __builtin_amdgcn_cvt_pk_fp8_f32(swiglu1(v0[0], v0[1]), swiglu1(v0[2], v0[3]), 0, false);
                    w = __builtin_amdgcn_cvt_pk_fp8_f32(swiglu1(v1[0], v1[1]), swiglu1(v1[2], v1[3]), w, true);
                    *(int*)(rowp + bj * 64) = w; } }
    }
};
struct EpiDown {
    static constexpr bool PERM = true, AFTER_DRAIN = false;
    bf16_t* O; const float* bias; const float* sgate;
    __device__ __forceinline__ void operator()(const f32x4 (&acc)[2][2][4][2], const Unit& u, int wr, int wc, int fr, int fq) const {
        const int e = u.pn >> 3, pnl = u.pn & 7;
        const int row0 = u.pm * BM + wr * 64 + fr; const int col0 = pnl * BM + wc * 32 + 8 * fq;
        const float* bp = bias + (size_t)e * 2048 + col0;
        f32x4 bv[2][2];
#pragma unroll
        for (int bj = 0; bj < 2; ++bj)
#pragma unroll
            for (int n = 0; n < 2; ++n) bv[bj][n] = *(const f32x4*)(bp + bj * HALF + 4 * n);
#pragma unroll
        for (int ai = 0; ai < 2; ++ai)
#pragma unroll
            for (int m = 0; m < 4; ++m) { const int row = row0 + ai * HALF + m * 16; const float gt = sgate[row]; bf16_t* rowp = O + (size_t)row * 2048 + col0;
#pragma unroll
                for (int bj = 0; bj < 2; ++bj) { const f32x4 v0 = (acc[ai][bj][m][0] + bv[bj][0]) * gt, v1 = (acc[ai][bj][m][1] + bv[bj][1]) * gt;
                    u32x4 w; w.x = cvt_pk_bf16(v0[0], v0[1]); w.y = cvt_pk_bf16(v0[2], v0[3]); w.z = cvt_pk_bf16(v1[0], v1[1]); w.w = cvt_pk_bf16(v1[2], v1[3]);
                    *(u32x4*)(rowp + bj * HALF) = w; } }
    }
};
struct MoeOrder {
    int nM, nN, nsh, nwg, G, c; const PG8_LAS unsigned char* tab;
    __device__ __forceinline__ bool next(int i, Unit& u) const {
        const long L = (long)i * G + c; if (L >= nwg) return false;
        int wgid = (int)L; { const int q = nwg / NXCD, r = nwg % NXCD, xcd = wgid % NXCD, off = wgid / NXCD; wgid = (xcd < r ? xcd * (q + 1) : r * (q + 1) + (xcd - r) * q) + off; }
        const int nig = WGM * nN, gid = wgid / nig, fm = gid * WGM, gsz = (nM - fm) < WGM ? (nM - fm) : WGM;
        const int pm = fm + ((wgid % nig) % gsz), pnl = (wgid % nig) / gsz;
        u.pm = pm; u.pn = ((int)tab[pm] << nsh) + pnl; return true;
    }
    __device__ __forceinline__ void a_ready(const Unit&) const {}
    __device__ __forceinline__ void done(const Unit&) const {}
};
typedef int v8i32 __attribute__((ext_vector_type(8)));
__device__ __forceinline__ v8i32 pg8_cat(const bf16x8 lo, const bf16x8 hi) { typedef int v4i32 __attribute__((ext_vector_type(4))); const v4i32 a = __builtin_bit_cast(v4i32, lo), b = __builtin_bit_cast(v4i32, hi); return __builtin_shufflevector(a, b, 0, 1, 2, 3, 4, 5, 6, 7); }
template <class Epi, class Sched, bool ALIGN_EPI = false, bool SP2 = false, bool F8 = false>
__device__ __forceinline__ void gemm_phase(PG8_LAS unsigned char* lds, const Gemm g, const Sched& S, const Epi& E) {
    const int tid = threadIdx.x, wid = __builtin_amdgcn_readfirstlane(tid >> 6), lane = tid & 63, wr = wid >> 2, wc = wid & 3, fr = lane & 15, fq = lane >> 4;
    const int K = g.K, KB = F8 ? K : 2 * K, nt = KB / 128;
    unsigned voffA[2], voffB[2];
#pragma unroll
    for (int i = 0; i < 2; ++i) { int R, C; stage_rc(tid * 16 + i * 8192, R, C); const int Rb = Epi::PERM ? ((R & ~31) + perm32(R & 31)) : R;
        voffA[i] = (unsigned)(R * KB + C * 2); voffB[i] = (unsigned)(Rb * KB + C * 2); }
    const size_t kstep = (size_t)(BK * 2);
    const size_t hstep = (size_t)HALF * KB;
    const size_t tstep = 2 * hstep;
    const unsigned ldsw = (unsigned)wid * 1024u;
    int aoffk[2], boffk[2];
#pragma unroll
    for (int h = 0; h < 2; ++h) { aoffk[h] = lds_byte(wr * 64 + fr, fq * 8) + h * 1024; boffk[h] = lds_byte(wc * 32 + fr, fq * 8) + h * 1024; }
#define PG8_SA(b, h) (((b) * 2 + (h)) * HTB)
#define PG8_SB(b, h) ((4 + (b) * 2 + (h)) * HTB)
#define PG8_STAGE(bufoff, gbase, voff) do { _Pragma("unroll") for (int _i = 0; _i < 2; ++_i) \
        __builtin_amdgcn_global_load_lds((const unsigned*)((const char*)(gbase) + (voff)[_i]), (PG8_LAS unsigned*)(lds + (bufoff) + ldsw + _i * 8192), 16, 0, 0); } while (0)
#define PG8_LDA(dst, b, h) do { if constexpr (F8) { _Pragma("unroll") for (int m = 0; m < 4; ++m) dst##8[m] = pg8_cat(*(const PG8_LAS bf16x8*)(lds + PG8_SA(b, h) + aoffk[0] + m * 2048), *(const PG8_LAS bf16x8*)(lds + PG8_SA(b, h) + aoffk[1] + m * 2048)); } \
        else { _Pragma("unroll") for (int m = 0; m < 4; ++m) _Pragma("unroll") for (int k = 0; k < 2; ++k) dst[m][k] = *(const PG8_LAS bf16x8*)(lds + PG8_SA(b, h) + aoffk[k] + m * 2048); } } while (0)
#define PG8_LDB(dst, b, h) do { if constexpr (F8) { _Pragma("unroll") for (int n = 0; n < 2; ++n) dst##8[n] = pg8_cat(*(const PG8_LAS bf16x8*)(lds + PG8_SB(b, h) + boffk[0] + n * 2048), *(const PG8_LAS bf16x8*)(lds + PG8_SB(b, h) + boffk[1] + n * 2048)); } \
        else { _Pragma("unroll") for (int n = 0; n < 2; ++n) _Pragma("unroll") for (int k = 0; k < 2; ++k) dst[n][k] = *(const PG8_LAS bf16x8*)(lds + PG8_SB(b, h) + boffk[k] + n * 2048); } } while (0)
#define PG8_MMA(ai, bj, At, Bt) do { __builtin_amdgcn_s_setprio(1); \
        if constexpr (F8) { _Pragma("unroll") for (int m = 0; m < 4; ++m) _Pragma("unroll") for (int n = 0; n < 2; ++n) \
            asm volatile("v_mfma_scale_f32_16x16x128_f8f6f4 %0, %1, %2, %0, %3, %4 op_sel_hi:[0,0,0]" : "+v"(acc[ai][bj][m][n]) : "v"(Bt##8[n]), "v"(At##8[m]), "v"(sc_w), "v"(sc_a)); } \
        else { _Pragma("unroll") for (int m = 0; m < 4; ++m) _Pragma("unroll") for (int n = 0; n < 2; ++n) _Pragma("unroll") for (int k = 0; k < 2; ++k) \
            acc[ai][bj][m][n] = __builtin_amdgcn_mfma_f32_16x16x32_bf16(Bt[n][k], At[m][k], acc[ai][bj][m][n], 0, 0, 0); } \
        __builtin_amdgcn_s_setprio(0); } while (0)
#define PG8_WAIT_V(n) asm volatile("s_waitcnt vmcnt(" #n ")" ::: "memory")
#define PG8_WAIT_L(n) asm volatile("s_waitcnt lgkmcnt(" #n ")" ::: "memory")
#define PG8_BAR __builtin_amdgcn_s_barrier()
#define PG8_SCHED __builtin_amdgcn_sched_barrier(0)
    Unit cur, nxt; int ui = 0;
    if (!S.next(0, cur)) return;
    f32x4 acc[2][2][4][2];
#pragma unroll
    for (int a = 0; a < 2; ++a)
#pragma unroll
        for (int b = 0; b < 2; ++b)
#pragma unroll
            for (int m = 0; m < 4; ++m)
#pragma unroll
                for (int n = 0; n < 2; ++n) acc[a][b][m][n] = (f32x4){0.f, 0.f, 0.f, 0.f};
    const int sc_w = 0x79797979, sc_a = 0x7f7f7f7f;
    bf16x8 At[4][2], B0[2][2], B1[2][2]; v8i32 At8[4], B08[2], B18[2];
    const char* cA = (const char*)g.A + (size_t)cur.pm * tstep; const char* cB = (const char*)g.Bt + (size_t)cur.pn * tstep;
    S.a_ready(cur);
    if constexpr (SP2) {
        PG8_STAGE(PG8_SB(0, 0), cB, voffB); PG8_STAGE(PG8_SB(0, 1), cB + hstep, voffB); PG8_STAGE(PG8_SA(0, 0), cA, voffA); PG8_STAGE(PG8_SA(0, 1), cA + hstep, voffA);
        if (wr == 1) PG8_BAR;
        PG8_WAIT_V(2); PG8_BAR;
        PG8_STAGE(PG8_SB(1, 0), cB + kstep, voffB); PG8_STAGE(PG8_SA(1, 0), cA + kstep, voffA); PG8_STAGE(PG8_SB(1, 1), cB + hstep + kstep, voffB);
        PG8_WAIT_V(6); PG8_BAR;
    } else {
        PG8_STAGE(PG8_SB(0, 0), cB, voffB); PG8_STAGE(PG8_SA(0, 0), cA, voffA); PG8_STAGE(PG8_SB(0, 1), cB + hstep, voffB); PG8_STAGE(PG8_SA(0, 1), cA + hstep, voffA);
        if (wr == 1) PG8_BAR;
        PG8_WAIT_V(4); PG8_BAR;
        PG8_STAGE(PG8_SB(1, 0), cB + kstep, voffB); PG8_STAGE(PG8_SA(1, 0), cA + kstep, voffA); PG8_STAGE(PG8_SB(1, 1), cB + hstep + kstep, voffB);
        PG8_WAIT_V(6); PG8_BAR;
    }
    for (;;) {
        const bool has_next = S.next(ui + 1, nxt);
        const char* nA = has_next ? (const char*)g.A + (size_t)nxt.pm * tstep : cA; const char* nB = has_next ? (const char*)g.Bt + (size_t)nxt.pn * tstep : cB;
        for (int t = 0; t < nt; t += 2) {
            const bool last = (t == nt - 2);
            const char* a1 = cA + (size_t)(t + 1) * kstep;
            const char* a2 = last ? nA : cA + (size_t)(t + 2) * kstep; const char* b2 = last ? nB : cB + (size_t)(t + 2) * kstep;
            const char* a3 = a2 + kstep; const char* b3 = b2 + kstep;
            if (last && has_next) S.a_ready(nxt);
            if constexpr (SP2) {
            PG8_LDB(B0, 0, 0); PG8_LDB(B1, 0, 1); PG8_SCHED; PG8_LDA(At, 0, 0); PG8_STAGE(PG8_SA(1, 1), a1 + hstep, voffA);
            PG8_WAIT_V(8); PG8_WAIT_L(0); PG8_BAR; PG8_MMA(0, 0, At, B0); PG8_MMA(0, 1, At, B1); PG8_BAR; PG8_SCHED;
            PG8_LDA(At, 0, 1); PG8_STAGE(PG8_SB(0, 0), b2, voffB); PG8_STAGE(PG8_SB(0, 1), b2 + hstep, voffB); PG8_STAGE(PG8_SA(0, 0), a2, voffA);
            PG8_WAIT_V(8); PG8_WAIT_L(0); PG8_BAR; PG8_MMA(1, 0, At, B0); PG8_MMA(1, 1, At, B1); PG8_BAR; PG8_SCHED;
            PG8_LDB(B0, 1, 0); PG8_LDB(B1, 1, 1); PG8_SCHED; PG8_LDA(At, 1, 0); PG8_STAGE(PG8_SA(0, 1), a2 + hstep, voffA);
            PG8_WAIT_V(8); PG8_WAIT_L(0); PG8_BAR; PG8_MMA(0, 0, At, B0); PG8_MMA(0, 1, At, B1); PG8_BAR; PG8_SCHED;
            PG8_LDA(At, 1, 1); PG8_STAGE(PG8_SB(1, 0), b3, voffB); PG8_STAGE(PG8_SB(1, 1), b3 + hstep, voffB); PG8_STAGE(PG8_SA(1, 0), a3, voffA);
            PG8_WAIT_V(8); PG8_WAIT_L(0); PG8_BAR; PG8_MMA(1, 0, At, B0); PG8_MMA(1, 1, At, B1); PG8_BAR; PG8_SCHED;
            } else {
            PG8_LDB(B0, 0, 0); PG8_SCHED; PG8_LDA(At, 0, 0); PG8_STAGE(PG8_SA(1, 1), a1 + hstep, voffA);
            PG8_WAIT_L(8); PG8_BAR; PG8_WAIT_L(0); PG8_MMA(0, 0, At, B0); PG8_BAR; PG8_SCHED;
            PG8_LDB(B1, 0, 1); PG8_STAGE(PG8_SB(0, 0), b2, voffB);
            PG8_BAR; PG8_WAIT_L(0); PG8_MMA(0, 1, At, B1); PG8_BAR;
            PG8_LDA(At, 0, 1); PG8_STAGE(PG8_SA(0, 0), a2, voffA);
            PG8_BAR; PG8_WAIT_L(0); PG8_MMA(1, 0, At, B0); PG8_BAR; PG8_SCHED;
            PG8_STAGE(PG8_SB(0, 1), b2 + hstep, voffB);
            PG8_WAIT_V(6); PG8_BAR; PG8_MMA(1, 1, At, B1); PG8_BAR;
            PG8_LDB(B0, 1, 0); PG8_SCHED; PG8_LDA(At, 1, 0); PG8_STAGE(PG8_SA(0, 1), a2 + hstep, voffA);
            PG8_WAIT_L(8); PG8_BAR; PG8_WAIT_L(0); PG8_MMA(0, 0, At, B0); PG8_BAR; PG8_SCHED;
            PG8_LDB(B1, 1, 1); PG8_STAGE(PG8_SB(1, 0), b3, voffB);
            PG8_BAR; PG8_WAIT_L(0); PG8_MMA(0, 1, At, B1); PG8_BAR;
            PG8_LDA(At, 1, 1); PG8_STAGE(PG8_SA(1, 0), a3, voffA);
            PG8_BAR; PG8_WAIT_L(0); PG8_MMA(1, 0, At, B0); PG8_BAR; PG8_SCHED;
            PG8_STAGE(PG8_SB(1, 1), b3 + hstep, voffB);
            PG8_WAIT_V(6); PG8_BAR; PG8_MMA(1, 1, At, B1); PG8_BAR;
            }
        }
        if constexpr (ALIGN_EPI) { if (wr == 0) PG8_BAR; }
        if constexpr (F8) asm volatile("s_nop 15\n\ts_nop 15" ::: "memory");
        if constexpr (!Epi::AFTER_DRAIN) { E(acc, cur, wr, wc, fr, fq); S.done(cur); }
        if (!has_next) break;
#pragma unroll
        for (int a = 0; a < 2; ++a)
#pragma unroll
            for (int b = 0; b < 2; ++b)
#pragma unroll
                for (int m = 0; m < 4; ++m)
#pragma unroll
                    for (int n = 0; n < 2; ++n) acc[a][b][m][n] = (f32x4){0.f, 0.f, 0.f, 0.f};
        cur = nxt; cA = nA; cB = nB; ++ui;
        if constexpr (ALIGN_EPI) { if (wr == 1) PG8_BAR; }
    }
    PG8_WAIT_V(0);
    if constexpr (!ALIGN_EPI) { if (wr == 0) PG8_BAR; }
    PG8_BAR;
    if constexpr (Epi::AFTER_DRAIN) { E.fused(acc, cur, wr, wc, fr, fq, lds, wid, lane); S.done(cur); }
#undef PG8_SA
#undef PG8_SB
#undef PG8_STAGE
#undef PG8_LDA
#undef PG8_LDB
#undef PG8_MMA
#undef PG8_WAIT_V
#undef PG8_WAIT_L
#undef PG8_BAR
#undef PG8_SCHED
}
}

constexpr int NWAVES = 8;
constexpr int TT = 16384, DM = 2048, SEQ = 2048;
constexpr int NPROJ = 11264;
constexpr int PC_Z = 0, PC_XBC = 2048, PC_Q = 5120, PC_K = 6144, PC_V = 7168, PC_O = 9216;
constexpr int WIN_LD = 11312;
constexpr int NSLOT = 65536 + 32 * 256;
constexpr float EPSF = 1e-5f;
#ifndef HSYNC_ON
#define HSYNC_ON 0
#endif
#define HWAIT() do { if (HSYNC_ON) asm volatile("s_waitcnt vmcnt(0) lgkmcnt(0)\n\ts_nop 15\n\ts_nop 15" ::: "memory"); } while (0)
#define HSYNC() do { if (HSYNC_ON) { HWAIT(); __syncthreads(); } } while (0)
#ifndef MK_PER_PHASE
#define MK_PER_PHASE 0
#endif
constexpr int N_PHASES = 11;

constexpr size_t MiB = 1u << 20;
constexpr size_t WS_CTL = 0, CTL_ZERO_BYTES = 1 * MiB;
constexpr size_t WS_WIN = 2 * MiB, WS_WSM = 46 * MiB, WS_WRT = 47 * MiB, WS_WOUT = 48 * MiB, WS_WGU = 64 * MiB, WS_WD = 576 * MiB;
constexpr size_t WS_XN1 = 832 * MiB, WS_PROJ = 896 * MiB, WS_SMALL = 1248 * MiB, WS_SSQ = 1252 * MiB, WS_YMIX = 1256 * MiB, WS_H2 = 1384 * MiB, WS_XN2 = 1512 * MiB;
constexpr size_t WS_ROUTE = 1576 * MiB, WS_XG = 1578 * MiB, WS_ACT = 1866 * MiB, WS_YR = 2154 * MiB, WS_XC = 2442 * MiB, WS_END = 2538 * MiB;
constexpr int CW_BAR = 4096;
constexpr int CW_CNT = 65536;

constexpr int RING_BYTES = 131072;
constexpr int LDS_BYTES = 147456;
constexpr int LDSCTL_OFF = LDS_BYTES - 576, MISC_OFF = LDSCTL_OFF;
constexpr int TAB_OFF = LDSCTL_OFF + 64;

#define GAS __attribute__((address_space(1)))
#define LAS __attribute__((address_space(3)))
typedef unsigned short bf16;
typedef unsigned v4u __attribute__((ext_vector_type(4)));
typedef unsigned v2u __attribute__((ext_vector_type(2)));
typedef float f32x4 __attribute__((ext_vector_type(4)));
typedef float f32x2 __attribute__((ext_vector_type(2)));
typedef short bf16x8 __attribute__((ext_vector_type(8)));
typedef GAS unsigned gu32;
#define RLX_AGENT __ATOMIC_RELAXED, __HIP_MEMORY_SCOPE_AGENT
#define LDS_WAIT() asm volatile("s_waitcnt lgkmcnt(0)" ::: "memory")
#define VM_WAIT() asm volatile("s_waitcnt vmcnt(0)" ::: "memory")
__device__ __forceinline__ unsigned f2bf(float f) { unsigned u = __builtin_bit_cast(unsigned, f); return (u + 0x7fffu + ((u >> 16) & 1u)) >> 16; }
__device__ __forceinline__ unsigned pk2(float lo, float hi) { return f2bf(lo) | (f2bf(hi) << 16); }
__device__ __forceinline__ float bflo(unsigned w) { return __builtin_bit_cast(float, w << 16); }
__device__ __forceinline__ float bfhi(unsigned w) { return __builtin_bit_cast(float, w & 0xffff0000u); }
__device__ __forceinline__ float wave_sum(float v) {
#pragma unroll
    for (int o = 1; o < 64; o <<= 1) v += __shfl_xor(v, o);
    return v;
}
__device__ __forceinline__ float softplusf(float x) { return x > 20.f ? x : log1pf(expf(x)); }
__device__ __forceinline__ float logsigf(float x) { return fminf(x, 0.f) - log1pf(expf(-fabsf(x))); }
__device__ __forceinline__ float siluf(float v) { return v * __builtin_amdgcn_rcpf(1.0f + __expf(-v)); }

#define XB_TMO      128
#define XB_XCNT(j)  (256  + 64 * (j))
#define XB_XSUB(j)  (1280 + 64 * (j))
#define XB_XGEN(j)  (2304 + 64 * (j))
#define XB_TOP      3328
#define XB_TOPGEN   3392
#define XCD_BAR_WORDS 3456
#define XB_SPIN_CAP (1u << 18)

__device__ __forceinline__ unsigned xb_ld(unsigned* p)              { return __hip_atomic_load(p, __ATOMIC_RELAXED, __HIP_MEMORY_SCOPE_AGENT); }
__device__ __forceinline__ unsigned xb_add(unsigned* p, unsigned v) { return __hip_atomic_fetch_add(p, v, __ATOMIC_RELAXED, __HIP_MEMORY_SCOPE_AGENT); }
__device__ __forceinline__ unsigned xb_xcc_id() { return (unsigned)__builtin_amdgcn_s_getreg((3 << 11) | 20) & 0xFu; }
#define XB_SPIN(cond, bar) do { unsigned _sp = 0; while (cond) { __builtin_amdgcn_s_sleep(1); \
    if ((++_sp & 255u) == 0u) { if (xb_ld(&(bar)[XB_TMO])) break; if (_sp > XB_SPIN_CAP) { atomicAdd(&(bar)[XB_TMO], 1u); break; } } } } while (0)

struct XcdBarrier {
    unsigned* bar; unsigned x;
    volatile LAS unsigned* st;
};

__device__ __forceinline__ XcdBarrier xcd_barrier_post(unsigned* bar, volatile LAS unsigned* st) {
    XcdBarrier b; b.bar = bar; b.x = xb_xcc_id(); b.st = st;
    if (threadIdx.x == 0) (void)xb_add(&bar[XB_XCNT(b.x)], 1u);
    return b;
}
__device__ __forceinline__ void xcd_barrier_complete(unsigned* bar, unsigned x, unsigned& nloc, unsigned& nx) {
    const unsigned G = gridDim.x * gridDim.y * gridDim.z;
    unsigned sum, cnt, mine, sp = 0u;
    for (;;) {
        sum = 0u; cnt = 0u; mine = 0u;
#pragma unroll
        for (unsigned j = 0; j < 16; ++j) { const unsigned c = xb_ld(&bar[XB_XCNT(j)]); sum += c; cnt += (c > 0u) ? 1u : 0u; mine = (j == x) ? c : mine; }
        if (sum == G) break;
        __builtin_amdgcn_s_sleep(1);
        if ((++sp & 255u) == 0u) { if (xb_ld(&bar[XB_TMO])) break; if (sp > XB_SPIN_CAP) { atomicAdd(&bar[XB_TMO], 1u); break; } }
    }
    nloc = mine > 0u ? mine : 1u; nx = cnt > 0u ? cnt : 1u;
}

__device__ __forceinline__ void xcd_barrier(const XcdBarrier& b) {
    asm volatile("s_waitcnt vmcnt(0)" ::: "memory");
    __syncthreads();
    if (threadIdx.x == 0) {
        unsigned* bar = b.bar;
        __builtin_amdgcn_s_waitcnt(0);
        unsigned nloc = b.st[0], nx = b.st[1];
        if (nloc == 0u) { xcd_barrier_complete(bar, b.x, nloc, nx); b.st[0] = nloc; b.st[1] = nx; }
        const unsigned old = xb_add(&bar[XB_XSUB(b.x)], 1u);
        const unsigned gen = old / nloc;
        if (old + 1u == (gen + 1u) * nloc) {
            __builtin_amdgcn_fence(__ATOMIC_RELEASE, "agent");
            asm volatile("s_waitcnt vmcnt(0)" ::: "memory");
            const unsigned og = xb_add(&bar[XB_TOP], 1u);
            const unsigned tg = og / nx;
            if (og + 1u == (tg + 1u) * nx) xb_add(&bar[XB_TOPGEN], 1u);
            else XB_SPIN(xb_ld(&bar[XB_TOPGEN]) == tg, bar);
            __builtin_amdgcn_fence(__ATOMIC_ACQUIRE, "agent");
            xb_add(&bar[XB_XGEN(b.x)], 1u);
            asm volatile("s_waitcnt vmcnt(0)" ::: "memory");
        } else {
            XB_SPIN(xb_ld(&bar[XB_XGEN(b.x)]) == gen, bar);
            __builtin_amdgcn_fence(__ATOMIC_ACQUIRE, "agent");
            asm volatile("s_waitcnt vmcnt(0)" ::: "memory");
        }
    }
    __syncthreads();
}

struct Frame {
    LAS unsigned char* lds;
    volatile LAS unsigned* MISC;
    gu32* ctl;
    int tid, lane, wave, G, bid;
    const float *x, *norm1_w, *w_in, *conv_w, *conv_b, *dt_bias, *a_log, *d_skip, *ssd_norm_w, *i_bias, *f_bias, *ml_norm_w, *w_out, *norm2_w, *router_w, *router_b, *w_gate_up, *b_gate_up, *w_down, *b_down, *final_norm_w;
    float* out; unsigned char* ws;
};

__device__ __forceinline__ void p0_transpose_item(const float* W, int ldw, int K, bf16* WT, int dst_row0, int src_col0, int k0, LAS float* scr, int lane) {
#pragma unroll 8
    for (int i = 0; i < 32; ++i) { const int kk = 2 * i + (lane >> 5); scr[kk * 33 + (lane & 31)] = W[(size_t)(k0 + kk) * ldw + src_col0 + (lane & 31)]; }
    LDS_WAIT(); asm volatile("" ::: "memory");
    const int c = lane & 7;
#pragma unroll
    for (int j = 0; j < 4; ++j) { const int n = (lane >> 3) + 8 * j; const LAS float* s = scr + (8 * c) * 33 + n;
        v4u o; o.x = pk2(s[0 * 33], s[1 * 33]); o.y = pk2(s[2 * 33], s[3 * 33]); o.z = pk2(s[4 * 33], s[5 * 33]); o.w = pk2(s[6 * 33], s[7 * 33]);
        *(v4u*)(WT + (size_t)(dst_row0 + n) * K + k0 + 8 * c) = o; }
    LDS_WAIT(); asm volatile("" ::: "memory");
}
__device__ __forceinline__ void p0_transpose_item_f8(const float* W, int ldw, int K, unsigned char* WT, int dst_row0, int src_col0, int k0, LAS float* scr, int lane) {
#pragma unroll 8
    for (int i = 0; i < 32; ++i) { const int kk = 2 * i + (lane >> 5); scr[kk * 33 + (lane & 31)] = W[(size_t)(k0 + kk) * ldw + src_col0 + (lane & 31)] * 64.0f; }
    LDS_WAIT(); asm volatile("" ::: "memory");
    const int c = lane & 3;
#pragma unroll
    for (int j = 0; j < 2; ++j) { const int n = (lane >> 2) + 16 * j; const LAS float* s = scr + (16 * c) * 33 + n; int o[4];
#pragma unroll
        for (int q = 0; q < 4; ++q) { int w = __builtin_amdgcn_cvt_pk_fp8_f32(s[(4 * q) * 33], s[(4 * q + 1) * 33], 0, false); o[q] = __builtin_amdgcn_cvt_pk_fp8_f32(s[(4 * q + 2) * 33], s[(4 * q + 3) * 33], w, true); }
        *(v4u*)(WT + (size_t)(dst_row0 + n) * K + k0 + 16 * c) = (v4u){(unsigned)o[0], (unsigned)o[1], (unsigned)o[2], (unsigned)o[3]}; }
    LDS_WAIT(); asm volatile("" ::: "memory");
}
template <bool F8> __device__ __forceinline__ void p0_transpose128(const float* W, int ldw, int K, void* WTv, int dst_row0, int src_col0, int k0, LAS float* scr, int lane) {
    const float* src = W + (size_t)(k0 + (lane >> 3)) * ldw + src_col0 + 4 * (lane & 7);
    f32x4 v[16];
#pragma unroll
    for (int i = 0; i < 16; ++i) v[i] = *(const f32x4*)(src + (size_t)(8 * i) * ldw);
#pragma unroll
    for (int i = 0; i < 16; ++i) { LAS float* d = scr + (8 * i + (lane >> 3)) * 33 + 4 * (lane & 7); d[0] = v[i].x; d[1] = v[i].y; d[2] = v[i].z; d[3] = v[i].w; }
    LDS_WAIT(); asm volatile("" ::: "memory");
    const int n = lane & 31, hf = lane >> 5; const LAS float* s = scr + (64 * hf) * 33 + n;
    if (F8) { unsigned char* dst = (unsigned char*)WTv + (size_t)(dst_row0 + n) * K + k0 + 64 * hf;
#pragma unroll
        for (int j = 0; j < 4; ++j) { int o[4];
#pragma unroll
            for (int q = 0; q < 4; ++q) { const LAS float* p = s + (16 * j + 4 * q) * 33; int w = __builtin_amdgcn_cvt_pk_fp8_f32(p[0] * 64.0f, p[33] * 64.0f, 0, false); o[q] = __builtin_amdgcn_cvt_pk_fp8_f32(p[66] * 64.0f, p[99] * 64.0f, w, true); }
            *(v4u*)(dst + 16 * j) = (v4u){(unsigned)o[0], (unsigned)o[1], (unsigned)o[2], (unsigned)o[3]}; }
    } else { bf16* dst = (bf16*)WTv + (size_t)(dst_row0 + n) * K + k0 + 64 * hf;
#pragma unroll
        for (int j = 0; j < 8; ++j) { const LAS float* p = s + (8 * j) * 33;
            *(v4u*)(dst + 8 * j) = (v4u){pk2(p[0], p[33]), pk2(p[66], p[99]), pk2(p[132], p[165]), pk2(p[198], p[231])}; }
    }
    LDS_WAIT(); asm volatile("" ::: "memory");
}
__device__ __forceinline__ void rms_row_to_bf16(const float* xrow, const float* w, bf16* orow, int lane) {
    const f32x4* xr = (const f32x4*)xrow + lane; const f32x4* wr = (const f32x4*)w + lane;
    f32x4 v[8]; float s = 0.f;
#pragma unroll
    for (int j = 0; j < 8; ++j) { v[j] = xr[64 * j]; s += (v[j].x * v[j].x + v[j].y * v[j].y) + (v[j].z * v[j].z + v[j].w * v[j].w); }
    const float rstd = 1.0f / sqrtf(wave_sum(s) * (1.0f / 2048.0f) + EPSF);
    v2u* o8 = (v2u*)orow + lane;
#pragma unroll
    for (int j = 0; j < 8; ++j) { const f32x4 ww = wr[64 * j]; v2u o; o.x = pk2(v[j].x * rstd * ww.x, v[j].y * rstd * ww.y); o.y = pk2(v[j].z * rstd * ww.z, v[j].w * rstd * ww.w); o8[64 * j] = o; }
}
__device__ __forceinline__ void phase0(Frame& F) {
    LAS float* scr = (LAS float*)(F.lds + F.wave * 16896);
    const int gw = F.bid * NWAVES + F.wave, NGW = F.G * NWAVES;
    bf16* WinT = (bf16*)(F.ws + WS_WIN); bf16* WsT = (bf16*)(F.ws + WS_WSM); float* Wrt = (float*)(F.ws + WS_WRT); bf16* WoutT = (bf16*)(F.ws + WS_WOUT);
    unsigned char* WguT = (unsigned char*)(F.ws + WS_WGU); unsigned char* WdT = (unsigned char*)(F.ws + WS_WD); bf16* XN1 = (bf16*)(F.ws + WS_XN1);
    constexpr int I_IN = 16 * 352, I_OUT = 32 * 64, I_GU = 32 * 2048, I_D = 32 * 1024, NITEMS = I_IN + I_OUT + I_GU + I_D;
    for (int it = gw; it < NITEMS; it += NGW) {
        int r = it;
        if (r < I_IN) { const int kb = r / 352, nb = r % 352, n0 = nb * 32; p0_transpose128<false>(F.w_in, WIN_LD, 2048, WinT, n0, n0 + (n0 >= 5120 ? 32 : 0), kb * 128, scr, F.lane); continue; } r -= I_IN;
        if (r < I_OUT) { const int kb = r >> 6, nb = r & 63; p0_transpose128<false>(F.w_out, 2048, 4096, WoutT, nb * 32, nb * 32, kb * 128, scr, F.lane); continue; } r -= I_OUT;
        if (r < I_GU) { const int e = r >> 11, rr = r & 2047, kb = rr >> 7, nb = rr & 127; p0_transpose128<true>(F.w_gate_up + (size_t)e * 2048 * 4096, 4096, 2048, WguT + (size_t)e * 4096 * 2048, nb * 32, nb * 32, kb * 128, scr, F.lane); continue; } r -= I_GU;
        { const int e = r >> 10, rr = r & 1023, kb = rr >> 6, nb = rr & 63; p0_transpose128<true>(F.w_down + (size_t)e * 2048 * 2048, 2048, 2048, WdT + (size_t)e * 2048 * 2048, nb * 32, nb * 32, kb * 128, scr, F.lane); }
    }
    for (int i = gw * 64 + F.lane; i < 64 * 2048; i += NGW * 64) { const int j = i >> 11, k = i & 2047;
        const int col = j < 32 ? 5120 + j : (j < 40 ? 11296 + (j - 32) : 11304 + (j - 40));
        WsT[i] = (bf16)(j < 48 ? f2bf(F.w_in[(size_t)k * WIN_LD + col]) : 0u); }
    for (int i = gw * 64 + F.lane; i < 2048 * 32; i += NGW * 64) Wrt[i] = F.norm2_w[i >> 5] * F.router_w[i];
    for (int m = gw; m < TT; m += NGW) rms_row_to_bf16(F.x + (size_t)m * DM, F.norm1_w, XN1 + (size_t)m * DM, F.lane);
}

__device__ __forceinline__ void p1_small(Frame& F) {
    const bf16* XN1 = (const bf16*)(F.ws + WS_XN1); const bf16* WsT = (const bf16*)(F.ws + WS_WSM); float* SMALL = (float*)(F.ws + WS_SMALL);
    const int gw = F.bid * NWAVES + F.wave, NGW = F.G * NWAVES, fr = F.lane & 15, fq = F.lane >> 4;
    for (int task = gw; task < TT / 16; task += NGW) {
        const int t0 = task * 16;
        f32x4 acc[4];
#pragma unroll
        for (int n = 0; n < 4; ++n) acc[n] = (f32x4){0.f, 0.f, 0.f, 0.f};
        const bf16* arow = XN1 + (size_t)(t0 + fr) * DM + 8 * fq; const bf16* brow = WsT + (size_t)fr * DM + 8 * fq;
#pragma unroll 16
        for (int ks = 0; ks < 64; ++ks) {
            const bf16x8 a = *(const bf16x8*)(arow + 32 * ks);
#pragma unroll
            for (int n = 0; n < 4; ++n) { const bf16x8 b = *(const bf16x8*)(brow + (size_t)n * 16 * DM + 32 * ks); acc[n] = __builtin_amdgcn_mfma_f32_16x16x32_bf16(a, b, acc[n], 0, 0, 0); }
        }
#pragma unroll
        for (int n = 0; n < 4; ++n)
#pragma unroll
            for (int r = 0; r < 4; ++r) SMALL[(size_t)(t0 + 4 * fq + r) * 64 + n * 16 + fr] = acc[n][r];
    }
}

__device__ __forceinline__ void unpack8(const v4u r, float (&f)[8]) { f[0] = bflo(r.x); f[1] = bfhi(r.x); f[2] = bflo(r.y); f[3] = bfhi(r.y); f[4] = bflo(r.z); f[5] = bfhi(r.z); f[6] = bflo(r.w); f[7] = bfhi(r.w); }

__device__ __forceinline__ void phase_conv(Frame& F) {
    const bf16* PROJ = (const bf16*)(F.ws + WS_PROJ); bf16* XC = (bf16*)(F.ws + WS_XC);
    constexpr int TB = 16, NCG = 384, NIT = (TT / TB) * NCG;
    for (int it = F.bid * (NWAVES * 64) + F.tid; it < NIT; it += F.G * NWAVES * 64) {
        const int cg = it % NCG, tb = it / NCG, ch = cg * 8, t0 = tb * TB; const bool seq0 = (t0 % SEQ) == 0;
        float w[4][8], bs[8];
#pragma unroll
        for (int j = 0; j < 4; ++j) { const f32x4 a = *(const f32x4*)(F.conv_w + j * 3072 + ch), b = *(const f32x4*)(F.conv_w + j * 3072 + ch + 4);
            w[j][0] = a.x; w[j][1] = a.y; w[j][2] = a.z; w[j][3] = a.w; w[j][4] = b.x; w[j][5] = b.y; w[j][6] = b.z; w[j][7] = b.w; }
        { const f32x4 a = *(const f32x4*)(F.conv_b + ch), b = *(const f32x4*)(F.conv_b + ch + 4); bs[0] = a.x; bs[1] = a.y; bs[2] = a.z; bs[3] = a.w; bs[4] = b.x; bs[5] = b.y; bs[6] = b.z; bs[7] = b.w; }
        const bf16* src = PROJ + (size_t)t0 * NPROJ + PC_XBC + ch;
        float r0[8], r1[8], r2[8], r3[8];
        if (seq0) {
#pragma unroll
            for (int i = 0; i < 8; ++i) { r0[i] = 0.f; r1[i] = 0.f; r2[i] = 0.f; }
        } else { unpack8(*(const v4u*)(src - 3 * (size_t)NPROJ), r0); unpack8(*(const v4u*)(src - 2 * (size_t)NPROJ), r1); unpack8(*(const v4u*)(src - (size_t)NPROJ), r2); }
        v4u rw[TB];
#pragma unroll
        for (int l = 0; l < TB; ++l) rw[l] = *(const v4u*)(src + (size_t)l * NPROJ);
#pragma unroll
        for (int l = 0; l < TB; ++l) {
            unpack8(rw[l], r3);
            float o[8];
#pragma unroll
            for (int i = 0; i < 8; ++i) { const float v = bs[i] + w[0][i] * r0[i] + w[1][i] * r1[i] + w[2][i] * r2[i] + w[3][i] * r3[i]; o[i] = siluf(v); r0[i] = r1[i]; r1[i] = r2[i]; r2[i] = r3[i]; }
            v4u ov; ov.x = pk2(o[0], o[1]); ov.y = pk2(o[2], o[3]); ov.z = pk2(o[4], o[5]); ov.w = pk2(o[6], o[7]);
            *(v4u*)(XC + (size_t)(t0 + l) * 3072 + ch) = ov;
        }
    }
}

constexpr int MX_PITCH = 272;
static_assert(true, "");
constexpr int MX_QM = 0, MX_KM = 34816, MX_KW = 69632, MX_VT = 104448, MX_SI = 121856, MX_VEC = 139264, MX_VECB = 3072, MX_NVEC = MX_VEC + 2 * MX_VECB, MX_SCAL = MX_NVEC + 512, MX_END = MX_SCAL + 64;
__device__ __forceinline__ unsigned cvt_pk_bf16_nop(float lo, float hi) { unsigned r; asm volatile("v_cvt_pk_bf16_f32 %0, %1, %2\n\ts_nop 1" : "=v"(r) : "v"(lo), "v"(hi)); return r; }
__device__ __forceinline__ int mx_sw(int row, int tbyte) { return row * MX_PITCH + ((((tbyte >> 4) ^ (row >> 3)) & 15) << 4) + (tbyte & 15); }
__device__ __forceinline__ bf16x8 lds_frag(const LAS unsigned char* img, int row, int kbyte) { return *(const LAS bf16x8*)(img + row * MX_PITCH + kbyte); }
static_assert(MX_END <= LDSCTL_OFF, "mixer LDS map");
template <bool ML> __device__ __forceinline__ void mixer_unit(Frame& F, int unit) {
    const bf16* PROJ = (const bf16*)(F.ws + WS_PROJ); const bf16* XC = (const bf16*)(F.ws + WS_XC); const float* SMALL = (const float*)(F.ws + WS_SMALL);
    bf16* YMIX = (bf16*)(F.ws + WS_YMIX); float* SSQ = (float*)(F.ws + WS_SSQ);
    const int w = F.wave, fr = F.lane & 15, fq = F.lane >> 4, tid = F.tid;
    const int b = unit >> 5, tok0 = b * SEQ, hd = unit & 31, grp = hd >> 3, mh = (unit & 31) >> 2, vq = unit & 3;
    const float qs = 0.08838834764831845f;
    LAS unsigned char* QM = F.lds + MX_QM; LAS unsigned char* KM = F.lds + MX_KM; LAS unsigned char* KW = F.lds + MX_KW; LAS unsigned char* VT = F.lds + MX_VT; LAS unsigned char* SI = F.lds + MX_SI;
    LAS float* exch = (LAS float*)(F.lds + MX_VEC + (w >> 2) * MX_VECB + 1024) + (w & 3) * 32;
    LAS float* nvec = (LAS float*)(F.lds + MX_NVEC); LAS float* scal = (LAS float*)(F.lds + MX_SCAL);
    const int fr3 = fr >> 3;
    int vtb[2];
#pragma unroll
    for (int p = 0; p < 2; ++p) vtb[p] = fr * MX_PITCH + ((fq ^ ((2 * p) | fr3)) << 4);
    int vpb[2][2];
#pragma unroll
    for (int p = 0; p < 2; ++p)
#pragma unroll
        for (int h = 0; h < 2; ++h) vpb[p][h] = fr * MX_PITCH + (((((fq >> 1) | (2 * h)) ^ ((2 * p) | fr3))) << 4) + 8 * (fq & 1);
    const int kwb = (16 * w + fr) * MX_PITCH + ((fq ^ ((2 * (w & 1)) | fr3)) << 4), kwh = w >> 1;

    const bf16* qsrc; const bf16* ksrc; const bf16* vsrc; int ld;
    if (ML) { qsrc = PROJ + PC_Q + mh * 128; ksrc = PROJ + PC_K + mh * 128; vsrc = PROJ + PC_V + mh * 256 + vq * 64; ld = NPROJ; }
    else { qsrc = XC + 2560 + grp * 128; ksrc = XC + 2048 + grp * 128; vsrc = XC + hd * 64; ld = 3072; }
    const float c_a = ML ? 0.f : -expf(F.a_log[hd]), c_dtb = ML ? 0.f : F.dt_bias[hd], c_D = ML ? 0.f : F.d_skip[hd], c_ib = ML ? F.i_bias[mh] : 0.f, c_fb = ML ? F.f_bias[mh] : 0.f;
    float mprev = 0.f;
    f32x4 sacc[4]; float nreg = 0.f;
#pragma unroll
    for (int j = 0; j < 4; ++j) sacc[j] = (f32x4){0.f, 0.f, 0.f, 0.f};
    v4u pq[4], pk[4], pv[2];
    float vA0 = 0.f, vA1 = 0.f, vB0 = 0.f, vB1 = 0.f, vC0 = 0.f, vC1 = 0.f, vD0 = 0.f, vD1 = 0.f, vE0 = 0.f, vE1 = 0.f, vG0 = 0.f, vG1 = 0.f, vSA = 0.f, vSG = 0.f;
    float sl0 = 0.f, sl1 = 0.f, sl2 = 0.f, sl3 = 0.f;
#define MX_SCAN_L(c) do { if (w == 0) { const size_t tt = (size_t)(tok0 + 128 * (c) + 2 * F.lane); \
        if (!ML) { sl0 = SMALL[tt * 64 + hd]; sl1 = SMALL[(tt + 1) * 64 + hd]; } \
        else { sl0 = SMALL[tt * 64 + 32 + mh]; sl1 = SMALL[(tt + 1) * 64 + 32 + mh]; sl2 = SMALL[tt * 64 + 40 + mh]; sl3 = SMALL[(tt + 1) * 64 + 40 + mh]; } } } while (0)
#define MX_SOFTPLUS(x) ((x) > 20.f ? (x) : __logf(1.0f + __expf(x)))
#define MX_LOGSIG(x) (fminf((x), 0.f) - __logf(1.0f + __expf(-fabsf(x))))
#define MX_SCAN_A(c) do { if (w == 0) { \
        if (!ML) { const float d0 = MX_SOFTPLUS(sl0 + c_dtb), d1 = MX_SOFTPLUS(sl1 + c_dtb); \
            const float x0 = d0 * c_a, x1 = d1 * c_a; float incl = x0 + x1; \
            _Pragma("unroll") for (int d = 1; d < 64; d <<= 1) { const float t_ = __shfl_up(incl, d); if (F.lane >= d) incl += t_; } \
            const float cum1 = incl, cum0 = incl - x1, tot = __shfl(incl, 63); \
            vA0 = -cum0; vA1 = -cum1; vB0 = -cum0; vB1 = -cum1; vC0 = d0; vC1 = d1; vD0 = __expf(cum0); vD1 = __expf(cum1); vE0 = d0 * __expf(tot - cum0); vE1 = d1 * __expf(tot - cum1); vSA = __expf(tot); vSG = 1.0f; \
        } else { const float li0 = sl0 + c_ib, li1 = sl1 + c_ib; \
            const float x0 = MX_LOGSIG(sl2 + c_fb), x1 = MX_LOGSIG(sl3 + c_fb); float incl = x0 + x1; \
            _Pragma("unroll") for (int d = 1; d < 64; d <<= 1) { const float t_ = __shfl_up(incl, d); if (F.lane >= d) incl += t_; } \
            const float cum1 = incl, cum0 = incl - x1, btot = __shfl(incl, 63); \
            const float dd0 = li0 - cum0, dd1 = li1 - cum1; float im = fmaxf(dd0, dd1); \
            _Pragma("unroll") for (int d = 1; d < 64; d <<= 1) { const float t_ = __shfl_up(im, d); if (F.lane >= d) im = fmaxf(im, t_); } \
            float pm = __shfl_up(im, 1); if (F.lane == 0) pm = -3.0e38f; const float pmax0 = fmaxf(pm, dd0), pmax1 = im, pm127 = __shfl(im, 63); \
            const float M0 = fmaxf(mprev, pmax0), M1 = fmaxf(mprev, pmax1); \
            vA0 = dd0; vA1 = dd1; vB0 = M0; vB1 = M1; vD0 = qs * __expf(mprev - M0); vD1 = qs * __expf(mprev - M1); vG0 = __expf(-(cum0 + M0)); vG1 = __expf(-(cum1 + M1)); \
            const float mloc = btot + pm127, mnew = fmaxf(btot + mprev, mloc); \
            vSA = __expf(btot + mprev - mnew); vSG = __expf(mloc - mnew); vE0 = __expf(dd0 - pm127) * vSG; vE1 = __expf(dd1 - pm127) * vSG; mprev = mnew; } } } while (0)
#define MX_SCAN_B(c) do { if (w == 0) { \
        LAS float* vb = (LAS float*)(F.lds + MX_VEC + ((c) & 1) * MX_VECB); const int l0 = 2 * F.lane; \
        *(LAS f32x2*)(vb + l0) = (f32x2){vA0, vA1}; *(LAS f32x2*)(vb + 128 + l0) = (f32x2){vB0, vB1}; if (!ML) *(LAS f32x2*)(vb + 256 + l0) = (f32x2){vC0, vC1}; \
        *(LAS f32x2*)(vb + 384 + l0) = (f32x2){vD0, vD1}; *(LAS f32x2*)(vb + 512 + l0) = (f32x2){vE0, vE1}; if (ML) *(LAS f32x2*)(vb + 640 + l0) = (f32x2){vG0, vG1}; \
        if (F.lane == 0) { scal[2 * ((c) & 1)] = vSA; scal[2 * ((c) & 1) + 1] = vSG; } } } while (0)
#define MX_SCAN(c) do { MX_SCAN_L(c); MX_SCAN_A(c); MX_SCAN_B(c); } while (0)
#define MX_PREFETCH(c) do { const size_t tb_ = (size_t)(tok0 + 128 * (c)); \
        _Pragma("unroll") for (int i = 0; i < 2; ++i) { const int pid = tid + 512 * i, a2 = pid >> 4, k8 = pid & 15; \
            pq[2 * i] = *(const v4u*)(qsrc + (tb_ + 2 * a2) * ld + 8 * k8); pq[2 * i + 1] = *(const v4u*)(qsrc + (tb_ + 2 * a2 + 1) * ld + 8 * k8); \
            pk[2 * i] = *(const v4u*)(ksrc + (tb_ + 2 * a2) * ld + 8 * k8); pk[2 * i + 1] = *(const v4u*)(ksrc + (tb_ + 2 * a2 + 1) * ld + 8 * k8); } \
        { const int a2 = tid >> 3, v8 = tid & 7; pv[0] = *(const v4u*)(vsrc + (tb_ + 2 * a2) * ld + 8 * v8); pv[1] = *(const v4u*)(vsrc + (tb_ + 2 * a2 + 1) * ld + 8 * v8); } } while (0)
#define MX_WRITE(c) do { const LAS float* vb = (const LAS float*)(F.lds + MX_VEC + ((c) & 1) * MX_VECB); \
        _Pragma("unroll") for (int i = 0; i < 2; ++i) { const int pid = tid + 512 * i, a2 = pid >> 4, k8 = pid & 15, l = 2 * a2; \
            *(LAS v4u*)(QM + l * MX_PITCH + 16 * k8) = pq[2 * i]; *(LAS v4u*)(QM + (l + 1) * MX_PITCH + 16 * k8) = pq[2 * i + 1]; \
            *(LAS v4u*)(KM + l * MX_PITCH + 16 * k8) = pk[2 * i]; *(LAS v4u*)(KM + (l + 1) * MX_PITCH + 16 * k8) = pk[2 * i + 1]; \
            float f0[8], f1[8]; unpack8(pk[2 * i], f0); unpack8(pk[2 * i + 1], f1); const f32x2 wl = *(const LAS f32x2*)(vb + 512 + l); \
            _Pragma("unroll") for (int e = 0; e < 8; ++e) *(LAS unsigned*)(KW + mx_sw(8 * k8 + e, 2 * l)) = pg8::cvt_pk_bf16(f0[e] * wl.x, f1[e] * wl.y); } \
        { const int a2 = tid >> 3, v8 = tid & 7, l = 2 * a2; const v4u r0 = pv[0], r1 = pv[1]; LAS unsigned char* vp_ = VT + mx_sw(8 * v8, 2 * l); \
            *(LAS unsigned*)(vp_ + 0 * MX_PITCH) = (r0.x & 0xffffu) | (r1.x << 16); *(LAS unsigned*)(vp_ + 1 * MX_PITCH) = (r0.x >> 16) | (r1.x & 0xffff0000u); \
            *(LAS unsigned*)(vp_ + 2 * MX_PITCH) = (r0.y & 0xffffu) | (r1.y << 16); *(LAS unsigned*)(vp_ + 3 * MX_PITCH) = (r0.y >> 16) | (r1.y & 0xffff0000u); \
            *(LAS unsigned*)(vp_ + 4 * MX_PITCH) = (r0.z & 0xffffu) | (r1.z << 16); *(LAS unsigned*)(vp_ + 5 * MX_PITCH) = (r0.z >> 16) | (r1.z & 0xffff0000u); \
            *(LAS unsigned*)(vp_ + 6 * MX_PITCH) = (r0.w & 0xffffu) | (r1.w << 16); *(LAS unsigned*)(vp_ + 7 * MX_PITCH) = (r0.w >> 16) | (r1.w & 0xffff0000u); } \
        _Pragma("unroll") for (int j = 0; j < 4; ++j) { v2u sv; sv.x = pg8::cvt_pk_bf16(sacc[j][0], sacc[j][1]); sv.y = pg8::cvt_pk_bf16(sacc[j][2], sacc[j][3]); *(LAS v2u*)(SI + (16 * j + fr) * MX_PITCH + (16 * w + 4 * fq) * 2) = sv; } \
        if (ML && fq == 0) nvec[16 * w + fr] = nreg; } while (0)
    v4u zc0 = (v4u){0u, 0u, 0u, 0u}, zc1 = zc0;
    if (!ML) { const bf16* zp = PROJ + (size_t)(tok0 + 16 * w + (F.lane >> 2)) * NPROJ + PC_Z + hd * 64 + 16 * (F.lane & 3); zc0 = *(const v4u*)zp; zc1 = *(const v4u*)(zp + 8); }
    MX_SCAN(0);
    MX_PREFETCH(0);
    __syncthreads();
    MX_WRITE(0);
    __syncthreads();
    for (int c = 0; c < SEQ / 128; ++c) {
        const LAS float* vb = (const LAS float*)(F.lds + MX_VEC + (c & 1) * MX_VECB);
        const bool more = (c + 1 < SEQ / 128);
        if (more) { MX_SCAN_L(c + 1); MX_PREFETCH(c + 1); }
        bf16x8 qf[4];
#pragma unroll
        for (int ks = 0; ks < 4; ++ks) qf[ks] = lds_frag(QM, 16 * w + fr, 64 * ks + 16 * fq);
        const float mlv = vb[128 + 16 * w + fr];
        float dsum = 0.f;
        f32x4 y1[4];
#pragma unroll
        for (int j = 0; j < 4; ++j) y1[j] = (f32x4){0.f, 0.f, 0.f, 0.f};
        const f32x4 rs4 = *(const LAS f32x4*)(vb + 384 + 16 * w + 4 * fq);
#pragma unroll
        for (int ks = 0; ks < 4; ++ks) { bf16x8 sf[4];
#pragma unroll
            for (int j = 0; j < 4; ++j) sf[j] = lds_frag(SI, 16 * j + fr, 64 * ks + 16 * fq);
#pragma unroll
            for (int j = 0; j < 4; ++j) y1[j] = __builtin_amdgcn_mfma_f32_16x16x32_bf16(qf[ks], sf[j], y1[j], 0, 0, 0); }
#pragma unroll
        for (int j = 0; j < 4; ++j) y1[j] = y1[j] * rs4;
        __builtin_amdgcn_sched_barrier(0);
#pragma unroll 1
        for (int k2 = 0; 2 * k2 <= w; ++k2) {
            unsigned pw[4];
#pragma unroll
            for (int h = 0; h < 2; ++h) {
                const int si = 2 * k2 + h;
                f32x4 acc = (f32x4){0.f, 0.f, 0.f, 0.f};
#pragma unroll
                for (int ks = 0; ks < 4; ++ks) acc = __builtin_amdgcn_mfma_f32_16x16x32_bf16(lds_frag(KM, 16 * si + fr, 64 * ks + 16 * fq), qf[ks], acc, 0, 0, 0);
                const f32x4 e4 = *(const LAS f32x4*)(vb + 16 * si + 4 * fq); f32x4 x4 = (f32x4){qs, qs, qs, qs}; if (!ML) x4 = *(const LAS f32x4*)(vb + 256 + 16 * si + 4 * fq);
                float p[4];
#pragma unroll
                for (int r = 0; r < 4; ++r) { const float v = acc[r] * __expf(e4[r] - mlv) * x4[r]; const bool ok = (si < w) || (si == w && 4 * fq + r <= fr); p[r] = ok ? v : 0.f; }
                if (ML) dsum += (p[0] + p[1]) + (p[2] + p[3]);
                pw[2 * h] = cvt_pk_bf16_nop(p[0], p[1]); pw[2 * h + 1] = cvt_pk_bf16_nop(p[2], p[3]);
            }
            HWAIT();
            const v4u pwv = (v4u){pw[0], pw[1], pw[2], pw[3]}; const bf16x8 pf = __builtin_bit_cast(bf16x8, pwv);
#pragma unroll
            for (int j = 0; j < 4; ++j) { const int ho = j * 16 * MX_PITCH + ((k2 ^ (j >> 1)) << 6); const v2u lo = *(const LAS v2u*)(VT + vpb[j & 1][0] + ho), hi = *(const LAS v2u*)(VT + vpb[j & 1][1] + ho); const v4u vw = (v4u){lo.x, lo.y, hi.x, hi.y};
                y1[j] = __builtin_amdgcn_mfma_f32_16x16x32_bf16(pf, __builtin_bit_cast(bf16x8, vw), y1[j], 0, 0, 0); }
            HWAIT();
        }
        HSYNC();
        __builtin_amdgcn_sched_barrier(0);
        __builtin_amdgcn_sched_barrier(0);
        if (ML) {
            dsum += __shfl_xor(dsum, 16); dsum += __shfl_xor(dsum, 32);
            float d2 = 0.f;
#pragma unroll
            for (int ks = 0; ks < 4; ++ks) { float qv[8]; unpack8(__builtin_bit_cast(v4u, qf[ks]), qv); const f32x4 n0 = *(const LAS f32x4*)(nvec + 32 * ks + 8 * fq), n1 = *(const LAS f32x4*)(nvec + 32 * ks + 8 * fq + 4);
                d2 += qv[0] * n0.x + qv[1] * n0.y + qv[2] * n0.z + qv[3] * n0.w + qv[4] * n1.x + qv[5] * n1.y + qv[6] * n1.z + qv[7] * n1.w; }
            d2 += __shfl_xor(d2, 16); d2 += __shfl_xor(d2, 32);
            if (fq == 0) { exch[fr] = dsum; exch[16 + fr] = d2; }
        }
        HSYNC();
        __builtin_amdgcn_sched_barrier(0);
        LAS float* stg = (LAS float*)(QM + 16 * w * MX_PITCH);
        if (ML) { const f32x4 fl4 = *(const LAS f32x4*)(vb + 640 + 16 * w + 4 * fq); const f32x4 dA = *(const LAS f32x4*)(exch + 4 * fq), dB = *(const LAS f32x4*)(exch + 16 + 4 * fq);
#pragma unroll
            for (int r = 0; r < 4; ++r) { const float den = fmaxf(fabsf(dA[r] + rs4[r] * dB[r]), fl4[r]); const float inv = __builtin_amdgcn_rcpf(den);
#pragma unroll
                for (int j = 0; j < 4; ++j) stg[(4 * fq + r) * 68 + 16 * j + fr] = y1[j][r] * inv; }
        } else {
#pragma unroll
            for (int j = 0; j < 4; ++j) { const v2u xw = *(const LAS v2u*)(VT + mx_sw(16 * j + fr, 32 * w + 8 * fq)); const float xs[4] = {bflo(xw.x), bfhi(xw.x), bflo(xw.y), bfhi(xw.y)};
#pragma unroll
                for (int r = 0; r < 4; ++r) stg[(4 * fq + r) * 68 + 16 * j + fr] = y1[j][r] + c_D * xs[r]; }
        }
        {   const int erow = F.lane >> 2, ecs = F.lane & 3; const size_t trow = (size_t)(tok0 + 128 * c + 16 * w + erow);
            float yv[16];
#pragma unroll
            for (int i = 0; i < 4; ++i) { const f32x4 t4 = *(const LAS f32x4*)(stg + erow * 68 + 16 * ecs + 4 * i); yv[4 * i] = t4.x; yv[4 * i + 1] = t4.y; yv[4 * i + 2] = t4.z; yv[4 * i + 3] = t4.w; }
            if (!ML) { float zf[16]; { float t8[8]; unpack8(zc0, t8);
#pragma unroll
                    for (int i = 0; i < 8; ++i) zf[i] = t8[i]; unpack8(zc1, t8);
#pragma unroll
                    for (int i = 0; i < 8; ++i) zf[8 + i] = t8[i]; }
#pragma unroll
                for (int i = 0; i < 16; ++i) yv[i] = yv[i] * zf[i] * __builtin_amdgcn_rcpf(1.0f + __expf(-zf[i])); }
            float ss = 0.f;
#pragma unroll
            for (int i = 0; i < 16; ++i) ss += yv[i] * yv[i];
            ss += __shfl_xor(ss, 1); ss += __shfl_xor(ss, 2);
            if (ecs == 0) SSQ[(ML ? (size_t)TT * 32 : 0) + trow * 32 + (ML ? mh * 4 + vq : hd)] = ss;
            bf16* yp = YMIX + trow * 4096 + (ML ? 2048 + mh * 256 + vq * 64 : hd * 64) + 16 * ecs;
            *(v4u*)yp = (v4u){pg8::cvt_pk_bf16(yv[0], yv[1]), pg8::cvt_pk_bf16(yv[2], yv[3]), pg8::cvt_pk_bf16(yv[4], yv[5]), pg8::cvt_pk_bf16(yv[6], yv[7])};
            *(v4u*)(yp + 8) = (v4u){pg8::cvt_pk_bf16(yv[8], yv[9]), pg8::cvt_pk_bf16(yv[10], yv[11]), pg8::cvt_pk_bf16(yv[12], yv[13]), pg8::cvt_pk_bf16(yv[14], yv[15])};
            if (!ML && more) { const bf16* zp = PROJ + (size_t)(tok0 + 128 * (c + 1) + 16 * w + (F.lane >> 2)) * NPROJ + PC_Z + hd * 64 + 16 * (F.lane & 3); zc0 = *(const v4u*)zp; zc1 = *(const v4u*)(zp + 8); }
        }
        __builtin_amdgcn_sched_barrier(0);
        const float sa = scal[2 * (c & 1)];
#pragma unroll
        for (int j = 0; j < 4; ++j) sacc[j] = sacc[j] * sa;
        float nsum = 0.f;
#pragma unroll
        for (int ks = 0; ks < 4; ++ks) { const bf16x8 kf = *(const LAS bf16x8*)(KW + kwb + ((ks ^ kwh) << 6)); bf16x8 vf[4];
#pragma unroll
            for (int j = 0; j < 4; ++j) vf[j] = *(const LAS bf16x8*)(VT + vtb[j & 1] + j * 16 * MX_PITCH + ((ks ^ (j >> 1)) << 6));
            if (ML) { float kv[8]; unpack8(__builtin_bit_cast(v4u, kf), kv); nsum += ((kv[0] + kv[1]) + (kv[2] + kv[3])) + ((kv[4] + kv[5]) + (kv[6] + kv[7])); }
#pragma unroll
            for (int j = 0; j < 4; ++j) sacc[j] = __builtin_amdgcn_mfma_f32_16x16x32_bf16(kf, vf[j], sacc[j], 0, 0, 0); }
        if (ML) { nsum += __shfl_xor(nsum, 16); nsum += __shfl_xor(nsum, 32); nreg = nreg * sa + nsum; }
        if (more) { MX_SCAN_A(c + 1); }
        __syncthreads();
        if (more) { MX_SCAN_B(c + 1); }
        __syncthreads();
        if (more) { MX_WRITE(c + 1); }
        __syncthreads();
    }
#undef MX_SCAN
#undef MX_SCAN_A
#undef MX_SCAN_L
#undef MX_SOFTPLUS
#undef MX_LOGSIG
#undef MX_SCAN_B
#undef MX_PREFETCH
#undef MX_WRITE
}
__device__ __forceinline__ void phase_mixer(Frame& F) {
    for (int unit = F.bid; unit < 256; unit += F.G) { mixer_unit<false>(F, unit); mixer_unit<true>(F, unit); }
}

__device__ __forceinline__ void phase3(Frame& F) {
    const bf16* PROJ = (const bf16*)(F.ws + WS_PROJ); bf16* YMIX = (bf16*)(F.ws + WS_YMIX); const float* SSQ = (const float*)(F.ws + WS_SSQ);
    const int gw = F.bid * NWAVES + F.wave, NGW = F.G * NWAVES;
    for (int t = gw; t < TT; t += NGW) {
        bf16* yrow = YMIX + (size_t)t * 4096;
#pragma unroll
        for (int j = 0; j < 8; ++j) {
            const int c0 = (j * 64 + F.lane) * 8;
            float y[8]; unpack8(*(const v4u*)(yrow + c0), y);
            float o[8];
            if (j < 4) {
                const int g = c0 >> 9; const f32x4 s0 = *(const f32x4*)(SSQ + (size_t)t * 32 + g * 8), s1 = *(const f32x4*)(SSQ + (size_t)t * 32 + g * 8 + 4);
                const float ms = ((s0.x + s0.y) + (s0.z + s0.w) + (s1.x + s1.y) + (s1.z + s1.w)) * (1.0f / 512.0f);
                const float rs = 1.0f / sqrtf(ms + EPSF);
                const f32x4 w0 = *(const f32x4*)(F.ssd_norm_w + c0), w1 = *(const f32x4*)(F.ssd_norm_w + c0 + 4);
                o[0] = y[0] * rs * w0.x; o[1] = y[1] * rs * w0.y; o[2] = y[2] * rs * w0.z; o[3] = y[3] * rs * w0.w;
                o[4] = y[4] * rs * w1.x; o[5] = y[5] * rs * w1.y; o[6] = y[6] * rs * w1.z; o[7] = y[7] * rs * w1.w;
            } else {
                const int cc = c0 - 2048, h = cc >> 8; const f32x4 s0 = *(const f32x4*)(SSQ + (size_t)TT * 32 + (size_t)t * 32 + h * 4);
                const float ms = ((s0.x + s0.y) + (s0.z + s0.w)) * (1.0f / 256.0f);
                const float rs = 1.0f / sqrtf(ms + EPSF);
                const f32x4 w0 = *(const f32x4*)(F.ml_norm_w + cc), w1 = *(const f32x4*)(F.ml_norm_w + cc + 4);
                float og[8]; unpack8(*(const v4u*)(PROJ + (size_t)t * NPROJ + PC_O + cc), og);
                const float wv[8] = {w0.x, w0.y, w0.z, w0.w, w1.x, w1.y, w1.z, w1.w};
#pragma unroll
                for (int i = 0; i < 8; ++i) o[i] = y[i] * rs * wv[i] * __builtin_amdgcn_rcpf(1.0f + __expf(-og[i]));
            }
            v4u ov; ov.x = pk2(o[0], o[1]); ov.y = pk2(o[2], o[3]); ov.z = pk2(o[4], o[5]); ov.w = pk2(o[6], o[7]);
            *(v4u*)(yrow + c0) = ov;
        }
    }
}

__device__ __forceinline__ void phase5(Frame& F) {
    const float* H2 = (const float*)(F.ws + WS_H2); const float* Wrt = (const float*)(F.ws + WS_WRT); bf16* XN2 = (bf16*)(F.ws + WS_XN2);
    int* EIDX = (int*)(F.ws + WS_ROUTE); int* RANK = EIDX + TT * 4; float* GATE = (float*)(RANK + TT * 4);
    LAS float* xT = (LAS float*)(F.lds + F.wave * 8192); LAS float* lg = (LAS float*)(F.lds + 65536 + F.wave * 1024);
    LAS int* cntl = (LAS int*)(F.lds + 73728); LAS int* baseg = cntl + 32;
    const int gw = F.bid * NWAVES + F.wave, NGW = F.G * NWAVES, ntask = TT / 8, iters = (ntask + NGW - 1) / NGW;
    for (int itx = 0; itx < iters; ++itx) {
        const int task = itx * NGW + gw; const bool valid = task < ntask; const int t0 = task * 8;
        if (F.tid < 32) cntl[F.tid] = 0;
        __syncthreads();
        float rstd[8]; int me[4] = {0, 0, 0, 0}, mr[4] = {0, 0, 0, 0}; float mg[4] = {0.f, 0.f, 0.f, 0.f};
#pragma unroll
        for (int k = 0; k < 8; ++k) rstd[k] = 0.f;
        float acc[8], ssq[8];
#pragma unroll
        for (int k = 0; k < 8; ++k) { acc[k] = 0.f; ssq[k] = 0.f; }
        const int e = F.lane & 31, dh = F.lane >> 5;
        LAS float* wl = (LAS float*)(F.lds + 81920);
        for (int dc = 0; dc < 8; ++dc) {
            __syncthreads();
#pragma unroll
            for (int q = 0; q < 4; ++q) ((LAS f32x4*)wl)[F.tid + 512 * q] = ((const f32x4*)(Wrt + (size_t)dc * 256 * 32))[F.tid + 512 * q];
            if (valid) {
                f32x4 xk[8];
#pragma unroll
                for (int k = 0; k < 8; ++k) { xk[k] = *(const f32x4*)(H2 + (size_t)(t0 + k) * DM + dc * 256 + 4 * F.lane); ssq[k] += (xk[k].x * xk[k].x + xk[k].y * xk[k].y) + (xk[k].z * xk[k].z + xk[k].w * xk[k].w); }
#pragma unroll
                for (int jj = 0; jj < 4; ++jj) { LAS float* dp = xT + (jj * 64 + F.lane) * 8;
                    *(LAS f32x4*)dp = (f32x4){xk[0][jj], xk[1][jj], xk[2][jj], xk[3][jj]}; *(LAS f32x4*)(dp + 4) = (f32x4){xk[4][jj], xk[5][jj], xk[6][jj], xk[7][jj]}; }
            }
            __syncthreads();
            if (valid) {
                const LAS float* xp = xT + dh * 128 * 8;
#pragma unroll 8
                for (int i = 0; i < 128; ++i) { const float w = wl[(4 * (i & 63) + 2 * dh + (i >> 6)) * 32 + e];     const f32x4 xa = *(const LAS f32x4*)(xp + i * 8), xb = *(const LAS f32x4*)(xp + i * 8 + 4);
                    acc[0] += w * xa.x; acc[1] += w * xa.y; acc[2] += w * xa.z; acc[3] += w * xa.w; acc[4] += w * xb.x; acc[5] += w * xb.y; acc[6] += w * xb.z; acc[7] += w * xb.w; }
            }
        }
        if (valid) {
            const float rb = F.router_b[e];
#pragma unroll
            for (int k = 0; k < 8; ++k) { rstd[k] = 1.0f / sqrtf(wave_sum(ssq[k]) * (1.0f / 2048.0f) + EPSF);
                const float v = (acc[k] + __shfl_xor(acc[k], 32)) * rstd[k] + rb; if (F.lane < 32) lg[k * 32 + e] = v; }
            LDS_WAIT(); asm volatile("" ::: "memory");
            if (F.lane < 8) {
                const LAS float* lp = lg + F.lane * 32; float bv[4]; int bi[4] = {-1, -1, -1, -1};
#pragma unroll
                for (int p = 0; p < 4; ++p) { float best = -3.0e38f; int bidx = 0;
                    for (int q = 0; q < 32; ++q) { const float v = lp[q]; const bool taken = (q == bi[0]) | (q == bi[1]) | (q == bi[2]) | (q == bi[3]); if (!taken && v > best) { best = v; bidx = q; } }
                    bv[p] = best; bi[p] = bidx; }
                const float p1 = expf(bv[1] - bv[0]), p2 = expf(bv[2] - bv[0]), p3 = expf(bv[3] - bv[0]); const float inv = 1.0f / (1.0f + p1 + p2 + p3);
                mg[0] = inv; mg[1] = p1 * inv; mg[2] = p2 * inv; mg[3] = p3 * inv;
#pragma unroll
                for (int p = 0; p < 4; ++p) { me[p] = bi[p]; mr[p] = __hip_atomic_fetch_add(cntl + bi[p], 1, __ATOMIC_RELAXED, __HIP_MEMORY_SCOPE_WORKGROUP); }
            }
        }
        __syncthreads();
        if (F.tid < 32) { const int c = cntl[F.tid]; int gb = 0; if (c > 0) gb = (int)__hip_atomic_fetch_add((unsigned*)(F.ctl + CW_CNT + 64 * F.tid), (unsigned)c, RLX_AGENT); baseg[F.tid] = gb; }
        __syncthreads();
        if (valid) {
            if (F.lane < 8) { const size_t t = (size_t)(t0 + F.lane);
#pragma unroll
                for (int p = 0; p < 4; ++p) { EIDX[t * 4 + p] = me[p]; RANK[t * 4 + p] = baseg[me[p]] + mr[p]; GATE[t * 4 + p] = mg[p]; } }
#pragma unroll
            for (int k = 0; k < 8; ++k) { const f32x4* xr = (const f32x4*)(H2 + (size_t)(t0 + k) * DM) + F.lane; const f32x4* wr = (const f32x4*)F.norm2_w + F.lane; int* o4 = (int*)((unsigned char*)XN2 + (size_t)(t0 + k) * DM) + F.lane;
#pragma unroll
                for (int j = 0; j < 8; ++j) { const f32x4 v = xr[64 * j], ww = wr[64 * j]; int o = __builtin_amdgcn_cvt_pk_fp8_f32(v.x * rstd[k] * ww.x, v.y * rstd[k] * ww.y, 0, false); o = __builtin_amdgcn_cvt_pk_fp8_f32(v.z * rstd[k] * ww.z, v.w * rstd[k] * ww.w, o, true); o4[64 * j] = o; } }
        }
        __syncthreads();
    }
}
__device__ __forceinline__ void phase5b(Frame& F) {
    const bf16* XN2 = (const bf16*)(F.ws + WS_XN2); bf16* XG = (bf16*)(F.ws + WS_XG);
    const int* EIDX = (const int*)(F.ws + WS_ROUTE); const int* RANK = EIDX + TT * 4; const float* GATE = (const float*)(RANK + TT * 4); int* SLOT = (int*)(GATE + TT * 4); float* SGATE = (float*)(SLOT + TT * 4);
    LAS int* sbase = (LAS int*)(F.lds); LAS int* spad = sbase + 32;
    if (F.tid < 32) { const int c = (int)__hip_atomic_load((unsigned*)(F.ctl + CW_CNT + 64 * F.tid), RLX_AGENT); spad[F.tid] = (c + 255) & ~255; }
    __syncthreads();
    if (F.tid == 0) { int a = 0; for (int e = 0; e < 32; ++e) { sbase[e] = a; a += spad[e]; } }
    __syncthreads();
    const int gw = F.bid * NWAVES + F.wave, NGW = F.G * NWAVES;
    for (int task = gw; task < TT / 8; task += NGW) {
#pragma unroll 2
        for (int k = 0; k < 8; ++k) { const size_t t = (size_t)task * 8 + k;
            int slot = 0;
            if (F.lane < 4) { const int e = EIDX[t * 4 + F.lane]; slot = sbase[e] + RANK[t * 4 + F.lane]; SLOT[t * 4 + F.lane] = slot; SGATE[slot] = GATE[t * 4 + F.lane]; }
            const int s0 = __shfl(slot, 0), s1 = __shfl(slot, 1), s2 = __shfl(slot, 2), s3 = __shfl(slot, 3);
            const v4u* src = (const v4u*)((const unsigned char*)XN2 + t * DM) + F.lane; v4u d[2];
#pragma unroll
            for (int j = 0; j < 2; ++j) d[j] = src[64 * j];
            v4u* d0 = (v4u*)((unsigned char*)XG + (size_t)s0 * DM) + F.lane; v4u* d1 = (v4u*)((unsigned char*)XG + (size_t)s1 * DM) + F.lane; v4u* d2 = (v4u*)((unsigned char*)XG + (size_t)s2 * DM) + F.lane; v4u* d3 = (v4u*)((unsigned char*)XG + (size_t)s3 * DM) + F.lane;
#pragma unroll
            for (int j = 0; j < 2; ++j) { d0[64 * j] = d[j]; d1[64 * j] = d[j]; d2[64 * j] = d[j]; d3[64 * j] = d[j]; }
        }
    }
}
__device__ __forceinline__ int build_moe_tab(Frame& F) {
    LAS unsigned char* tab = (LAS unsigned char*)(F.lds + TAB_OFF); LAS int* tinfo = (LAS int*)(F.lds + TAB_OFF + 320);
    if (F.tid < 32) { const int c = (int)__hip_atomic_load((unsigned*)(F.ctl + CW_CNT + 64 * F.tid), RLX_AGENT); tinfo[4 + F.tid] = (c + 255) >> 8; }
    __syncthreads();
    if (F.tid == 0) { int a = 0; for (int e = 0; e < 32; ++e) { const int n = tinfo[4 + e]; for (int j = 0; j < n; ++j) tab[a + j] = (unsigned char)e; a += n; } tinfo[0] = a; }
    __syncthreads();
    return tinfo[0];
}
__device__ __forceinline__ void phase8(Frame& F) {
    const float* H2 = (const float*)(F.ws + WS_H2); const bf16* YR = (const bf16*)(F.ws + WS_YR);
    const int* SLOT = (const int*)(F.ws + WS_ROUTE) + TT * 12;
    const int gw = F.bid * NWAVES + F.wave, NGW = F.G * NWAVES;
    for (int t = gw; t < TT; t += NGW) {
        int slot = 0; if (F.lane < 4) slot = SLOT[(size_t)t * 4 + F.lane];
        int sl[4]; sl[0] = __shfl(slot, 0); sl[1] = __shfl(slot, 1); sl[2] = __shfl(slot, 2); sl[3] = __shfl(slot, 3);
        float v[4][8]; float ss = 0.f;
#pragma unroll
        for (int j = 0; j < 4; ++j) { const int pz = F.lane + 64 * j; const f32x4 a = *(const f32x4*)(H2 + (size_t)t * DM + 8 * pz), b = *(const f32x4*)(H2 + (size_t)t * DM + 8 * pz + 4);
            v[j][0] = a.x; v[j][1] = a.y; v[j][2] = a.z; v[j][3] = a.w; v[j][4] = b.x; v[j][5] = b.y; v[j][6] = b.z; v[j][7] = b.w; }
#pragma unroll
        for (int k = 0; k < 4; ++k)
#pragma unroll
            for (int j = 0; j < 4; ++j) { float f[8]; unpack8(*((const v4u*)(YR + (size_t)sl[k] * DM) + F.lane + 64 * j), f);
#pragma unroll
                for (int i = 0; i < 8; ++i) v[j][i] += f[i]; }
#pragma unroll
        for (int j = 0; j < 4; ++j)
#pragma unroll
            for (int i = 0; i < 8; ++i) ss += v[j][i] * v[j][i];
        const float rstd = 1.0f / sqrtf(wave_sum(ss) * (1.0f / 2048.0f) + EPSF);
#pragma unroll
        for (int j = 0; j < 4; ++j) { const int pz = F.lane + 64 * j; const f32x4 w0 = *(const f32x4*)(F.final_norm_w + 8 * pz), w1 = *(const f32x4*)(F.final_norm_w + 8 * pz + 4);
            *(f32x4*)(F.out + (size_t)t * DM + 8 * pz) = (f32x4){v[j][0] * rstd * w0.x, v[j][1] * rstd * w0.y, v[j][2] * rstd * w0.z, v[j][3] * rstd * w0.w};
            *(f32x4*)(F.out + (size_t)t * DM + 8 * pz + 4) = (f32x4){v[j][4] * rstd * w1.x, v[j][5] * rstd * w1.y, v[j][6] * rstd * w1.z, v[j][7] * rstd * w1.w}; }
    }
}

struct Args { const float* in[21]; float* out; unsigned char* ws; int ph_lo, ph_hi, li, pad; };
__global__ void __launch_bounds__(NWAVES * 64, 2) hymba_fwd(Args args) {
    extern __shared__ __attribute__((aligned(16))) unsigned char lds[];
    Frame F;
    F.lds = (LAS unsigned char*)lds; F.MISC = (volatile LAS unsigned*)(F.lds + MISC_OFF);
    F.tid = threadIdx.x; F.lane = F.tid & 63; F.wave = __builtin_amdgcn_readfirstlane(F.tid >> 6); F.G = gridDim.x; F.bid = blockIdx.x;
    F.ws = args.ws; F.ctl = (gu32*)(args.ws + WS_CTL); F.out = args.out;
    F.x = args.in[0]; F.norm1_w = args.in[1]; F.w_in = args.in[2]; F.conv_w = args.in[3]; F.conv_b = args.in[4]; F.dt_bias = args.in[5]; F.a_log = args.in[6]; F.d_skip = args.in[7]; F.ssd_norm_w = args.in[8];
    F.i_bias = args.in[9]; F.f_bias = args.in[10]; F.ml_norm_w = args.in[11]; F.w_out = args.in[12]; F.norm2_w = args.in[13]; F.router_w = args.in[14]; F.router_b = args.in[15];
    F.w_gate_up = args.in[16]; F.b_gate_up = args.in[17]; F.w_down = args.in[18]; F.b_down = args.in[19]; F.final_norm_w = args.in[20];
    for (int u = F.tid; u < (LDS_BYTES - LDSCTL_OFF) / 4; u += NWAVES * 64) ((LAS unsigned*)(F.lds + LDSCTL_OFF))[u] = 0u;
    __syncthreads();
    XcdBarrier bar; bar.bar = (unsigned*)(F.ctl + CW_BAR) + args.li * XCD_BAR_WORDS; bar.x = 0; bar.st = nullptr;
    const bool use_bar = (args.ph_hi - args.ph_lo) > 1;
    if (use_bar) bar = xcd_barrier_post((unsigned*)(F.ctl + CW_BAR) + args.li * XCD_BAR_WORDS, F.MISC + 8);
    const int lo = args.ph_lo, hi = args.ph_hi;
#ifndef PHASE_MASK
#define PHASE_MASK 0x7ff
#endif
#define IN(k) (((PHASE_MASK >> (k)) & 1) && lo <= (k) && (k) < hi)
#define SEAM(k) do { if (IN(k) && IN((k) + 1)) xcd_barrier(bar); } while (0)
    if (IN(0)) { phase0(F); } SEAM(0);
    if (IN(1)) {
        pg8::Gemm g{(const pg8::bf16_t*)(F.ws + WS_XN1), (const pg8::bf16_t*)(F.ws + WS_WIN), TT, NPROJ, DM}; pg8::StaticOrder S; S.init(TT, NPROJ, F.G, F.bid);
        pg8::EpiBf16 E{(pg8::bf16_t*)(F.ws + WS_PROJ), NPROJ};
        pg8::gemm_phase<pg8::EpiBf16, pg8::StaticOrder, true, true>(F.lds, g, S, E);
        p1_small(F);
    } SEAM(1);
    if (IN(2)) { phase_conv(F); } SEAM(2);
    if (IN(3)) { phase_mixer(F); } SEAM(3);
    if (IN(4)) { phase3(F); } SEAM(4);
    if (IN(5)) {
        pg8::Gemm g{(const pg8::bf16_t*)(F.ws + WS_YMIX), (const pg8::bf16_t*)(F.ws + WS_WOUT), TT, DM, 4096}; pg8::StaticOrder S; S.init(TT, DM, F.G, F.bid);
        pg8::EpiResF32 E{(float*)(F.ws + WS_H2), F.x, DM};
        pg8::gemm_phase<pg8::EpiResF32, pg8::StaticOrder, true, true>(F.lds, g, S, E);
    } SEAM(5);
    if (IN(6)) { phase5(F); } SEAM(6);
    if (IN(7)) { phase5b(F); } SEAM(7);
    if (IN(8)) {
        const int nM = build_moe_tab(F);
        pg8::Gemm g{(const pg8::bf16_t*)(F.ws + WS_XG), (const pg8::bf16_t*)(F.ws + WS_WGU), nM * 256, 4096, DM};
        pg8::MoeOrder S{nM, 16, 4, nM * 16, F.G, F.bid, (const PG8_LAS unsigned char*)(F.lds + TAB_OFF)};
        pg8::EpiSwiglu E{(unsigned char*)(F.ws + WS_ACT), F.b_gate_up};
        pg8::gemm_phase<pg8::EpiSwiglu, pg8::MoeOrder, true, true, true>(F.lds, g, S, E);
    } SEAM(8);
    if (IN(9)) {
        const int nM = build_moe_tab(F);
        pg8::Gemm g{(const pg8::bf16_t*)(F.ws + WS_ACT), (const pg8::bf16_t*)(F.ws + WS_WD), nM * 256, 2048, DM};
        pg8::MoeOrder S{nM, 8, 3, nM * 8, F.G, F.bid, (const PG8_LAS unsigned char*)(F.lds + TAB_OFF)};
        pg8::EpiDown E{(pg8::bf16_t*)(F.ws + WS_YR), F.b_down, (const float*)((const int*)(F.ws + WS_ROUTE) + TT * 16)};
        pg8::gemm_phase<pg8::EpiDown, pg8::MoeOrder, true, true, true>(F.lds, g, S, E);
    } SEAM(9);
    if (IN(10)) { phase8(F); }
#undef IN
#undef SEAM
}

extern "C" void kernel_launch(void* const* d_in, const int* in_sizes, int n_in, void* d_out, int out_size, void* d_ws, size_t ws_size, hipStream_t stream) {
    static int grid = 0;
    if (grid == 0) {
        if (n_in != 21 || out_size != TT * DM || ws_size < WS_END) { fprintf(stderr, "kernel_launch: unexpected problem (n_in %d, out %d, ws %zu); nothing launched\n", n_in, out_size, ws_size); grid = -1; return; }
        int dev = 0, cus = 0, per_cu = 0;
        if (hipGetDevice(&dev) != hipSuccess || hipDeviceGetAttribute(&cus, hipDeviceAttributeMultiprocessorCount, dev) != hipSuccess) { grid = -1; return; }
        if (hipFuncSetAttribute((const void*)hymba_fwd, hipFuncAttributeMaxDynamicSharedMemorySize, LDS_BYTES) != hipSuccess) { fprintf(stderr, "kernel_launch: hipFuncSetAttribute failed\n"); grid = -1; return; }
        if (hipOccupancyMaxActiveBlocksPerMultiprocessor(&per_cu, (const void*)hymba_fwd, NWAVES * 64, LDS_BYTES) != hipSuccess || per_cu < 1) { fprintf(stderr, "kernel_launch: occupancy query says %d blocks per CU\n", per_cu); }
        (void)hipGetLastError();
        grid = cus;
    }
    if (grid < 0) return;
    (void)hipMemsetAsync((char*)d_ws + WS_CTL, 0, CTL_ZERO_BYTES, stream);
    Args a{};
    for (int i = 0; i < 21; ++i) a.in[i] = (const float*)d_in[i];
    a.out = (float*)d_out; a.ws = (unsigned char*)d_ws; a.pad = 0;
#if MK_PER_PHASE
    for (int li = 0; li < N_PHASES; ++li) { a.ph_lo = li; a.ph_hi = li + 1; a.li = li; hipLaunchKernelGGL(hymba_fwd, dim3(grid), dim3(NWAVES * 64), LDS_BYTES, stream, a); }
#else
    a.ph_lo = 0; a.ph_hi = N_PHASES; a.li = 0;
    hipLaunchKernelGGL(hymba_fwd, dim3(grid), dim3(NWAVES * 64), LDS_BYTES, stream, a);
#endif
}
```

```cpp
#include <hip/hip_runtime.h>
#include <cstdio>
#include <cstdint>
namespace pg8 {
#define PG8_LAS __attribute__((address_space(3)))
typedef unsigned short bf16_t;
typedef short bf16x8 __attribute__((ext_vector_type(8)));
typedef float f32x4 __attribute__((ext_vector_type(4)));
typedef unsigned u32x4 __attribute__((ext_vector_type(4)));
constexpr int BM = 256, BK = 64, HALF = 128, HTB = HALF * BK * 2  , STAGE_BYTES = 8 * HTB, NXCD = 8, WGM = 8;

__host__ __device__ __forceinline__ int lds_byte(int r, int c) { const int st = (r >> 4) * 2 + (c >> 5), rr = r & 15, cc = c & 31, ob = rr * 64 + cc * 2; return st * 1024 + (ob ^ (((ob >> 9) & 1) << 5)); }
__host__ __device__ __forceinline__ void stage_rc(int b, int& R, int& C) { const int st = b / 1024, sb = b % 1024, swz = sb ^ (((sb >> 9) & 1) << 5); R = (st >> 1) * 16 + swz / 64; C = (st & 1) * 32 + (swz % 64) / 2; }
__host__ __device__ __forceinline__ int perm32(int rho) { const int n = rho >> 4, i = rho & 15; return 8 * (i >> 2) + 4 * n + (i & 3); }

struct Unit { int pm, pn; };
struct Gemm { const bf16_t* A; const bf16_t* Bt; int M, N, K; };

struct StaticOrder {
    int nM, nN, nwg, G, c;
    __host__ __device__ void init(int M, int N, int G_, int c_) { nM = M / BM; nN = N / BM; nwg = nM * nN; G = G_; c = c_; }
    __host__ __device__ bool next(int i, Unit& u) const {
        const long L = (long)i * G + c; if (L >= nwg) return false;
        int wgid = (int)L; { const int q = nwg / NXCD, r = nwg % NXCD, xcd = wgid % NXCD, off = wgid / NXCD; wgid = (xcd < r ? xcd * (q + 1) : r * (q + 1) + (xcd - r) * q) + off; }
        const int nig = WGM * nN, gid = wgid / nig, fm = gid * WGM, gsz = (nM - fm) < WGM ? (nM - fm) : WGM;
        u.pm = fm + ((wgid % nig) % gsz); u.pn = (wgid % nig) / gsz; return true;
    }
    __device__ __forceinline__ const PG8_LAS unsigned short* rowp(int) const { return nullptr; }
    __device__ __forceinline__ void a_ready(const Unit&) const {}
    __device__ __forceinline__ void done(const Unit&) const {}
};


__device__ __forceinline__ unsigned cvt_pk_bf16(float lo, float hi) { unsigned r; asm volatile("v_cvt_pk_bf16_f32 %0, %1, %2" : "=v"(r) : "v"(lo), "v"(hi)); return r; }
typedef unsigned u32x2 __attribute__((ext_vector_type(2)));

struct EpiBf16 {
    static constexpr bool PERM = true, AFTER_DRAIN = false;
    bf16_t* O; int ldc;
    __device__ __forceinline__ void operator()(const f32x4 (&acc)[2][2][4][2], const Unit& u, int wr, int wc, int fr, int fq) const {
        const int row0 = u.pm * BM + wr * 64 + fr; const int col0 = u.pn * BM + wc * 32 + 8 * fq;
#pragma unroll
        for (int ai = 0; ai < 2; ++ai)
#pragma unroll
            for (int m = 0; m < 4; ++m) { bf16_t* rowp = O + (size_t)(row0 + ai * HALF + m * 16) * ldc + col0;
#pragma unroll
                for (int bj = 0; bj < 2; ++bj) { const f32x4 v0 = acc[ai][bj][m][0], v1 = acc[ai][bj][m][1];
                    u32x4 w; w.x = cvt_pk_bf16(v0[0], v0[1]); w.y = cvt_pk_bf16(v0[2], v0[3]); w.z = cvt_pk_bf16(v1[0], v1[1]); w.w = cvt_pk_bf16(v1[2], v1[3]);
                    *(u32x4*)(rowp + bj * HALF) = w; } }
    }
};
struct EpiResF32 {
    static constexpr bool PERM = false, AFTER_DRAIN = false;
    float* C; const float* base; int ldc;
    __device__ __forceinline__ void operator()(const f32x4 (&acc)[2][2][4][2], const Unit& u, int wr, int wc, int fr, int fq) const {
        const int row0 = u.pm * BM + wr * 64 + fr, col0 = u.pn * BM + wc * 32 + 4 * fq;
#pragma unroll
        for (int ai = 0; ai < 2; ++ai)
#pragma unroll
            for (int m = 0; m < 4; ++m) { const size_t off = (size_t)(row0 + ai * HALF + m * 16) * ldc + col0;
#pragma unroll
                for (int bj = 0; bj < 2; ++bj)
#pragma unroll
                    for (int n = 0; n < 2; ++n) *(f32x4*)(C + off + bj * HALF + n * 16) = acc[ai][bj][m][n] + *(const f32x4*)(base + off + bj * HALF + n * 16); }
    }
};
__device__ __forceinline__ float swiglu1(float a, float b) {
    const float glu = fminf(a, 7.0f), lin = fminf(fmaxf(b, -7.0f), 7.0f);
    return glu * __builtin_amdgcn_rcpf(1.0f + __expf(-1.702f * glu)) * (lin + 1.0f);
}
struct EpiSwiglu {
    static constexpr bool PERM = true, AFTER_DRAIN = false;
    unsigned char* O; const float* bias;
    __device__ __forceinline__ void operator()(const f32x4 (&acc)[2][2][4][2], const Unit& u, int wr, int wc, int fr, int fq) const {
        const int e = u.pn >> 4, pnl = u.pn & 15;
        const int row0 = u.pm * BM + wr * 64 + fr; const int hcol0 = pnl * BM + wc * 32 + 8 * fq;
        const float* bp = bias + (size_t)e * 4096 + hcol0;
        f32x4 bv[2][2];
#pragma unroll
        for (int bj = 0; bj < 2; ++bj)
#pragma unroll
            for (int n = 0; n < 2; ++n) bv[bj][n] = *(const f32x4*)(bp + bj * HALF + 4 * n);
#pragma unroll
        for (int ai = 0; ai < 2; ++ai)
#pragma unroll
            for (int m = 0; m < 4; ++m) { unsigned char* rowp = O + (size_t)(row0 + ai * HALF + m * 16) * 2048 + (hcol0 >> 1);
#pragma unroll
                for (int bj = 0; bj < 2; ++bj) { const f32x4 v0 = acc[ai][bj][m][0] + bv[bj][0], v1 = acc[ai][bj][m][1] + bv[bj][1];
                    int w = __builtin_amdgcn_cvt_pk_fp8_f32(swiglu1(v0[0], v0[1]), swiglu1(v0[2], v0[3]), 0, false);
                    w = __builtin_amdgcn_cvt_pk_fp8_f32(swiglu1(v1[0], v1[1]), swiglu1(v1[2], v1[3]), w, true);
                    *(int*)(rowp + bj * 64) = w; } }
    }
};
struct EpiDown {
    static constexpr bool PERM = true, AFTER_DRAIN = false;
    bf16_t* O; const float* bias; const float* gatel; const PG8_LAS int* tinfo;
    __device__ __forceinline__ void operator()(const f32x4 (&acc)[2][2][4][2], const Unit& u, int wr, int wc, int fr, int fq) const {
        const int e = u.pn >> 3, pnl = u.pn & 7;
        const int row0 = u.pm * BM + wr * 64 + fr; const int col0 = pnl * BM + wc * 32 + 8 * fq;
        const float* bp = bias + (size_t)e * 2048 + col0; const float* gp = gatel + (size_t)e * 16384 - 256 * tinfo[40 + e];
        f32x4 bv[2][2];
#pragma unroll
        for (int bj = 0; bj < 2; ++bj)
#pragma unroll
            for (int n = 0; n < 2; ++n) bv[bj][n] = *(const f32x4*)(bp + bj * HALF + 4 * n);
#pragma unroll
        for (int ai = 0; ai < 2; ++ai)
#pragma unroll
            for (int m = 0; m < 4; ++m) { const int row = row0 + ai * HALF + m * 16; const float gt = gp[row]; bf16_t* rowp = O + (size_t)row * 2048 + col0;
#pragma unroll
                for (int bj = 0; bj < 2; ++bj) { const f32x4 v0 = (acc[ai][bj][m][0] + bv[bj][0]) * gt, v1 = (acc[ai][bj][m][1] + bv[bj][1]) * gt;
                    u32x4 w; w.x = cvt_pk_bf16(v0[0], v0[1]); w.y = cvt_pk_bf16(v0[2], v0[3]); w.z = cvt_pk_bf16(v1[0], v1[1]); w.w = cvt_pk_bf16(v1[2], v1[3]);
                    *(u32x4*)(rowp + bj * HALF) = w; } }
    }
};
struct MoeOrder {
    int nM, nN, nsh, nwg, G, c; const PG8_LAS unsigned char* tab; const PG8_LAS unsigned short* rt;
    __device__ __forceinline__ const PG8_LAS unsigned short* rowp(int ui) const { return rt + ui * 256; }
    __device__ __forceinline__ bool next(int i, Unit& u) const {
        const long L = (long)i * G + c; if (L >= nwg) return false;
        int wgid = (int)L; { const int q = nwg / NXCD, r = nwg % NXCD, xcd = wgid % NXCD, off = wgid / NXCD; wgid = (xcd < r ? xcd * (q + 1) : r * (q + 1) + (xcd - r) * q) + off; }
        const int nig = WGM * nN, gid = wgid / nig, fm = gid * WGM, gsz = (nM - fm) < WGM ? (nM - fm) : WGM;
        const int pm = fm + ((wgid % nig) % gsz), pnl = (wgid % nig) / gsz;
        u.pm = pm; u.pn = ((int)tab[pm] << nsh) + pnl; return true;
    }
    __device__ __forceinline__ void a_ready(const Unit&) const {}
    __device__ __forceinline__ void done(const Unit&) const {}
};
typedef int v8i32 __attribute__((ext_vector_type(8)));
__device__ __forceinline__ v8i32 pg8_cat(const bf16x8 lo, const bf16x8 hi) { typedef int v4i32 __attribute__((ext_vector_type(4))); const v4i32 a = __builtin_bit_cast(v4i32, lo), b = __builtin_bit_cast(v4i32, hi); return __builtin_shufflevector(a, b, 0, 1, 2, 3, 4, 5, 6, 7); }
template <class Epi, class Sched, bool ALIGN_EPI = false, bool SP2 = false, bool F8 = false, bool GA = false>
__device__ __forceinline__ void gemm_phase(PG8_LAS unsigned char* lds, const Gemm g, const Sched& S, const Epi& E) {
    const int tid = threadIdx.x, wid = __builtin_amdgcn_readfirstlane(tid >> 6), lane = tid & 63, wr = wid >> 2, wc = wid & 3, fr = lane & 15, fq = lane >> 4;
    const int K = g.K, KB = F8 ? K : 2 * K, nt = KB / 128;
    unsigned voffA[2], voffB[2]; int gaR[2]; unsigned gaC[2]; static_assert(!GA || SP2, "gathered A needs the SP2 loop");
#pragma unroll
    for (int i = 0; i < 2; ++i) { int R, C; stage_rc(tid * 16 + i * 8192, R, C); const int Rb = Epi::PERM ? ((R & ~31) + perm32(R & 31)) : R;
        voffA[i] = (unsigned)(R * KB + C * 2); voffB[i] = (unsigned)(Rb * KB + C * 2); gaR[i] = R; gaC[i] = (unsigned)(C * 2); }
    const size_t kstep = (size_t)(BK * 2);
    const size_t hstep = (size_t)HALF * KB;
    const size_t tstep = 2 * hstep;
    const unsigned ldsw = (unsigned)wid * 1024u;
    int aoffk[2], boffk[2];
#pragma unroll
    for (int h = 0; h < 2; ++h) { aoffk[h] = lds_byte(wr * 64 + fr, fq * 8) + h * 1024; boffk[h] = lds_byte(wc * 32 + fr, fq * 8) + h * 1024; }
#define PG8_SA(b, h) (((b) * 2 + (h)) * HTB)
#define PG8_SB(b, h) ((4 + (b) * 2 + (h)) * HTB)
#define PG8_STAGE(bufoff, gbase, voff) do { _Pragma("unroll") for (int _i = 0; _i < 2; ++_i) \
        __builtin_amdgcn_global_load_lds((const unsigned*)((const char*)(gbase) + (voff)[_i]), (PG8_LAS unsigned*)(lds + (bufoff) + ldsw + _i * 8192), 16, 0, 0); } while (0)
#define PG8_STAGE_A(bufoff, kptr, h, usenext) do { if constexpr (GA) { _Pragma("unroll") for (int _i = 0; _i < 2; ++_i) { const unsigned _o = (usenext) ? gn[h][_i] : gc[h][_i]; \
            __builtin_amdgcn_global_load_lds((const unsigned*)((const char*)(kptr) + _o), (PG8_LAS unsigned*)(lds + (bufoff) + ldsw + _i * 8192), 16, 0, 0); } } \
        else { PG8_STAGE(bufoff, (kptr) + (h) * hstep, voffA); } } while (0)
#define PG8_GROWS(dst, ui_) do { const PG8_LAS unsigned short* _rt = S.rowp(ui_); _Pragma("unroll") for (int _h = 0; _h < 2; ++_h) _Pragma("unroll") for (int _i = 0; _i < 2; ++_i) dst[_h][_i] = (unsigned)_rt[gaR[_i] + 128 * _h] * (unsigned)KB + gaC[_i]; } while (0)
#define PG8_LDA(dst, b, h) do { if constexpr (F8) { _Pragma("unroll") for (int m = 0; m < 4; ++m) dst##8[m] = pg8_cat(*(const PG8_LAS bf16x8*)(lds + PG8_SA(b, h) + aoffk[0] + m * 2048), *(const PG8_LAS bf16x8*)(lds + PG8_SA(b, h) + aoffk[1] + m * 2048)); } \
        else { _Pragma("unroll") for (int m = 0; m < 4; ++m) _Pragma("unroll") for (int k = 0; k < 2; ++k) dst[m][k] = *(const PG8_LAS bf16x8*)(lds + PG8_SA(b, h) + aoffk[k] + m * 2048); } } while (0)
#define PG8_LDB(dst, b, h) do { if constexpr (F8) { _Pragma("unroll") for (int n = 0; n < 2; ++n) dst##8[n] = pg8_cat(*(const PG8_LAS bf16x8*)(lds + PG8_SB(b, h) + boffk[0] + n * 2048), *(const PG8_LAS bf16x8*)(lds + PG8_SB(b, h) + boffk[1] + n * 2048)); } \
        else { _Pragma("unroll") for (int n = 0; n < 2; ++n) _Pragma("unroll") for (int k = 0; k < 2; ++k) dst[n][k] = *(const PG8_LAS bf16x8*)(lds + PG8_SB(b, h) + boffk[k] + n * 2048); } } while (0)
#define PG8_MMA(ai, bj, At, Bt) do { __builtin_amdgcn_s_setprio(1); \
        if constexpr (F8) { _Pragma("unroll") for (int m = 0; m < 4; ++m) _Pragma("unroll") for (int n = 0; n < 2; ++n) \
            asm volatile("v_mfma_scale_f32_16x16x128_f8f6f4 %0, %1, %2, %0, %3, %4 op_sel_hi:[0,0,0]" : "+v"(acc[ai][bj][m][n]) : "v"(Bt##8[n]), "v"(At##8[m]), "v"(sc_w), "v"(sc_a)); } \
        else { _Pragma("unroll") for (int m = 0; m < 4; ++m) _Pragma("unroll") for (int n = 0; n < 2; ++n) _Pragma("unroll") for (int k = 0; k < 2; ++k) \
            acc[ai][bj][m][n] = __builtin_amdgcn_mfma_f32_16x16x32_bf16(Bt[n][k], At[m][k], acc[ai][bj][m][n], 0, 0, 0); } \
        __builtin_amdgcn_s_setprio(0); } while (0)
#define PG8_WAIT_V(n) asm volatile("s_waitcnt vmcnt(" #n ")" ::: "memory")
#define PG8_WAIT_L(n) asm volatile("s_waitcnt lgkmcnt(" #n ")" ::: "memory")
#define PG8_BAR __builtin_amdgcn_s_barrier()
#define PG8_SCHED __builtin_amdgcn_sched_barrier(0)
    Unit cur, nxt; int ui = 0;
    if (!S.next(0, cur)) return;
    f32x4 acc[2][2][4][2];
#pragma unroll
    for (int a = 0; a < 2; ++a)
#pragma unroll
        for (int b = 0; b < 2; ++b)
#pragma unroll
            for (int m = 0; m < 4; ++m)
#pragma unroll
                for (int n = 0; n < 2; ++n) acc[a][b][m][n] = (f32x4){0.f, 0.f, 0.f, 0.f};
    const int sc_w = 0x79797979, sc_a = 0x7f7f7f7f;
    bf16x8 At[4][2], B0[2][2], B1[2][2]; v8i32 At8[4], B08[2], B18[2];
    const char* cA = (const char*)g.A + (GA ? (size_t)0 : (size_t)cur.pm * tstep); const char* cB = (const char*)g.Bt + (size_t)cur.pn * tstep;
    unsigned gc[2][2] = {{0u, 0u}, {0u, 0u}}, gn[2][2] = {{0u, 0u}, {0u, 0u}};
    if constexpr (GA) { PG8_GROWS(gc, 0); }
    S.a_ready(cur);
    if constexpr (SP2) {
        PG8_STAGE(PG8_SB(0, 0), cB, voffB); PG8_STAGE(PG8_SB(0, 1), cB + hstep, voffB); PG8_STAGE_A(PG8_SA(0, 0), cA, 0, false); PG8_STAGE_A(PG8_SA(0, 1), cA, 1, false);
        if (wr == 1) PG8_BAR;
        PG8_WAIT_V(2); PG8_BAR;
        PG8_STAGE(PG8_SB(1, 0), cB + kstep, voffB); PG8_STAGE_A(PG8_SA(1, 0), cA + kstep, 0, false); PG8_STAGE(PG8_SB(1, 1), cB + hstep + kstep, voffB);
        PG8_WAIT_V(6); PG8_BAR;
    } else {
        PG8_STAGE(PG8_SB(0, 0), cB, voffB); PG8_STAGE(PG8_SA(0, 0), cA, voffA); PG8_STAGE(PG8_SB(0, 1), cB + hstep, voffB); PG8_STAGE(PG8_SA(0, 1), cA + hstep, voffA);
        if (wr == 1) PG8_BAR;
        PG8_WAIT_V(4); PG8_BAR;
        PG8_STAGE(PG8_SB(1, 0), cB + kstep, voffB); PG8_STAGE(PG8_SA(1, 0), cA + kstep, voffA); PG8_STAGE(PG8_SB(1, 1), cB + hstep + kstep, voffB);
        PG8_WAIT_V(6); PG8_BAR;
    }
    for (;;) {
        const bool has_next = S.next(ui + 1, nxt);
        const char* nA = (has_next && !GA) ? (const char*)g.A + (size_t)nxt.pm * tstep : cA; const char* nB = has_next ? (const char*)g.Bt + (size_t)nxt.pn * tstep : cB;
        if constexpr (GA) { if (has_next) { PG8_GROWS(gn, ui + 1); } else {
#pragma unroll
            for (int _h = 0; _h < 2; ++_h) { gn[_h][0] = gc[_h][0]; gn[_h][1] = gc[_h][1]; } } }
        for (int t = 0; t < nt; t += 2) {
            const bool last = (t == nt - 2);
            const char* a1 = cA + (size_t)(t + 1) * kstep;
            const char* a2 = last ? nA : cA + (size_t)(t + 2) * kstep; const char* b2 = last ? nB : cB + (size_t)(t + 2) * kstep;
            const char* a3 = a2 + kstep; const char* b3 = b2 + kstep;
            if (last && has_next) S.a_ready(nxt);
            if constexpr (SP2) {
            PG8_LDB(B0, 0, 0); PG8_LDB(B1, 0, 1); PG8_SCHED; PG8_LDA(At, 0, 0); PG8_STAGE_A(PG8_SA(1, 1), a1, 1, false);
            PG8_WAIT_V(8); PG8_WAIT_L(0); PG8_BAR; PG8_MMA(0, 0, At, B0); PG8_MMA(0, 1, At, B1); PG8_BAR; PG8_SCHED;
            PG8_LDA(At, 0, 1); PG8_STAGE(PG8_SB(0, 0), b2, voffB); PG8_STAGE(PG8_SB(0, 1), b2 + hstep, voffB); PG8_STAGE_A(PG8_SA(0, 0), a2, 0, last);
            PG8_WAIT_V(8); PG8_WAIT_L(0); PG8_BAR; PG8_MMA(1, 0, At, B0); PG8_MMA(1, 1, At, B1); PG8_BAR; PG8_SCHED;
            PG8_LDB(B0, 1, 0); PG8_LDB(B1, 1, 1); PG8_SCHED; PG8_LDA(At, 1, 0); PG8_STAGE_A(PG8_SA(0, 1), a2, 1, last);
            PG8_WAIT_V(8); PG8_WAIT_L(0); PG8_BAR; PG8_MMA(0, 0, At, B0); PG8_MMA(0, 1, At, B1); PG8_BAR; PG8_SCHED;
            PG8_LDA(At, 1, 1); PG8_STAGE(PG8_SB(1, 0), b3, voffB); PG8_STAGE(PG8_SB(1, 1), b3 + hstep, voffB); PG8_STAGE_A(PG8_SA(1, 0), a3, 0, last);
            PG8_WAIT_V(8); PG8_WAIT_L(0); PG8_BAR; PG8_MMA(1, 0, At, B0); PG8_MMA(1, 1, At, B1); PG8_BAR; PG8_SCHED;
            } else {
            PG8_LDB(B0, 0, 0); PG8_SCHED; PG8_LDA(At, 0, 0); PG8_STAGE(PG8_SA(1, 1), a1 + hstep, voffA);
            PG8_WAIT_L(8); PG8_BAR; PG8_WAIT_L(0); PG8_MMA(0, 0, At, B0); PG8_BAR; PG8_SCHED;
            PG8_LDB(B1, 0, 1); PG8_STAGE(PG8_SB(0, 0), b2, voffB);
            PG8_BAR; PG8_WAIT_L(0); PG8_MMA(0, 1, At, B1); PG8_BAR;
            PG8_LDA(At, 0, 1); PG8_STAGE(PG8_SA(0, 0), a2, voffA);
            PG8_BAR; PG8_WAIT_L(0); PG8_MMA(1, 0, At, B0); PG8_BAR; PG8_SCHED;
            PG8_STAGE(PG8_SB(0, 1), b2 + hstep, voffB);
            PG8_WAIT_V(6); PG8_BAR; PG8_MMA(1, 1, At, B1); PG8_BAR;
            PG8_LDB(B0, 1, 0); PG8_SCHED; PG8_LDA(At, 1, 0); PG8_STAGE(PG8_SA(0, 1), a2 + hstep, voffA);
            PG8_WAIT_L(8); PG8_BAR; PG8_WAIT_L(0); PG8_MMA(0, 0, At, B0); PG8_BAR; PG8_SCHED;
            PG8_LDB(B1, 1, 1); PG8_STAGE(PG8_SB(1, 0), b3, voffB);
            PG8_BAR; PG8_WAIT_L(0); PG8_MMA(0, 1, At, B1); PG8_BAR;
            PG8_LDA(At, 1, 1); PG8_STAGE(PG8_SA(1, 0), a3, voffA);
            PG8_BAR; PG8_WAIT_L(0); PG8_MMA(1, 0, At, B0); PG8_BAR; PG8_SCHED;
            PG8_STAGE(PG8_SB(1, 1), b3 + hstep, voffB);
            PG8_WAIT_V(6); PG8_BAR; PG8_MMA(1, 1, At, B1); PG8_BAR;
            }
        }
        if constexpr (ALIGN_EPI) { if (wr == 0) PG8_BAR; }
        if constexpr (F8) asm volatile("s_nop 15\n\ts_nop 15" ::: "memory");
        if constexpr (!Epi::AFTER_DRAIN) { E(acc, cur, wr, wc, fr, fq); S.done(cur); }
        if (!has_next) break;
#pragma unroll
        for (int a = 0; a < 2; ++a)
#pragma unroll
            for (int b = 0; b < 2; ++b)
#pragma unroll
                for (int m = 0; m < 4; ++m)
#pragma unroll
                    for (int n = 0; n < 2; ++n) acc[a][b][m][n] = (f32x4){0.f, 0.f, 0.f, 0.f};
        cur = nxt; cA = nA; cB = nB; ++ui;
        if constexpr (GA) {
#pragma unroll
            for (int _h = 0; _h < 2; ++_h) { gc[_h][0] = gn[_h][0]; gc[_h][1] = gn[_h][1]; } }
        if constexpr (ALIGN_EPI) { if (wr == 1) PG8_BAR; }
    }
    PG8_WAIT_V(0);
    if constexpr (!ALIGN_EPI) { if (wr == 0) PG8_BAR; }
    PG8_BAR;
    if constexpr (Epi::AFTER_DRAIN) { E.fused(acc, cur, wr, wc, fr, fq, lds, wid, lane); S.done(cur); }
#undef PG8_SA
#undef PG8_SB
#undef PG8_STAGE
#undef PG8_STAGE_A
#undef PG8_GROWS
#undef PG8_LDA
#undef PG8_LDB
#undef PG8_MMA
#undef PG8_WAIT_V
#undef PG8_WAIT_L
#undef PG8_BAR
#undef PG8_SCHED
}
}

constexpr int NWAVES = 8;
constexpr int TT = 16384, DM = 2048, SEQ = 2048;
constexpr int NPROJ = 11264;
constexpr int PC_Z = 0, PC_XBC = 2048, PC_Q = 5120, PC_K = 6144, PC_V = 7168, PC_O = 9216;
constexpr int WIN_LD = 11312;
constexpr int NSLOT = 65536 + 32 * 256;
constexpr float EPSF = 1e-5f;
#ifndef HSYNC_ON
#define HSYNC_ON 0
#endif
#define HWAIT() do { if (HSYNC_ON) asm volatile("s_waitcnt vmcnt(0) lgkmcnt(0)\n\ts_nop 15\n\ts_nop 15" ::: "memory"); } while (0)
#define HSYNC() do { if (HSYNC_ON) { HWAIT(); __syncthreads(); } } while (0)
#ifndef MK_PER_PHASE
#define MK_PER_PHASE 0
#endif
constexpr int N_PHASES = 10;

constexpr size_t MiB = 1u << 20;
constexpr size_t WS_CTL = 0, CTL_ZERO_BYTES = 1 * MiB;
constexpr size_t WS_WIN = 2 * MiB, WS_WSM = 46 * MiB, WS_WRT = 47 * MiB, WS_WOUT = 48 * MiB, WS_WGU = 64 * MiB, WS_WD = 576 * MiB;
constexpr size_t WS_XN1 = 832 * MiB, WS_PROJ = 896 * MiB, WS_SMALL = 1248 * MiB, WS_SSQ = 1252 * MiB, WS_YMIX = 1256 * MiB, WS_H2 = 1384 * MiB, WS_XN2 = 1512 * MiB;
constexpr size_t WS_ROUTE = 1576 * MiB, WS_XG = 1578 * MiB, WS_ACT = 1866 * MiB, WS_YR = 2154 * MiB, WS_XC = 2442 * MiB, WS_END = 2538 * MiB;
constexpr int CW_BAR = 4096;
constexpr int CW_CNT = 65536;

constexpr int RING_BYTES = 131072;
constexpr int LDS_BYTES = 147456;
constexpr int LDSCTL_OFF = LDS_BYTES - 1024, MISC_OFF = LDSCTL_OFF;
constexpr int TAB_OFF = LDSCTL_OFF + 64;
constexpr int ROWTAB_OFF = RING_BYTES;

#define GAS __attribute__((address_space(1)))
#define LAS __attribute__((address_space(3)))
typedef unsigned short bf16;
typedef unsigned v4u __attribute__((ext_vector_type(4)));
typedef unsigned v2u __attribute__((ext_vector_type(2)));
typedef float f32x4 __attribute__((ext_vector_type(4)));
typedef float f32x2 __attribute__((ext_vector_type(2)));
typedef short bf16x8 __attribute__((ext_vector_type(8)));
typedef GAS unsigned gu32;
#define RLX_AGENT __ATOMIC_RELAXED, __HIP_MEMORY_SCOPE_AGENT
#define LDS_WAIT() asm volatile("s_waitcnt lgkmcnt(0)" ::: "memory")
#define VM_WAIT() asm volatile("s_waitcnt vmcnt(0)" ::: "memory")
__device__ __forceinline__ unsigned f2bf(float f) { unsigned u = __builtin_bit_cast(unsigned, f); return (u + 0x7fffu + ((u >> 16) & 1u)) >> 16; }
__device__ __forceinline__ unsigned pk2(float lo, float hi) { return f2bf(lo) | (f2bf(hi) << 16); }
__device__ __forceinline__ float bflo(unsigned w) { return __builtin_bit_cast(float, w << 16); }
__device__ __forceinline__ float bfhi(unsigned w) { return __builtin_bit_cast(float, w & 0xffff0000u); }
__device__ __forceinline__ float wave_sum(float v) {
#pragma unroll
    for (int o = 1; o < 64; o <<= 1) v += __shfl_xor(v, o);
    return v;
}
__device__ __forceinline__ float softplusf(float x) { return x > 20.f ? x : log1pf(expf(x)); }
__device__ __forceinline__ float logsigf(float x) { return fminf(x, 0.f) - log1pf(expf(-fabsf(x))); }
__device__ __forceinline__ float siluf(float v) { return v * __builtin_amdgcn_rcpf(1.0f + __expf(-v)); }

#define XB_TMO      128
#define XB_XCNT(j)  (256  + 64 * (j))
#define XB_XSUB(j)  (1280 + 64 * (j))
#define XB_XGEN(j)  (2304 + 64 * (j))
#define XB_TOP      3328
#define XB_TOPGEN   3392
#define XCD_BAR_WORDS 3456
#define XB_SPIN_CAP (1u << 18)

__device__ __forceinline__ unsigned xb_ld(unsigned* p)              { return __hip_atomic_load(p, __ATOMIC_RELAXED, __HIP_MEMORY_SCOPE_AGENT); }
__device__ __forceinline__ unsigned xb_add(unsigned* p, unsigned v) { return __hip_atomic_fetch_add(p, v, __ATOMIC_RELAXED, __HIP_MEMORY_SCOPE_AGENT); }
__device__ __forceinline__ unsigned xb_xcc_id() { return (unsigned)__builtin_amdgcn_s_getreg((3 << 11) | 20) & 0xFu; }
#define XB_SPIN(cond, bar) do { unsigned _sp = 0; while (cond) { __builtin_amdgcn_s_sleep(1); \
    if ((++_sp & 255u) == 0u) { if (xb_ld(&(bar)[XB_TMO])) break; if (_sp > XB_SPIN_CAP) { atomicAdd(&(bar)[XB_TMO], 1u); break; } } } } while (0)

struct XcdBarrier {
    unsigned* bar; unsigned x;
    volatile LAS unsigned* st;
};

__device__ __forceinline__ XcdBarrier xcd_barrier_post(unsigned* bar, volatile LAS unsigned* st) {
    XcdBarrier b; b.bar = bar; b.x = xb_xcc_id(); b.st = st;
    if (threadIdx.x == 0) (void)xb_add(&bar[XB_XCNT(b.x)], 1u);
    return b;
}
__device__ __forceinline__ void xcd_barrier_complete(unsigned* bar, unsigned x, unsigned& nloc, unsigned& nx) {
    const unsigned G = gridDim.x * gridDim.y * gridDim.z;
    unsigned sum, cnt, mine, sp = 0u;
    for (;;) {
        sum = 0u; cnt = 0u; mine = 0u;
#pragma unroll
        for (unsigned j = 0; j < 16; ++j) { const unsigned c = xb_ld(&bar[XB_XCNT(j)]); sum += c; cnt += (c > 0u) ? 1u : 0u; mine = (j == x) ? c : mine; }
        if (sum == G) break;
        __builtin_amdgcn_s_sleep(1);
        if ((++sp & 255u) == 0u) { if (xb_ld(&bar[XB_TMO])) break; if (sp > XB_SPIN_CAP) { atomicAdd(&bar[XB_TMO], 1u); break; } }
    }
    nloc = mine > 0u ? mine : 1u; nx = cnt > 0u ? cnt : 1u;
}

__device__ __forceinline__ void xcd_barrier(const XcdBarrier& b) {
    asm volatile("s_waitcnt vmcnt(0)" ::: "memory");
    __syncthreads();
    if (threadIdx.x == 0) {
        unsigned* bar = b.bar;
        __builtin_amdgcn_s_waitcnt(0);
        unsigned nloc = b.st[0], nx = b.st[1];
        if (nloc == 0u) { xcd_barrier_complete(bar, b.x, nloc, nx); b.st[0] = nloc; b.st[1] = nx; }
        const unsigned old = xb_add(&bar[XB_XSUB(b.x)], 1u);
        const unsigned gen = old / nloc;
        if (old + 1u == (gen + 1u) * nloc) {
            __builtin_amdgcn_fence(__ATOMIC_RELEASE, "agent");
            asm volatile("s_waitcnt vmcnt(0)" ::: "memory");
            const unsigned og = xb_add(&bar[XB_TOP], 1u);
            const unsigned tg = og / nx;
            if (og + 1u == (tg + 1u) * nx) xb_add(&bar[XB_TOPGEN], 1u);
            else XB_SPIN(xb_ld(&bar[XB_TOPGEN]) == tg, bar);
            __builtin_amdgcn_fence(__ATOMIC_ACQUIRE, "agent");
            xb_add(&bar[XB_XGEN(b.x)], 1u);
            asm volatile("s_waitcnt vmcnt(0)" ::: "memory");
        } else {
            XB_SPIN(xb_ld(&bar[XB_XGEN(b.x)]) == gen, bar);
            __builtin_amdgcn_fence(__ATOMIC_ACQUIRE, "agent");
            asm volatile("s_waitcnt vmcnt(0)" ::: "memory");
        }
    }
    __syncthreads();
}

struct Frame {
    LAS unsigned char* lds;
    volatile LAS unsigned* MISC;
    gu32* ctl;
    int tid, lane, wave, G, bid;
    const float *x, *norm1_w, *w_in, *conv_w, *conv_b, *dt_bias, *a_log, *d_skip, *ssd_norm_w, *i_bias, *f_bias, *ml_norm_w, *w_out, *norm2_w, *router_w, *router_b, *w_gate_up, *b_gate_up, *w_down, *b_down, *final_norm_w;
    float* out; unsigned char* ws;
};

__device__ __forceinline__ void p0_transpose_item(const float* W, int ldw, int K, bf16* WT, int dst_row0, int src_col0, int k0, LAS float* scr, int lane) {
#pragma unroll 8
    for (int i = 0; i < 32; ++i) { const int kk = 2 * i + (lane >> 5); scr[kk * 33 + (lane & 31)] = W[(size_t)(k0 + kk) * ldw + src_col0 + (lane & 31)]; }
    LDS_WAIT(); asm volatile("" ::: "memory");
    const int c = lane & 7;
#pragma unroll
    for (int j = 0; j < 4; ++j) { const int n = (lane >> 3) + 8 * j; const LAS float* s = scr + (8 * c) * 33 + n;
        v4u o; o.x = pk2(s[0 * 33], s[1 * 33]); o.y = pk2(s[2 * 33], s[3 * 33]); o.z = pk2(s[4 * 33], s[5 * 33]); o.w = pk2(s[6 * 33], s[7 * 33]);
        *(v4u*)(WT + (size_t)(dst_row0 + n) * K + k0 + 8 * c) = o; }
    LDS_WAIT(); asm volatile("" ::: "memory");
}
__device__ __forceinline__ void p0_transpose_item_f8(const float* W, int ldw, int K, unsigned char* WT, int dst_row0, int src_col0, int k0, LAS float* scr, int lane) {
#pragma unroll 8
    for (int i = 0; i < 32; ++i) { const int kk = 2 * i + (lane >> 5); scr[kk * 33 + (lane & 31)] = W[(size_t)(k0 + kk) * ldw + src_col0 + (lane & 31)] * 64.0f; }
    LDS_WAIT(); asm volatile("" ::: "memory");
    const int c = lane & 3;
#pragma unroll
    for (int j = 0; j < 2; ++j) { const int n = (lane >> 2) + 16 * j; const LAS float* s = scr + (16 * c) * 33 + n; int o[4];
#pragma unroll
        for (int q = 0; q < 4; ++q) { int w = __builtin_amdgcn_cvt_pk_fp8_f32(s[(4 * q) * 33], s[(4 * q + 1) * 33], 0, false); o[q] = __builtin_amdgcn_cvt_pk_fp8_f32(s[(4 * q + 2) * 33], s[(4 * q + 3) * 33], w, true); }
        *(v4u*)(WT + (size_t)(dst_row0 + n) * K + k0 + 16 * c) = (v4u){(unsigned)o[0], (unsigned)o[1], (unsigned)o[2], (unsigned)o[3]}; }
    LDS_WAIT(); asm volatile("" ::: "memory");
}
template <bool F8> __device__ __forceinline__ void p0_transpose128(const float* W, int ldw, int K, void* WTv, int dst_row0, int src_col0, int k0, LAS float* scr, int lane) {
    const float* src = W + (size_t)(k0 + (lane >> 3)) * ldw + src_col0 + 4 * (lane & 7);
    f32x4 v[16];
#pragma unroll
    for (int i = 0; i < 16; ++i) v[i] = *(const f32x4*)(src + (size_t)(8 * i) * ldw);
#pragma unroll
    for (int i = 0; i < 16; ++i) { LAS float* d = scr + (8 * i + (lane >> 3)) * 33 + 4 * (lane & 7); d[0] = v[i].x; d[1] = v[i].y; d[2] = v[i].z; d[3] = v[i].w; }
    LDS_WAIT(); asm volatile("" ::: "memory");
    const int n = lane & 31, hf = lane >> 5; const LAS float* s = scr + (64 * hf) * 33 + n;
    if (F8) { unsigned char* dst = (unsigned char*)WTv + (size_t)(dst_row0 + n) * K + k0 + 64 * hf;
#pragma unroll
        for (int j = 0; j < 4; ++j) { int o[4];
#pragma unroll
            for (int q = 0; q < 4; ++q) { const LAS float* p = s + (16 * j + 4 * q) * 33; int w = __builtin_amdgcn_cvt_pk_fp8_f32(p[0] * 64.0f, p[33] * 64.0f, 0, false); o[q] = __builtin_amdgcn_cvt_pk_fp8_f32(p[66] * 64.0f, p[99] * 64.0f, w, true); }
            *(v4u*)(dst + 16 * j) = (v4u){(unsigned)o[0], (unsigned)o[1], (unsigned)o[2], (unsigned)o[3]}; }
    } else { bf16* dst = (bf16*)WTv + (size_t)(dst_row0 + n) * K + k0 + 64 * hf;
#pragma unroll
        for (int j = 0; j < 8; ++j) { const LAS float* p = s + (8 * j) * 33;
            *(v4u*)(dst + 8 * j) = (v4u){pk2(p[0], p[33]), pk2(p[66], p[99]), pk2(p[132], p[165]), pk2(p[198], p[231])}; }
    }
    LDS_WAIT(); asm volatile("" ::: "memory");
}
__device__ __forceinline__ void rms_row_to_bf16(const float* xrow, const float* w, bf16* orow, int lane) {
    const f32x4* xr = (const f32x4*)xrow + lane; const f32x4* wr = (const f32x4*)w + lane;
    f32x4 v[8]; float s = 0.f;
#pragma unroll
    for (int j = 0; j < 8; ++j) { v[j] = xr[64 * j]; s += (v[j].x * v[j].x + v[j].y * v[j].y) + (v[j].z * v[j].z + v[j].w * v[j].w); }
    const float rstd = 1.0f / sqrtf(wave_sum(s) * (1.0f / 2048.0f) + EPSF);
    v2u* o8 = (v2u*)orow + lane;
#pragma unroll
    for (int j = 0; j < 8; ++j) { const f32x4 ww = wr[64 * j]; v2u o; o.x = pk2(v[j].x * rstd * ww.x, v[j].y * rstd * ww.y); o.y = pk2(v[j].z * rstd * ww.z, v[j].w * rstd * ww.w); o8[64 * j] = o; }
}
__device__ __forceinline__ void phase0(Frame& F) {
    LAS float* scr = (LAS float*)(F.lds + F.wave * 16896);
    const int gw = F.bid * NWAVES + F.wave, NGW = F.G * NWAVES;
    bf16* WinT = (bf16*)(F.ws + WS_WIN); bf16* WsT = (bf16*)(F.ws + WS_WSM); float* Wrt = (float*)(F.ws + WS_WRT); bf16* WoutT = (bf16*)(F.ws + WS_WOUT);
    unsigned char* WguT = (unsigned char*)(F.ws + WS_WGU); unsigned char* WdT = (unsigned char*)(F.ws + WS_WD); bf16* XN1 = (bf16*)(F.ws + WS_XN1);
    constexpr int I_IN = 16 * 352, I_OUT = 32 * 64, I_GU = 32 * 2048, I_D = 32 * 1024, NITEMS = I_IN + I_OUT + I_GU + I_D;
    for (int it = gw; it < NITEMS; it += NGW) {
        int r = it;
        if (r < I_IN) { const int kb = r / 352, nb = r % 352, n0 = nb * 32; p0_transpose128<false>(F.w_in, WIN_LD, 2048, WinT, n0, n0 + (n0 >= 5120 ? 32 : 0), kb * 128, scr, F.lane); continue; } r -= I_IN;
        if (r < I_OUT) { const int kb = r >> 6, nb = r & 63; p0_transpose128<false>(F.w_out, 2048, 4096, WoutT, nb * 32, nb * 32, kb * 128, scr, F.lane); continue; } r -= I_OUT;
        if (r < I_GU) { const int e = r >> 11, rr = r & 2047, kb = rr >> 7, nb = rr & 127; p0_transpose128<true>(F.w_gate_up + (size_t)e * 2048 * 4096, 4096, 2048, WguT + (size_t)e * 4096 * 2048, nb * 32, nb * 32, kb * 128, scr, F.lane); continue; } r -= I_GU;
        { const int e = r >> 10, rr = r & 1023, kb = rr >> 6, nb = rr & 63; p0_transpose128<true>(F.w_down + (size_t)e * 2048 * 2048, 2048, 2048, WdT + (size_t)e * 2048 * 2048, nb * 32, nb * 32, kb * 128, scr, F.lane); }
    }
    for (int i = gw * 64 + F.lane; i < 64 * 2048; i += NGW * 64) { const int j = i >> 11, k = i & 2047;
        const int col = j < 32 ? 5120 + j : (j < 40 ? 11296 + (j - 32) : 11304 + (j - 40));
        WsT[i] = (bf16)(j < 48 ? f2bf(F.w_in[(size_t)k * WIN_LD + col]) : 0u); }
    for (int i = gw * 64 + F.lane; i < 2048 * 32; i += NGW * 64) Wrt[i] = F.norm2_w[i >> 5] * F.router_w[i];
    for (int m = gw; m < TT; m += NGW) rms_row_to_bf16(F.x + (size_t)m * DM, F.norm1_w, XN1 + (size_t)m * DM, F.lane);
}

__device__ __forceinline__ void p1_small(Frame& F) {
    const bf16* XN1 = (const bf16*)(F.ws + WS_XN1); const bf16* WsT = (const bf16*)(F.ws + WS_WSM); float* SMALL = (float*)(F.ws + WS_SMALL);
    const int gw = F.bid * NWAVES + F.wave, NGW = F.G * NWAVES, fr = F.lane & 15, fq = F.lane >> 4;
    for (int task = gw; task < TT / 16; task += NGW) {
        const int t0 = task * 16;
        f32x4 acc[4];
#pragma unroll
        for (int n = 0; n < 4; ++n) acc[n] = (f32x4){0.f, 0.f, 0.f, 0.f};
        const bf16* arow = XN1 + (size_t)(t0 + fr) * DM + 8 * fq; const bf16* brow = WsT + (size_t)fr * DM + 8 * fq;
#pragma unroll 16
        for (int ks = 0; ks < 64; ++ks) {
            const bf16x8 a = *(const bf16x8*)(arow + 32 * ks);
#pragma unroll
            for (int n = 0; n < 4; ++n) { const bf16x8 b = *(const bf16x8*)(brow + (size_t)n * 16 * DM + 32 * ks); acc[n] = __builtin_amdgcn_mfma_f32_16x16x32_bf16(a, b, acc[n], 0, 0, 0); }
        }
#pragma unroll
        for (int n = 0; n < 4; ++n)
#pragma unroll
            for (int r = 0; r < 4; ++r) SMALL[(size_t)(t0 + 4 * fq + r) * 64 + n * 16 + fr] = acc[n][r];
    }
}

__device__ __forceinline__ void unpack8(const v4u r, float (&f)[8]) { f[0] = bflo(r.x); f[1] = bfhi(r.x); f[2] = bflo(r.y); f[3] = bfhi(r.y); f[4] = bflo(r.z); f[5] = bfhi(r.z); f[6] = bflo(r.w); f[7] = bfhi(r.w); }

__device__ __forceinline__ void phase_conv(Frame& F) {
    const bf16* PROJ = (const bf16*)(F.ws + WS_PROJ); bf16* XC = (bf16*)(F.ws + WS_XC);
    constexpr int TB = 16, NCG = 384, NIT = (TT / TB) * NCG;
    for (int it = F.bid * (NWAVES * 64) + F.tid; it < NIT; it += F.G * NWAVES * 64) {
        const int cg = it % NCG, tb = it / NCG, ch = cg * 8, t0 = tb * TB; const bool seq0 = (t0 % SEQ) == 0;
        float w[4][8], bs[8];
#pragma unroll
        for (int j = 0; j < 4; ++j) { const f32x4 a = *(const f32x4*)(F.conv_w + j * 3072 + ch), b = *(const f32x4*)(F.conv_w + j * 3072 + ch + 4);
            w[j][0] = a.x; w[j][1] = a.y; w[j][2] = a.z; w[j][3] = a.w; w[j][4] = b.x; w[j][5] = b.y; w[j][6] = b.z; w[j][7] = b.w; }
        { const f32x4 a = *(const f32x4*)(F.conv_b + ch), b = *(const f32x4*)(F.conv_b + ch + 4); bs[0] = a.x; bs[1] = a.y; bs[2] = a.z; bs[3] = a.w; bs[4] = b.x; bs[5] = b.y; bs[6] = b.z; bs[7] = b.w; }
        const bf16* src = PROJ + (size_t)t0 * NPROJ + PC_XBC + ch;
        float r0[8], r1[8], r2[8], r3[8];
        if (seq0) {
#pragma unroll
            for (int i = 0; i < 8; ++i) { r0[i] = 0.f; r1[i] = 0.f; r2[i] = 0.f; }
        } else { unpack8(*(const v4u*)(src - 3 * (size_t)NPROJ), r0); unpack8(*(const v4u*)(src - 2 * (size_t)NPROJ), r1); unpack8(*(const v4u*)(src - (size_t)NPROJ), r2); }
        v4u rw[TB];
#pragma unroll
        for (int l = 0; l < TB; ++l) rw[l] = *(const v4u*)(src + (size_t)l * NPROJ);
#pragma unroll
        for (int l = 0; l < TB; ++l) {
            unpack8(rw[l], r3);
            float o[8];
#pragma unroll
            for (int i = 0; i < 8; ++i) { const float v = bs[i] + w[0][i] * r0[i] + w[1][i] * r1[i] + w[2][i] * r2[i] + w[3][i] * r3[i]; o[i] = siluf(v); r0[i] = r1[i]; r1[i] = r2[i]; r2[i] = r3[i]; }
            v4u ov; ov.x = pk2(o[0], o[1]); ov.y = pk2(o[2], o[3]); ov.z = pk2(o[4], o[5]); ov.w = pk2(o[6], o[7]);
            *(v4u*)(XC + (size_t)(t0 + l) * 3072 + ch) = ov;
        }
    }
}

constexpr int MX_PITCH = 272;
static_assert(true, "");
constexpr int MX_QM = 0, MX_KM = 34816, MX_KW = 69632, MX_VT = 104448, MX_SI = 121856, MX_VEC = 139264, MX_VECB = 3072, MX_NVEC = MX_VEC + 2 * MX_VECB, MX_SCAL = MX_NVEC + 512, MX_END = MX_SCAL + 64;
__device__ __forceinline__ unsigned cvt_pk_bf16_nop(float lo, float hi) { unsigned r; asm volatile("v_cvt_pk_bf16_f32 %0, %1, %2\n\ts_nop 1" : "=v"(r) : "v"(lo), "v"(hi)); return r; }
__device__ __forceinline__ int mx_sw(int row, int tbyte) { return row * MX_PITCH + ((((tbyte >> 4) ^ (row >> 3)) & 15) << 4) + (tbyte & 15); }
__device__ __forceinline__ bf16x8 lds_frag(const LAS unsigned char* img, int row, int kbyte) { return *(const LAS bf16x8*)(img + row * MX_PITCH + kbyte); }
static_assert(MX_END <= LDSCTL_OFF, "mixer LDS map");
template <bool ML> __device__ __forceinline__ void mixer_unit(Frame& F, int unit) {
    const bf16* PROJ = (const bf16*)(F.ws + WS_PROJ); const bf16* XC = (const bf16*)(F.ws + WS_XC); const float* SMALL = (const float*)(F.ws + WS_SMALL);
    bf16* YMIX = (bf16*)(F.ws + WS_YMIX); float* SSQ = (float*)(F.ws + WS_SSQ);
    const int w = F.wave, fr = F.lane & 15, fq = F.lane >> 4, tid = F.tid;
    const int b = unit >> 5, tok0 = b * SEQ, hd = unit & 31, grp = hd >> 3, mh = (unit & 31) >> 2, vq = unit & 3;
    const float qs = 0.08838834764831845f;
    LAS unsigned char* QM = F.lds + MX_QM; LAS unsigned char* KM = F.lds + MX_KM; LAS unsigned char* KW = F.lds + MX_KW; LAS unsigned char* VT = F.lds + MX_VT; LAS unsigned char* SI = F.lds + MX_SI;
    LAS float* exch = (LAS float*)(F.lds + MX_VEC + (w >> 2) * MX_VECB + 1024) + (w & 3) * 32;
    LAS float* nvec = (LAS float*)(F.lds + MX_NVEC); LAS float* scal = (LAS float*)(F.lds + MX_SCAL);
    const int fr3 = fr >> 3;
    int vtb[2];
#pragma unroll
    for (int p = 0; p < 2; ++p) vtb[p] = fr * MX_PITCH + ((fq ^ ((2 * p) | fr3)) << 4);
    int vpb[2][2];
#pragma unroll
    for (int p = 0; p < 2; ++p)
#pragma unroll
        for (int h = 0; h < 2; ++h) vpb[p][h] = fr * MX_PITCH + (((((fq >> 1) | (2 * h)) ^ ((2 * p) | fr3))) << 4) + 8 * (fq & 1);
    const int kwb = (16 * w + fr) * MX_PITCH + ((fq ^ ((2 * (w & 1)) | fr3)) << 4), kwh = w >> 1;

    const bf16* qsrc; const bf16* ksrc; const bf16* vsrc; int ld;
    if (ML) { qsrc = PROJ + PC_Q + mh * 128; ksrc = PROJ + PC_K + mh * 128; vsrc = PROJ + PC_V + mh * 256 + vq * 64; ld = NPROJ; }
    else { qsrc = XC + 2560 + grp * 128; ksrc = XC + 2048 + grp * 128; vsrc = XC + hd * 64; ld = 3072; }
    const float c_a = ML ? 0.f : -expf(F.a_log[hd]), c_dtb = ML ? 0.f : F.dt_bias[hd], c_D = ML ? 0.f : F.d_skip[hd], c_ib = ML ? F.i_bias[mh] : 0.f, c_fb = ML ? F.f_bias[mh] : 0.f;
    float mprev = 0.f;
    f32x4 sacc[4]; float nreg = 0.f;
#pragma unroll
    for (int j = 0; j < 4; ++j) sacc[j] = (f32x4){0.f, 0.f, 0.f, 0.f};
    v4u pq[4], pk[4], pv[2];
    float vA0 = 0.f, vA1 = 0.f, vB0 = 0.f, vB1 = 0.f, vC0 = 0.f, vC1 = 0.f, vD0 = 0.f, vD1 = 0.f, vE0 = 0.f, vE1 = 0.f, vG0 = 0.f, vG1 = 0.f, vSA = 0.f, vSG = 0.f;
    float sl0 = 0.f, sl1 = 0.f, sl2 = 0.f, sl3 = 0.f;
#define MX_SCAN_L(c) do { if (w == 0) { const size_t tt = (size_t)(tok0 + 128 * (c) + 2 * F.lane); \
        if (!ML) { sl0 = SMALL[tt * 64 + hd]; sl1 = SMALL[(tt + 1) * 64 + hd]; } \
        else { sl0 = SMALL[tt * 64 + 32 + mh]; sl1 = SMALL[(tt + 1) * 64 + 32 + mh]; sl2 = SMALL[tt * 64 + 40 + mh]; sl3 = SMALL[(tt + 1) * 64 + 40 + mh]; } } } while (0)
#define MX_SOFTPLUS(x) ((x) > 20.f ? (x) : __logf(1.0f + __expf(x)))
#define MX_LOGSIG(x) (fminf((x), 0.f) - __logf(1.0f + __expf(-fabsf(x))))
#define MX_SCAN_A(c) do { if (w == 0) { \
        if (!ML) { const float d0 = MX_SOFTPLUS(sl0 + c_dtb), d1 = MX_SOFTPLUS(sl1 + c_dtb); \
            const float x0 = d0 * c_a, x1 = d1 * c_a; float incl = x0 + x1; \
            _Pragma("unroll") for (int d = 1; d < 64; d <<= 1) { const float t_ = __shfl_up(incl, d); if (F.lane >= d) incl += t_; } \
            const float cum1 = incl, cum0 = incl - x1, tot = __shfl(incl, 63); \
            vA0 = -cum0; vA1 = -cum1; vB0 = -cum0; vB1 = -cum1; vC0 = d0; vC1 = d1; vD0 = __expf(cum0); vD1 = __expf(cum1); vE0 = d0 * __expf(tot - cum0); vE1 = d1 * __expf(tot - cum1); vSA = __expf(tot); vSG = 1.0f; \
        } else { const float li0 = sl0 + c_ib, li1 = sl1 + c_ib; \
            const float x0 = MX_LOGSIG(sl2 + c_fb), x1 = MX_LOGSIG(sl3 + c_fb); float incl = x0 + x1; \
            _Pragma("unroll") for (int d = 1; d < 64; d <<= 1) { const float t_ = __shfl_up(incl, d); if (F.lane >= d) incl += t_; } \
            const float cum1 = incl, cum0 = incl - x1, btot = __shfl(incl, 63); \
            const float dd0 = li0 - cum0, dd1 = li1 - cum1; float im = fmaxf(dd0, dd1); \
            _Pragma("unroll") for (int d = 1; d < 64; d <<= 1) { const float t_ = __shfl_up(im, d); if (F.lane >= d) im = fmaxf(im, t_); } \
            float pm = __shfl_up(im, 1); if (F.lane == 0) pm = -3.0e38f; const float pmax0 = fmaxf(pm, dd0), pmax1 = im, pm127 = __shfl(im, 63); \
            const float M0 = fmaxf(mprev, pmax0), M1 = fmaxf(mprev, pmax1); \
            vA0 = dd0; vA1 = dd1; vB0 = M0; vB1 = M1; vD0 = qs * __expf(mprev - M0); vD1 = qs * __expf(mprev - M1); vG0 = __expf(-(cum0 + M0)); vG1 = __expf(-(cum1 + M1)); \
            const float mloc = btot + pm127, mnew = fmaxf(btot + mprev, mloc); \
            vSA = __expf(btot + mprev - mnew); vSG = __expf(mloc - mnew); vE0 = __expf(dd0 - pm127) * vSG; vE1 = __expf(dd1 - pm127) * vSG; mprev = mnew; } } } while (0)
#define MX_SCAN_B(c) do { if (w == 0) { \
        LAS float* vb = (LAS float*)(F.lds + MX_VEC + ((c) & 1) * MX_VECB); const int l0 = 2 * F.lane; \
        *(LAS f32x2*)(vb + l0) = (f32x2){vA0, vA1}; *(LAS f32x2*)(vb + 128 + l0) = (f32x2){vB0, vB1}; if (!ML) *(LAS f32x2*)(vb + 256 + l0) = (f32x2){vC0, vC1}; \
        *(LAS f32x2*)(vb + 384 + l0) = (f32x2){vD0, vD1}; *(LAS f32x2*)(vb + 512 + l0) = (f32x2){vE0, vE1}; if (ML) *(LAS f32x2*)(vb + 640 + l0) = (f32x2){vG0, vG1}; \
        if (F.lane == 0) { scal[2 * ((c) & 1)] = vSA; scal[2 * ((c) & 1) + 1] = vSG; } } } while (0)
#define MX_SCAN(c) do { MX_SCAN_L(c); MX_SCAN_A(c); MX_SCAN_B(c); } while (0)
#define MX_PREFETCH(c) do { const size_t tb_ = (size_t)(tok0 + 128 * (c)); \
        _Pragma("unroll") for (int i = 0; i < 2; ++i) { const int pid = tid + 512 * i, a2 = pid >> 4, k8 = pid & 15; \
            pq[2 * i] = *(const v4u*)(qsrc + (tb_ + 2 * a2) * ld + 8 * k8); pq[2 * i + 1] = *(const v4u*)(qsrc + (tb_ + 2 * a2 + 1) * ld + 8 * k8); \
            pk[2 * i] = *(const v4u*)(ksrc + (tb_ + 2 * a2) * ld + 8 * k8); pk[2 * i + 1] = *(const v4u*)(ksrc + (tb_ + 2 * a2 + 1) * ld + 8 * k8); } \
        { const int a2 = tid >> 3, v8 = tid & 7; pv[0] = *(const v4u*)(vsrc + (tb_ + 2 * a2) * ld + 8 * v8); pv[1] = *(const v4u*)(vsrc + (tb_ + 2 * a2 + 1) * ld + 8 * v8); } } while (0)
#define MX_WRITE(c) do { const LAS float* vb = (const LAS float*)(F.lds + MX_VEC + ((c) & 1) * MX_VECB); \
        _Pragma("unroll") for (int i = 0; i < 2; ++i) { const int pid = tid + 512 * i, a2 = pid >> 4, k8 = pid & 15, l = 2 * a2; \
            *(LAS v4u*)(QM + l * MX_PITCH + 16 * k8) = pq[2 * i]; *(LAS v4u*)(QM + (l + 1) * MX_PITCH + 16 * k8) = pq[2 * i + 1]; \
            *(LAS v4u*)(KM + l * MX_PITCH + 16 * k8) = pk[2 * i]; *(LAS v4u*)(KM + (l + 1) * MX_PITCH + 16 * k8) = pk[2 * i + 1]; \
            float f0[8], f1[8]; unpack8(pk[2 * i], f0); unpack8(pk[2 * i + 1], f1); const f32x2 wl = *(const LAS f32x2*)(vb + 512 + l); \
            _Pragma("unroll") for (int e = 0; e < 8; ++e) *(LAS unsigned*)(KW + mx_sw(8 * k8 + e, 2 * l)) = pg8::cvt_pk_bf16(f0[e] * wl.x, f1[e] * wl.y); } \
        { const int a2 = tid >> 3, v8 = tid & 7, l = 2 * a2; const v4u r0 = pv[0], r1 = pv[1]; LAS unsigned char* vp_ = VT + mx_sw(8 * v8, 2 * l); \
            *(LAS unsigned*)(vp_ + 0 * MX_PITCH) = (r0.x & 0xffffu) | (r1.x << 16); *(LAS unsigned*)(vp_ + 1 * MX_PITCH) = (r0.x >> 16) | (r1.x & 0xffff0000u); \
            *(LAS unsigned*)(vp_ + 2 * MX_PITCH) = (r0.y & 0xffffu) | (r1.y << 16); *(LAS unsigned*)(vp_ + 3 * MX_PITCH) = (r0.y >> 16) | (r1.y & 0xffff0000u); \
            *(LAS unsigned*)(vp_ + 4 * MX_PITCH) = (r0.z & 0xffffu) | (r1.z << 16); *(LAS unsigned*)(vp_ + 5 * MX_PITCH) = (r0.z >> 16) | (r1.z & 0xffff0000u); \
            *(LAS unsigned*)(vp_ + 6 * MX_PITCH) = (r0.w & 0xffffu) | (r1.w << 16); *(LAS unsigned*)(vp_ + 7 * MX_PITCH) = (r0.w >> 16) | (r1.w & 0xffff0000u); } \
        _Pragma("unroll") for (int j = 0; j < 4; ++j) { v2u sv; sv.x = pg8::cvt_pk_bf16(sacc[j][0], sacc[j][1]); sv.y = pg8::cvt_pk_bf16(sacc[j][2], sacc[j][3]); *(LAS v2u*)(SI + (16 * j + fr) * MX_PITCH + (16 * w + 4 * fq) * 2) = sv; } \
        if (ML && fq == 0) nvec[16 * w + fr] = nreg; } while (0)
    v4u zc0 = (v4u){0u, 0u, 0u, 0u}, zc1 = zc0;
    if (!ML) { const bf16* zp = PROJ + (size_t)(tok0 + 16 * w + (F.lane >> 2)) * NPROJ + PC_Z + hd * 64 + 16 * (F.lane & 3); zc0 = *(const v4u*)zp; zc1 = *(const v4u*)(zp + 8); }
    MX_SCAN(0);
    MX_PREFETCH(0);
    __syncthreads();
    MX_WRITE(0);
    __syncthreads();
    for (int c = 0; c < SEQ / 128; ++c) {
        const LAS float* vb = (const LAS float*)(F.lds + MX_VEC + (c & 1) * MX_VECB);
        const bool more = (c + 1 < SEQ / 128);
        if (more) { MX_SCAN_L(c + 1); MX_PREFETCH(c + 1); }
        bf16x8 qf[4];
#pragma unroll
        for (int ks = 0; ks < 4; ++ks) qf[ks] = lds_frag(QM, 16 * w + fr, 64 * ks + 16 * fq);
        const float mlv = vb[128 + 16 * w + fr];
        float dsum = 0.f;
        f32x4 y1[4];
#pragma unroll
        for (int j = 0; j < 4; ++j) y1[j] = (f32x4){0.f, 0.f, 0.f, 0.f};
        const f32x4 rs4 = *(const LAS f32x4*)(vb + 384 + 16 * w + 4 * fq);
#pragma unroll
        for (int ks = 0; ks < 4; ++ks) { bf16x8 sf[4];
#pragma unroll
            for (int j = 0; j < 4; ++j) sf[j] = lds_frag(SI, 16 * j + fr, 64 * ks + 16 * fq);
#pragma unroll
            for (int j = 0; j < 4; ++j) y1[j] = __builtin_amdgcn_mfma_f32_16x16x32_bf16(qf[ks], sf[j], y1[j], 0, 0, 0); }
#pragma unroll
        for (int j = 0; j < 4; ++j) y1[j] = y1[j] * rs4;
        __builtin_amdgcn_sched_barrier(0);
#pragma unroll 1
        for (int k2 = 0; 2 * k2 <= w; ++k2) {
            unsigned pw[4];
#pragma unroll
            for (int h = 0; h < 2; ++h) {
                const int si = 2 * k2 + h;
                f32x4 acc = (f32x4){0.f, 0.f, 0.f, 0.f};
#pragma unroll
                for (int ks = 0; ks < 4; ++ks) acc = __builtin_amdgcn_mfma_f32_16x16x32_bf16(lds_frag(KM, 16 * si + fr, 64 * ks + 16 * fq), qf[ks], acc, 0, 0, 0);
                const f32x4 e4 = *(const LAS f32x4*)(vb + 16 * si + 4 * fq); f32x4 x4 = (f32x4){qs, qs, qs, qs}; if (!ML) x4 = *(const LAS f32x4*)(vb + 256 + 16 * si + 4 * fq);
                float p[4];
#pragma unroll
                for (int r = 0; r < 4; ++r) { const float v = acc[r] * __expf(e4[r] - mlv) * x4[r]; const bool ok = (si < w) || (si == w && 4 * fq + r <= fr); p[r] = ok ? v : 0.f; }
                if (ML) dsum += (p[0] + p[1]) + (p[2] + p[3]);
                pw[2 * h] = cvt_pk_bf16_nop(p[0], p[1]); pw[2 * h + 1] = cvt_pk_bf16_nop(p[2], p[3]);
            }
            HWAIT();
            const v4u pwv = (v4u){pw[0], pw[1], pw[2], pw[3]}; const bf16x8 pf = __builtin_bit_cast(bf16x8, pwv);
#pragma unroll
            for (int j = 0; j < 4; ++j) { const int ho = j * 16 * MX_PITCH + ((k2 ^ (j >> 1)) << 6); const v2u lo = *(const LAS v2u*)(VT + vpb[j & 1][0] + ho), hi = *(const LAS v2u*)(VT + vpb[j & 1][1] + ho); const v4u vw = (v4u){lo.x, lo.y, hi.x, hi.y};
                y1[j] = __builtin_amdgcn_mfma_f32_16x16x32_bf16(pf, __builtin_bit_cast(bf16x8, vw), y1[j], 0, 0, 0); }
            HWAIT();
        }
        HSYNC();
        __builtin_amdgcn_sched_barrier(0);
        __builtin_amdgcn_sched_barrier(0);
        if (ML) {
            dsum += __shfl_xor(dsum, 16); dsum += __shfl_xor(dsum, 32);
            float d2 = 0.f;
#pragma unroll
            for (int ks = 0; ks < 4; ++ks) { float qv[8]; unpack8(__builtin_bit_cast(v4u, qf[ks]), qv); const f32x4 n0 = *(const LAS f32x4*)(nvec + 32 * ks + 8 * fq), n1 = *(const LAS f32x4*)(nvec + 32 * ks + 8 * fq + 4);
                d2 += qv[0] * n0.x + qv[1] * n0.y + qv[2] * n0.z + qv[3] * n0.w + qv[4] * n1.x + qv[5] * n1.y + qv[6] * n1.z + qv[7] * n1.w; }
            d2 += __shfl_xor(d2, 16); d2 += __shfl_xor(d2, 32);
            if (fq == 0) { exch[fr] = dsum; exch[16 + fr] = d2; }
        }
        HSYNC();
        __builtin_amdgcn_sched_barrier(0);
        LAS float* stg = (LAS float*)(QM + 16 * w * MX_PITCH);
        if (ML) { const f32x4 fl4 = *(const LAS f32x4*)(vb + 640 + 16 * w + 4 * fq); const f32x4 dA = *(const LAS f32x4*)(exch + 4 * fq), dB = *(const LAS f32x4*)(exch + 16 + 4 * fq);
#pragma unroll
            for (int r = 0; r < 4; ++r) { const float den = fmaxf(fabsf(dA[r] + rs4[r] * dB[r]), fl4[r]); const float inv = __builtin_amdgcn_rcpf(den);
#pragma unroll
                for (int j = 0; j < 4; ++j) stg[(4 * fq + r) * 68 + 16 * j + fr] = y1[j][r] * inv; }
        } else {
#pragma unroll
            for (int j = 0; j < 4; ++j) { const v2u xw = *(const LAS v2u*)(VT + mx_sw(16 * j + fr, 32 * w + 8 * fq)); const float xs[4] = {bflo(xw.x), bfhi(xw.x), bflo(xw.y), bfhi(xw.y)};
#pragma unroll
                for (int r = 0; r < 4; ++r) stg[(4 * fq + r) * 68 + 16 * j + fr] = y1[j][r] + c_D * xs[r]; }
        }
        {   const int erow = F.lane >> 2, ecs = F.lane & 3; const size_t trow = (size_t)(tok0 + 128 * c + 16 * w + erow);
            float yv[16];
#pragma unroll
            for (int i = 0; i < 4; ++i) { const f32x4 t4 = *(const LAS f32x4*)(stg + erow * 68 + 16 * ecs + 4 * i); yv[4 * i] = t4.x; yv[4 * i + 1] = t4.y; yv[4 * i + 2] = t4.z; yv[4 * i + 3] = t4.w; }
            if (!ML) { float zf[16]; { float t8[8]; unpack8(zc0, t8);
#pragma unroll
                    for (int i = 0; i < 8; ++i) zf[i] = t8[i]; unpack8(zc1, t8);
#pragma unroll
                    for (int i = 0; i < 8; ++i) zf[8 + i] = t8[i]; }
#pragma unroll
                for (int i = 0; i < 16; ++i) yv[i] = yv[i] * zf[i] * __builtin_amdgcn_rcpf(1.0f + __expf(-zf[i])); }
            float ss = 0.f;
#pragma unroll
            for (int i = 0; i < 16; ++i) ss += yv[i] * yv[i];
            ss += __shfl_xor(ss, 1); ss += __shfl_xor(ss, 2);
            if (ecs == 0) SSQ[(ML ? (size_t)TT * 32 : 0) + trow * 32 + (ML ? mh * 4 + vq : hd)] = ss;
            bf16* yp = YMIX + trow * 4096 + (ML ? 2048 + mh * 256 + vq * 64 : hd * 64) + 16 * ecs;
            *(v4u*)yp = (v4u){pg8::cvt_pk_bf16(yv[0], yv[1]), pg8::cvt_pk_bf16(yv[2], yv[3]), pg8::cvt_pk_bf16(yv[4], yv[5]), pg8::cvt_pk_bf16(yv[6], yv[7])};
            *(v4u*)(yp + 8) = (v4u){pg8::cvt_pk_bf16(yv[8], yv[9]), pg8::cvt_pk_bf16(yv[10], yv[11]), pg8::cvt_pk_bf16(yv[12], yv[13]), pg8::cvt_pk_bf16(yv[14], yv[15])};
            if (!ML && more) { const bf16* zp = PROJ + (size_t)(tok0 + 128 * (c + 1) + 16 * w + (F.lane >> 2)) * NPROJ + PC_Z + hd * 64 + 16 * (F.lane & 3); zc0 = *(const v4u*)zp; zc1 = *(const v4u*)(zp + 8); }
        }
        __builtin_amdgcn_sched_barrier(0);
        const float sa = scal[2 * (c & 1)];
#pragma unroll
        for (int j = 0; j < 4; ++j) sacc[j] = sacc[j] * sa;
        float nsum = 0.f;
#pragma unroll
        for (int ks = 0; ks < 4; ++ks) { const bf16x8 kf = *(const LAS bf16x8*)(KW + kwb + ((ks ^ kwh) << 6)); bf16x8 vf[4];
#pragma unroll
            for (int j = 0; j < 4; ++j) vf[j] = *(const LAS bf16x8*)(VT + vtb[j & 1] + j * 16 * MX_PITCH + ((ks ^ (j >> 1)) << 6));
            if (ML) { float kv[8]; unpack8(__builtin_bit_cast(v4u, kf), kv); nsum += ((kv[0] + kv[1]) + (kv[2] + kv[3])) + ((kv[4] + kv[5]) + (kv[6] + kv[7])); }
#pragma unroll
            for (int j = 0; j < 4; ++j) sacc[j] = __builtin_amdgcn_mfma_f32_16x16x32_bf16(kf, vf[j], sacc[j], 0, 0, 0); }
        if (ML) { nsum += __shfl_xor(nsum, 16); nsum += __shfl_xor(nsum, 32); nreg = nreg * sa + nsum; }
        if (more) { MX_SCAN_A(c + 1); }
        __syncthreads();
        if (more) { MX_SCAN_B(c + 1); }
        __syncthreads();
        if (more) { MX_WRITE(c + 1); }
        __syncthreads();
    }
#undef MX_SCAN
#undef MX_SCAN_A
#undef MX_SCAN_L
#undef MX_SOFTPLUS
#undef MX_LOGSIG
#undef MX_SCAN_B
#undef MX_PREFETCH
#undef MX_WRITE
}
__device__ __forceinline__ void phase_mixer(Frame& F) {
    for (int unit = F.bid; unit < 256; unit += F.G) { mixer_unit<false>(F, unit); mixer_unit<true>(F, unit); }
}

__device__ __forceinline__ void phase3(Frame& F) {
    const bf16* PROJ = (const bf16*)(F.ws + WS_PROJ); bf16* YMIX = (bf16*)(F.ws + WS_YMIX); const float* SSQ = (const float*)(F.ws + WS_SSQ);
    const int gw = F.bid * NWAVES + F.wave, NGW = F.G * NWAVES;
    for (int t = gw; t < TT; t += NGW) {
        bf16* yrow = YMIX + (size_t)t * 4096;
#pragma unroll
        for (int j = 0; j < 8; ++j) {
            const int c0 = (j * 64 + F.lane) * 8;
            float y[8]; unpack8(*(const v4u*)(yrow + c0), y);
            float o[8];
            if (j < 4) {
                const int g = c0 >> 9; const f32x4 s0 = *(const f32x4*)(SSQ + (size_t)t * 32 + g * 8), s1 = *(const f32x4*)(SSQ + (size_t)t * 32 + g * 8 + 4);
                const float ms = ((s0.x + s0.y) + (s0.z + s0.w) + (s1.x + s1.y) + (s1.z + s1.w)) * (1.0f / 512.0f);
                const float rs = 1.0f / sqrtf(ms + EPSF);
                const f32x4 w0 = *(const f32x4*)(F.ssd_norm_w + c0), w1 = *(const f32x4*)(F.ssd_norm_w + c0 + 4);
                o[0] = y[0] * rs * w0.x; o[1] = y[1] * rs * w0.y; o[2] = y[2] * rs * w0.z; o[3] = y[3] * rs * w0.w;
                o[4] = y[4] * rs * w1.x; o[5] = y[5] * rs * w1.y; o[6] = y[6] * rs * w1.z; o[7] = y[7] * rs * w1.w;
            } else {
                const int cc = c0 - 2048, h = cc >> 8; const f32x4 s0 = *(const f32x4*)(SSQ + (size_t)TT * 32 + (size_t)t * 32 + h * 4);
                const float ms = ((s0.x + s0.y) + (s0.z + s0.w)) * (1.0f / 256.0f);
                const float rs = 1.0f / sqrtf(ms + EPSF);
                const f32x4 w0 = *(const f32x4*)(F.ml_norm_w + cc), w1 = *(const f32x4*)(F.ml_norm_w + cc + 4);
                float og[8]; unpack8(*(const v4u*)(PROJ + (size_t)t * NPROJ + PC_O + cc), og);
                const float wv[8] = {w0.x, w0.y, w0.z, w0.w, w1.x, w1.y, w1.z, w1.w};
#pragma unroll
                for (int i = 0; i < 8; ++i) o[i] = y[i] * rs * wv[i] * __builtin_amdgcn_rcpf(1.0f + __expf(-og[i]));
            }
            v4u ov; ov.x = pk2(o[0], o[1]); ov.y = pk2(o[2], o[3]); ov.z = pk2(o[4], o[5]); ov.w = pk2(o[6], o[7]);
            *(v4u*)(yrow + c0) = ov;
        }
    }
}

__device__ __forceinline__ void phase5(Frame& F) {
    const float* H2 = (const float*)(F.ws + WS_H2); const float* Wrt = (const float*)(F.ws + WS_WRT); bf16* XN2 = (bf16*)(F.ws + WS_XN2);
    int* EIDX = (int*)(F.ws + WS_ROUTE); int* RANK = EIDX + TT * 4;
    int* TOKL = (int*)(F.ws + WS_XG); float* GATEL = (float*)(F.ws + WS_XG + 4 * MiB);
    LAS float* xT = (LAS float*)(F.lds + F.wave * 8192); LAS float* lg = (LAS float*)(F.lds + 65536 + F.wave * 1024);
    LAS int* cntl = (LAS int*)(F.lds + 73728); LAS int* baseg = cntl + 32;
    const int gw = F.bid * NWAVES + F.wave, NGW = F.G * NWAVES, ntask = TT / 8, iters = (ntask + NGW - 1) / NGW;
    for (int itx = 0; itx < iters; ++itx) {
        const int task = itx * NGW + gw; const bool valid = task < ntask; const int t0 = task * 8;
        if (F.tid < 32) cntl[F.tid] = 0;
        __syncthreads();
        float rstd[8]; int me[4] = {0, 0, 0, 0}, mr[4] = {0, 0, 0, 0}; float mg[4] = {0.f, 0.f, 0.f, 0.f};
#pragma unroll
        for (int k = 0; k < 8; ++k) rstd[k] = 0.f;
        float acc[8], ssq[8];
#pragma unroll
        for (int k = 0; k < 8; ++k) { acc[k] = 0.f; ssq[k] = 0.f; }
        const int e = F.lane & 31, dh = F.lane >> 5;
        LAS float* wl = (LAS float*)(F.lds + 81920);
        for (int dc = 0; dc < 8; ++dc) {
            __syncthreads();
#pragma unroll
            for (int q = 0; q < 4; ++q) ((LAS f32x4*)wl)[F.tid + 512 * q] = ((const f32x4*)(Wrt + (size_t)dc * 256 * 32))[F.tid + 512 * q];
            if (valid) {
                f32x4 xk[8];
#pragma unroll
                for (int k = 0; k < 8; ++k) { xk[k] = *(const f32x4*)(H2 + (size_t)(t0 + k) * DM + dc * 256 + 4 * F.lane); ssq[k] += (xk[k].x * xk[k].x + xk[k].y * xk[k].y) + (xk[k].z * xk[k].z + xk[k].w * xk[k].w); }
#pragma unroll
                for (int jj = 0; jj < 4; ++jj) { LAS float* dp = xT + (jj * 64 + F.lane) * 8;
                    *(LAS f32x4*)dp = (f32x4){xk[0][jj], xk[1][jj], xk[2][jj], xk[3][jj]}; *(LAS f32x4*)(dp + 4) = (f32x4){xk[4][jj], xk[5][jj], xk[6][jj], xk[7][jj]}; }
            }
            __syncthreads();
            if (valid) {
                const LAS float* xp = xT + dh * 128 * 8;
#pragma unroll 8
                for (int i = 0; i < 128; ++i) { const float w = wl[(4 * (i & 63) + 2 * dh + (i >> 6)) * 32 + e];     const f32x4 xa = *(const LAS f32x4*)(xp + i * 8), xb = *(const LAS f32x4*)(xp + i * 8 + 4);
                    acc[0] += w * xa.x; acc[1] += w * xa.y; acc[2] += w * xa.z; acc[3] += w * xa.w; acc[4] += w * xb.x; acc[5] += w * xb.y; acc[6] += w * xb.z; acc[7] += w * xb.w; }
            }
        }
        if (valid) {
            const float rb = F.router_b[e];
#pragma unroll
            for (int k = 0; k < 8; ++k) { rstd[k] = 1.0f / sqrtf(wave_sum(ssq[k]) * (1.0f / 2048.0f) + EPSF);
                const float v = (acc[k] + __shfl_xor(acc[k], 32)) * rstd[k] + rb; if (F.lane < 32) lg[k * 32 + e] = v; }
            LDS_WAIT(); asm volatile("" ::: "memory");
            if (F.lane < 8) {
                const LAS float* lp = lg + F.lane * 32; float bv[4]; int bi[4] = {-1, -1, -1, -1};
#pragma unroll
                for (int p = 0; p < 4; ++p) { float best = -3.0e38f; int bidx = 0;
                    for (int q = 0; q < 32; ++q) { const float v = lp[q]; const bool taken = (q == bi[0]) | (q == bi[1]) | (q == bi[2]) | (q == bi[3]); if (!taken && v > best) { best = v; bidx = q; } }
                    bv[p] = best; bi[p] = bidx; }
                const float p1 = expf(bv[1] - bv[0]), p2 = expf(bv[2] - bv[0]), p3 = expf(bv[3] - bv[0]); const float inv = 1.0f / (1.0f + p1 + p2 + p3);
                mg[0] = inv; mg[1] = p1 * inv; mg[2] = p2 * inv; mg[3] = p3 * inv;
#pragma unroll
                for (int p = 0; p < 4; ++p) { me[p] = bi[p]; mr[p] = __hip_atomic_fetch_add(cntl + bi[p], 1, __ATOMIC_RELAXED, __HIP_MEMORY_SCOPE_WORKGROUP); }
            }
        }
        __syncthreads();
        if (F.tid < 32) { const int c = cntl[F.tid]; int gb = 0; if (c > 0) gb = (int)__hip_atomic_fetch_add((unsigned*)(F.ctl + CW_CNT + 64 * F.tid), (unsigned)c, RLX_AGENT); baseg[F.tid] = gb; }
        __syncthreads();
        if (valid) {
            if (F.lane < 8) { const size_t t = (size_t)(t0 + F.lane);
#pragma unroll
                for (int p = 0; p < 4; ++p) { const int rk = baseg[me[p]] + mr[p]; EIDX[t * 4 + p] = me[p]; RANK[t * 4 + p] = rk; TOKL[(size_t)me[p] * TT + rk] = (int)t; GATEL[(size_t)me[p] * TT + rk] = mg[p]; } }
#pragma unroll
            for (int k = 0; k < 8; ++k) { const f32x4* xr = (const f32x4*)(H2 + (size_t)(t0 + k) * DM) + F.lane; const f32x4* wr = (const f32x4*)F.norm2_w + F.lane; int* o4 = (int*)((unsigned char*)XN2 + (size_t)(t0 + k) * DM) + F.lane;
#pragma unroll
                for (int j = 0; j < 8; ++j) { const f32x4 v = xr[64 * j], ww = wr[64 * j]; int o = __builtin_amdgcn_cvt_pk_fp8_f32(v.x * rstd[k] * ww.x, v.y * rstd[k] * ww.y, 0, false); o = __builtin_amdgcn_cvt_pk_fp8_f32(v.z * rstd[k] * ww.z, v.w * rstd[k] * ww.w, o, true); o4[64 * j] = o; } }
        }
        __syncthreads();
    }
}
__device__ __forceinline__ int build_moe_tab(Frame& F) {
    LAS unsigned char* tab = (LAS unsigned char*)(F.lds + TAB_OFF); LAS int* tinfo = (LAS int*)(F.lds + TAB_OFF + 320);
    if (F.tid < 32) { const int c = (int)__hip_atomic_load((unsigned*)(F.ctl + CW_CNT + 64 * F.tid), RLX_AGENT); tinfo[4 + F.tid] = (c + 255) >> 8; tinfo[72 + F.tid] = c; }
    __syncthreads();
    if (F.tid == 0) { int a = 0; for (int e = 0; e < 32; ++e) { const int n = tinfo[4 + e]; tinfo[40 + e] = a; for (int j = 0; j < n; ++j) tab[a + j] = (unsigned char)e; a += n; } tinfo[0] = a; }
    __syncthreads();
    return tinfo[0];
}
__device__ __forceinline__ void phase8(Frame& F) {
    const float* H2 = (const float*)(F.ws + WS_H2); const bf16* YR = (const bf16*)(F.ws + WS_YR);
    const int* EIDX = (const int*)(F.ws + WS_ROUTE); const int* RANK = EIDX + TT * 4; (void)build_moe_tab(F); const LAS int* tinfo = (const LAS int*)(F.lds + TAB_OFF + 320);
    const int gw = F.bid * NWAVES + F.wave, NGW = F.G * NWAVES;
    for (int t = gw; t < TT; t += NGW) {
        int slot = 0; if (F.lane < 4) slot = 256 * tinfo[40 + EIDX[(size_t)t * 4 + F.lane]] + RANK[(size_t)t * 4 + F.lane];
        int sl[4]; sl[0] = __shfl(slot, 0); sl[1] = __shfl(slot, 1); sl[2] = __shfl(slot, 2); sl[3] = __shfl(slot, 3);
        float v[4][8]; float ss = 0.f;
#pragma unroll
        for (int j = 0; j < 4; ++j) { const int pz = F.lane + 64 * j; const f32x4 a = *(const f32x4*)(H2 + (size_t)t * DM + 8 * pz), b = *(const f32x4*)(H2 + (size_t)t * DM + 8 * pz + 4);
            v[j][0] = a.x; v[j][1] = a.y; v[j][2] = a.z; v[j][3] = a.w; v[j][4] = b.x; v[j][5] = b.y; v[j][6] = b.z; v[j][7] = b.w; }
#pragma unroll
        for (int k = 0; k < 4; ++k)
#pragma unroll
            for (int j = 0; j < 4; ++j) { float f[8]; unpack8(*((const v4u*)(YR + (size_t)sl[k] * DM) + F.lane + 64 * j), f);
#pragma unroll
                for (int i = 0; i < 8; ++i) v[j][i] += f[i]; }
#pragma unroll
        for (int j = 0; j < 4; ++j)
#pragma unroll
            for (int i = 0; i < 8; ++i) ss += v[j][i] * v[j][i];
        const float rstd = 1.0f / sqrtf(wave_sum(ss) * (1.0f / 2048.0f) + EPSF);
#pragma unroll
        for (int j = 0; j < 4; ++j) { const int pz = F.lane + 64 * j; const f32x4 w0 = *(const f32x4*)(F.final_norm_w + 8 * pz), w1 = *(const f32x4*)(F.final_norm_w + 8 * pz + 4);
            *(f32x4*)(F.out + (size_t)t * DM + 8 * pz) = (f32x4){v[j][0] * rstd * w0.x, v[j][1] * rstd * w0.y, v[j][2] * rstd * w0.z, v[j][3] * rstd * w0.w};
            *(f32x4*)(F.out + (size_t)t * DM + 8 * pz + 4) = (f32x4){v[j][4] * rstd * w1.x, v[j][5] * rstd * w1.y, v[j][6] * rstd * w1.z, v[j][7] * rstd * w1.w}; }
    }
}

struct Args { const float* in[21]; float* out; unsigned char* ws; int ph_lo, ph_hi, li, pad; };
__global__ void __launch_bounds__(NWAVES * 64, 2) hymba_fwd(Args args) {
    extern __shared__ __attribute__((aligned(16))) unsigned char lds[];
    Frame F;
    F.lds = (LAS unsigned char*)lds; F.MISC = (volatile LAS unsigned*)(F.lds + MISC_OFF);
    F.tid = threadIdx.x; F.lane = F.tid & 63; F.wave = __builtin_amdgcn_readfirstlane(F.tid >> 6); F.G = gridDim.x; F.bid = blockIdx.x;
    F.ws = args.ws; F.ctl = (gu32*)(args.ws + WS_CTL); F.out = args.out;
    F.x = args.in[0]; F.norm1_w = args.in[1]; F.w_in = args.in[2]; F.conv_w = args.in[3]; F.conv_b = args.in[4]; F.dt_bias = args.in[5]; F.a_log = args.in[6]; F.d_skip = args.in[7]; F.ssd_norm_w = args.in[8];
    F.i_bias = args.in[9]; F.f_bias = args.in[10]; F.ml_norm_w = args.in[11]; F.w_out = args.in[12]; F.norm2_w = args.in[13]; F.router_w = args.in[14]; F.router_b = args.in[15];
    F.w_gate_up = args.in[16]; F.b_gate_up = args.in[17]; F.w_down = args.in[18]; F.b_down = args.in[19]; F.final_norm_w = args.in[20];
    for (int u = F.tid; u < (LDS_BYTES - LDSCTL_OFF) / 4; u += NWAVES * 64) ((LAS unsigned*)(F.lds + LDSCTL_OFF))[u] = 0u;
    __syncthreads();
    XcdBarrier bar; bar.bar = (unsigned*)(F.ctl + CW_BAR) + args.li * XCD_BAR_WORDS; bar.x = 0; bar.st = nullptr;
    const bool use_bar = (args.ph_hi - args.ph_lo) > 1;
    if (use_bar) bar = xcd_barrier_post((unsigned*)(F.ctl + CW_BAR) + args.li * XCD_BAR_WORDS, F.MISC + 8);
    const int lo = args.ph_lo, hi = args.ph_hi;
#ifndef PHASE_MASK
#define PHASE_MASK 0x3ff
#endif
#define IN(k) (((PHASE_MASK >> (k)) & 1) && lo <= (k) && (k) < hi)
#define SEAM(k) do { if (IN(k) && IN((k) + 1)) xcd_barrier(bar); } while (0)
    if (IN(0)) { phase0(F); } SEAM(0);
    if (IN(1)) {
        pg8::Gemm g{(const pg8::bf16_t*)(F.ws + WS_XN1), (const pg8::bf16_t*)(F.ws + WS_WIN), TT, NPROJ, DM}; pg8::StaticOrder S; S.init(TT, NPROJ, F.G, F.bid);
        pg8::EpiBf16 E{(pg8::bf16_t*)(F.ws + WS_PROJ), NPROJ};
        pg8::gemm_phase<pg8::EpiBf16, pg8::StaticOrder, true, true>(F.lds, g, S, E);
        p1_small(F);
    } SEAM(1);
    if (IN(2)) { phase_conv(F); } SEAM(2);
    if (IN(3)) { phase_mixer(F); } SEAM(3);
    if (IN(4)) { phase3(F); } SEAM(4);
    if (IN(5)) {
        pg8::Gemm g{(const pg8::bf16_t*)(F.ws + WS_YMIX), (const pg8::bf16_t*)(F.ws + WS_WOUT), TT, DM, 4096}; pg8::StaticOrder S; S.init(TT, DM, F.G, F.bid);
        pg8::EpiResF32 E{(float*)(F.ws + WS_H2), F.x, DM};
        pg8::gemm_phase<pg8::EpiResF32, pg8::StaticOrder, true, true>(F.lds, g, S, E);
    } SEAM(5);
    if (IN(6)) { phase5(F); } SEAM(6);
    if (IN(7)) {
        const int nM = build_moe_tab(F);
        const LAS int* tinfo = (const LAS int*)(F.lds + TAB_OFF + 320); LAS unsigned short* rt = (LAS unsigned short*)(F.lds + ROWTAB_OFF);
        pg8::Gemm g{(const pg8::bf16_t*)(F.ws + WS_XN2), (const pg8::bf16_t*)(F.ws + WS_WGU), nM * 256, 4096, DM};
        pg8::MoeOrder S{nM, 16, 4, nM * 16, F.G, F.bid, (const PG8_LAS unsigned char*)(F.lds + TAB_OFF), (const PG8_LAS unsigned short*)rt};
        { const int* TOKL = (const int*)(F.ws + WS_XG);
          for (int i = 0; i < 18; ++i) { pg8::Unit u; if (!S.next(i, u)) break; const int e = u.pn >> 4, rank = (u.pm - tinfo[40 + e]) * 256 + (F.tid & 255);
              if (F.tid < 256) rt[i * 256 + F.tid] = (unsigned short)(rank < tinfo[72 + e] ? TOKL[(size_t)e * TT + rank] : 0); }
          __syncthreads(); }
        pg8::EpiSwiglu E{(unsigned char*)(F.ws + WS_ACT), F.b_gate_up};
        pg8::gemm_phase<pg8::EpiSwiglu, pg8::MoeOrder, true, true, true, true>(F.lds, g, S, E);
    } SEAM(7);
    if (IN(8)) {
        const int nM = build_moe_tab(F);
        pg8::Gemm g{(const pg8::bf16_t*)(F.ws + WS_ACT), (const pg8::bf16_t*)(F.ws + WS_WD), nM * 256, 2048, DM};
        pg8::MoeOrder S{nM, 8, 3, nM * 8, F.G, F.bid, (const PG8_LAS unsigned char*)(F.lds + TAB_OFF), nullptr};
        pg8::EpiDown E{(pg8::bf16_t*)(F.ws + WS_YR), F.b_down, (const float*)(F.ws + WS_XG + 4 * MiB), (const PG8_LAS int*)(F.lds + TAB_OFF + 320)};
        pg8::gemm_phase<pg8::EpiDown, pg8::MoeOrder, true, true, true>(F.lds, g, S, E);
    } SEAM(8);
    if (IN(9)) { phase8(F); }
#undef IN
#undef SEAM
}

extern "C" void kernel_launch(void* const* d_in, const int* in_sizes, int n_in, void* d_out, int out_size, void* d_ws, size_t ws_size, hipStream_t stream) {
    static int grid = 0;
    if (grid == 0) {
        if (n_in != 21 || out_size != TT * DM || ws_size < WS_END) { fprintf(stderr, "kernel_launch: unexpected problem (n_in %d, out %d, ws %zu); nothing launched\n", n_in, out_size, ws_size); grid = -1; return; }
        int dev = 0, cus = 0, per_cu = 0;
        if (hipGetDevice(&dev) != hipSuccess || hipDeviceGetAttribute(&cus, hipDeviceAttributeMultiprocessorCount, dev) != hipSuccess) { grid = -1; return; }
        if (hipFuncSetAttribute((const void*)hymba_fwd, hipFuncAttributeMaxDynamicSharedMemorySize, LDS_BYTES) != hipSuccess) { fprintf(stderr, "kernel_launch: hipFuncSetAttribute failed\n"); grid = -1; return; }
        if (hipOccupancyMaxActiveBlocksPerMultiprocessor(&per_cu, (const void*)hymba_fwd, NWAVES * 64, LDS_BYTES) != hipSuccess || per_cu < 1) { fprintf(stderr, "kernel_launch: occupancy query says %d blocks per CU\n", per_cu); }
        (void)hipGetLastError();
        grid = cus;
    }
    if (grid < 0) return;
    (void)hipMemsetAsync((char*)d_ws + WS_CTL, 0, CTL_ZERO_BYTES, stream);
    Args a{};
    for (int i = 0; i < 21; ++i) a.in[i] = (const float*)d_in[i];
    a.out = (float*)d_out; a.ws = (unsigned char*)d_ws; a.pad = 0;
#if MK_PER_PHASE
    for (int li = 0; li < N_PHASES; ++li) { a.ph_lo = li; a.ph_hi = li + 1; a.li = li; hipLaunchKernelGGL(hymba_fwd, dim3(grid), dim3(NWAVES * 64), LDS_BYTES, stream, a); }
#else
    a.ph_lo = 0; a.ph_hi = N_PHASES; a.li = 0;
    hipLaunchKernelGGL(hymba_fwd, dim3(grid), dim3(NWAVES * 64), LDS_BYTES, stream, a);
#endif
}
```

```cpp
#include <hip/hip_runtime.h>
#include <cstdio>
#include <cstdint>
namespace pg8 {
#define PG8_LAS __attribute__((address_space(3)))
typedef unsigned short bf16_t;
typedef short bf16x8 __attribute__((ext_vector_type(8)));
typedef float f32x4 __attribute__((ext_vector_type(4)));
typedef unsigned u32x4 __attribute__((ext_vector_type(4)));
constexpr int BM = 256, BK = 64, HALF = 128, HTB = HALF * BK * 2  , STAGE_BYTES = 8 * HTB, NXCD = 8, WGM = 8;

__host__ __device__ __forceinline__ int lds_byte(int r, int c) { const int st = (r >> 4) * 2 + (c >> 5), rr = r & 15, cc = c & 31, ob = rr * 64 + cc * 2; return st * 1024 + (ob ^ (((ob >> 9) & 1) << 5)); }
__host__ __device__ __forceinline__ void stage_rc(int b, int& R, int& C) { const int st = b / 1024, sb = b % 1024, swz = sb ^ (((sb >> 9) & 1) << 5); R = (st >> 1) * 16 + swz / 64; C = (st & 1) * 32 + (swz % 64) / 2; }
__host__ __device__ __forceinline__ int perm32(int rho) { const int n = rho >> 4, i = rho & 15; return 8 * (i >> 2) + 4 * n + (i & 3); }

struct Unit { int pm, pn; };
struct Gemm { const bf16_t* A; const bf16_t* Bt; int M, N, K; };

struct StaticOrder {
    int nM, nN, nwg, G, c;
    __host__ __device__ void init(int M, int N, int G_, int c_) { nM = M / BM; nN = N / BM; nwg = nM * nN; G = G_; c = c_; }
    __host__ __device__ bool next(int i, Unit& u) const {
        const long L = (long)i * G + c; if (L >= nwg) return false;
        int wgid = (int)L; { const int q = nwg / NXCD, r = nwg % NXCD, xcd = wgid % NXCD, off = wgid / NXCD; wgid = (xcd < r ? xcd * (q + 1) : r * (q + 1) + (xcd - r) * q) + off; }
        const int nig = WGM * nN, gid = wgid / nig, fm = gid * WGM, gsz = (nM - fm) < WGM ? (nM - fm) : WGM;
        u.pm = fm + ((wgid % nig) % gsz); u.pn = (wgid % nig) / gsz; return true;
    }
    __device__ __forceinline__ const PG8_LAS unsigned short* rowp(int) const { return nullptr; }
    __device__ __forceinline__ void a_ready(const Unit&) const {}
    __device__ __forceinline__ void done(const Unit&) const {}
};


__device__ __forceinline__ unsigned cvt_pk_bf16(float lo, float hi) { unsigned r; asm volatile("v_cvt_pk_bf16_f32 %0, %1, %2" : "=v"(r) : "v"(lo), "v"(hi)); return r; }
typedef unsigned u32x2 __attribute__((ext_vector_type(2)));

struct EpiBf16 {
    static constexpr bool PERM = true, AFTER_DRAIN = false;
    bf16_t* O; int ldc;
    __device__ __forceinline__ void operator()(const f32x4 (&acc)[2][2][4][2], const Unit& u, int wr, int wc, int fr, int fq) const {
        const int row0 = u.pm * BM + wr * 64 + fr; const int col0 = u.pn * BM + wc * 32 + 8 * fq;
#pragma unroll
        for (int ai = 0; ai < 2; ++ai)
#pragma unroll
            for (int m = 0; m < 4; ++m) { bf16_t* rowp = O + (size_t)(row0 + ai * HALF + m * 16) * ldc + col0;
#pragma unroll
                for (int bj = 0; bj < 2; ++bj) { const f32x4 v0 = acc[ai][bj][m][0], v1 = acc[ai][bj][m][1];
                    u32x4 w; w.x = cvt_pk_bf16(v0[0], v0[1]); w.y = cvt_pk_bf16(v0[2], v0[3]); w.z = cvt_pk_bf16(v1[0], v1[1]); w.w = cvt_pk_bf16(v1[2], v1[3]);
                    *(u32x4*)(rowp + bj * HALF) = w; } }
    }
};
struct EpiResNorm {
    static constexpr bool PERM = false, AFTER_DRAIN = false, KSCALE = true;
    float* C; const float* base; int ldc; const float* ssq; PG8_LAS float* tabl; float eps;
    __device__ __forceinline__ void build(const Unit& u, int tid) const {
        const int row = tid & 255, part = tid >> 8; const size_t t = (size_t)u.pm * BM + row; float rs[7];
        if (part == 0) { const f32x4* p = (const f32x4*)(ssq + t * 32);
#pragma unroll
            for (int g = 0; g < 4; ++g) { const f32x4 a = p[2 * g], b = p[2 * g + 1]; rs[g] = 1.0f / sqrtf(((a.x + a.y) + (a.z + a.w) + (b.x + b.y) + (b.z + b.w)) * (1.0f / 512.0f) + eps); }
            const f32x4* q = (const f32x4*)(ssq + (size_t)16384 * 32 + t * 32);
#pragma unroll
            for (int h = 0; h < 3; ++h) { const f32x4 a = q[h]; rs[4 + h] = 1.0f / sqrtf(((a.x + a.y) + (a.z + a.w)) * (1.0f / 256.0f) + eps); }
        } else { const f32x4* q = (const f32x4*)(ssq + (size_t)16384 * 32 + t * 32);
#pragma unroll
            for (int h = 0; h < 6; ++h) { const f32x4 a = q[2 + h]; rs[h] = 1.0f / sqrtf(((a.x + a.y) + (a.z + a.w)) * (1.0f / 256.0f) + eps); }
            rs[6] = 1.0f; }
        PG8_LAS float* d = tabl + row * 12 + 6 * part;
#pragma unroll
        for (int s = 0; s < 6; ++s) d[s] = (part == 1 && s == 5) ? rs[5] : rs[s] / rs[s + 1];
    }
    __device__ __forceinline__ void kscale(f32x4 (&acc)[2][2][4][2], int t, int nt, int wr, int fr) const {
        const int kt = t + 1; const bool segend = kt < 32 ? ((kt & 7) == 7) : ((kt & 3) == 3);
        if (segend && kt != nt - 1) { const int sg = kt < 32 ? (kt >> 3) : 4 + ((kt - 32) >> 2);
#pragma unroll
            for (int ai = 0; ai < 2; ++ai)
#pragma unroll
                for (int m = 0; m < 4; ++m) { const float r = tabl[(ai * HALF + wr * 64 + m * 16 + fr) * 12 + sg];
#pragma unroll
                    for (int bj = 0; bj < 2; ++bj)
#pragma unroll
                        for (int n = 0; n < 2; ++n) acc[ai][bj][m][n] = acc[ai][bj][m][n] * r; } }
    }
    __device__ __forceinline__ void operator()(const f32x4 (&acc)[2][2][4][2], const Unit& u, int wr, int wc, int fr, int fq) const {
        const int row0 = u.pm * BM + wr * 64 + fr, col0 = u.pn * BM + wc * 32 + 4 * fq;
#pragma unroll
        for (int ai = 0; ai < 2; ++ai)
#pragma unroll
            for (int m = 0; m < 4; ++m) { const size_t off = (size_t)(row0 + ai * HALF + m * 16) * ldc + col0; const float r = tabl[(ai * HALF + wr * 64 + m * 16 + fr) * 12 + 11];
#pragma unroll
                for (int bj = 0; bj < 2; ++bj)
#pragma unroll
                    for (int n = 0; n < 2; ++n) *(f32x4*)(C + off + bj * HALF + n * 16) = acc[ai][bj][m][n] * r + *(const f32x4*)(base + off + bj * HALF + n * 16); }
    }
};
struct EpiResF32 {
    static constexpr bool PERM = false, AFTER_DRAIN = false;
    float* C; const float* base; int ldc;
    __device__ __forceinline__ void operator()(const f32x4 (&acc)[2][2][4][2], const Unit& u, int wr, int wc, int fr, int fq) const {
        const int row0 = u.pm * BM + wr * 64 + fr, col0 = u.pn * BM + wc * 32 + 4 * fq;
#pragma unroll
        for (int ai = 0; ai < 2; ++ai)
#pragma unroll
            for (int m = 0; m < 4; ++m) { const size_t off = (size_t)(row0 + ai * HALF + m * 16) * ldc + col0;
#pragma unroll
                for (int bj = 0; bj < 2; ++bj)
#pragma unroll
                    for (int n = 0; n < 2; ++n) *(f32x4*)(C + off + bj * HALF + n * 16) = acc[ai][bj][m][n] + *(const f32x4*)(base + off + bj * HALF + n * 16); }
    }
};
__device__ __forceinline__ float swiglu1(float a, float b) {
    const float glu = fminf(a, 7.0f), lin = fminf(fmaxf(b, -7.0f), 7.0f);
    return glu * __builtin_amdgcn_rcpf(1.0f + __expf(-1.702f * glu)) * (lin + 1.0f);
}
struct EpiSwiglu {
    static constexpr bool PERM = true, AFTER_DRAIN = false;
    unsigned char* O; const float* bias;
    __device__ __forceinline__ void operator()(const f32x4 (&acc)[2][2][4][2], const Unit& u, int wr, int wc, int fr, int fq) const {
        const int e = u.pn >> 4, pnl = u.pn & 15;
        const int row0 = u.pm * BM + wr * 64 + fr; const int hcol0 = pnl * BM + wc * 32 + 8 * fq;
        const float* bp = bias + (size_t)e * 4096 + hcol0;
        f32x4 bv[2][2];
#pragma unroll
        for (int bj = 0; bj < 2; ++bj)
#pragma unroll
            for (int n = 0; n < 2; ++n) bv[bj][n] = *(const f32x4*)(bp + bj * HALF + 4 * n);
#pragma unroll
        for (int ai = 0; ai < 2; ++ai)
#pragma unroll
            for (int m = 0; m < 4; ++m) { unsigned char* rowp = O + (size_t)(row0 + ai * HALF + m * 16) * 2048 + (hcol0 >> 1);
#pragma unroll
                for (int bj = 0; bj < 2; ++bj) { const f32x4 v0 = acc[ai][bj][m][0] + bv[bj][0], v1 = acc[ai][bj][m][1] + bv[bj][1];
                    int w = __builtin_amdgcn_cvt_pk_fp8_f32(swiglu1(v0[0], v0[1]), swiglu1(v0[2], v0[3]), 0, false);
                    w = __builtin_amdgcn_cvt_pk_fp8_f32(swiglu1(v1[0], v1[1]), swiglu1(v1[2], v1[3]), w, true);
                    *(int*)(rowp + bj * 64) = w; } }
    }
};
struct EpiDown {
    static constexpr bool PERM = true, AFTER_DRAIN = false;
    bf16_t* O; const float* bias; const float* gatel; const PG8_LAS int* tinfo;
    __device__ __forceinline__ void operator()(const f32x4 (&acc)[2][2][4][2], const Unit& u, int wr, int wc, int fr, int fq) const {
        const int e = u.pn >> 3, pnl = u.pn & 7;
        const int row0 = u.pm * BM + wr * 64 + fr; const int col0 = pnl * BM + wc * 32 + 8 * fq;
        const float* bp = bias + (size_t)e * 2048 + col0; const float* gp = gatel + (size_t)e * 16384 - 256 * tinfo[40 + e];
        f32x4 bv[2][2];
#pragma unroll
        for (int bj = 0; bj < 2; ++bj)
#pragma unroll
            for (int n = 0; n < 2; ++n) bv[bj][n] = *(const f32x4*)(bp + bj * HALF + 4 * n);
#pragma unroll
        for (int ai = 0; ai < 2; ++ai)
#pragma unroll
            for (int m = 0; m < 4; ++m) { const int row = row0 + ai * HALF + m * 16; const float gt = gp[row]; bf16_t* rowp = O + (size_t)row * 2048 + col0;
#pragma unroll
                for (int bj = 0; bj < 2; ++bj) { const f32x4 v0 = (acc[ai][bj][m][0] + bv[bj][0]) * gt, v1 = (acc[ai][bj][m][1] + bv[bj][1]) * gt;
                    u32x4 w; w.x = cvt_pk_bf16(v0[0], v0[1]); w.y = cvt_pk_bf16(v0[2], v0[3]); w.z = cvt_pk_bf16(v1[0], v1[1]); w.w = cvt_pk_bf16(v1[2], v1[3]);
                    *(u32x4*)(rowp + bj * HALF) = w; } }
    }
};
struct MoeOrder {
    int nM, nN, nsh, nwg, G, c; const PG8_LAS unsigned char* tab; const PG8_LAS unsigned short* rt;
    __device__ __forceinline__ const PG8_LAS unsigned short* rowp(int ui) const { return rt + ui * 256; }
    __device__ __forceinline__ bool next(int i, Unit& u) const {
        const long L = (long)i * G + c; if (L >= nwg) return false;
        int wgid = (int)L; { const int q = nwg / NXCD, r = nwg % NXCD, xcd = wgid % NXCD, off = wgid / NXCD; wgid = (xcd < r ? xcd * (q + 1) : r * (q + 1) + (xcd - r) * q) + off; }
        const int nig = WGM * nN, gid = wgid / nig, fm = gid * WGM, gsz = (nM - fm) < WGM ? (nM - fm) : WGM;
        const int pm = fm + ((wgid % nig) % gsz), pnl = (wgid % nig) / gsz;
        u.pm = pm; u.pn = ((int)tab[pm] << nsh) + pnl; return true;
    }
    __device__ __forceinline__ void a_ready(const Unit&) const {}
    __device__ __forceinline__ void done(const Unit&) const {}
};
template <class E, class = void> struct epi_kscale { static constexpr bool value = false; };
template <class E> struct epi_kscale<E, decltype((void)E::KSCALE)> { static constexpr bool value = E::KSCALE; };
typedef int v8i32 __attribute__((ext_vector_type(8)));
__device__ __forceinline__ v8i32 pg8_cat(const bf16x8 lo, const bf16x8 hi) { typedef int v4i32 __attribute__((ext_vector_type(4))); const v4i32 a = __builtin_bit_cast(v4i32, lo), b = __builtin_bit_cast(v4i32, hi); return __builtin_shufflevector(a, b, 0, 1, 2, 3, 4, 5, 6, 7); }
template <class Epi, class Sched, bool ALIGN_EPI = false, bool SP2 = false, bool F8 = false, bool GA = false>
__device__ __forceinline__ void gemm_phase(PG8_LAS unsigned char* lds, const Gemm g, const Sched& S, const Epi& E) {
    const int tid = threadIdx.x, wid = __builtin_amdgcn_readfirstlane(tid >> 6), lane = tid & 63, wr = wid >> 2, wc = wid & 3, fr = lane & 15, fq = lane >> 4;
    const int K = g.K, KB = F8 ? K : 2 * K, nt = KB / 128;
    unsigned voffA[2], voffB[2]; int gaR[2]; unsigned gaC[2]; static_assert(!GA || SP2, "gathered A needs the SP2 loop");
#pragma unroll
    for (int i = 0; i < 2; ++i) { int R, C; stage_rc(tid * 16 + i * 8192, R, C); const int Rb = Epi::PERM ? ((R & ~31) + perm32(R & 31)) : R;
        voffA[i] = (unsigned)(R * KB + C * 2); voffB[i] = (unsigned)(Rb * KB + C * 2); gaR[i] = R; gaC[i] = (unsigned)(C * 2); }
    const size_t kstep = (size_t)(BK * 2);
    const size_t hstep = (size_t)HALF * KB;
    const size_t tstep = 2 * hstep;
    const unsigned ldsw = (unsigned)wid * 1024u;
    int aoffk[2], boffk[2];
#pragma unroll
    for (int h = 0; h < 2; ++h) { aoffk[h] = lds_byte(wr * 64 + fr, fq * 8) + h * 1024; boffk[h] = lds_byte(wc * 32 + fr, fq * 8) + h * 1024; }
#define PG8_SA(b, h) (((b) * 2 + (h)) * HTB)
#define PG8_SB(b, h) ((4 + (b) * 2 + (h)) * HTB)
#define PG8_STAGE(bufoff, gbase, voff) do { _Pragma("unroll") for (int _i = 0; _i < 2; ++_i) \
        __builtin_amdgcn_global_load_lds((const unsigned*)((const char*)(gbase) + (voff)[_i]), (PG8_LAS unsigned*)(lds + (bufoff) + ldsw + _i * 8192), 16, 0, 0); } while (0)
#define PG8_STAGE_A(bufoff, kptr, h, usenext) do { if constexpr (GA) { _Pragma("unroll") for (int _i = 0; _i < 2; ++_i) { const unsigned _o = (usenext) ? gn[h][_i] : gc[h][_i]; \
            __builtin_amdgcn_global_load_lds((const unsigned*)((const char*)(kptr) + _o), (PG8_LAS unsigned*)(lds + (bufoff) + ldsw + _i * 8192), 16, 0, 0); } } \
        else { PG8_STAGE(bufoff, (kptr) + (h) * hstep, voffA); } } while (0)
#define PG8_GROWS(dst, ui_) do { const PG8_LAS unsigned short* _rt = S.rowp(ui_); _Pragma("unroll") for (int _h = 0; _h < 2; ++_h) _Pragma("unroll") for (int _i = 0; _i < 2; ++_i) dst[_h][_i] = (unsigned)_rt[gaR[_i] + 128 * _h] * (unsigned)KB + gaC[_i]; } while (0)
#define PG8_LDA(dst, b, h) do { if constexpr (F8) { _Pragma("unroll") for (int m = 0; m < 4; ++m) dst##8[m] = pg8_cat(*(const PG8_LAS bf16x8*)(lds + PG8_SA(b, h) + aoffk[0] + m * 2048), *(const PG8_LAS bf16x8*)(lds + PG8_SA(b, h) + aoffk[1] + m * 2048)); } \
        else { _Pragma("unroll") for (int m = 0; m < 4; ++m) _Pragma("unroll") for (int k = 0; k < 2; ++k) dst[m][k] = *(const PG8_LAS bf16x8*)(lds + PG8_SA(b, h) + aoffk[k] + m * 2048); } } while (0)
#define PG8_LDB(dst, b, h) do { if constexpr (F8) { _Pragma("unroll") for (int n = 0; n < 2; ++n) dst##8[n] = pg8_cat(*(const PG8_LAS bf16x8*)(lds + PG8_SB(b, h) + boffk[0] + n * 2048), *(const PG8_LAS bf16x8*)(lds + PG8_SB(b, h) + boffk[1] + n * 2048)); } \
        else { _Pragma("unroll") for (int n = 0; n < 2; ++n) _Pragma("unroll") for (int k = 0; k < 2; ++k) dst[n][k] = *(const PG8_LAS bf16x8*)(lds + PG8_SB(b, h) + boffk[k] + n * 2048); } } while (0)
#define PG8_MMA(ai, bj, At, Bt) do { __builtin_amdgcn_s_setprio(1); \
        if constexpr (F8) { _Pragma("unroll") for (int m = 0; m < 4; ++m) _Pragma("unroll") for (int n = 0; n < 2; ++n) \
            asm volatile("v_mfma_scale_f32_16x16x128_f8f6f4 %0, %1, %2, %0, %3, %4 op_sel_hi:[0,0,0]" : "+v"(acc[ai][bj][m][n]) : "v"(Bt##8[n]), "v"(At##8[m]), "v"(sc_w), "v"(sc_a)); } \
        else { _Pragma("unroll") for (int m = 0; m < 4; ++m) _Pragma("unroll") for (int n = 0; n < 2; ++n) _Pragma("unroll") for (int k = 0; k < 2; ++k) \
            acc[ai][bj][m][n] = __builtin_amdgcn_mfma_f32_16x16x32_bf16(Bt[n][k], At[m][k], acc[ai][bj][m][n], 0, 0, 0); } \
        __builtin_amdgcn_s_setprio(0); } while (0)
#define PG8_WAIT_V(n) asm volatile("s_waitcnt vmcnt(" #n ")" ::: "memory")
#define PG8_WAIT_L(n) asm volatile("s_waitcnt lgkmcnt(" #n ")" ::: "memory")
#define PG8_BAR __builtin_amdgcn_s_barrier()
#define PG8_SCHED __builtin_amdgcn_sched_barrier(0)
    Unit cur, nxt; int ui = 0;
    if (!S.next(0, cur)) return;
    f32x4 acc[2][2][4][2];
#pragma unroll
    for (int a = 0; a < 2; ++a)
#pragma unroll
        for (int b = 0; b < 2; ++b)
#pragma unroll
            for (int m = 0; m < 4; ++m)
#pragma unroll
                for (int n = 0; n < 2; ++n) acc[a][b][m][n] = (f32x4){0.f, 0.f, 0.f, 0.f};
    const int sc_w = 0x79797979, sc_a = 0x7f7f7f7f;
    bf16x8 At[4][2], B0[2][2], B1[2][2]; v8i32 At8[4], B08[2], B18[2];
    const char* cA = (const char*)g.A + (GA ? (size_t)0 : (size_t)cur.pm * tstep); const char* cB = (const char*)g.Bt + (size_t)cur.pn * tstep;
    unsigned gc[2][2] = {{0u, 0u}, {0u, 0u}}, gn[2][2] = {{0u, 0u}, {0u, 0u}};
    if constexpr (GA) { PG8_GROWS(gc, 0); }
    if constexpr (epi_kscale<Epi>::value) { E.build(cur, tid); asm volatile("s_waitcnt lgkmcnt(0)" ::: "memory"); PG8_BAR; asm volatile("" ::: "memory"); }
    S.a_ready(cur);
    if constexpr (SP2) {
        PG8_STAGE(PG8_SB(0, 0), cB, voffB); PG8_STAGE(PG8_SB(0, 1), cB + hstep, voffB); PG8_STAGE_A(PG8_SA(0, 0), cA, 0, false); PG8_STAGE_A(PG8_SA(0, 1), cA, 1, false);
        if (wr == 1) PG8_BAR;
        PG8_WAIT_V(2); PG8_BAR;
        PG8_STAGE(PG8_SB(1, 0), cB + kstep, voffB); PG8_STAGE_A(PG8_SA(1, 0), cA + kstep, 0, false); PG8_STAGE(PG8_SB(1, 1), cB + hstep + kstep, voffB);
        PG8_WAIT_V(6); PG8_BAR;
    } else {
        PG8_STAGE(PG8_SB(0, 0), cB, voffB); PG8_STAGE(PG8_SA(0, 0), cA, voffA); PG8_STAGE(PG8_SB(0, 1), cB + hstep, voffB); PG8_STAGE(PG8_SA(0, 1), cA + hstep, voffA);
        if (wr == 1) PG8_BAR;
        PG8_WAIT_V(4); PG8_BAR;
        PG8_STAGE(PG8_SB(1, 0), cB + kstep, voffB); PG8_STAGE(PG8_SA(1, 0), cA + kstep, voffA); PG8_STAGE(PG8_SB(1, 1), cB + hstep + kstep, voffB);
        PG8_WAIT_V(6); PG8_BAR;
    }
    for (;;) {
        const bool has_next = S.next(ui + 1, nxt);
        const char* nA = (has_next && !GA) ? (const char*)g.A + (size_t)nxt.pm * tstep : cA; const char* nB = has_next ? (const char*)g.Bt + (size_t)nxt.pn * tstep : cB;
        if constexpr (GA) { if (has_next) { PG8_GROWS(gn, ui + 1); } else {
#pragma unroll
            for (int _h = 0; _h < 2; ++_h) { gn[_h][0] = gc[_h][0]; gn[_h][1] = gc[_h][1]; } } }
        for (int t = 0; t < nt; t += 2) {
            const bool last = (t == nt - 2);
            const char* a1 = cA + (size_t)(t + 1) * kstep;
            const char* a2 = last ? nA : cA + (size_t)(t + 2) * kstep; const char* b2 = last ? nB : cB + (size_t)(t + 2) * kstep;
            const char* a3 = a2 + kstep; const char* b3 = b2 + kstep;
            if (last && has_next) S.a_ready(nxt);
            if constexpr (SP2) {
            PG8_LDB(B0, 0, 0); PG8_LDB(B1, 0, 1); PG8_SCHED; PG8_LDA(At, 0, 0); PG8_STAGE_A(PG8_SA(1, 1), a1, 1, false);
            PG8_WAIT_V(8); PG8_WAIT_L(0); PG8_BAR; PG8_MMA(0, 0, At, B0); PG8_MMA(0, 1, At, B1); PG8_BAR; PG8_SCHED;
            PG8_LDA(At, 0, 1); PG8_STAGE(PG8_SB(0, 0), b2, voffB); PG8_STAGE(PG8_SB(0, 1), b2 + hstep, voffB); PG8_STAGE_A(PG8_SA(0, 0), a2, 0, last);
            PG8_WAIT_V(8); PG8_WAIT_L(0); PG8_BAR; PG8_MMA(1, 0, At, B0); PG8_MMA(1, 1, At, B1); PG8_BAR; PG8_SCHED;
            PG8_LDB(B0, 1, 0); PG8_LDB(B1, 1, 1); PG8_SCHED; PG8_LDA(At, 1, 0); PG8_STAGE_A(PG8_SA(0, 1), a2, 1, last);
            PG8_WAIT_V(8); PG8_WAIT_L(0); PG8_BAR; PG8_MMA(0, 0, At, B0); PG8_MMA(0, 1, At, B1); PG8_BAR; PG8_SCHED;
            PG8_LDA(At, 1, 1); PG8_STAGE(PG8_SB(1, 0), b3, voffB); PG8_STAGE(PG8_SB(1, 1), b3 + hstep, voffB); PG8_STAGE_A(PG8_SA(1, 0), a3, 0, last);
            PG8_WAIT_V(8); PG8_WAIT_L(0); PG8_BAR; PG8_MMA(1, 0, At, B0); PG8_MMA(1, 1, At, B1); PG8_BAR; PG8_SCHED;
            if constexpr (epi_kscale<Epi>::value) { E.kscale(acc, t, nt, wr, fr); PG8_SCHED; }
            } else {
            PG8_LDB(B0, 0, 0); PG8_SCHED; PG8_LDA(At, 0, 0); PG8_STAGE(PG8_SA(1, 1), a1 + hstep, voffA);
            PG8_WAIT_L(8); PG8_BAR; PG8_WAIT_L(0); PG8_MMA(0, 0, At, B0); PG8_BAR; PG8_SCHED;
            PG8_LDB(B1, 0, 1); PG8_STAGE(PG8_SB(0, 0), b2, voffB);
            PG8_BAR; PG8_WAIT_L(0); PG8_MMA(0, 1, At, B1); PG8_BAR;
            PG8_LDA(At, 0, 1); PG8_STAGE(PG8_SA(0, 0), a2, voffA);
            PG8_BAR; PG8_WAIT_L(0); PG8_MMA(1, 0, At, B0); PG8_BAR; PG8_SCHED;
            PG8_STAGE(PG8_SB(0, 1), b2 + hstep, voffB);
            PG8_WAIT_V(6); PG8_BAR; PG8_MMA(1, 1, At, B1); PG8_BAR;
            PG8_LDB(B0, 1, 0); PG8_SCHED; PG8_LDA(At, 1, 0); PG8_STAGE(PG8_SA(0, 1), a2 + hstep, voffA);
            PG8_WAIT_L(8); PG8_BAR; PG8_WAIT_L(0); PG8_MMA(0, 0, At, B0); PG8_BAR; PG8_SCHED;
            PG8_LDB(B1, 1, 1); PG8_STAGE(PG8_SB(1, 0), b3, voffB);
            PG8_BAR; PG8_WAIT_L(0); PG8_MMA(0, 1, At, B1); PG8_BAR;
            PG8_LDA(At, 1, 1); PG8_STAGE(PG8_SA(1, 0), a3, voffA);
            PG8_BAR; PG8_WAIT_L(0); PG8_MMA(1, 0, At, B0); PG8_BAR; PG8_SCHED;
            PG8_STAGE(PG8_SB(1, 1), b3 + hstep, voffB);
            PG8_WAIT_V(6); PG8_BAR; PG8_MMA(1, 1, At, B1); PG8_BAR;
            }
        }
        if constexpr (ALIGN_EPI) { if (wr == 0) PG8_BAR; }
        if constexpr (F8) asm volatile("s_nop 15\n\ts_nop 15" ::: "memory");
        if constexpr (!Epi::AFTER_DRAIN) { E(acc, cur, wr, wc, fr, fq); S.done(cur); }
        if (!has_next) break;
#pragma unroll
        for (int a = 0; a < 2; ++a)
#pragma unroll
            for (int b = 0; b < 2; ++b)
#pragma unroll
                for (int m = 0; m < 4; ++m)
#pragma unroll
                    for (int n = 0; n < 2; ++n) acc[a][b][m][n] = (f32x4){0.f, 0.f, 0.f, 0.f};
        if constexpr (epi_kscale<Epi>::value) { static_assert(!epi_kscale<Epi>::value || (ALIGN_EPI && SP2), "K-segment rescale needs aligned epilogues");
            asm volatile("s_waitcnt lgkmcnt(0)" ::: "memory"); PG8_BAR; asm volatile("" ::: "memory");
            E.build(nxt, tid); asm volatile("s_waitcnt lgkmcnt(0)" ::: "memory"); PG8_BAR; asm volatile("" ::: "memory"); }
        cur = nxt; cA = nA; cB = nB; ++ui;
        if constexpr (GA) {
#pragma unroll
            for (int _h = 0; _h < 2; ++_h) { gc[_h][0] = gn[_h][0]; gc[_h][1] = gn[_h][1]; } }
        if constexpr (ALIGN_EPI) { if (wr == 1) PG8_BAR; }
    }
    PG8_WAIT_V(0);
    if constexpr (!ALIGN_EPI) { if (wr == 0) PG8_BAR; }
    PG8_BAR;
    if constexpr (Epi::AFTER_DRAIN) { E.fused(acc, cur, wr, wc, fr, fq, lds, wid, lane); S.done(cur); }
#undef PG8_SA
#undef PG8_SB
#undef PG8_STAGE
#undef PG8_STAGE_A
#undef PG8_GROWS
#undef PG8_LDA
#undef PG8_LDB
#undef PG8_MMA
#undef PG8_WAIT_V
#undef PG8_WAIT_L
#undef PG8_BAR
#undef PG8_SCHED
}
}

constexpr int NWAVES = 8;
constexpr int TT = 16384, DM = 2048, SEQ = 2048;
constexpr int NPROJ = 11264;
constexpr int PC_Z = 0, PC_XBC = 2048, PC_Q = 5120, PC_K = 6144, PC_V = 7168, PC_O = 9216;
constexpr int WIN_LD = 11312;
constexpr int NSLOT = 65536 + 32 * 256;
constexpr float EPSF = 1e-5f;
#ifndef HSYNC_ON
#define HSYNC_ON 0
#endif
#define HWAIT() do { if (HSYNC_ON) asm volatile("s_waitcnt vmcnt(0) lgkmcnt(0)\n\ts_nop 15\n\ts_nop 15" ::: "memory"); } while (0)
#define HSYNC() do { if (HSYNC_ON) { HWAIT(); __syncthreads(); } } while (0)
#ifndef MK_PER_PHASE
#define MK_PER_PHASE 0
#endif
constexpr int N_PHASES = 9;

constexpr size_t MiB = 1u << 20;
constexpr size_t WS_CTL = 0, CTL_ZERO_BYTES = 1 * MiB;
constexpr size_t WS_WIN = 2 * MiB, WS_WSM = 46 * MiB, WS_WRT = 47 * MiB, WS_WOUT = 48 * MiB, WS_WGU = 64 * MiB, WS_WD = 576 * MiB;
constexpr size_t WS_XN1 = 832 * MiB, WS_PROJ = 896 * MiB, WS_SMALL = 1248 * MiB, WS_SSQ = 1252 * MiB, WS_YMIX = 1256 * MiB, WS_H2 = 1384 * MiB, WS_XN2 = 1512 * MiB;
constexpr size_t WS_ROUTE = 1576 * MiB, WS_XG = 1578 * MiB, WS_ACT = 1866 * MiB, WS_YR = 2154 * MiB, WS_XC = 2442 * MiB, WS_END = 2538 * MiB;
constexpr int CW_BAR = 4096;
constexpr int CW_CNT = 65536;

constexpr int RING_BYTES = 131072;
constexpr int LDS_BYTES = 147456;
constexpr int LDSCTL_OFF = LDS_BYTES - 1024, MISC_OFF = LDSCTL_OFF;
constexpr int TAB_OFF = LDSCTL_OFF + 64;
constexpr int ROWTAB_OFF = RING_BYTES;

#define GAS __attribute__((address_space(1)))
#define LAS __attribute__((address_space(3)))
typedef unsigned short bf16;
typedef unsigned v4u __attribute__((ext_vector_type(4)));
typedef unsigned v2u __attribute__((ext_vector_type(2)));
typedef float f32x4 __attribute__((ext_vector_type(4)));
typedef float f32x2 __attribute__((ext_vector_type(2)));
typedef short bf16x8 __attribute__((ext_vector_type(8)));
typedef GAS unsigned gu32;
#define RLX_AGENT __ATOMIC_RELAXED, __HIP_MEMORY_SCOPE_AGENT
#define LDS_WAIT() asm volatile("s_waitcnt lgkmcnt(0)" ::: "memory")
#define VM_WAIT() asm volatile("s_waitcnt vmcnt(0)" ::: "memory")
__device__ __forceinline__ unsigned f2bf(float f) { unsigned u = __builtin_bit_cast(unsigned, f); return (u + 0x7fffu + ((u >> 16) & 1u)) >> 16; }
__device__ __forceinline__ unsigned pk2(float lo, float hi) { return f2bf(lo) | (f2bf(hi) << 16); }
__device__ __forceinline__ float bflo(unsigned w) { return __builtin_bit_cast(float, w << 16); }
__device__ __forceinline__ float bfhi(unsigned w) { return __builtin_bit_cast(float, w & 0xffff0000u); }
__device__ __forceinline__ float wave_sum(float v) {
#pragma unroll
    for (int o = 1; o < 64; o <<= 1) v += __shfl_xor(v, o);
    return v;
}
__device__ __forceinline__ float softplusf(float x) { return x > 20.f ? x : log1pf(expf(x)); }
__device__ __forceinline__ float logsigf(float x) { return fminf(x, 0.f) - log1pf(expf(-fabsf(x))); }
__device__ __forceinline__ float siluf(float v) { return v * __builtin_amdgcn_rcpf(1.0f + __expf(-v)); }

#define XB_TMO      128
#define XB_XCNT(j)  (256  + 64 * (j))
#define XB_XSUB(j)  (1280 + 64 * (j))
#define XB_XGEN(j)  (2304 + 64 * (j))
#define XB_TOP      3328
#define XB_TOPGEN   3392
#define XCD_BAR_WORDS 3456
#define XB_SPIN_CAP (1u << 18)

__device__ __forceinline__ unsigned xb_ld(unsigned* p)              { return __hip_atomic_load(p, __ATOMIC_RELAXED, __HIP_MEMORY_SCOPE_AGENT); }
__device__ __forceinline__ unsigned xb_add(unsigned* p, unsigned v) { return __hip_atomic_fetch_add(p, v, __ATOMIC_RELAXED, __HIP_MEMORY_SCOPE_AGENT); }
__device__ __forceinline__ unsigned xb_xcc_id() { return (unsigned)__builtin_amdgcn_s_getreg((3 << 11) | 20) & 0xFu; }
#define XB_SPIN(cond, bar) do { unsigned _sp = 0; while (cond) { __builtin_amdgcn_s_sleep(1); \
    if ((++_sp & 255u) == 0u) { if (xb_ld(&(bar)[XB_TMO])) break; if (_sp > XB_SPIN_CAP) { atomicAdd(&(bar)[XB_TMO], 1u); break; } } } } while (0)

struct XcdBarrier {
    unsigned* bar; unsigned x;
    volatile LAS unsigned* st;
};

__device__ __forceinline__ XcdBarrier xcd_barrier_post(unsigned* bar, volatile LAS unsigned* st) {
    XcdBarrier b; b.bar = bar; b.x = xb_xcc_id(); b.st = st;
    if (threadIdx.x == 0) (void)xb_add(&bar[XB_XCNT(b.x)], 1u);
    return b;
}
__device__ __forceinline__ void xcd_barrier_complete(unsigned* bar, unsigned x, unsigned& nloc, unsigned& nx) {
    const unsigned G = gridDim.x * gridDim.y * gridDim.z;
    unsigned sum, cnt, mine, sp = 0u;
    for (;;) {
        sum = 0u; cnt = 0u; mine = 0u;
#pragma unroll
        for (unsigned j = 0; j < 16; ++j) { const unsigned c = xb_ld(&bar[XB_XCNT(j)]); sum += c; cnt += (c > 0u) ? 1u : 0u; mine = (j == x) ? c : mine; }
        if (sum == G) break;
        __builtin_amdgcn_s_sleep(1);
        if ((++sp & 255u) == 0u) { if (xb_ld(&bar[XB_TMO])) break; if (sp > XB_SPIN_CAP) { atomicAdd(&bar[XB_TMO], 1u); break; } }
    }
    nloc = mine > 0u ? mine : 1u; nx = cnt > 0u ? cnt : 1u;
}

__device__ __forceinline__ void xcd_barrier(const XcdBarrier& b) {
    asm volatile("s_waitcnt vmcnt(0)" ::: "memory");
    __syncthreads();
    if (threadIdx.x == 0) {
        unsigned* bar = b.bar;
        __builtin_amdgcn_s_waitcnt(0);
        unsigned nloc = b.st[0], nx = b.st[1];
        if (nloc == 0u) { xcd_barrier_complete(bar, b.x, nloc, nx); b.st[0] = nloc; b.st[1] = nx; }
        const unsigned old = xb_add(&bar[XB_XSUB(b.x)], 1u);
        const unsigned gen = old / nloc;
        if (old + 1u == (gen + 1u) * nloc) {
            __builtin_amdgcn_fence(__ATOMIC_RELEASE, "agent");
            asm volatile("s_waitcnt vmcnt(0)" ::: "memory");
            const unsigned og = xb_add(&bar[XB_TOP], 1u);
            const unsigned tg = og / nx;
            if (og + 1u == (tg + 1u) * nx) xb_add(&bar[XB_TOPGEN], 1u);
            else XB_SPIN(xb_ld(&bar[XB_TOPGEN]) == tg, bar);
            __builtin_amdgcn_fence(__ATOMIC_ACQUIRE, "agent");
            xb_add(&bar[XB_XGEN(b.x)], 1u);
            asm volatile("s_waitcnt vmcnt(0)" ::: "memory");
        } else {
            XB_SPIN(xb_ld(&bar[XB_XGEN(b.x)]) == gen, bar);
            __builtin_amdgcn_fence(__ATOMIC_ACQUIRE, "agent");
            asm volatile("s_waitcnt vmcnt(0)" ::: "memory");
        }
    }
    __syncthreads();
}

struct Frame {
    LAS unsigned char* lds;
    volatile LAS unsigned* MISC;
    gu32* ctl;
    int tid, lane, wave, G, bid;
    const float *x, *norm1_w, *w_in, *conv_w, *conv_b, *dt_bias, *a_log, *d_skip, *ssd_norm_w, *i_bias, *f_bias, *ml_norm_w, *w_out, *norm2_w, *router_w, *router_b, *w_gate_up, *b_gate_up, *w_down, *b_down, *final_norm_w;
    float* out; unsigned char* ws;
};

__device__ __forceinline__ void p0_transpose_item(const float* W, int ldw, int K, bf16* WT, int dst_row0, int src_col0, int k0, LAS float* scr, int lane) {
#pragma unroll 8
    for (int i = 0; i < 32; ++i) { const int kk = 2 * i + (lane >> 5); scr[kk * 33 + (lane & 31)] = W[(size_t)(k0 + kk) * ldw + src_col0 + (lane & 31)]; }
    LDS_WAIT(); asm volatile("" ::: "memory");
    const int c = lane & 7;
#pragma unroll
    for (int j = 0; j < 4; ++j) { const int n = (lane >> 3) + 8 * j; const LAS float* s = scr + (8 * c) * 33 + n;
        v4u o; o.x = pk2(s[0 * 33], s[1 * 33]); o.y = pk2(s[2 * 33], s[3 * 33]); o.z = pk2(s[4 * 33], s[5 * 33]); o.w = pk2(s[6 * 33], s[7 * 33]);
        *(v4u*)(WT + (size_t)(dst_row0 + n) * K + k0 + 8 * c) = o; }
    LDS_WAIT(); asm volatile("" ::: "memory");
}
__device__ __forceinline__ void p0_transpose_item_f8(const float* W, int ldw, int K, unsigned char* WT, int dst_row0, int src_col0, int k0, LAS float* scr, int lane) {
#pragma unroll 8
    for (int i = 0; i < 32; ++i) { const int kk = 2 * i + (lane >> 5); scr[kk * 33 + (lane & 31)] = W[(size_t)(k0 + kk) * ldw + src_col0 + (lane & 31)] * 64.0f; }
    LDS_WAIT(); asm volatile("" ::: "memory");
    const int c = lane & 3;
#pragma unroll
    for (int j = 0; j < 2; ++j) { const int n = (lane >> 2) + 16 * j; const LAS float* s = scr + (16 * c) * 33 + n; int o[4];
#pragma unroll
        for (int q = 0; q < 4; ++q) { int w = __builtin_amdgcn_cvt_pk_fp8_f32(s[(4 * q) * 33], s[(4 * q + 1) * 33], 0, false); o[q] = __builtin_amdgcn_cvt_pk_fp8_f32(s[(4 * q + 2) * 33], s[(4 * q + 3) * 33], w, true); }
        *(v4u*)(WT + (size_t)(dst_row0 + n) * K + k0 + 16 * c) = (v4u){(unsigned)o[0], (unsigned)o[1], (unsigned)o[2], (unsigned)o[3]}; }
    LDS_WAIT(); asm volatile("" ::: "memory");
}
template <bool F8> __device__ __forceinline__ void p0_transpose128(const float* W, int ldw, int K, void* WTv, int dst_row0, int src_col0, int k0, LAS float* scr, int lane) {
    const float* src = W + (size_t)(k0 + (lane >> 3)) * ldw + src_col0 + 4 * (lane & 7);
    f32x4 v[16];
#pragma unroll
    for (int i = 0; i < 16; ++i) v[i] = *(const f32x4*)(src + (size_t)(8 * i) * ldw);
#pragma unroll
    for (int i = 0; i < 16; ++i) { LAS float* d = scr + (8 * i + (lane >> 3)) * 33 + 4 * (lane & 7); d[0] = v[i].x; d[1] = v[i].y; d[2] = v[i].z; d[3] = v[i].w; }
    LDS_WAIT(); asm volatile("" ::: "memory");
    const int n = lane & 31, hf = lane >> 5; const LAS float* s = scr + (64 * hf) * 33 + n;
    if (F8) { unsigned char* dst = (unsigned char*)WTv + (size_t)(dst_row0 + n) * K + k0 + 64 * hf;
#pragma unroll
        for (int j = 0; j < 4; ++j) { int o[4];
#pragma unroll
            for (int q = 0; q < 4; ++q) { const LAS float* p = s + (16 * j + 4 * q) * 33; int w = __builtin_amdgcn_cvt_pk_fp8_f32(p[0] * 64.0f, p[33] * 64.0f, 0, false); o[q] = __builtin_amdgcn_cvt_pk_fp8_f32(p[66] * 64.0f, p[99] * 64.0f, w, true); }
            *(v4u*)(dst + 16 * j) = (v4u){(unsigned)o[0], (unsigned)o[1], (unsigned)o[2], (unsigned)o[3]}; }
    } else { bf16* dst = (bf16*)WTv + (size_t)(dst_row0 + n) * K + k0 + 64 * hf;
#pragma unroll
        for (int j = 0; j < 8; ++j) { const LAS float* p = s + (8 * j) * 33;
            *(v4u*)(dst + 8 * j) = (v4u){pk2(p[0], p[33]), pk2(p[66], p[99]), pk2(p[132], p[165]), pk2(p[198], p[231])}; }
    }
    LDS_WAIT(); asm volatile("" ::: "memory");
}
__device__ __forceinline__ void rms_row_to_bf16(const float* xrow, const float* w, bf16* orow, int lane) {
    const f32x4* xr = (const f32x4*)xrow + lane; const f32x4* wr = (const f32x4*)w + lane;
    f32x4 v[8]; float s = 0.f;
#pragma unroll
    for (int j = 0; j < 8; ++j) { v[j] = xr[64 * j]; s += (v[j].x * v[j].x + v[j].y * v[j].y) + (v[j].z * v[j].z + v[j].w * v[j].w); }
    const float rstd = 1.0f / sqrtf(wave_sum(s) * (1.0f / 2048.0f) + EPSF);
    v2u* o8 = (v2u*)orow + lane;
#pragma unroll
    for (int j = 0; j < 8; ++j) { const f32x4 ww = wr[64 * j]; v2u o; o.x = pk2(v[j].x * rstd * ww.x, v[j].y * rstd * ww.y); o.y = pk2(v[j].z * rstd * ww.z, v[j].w * rstd * ww.w); o8[64 * j] = o; }
}
__device__ __forceinline__ void phase0(Frame& F) {
    LAS float* scr = (LAS float*)(F.lds + F.wave * 16896);
    const int gw = F.bid * NWAVES + F.wave, NGW = F.G * NWAVES;
    bf16* WinT = (bf16*)(F.ws + WS_WIN); bf16* WsT = (bf16*)(F.ws + WS_WSM); float* Wrt = (float*)(F.ws + WS_WRT); bf16* WoutT = (bf16*)(F.ws + WS_WOUT);
    unsigned char* WguT = (unsigned char*)(F.ws + WS_WGU); unsigned char* WdT = (unsigned char*)(F.ws + WS_WD); bf16* XN1 = (bf16*)(F.ws + WS_XN1);
    constexpr int I_IN = 16 * 352, I_OUT = 32 * 64, I_GU = 32 * 2048, I_D = 32 * 1024, NITEMS = I_IN + I_OUT + I_GU + I_D;
    for (int it = gw; it < NITEMS; it += NGW) {
        int r = it;
        if (r < I_IN) { const int kb = r / 352, nb = r % 352, n0 = nb * 32; p0_transpose128<false>(F.w_in, WIN_LD, 2048, WinT, n0, n0 + (n0 >= 5120 ? 32 : 0), kb * 128, scr, F.lane); continue; } r -= I_IN;
        if (r < I_OUT) { const int kb = r >> 6, nb = r & 63; p0_transpose128<false>(F.w_out, 2048, 4096, WoutT, nb * 32, nb * 32, kb * 128, scr, F.lane); continue; } r -= I_OUT;
        if (r < I_GU) { const int e = r >> 11, rr = r & 2047, kb = rr >> 7, nb = rr & 127; p0_transpose128<true>(F.w_gate_up + (size_t)e * 2048 * 4096, 4096, 2048, WguT + (size_t)e * 4096 * 2048, nb * 32, nb * 32, kb * 128, scr, F.lane); continue; } r -= I_GU;
        { const int e = r >> 10, rr = r & 1023, kb = rr >> 6, nb = rr & 63; p0_transpose128<true>(F.w_down + (size_t)e * 2048 * 2048, 2048, 2048, WdT + (size_t)e * 2048 * 2048, nb * 32, nb * 32, kb * 128, scr, F.lane); }
    }
    for (int i = gw * 64 + F.lane; i < 64 * 2048; i += NGW * 64) { const int j = i >> 11, k = i & 2047;
        const int col = j < 32 ? 5120 + j : (j < 40 ? 11296 + (j - 32) : 11304 + (j - 40));
        WsT[i] = (bf16)(j < 48 ? f2bf(F.w_in[(size_t)k * WIN_LD + col]) : 0u); }
    for (int i = gw * 64 + F.lane; i < 2048 * 32; i += NGW * 64) Wrt[i] = F.norm2_w[i >> 5] * F.router_w[i];
    for (int m = gw; m < TT; m += NGW) rms_row_to_bf16(F.x + (size_t)m * DM, F.norm1_w, XN1 + (size_t)m * DM, F.lane);
}

__device__ __forceinline__ void p1_small(Frame& F) {
    const bf16* XN1 = (const bf16*)(F.ws + WS_XN1); const bf16* WsT = (const bf16*)(F.ws + WS_WSM); float* SMALL = (float*)(F.ws + WS_SMALL);
    const int gw = F.bid * NWAVES + F.wave, NGW = F.G * NWAVES, fr = F.lane & 15, fq = F.lane >> 4;
    for (int task = gw; task < TT / 16; task += NGW) {
        const int t0 = task * 16;
        f32x4 acc[4];
#pragma unroll
        for (int n = 0; n < 4; ++n) acc[n] = (f32x4){0.f, 0.f, 0.f, 0.f};
        const bf16* arow = XN1 + (size_t)(t0 + fr) * DM + 8 * fq; const bf16* brow = WsT + (size_t)fr * DM + 8 * fq;
#pragma unroll 16
        for (int ks = 0; ks < 64; ++ks) {
            const bf16x8 a = *(const bf16x8*)(arow + 32 * ks);
#pragma unroll
            for (int n = 0; n < 4; ++n) { const bf16x8 b = *(const bf16x8*)(brow + (size_t)n * 16 * DM + 32 * ks); acc[n] = __builtin_amdgcn_mfma_f32_16x16x32_bf16(a, b, acc[n], 0, 0, 0); }
        }
#pragma unroll
        for (int n = 0; n < 4; ++n)
#pragma unroll
            for (int r = 0; r < 4; ++r) SMALL[(size_t)(t0 + 4 * fq + r) * 64 + n * 16 + fr] = acc[n][r];
    }
}

__device__ __forceinline__ void unpack8(const v4u r, float (&f)[8]) { f[0] = bflo(r.x); f[1] = bfhi(r.x); f[2] = bflo(r.y); f[3] = bfhi(r.y); f[4] = bflo(r.z); f[5] = bfhi(r.z); f[6] = bflo(r.w); f[7] = bfhi(r.w); }

__device__ __forceinline__ void phase_conv(Frame& F) {
    const bf16* PROJ = (const bf16*)(F.ws + WS_PROJ); bf16* XC = (bf16*)(F.ws + WS_XC);
    constexpr int TB = 16, NCG = 384, NIT = (TT / TB) * NCG;
    for (int it = F.bid * (NWAVES * 64) + F.tid; it < NIT; it += F.G * NWAVES * 64) {
        const int cg = it % NCG, tb = it / NCG, ch = cg * 8, t0 = tb * TB; const bool seq0 = (t0 % SEQ) == 0;
        float w[4][8], bs[8];
#pragma unroll
        for (int j = 0; j < 4; ++j) { const f32x4 a = *(const f32x4*)(F.conv_w + j * 3072 + ch), b = *(const f32x4*)(F.conv_w + j * 3072 + ch + 4);
            w[j][0] = a.x; w[j][1] = a.y; w[j][2] = a.z; w[j][3] = a.w; w[j][4] = b.x; w[j][5] = b.y; w[j][6] = b.z; w[j][7] = b.w; }
        { const f32x4 a = *(const f32x4*)(F.conv_b + ch), b = *(const f32x4*)(F.conv_b + ch + 4); bs[0] = a.x; bs[1] = a.y; bs[2] = a.z; bs[3] = a.w; bs[4] = b.x; bs[5] = b.y; bs[6] = b.z; bs[7] = b.w; }
        const bf16* src = PROJ + (size_t)t0 * NPROJ + PC_XBC + ch;
        float r0[8], r1[8], r2[8], r3[8];
        if (seq0) {
#pragma unroll
            for (int i = 0; i < 8; ++i) { r0[i] = 0.f; r1[i] = 0.f; r2[i] = 0.f; }
        } else { unpack8(*(const v4u*)(src - 3 * (size_t)NPROJ), r0); unpack8(*(const v4u*)(src - 2 * (size_t)NPROJ), r1); unpack8(*(const v4u*)(src - (size_t)NPROJ), r2); }
        v4u rw[TB];
#pragma unroll
        for (int l = 0; l < TB; ++l) rw[l] = *(const v4u*)(src + (size_t)l * NPROJ);
#pragma unroll
        for (int l = 0; l < TB; ++l) {
            unpack8(rw[l], r3);
            float o[8];
#pragma unroll
            for (int i = 0; i < 8; ++i) { const float v = bs[i] + w[0][i] * r0[i] + w[1][i] * r1[i] + w[2][i] * r2[i] + w[3][i] * r3[i]; o[i] = siluf(v); r0[i] = r1[i]; r1[i] = r2[i]; r2[i] = r3[i]; }
            v4u ov; ov.x = pk2(o[0], o[1]); ov.y = pk2(o[2], o[3]); ov.z = pk2(o[4], o[5]); ov.w = pk2(o[6], o[7]);
            *(v4u*)(XC + (size_t)(t0 + l) * 3072 + ch) = ov;
        }
    }
}

constexpr int MX_PITCH = 272;
static_assert(true, "");
constexpr int MX_QM = 0, MX_KM = 34816, MX_KW = 69632, MX_VT = 104448, MX_SI = 121856, MX_VEC = 139264, MX_VECB = 3072, MX_NVEC = MX_VEC + 2 * MX_VECB, MX_SCAL = MX_NVEC + 512, MX_END = MX_SCAL + 64;
__device__ __forceinline__ unsigned cvt_pk_bf16_nop(float lo, float hi) { unsigned r; asm volatile("v_cvt_pk_bf16_f32 %0, %1, %2\n\ts_nop 1" : "=v"(r) : "v"(lo), "v"(hi)); return r; }
__device__ __forceinline__ int mx_sw(int row, int tbyte) { return row * MX_PITCH + ((((tbyte >> 4) ^ (row >> 3)) & 15) << 4) + (tbyte & 15); }
__device__ __forceinline__ bf16x8 lds_frag(const LAS unsigned char* img, int row, int kbyte) { return *(const LAS bf16x8*)(img + row * MX_PITCH + kbyte); }
static_assert(MX_END + 256 <= LDSCTL_OFF, "mixer LDS map");
template <bool ML> __device__ __forceinline__ void mixer_unit(Frame& F, int unit) {
    const bf16* PROJ = (const bf16*)(F.ws + WS_PROJ); const bf16* XC = (const bf16*)(F.ws + WS_XC); const float* SMALL = (const float*)(F.ws + WS_SMALL);
    bf16* YMIX = (bf16*)(F.ws + WS_YMIX); float* SSQ = (float*)(F.ws + WS_SSQ);
    const int w = F.wave, fr = F.lane & 15, fq = F.lane >> 4, tid = F.tid;
    const int b = unit >> 5, tok0 = b * SEQ, hd = unit & 31, grp = hd >> 3, mh = (unit & 31) >> 2, vq = unit & 3;
    const float qs = 0.08838834764831845f;
    LAS unsigned char* QM = F.lds + MX_QM; LAS unsigned char* KM = F.lds + MX_KM; LAS unsigned char* KW = F.lds + MX_KW; LAS unsigned char* VT = F.lds + MX_VT; LAS unsigned char* SI = F.lds + MX_SI;
    LAS float* exch = (LAS float*)(F.lds + MX_VEC + (w >> 2) * MX_VECB + 1024) + (w & 3) * 32;
    LAS float* nvec = (LAS float*)(F.lds + MX_NVEC); LAS float* scal = (LAS float*)(F.lds + MX_SCAL);
    const int fr3 = fr >> 3;
    int vtb[2];
#pragma unroll
    for (int p = 0; p < 2; ++p) vtb[p] = fr * MX_PITCH + ((fq ^ ((2 * p) | fr3)) << 4);
    int vpb[2][2];
#pragma unroll
    for (int p = 0; p < 2; ++p)
#pragma unroll
        for (int h = 0; h < 2; ++h) vpb[p][h] = fr * MX_PITCH + (((((fq >> 1) | (2 * h)) ^ ((2 * p) | fr3))) << 4) + 8 * (fq & 1);
    const int kwb = (16 * w + fr) * MX_PITCH + ((fq ^ ((2 * (w & 1)) | fr3)) << 4), kwh = w >> 1;

    const bf16* qsrc; const bf16* ksrc; const bf16* vsrc; int ld;
    if (ML) { qsrc = PROJ + PC_Q + mh * 128; ksrc = PROJ + PC_K + mh * 128; vsrc = PROJ + PC_V + mh * 256 + vq * 64; ld = NPROJ; }
    else { qsrc = XC + 2560 + grp * 128; ksrc = XC + 2048 + grp * 128; vsrc = XC + hd * 64; ld = 3072; }
    const float c_a = ML ? 0.f : -expf(F.a_log[hd]), c_dtb = ML ? 0.f : F.dt_bias[hd], c_D = ML ? 0.f : F.d_skip[hd], c_ib = ML ? F.i_bias[mh] : 0.f, c_fb = ML ? F.f_bias[mh] : 0.f;
    float mprev = 0.f;
    f32x4 sacc[4]; float nreg = 0.f;
#pragma unroll
    for (int j = 0; j < 4; ++j) sacc[j] = (f32x4){0.f, 0.f, 0.f, 0.f};
    v4u pq[4], pk[4], pv[2];
    float vA0 = 0.f, vA1 = 0.f, vB0 = 0.f, vB1 = 0.f, vC0 = 0.f, vC1 = 0.f, vD0 = 0.f, vD1 = 0.f, vE0 = 0.f, vE1 = 0.f, vG0 = 0.f, vG1 = 0.f, vSA = 0.f, vSG = 0.f;
    float sl0 = 0.f, sl1 = 0.f, sl2 = 0.f, sl3 = 0.f;
#define MX_SCAN_L(c) do { if (w == 0) { const size_t tt = (size_t)(tok0 + 128 * (c) + 2 * F.lane); \
        if (!ML) { sl0 = SMALL[tt * 64 + hd]; sl1 = SMALL[(tt + 1) * 64 + hd]; } \
        else { sl0 = SMALL[tt * 64 + 32 + mh]; sl1 = SMALL[(tt + 1) * 64 + 32 + mh]; sl2 = SMALL[tt * 64 + 40 + mh]; sl3 = SMALL[(tt + 1) * 64 + 40 + mh]; } } } while (0)
#define MX_SOFTPLUS(x) ((x) > 20.f ? (x) : __logf(1.0f + __expf(x)))
#define MX_LOGSIG(x) (fminf((x), 0.f) - __logf(1.0f + __expf(-fabsf(x))))
#define MX_SCAN_A(c) do { if (w == 0) { \
        if (!ML) { const float d0 = MX_SOFTPLUS(sl0 + c_dtb), d1 = MX_SOFTPLUS(sl1 + c_dtb); \
            const float x0 = d0 * c_a, x1 = d1 * c_a; float incl = x0 + x1; \
            _Pragma("unroll") for (int d = 1; d < 64; d <<= 1) { const float t_ = __shfl_up(incl, d); if (F.lane >= d) incl += t_; } \
            const float cum1 = incl, cum0 = incl - x1, tot = __shfl(incl, 63); \
            vA0 = -cum0; vA1 = -cum1; vB0 = -cum0; vB1 = -cum1; vC0 = d0; vC1 = d1; vD0 = __expf(cum0); vD1 = __expf(cum1); vE0 = d0 * __expf(tot - cum0); vE1 = d1 * __expf(tot - cum1); vSA = __expf(tot); vSG = 1.0f; \
        } else { const float li0 = sl0 + c_ib, li1 = sl1 + c_ib; \
            const float x0 = MX_LOGSIG(sl2 + c_fb), x1 = MX_LOGSIG(sl3 + c_fb); float incl = x0 + x1; \
            _Pragma("unroll") for (int d = 1; d < 64; d <<= 1) { const float t_ = __shfl_up(incl, d); if (F.lane >= d) incl += t_; } \
            const float cum1 = incl, cum0 = incl - x1, btot = __shfl(incl, 63); \
            const float dd0 = li0 - cum0, dd1 = li1 - cum1; float im = fmaxf(dd0, dd1); \
            _Pragma("unroll") for (int d = 1; d < 64; d <<= 1) { const float t_ = __shfl_up(im, d); if (F.lane >= d) im = fmaxf(im, t_); } \
            float pm = __shfl_up(im, 1); if (F.lane == 0) pm = -3.0e38f; const float pmax0 = fmaxf(pm, dd0), pmax1 = im, pm127 = __shfl(im, 63); \
            const float M0 = fmaxf(mprev, pmax0), M1 = fmaxf(mprev, pmax1); \
            vA0 = dd0; vA1 = dd1; vB0 = M0; vB1 = M1; vD0 = qs * __expf(mprev - M0); vD1 = qs * __expf(mprev - M1); vG0 = __expf(-(cum0 + M0)); vG1 = __expf(-(cum1 + M1)); \
            const float mloc = btot + pm127, mnew = fmaxf(btot + mprev, mloc); \
            vSA = __expf(btot + mprev - mnew); vSG = __expf(mloc - mnew); vE0 = __expf(dd0 - pm127) * vSG; vE1 = __expf(dd1 - pm127) * vSG; mprev = mnew; } } } while (0)
#define MX_SCAN_B(c) do { if (w == 0) { \
        LAS float* vb = (LAS float*)(F.lds + MX_VEC + ((c) & 1) * MX_VECB); const int l0 = 2 * F.lane; \
        *(LAS f32x2*)(vb + l0) = (f32x2){vA0, vA1}; *(LAS f32x2*)(vb + 128 + l0) = (f32x2){vB0, vB1}; if (!ML) *(LAS f32x2*)(vb + 256 + l0) = (f32x2){vC0, vC1}; \
        *(LAS f32x2*)(vb + 384 + l0) = (f32x2){vD0, vD1}; *(LAS f32x2*)(vb + 512 + l0) = (f32x2){vE0, vE1}; if (ML) *(LAS f32x2*)(vb + 640 + l0) = (f32x2){vG0, vG1}; \
        if (F.lane == 0) { scal[2 * ((c) & 1)] = vSA; scal[2 * ((c) & 1) + 1] = vSG; } } } while (0)
#define MX_SCAN(c) do { MX_SCAN_L(c); MX_SCAN_A(c); MX_SCAN_B(c); } while (0)
#define MX_PREFETCH(c) do { const size_t tb_ = (size_t)(tok0 + 128 * (c)); \
        _Pragma("unroll") for (int i = 0; i < 2; ++i) { const int pid = tid + 512 * i, a2 = pid >> 4, k8 = pid & 15; \
            pq[2 * i] = *(const v4u*)(qsrc + (tb_ + 2 * a2) * ld + 8 * k8); pq[2 * i + 1] = *(const v4u*)(qsrc + (tb_ + 2 * a2 + 1) * ld + 8 * k8); \
            pk[2 * i] = *(const v4u*)(ksrc + (tb_ + 2 * a2) * ld + 8 * k8); pk[2 * i + 1] = *(const v4u*)(ksrc + (tb_ + 2 * a2 + 1) * ld + 8 * k8); } \
        { const int a2 = tid >> 3, v8 = tid & 7; pv[0] = *(const v4u*)(vsrc + (tb_ + 2 * a2) * ld + 8 * v8); pv[1] = *(const v4u*)(vsrc + (tb_ + 2 * a2 + 1) * ld + 8 * v8); } } while (0)
#define MX_WRITE(c) do { const LAS float* vb = (const LAS float*)(F.lds + MX_VEC + ((c) & 1) * MX_VECB); \
        _Pragma("unroll") for (int i = 0; i < 2; ++i) { const int pid = tid + 512 * i, a2 = pid >> 4, k8 = pid & 15, l = 2 * a2; \
            *(LAS v4u*)(QM + l * MX_PITCH + 16 * k8) = pq[2 * i]; *(LAS v4u*)(QM + (l + 1) * MX_PITCH + 16 * k8) = pq[2 * i + 1]; \
            *(LAS v4u*)(KM + l * MX_PITCH + 16 * k8) = pk[2 * i]; *(LAS v4u*)(KM + (l + 1) * MX_PITCH + 16 * k8) = pk[2 * i + 1]; \
            float f0[8], f1[8]; unpack8(pk[2 * i], f0); unpack8(pk[2 * i + 1], f1); const f32x2 wl = *(const LAS f32x2*)(vb + 512 + l); \
            _Pragma("unroll") for (int e = 0; e < 8; ++e) *(LAS unsigned*)(KW + mx_sw(8 * k8 + e, 2 * l)) = pg8::cvt_pk_bf16(f0[e] * wl.x, f1[e] * wl.y); } \
        { const int a2 = tid >> 3, v8 = tid & 7, l = 2 * a2; const v4u r0 = pv[0], r1 = pv[1]; LAS unsigned char* vp_ = VT + mx_sw(8 * v8, 2 * l); \
            *(LAS unsigned*)(vp_ + 0 * MX_PITCH) = (r0.x & 0xffffu) | (r1.x << 16); *(LAS unsigned*)(vp_ + 1 * MX_PITCH) = (r0.x >> 16) | (r1.x & 0xffff0000u); \
            *(LAS unsigned*)(vp_ + 2 * MX_PITCH) = (r0.y & 0xffffu) | (r1.y << 16); *(LAS unsigned*)(vp_ + 3 * MX_PITCH) = (r0.y >> 16) | (r1.y & 0xffff0000u); \
            *(LAS unsigned*)(vp_ + 4 * MX_PITCH) = (r0.z & 0xffffu) | (r1.z << 16); *(LAS unsigned*)(vp_ + 5 * MX_PITCH) = (r0.z >> 16) | (r1.z & 0xffff0000u); \
            *(LAS unsigned*)(vp_ + 6 * MX_PITCH) = (r0.w & 0xffffu) | (r1.w << 16); *(LAS unsigned*)(vp_ + 7 * MX_PITCH) = (r0.w >> 16) | (r1.w & 0xffff0000u); } \
        _Pragma("unroll") for (int j = 0; j < 4; ++j) { v2u sv; sv.x = pg8::cvt_pk_bf16(sacc[j][0], sacc[j][1]); sv.y = pg8::cvt_pk_bf16(sacc[j][2], sacc[j][3]); *(LAS v2u*)(SI + (16 * j + fr) * MX_PITCH + (16 * w + 4 * fq) * 2) = sv; } \
        if (ML && fq == 0) nvec[16 * w + fr] = nreg; } while (0)
    const int gcol = (ML ? PC_O + mh * 256 + vq * 64 : PC_Z + hd * 64) + 16 * (F.lane & 3);
    LAS float* nwl = (LAS float*)(F.lds + MX_END);
    if (tid < 64) nwl[tid] = ML ? F.ml_norm_w[mh * 256 + vq * 64 + tid] : F.ssd_norm_w[hd * 64 + tid];
    v4u zc0 = (v4u){0u, 0u, 0u, 0u}, zc1 = zc0;
    { const bf16* zp = PROJ + (size_t)(tok0 + 16 * w + (F.lane >> 2)) * NPROJ + gcol; zc0 = *(const v4u*)zp; zc1 = *(const v4u*)(zp + 8); }
    MX_SCAN(0);
    MX_PREFETCH(0);
    __syncthreads();
    MX_WRITE(0);
    __syncthreads();
    for (int c = 0; c < SEQ / 128; ++c) {
        const LAS float* vb = (const LAS float*)(F.lds + MX_VEC + (c & 1) * MX_VECB);
        const bool more = (c + 1 < SEQ / 128);
        if (more) { MX_SCAN_L(c + 1); MX_PREFETCH(c + 1); }
        bf16x8 qf[4];
#pragma unroll
        for (int ks = 0; ks < 4; ++ks) qf[ks] = lds_frag(QM, 16 * w + fr, 64 * ks + 16 * fq);
        const float mlv = vb[128 + 16 * w + fr];
        float dsum = 0.f;
        f32x4 y1[4];
#pragma unroll
        for (int j = 0; j < 4; ++j) y1[j] = (f32x4){0.f, 0.f, 0.f, 0.f};
        const f32x4 rs4 = *(const LAS f32x4*)(vb + 384 + 16 * w + 4 * fq);
#pragma unroll
        for (int ks = 0; ks < 4; ++ks) { bf16x8 sf[4];
#pragma unroll
            for (int j = 0; j < 4; ++j) sf[j] = lds_frag(SI, 16 * j + fr, 64 * ks + 16 * fq);
#pragma unroll
            for (int j = 0; j < 4; ++j) y1[j] = __builtin_amdgcn_mfma_f32_16x16x32_bf16(qf[ks], sf[j], y1[j], 0, 0, 0); }
#pragma unroll
        for (int j = 0; j < 4; ++j) y1[j] = y1[j] * rs4;
        __builtin_amdgcn_sched_barrier(0);
#pragma unroll 1
        for (int k2 = 0; 2 * k2 <= w; ++k2) {
            unsigned pw[4];
#pragma unroll
            for (int h = 0; h < 2; ++h) {
                const int si = 2 * k2 + h;
                f32x4 acc = (f32x4){0.f, 0.f, 0.f, 0.f};
#pragma unroll
                for (int ks = 0; ks < 4; ++ks) acc = __builtin_amdgcn_mfma_f32_16x16x32_bf16(lds_frag(KM, 16 * si + fr, 64 * ks + 16 * fq), qf[ks], acc, 0, 0, 0);
                const f32x4 e4 = *(const LAS f32x4*)(vb + 16 * si + 4 * fq); f32x4 x4 = (f32x4){qs, qs, qs, qs}; if (!ML) x4 = *(const LAS f32x4*)(vb + 256 + 16 * si + 4 * fq);
                float p[4];
#pragma unroll
                for (int r = 0; r < 4; ++r) { const float v = acc[r] * __expf(e4[r] - mlv) * x4[r]; const bool ok = (si < w) || (si == w && 4 * fq + r <= fr); p[r] = ok ? v : 0.f; }
                if (ML) dsum += (p[0] + p[1]) + (p[2] + p[3]);
                pw[2 * h] = cvt_pk_bf16_nop(p[0], p[1]); pw[2 * h + 1] = cvt_pk_bf16_nop(p[2], p[3]);
            }
            HWAIT();
            const v4u pwv = (v4u){pw[0], pw[1], pw[2], pw[3]}; const bf16x8 pf = __builtin_bit_cast(bf16x8, pwv);
#pragma unroll
            for (int j = 0; j < 4; ++j) { const int ho = j * 16 * MX_PITCH + ((k2 ^ (j >> 1)) << 6); const v2u lo = *(const LAS v2u*)(VT + vpb[j & 1][0] + ho), hi = *(const LAS v2u*)(VT + vpb[j & 1][1] + ho); const v4u vw = (v4u){lo.x, lo.y, hi.x, hi.y};
                y1[j] = __builtin_amdgcn_mfma_f32_16x16x32_bf16(pf, __builtin_bit_cast(bf16x8, vw), y1[j], 0, 0, 0); }
            HWAIT();
        }
        HSYNC();
        __builtin_amdgcn_sched_barrier(0);
        __builtin_amdgcn_sched_barrier(0);
        if (ML) {
            dsum += __shfl_xor(dsum, 16); dsum += __shfl_xor(dsum, 32);
            float d2 = 0.f;
#pragma unroll
            for (int ks = 0; ks < 4; ++ks) { float qv[8]; unpack8(__builtin_bit_cast(v4u, qf[ks]), qv); const f32x4 n0 = *(const LAS f32x4*)(nvec + 32 * ks + 8 * fq), n1 = *(const LAS f32x4*)(nvec + 32 * ks + 8 * fq + 4);
                d2 += qv[0] * n0.x + qv[1] * n0.y + qv[2] * n0.z + qv[3] * n0.w + qv[4] * n1.x + qv[5] * n1.y + qv[6] * n1.z + qv[7] * n1.w; }
            d2 += __shfl_xor(d2, 16); d2 += __shfl_xor(d2, 32);
            if (fq == 0) { exch[fr] = dsum; exch[16 + fr] = d2; }
        }
        HSYNC();
        __builtin_amdgcn_sched_barrier(0);
        LAS float* stg = (LAS float*)(QM + 16 * w * MX_PITCH);
        if (ML) { const f32x4 fl4 = *(const LAS f32x4*)(vb + 640 + 16 * w + 4 * fq); const f32x4 dA = *(const LAS f32x4*)(exch + 4 * fq), dB = *(const LAS f32x4*)(exch + 16 + 4 * fq);
#pragma unroll
            for (int r = 0; r < 4; ++r) { const float den = fmaxf(fabsf(dA[r] + rs4[r] * dB[r]), fl4[r]); const float inv = __builtin_amdgcn_rcpf(den);
#pragma unroll
                for (int j = 0; j < 4; ++j) stg[(4 * fq + r) * 68 + 16 * j + fr] = y1[j][r] * inv; }
        } else {
#pragma unroll
            for (int j = 0; j < 4; ++j) { const v2u xw = *(const LAS v2u*)(VT + mx_sw(16 * j + fr, 32 * w + 8 * fq)); const float xs[4] = {bflo(xw.x), bfhi(xw.x), bflo(xw.y), bfhi(xw.y)};
#pragma unroll
                for (int r = 0; r < 4; ++r) stg[(4 * fq + r) * 68 + 16 * j + fr] = y1[j][r] + c_D * xs[r]; }
        }
        {   const int erow = F.lane >> 2, ecs = F.lane & 3; const size_t trow = (size_t)(tok0 + 128 * c + 16 * w + erow);
            float yv[16];
#pragma unroll
            for (int i = 0; i < 4; ++i) { const f32x4 t4 = *(const LAS f32x4*)(stg + erow * 68 + 16 * ecs + 4 * i); yv[4 * i] = t4.x; yv[4 * i + 1] = t4.y; yv[4 * i + 2] = t4.z; yv[4 * i + 3] = t4.w; }
            float zf[16]; { float t8[8]; unpack8(zc0, t8);
#pragma unroll
                for (int i = 0; i < 8; ++i) zf[i] = t8[i]; unpack8(zc1, t8);
#pragma unroll
                for (int i = 0; i < 8; ++i) zf[8 + i] = t8[i]; }
            if (!ML) {
#pragma unroll
                for (int i = 0; i < 16; ++i) yv[i] = yv[i] * zf[i] * __builtin_amdgcn_rcpf(1.0f + __expf(-zf[i])); }
            float ss = 0.f;
#pragma unroll
            for (int i = 0; i < 16; ++i) ss += yv[i] * yv[i];
            ss += __shfl_xor(ss, 1); ss += __shfl_xor(ss, 2);
            if (ecs == 0) SSQ[(ML ? (size_t)TT * 32 : 0) + trow * 32 + (ML ? mh * 4 + vq : hd)] = ss;
#pragma unroll
            for (int i = 0; i < 4; ++i) { const f32x4 w4 = *(const LAS f32x4*)(nwl + 16 * ecs + 4 * i);
                yv[4 * i] *= w4.x; yv[4 * i + 1] *= w4.y; yv[4 * i + 2] *= w4.z; yv[4 * i + 3] *= w4.w; }
            if (ML) {
#pragma unroll
                for (int i = 0; i < 16; ++i) yv[i] *= __builtin_amdgcn_rcpf(1.0f + __expf(-zf[i])); }
            bf16* yp = YMIX + trow * 4096 + (ML ? 2048 + mh * 256 + vq * 64 : hd * 64) + 16 * ecs;
            *(v4u*)yp = (v4u){pg8::cvt_pk_bf16(yv[0], yv[1]), pg8::cvt_pk_bf16(yv[2], yv[3]), pg8::cvt_pk_bf16(yv[4], yv[5]), pg8::cvt_pk_bf16(yv[6], yv[7])};
            *(v4u*)(yp + 8) = (v4u){pg8::cvt_pk_bf16(yv[8], yv[9]), pg8::cvt_pk_bf16(yv[10], yv[11]), pg8::cvt_pk_bf16(yv[12], yv[13]), pg8::cvt_pk_bf16(yv[14], yv[15])};
            if (more) { const bf16* zp = PROJ + (size_t)(tok0 + 128 * (c + 1) + 16 * w + (F.lane >> 2)) * NPROJ + gcol; zc0 = *(const v4u*)zp; zc1 = *(const v4u*)(zp + 8); }
        }
        __builtin_amdgcn_sched_barrier(0);
        const float sa = scal[2 * (c & 1)];
#pragma unroll
        for (int j = 0; j < 4; ++j) sacc[j] = sacc[j] * sa;
        float nsum = 0.f;
#pragma unroll
        for (int ks = 0; ks < 4; ++ks) { const bf16x8 kf = *(const LAS bf16x8*)(KW + kwb + ((ks ^ kwh) << 6)); bf16x8 vf[4];
#pragma unroll
            for (int j = 0; j < 4; ++j) vf[j] = *(const LAS bf16x8*)(VT + vtb[j & 1] + j * 16 * MX_PITCH + ((ks ^ (j >> 1)) << 6));
            if (ML) { float kv[8]; unpack8(__builtin_bit_cast(v4u, kf), kv); nsum += ((kv[0] + kv[1]) + (kv[2] + kv[3])) + ((kv[4] + kv[5]) + (kv[6] + kv[7])); }
#pragma unroll
            for (int j = 0; j < 4; ++j) sacc[j] = __builtin_amdgcn_mfma_f32_16x16x32_bf16(kf, vf[j], sacc[j], 0, 0, 0); }
        if (ML) { nsum += __shfl_xor(nsum, 16); nsum += __shfl_xor(nsum, 32); nreg = nreg * sa + nsum; }
        if (more) { MX_SCAN_A(c + 1); }
        __syncthreads();
        if (more) { MX_SCAN_B(c + 1); }
        __syncthreads();
        if (more) { MX_WRITE(c + 1); }
        __syncthreads();
    }
#undef MX_SCAN
#undef MX_SCAN_A
#undef MX_SCAN_L
#undef MX_SOFTPLUS
#undef MX_LOGSIG
#undef MX_SCAN_B
#undef MX_PREFETCH
#undef MX_WRITE
}
__device__ __forceinline__ void phase_mixer(Frame& F) {
    for (int unit = F.bid; unit < 256; unit += F.G) { mixer_unit<false>(F, unit); mixer_unit<true>(F, unit); }
}

__device__ __forceinline__ void phase3(Frame& F) {
    const bf16* PROJ = (const bf16*)(F.ws + WS_PROJ); bf16* YMIX = (bf16*)(F.ws + WS_YMIX); const float* SSQ = (const float*)(F.ws + WS_SSQ);
    const int gw = F.bid * NWAVES + F.wave, NGW = F.G * NWAVES;
    for (int t = gw; t < TT; t += NGW) {
        bf16* yrow = YMIX + (size_t)t * 4096;
#pragma unroll
        for (int j = 0; j < 8; ++j) {
            const int c0 = (j * 64 + F.lane) * 8;
            float y[8]; unpack8(*(const v4u*)(yrow + c0), y);
            float o[8];
            if (j < 4) {
                const int g = c0 >> 9; const f32x4 s0 = *(const f32x4*)(SSQ + (size_t)t * 32 + g * 8), s1 = *(const f32x4*)(SSQ + (size_t)t * 32 + g * 8 + 4);
                const float ms = ((s0.x + s0.y) + (s0.z + s0.w) + (s1.x + s1.y) + (s1.z + s1.w)) * (1.0f / 512.0f);
                const float rs = 1.0f / sqrtf(ms + EPSF);
                const f32x4 w0 = *(const f32x4*)(F.ssd_norm_w + c0), w1 = *(const f32x4*)(F.ssd_norm_w + c0 + 4);
                o[0] = y[0] * rs * w0.x; o[1] = y[1] * rs * w0.y; o[2] = y[2] * rs * w0.z; o[3] = y[3] * rs * w0.w;
                o[4] = y[4] * rs * w1.x; o[5] = y[5] * rs * w1.y; o[6] = y[6] * rs * w1.z; o[7] = y[7] * rs * w1.w;
            } else {
                const int cc = c0 - 2048, h = cc >> 8; const f32x4 s0 = *(const f32x4*)(SSQ + (size_t)TT * 32 + (size_t)t * 32 + h * 4);
                const float ms = ((s0.x + s0.y) + (s0.z + s0.w)) * (1.0f / 256.0f);
                const float rs = 1.0f / sqrtf(ms + EPSF);
                const f32x4 w0 = *(const f32x4*)(F.ml_norm_w + cc), w1 = *(const f32x4*)(F.ml_norm_w + cc + 4);
                float og[8]; unpack8(*(const v4u*)(PROJ + (size_t)t * NPROJ + PC_O + cc), og);
                const float wv[8] = {w0.x, w0.y, w0.z, w0.w, w1.x, w1.y, w1.z, w1.w};
#pragma unroll
                for (int i = 0; i < 8; ++i) o[i] = y[i] * rs * wv[i] * __builtin_amdgcn_rcpf(1.0f + __expf(-og[i]));
            }
            v4u ov; ov.x = pk2(o[0], o[1]); ov.y = pk2(o[2], o[3]); ov.z = pk2(o[4], o[5]); ov.w = pk2(o[6], o[7]);
            *(v4u*)(yrow + c0) = ov;
        }
    }
}

__device__ __forceinline__ void phase5(Frame& F) {
    const float* H2 = (const float*)(F.ws + WS_H2); const float* Wrt = (const float*)(F.ws + WS_WRT); bf16* XN2 = (bf16*)(F.ws + WS_XN2);
    int* EIDX = (int*)(F.ws + WS_ROUTE); int* RANK = EIDX + TT * 4;
    int* TOKL = (int*)(F.ws + WS_XG); float* GATEL = (float*)(F.ws + WS_XG + 4 * MiB);
    LAS float* xT = (LAS float*)(F.lds + F.wave * 8192); LAS float* lg = (LAS float*)(F.lds + 65536 + F.wave * 1024);
    LAS int* cntl = (LAS int*)(F.lds + 73728); LAS int* baseg = cntl + 32;
    const int gw = F.bid * NWAVES + F.wave, NGW = F.G * NWAVES, ntask = TT / 8, iters = (ntask + NGW - 1) / NGW;
    for (int itx = 0; itx < iters; ++itx) {
        const int task = itx * NGW + gw; const bool valid = task < ntask; const int t0 = task * 8;
        if (F.tid < 32) cntl[F.tid] = 0;
        __syncthreads();
        float rstd[8]; int me[4] = {0, 0, 0, 0}, mr[4] = {0, 0, 0, 0}; float mg[4] = {0.f, 0.f, 0.f, 0.f};
#pragma unroll
        for (int k = 0; k < 8; ++k) rstd[k] = 0.f;
        float acc[8], ssq[8];
#pragma unroll
        for (int k = 0; k < 8; ++k) { acc[k] = 0.f; ssq[k] = 0.f; }
        const int e = F.lane & 31, dh = F.lane >> 5;
        LAS float* wl = (LAS float*)(F.lds + 81920);
        for (int dc = 0; dc < 8; ++dc) {
            __syncthreads();
#pragma unroll
            for (int q = 0; q < 4; ++q) ((LAS f32x4*)wl)[F.tid + 512 * q] = ((const f32x4*)(Wrt + (size_t)dc * 256 * 32))[F.tid + 512 * q];
            if (valid) {
                f32x4 xk[8];
#pragma unroll
                for (int k = 0; k < 8; ++k) { xk[k] = *(const f32x4*)(H2 + (size_t)(t0 + k) * DM + dc * 256 + 4 * F.lane); ssq[k] += (xk[k].x * xk[k].x + xk[k].y * xk[k].y) + (xk[k].z * xk[k].z + xk[k].w * xk[k].w); }
#pragma unroll
                for (int jj = 0; jj < 4; ++jj) { LAS float* dp = xT + (jj * 64 + F.lane) * 8;
                    *(LAS f32x4*)dp = (f32x4){xk[0][jj], xk[1][jj], xk[2][jj], xk[3][jj]}; *(LAS f32x4*)(dp + 4) = (f32x4){xk[4][jj], xk[5][jj], xk[6][jj], xk[7][jj]}; }
            }
            __syncthreads();
            if (valid) {
                const LAS float* xp = xT + dh * 128 * 8;
#pragma unroll 8
                for (int i = 0; i < 128; ++i) { const float w = wl[(4 * (i & 63) + 2 * dh + (i >> 6)) * 32 + e];     const f32x4 xa = *(const LAS f32x4*)(xp + i * 8), xb = *(const LAS f32x4*)(xp + i * 8 + 4);
                    acc[0] += w * xa.x; acc[1] += w * xa.y; acc[2] += w * xa.z; acc[3] += w * xa.w; acc[4] += w * xb.x; acc[5] += w * xb.y; acc[6] += w * xb.z; acc[7] += w * xb.w; }
            }
        }
        if (valid) {
            const float rb = F.router_b[e];
#pragma unroll
            for (int k = 0; k < 8; ++k) { rstd[k] = 1.0f / sqrtf(wave_sum(ssq[k]) * (1.0f / 2048.0f) + EPSF);
                const float v = (acc[k] + __shfl_xor(acc[k], 32)) * rstd[k] + rb; if (F.lane < 32) lg[k * 32 + e] = v; }
            LDS_WAIT(); asm volatile("" ::: "memory");
            if (F.lane < 8) {
                const LAS float* lp = lg + F.lane * 32; float bv[4]; int bi[4] = {-1, -1, -1, -1};
#pragma unroll
                for (int p = 0; p < 4; ++p) { float best = -3.0e38f; int bidx = 0;
                    for (int q = 0; q < 32; ++q) { const float v = lp[q]; const bool taken = (q == bi[0]) | (q == bi[1]) | (q == bi[2]) | (q == bi[3]); if (!taken && v > best) { best = v; bidx = q; } }
                    bv[p] = best; bi[p] = bidx; }
                const float p1 = expf(bv[1] - bv[0]), p2 = expf(bv[2] - bv[0]), p3 = expf(bv[3] - bv[0]); const float inv = 1.0f / (1.0f + p1 + p2 + p3);
                mg[0] = inv; mg[1] = p1 * inv; mg[2] = p2 * inv; mg[3] = p3 * inv;
#pragma unroll
                for (int p = 0; p < 4; ++p) { me[p] = bi[p]; mr[p] = __hip_atomic_fetch_add(cntl + bi[p], 1, __ATOMIC_RELAXED, __HIP_MEMORY_SCOPE_WORKGROUP); }
            }
        }
        __syncthreads();
        if (F.tid < 32) { const int c = cntl[F.tid]; int gb = 0; if (c > 0) gb = (int)__hip_atomic_fetch_add((unsigned*)(F.ctl + CW_CNT + 64 * F.tid), (unsigned)c, RLX_AGENT); baseg[F.tid] = gb; }
        __syncthreads();
        if (valid) {
            if (F.lane < 8) { const size_t t = (size_t)(t0 + F.lane);
#pragma unroll
                for (int p = 0; p < 4; ++p) { const int rk = baseg[me[p]] + mr[p]; EIDX[t * 4 + p] = me[p]; RANK[t * 4 + p] = rk; TOKL[(size_t)me[p] * TT + rk] = (int)t; GATEL[(size_t)me[p] * TT + rk] = mg[p]; } }
#pragma unroll
            for (int k = 0; k < 8; ++k) { const f32x4* xr = (const f32x4*)(H2 + (size_t)(t0 + k) * DM) + F.lane; const f32x4* wr = (const f32x4*)F.norm2_w + F.lane; int* o4 = (int*)((unsigned char*)XN2 + (size_t)(t0 + k) * DM) + F.lane;
#pragma unroll
                for (int j = 0; j < 8; ++j) { const f32x4 v = xr[64 * j], ww = wr[64 * j]; int o = __builtin_amdgcn_cvt_pk_fp8_f32(v.x * rstd[k] * ww.x, v.y * rstd[k] * ww.y, 0, false); o = __builtin_amdgcn_cvt_pk_fp8_f32(v.z * rstd[k] * ww.z, v.w * rstd[k] * ww.w, o, true); o4[64 * j] = o; } }
        }
        __syncthreads();
    }
}
__device__ __forceinline__ int build_moe_tab(Frame& F) {
    LAS unsigned char* tab = (LAS unsigned char*)(F.lds + TAB_OFF); LAS int* tinfo = (LAS int*)(F.lds + TAB_OFF + 320);
    if (F.tid < 32) { const int c = (int)__hip_atomic_load((unsigned*)(F.ctl + CW_CNT + 64 * F.tid), RLX_AGENT); tinfo[4 + F.tid] = (c + 255) >> 8; tinfo[72 + F.tid] = c; }
    __syncthreads();
    if (F.tid == 0) { int a = 0; for (int e = 0; e < 32; ++e) { const int n = tinfo[4 + e]; tinfo[40 + e] = a; for (int j = 0; j < n; ++j) tab[a + j] = (unsigned char)e; a += n; } tinfo[0] = a; }
    __syncthreads();
    return tinfo[0];
}
__device__ __forceinline__ void phase8(Frame& F) {
    const float* H2 = (const float*)(F.ws + WS_H2); const bf16* YR = (const bf16*)(F.ws + WS_YR);
    const int* EIDX = (const int*)(F.ws + WS_ROUTE); const int* RANK = EIDX + TT * 4; (void)build_moe_tab(F); const LAS int* tinfo = (const LAS int*)(F.lds + TAB_OFF + 320);
    const int gw = F.bid * NWAVES + F.wave, NGW = F.G * NWAVES;
    for (int t = gw; t < TT; t += NGW) {
        int slot = 0; if (F.lane < 4) slot = 256 * tinfo[40 + EIDX[(size_t)t * 4 + F.lane]] + RANK[(size_t)t * 4 + F.lane];
        int sl[4]; sl[0] = __shfl(slot, 0); sl[1] = __shfl(slot, 1); sl[2] = __shfl(slot, 2); sl[3] = __shfl(slot, 3);
        float v[4][8]; float ss = 0.f;
#pragma unroll
        for (int j = 0; j < 4; ++j) { const int pz = F.lane + 64 * j; const f32x4 a = *(const f32x4*)(H2 + (size_t)t * DM + 8 * pz), b = *(const f32x4*)(H2 + (size_t)t * DM + 8 * pz + 4);
            v[j][0] = a.x; v[j][1] = a.y; v[j][2] = a.z; v[j][3] = a.w; v[j][4] = b.x; v[j][5] = b.y; v[j][6] = b.z; v[j][7] = b.w; }
#pragma unroll
        for (int k = 0; k < 4; ++k)
#pragma unroll
            for (int j = 0; j < 4; ++j) { float f[8]; unpack8(*((const v4u*)(YR + (size_t)sl[k] * DM) + F.lane + 64 * j), f);
#pragma unroll
                for (int i = 0; i < 8; ++i) v[j][i] += f[i]; }
#pragma unroll
        for (int j = 0; j < 4; ++j)
#pragma unroll
            for (int i = 0; i < 8; ++i) ss += v[j][i] * v[j][i];
        const float rstd = 1.0f / sqrtf(wave_sum(ss) * (1.0f / 2048.0f) + EPSF);
#pragma unroll
        for (int j = 0; j < 4; ++j) { const int pz = F.lane + 64 * j; const f32x4 w0 = *(const f32x4*)(F.final_norm_w + 8 * pz), w1 = *(const f32x4*)(F.final_norm_w + 8 * pz + 4);
            *(f32x4*)(F.out + (size_t)t * DM + 8 * pz) = (f32x4){v[j][0] * rstd * w0.x, v[j][1] * rstd * w0.y, v[j][2] * rstd * w0.z, v[j][3] * rstd * w0.w};
            *(f32x4*)(F.out + (size_t)t * DM + 8 * pz + 4) = (f32x4){v[j][4] * rstd * w1.x, v[j][5] * rstd * w1.y, v[j][6] * rstd * w1.z, v[j][7] * rstd * w1.w}; }
    }
}

struct Args { const float* in[21]; float* out; unsigned char* ws; int ph_lo, ph_hi, li, pad; };
__global__ void __launch_bounds__(NWAVES * 64, 2) hymba_fwd(Args args) {
    extern __shared__ __attribute__((aligned(16))) unsigned char lds[];
    Frame F;
    F.lds = (LAS unsigned char*)lds; F.MISC = (volatile LAS unsigned*)(F.lds + MISC_OFF);
    F.tid = threadIdx.x; F.lane = F.tid & 63; F.wave = __builtin_amdgcn_readfirstlane(F.tid >> 6); F.G = gridDim.x; F.bid = blockIdx.x;
    F.ws = args.ws; F.ctl = (gu32*)(args.ws + WS_CTL); F.out = args.out;
    F.x = args.in[0]; F.norm1_w = args.in[1]; F.w_in = args.in[2]; F.conv_w = args.in[3]; F.conv_b = args.in[4]; F.dt_bias = args.in[5]; F.a_log = args.in[6]; F.d_skip = args.in[7]; F.ssd_norm_w = args.in[8];
    F.i_bias = args.in[9]; F.f_bias = args.in[10]; F.ml_norm_w = args.in[11]; F.w_out = args.in[12]; F.norm2_w = args.in[13]; F.router_w = args.in[14]; F.router_b = args.in[15];
    F.w_gate_up = args.in[16]; F.b_gate_up = args.in[17]; F.w_down = args.in[18]; F.b_down = args.in[19]; F.final_norm_w = args.in[20];
    for (int u = F.tid; u < (LDS_BYTES - LDSCTL_OFF) / 4; u += NWAVES * 64) ((LAS unsigned*)(F.lds + LDSCTL_OFF))[u] = 0u;
    __syncthreads();
    XcdBarrier bar; bar.bar = (unsigned*)(F.ctl + CW_BAR) + args.li * XCD_BAR_WORDS; bar.x = 0; bar.st = nullptr;
    const bool use_bar = (args.ph_hi - args.ph_lo) > 1;
    if (use_bar) bar = xcd_barrier_post((unsigned*)(F.ctl + CW_BAR) + args.li * XCD_BAR_WORDS, F.MISC + 8);
    const int lo = args.ph_lo, hi = args.ph_hi;
#ifndef PHASE_MASK
#define PHASE_MASK 0x1ff
#endif
#define IN(k) (((PHASE_MASK >> (k)) & 1) && lo <= (k) && (k) < hi)
#define SEAM(k) do { if (IN(k) && IN((k) + 1)) xcd_barrier(bar); } while (0)
    if (IN(0)) { phase0(F); } SEAM(0);
    if (IN(1)) {
        pg8::Gemm g{(const pg8::bf16_t*)(F.ws + WS_XN1), (const pg8::bf16_t*)(F.ws + WS_WIN), TT, NPROJ, DM}; pg8::StaticOrder S; S.init(TT, NPROJ, F.G, F.bid);
        pg8::EpiBf16 E{(pg8::bf16_t*)(F.ws + WS_PROJ), NPROJ};
        pg8::gemm_phase<pg8::EpiBf16, pg8::StaticOrder, true, true>(F.lds, g, S, E);
        p1_small(F);
    } SEAM(1);
    if (IN(2)) { phase_conv(F); } SEAM(2);
    if (IN(3)) { phase_mixer(F); } SEAM(3);
    if (IN(4)) {
        pg8::Gemm g{(const pg8::bf16_t*)(F.ws + WS_YMIX), (const pg8::bf16_t*)(F.ws + WS_WOUT), TT, DM, 4096}; pg8::StaticOrder S; S.init(TT, DM, F.G, F.bid);
        pg8::EpiResNorm E{(float*)(F.ws + WS_H2), F.x, DM, (const float*)(F.ws + WS_SSQ), (PG8_LAS float*)(F.lds + RING_BYTES), EPSF};
        pg8::gemm_phase<pg8::EpiResNorm, pg8::StaticOrder, true, true>(F.lds, g, S, E);
    } SEAM(4);
    if (IN(5)) { phase5(F); } SEAM(5);
    if (IN(6)) {
        const int nM = build_moe_tab(F);
        const LAS int* tinfo = (const LAS int*)(F.lds + TAB_OFF + 320); LAS unsigned short* rt = (LAS unsigned short*)(F.lds + ROWTAB_OFF);
        pg8::Gemm g{(const pg8::bf16_t*)(F.ws + WS_XN2), (const pg8::bf16_t*)(F.ws + WS_WGU), nM * 256, 4096, DM};
        pg8::MoeOrder S{nM, 16, 4, nM * 16, F.G, F.bid, (const PG8_LAS unsigned char*)(F.lds + TAB_OFF), (const PG8_LAS unsigned short*)rt};
        { const int* TOKL = (const int*)(F.ws + WS_XG);
          for (int i = 0; i < 18; ++i) { pg8::Unit u; if (!S.next(i, u)) break; const int e = u.pn >> 4, rank = (u.pm - tinfo[40 + e]) * 256 + (F.tid & 255);
              if (F.tid < 256) rt[i * 256 + F.tid] = (unsigned short)(rank < tinfo[72 + e] ? TOKL[(size_t)e * TT + rank] : 0); }
          __syncthreads(); }
        pg8::EpiSwiglu E{(unsigned char*)(F.ws + WS_ACT), F.b_gate_up};
        pg8::gemm_phase<pg8::EpiSwiglu, pg8::MoeOrder, true, true, true, true>(F.lds, g, S, E);
    } SEAM(6);
    if (IN(7)) {
        const int nM = build_moe_tab(F);
        pg8::Gemm g{(const pg8::bf16_t*)(F.ws + WS_ACT), (const pg8::bf16_t*)(F.ws + WS_WD), nM * 256, 2048, DM};
        pg8::MoeOrder S{nM, 8, 3, nM * 8, F.G, F.bid, (const PG8_LAS unsigned char*)(F.lds + TAB_OFF), nullptr};
        pg8::EpiDown E{(pg8::bf16_t*)(F.ws + WS_YR), F.b_down, (const float*)(F.ws + WS_XG + 4 * MiB), (const PG8_LAS int*)(F.lds + TAB_OFF + 320)};
        pg8::gemm_phase<pg8::EpiDown, pg8::MoeOrder, true, true, true>(F.lds, g, S, E);
    } SEAM(7);
    if (IN(8)) { phase8(F); }
#undef IN
#undef SEAM
}

extern "C" void kernel_launch(void* const* d_in, const int* in_sizes, int n_in, void* d_out, int out_size, void* d_ws, size_t ws_size, hipStream_t stream) {
    static int grid = 0;
    if (grid == 0) {
        if (n_in != 21 || out_size != TT * DM || ws_size < WS_END) { fprintf(stderr, "kernel_launch: unexpected problem (n_in %d, out %d, ws %zu); nothing launched\n", n_in, out_size, ws_size); grid = -1; return; }
        int dev = 0, cus = 0, per_cu = 0;
        if (hipGetDevice(&dev) != hipSuccess || hipDeviceGetAttribute(&cus, hipDeviceAttributeMultiprocessorCount, dev) != hipSuccess) { grid = -1; return; }
        if (hipFuncSetAttribute((const void*)hymba_fwd, hipFuncAttributeMaxDynamicSharedMemorySize, LDS_BYTES) != hipSuccess) { fprintf(stderr, "kernel_launch: hipFuncSetAttribute failed\n"); grid = -1; return; }
        if (hipOccupancyMaxActiveBlocksPerMultiprocessor(&per_cu, (const void*)hymba_fwd, NWAVES * 64, LDS_BYTES) != hipSuccess || per_cu < 1) { fprintf(stderr, "kernel_launch: occupancy query says %d blocks per CU\n", per_cu); }
        (void)hipGetLastError();
        grid = cus;
    }
    if (grid < 0) return;
    (void)hipMemsetAsync((char*)d_ws + WS_CTL, 0, CTL_ZERO_BYTES, stream);
    Args a{};
    for (int i = 0; i < 21; ++i) a.in[i] = (const float*)d_in[i];
    a.out = (float*)d_out; a.ws = (unsigned char*)d_ws; a.pad = 0;
#if MK_PER_PHASE
    for (int li = 0; li < N_PHASES; ++li) { a.ph_lo = li; a.ph_hi = li + 1; a.li = li; hipLaunchKernelGGL(hymba_fwd, dim3(grid), dim3(NWAVES * 64), LDS_BYTES, stream, a); }
#else
    a.ph_lo = 0; a.ph_hi = N_PHASES; a.li = 0;
    hipLaunchKernelGGL(hymba_fwd, dim3(grid), dim3(NWAVES * 64), LDS_BYTES, stream, a);
#endif
}
```

```cpp
#include <hip/hip_runtime.h>
#include <cstdio>
#include <cstdint>
namespace pg8 {
#define PG8_LAS __attribute__((address_space(3)))
typedef unsigned short bf16_t;
typedef short bf16x8 __attribute__((ext_vector_type(8)));
typedef float f32x4 __attribute__((ext_vector_type(4)));
typedef unsigned u32x4 __attribute__((ext_vector_type(4)));
constexpr int BM = 256, BK = 64, HALF = 128, HTB = HALF * BK * 2  , STAGE_BYTES = 8 * HTB, NXCD = 8, WGM = 8;

__host__ __device__ __forceinline__ int lds_byte(int r, int c) { const int st = (r >> 4) * 2 + (c >> 5), rr = r & 15, cc = c & 31, ob = rr * 64 + cc * 2; return st * 1024 + (ob ^ (((ob >> 9) & 1) << 5)); }
__host__ __device__ __forceinline__ void stage_rc(int b, int& R, int& C) { const int st = b / 1024, sb = b % 1024, swz = sb ^ (((sb >> 9) & 1) << 5); R = (st >> 1) * 16 + swz / 64; C = (st & 1) * 32 + (swz % 64) / 2; }
__host__ __device__ __forceinline__ int perm32(int rho) { const int n = rho >> 4, i = rho & 15; return 8 * (i >> 2) + 4 * n + (i & 3); }

struct Unit { int pm, pn; };
struct Gemm { const bf16_t* A; const bf16_t* Bt; int M, N, K; };

struct StaticOrder {
    int nM, nN, nwg, G, c;
    __host__ __device__ void init(int M, int N, int G_, int c_) { nM = M / BM; nN = N / BM; nwg = nM * nN; G = G_; c = c_; }
    __host__ __device__ bool next(int i, Unit& u) const {
        const long L = (long)i * G + c; if (L >= nwg) return false;
        int wgid = (int)L; { const int q = nwg / NXCD, r = nwg % NXCD, xcd = wgid % NXCD, off = wgid / NXCD; wgid = (xcd < r ? xcd * (q + 1) : r * (q + 1) + (xcd - r) * q) + off; }
        const int nig = WGM * nN, gid = wgid / nig, fm = gid * WGM, gsz = (nM - fm) < WGM ? (nM - fm) : WGM;
        u.pm = fm + ((wgid % nig) % gsz); u.pn = (wgid % nig) / gsz; return true;
    }
    __device__ __forceinline__ const PG8_LAS unsigned short* rowp(int) const { return nullptr; }
    __device__ __forceinline__ void a_ready(const Unit&) const {}
    __device__ __forceinline__ void done(const Unit&) const {}
};


__device__ __forceinline__ unsigned cvt_pk_bf16(float lo, float hi) { unsigned r; asm volatile("v_cvt_pk_bf16_f32 %0, %1, %2" : "=v"(r) : "v"(lo), "v"(hi)); return r; }
typedef unsigned u32x2 __attribute__((ext_vector_type(2)));

struct EpiBf16 {
    static constexpr bool PERM = true, AFTER_DRAIN = false;
    bf16_t* O; int ldc;
    __device__ __forceinline__ void operator()(const f32x4 (&acc)[2][2][4][2], const Unit& u, int wr, int wc, int fr, int fq) const {
        const int row0 = u.pm * BM + wr * 64 + fr; const int col0 = u.pn * BM + wc * 32 + 8 * fq;
#pragma unroll
        for (int ai = 0; ai < 2; ++ai)
#pragma unroll
            for (int m = 0; m < 4; ++m) { bf16_t* rowp = O + (size_t)(row0 + ai * HALF + m * 16) * ldc + col0;
#pragma unroll
                for (int bj = 0; bj < 2; ++bj) { const f32x4 v0 = acc[ai][bj][m][0], v1 = acc[ai][bj][m][1];
                    u32x4 w; w.x = cvt_pk_bf16(v0[0], v0[1]); w.y = cvt_pk_bf16(v0[2], v0[3]); w.z = cvt_pk_bf16(v1[0], v1[1]); w.w = cvt_pk_bf16(v1[2], v1[3]);
                    *(u32x4*)(rowp + bj * HALF) = w; } }
    }
};
struct EpiResNorm {
    static constexpr bool PERM = false, AFTER_DRAIN = false, KSCALE = true;
    float* C; const float* base; int ldc; const float* ssq; PG8_LAS float* tabl; float eps;
    __device__ __forceinline__ void build(const Unit& u, int tid) const {
        const int row = tid & 255, part = tid >> 8; const size_t t = (size_t)u.pm * BM + row; float rs[7];
        if (part == 0) { const f32x4* p = (const f32x4*)(ssq + t * 32);
#pragma unroll
            for (int g = 0; g < 4; ++g) { const f32x4 a = p[2 * g], b = p[2 * g + 1]; rs[g] = 1.0f / sqrtf(((a.x + a.y) + (a.z + a.w) + (b.x + b.y) + (b.z + b.w)) * (1.0f / 512.0f) + eps); }
            const f32x4* q = (const f32x4*)(ssq + (size_t)16384 * 32 + t * 32);
#pragma unroll
            for (int h = 0; h < 3; ++h) { const f32x4 a = q[h]; rs[4 + h] = 1.0f / sqrtf(((a.x + a.y) + (a.z + a.w)) * (1.0f / 256.0f) + eps); }
        } else { const f32x4* q = (const f32x4*)(ssq + (size_t)16384 * 32 + t * 32);
#pragma unroll
            for (int h = 0; h < 6; ++h) { const f32x4 a = q[2 + h]; rs[h] = 1.0f / sqrtf(((a.x + a.y) + (a.z + a.w)) * (1.0f / 256.0f) + eps); }
            rs[6] = 1.0f; }
        PG8_LAS float* d = tabl + row * 12 + 6 * part;
#pragma unroll
        for (int s = 0; s < 6; ++s) d[s] = (part == 1 && s == 5) ? rs[5] : rs[s] / rs[s + 1];
    }
    __device__ __forceinline__ void kscale(f32x4 (&acc)[2][2][4][2], int t, int nt, int wr, int fr) const {
        const int kt = t + 1; const bool segend = kt < 32 ? ((kt & 7) == 7) : ((kt & 3) == 3);
        if (segend && kt != nt - 1) { const int sg = kt < 32 ? (kt >> 3) : 4 + ((kt - 32) >> 2);
#pragma unroll
            for (int ai = 0; ai < 2; ++ai)
#pragma unroll
                for (int m = 0; m < 4; ++m) { const float r = tabl[(ai * HALF + wr * 64 + m * 16 + fr) * 12 + sg];
#pragma unroll
                    for (int bj = 0; bj < 2; ++bj)
#pragma unroll
                        for (int n = 0; n < 2; ++n) acc[ai][bj][m][n] = acc[ai][bj][m][n] * r; } }
    }
    __device__ __forceinline__ void operator()(const f32x4 (&acc)[2][2][4][2], const Unit& u, int wr, int wc, int fr, int fq) const {
        const int row0 = u.pm * BM + wr * 64 + fr, col0 = u.pn * BM + wc * 32 + 4 * fq;
#pragma unroll
        for (int ai = 0; ai < 2; ++ai)
#pragma unroll
            for (int m = 0; m < 4; ++m) { const size_t off = (size_t)(row0 + ai * HALF + m * 16) * ldc + col0; const float r = tabl[(ai * HALF + wr * 64 + m * 16 + fr) * 12 + 11];
#pragma unroll
                for (int bj = 0; bj < 2; ++bj)
#pragma unroll
                    for (int n = 0; n < 2; ++n) *(f32x4*)(C + off + bj * HALF + n * 16) = acc[ai][bj][m][n] * r + *(const f32x4*)(base + off + bj * HALF + n * 16); }
    }
};
struct EpiResF32 {
    static constexpr bool PERM = false, AFTER_DRAIN = false;
    float* C; const float* base; int ldc;
    __device__ __forceinline__ void operator()(const f32x4 (&acc)[2][2][4][2], const Unit& u, int wr, int wc, int fr, int fq) const {
        const int row0 = u.pm * BM + wr * 64 + fr, col0 = u.pn * BM + wc * 32 + 4 * fq;
#pragma unroll
        for (int ai = 0; ai < 2; ++ai)
#pragma unroll
            for (int m = 0; m < 4; ++m) { const size_t off = (size_t)(row0 + ai * HALF + m * 16) * ldc + col0;
#pragma unroll
                for (int bj = 0; bj < 2; ++bj)
#pragma unroll
                    for (int n = 0; n < 2; ++n) *(f32x4*)(C + off + bj * HALF + n * 16) = acc[ai][bj][m][n] + *(const f32x4*)(base + off + bj * HALF + n * 16); }
    }
};
__device__ __forceinline__ float swiglu1(float a, float b) {
    const float glu = fminf(a, 7.0f), lin = fminf(fmaxf(b, -7.0f), 7.0f);
    return glu * __builtin_amdgcn_rcpf(1.0f + __expf(-1.702f * glu)) * (lin + 1.0f);
}
struct EpiSwiglu {
    static constexpr bool PERM = true, AFTER_DRAIN = false;
    unsigned char* O; const float* bias;
    __device__ __forceinline__ void operator()(const f32x4 (&acc)[2][2][4][2], const Unit& u, int wr, int wc, int fr, int fq) const {
        const int e = u.pn >> 4, pnl = u.pn & 15;
        const int row0 = u.pm * BM + wr * 64 + fr; const int hcol0 = pnl * BM + wc * 32 + 8 * fq;
        const float* bp = bias + (size_t)e * 4096 + hcol0;
        f32x4 bv[2][2];
#pragma unroll
        for (int bj = 0; bj < 2; ++bj)
#pragma unroll
            for (int n = 0; n < 2; ++n) bv[bj][n] = *(const f32x4*)(bp + bj * HALF + 4 * n);
#pragma unroll
        for (int ai = 0; ai < 2; ++ai)
#pragma unroll
            for (int m = 0; m < 4; ++m) { unsigned char* rowp = O + (size_t)(row0 + ai * HALF + m * 16) * 2048 + (hcol0 >> 1);
#pragma unroll
                for (int bj = 0; bj < 2; ++bj) { const f32x4 v0 = acc[ai][bj][m][0] + bv[bj][0], v1 = acc[ai][bj][m][1] + bv[bj][1];
                    int w = __builtin_amdgcn_cvt_pk_fp8_f32(swiglu1(v0[0], v0[1]), swiglu1(v0[2], v0[3]), 0, false);
                    w = __builtin_amdgcn_cvt_pk_fp8_f32(swiglu1(v1[0], v1[1]), swiglu1(v1[2], v1[3]), w, true);
                    *(int*)(rowp + bj * 64) = w; } }
    }
};
struct EpiDown {
    static constexpr bool PERM = true, AFTER_DRAIN = false;
    bf16_t* O; const float* bias; const float* gatel; const PG8_LAS int* tinfo;
    __device__ __forceinline__ void operator()(const f32x4 (&acc)[2][2][4][2], const Unit& u, int wr, int wc, int fr, int fq) const {
        const int e = u.pn >> 3, pnl = u.pn & 7;
        const int row0 = u.pm * BM + wr * 64 + fr; const int col0 = pnl * BM + wc * 32 + 8 * fq;
        const float* bp = bias + (size_t)e * 2048 + col0; const float* gp = gatel + (size_t)e * 16384 - 256 * tinfo[40 + e];
        f32x4 bv[2][2];
#pragma unroll
        for (int bj = 0; bj < 2; ++bj)
#pragma unroll
            for (int n = 0; n < 2; ++n) bv[bj][n] = *(const f32x4*)(bp + bj * HALF + 4 * n);
#pragma unroll
        for (int ai = 0; ai < 2; ++ai)
#pragma unroll
            for (int m = 0; m < 4; ++m) { const int row = row0 + ai * HALF + m * 16; const float gt = gp[row]; bf16_t* rowp = O + (size_t)row * 2048 + col0;
#pragma unroll
                for (int bj = 0; bj < 2; ++bj) { const f32x4 v0 = (acc[ai][bj][m][0] + bv[bj][0]) * gt, v1 = (acc[ai][bj][m][1] + bv[bj][1]) * gt;
                    u32x4 w; w.x = cvt_pk_bf16(v0[0], v0[1]); w.y = cvt_pk_bf16(v0[2], v0[3]); w.z = cvt_pk_bf16(v1[0], v1[1]); w.w = cvt_pk_bf16(v1[2], v1[3]);
                    *(u32x4*)(rowp + bj * HALF) = w; } }
    }
};
struct MoeOrder {
    int nM, nN, nsh, nwg, G, c; const PG8_LAS unsigned char* tab; const PG8_LAS unsigned short* rt;
    __device__ __forceinline__ const PG8_LAS unsigned short* rowp(int ui) const { return rt + ui * 256; }
    __device__ __forceinline__ bool next(int i, Unit& u) const {
        const long L = (long)i * G + c; if (L >= nwg) return false;
        int wgid = (int)L; { const int q = nwg / NXCD, r = nwg % NXCD, xcd = wgid % NXCD, off = wgid / NXCD; wgid = (xcd < r ? xcd * (q + 1) : r * (q + 1) + (xcd - r) * q) + off; }
        const int nig = WGM * nN, gid = wgid / nig, fm = gid * WGM, gsz = (nM - fm) < WGM ? (nM - fm) : WGM;
        const int pm = fm + ((wgid % nig) % gsz), pnl = (wgid % nig) / gsz;
        u.pm = pm; u.pn = ((int)tab[pm] << nsh) + pnl; return true;
    }
    __device__ __forceinline__ void a_ready(const Unit&) const {}
    __device__ __forceinline__ void done(const Unit&) const {}
};
template <class E, class = void> struct epi_kscale { static constexpr bool value = false; };
template <class E> struct epi_kscale<E, decltype((void)E::KSCALE)> { static constexpr bool value = E::KSCALE; };
typedef int v8i32 __attribute__((ext_vector_type(8)));
__device__ __forceinline__ v8i32 pg8_cat(const bf16x8 lo, const bf16x8 hi) { typedef int v4i32 __attribute__((ext_vector_type(4))); const v4i32 a = __builtin_bit_cast(v4i32, lo), b = __builtin_bit_cast(v4i32, hi); return __builtin_shufflevector(a, b, 0, 1, 2, 3, 4, 5, 6, 7); }
template <class Epi, class Sched, bool ALIGN_EPI = false, bool SP2 = false, bool F8 = false, bool GA = false>
__device__ __forceinline__ void gemm_phase(PG8_LAS unsigned char* lds, const Gemm g, const Sched& S, const Epi& E) {
    const int tid = threadIdx.x, wid = __builtin_amdgcn_readfirstlane(tid >> 6), lane = tid & 63, wr = wid >> 2, wc = wid & 3, fr = lane & 15, fq = lane >> 4;
    const int K = g.K, KB = F8 ? K : 2 * K, nt = KB / 128;
    unsigned voffA[2], voffB[2]; int gaR[2]; unsigned gaC[2]; static_assert(!GA || SP2, "gathered A needs the SP2 loop");
#pragma unroll
    for (int i = 0; i < 2; ++i) { int R, C; stage_rc(tid * 16 + i * 8192, R, C); const int Rb = Epi::PERM ? ((R & ~31) + perm32(R & 31)) : R;
        voffA[i] = (unsigned)(R * KB + C * 2); voffB[i] = (unsigned)(Rb * KB + C * 2); gaR[i] = R; gaC[i] = (unsigned)(C * 2); }
    const size_t kstep = (size_t)(BK * 2);
    const size_t hstep = (size_t)HALF * KB;
    const size_t tstep = 2 * hstep;
    const unsigned ldsw = (unsigned)wid * 1024u;
    int aoffk[2], boffk[2];
#pragma unroll
    for (int h = 0; h < 2; ++h) { aoffk[h] = lds_byte(wr * 64 + fr, fq * 8) + h * 1024; boffk[h] = lds_byte(wc * 32 + fr, fq * 8) + h * 1024; }
#define PG8_SA(b, h) (((b) * 2 + (h)) * HTB)
#define PG8_SB(b, h) ((4 + (b) * 2 + (h)) * HTB)
#define PG8_STAGE(bufoff, gbase, voff) do { _Pragma("unroll") for (int _i = 0; _i < 2; ++_i) \
        __builtin_amdgcn_global_load_lds((const unsigned*)((const char*)(gbase) + (voff)[_i]), (PG8_LAS unsigned*)(lds + (bufoff) + ldsw + _i * 8192), 16, 0, 0); } while (0)
#define PG8_STAGE_A(bufoff, kptr, h, usenext) do { if constexpr (GA) { _Pragma("unroll") for (int _i = 0; _i < 2; ++_i) { const unsigned _o = (usenext) ? gn[h][_i] : gc[h][_i]; \
            __builtin_amdgcn_global_load_lds((const unsigned*)((const char*)(kptr) + _o), (PG8_LAS unsigned*)(lds + (bufoff) + ldsw + _i * 8192), 16, 0, 0); } } \
        else { PG8_STAGE(bufoff, (kptr) + (h) * hstep, voffA); } } while (0)
#define PG8_GROWS(dst, ui_) do { const PG8_LAS unsigned short* _rt = S.rowp(ui_); _Pragma("unroll") for (int _h = 0; _h < 2; ++_h) _Pragma("unroll") for (int _i = 0; _i < 2; ++_i) dst[_h][_i] = (unsigned)_rt[gaR[_i] + 128 * _h] * (unsigned)KB + gaC[_i]; } while (0)
#define PG8_LDA(dst, b, h) do { if constexpr (F8) { _Pragma("unroll") for (int m = 0; m < 4; ++m) dst##8[m] = pg8_cat(*(const PG8_LAS bf16x8*)(lds + PG8_SA(b, h) + aoffk[0] + m * 2048), *(const PG8_LAS bf16x8*)(lds + PG8_SA(b, h) + aoffk[1] + m * 2048)); } \
        else { _Pragma("unroll") for (int m = 0; m < 4; ++m) _Pragma("unroll") for (int k = 0; k < 2; ++k) dst[m][k] = *(const PG8_LAS bf16x8*)(lds + PG8_SA(b, h) + aoffk[k] + m * 2048); } } while (0)
#define PG8_LDB(dst, b, h) do { if constexpr (F8) { _Pragma("unroll") for (int n = 0; n < 2; ++n) dst##8[n] = pg8_cat(*(const PG8_LAS bf16x8*)(lds + PG8_SB(b, h) + boffk[0] + n * 2048), *(const PG8_LAS bf16x8*)(lds + PG8_SB(b, h) + boffk[1] + n * 2048)); } \
        else { _Pragma("unroll") for (int n = 0; n < 2; ++n) _Pragma("unroll") for (int k = 0; k < 2; ++k) dst[n][k] = *(const PG8_LAS bf16x8*)(lds + PG8_SB(b, h) + boffk[k] + n * 2048); } } while (0)
#define PG8_MMA(ai, bj, At, Bt) do { __builtin_amdgcn_s_setprio(1); \
        if constexpr (F8) { _Pragma("unroll") for (int m = 0; m < 4; ++m) _Pragma("unroll") for (int n = 0; n < 2; ++n) \
            asm volatile("v_mfma_scale_f32_16x16x128_f8f6f4 %0, %1, %2, %0, %3, %4 op_sel_hi:[0,0,0]" : "+v"(acc[ai][bj][m][n]) : "v"(Bt##8[n]), "v"(At##8[m]), "v"(sc_w), "v"(sc_a)); } \
        else { _Pragma("unroll") for (int m = 0; m < 4; ++m) _Pragma("unroll") for (int n = 0; n < 2; ++n) _Pragma("unroll") for (int k = 0; k < 2; ++k) \
            acc[ai][bj][m][n] = __builtin_amdgcn_mfma_f32_16x16x32_bf16(Bt[n][k], At[m][k], acc[ai][bj][m][n], 0, 0, 0); } \
        __builtin_amdgcn_s_setprio(0); } while (0)
#define PG8_WAIT_V(n) asm volatile("s_waitcnt vmcnt(" #n ")" ::: "memory")
#define PG8_WAIT_L(n) asm volatile("s_waitcnt lgkmcnt(" #n ")" ::: "memory")
#define PG8_BAR __builtin_amdgcn_s_barrier()
#define PG8_SCHED __builtin_amdgcn_sched_barrier(0)
    Unit cur, nxt; int ui = 0;
    if (!S.next(0, cur)) return;
    f32x4 acc[2][2][4][2];
#pragma unroll
    for (int a = 0; a < 2; ++a)
#pragma unroll
        for (int b = 0; b < 2; ++b)
#pragma unroll
            for (int m = 0; m < 4; ++m)
#pragma unroll
                for (int n = 0; n < 2; ++n) acc[a][b][m][n] = (f32x4){0.f, 0.f, 0.f, 0.f};
    const int sc_w = 0x79797979, sc_a = 0x7f7f7f7f;
    bf16x8 At[4][2], B0[2][2], B1[2][2]; v8i32 At8[4], B08[2], B18[2];
    const char* cA = (const char*)g.A + (GA ? (size_t)0 : (size_t)cur.pm * tstep); const char* cB = (const char*)g.Bt + (size_t)cur.pn * tstep;
    unsigned gc[2][2] = {{0u, 0u}, {0u, 0u}}, gn[2][2] = {{0u, 0u}, {0u, 0u}};
    if constexpr (GA) { PG8_GROWS(gc, 0); }
    if constexpr (epi_kscale<Epi>::value) { E.build(cur, tid); asm volatile("s_waitcnt lgkmcnt(0)" ::: "memory"); PG8_BAR; asm volatile("" ::: "memory"); }
    S.a_ready(cur);
    if constexpr (SP2) {
        PG8_STAGE(PG8_SB(0, 0), cB, voffB); PG8_STAGE(PG8_SB(0, 1), cB + hstep, voffB); PG8_STAGE_A(PG8_SA(0, 0), cA, 0, false); PG8_STAGE_A(PG8_SA(0, 1), cA, 1, false);
        if (wr == 1) PG8_BAR;
        PG8_WAIT_V(2); PG8_BAR;
        PG8_STAGE(PG8_SB(1, 0), cB + kstep, voffB); PG8_STAGE_A(PG8_SA(1, 0), cA + kstep, 0, false); PG8_STAGE(PG8_SB(1, 1), cB + hstep + kstep, voffB);
        PG8_WAIT_V(6); PG8_BAR;
    } else {
        PG8_STAGE(PG8_SB(0, 0), cB, voffB); PG8_STAGE(PG8_SA(0, 0), cA, voffA); PG8_STAGE(PG8_SB(0, 1), cB + hstep, voffB); PG8_STAGE(PG8_SA(0, 1), cA + hstep, voffA);
        if (wr == 1) PG8_BAR;
        PG8_WAIT_V(4); PG8_BAR;
        PG8_STAGE(PG8_SB(1, 0), cB + kstep, voffB); PG8_STAGE(PG8_SA(1, 0), cA + kstep, voffA); PG8_STAGE(PG8_SB(1, 1), cB + hstep + kstep, voffB);
        PG8_WAIT_V(6); PG8_BAR;
    }
    for (;;) {
        const bool has_next = S.next(ui + 1, nxt);
        const char* nA = (has_next && !GA) ? (const char*)g.A + (size_t)nxt.pm * tstep : cA; const char* nB = has_next ? (const char*)g.Bt + (size_t)nxt.pn * tstep : cB;
        if constexpr (GA) { if (has_next) { PG8_GROWS(gn, ui + 1); } else {
#pragma unroll
            for (int _h = 0; _h < 2; ++_h) { gn[_h][0] = gc[_h][0]; gn[_h][1] = gc[_h][1]; } } }
        for (int t = 0; t < nt; t += 2) {
            const bool last = (t == nt - 2);
            const char* a1 = cA + (size_t)(t + 1) * kstep;
            const char* a2 = last ? nA : cA + (size_t)(t + 2) * kstep; const char* b2 = last ? nB : cB + (size_t)(t + 2) * kstep;
            const char* a3 = a2 + kstep; const char* b3 = b2 + kstep;
            if (last && has_next) S.a_ready(nxt);
            if constexpr (SP2) {
            PG8_LDB(B0, 0, 0); PG8_LDB(B1, 0, 1); PG8_SCHED; PG8_LDA(At, 0, 0); PG8_STAGE_A(PG8_SA(1, 1), a1, 1, false);
            PG8_WAIT_V(8); PG8_WAIT_L(0); PG8_BAR; PG8_MMA(0, 0, At, B0); PG8_MMA(0, 1, At, B1); PG8_BAR; PG8_SCHED;
            PG8_LDA(At, 0, 1); PG8_STAGE(PG8_SB(0, 0), b2, voffB); PG8_STAGE(PG8_SB(0, 1), b2 + hstep, voffB); PG8_STAGE_A(PG8_SA(0, 0), a2, 0, last);
            PG8_WAIT_V(8); PG8_WAIT_L(0); PG8_BAR; PG8_MMA(1, 0, At, B0); PG8_MMA(1, 1, At, B1); PG8_BAR; PG8_SCHED;
            PG8_LDB(B0, 1, 0); PG8_LDB(B1, 1, 1); PG8_SCHED; PG8_LDA(At, 1, 0); PG8_STAGE_A(PG8_SA(0, 1), a2, 1, last);
            PG8_WAIT_V(8); PG8_WAIT_L(0); PG8_BAR; PG8_MMA(0, 0, At, B0); PG8_MMA(0, 1, At, B1); PG8_BAR; PG8_SCHED;
            PG8_LDA(At, 1, 1); PG8_STAGE(PG8_SB(1, 0), b3, voffB); PG8_STAGE(PG8_SB(1, 1), b3 + hstep, voffB); PG8_STAGE_A(PG8_SA(1, 0), a3, 0, last);
            PG8_WAIT_V(8); PG8_WAIT_L(0); PG8_BAR; PG8_MMA(1, 0, At, B0); PG8_MMA(1, 1, At, B1); PG8_BAR; PG8_SCHED;
            if constexpr (epi_kscale<Epi>::value) { E.kscale(acc, t, nt, wr, fr); PG8_SCHED; }
            } else {
            PG8_LDB(B0, 0, 0); PG8_SCHED; PG8_LDA(At, 0, 0); PG8_STAGE(PG8_SA(1, 1), a1 + hstep, voffA);
            PG8_WAIT_L(8); PG8_BAR; PG8_WAIT_L(0); PG8_MMA(0, 0, At, B0); PG8_BAR; PG8_SCHED;
            PG8_LDB(B1, 0, 1); PG8_STAGE(PG8_SB(0, 0), b2, voffB);
            PG8_BAR; PG8_WAIT_L(0); PG8_MMA(0, 1, At, B1); PG8_BAR;
            PG8_LDA(At, 0, 1); PG8_STAGE(PG8_SA(0, 0), a2, voffA);
            PG8_BAR; PG8_WAIT_L(0); PG8_MMA(1, 0, At, B0); PG8_BAR; PG8_SCHED;
            PG8_STAGE(PG8_SB(0, 1), b2 + hstep, voffB);
            PG8_WAIT_V(6); PG8_BAR; PG8_MMA(1, 1, At, B1); PG8_BAR;
            PG8_LDB(B0, 1, 0); PG8_SCHED; PG8_LDA(At, 1, 0); PG8_STAGE(PG8_SA(0, 1), a2 + hstep, voffA);
            PG8_WAIT_L(8); PG8_BAR; PG8_WAIT_L(0); PG8_MMA(0, 0, At, B0); PG8_BAR; PG8_SCHED;
            PG8_LDB(B1, 1, 1); PG8_STAGE(PG8_SB(1, 0), b3, voffB);
            PG8_BAR; PG8_WAIT_L(0); PG8_MMA(0, 1, At, B1); PG8_BAR;
            PG8_LDA(At, 1, 1); PG8_STAGE(PG8_SA(1, 0), a3, voffA);
            PG8_BAR; PG8_WAIT_L(0); PG8_MMA(1, 0, At, B0); PG8_BAR; PG8_SCHED;
            PG8_STAGE(PG8_SB(1, 1), b3 + hstep, voffB);
            PG8_WAIT_V(6); PG8_BAR; PG8_MMA(1, 1, At, B1); PG8_BAR;
            }
        }
        if constexpr (ALIGN_EPI) { if (wr == 0) PG8_BAR; }
        if constexpr (F8) asm volatile("s_nop 15\n\ts_nop 15" ::: "memory");
        if constexpr (!Epi::AFTER_DRAIN) { E(acc, cur, wr, wc, fr, fq); S.done(cur); }
        if (!has_next) break;
#pragma unroll
        for (int a = 0; a < 2; ++a)
#pragma unroll
            for (int b = 0; b < 2; ++b)
#pragma unroll
                for (int m = 0; m < 4; ++m)
#pragma unroll
                    for (int n = 0; n < 2; ++n) acc[a][b][m][n] = (f32x4){0.f, 0.f, 0.f, 0.f};
        if constexpr (epi_kscale<Epi>::value) { static_assert(!epi_kscale<Epi>::value || (ALIGN_EPI && SP2), "K-segment rescale needs aligned epilogues");
            asm volatile("s_waitcnt lgkmcnt(0)" ::: "memory"); PG8_BAR; asm volatile("" ::: "memory");
            E.build(nxt, tid); asm volatile("s_waitcnt lgkmcnt(0)" ::: "memory"); PG8_BAR; asm volatile("" ::: "memory"); }
        cur = nxt; cA = nA; cB = nB; ++ui;
        if constexpr (GA) {
#pragma unroll
            for (int _h = 0; _h < 2; ++_h) { gc[_h][0] = gn[_h][0]; gc[_h][1] = gn[_h][1]; } }
        if constexpr (ALIGN_EPI) { if (wr == 1) PG8_BAR; }
    }
    PG8_WAIT_V(0);
    if constexpr (!ALIGN_EPI) { if (wr == 0) PG8_BAR; }
    PG8_BAR;
    if constexpr (Epi::AFTER_DRAIN) { E.fused(acc, cur, wr, wc, fr, fq, lds, wid, lane); S.done(cur); }
#undef PG8_SA
#undef PG8_SB
#undef PG8_STAGE
#undef PG8_STAGE_A
#undef PG8_GROWS
#undef PG8_LDA
#undef PG8_LDB
#undef PG8_MMA
#undef PG8_WAIT_V
#undef PG8_WAIT_L
#undef PG8_BAR
#undef PG8_SCHED
}
}

constexpr int NWAVES = 8;
constexpr int TT = 16384, DM = 2048, SEQ = 2048;
constexpr int NPROJ = 11264;
constexpr int PC_Z = 0, PC_XBC = 2048, PC_Q = 5120, PC_K = 6144, PC_V = 7168, PC_O = 9216;
constexpr int WIN_LD = 11312;
constexpr int NSLOT = 65536 + 32 * 256;
constexpr float EPSF = 1e-5f;
#ifndef HSYNC_ON
#define HSYNC_ON 0
#endif
#define HWAIT() do { if (HSYNC_ON) asm volatile("s_waitcnt vmcnt(0) lgkmcnt(0)\n\ts_nop 15\n\ts_nop 15" ::: "memory"); } while (0)
#define HSYNC() do { if (HSYNC_ON) { HWAIT(); __syncthreads(); } } while (0)
#ifndef MK_PER_PHASE
#define MK_PER_PHASE 0
#endif
constexpr int N_PHASES = 9;

constexpr size_t MiB = 1u << 20;
constexpr size_t WS_CTL = 0, CTL_ZERO_BYTES = 1 * MiB;
constexpr size_t WS_WIN = 2 * MiB, WS_WSM = 46 * MiB, WS_WRT = 47 * MiB, WS_WOUT = 48 * MiB, WS_WGU = 64 * MiB, WS_WD = 576 * MiB;
constexpr size_t WS_XN1 = 832 * MiB, WS_PROJ = 896 * MiB, WS_SMALL = 1248 * MiB, WS_SSQ = 1252 * MiB, WS_YMIX = 1256 * MiB, WS_H2 = 1384 * MiB, WS_XN2 = 1512 * MiB;
constexpr size_t WS_ROUTE = 1576 * MiB, WS_XG = 1578 * MiB, WS_ACT = 1866 * MiB, WS_YR = 2154 * MiB, WS_XC = 2442 * MiB, WS_END = 2538 * MiB;
constexpr int CW_BAR = 4096;
constexpr int CW_CNT = 65536;

constexpr int RING_BYTES = 131072;
constexpr int LDS_BYTES = 147456;
constexpr int LDSCTL_OFF = LDS_BYTES - 1024, MISC_OFF = LDSCTL_OFF;
constexpr int TAB_OFF = LDSCTL_OFF + 64;
constexpr int ROWTAB_OFF = RING_BYTES;

#define GAS __attribute__((address_space(1)))
#define LAS __attribute__((address_space(3)))
typedef unsigned short bf16;
typedef unsigned v4u __attribute__((ext_vector_type(4)));
typedef unsigned v2u __attribute__((ext_vector_type(2)));
typedef float f32x4 __attribute__((ext_vector_type(4)));
typedef float f32x2 __attribute__((ext_vector_type(2)));
typedef short bf16x8 __attribute__((ext_vector_type(8)));
typedef GAS unsigned gu32;
#define RLX_AGENT __ATOMIC_RELAXED, __HIP_MEMORY_SCOPE_AGENT
#define LDS_WAIT() asm volatile("s_waitcnt lgkmcnt(0)" ::: "memory")
#define VM_WAIT() asm volatile("s_waitcnt vmcnt(0)" ::: "memory")
__device__ __forceinline__ unsigned f2bf(float f) { unsigned u = __builtin_bit_cast(unsigned, f); return (u + 0x7fffu + ((u >> 16) & 1u)) >> 16; }
__device__ __forceinline__ unsigned pk2(float lo, float hi) { return f2bf(lo) | (f2bf(hi) << 16); }
__device__ __forceinline__ float bflo(unsigned w) { return __builtin_bit_cast(float, w << 16); }
__device__ __forceinline__ float bfhi(unsigned w) { return __builtin_bit_cast(float, w & 0xffff0000u); }
__device__ __forceinline__ float wave_sum(float v) {
#pragma unroll
    for (int o = 1; o < 64; o <<= 1) v += __shfl_xor(v, o);
    return v;
}
__device__ __forceinline__ float softplusf(float x) { return x > 20.f ? x : log1pf(expf(x)); }
__device__ __forceinline__ float logsigf(float x) { return fminf(x, 0.f) - log1pf(expf(-fabsf(x))); }
__device__ __forceinline__ float siluf(float v) { return v * __builtin_amdgcn_rcpf(1.0f + __expf(-v)); }

#define XB_TMO      128
#define XB_XCNT(j)  (256  + 64 * (j))
#define XB_XSUB(j)  (1280 + 64 * (j))
#define XB_XGEN(j)  (2304 + 64 * (j))
#define XB_TOP      3328
#define XB_TOPGEN   3392
#define XCD_BAR_WORDS 3456
#define XB_SPIN_CAP (1u << 18)

__device__ __forceinline__ unsigned xb_ld(unsigned* p)              { return __hip_atomic_load(p, __ATOMIC_RELAXED, __HIP_MEMORY_SCOPE_AGENT); }
__device__ __forceinline__ unsigned xb_add(unsigned* p, unsigned v) { return __hip_atomic_fetch_add(p, v, __ATOMIC_RELAXED, __HIP_MEMORY_SCOPE_AGENT); }
__device__ __forceinline__ unsigned xb_xcc_id() { return (unsigned)__builtin_amdgcn_s_getreg((3 << 11) | 20) & 0xFu; }
#define XB_SPIN(cond, bar) do { unsigned _sp = 0; while (cond) { __builtin_amdgcn_s_sleep(1); \
    if ((++_sp & 255u) == 0u) { if (xb_ld(&(bar)[XB_TMO])) break; if (_sp > XB_SPIN_CAP) { atomicAdd(&(bar)[XB_TMO], 1u); break; } } } } while (0)

struct XcdBarrier {
    unsigned* bar; unsigned x;
    volatile LAS unsigned* st;
};

__device__ __forceinline__ XcdBarrier xcd_barrier_post(unsigned* bar, volatile LAS unsigned* st) {
    XcdBarrier b; b.bar = bar; b.x = xb_xcc_id(); b.st = st;
    if (threadIdx.x == 0) (void)xb_add(&bar[XB_XCNT(b.x)], 1u);
    return b;
}
__device__ __forceinline__ void xcd_barrier_complete(unsigned* bar, unsigned x, unsigned& nloc, unsigned& nx) {
    const unsigned G = gridDim.x * gridDim.y * gridDim.z;
    unsigned sum, cnt, mine, sp = 0u;
    for (;;) {
        sum = 0u; cnt = 0u; mine = 0u;
#pragma unroll
        for (unsigned j = 0; j < 16; ++j) { const unsigned c = xb_ld(&bar[XB_XCNT(j)]); sum += c; cnt += (c > 0u) ? 1u : 0u; mine = (j == x) ? c : mine; }
        if (sum == G) break;
        __builtin_amdgcn_s_sleep(1);
        if ((++sp & 255u) == 0u) { if (xb_ld(&bar[XB_TMO])) break; if (sp > XB_SPIN_CAP) { atomicAdd(&bar[XB_TMO], 1u); break; } }
    }
    nloc = mine > 0u ? mine : 1u; nx = cnt > 0u ? cnt : 1u;
}

__device__ __forceinline__ void xcd_barrier(const XcdBarrier& b) {
    asm volatile("s_waitcnt vmcnt(0)" ::: "memory");
    __syncthreads();
    if (threadIdx.x == 0) {
        unsigned* bar = b.bar;
        __builtin_amdgcn_s_waitcnt(0);
        unsigned nloc = b.st[0], nx = b.st[1];
        if (nloc == 0u) { xcd_barrier_complete(bar, b.x, nloc, nx); b.st[0] = nloc; b.st[1] = nx; }
        const unsigned old = xb_add(&bar[XB_XSUB(b.x)], 1u);
        const unsigned gen = old / nloc;
        if (old + 1u == (gen + 1u) * nloc) {
            __builtin_amdgcn_fence(__ATOMIC_RELEASE, "agent");
            asm volatile("s_waitcnt vmcnt(0)" ::: "memory");
            const unsigned og = xb_add(&bar[XB_TOP], 1u);
            const unsigned tg = og / nx;
            if (og + 1u == (tg + 1u) * nx) xb_add(&bar[XB_TOPGEN], 1u);
            else XB_SPIN(xb_ld(&bar[XB_TOPGEN]) == tg, bar);
            __builtin_amdgcn_fence(__ATOMIC_ACQUIRE, "agent");
            xb_add(&bar[XB_XGEN(b.x)], 1u);
            asm volatile("s_waitcnt vmcnt(0)" ::: "memory");
        } else {
            XB_SPIN(xb_ld(&bar[XB_XGEN(b.x)]) == gen, bar);
            __builtin_amdgcn_fence(__ATOMIC_ACQUIRE, "agent");
            asm volatile("s_waitcnt vmcnt(0)" ::: "memory");
        }
    }
    __syncthreads();
}

struct Frame {
    LAS unsigned char* lds;
    volatile LAS unsigned* MISC;
    gu32* ctl;
    int tid, lane, wave, G, bid;
    const float *x, *norm1_w, *w_in, *conv_w, *conv_b, *dt_bias, *a_log, *d_skip, *ssd_norm_w, *i_bias, *f_bias, *ml_norm_w, *w_out, *norm2_w, *router_w, *router_b, *w_gate_up, *b_gate_up, *w_down, *b_down, *final_norm_w;
    float* out; unsigned char* ws;
};

__device__ __forceinline__ void p0_transpose_item(const float* W, int ldw, int K, bf16* WT, int dst_row0, int src_col0, int k0, LAS float* scr, int lane) {
#pragma unroll 8
    for (int i = 0; i < 32; ++i) { const int kk = 2 * i + (lane >> 5); scr[kk * 33 + (lane & 31)] = W[(size_t)(k0 + kk) * ldw + src_col0 + (lane & 31)]; }
    LDS_WAIT(); asm volatile("" ::: "memory");
    const int c = lane & 7;
#pragma unroll
    for (int j = 0; j < 4; ++j) { const int n = (lane >> 3) + 8 * j; const LAS float* s = scr + (8 * c) * 33 + n;
        v4u o; o.x = pk2(s[0 * 33], s[1 * 33]); o.y = pk2(s[2 * 33], s[3 * 33]); o.z = pk2(s[4 * 33], s[5 * 33]); o.w = pk2(s[6 * 33], s[7 * 33]);
        *(v4u*)(WT + (size_t)(dst_row0 + n) * K + k0 + 8 * c) = o; }
    LDS_WAIT(); asm volatile("" ::: "memory");
}
__device__ __forceinline__ void p0_transpose_item_f8(const float* W, int ldw, int K, unsigned char* WT, int dst_row0, int src_col0, int k0, LAS float* scr, int lane) {
#pragma unroll 8
    for (int i = 0; i < 32; ++i) { const int kk = 2 * i + (lane >> 5); scr[kk * 33 + (lane & 31)] = W[(size_t)(k0 + kk) * ldw + src_col0 + (lane & 31)] * 64.0f; }
    LDS_WAIT(); asm volatile("" ::: "memory");
    const int c = lane & 3;
#pragma unroll
    for (int j = 0; j < 2; ++j) { const int n = (lane >> 2) + 16 * j; const LAS float* s = scr + (16 * c) * 33 + n; int o[4];
#pragma unroll
        for (int q = 0; q < 4; ++q) { int w = __builtin_amdgcn_cvt_pk_fp8_f32(s[(4 * q) * 33], s[(4 * q + 1) * 33], 0, false); o[q] = __builtin_amdgcn_cvt_pk_fp8_f32(s[(4 * q + 2) * 33], s[(4 * q + 3) * 33], w, true); }
        *(v4u*)(WT + (size_t)(dst_row0 + n) * K + k0 + 16 * c) = (v4u){(unsigned)o[0], (unsigned)o[1], (unsigned)o[2], (unsigned)o[3]}; }
    LDS_WAIT(); asm volatile("" ::: "memory");
}
template <bool F8> __device__ __forceinline__ void p0_transpose128(const float* W, int ldw, int K, void* WTv, int dst_row0, int src_col0, int k0, LAS float* scr, int lane) {
    const float* src = W + (size_t)(k0 + (lane >> 3)) * ldw + src_col0 + 4 * (lane & 7);
    f32x4 v[16];
#pragma unroll
    for (int i = 0; i < 16; ++i) v[i] = *(const f32x4*)(src + (size_t)(8 * i) * ldw);
#pragma unroll
    for (int i = 0; i < 16; ++i) { LAS float* d = scr + (8 * i + (lane >> 3)) * 33 + 4 * (lane & 7); d[0] = v[i].x; d[1] = v[i].y; d[2] = v[i].z; d[3] = v[i].w; }
    LDS_WAIT(); asm volatile("" ::: "memory");
    const int n = lane & 31, hf = lane >> 5; const LAS float* s = scr + (64 * hf) * 33 + n;
    if (F8) { unsigned char* dst = (unsigned char*)WTv + (size_t)(dst_row0 + n) * K + k0 + 64 * hf;
#pragma unroll
        for (int j = 0; j < 4; ++j) { int o[4];
#pragma unroll
            for (int q = 0; q < 4; ++q) { const LAS float* p = s + (16 * j + 4 * q) * 33; int w = __builtin_amdgcn_cvt_pk_fp8_f32(p[0] * 64.0f, p[33] * 64.0f, 0, false); o[q] = __builtin_amdgcn_cvt_pk_fp8_f32(p[66] * 64.0f, p[99] * 64.0f, w, true); }
            *(v4u*)(dst + 16 * j) = (v4u){(unsigned)o[0], (unsigned)o[1], (unsigned)o[2], (unsigned)o[3]}; }
    } else { bf16* dst = (bf16*)WTv + (size_t)(dst_row0 + n) * K + k0 + 64 * hf;
#pragma unroll
        for (int j = 0; j < 8; ++j) { const LAS float* p = s + (8 * j) * 33;
            *(v4u*)(dst + 8 * j) = (v4u){pk2(p[0], p[33]), pk2(p[66], p[99]), pk2(p[132], p[165]), pk2(p[198], p[231])}; }
    }
    LDS_WAIT(); asm volatile("" ::: "memory");
}
__device__ __forceinline__ void rms_row_to_bf16(const float* xrow, const float* w, bf16* orow, int lane) {
    const f32x4* xr = (const f32x4*)xrow + lane; const f32x4* wr = (const f32x4*)w + lane;
    f32x4 v[8]; float s = 0.f;
#pragma unroll
    for (int j = 0; j < 8; ++j) { v[j] = xr[64 * j]; s += (v[j].x * v[j].x + v[j].y * v[j].y) + (v[j].z * v[j].z + v[j].w * v[j].w); }
    const float rstd = 1.0f / sqrtf(wave_sum(s) * (1.0f / 2048.0f) + EPSF);
    v2u* o8 = (v2u*)orow + lane;
#pragma unroll
    for (int j = 0; j < 8; ++j) { const f32x4 ww = wr[64 * j]; v2u o; o.x = pk2(v[j].x * rstd * ww.x, v[j].y * rstd * ww.y); o.y = pk2(v[j].z * rstd * ww.z, v[j].w * rstd * ww.w); o8[64 * j] = o; }
}
__device__ __forceinline__ void p0_moe_weights_coop(Frame& F) {
    LAS float* tile = (LAS float*)F.lds;
    unsigned char* WguT = (unsigned char*)(F.ws + WS_WGU); unsigned char* WdT = (unsigned char*)(F.ws + WS_WD);
    constexpr int I_GU = 32 * 256, I_D = 32 * 128, NI = I_GU + I_D;
    const int lrow = 32 * F.wave + (F.lane >> 5), lcol = 4 * (F.lane & 31);
    const int on = F.tid & 127, okq = F.tid >> 7;
    f32x4 v[16];
    auto item = [&](int r, const float*& W, unsigned char*& WT, int& ldw, int& n0, int& k0) {
        if (r < I_GU) { const int e = r >> 8, rr = r & 255, kb = rr >> 5, nb = rr & 31; W = F.w_gate_up + (size_t)e * 2048 * 4096; WT = WguT + (size_t)e * 4096 * 2048; ldw = 4096; n0 = nb * 128; k0 = kb * 256; }
        else { r -= I_GU; const int e = r >> 7, rr = r & 127, kb = rr >> 4, nb = rr & 15; W = F.w_down + (size_t)e * 2048 * 2048; WT = WdT + (size_t)e * 2048 * 2048; ldw = 2048; n0 = nb * 128; k0 = kb * 256; } };
    int it = F.bid; if (it >= NI) return;
    const float* W; unsigned char* WT; int ldw, n0, k0; item(it, W, WT, ldw, n0, k0);
#pragma unroll
    for (int i = 0; i < 16; ++i) v[i] = *(const f32x4*)(W + (size_t)(k0 + lrow + 2 * i) * ldw + n0 + lcol);
    for (;;) {
#pragma unroll
        for (int i = 0; i < 16; ++i) *(LAS f32x4*)(tile + (lrow + 2 * i) * 132 + lcol) = v[i];
        __syncthreads();
        unsigned char* dst = WT + (size_t)(n0 + on) * 2048 + k0 + 64 * okq;
        const int nit = it + F.G; const bool more = nit < NI;
        if (more) { item(nit, W, WT, ldw, n0, k0);
#pragma unroll
            for (int i = 0; i < 16; ++i) v[i] = *(const f32x4*)(W + (size_t)(k0 + lrow + 2 * i) * ldw + n0 + lcol); }
        const LAS float* sp = tile + (64 * okq) * 132 + on;
#pragma unroll
        for (int j = 0; j < 4; ++j) { int o[4];
#pragma unroll
            for (int q = 0; q < 4; ++q) { const LAS float* p = sp + (16 * j + 4 * q) * 132; int w_ = __builtin_amdgcn_cvt_pk_fp8_f32(p[0] * 64.0f, p[132] * 64.0f, 0, false); o[q] = __builtin_amdgcn_cvt_pk_fp8_f32(p[264] * 64.0f, p[396] * 64.0f, w_, true); }
            *(v4u*)(dst + 16 * j) = (v4u){(unsigned)o[0], (unsigned)o[1], (unsigned)o[2], (unsigned)o[3]}; }
        __syncthreads();
        if (!more) break; it = nit;
    }
}
__device__ __forceinline__ void phase0(Frame& F) {
    LAS float* scr = (LAS float*)(F.lds + F.wave * 16896);
    const int gw = F.bid * NWAVES + F.wave, NGW = F.G * NWAVES;
    bf16* WinT = (bf16*)(F.ws + WS_WIN); bf16* WsT = (bf16*)(F.ws + WS_WSM); float* Wrt = (float*)(F.ws + WS_WRT); bf16* WoutT = (bf16*)(F.ws + WS_WOUT);
    bf16* XN1 = (bf16*)(F.ws + WS_XN1);
    p0_moe_weights_coop(F);
    constexpr int I_IN = 16 * 352, I_OUT = 32 * 64, NITEMS = I_IN + I_OUT;
    for (int it = gw; it < NITEMS; it += NGW) {
        int r = it;
        if (r < I_IN) { const int kb = r / 352, nb = r % 352, n0 = nb * 32; p0_transpose128<false>(F.w_in, WIN_LD, 2048, WinT, n0, n0 + (n0 >= 5120 ? 32 : 0), kb * 128, scr, F.lane); continue; } r -= I_IN;
        { const int kb = r >> 6, nb = r & 63; p0_transpose128<false>(F.w_out, 2048, 4096, WoutT, nb * 32, nb * 32, kb * 128, scr, F.lane); }
    }
    for (int i = gw * 64 + F.lane; i < 64 * 2048; i += NGW * 64) { const int j = i >> 11, k = i & 2047;
        const int col = j < 32 ? 5120 + j : (j < 40 ? 11296 + (j - 32) : 11304 + (j - 40));
        WsT[i] = (bf16)(j < 48 ? f2bf(F.w_in[(size_t)k * WIN_LD + col]) : 0u); }
    for (int i = gw * 64 + F.lane; i < 2048 * 32; i += NGW * 64) Wrt[i] = F.norm2_w[i >> 5] * F.router_w[i];
    for (int m = gw; m < TT; m += NGW) rms_row_to_bf16(F.x + (size_t)m * DM, F.norm1_w, XN1 + (size_t)m * DM, F.lane);
}

__device__ __forceinline__ void p1_small(Frame& F) {
    const bf16* XN1 = (const bf16*)(F.ws + WS_XN1); const bf16* WsT = (const bf16*)(F.ws + WS_WSM); float* SMALL = (float*)(F.ws + WS_SMALL);
    const int gw = F.bid * NWAVES + F.wave, NGW = F.G * NWAVES, fr = F.lane & 15, fq = F.lane >> 4;
    for (int task = gw; task < TT / 16; task += NGW) {
        const int t0 = task * 16;
        f32x4 acc[4];
#pragma unroll
        for (int n = 0; n < 4; ++n) acc[n] = (f32x4){0.f, 0.f, 0.f, 0.f};
        const bf16* arow = XN1 + (size_t)(t0 + fr) * DM + 8 * fq; const bf16* brow = WsT + (size_t)fr * DM + 8 * fq;
#pragma unroll 16
        for (int ks = 0; ks < 64; ++ks) {
            const bf16x8 a = *(const bf16x8*)(arow + 32 * ks);
#pragma unroll
            for (int n = 0; n < 4; ++n) { const bf16x8 b = *(const bf16x8*)(brow + (size_t)n * 16 * DM + 32 * ks); acc[n] = __builtin_amdgcn_mfma_f32_16x16x32_bf16(a, b, acc[n], 0, 0, 0); }
        }
#pragma unroll
        for (int n = 0; n < 4; ++n)
#pragma unroll
            for (int r = 0; r < 4; ++r) SMALL[(size_t)(t0 + 4 * fq + r) * 64 + n * 16 + fr] = acc[n][r];
    }
}

__device__ __forceinline__ void unpack8(const v4u r, float (&f)[8]) { f[0] = bflo(r.x); f[1] = bfhi(r.x); f[2] = bflo(r.y); f[3] = bfhi(r.y); f[4] = bflo(r.z); f[5] = bfhi(r.z); f[6] = bflo(r.w); f[7] = bfhi(r.w); }

__device__ __forceinline__ void phase_conv(Frame& F) {
    const bf16* PROJ = (const bf16*)(F.ws + WS_PROJ); bf16* XC = (bf16*)(F.ws + WS_XC);
    constexpr int TB = 16, NCG = 384, NIT = (TT / TB) * NCG;
    for (int it = F.bid * (NWAVES * 64) + F.tid; it < NIT; it += F.G * NWAVES * 64) {
        const int cg = it % NCG, tb = it / NCG, ch = cg * 8, t0 = tb * TB; const bool seq0 = (t0 % SEQ) == 0;
        float w[4][8], bs[8];
#pragma unroll
        for (int j = 0; j < 4; ++j) { const f32x4 a = *(const f32x4*)(F.conv_w + j * 3072 + ch), b = *(const f32x4*)(F.conv_w + j * 3072 + ch + 4);
            w[j][0] = a.x; w[j][1] = a.y; w[j][2] = a.z; w[j][3] = a.w; w[j][4] = b.x; w[j][5] = b.y; w[j][6] = b.z; w[j][7] = b.w; }
        { const f32x4 a = *(const f32x4*)(F.conv_b + ch), b = *(const f32x4*)(F.conv_b + ch + 4); bs[0] = a.x; bs[1] = a.y; bs[2] = a.z; bs[3] = a.w; bs[4] = b.x; bs[5] = b.y; bs[6] = b.z; bs[7] = b.w; }
        const bf16* src = PROJ + (size_t)t0 * NPROJ + PC_XBC + ch;
        float r0[8], r1[8], r2[8], r3[8];
        if (seq0) {
#pragma unroll
            for (int i = 0; i < 8; ++i) { r0[i] = 0.f; r1[i] = 0.f; r2[i] = 0.f; }
        } else { unpack8(*(const v4u*)(src - 3 * (size_t)NPROJ), r0); unpack8(*(const v4u*)(src - 2 * (size_t)NPROJ), r1); unpack8(*(const v4u*)(src - (size_t)NPROJ), r2); }
        v4u rw[TB];
#pragma unroll
        for (int l = 0; l < TB; ++l) rw[l] = *(const v4u*)(src + (size_t)l * NPROJ);
#pragma unroll
        for (int l = 0; l < TB; ++l) {
            unpack8(rw[l], r3);
            float o[8];
#pragma unroll
            for (int i = 0; i < 8; ++i) { const float v = bs[i] + w[0][i] * r0[i] + w[1][i] * r1[i] + w[2][i] * r2[i] + w[3][i] * r3[i]; o[i] = siluf(v); r0[i] = r1[i]; r1[i] = r2[i]; r2[i] = r3[i]; }
            v4u ov; ov.x = pk2(o[0], o[1]); ov.y = pk2(o[2], o[3]); ov.z = pk2(o[4], o[5]); ov.w = pk2(o[6], o[7]);
            *(v4u*)(XC + (size_t)(t0 + l) * 3072 + ch) = ov;
        }
    }
}

constexpr int MX_PITCH = 272;
static_assert(true, "");
constexpr int MX_QM = 0, MX_KM = 34816, MX_KW = 69632, MX_VT = 104448, MX_SI = 121856, MX_VEC = 139264, MX_VECB = 3072, MX_NVEC = MX_VEC + 2 * MX_VECB, MX_SCAL = MX_NVEC + 512, MX_END = MX_SCAL + 64;
__device__ __forceinline__ unsigned cvt_pk_bf16_nop(float lo, float hi) { unsigned r; asm volatile("v_cvt_pk_bf16_f32 %0, %1, %2\n\ts_nop 1" : "=v"(r) : "v"(lo), "v"(hi)); return r; }
__device__ __forceinline__ int mx_sw(int row, int tbyte) { return row * MX_PITCH + ((((tbyte >> 4) ^ (row >> 3)) & 15) << 4) + (tbyte & 15); }
__device__ __forceinline__ bf16x8 lds_frag(const LAS unsigned char* img, int row, int kbyte) { return *(const LAS bf16x8*)(img + row * MX_PITCH + kbyte); }
static_assert(MX_END + 256 <= LDSCTL_OFF, "mixer LDS map");
template <bool ML> __device__ __forceinline__ void mixer_unit(Frame& F, int unit) {
    const bf16* PROJ = (const bf16*)(F.ws + WS_PROJ); const bf16* XC = (const bf16*)(F.ws + WS_XC); const float* SMALL = (const float*)(F.ws + WS_SMALL);
    bf16* YMIX = (bf16*)(F.ws + WS_YMIX); float* SSQ = (float*)(F.ws + WS_SSQ);
    const int w = F.wave, fr = F.lane & 15, fq = F.lane >> 4, tid = F.tid;
    const int b = unit >> 5, tok0 = b * SEQ, hd = unit & 31, grp = hd >> 3, mh = (unit & 31) >> 2, vq = unit & 3;
    const float qs = 0.08838834764831845f;
    LAS unsigned char* QM = F.lds + MX_QM; LAS unsigned char* KM = F.lds + MX_KM; LAS unsigned char* KW = F.lds + MX_KW; LAS unsigned char* VT = F.lds + MX_VT; LAS unsigned char* SI = F.lds + MX_SI;
    LAS float* exch = (LAS float*)(F.lds + MX_VEC + (w >> 2) * MX_VECB + 1024) + (w & 3) * 32;
    LAS float* nvec = (LAS float*)(F.lds + MX_NVEC); LAS float* scal = (LAS float*)(F.lds + MX_SCAL);
    const int fr3 = fr >> 3;
    int vtb[2];
#pragma unroll
    for (int p = 0; p < 2; ++p) vtb[p] = fr * MX_PITCH + ((fq ^ ((2 * p) | fr3)) << 4);
    int vpb[2][2];
#pragma unroll
    for (int p = 0; p < 2; ++p)
#pragma unroll
        for (int h = 0; h < 2; ++h) vpb[p][h] = fr * MX_PITCH + (((((fq >> 1) | (2 * h)) ^ ((2 * p) | fr3))) << 4) + 8 * (fq & 1);
    const int kwb = (16 * w + fr) * MX_PITCH + ((fq ^ ((2 * (w & 1)) | fr3)) << 4), kwh = w >> 1;

    const bf16* qsrc; const bf16* ksrc; const bf16* vsrc; int ld;
    if (ML) { qsrc = PROJ + PC_Q + mh * 128; ksrc = PROJ + PC_K + mh * 128; vsrc = PROJ + PC_V + mh * 256 + vq * 64; ld = NPROJ; }
    else { qsrc = XC + 2560 + grp * 128; ksrc = XC + 2048 + grp * 128; vsrc = XC + hd * 64; ld = 3072; }
    const float c_a = ML ? 0.f : -expf(F.a_log[hd]), c_dtb = ML ? 0.f : F.dt_bias[hd], c_D = ML ? 0.f : F.d_skip[hd], c_ib = ML ? F.i_bias[mh] : 0.f, c_fb = ML ? F.f_bias[mh] : 0.f;
    float mprev = 0.f;
    f32x4 sacc[4]; float nreg = 0.f;
#pragma unroll
    for (int j = 0; j < 4; ++j) sacc[j] = (f32x4){0.f, 0.f, 0.f, 0.f};
    v4u pq[4], pk[4], pv[2];
    float vA0 = 0.f, vA1 = 0.f, vB0 = 0.f, vB1 = 0.f, vC0 = 0.f, vC1 = 0.f, vD0 = 0.f, vD1 = 0.f, vE0 = 0.f, vE1 = 0.f, vG0 = 0.f, vG1 = 0.f, vSA = 0.f, vSG = 0.f;
    float sl0 = 0.f, sl1 = 0.f, sl2 = 0.f, sl3 = 0.f;
#define MX_SCAN_L(c) do { if (w == 0) { const size_t tt = (size_t)(tok0 + 128 * (c) + 2 * F.lane); \
        if (!ML) { sl0 = SMALL[tt * 64 + hd]; sl1 = SMALL[(tt + 1) * 64 + hd]; } \
        else { sl0 = SMALL[tt * 64 + 32 + mh]; sl1 = SMALL[(tt + 1) * 64 + 32 + mh]; sl2 = SMALL[tt * 64 + 40 + mh]; sl3 = SMALL[(tt + 1) * 64 + 40 + mh]; } } } while (0)
#define MX_SOFTPLUS(x) ((x) > 20.f ? (x) : __logf(1.0f + __expf(x)))
#define MX_LOGSIG(x) (fminf((x), 0.f) - __logf(1.0f + __expf(-fabsf(x))))
#define MX_SCAN_A(c) do { if (w == 0) { \
        if (!ML) { const float d0 = MX_SOFTPLUS(sl0 + c_dtb), d1 = MX_SOFTPLUS(sl1 + c_dtb); \
            const float x0 = d0 * c_a, x1 = d1 * c_a; float incl = x0 + x1; \
            _Pragma("unroll") for (int d = 1; d < 64; d <<= 1) { const float t_ = __shfl_up(incl, d); if (F.lane >= d) incl += t_; } \
            const float cum1 = incl, cum0 = incl - x1, tot = __shfl(incl, 63); \
            vA0 = -cum0; vA1 = -cum1; vB0 = -cum0; vB1 = -cum1; vC0 = d0; vC1 = d1; vD0 = __expf(cum0); vD1 = __expf(cum1); vE0 = d0 * __expf(tot - cum0); vE1 = d1 * __expf(tot - cum1); vSA = __expf(tot); vSG = 1.0f; \
        } else { const float li0 = sl0 + c_ib, li1 = sl1 + c_ib; \
            const float x0 = MX_LOGSIG(sl2 + c_fb), x1 = MX_LOGSIG(sl3 + c_fb); float incl = x0 + x1; \
            _Pragma("unroll") for (int d = 1; d < 64; d <<= 1) { const float t_ = __shfl_up(incl, d); if (F.lane >= d) incl += t_; } \
            const float cum1 = incl, cum0 = incl - x1, btot = __shfl(incl, 63); \
            const float dd0 = li0 - cum0, dd1 = li1 - cum1; float im = fmaxf(dd0, dd1); \
            _Pragma("unroll") for (int d = 1; d < 64; d <<= 1) { const float t_ = __shfl_up(im, d); if (F.lane >= d) im = fmaxf(im, t_); } \
            float pm = __shfl_up(im, 1); if (F.lane == 0) pm = -3.0e38f; const float pmax0 = fmaxf(pm, dd0), pmax1 = im, pm127 = __shfl(im, 63); \
            const float M0 = fmaxf(mprev, pmax0), M1 = fmaxf(mprev, pmax1); \
            vA0 = dd0; vA1 = dd1; vB0 = M0; vB1 = M1; vD0 = qs * __expf(mprev - M0); vD1 = qs * __expf(mprev - M1); vG0 = __expf(-(cum0 + M0)); vG1 = __expf(-(cum1 + M1)); \
            const float mloc = btot + pm127, mnew = fmaxf(btot + mprev, mloc); \
            vSA = __expf(btot + mprev - mnew); vSG = __expf(mloc - mnew); vE0 = __expf(dd0 - pm127) * vSG; vE1 = __expf(dd1 - pm127) * vSG; mprev = mnew; } } } while (0)
#define MX_SCAN_B(c) do { if (w == 0) { \
        LAS float* vb = (LAS float*)(F.lds + MX_VEC + ((c) & 1) * MX_VECB); const int l0 = 2 * F.lane; \
        *(LAS f32x2*)(vb + l0) = (f32x2){vA0, vA1}; *(LAS f32x2*)(vb + 128 + l0) = (f32x2){vB0, vB1}; if (!ML) *(LAS f32x2*)(vb + 256 + l0) = (f32x2){vC0, vC1}; \
        *(LAS f32x2*)(vb + 384 + l0) = (f32x2){vD0, vD1}; *(LAS f32x2*)(vb + 512 + l0) = (f32x2){vE0, vE1}; if (ML) *(LAS f32x2*)(vb + 640 + l0) = (f32x2){vG0, vG1}; \
        if (F.lane == 0) { scal[2 * ((c) & 1)] = vSA; scal[2 * ((c) & 1) + 1] = vSG; } } } while (0)
#define MX_SCAN(c) do { MX_SCAN_L(c); MX_SCAN_A(c); MX_SCAN_B(c); } while (0)
#define MX_PREFETCH(c) do { const size_t tb_ = (size_t)(tok0 + 128 * (c)); \
        _Pragma("unroll") for (int i = 0; i < 2; ++i) { const int pid = tid + 512 * i, a2 = pid >> 4, k8 = pid & 15; \
            pq[2 * i] = *(const v4u*)(qsrc + (tb_ + 2 * a2) * ld + 8 * k8); pq[2 * i + 1] = *(const v4u*)(qsrc + (tb_ + 2 * a2 + 1) * ld + 8 * k8); \
            pk[2 * i] = *(const v4u*)(ksrc + (tb_ + 2 * a2) * ld + 8 * k8); pk[2 * i + 1] = *(const v4u*)(ksrc + (tb_ + 2 * a2 + 1) * ld + 8 * k8); } \
        { const int a2 = tid >> 3, v8 = tid & 7; pv[0] = *(const v4u*)(vsrc + (tb_ + 2 * a2) * ld + 8 * v8); pv[1] = *(const v4u*)(vsrc + (tb_ + 2 * a2 + 1) * ld + 8 * v8); } } while (0)
#define MX_WRITE(c) do { const LAS float* vb = (const LAS float*)(F.lds + MX_VEC + ((c) & 1) * MX_VECB); \
        _Pragma("unroll") for (int i = 0; i < 2; ++i) { const int pid = tid + 512 * i, a2 = pid >> 4, k8 = pid & 15, l = 2 * a2; \
            *(LAS v4u*)(QM + l * MX_PITCH + 16 * k8) = pq[2 * i]; *(LAS v4u*)(QM + (l + 1) * MX_PITCH + 16 * k8) = pq[2 * i + 1]; \
            *(LAS v4u*)(KM + l * MX_PITCH + 16 * k8) = pk[2 * i]; *(LAS v4u*)(KM + (l + 1) * MX_PITCH + 16 * k8) = pk[2 * i + 1]; \
            float f0[8], f1[8]; unpack8(pk[2 * i], f0); unpack8(pk[2 * i + 1], f1); const f32x2 wl = *(const LAS f32x2*)(vb + 512 + l); \
            _Pragma("unroll") for (int e = 0; e < 8; ++e) *(LAS unsigned*)(KW + mx_sw(8 * k8 + e, 2 * l)) = pg8::cvt_pk_bf16(f0[e] * wl.x, f1[e] * wl.y); } \
        { const int a2 = tid >> 3, v8 = tid & 7, l = 2 * a2; const v4u r0 = pv[0], r1 = pv[1]; LAS unsigned char* vp_ = VT + mx_sw(8 * v8, 2 * l); \
            *(LAS unsigned*)(vp_ + 0 * MX_PITCH) = (r0.x & 0xffffu) | (r1.x << 16); *(LAS unsigned*)(vp_ + 1 * MX_PITCH) = (r0.x >> 16) | (r1.x & 0xffff0000u); \
            *(LAS unsigned*)(vp_ + 2 * MX_PITCH) = (r0.y & 0xffffu) | (r1.y << 16); *(LAS unsigned*)(vp_ + 3 * MX_PITCH) = (r0.y >> 16) | (r1.y & 0xffff0000u); \
            *(LAS unsigned*)(vp_ + 4 * MX_PITCH) = (r0.z & 0xffffu) | (r1.z << 16); *(LAS unsigned*)(vp_ + 5 * MX_PITCH) = (r0.z >> 16) | (r1.z & 0xffff0000u); \
            *(LAS unsigned*)(vp_ + 6 * MX_PITCH) = (r0.w & 0xffffu) | (r1.w << 16); *(LAS unsigned*)(vp_ + 7 * MX_PITCH) = (r0.w >> 16) | (r1.w & 0xffff0000u); } \
        _Pragma("unroll") for (int j = 0; j < 4; ++j) { v2u sv; sv.x = pg8::cvt_pk_bf16(sacc[j][0], sacc[j][1]); sv.y = pg8::cvt_pk_bf16(sacc[j][2], sacc[j][3]); *(LAS v2u*)(SI + (16 * j + fr) * MX_PITCH + (16 * w + 4 * fq) * 2) = sv; } \
        if (ML && fq == 0) nvec[16 * w + fr] = nreg; } while (0)
    const int gcol = (ML ? PC_O + mh * 256 + vq * 64 : PC_Z + hd * 64) + 16 * (F.lane & 3);
    LAS float* nwl = (LAS float*)(F.lds + MX_END);
    if (tid < 64) nwl[tid] = ML ? F.ml_norm_w[mh * 256 + vq * 64 + tid] : F.ssd_norm_w[hd * 64 + tid];
    v4u zc0 = (v4u){0u, 0u, 0u, 0u}, zc1 = zc0;
    { const bf16* zp = PROJ + (size_t)(tok0 + 16 * w + (F.lane >> 2)) * NPROJ + gcol; zc0 = *(const v4u*)zp; zc1 = *(const v4u*)(zp + 8); }
    MX_SCAN(0);
    MX_PREFETCH(0);
    __syncthreads();
    MX_WRITE(0);
    __syncthreads();
    for (int c = 0; c < SEQ / 128; ++c) {
        const LAS float* vb = (const LAS float*)(F.lds + MX_VEC + (c & 1) * MX_VECB);
        const bool more = (c + 1 < SEQ / 128);
        if (more) { MX_SCAN_L(c + 1); MX_PREFETCH(c + 1); }
        bf16x8 qf[4];
#pragma unroll
        for (int ks = 0; ks < 4; ++ks) qf[ks] = lds_frag(QM, 16 * w + fr, 64 * ks + 16 * fq);
        const float mlv = vb[128 + 16 * w + fr];
        float dsum = 0.f;
        f32x4 y1[4];
#pragma unroll
        for (int j = 0; j < 4; ++j) y1[j] = (f32x4){0.f, 0.f, 0.f, 0.f};
        const f32x4 rs4 = *(const LAS f32x4*)(vb + 384 + 16 * w + 4 * fq);
#pragma unroll
        for (int ks = 0; ks < 4; ++ks) { bf16x8 sf[4];
#pragma unroll
            for (int j = 0; j < 4; ++j) sf[j] = lds_frag(SI, 16 * j + fr, 64 * ks + 16 * fq);
#pragma unroll
            for (int j = 0; j < 4; ++j) y1[j] = __builtin_amdgcn_mfma_f32_16x16x32_bf16(qf[ks], sf[j], y1[j], 0, 0, 0); }
#pragma unroll
        for (int j = 0; j < 4; ++j) y1[j] = y1[j] * rs4;
        __builtin_amdgcn_sched_barrier(0);
#pragma unroll 1
        for (int k2 = 0; 2 * k2 <= w; ++k2) {
            unsigned pw[4];
#pragma unroll
            for (int h = 0; h < 2; ++h) {
                const int si = 2 * k2 + h;
                f32x4 acc = (f32x4){0.f, 0.f, 0.f, 0.f};
#pragma unroll
                for (int ks = 0; ks < 4; ++ks) acc = __builtin_amdgcn_mfma_f32_16x16x32_bf16(lds_frag(KM, 16 * si + fr, 64 * ks + 16 * fq), qf[ks], acc, 0, 0, 0);
                const f32x4 e4 = *(const LAS f32x4*)(vb + 16 * si + 4 * fq); f32x4 x4 = (f32x4){qs, qs, qs, qs}; if (!ML) x4 = *(const LAS f32x4*)(vb + 256 + 16 * si + 4 * fq);
                float p[4];
#pragma unroll
                for (int r = 0; r < 4; ++r) { const float v = acc[r] * __expf(e4[r] - mlv) * x4[r]; const bool ok = (si < w) || (si == w && 4 * fq + r <= fr); p[r] = ok ? v : 0.f; }
                if (ML) dsum += (p[0] + p[1]) + (p[2] + p[3]);
                pw[2 * h] = cvt_pk_bf16_nop(p[0], p[1]); pw[2 * h + 1] = cvt_pk_bf16_nop(p[2], p[3]);
            }
            HWAIT();
            const v4u pwv = (v4u){pw[0], pw[1], pw[2], pw[3]}; const bf16x8 pf = __builtin_bit_cast(bf16x8, pwv);
#pragma unroll
            for (int j = 0; j < 4; ++j) { const int ho = j * 16 * MX_PITCH + ((k2 ^ (j >> 1)) << 6); const v2u lo = *(const LAS v2u*)(VT + vpb[j & 1][0] + ho), hi = *(const LAS v2u*)(VT + vpb[j & 1][1] + ho); const v4u vw = (v4u){lo.x, lo.y, hi.x, hi.y};
                y1[j] = __builtin_amdgcn_mfma_f32_16x16x32_bf16(pf, __builtin_bit_cast(bf16x8, vw), y1[j], 0, 0, 0); }
            HWAIT();
        }
        HSYNC();
        __builtin_amdgcn_sched_barrier(0);
        __builtin_amdgcn_sched_barrier(0);
        if (ML) {
            dsum += __shfl_xor(dsum, 16); dsum += __shfl_xor(dsum, 32);
            float d2 = 0.f;
#pragma unroll
            for (int ks = 0; ks < 4; ++ks) { float qv[8]; unpack8(__builtin_bit_cast(v4u, qf[ks]), qv); const f32x4 n0 = *(const LAS f32x4*)(nvec + 32 * ks + 8 * fq), n1 = *(const LAS f32x4*)(nvec + 32 * ks + 8 * fq + 4);
                d2 += qv[0] * n0.x + qv[1] * n0.y + qv[2] * n0.z + qv[3] * n0.w + qv[4] * n1.x + qv[5] * n1.y + qv[6] * n1.z + qv[7] * n1.w; }
            d2 += __shfl_xor(d2, 16); d2 += __shfl_xor(d2, 32);
            if (fq == 0) { exch[fr] = dsum; exch[16 + fr] = d2; }
        }
        HSYNC();
        __builtin_amdgcn_sched_barrier(0);
        LAS float* stg = (LAS float*)(QM + 16 * w * MX_PITCH);
        if (ML) { const f32x4 fl4 = *(const LAS f32x4*)(vb + 640 + 16 * w + 4 * fq); const f32x4 dA = *(const LAS f32x4*)(exch + 4 * fq), dB = *(const LAS f32x4*)(exch + 16 + 4 * fq);
#pragma unroll
            for (int r = 0; r < 4; ++r) { const float den = fmaxf(fabsf(dA[r] + rs4[r] * dB[r]), fl4[r]); const float inv = __builtin_amdgcn_rcpf(den);
#pragma unroll
                for (int j = 0; j < 4; ++j) stg[(4 * fq + r) * 68 + 16 * j + fr] = y1[j][r] * inv; }
        } else {
#pragma unroll
            for (int j = 0; j < 4; ++j) { const v2u xw = *(const LAS v2u*)(VT + mx_sw(16 * j + fr, 32 * w + 8 * fq)); const float xs[4] = {bflo(xw.x), bfhi(xw.x), bflo(xw.y), bfhi(xw.y)};
#pragma unroll
                for (int r = 0; r < 4; ++r) stg[(4 * fq + r) * 68 + 16 * j + fr] = y1[j][r] + c_D * xs[r]; }
        }
        {   const int erow = F.lane >> 2, ecs = F.lane & 3; const size_t trow = (size_t)(tok0 + 128 * c + 16 * w + erow);
            float yv[16];
#pragma unroll
            for (int i = 0; i < 4; ++i) { const f32x4 t4 = *(const LAS f32x4*)(stg + erow * 68 + 16 * ecs + 4 * i); yv[4 * i] = t4.x; yv[4 * i + 1] = t4.y; yv[4 * i + 2] = t4.z; yv[4 * i + 3] = t4.w; }
            float zf[16]; { float t8[8]; unpack8(zc0, t8);
#pragma unroll
                for (int i = 0; i < 8; ++i) zf[i] = t8[i]; unpack8(zc1, t8);
#pragma unroll
                for (int i = 0; i < 8; ++i) zf[8 + i] = t8[i]; }
            if (!ML) {
#pragma unroll
                for (int i = 0; i < 16; ++i) yv[i] = yv[i] * zf[i] * __builtin_amdgcn_rcpf(1.0f + __expf(-zf[i])); }
            float ss = 0.f;
#pragma unroll
            for (int i = 0; i < 16; ++i) ss += yv[i] * yv[i];
            ss += __shfl_xor(ss, 1); ss += __shfl_xor(ss, 2);
            if (ecs == 0) SSQ[(ML ? (size_t)TT * 32 : 0) + trow * 32 + (ML ? mh * 4 + vq : hd)] = ss;
#pragma unroll
            for (int i = 0; i < 4; ++i) { const f32x4 w4 = *(const LAS f32x4*)(nwl + 16 * ecs + 4 * i);
                yv[4 * i] *= w4.x; yv[4 * i + 1] *= w4.y; yv[4 * i + 2] *= w4.z; yv[4 * i + 3] *= w4.w; }
            if (ML) {
#pragma unroll
                for (int i = 0; i < 16; ++i) yv[i] *= __builtin_amdgcn_rcpf(1.0f + __expf(-zf[i])); }
            bf16* yp = YMIX + trow * 4096 + (ML ? 2048 + mh * 256 + vq * 64 : hd * 64) + 16 * ecs;
            *(v4u*)yp = (v4u){pg8::cvt_pk_bf16(yv[0], yv[1]), pg8::cvt_pk_bf16(yv[2], yv[3]), pg8::cvt_pk_bf16(yv[4], yv[5]), pg8::cvt_pk_bf16(yv[6], yv[7])};
            *(v4u*)(yp + 8) = (v4u){pg8::cvt_pk_bf16(yv[8], yv[9]), pg8::cvt_pk_bf16(yv[10], yv[11]), pg8::cvt_pk_bf16(yv[12], yv[13]), pg8::cvt_pk_bf16(yv[14], yv[15])};
            if (more) { const bf16* zp = PROJ + (size_t)(tok0 + 128 * (c + 1) + 16 * w + (F.lane >> 2)) * NPROJ + gcol; zc0 = *(const v4u*)zp; zc1 = *(const v4u*)(zp + 8); }
        }
        __builtin_amdgcn_sched_barrier(0);
        const float sa = scal[2 * (c & 1)];
#pragma unroll
        for (int j = 0; j < 4; ++j) sacc[j] = sacc[j] * sa;
        float nsum = 0.f;
#pragma unroll
        for (int ks = 0; ks < 4; ++ks) { const bf16x8 kf = *(const LAS bf16x8*)(KW + kwb + ((ks ^ kwh) << 6)); bf16x8 vf[4];
#pragma unroll
            for (int j = 0; j < 4; ++j) vf[j] = *(const LAS bf16x8*)(VT + vtb[j & 1] + j * 16 * MX_PITCH + ((ks ^ (j >> 1)) << 6));
            if (ML) { float kv[8]; unpack8(__builtin_bit_cast(v4u, kf), kv); nsum += ((kv[0] + kv[1]) + (kv[2] + kv[3])) + ((kv[4] + kv[5]) + (kv[6] + kv[7])); }
#pragma unroll
            for (int j = 0; j < 4; ++j) sacc[j] = __builtin_amdgcn_mfma_f32_16x16x32_bf16(kf, vf[j], sacc[j], 0, 0, 0); }
        if (ML) { nsum += __shfl_xor(nsum, 16); nsum += __shfl_xor(nsum, 32); nreg = nreg * sa + nsum; }
        if (more) { MX_SCAN_A(c + 1); }
        __syncthreads();
        if (more) { MX_SCAN_B(c + 1); }
        __syncthreads();
        if (more) { MX_WRITE(c + 1); }
        __syncthreads();
    }
#undef MX_SCAN
#undef MX_SCAN_A
#undef MX_SCAN_L
#undef MX_SOFTPLUS
#undef MX_LOGSIG
#undef MX_SCAN_B
#undef MX_PREFETCH
#undef MX_WRITE
}
__device__ __forceinline__ void phase_mixer(Frame& F) {
    for (int unit = F.bid; unit < 256; unit += F.G) { mixer_unit<false>(F, unit); mixer_unit<true>(F, unit); }
}

__device__ __forceinline__ void phase3(Frame& F) {
    const bf16* PROJ = (const bf16*)(F.ws + WS_PROJ); bf16* YMIX = (bf16*)(F.ws + WS_YMIX); const float* SSQ = (const float*)(F.ws + WS_SSQ);
    const int gw = F.bid * NWAVES + F.wave, NGW = F.G * NWAVES;
    for (int t = gw; t < TT; t += NGW) {
        bf16* yrow = YMIX + (size_t)t * 4096;
#pragma unroll
        for (int j = 0; j < 8; ++j) {
            const int c0 = (j * 64 + F.lane) * 8;
            float y[8]; unpack8(*(const v4u*)(yrow + c0), y);
            float o[8];
            if (j < 4) {
                const int g = c0 >> 9; const f32x4 s0 = *(const f32x4*)(SSQ + (size_t)t * 32 + g * 8), s1 = *(const f32x4*)(SSQ + (size_t)t * 32 + g * 8 + 4);
                const float ms = ((s0.x + s0.y) + (s0.z + s0.w) + (s1.x + s1.y) + (s1.z + s1.w)) * (1.0f / 512.0f);
                const float rs = 1.0f / sqrtf(ms + EPSF);
                const f32x4 w0 = *(const f32x4*)(F.ssd_norm_w + c0), w1 = *(const f32x4*)(F.ssd_norm_w + c0 + 4);
                o[0] = y[0] * rs * w0.x; o[1] = y[1] * rs * w0.y; o[2] = y[2] * rs * w0.z; o[3] = y[3] * rs * w0.w;
                o[4] = y[4] * rs * w1.x; o[5] = y[5] * rs * w1.y; o[6] = y[6] * rs * w1.z; o[7] = y[7] * rs * w1.w;
            } else {
                const int cc = c0 - 2048, h = cc >> 8; const f32x4 s0 = *(const f32x4*)(SSQ + (size_t)TT * 32 + (size_t)t * 32 + h * 4);
                const float ms = ((s0.x + s0.y) + (s0.z + s0.w)) * (1.0f / 256.0f);
                const float rs = 1.0f / sqrtf(ms + EPSF);
                const f32x4 w0 = *(const f32x4*)(F.ml_norm_w + cc), w1 = *(const f32x4*)(F.ml_norm_w + cc + 4);
                float og[8]; unpack8(*(const v4u*)(PROJ + (size_t)t * NPROJ + PC_O + cc), og);
                const float wv[8] = {w0.x, w0.y, w0.z, w0.w, w1.x, w1.y, w1.z, w1.w};
#pragma unroll
                for (int i = 0; i < 8; ++i) o[i] = y[i] * rs * wv[i] * __builtin_amdgcn_rcpf(1.0f + __expf(-og[i]));
            }
            v4u ov; ov.x = pk2(o[0], o[1]); ov.y = pk2(o[2], o[3]); ov.z = pk2(o[4], o[5]); ov.w = pk2(o[6], o[7]);
            *(v4u*)(yrow + c0) = ov;
        }
    }
}

__device__ __forceinline__ void phase5(Frame& F) {
    const float* H2 = (const float*)(F.ws + WS_H2); const float* Wrt = (const float*)(F.ws + WS_WRT); bf16* XN2 = (bf16*)(F.ws + WS_XN2);
    int* EIDX = (int*)(F.ws + WS_ROUTE); int* RANK = EIDX + TT * 4;
    int* TOKL = (int*)(F.ws + WS_XG); float* GATEL = (float*)(F.ws + WS_XG + 4 * MiB);
    LAS float* xT = (LAS float*)(F.lds + F.wave * 8192); LAS float* lg = (LAS float*)(F.lds + 65536 + F.wave * 1024);
    LAS int* cntl = (LAS int*)(F.lds + 73728); LAS int* baseg = cntl + 32;
    const int gw = F.bid * NWAVES + F.wave, NGW = F.G * NWAVES, ntask = TT / 8, iters = (ntask + NGW - 1) / NGW;
    for (int itx = 0; itx < iters; ++itx) {
        const int task = itx * NGW + gw; const bool valid = task < ntask; const int t0 = task * 8;
        if (F.tid < 32) cntl[F.tid] = 0;
        __syncthreads();
        float rstd[8]; int me[4] = {0, 0, 0, 0}, mr[4] = {0, 0, 0, 0}; float mg[4] = {0.f, 0.f, 0.f, 0.f};
#pragma unroll
        for (int k = 0; k < 8; ++k) rstd[k] = 0.f;
        float acc[8], ssq[8];
#pragma unroll
        for (int k = 0; k < 8; ++k) { acc[k] = 0.f; ssq[k] = 0.f; }
        const int e = F.lane & 31, dh = F.lane >> 5;
        LAS float* wl = (LAS float*)(F.lds + 81920);
        for (int dc = 0; dc < 8; ++dc) {
            __syncthreads();
#pragma unroll
            for (int q = 0; q < 4; ++q) ((LAS f32x4*)wl)[F.tid + 512 * q] = ((const f32x4*)(Wrt + (size_t)dc * 256 * 32))[F.tid + 512 * q];
            if (valid) {
                f32x4 xk[8];
#pragma unroll
                for (int k = 0; k < 8; ++k) { xk[k] = *(const f32x4*)(H2 + (size_t)(t0 + k) * DM + dc * 256 + 4 * F.lane); ssq[k] += (xk[k].x * xk[k].x + xk[k].y * xk[k].y) + (xk[k].z * xk[k].z + xk[k].w * xk[k].w); }
#pragma unroll
                for (int jj = 0; jj < 4; ++jj) { LAS float* dp = xT + (jj * 64 + F.lane) * 8;
                    *(LAS f32x4*)dp = (f32x4){xk[0][jj], xk[1][jj], xk[2][jj], xk[3][jj]}; *(LAS f32x4*)(dp + 4) = (f32x4){xk[4][jj], xk[5][jj], xk[6][jj], xk[7][jj]}; }
            }
            __syncthreads();
            if (valid) {
                const LAS float* xp = xT + dh * 128 * 8;
#pragma unroll 8
                for (int i = 0; i < 128; ++i) { const float w = wl[(4 * (i & 63) + 2 * dh + (i >> 6)) * 32 + e];     const f32x4 xa = *(const LAS f32x4*)(xp + i * 8), xb = *(const LAS f32x4*)(xp + i * 8 + 4);
                    acc[0] += w * xa.x; acc[1] += w * xa.y; acc[2] += w * xa.z; acc[3] += w * xa.w; acc[4] += w * xb.x; acc[5] += w * xb.y; acc[6] += w * xb.z; acc[7] += w * xb.w; }
            }
        }
        if (valid) {
            const float rb = F.router_b[e];
#pragma unroll
            for (int k = 0; k < 8; ++k) { rstd[k] = 1.0f / sqrtf(wave_sum(ssq[k]) * (1.0f / 2048.0f) + EPSF);
                const float v = (acc[k] + __shfl_xor(acc[k], 32)) * rstd[k] + rb; if (F.lane < 32) lg[k * 32 + e] = v; }
            LDS_WAIT(); asm volatile("" ::: "memory");
            if (F.lane < 8) {
                const LAS float* lp = lg + F.lane * 32; float bv[4]; int bi[4] = {-1, -1, -1, -1};
#pragma unroll
                for (int p = 0; p < 4; ++p) { float best = -3.0e38f; int bidx = 0;
                    for (int q = 0; q < 32; ++q) { const float v = lp[q]; const bool taken = (q == bi[0]) | (q == bi[1]) | (q == bi[2]) | (q == bi[3]); if (!taken && v > best) { best = v; bidx = q; } }
                    bv[p] = best; bi[p] = bidx; }
                const float p1 = expf(bv[1] - bv[0]), p2 = expf(bv[2] - bv[0]), p3 = expf(bv[3] - bv[0]); const float inv = 1.0f / (1.0f + p1 + p2 + p3);
                mg[0] = inv; mg[1] = p1 * inv; mg[2] = p2 * inv; mg[3] = p3 * inv;
#pragma unroll
                for (int p = 0; p < 4; ++p) { me[p] = bi[p]; mr[p] = __hip_atomic_fetch_add(cntl + bi[p], 1, __ATOMIC_RELAXED, __HIP_MEMORY_SCOPE_WORKGROUP); }
            }
        }
        __syncthreads();
        if (F.tid < 32) { const int c = cntl[F.tid]; int gb = 0; if (c > 0) gb = (int)__hip_atomic_fetch_add((unsigned*)(F.ctl + CW_CNT + 64 * F.tid), (unsigned)c, RLX_AGENT); baseg[F.tid] = gb; }
        __syncthreads();
        if (valid) {
            if (F.lane < 8) { const size_t t = (size_t)(t0 + F.lane);
#pragma unroll
                for (int p = 0; p < 4; ++p) { const int rk = baseg[me[p]] + mr[p]; EIDX[t * 4 + p] = me[p]; RANK[t * 4 + p] = rk; TOKL[(size_t)me[p] * TT + rk] = (int)t; GATEL[(size_t)me[p] * TT + rk] = mg[p]; } }
#pragma unroll
            for (int k = 0; k < 8; ++k) { const f32x4* xr = (const f32x4*)(H2 + (size_t)(t0 + k) * DM) + F.lane; const f32x4* wr = (const f32x4*)F.norm2_w + F.lane; int* o4 = (int*)((unsigned char*)XN2 + (size_t)(t0 + k) * DM) + F.lane;
#pragma unroll
                for (int j = 0; j < 8; ++j) { const f32x4 v = xr[64 * j], ww = wr[64 * j]; int o = __builtin_amdgcn_cvt_pk_fp8_f32(v.x * rstd[k] * ww.x, v.y * rstd[k] * ww.y, 0, false); o = __builtin_amdgcn_cvt_pk_fp8_f32(v.z * rstd[k] * ww.z, v.w * rstd[k] * ww.w, o, true); o4[64 * j] = o; } }
        }
        __syncthreads();
    }
}
__device__ __forceinline__ int build_moe_tab(Frame& F) {
    LAS unsigned char* tab = (LAS unsigned char*)(F.lds + TAB_OFF); LAS int* tinfo = (LAS int*)(F.lds + TAB_OFF + 320);
    if (F.tid < 32) { const int c = (int)__hip_atomic_load((unsigned*)(F.ctl + CW_CNT + 64 * F.tid), RLX_AGENT); tinfo[4 + F.tid] = (c + 255) >> 8; tinfo[72 + F.tid] = c; }
    __syncthreads();
    if (F.tid == 0) { int a = 0; for (int e = 0; e < 32; ++e) { const int n = tinfo[4 + e]; tinfo[40 + e] = a; for (int j = 0; j < n; ++j) tab[a + j] = (unsigned char)e; a += n; } tinfo[0] = a; }
    __syncthreads();
    return tinfo[0];
}
__device__ __forceinline__ void phase8(Frame& F) {
    const float* H2 = (const float*)(F.ws + WS_H2); const bf16* YR = (const bf16*)(F.ws + WS_YR);
    const int* EIDX = (const int*)(F.ws + WS_ROUTE); const int* RANK = EIDX + TT * 4; (void)build_moe_tab(F); const LAS int* tinfo = (const LAS int*)(F.lds + TAB_OFF + 320);
    const int gw = F.bid * NWAVES + F.wave, NGW = F.G * NWAVES;
    for (int t = gw; t < TT; t += NGW) {
        int slot = 0; if (F.lane < 4) slot = 256 * tinfo[40 + EIDX[(size_t)t * 4 + F.lane]] + RANK[(size_t)t * 4 + F.lane];
        int sl[4]; sl[0] = __shfl(slot, 0); sl[1] = __shfl(slot, 1); sl[2] = __shfl(slot, 2); sl[3] = __shfl(slot, 3);
        float v[4][8]; float ss = 0.f;
#pragma unroll
        for (int j = 0; j < 4; ++j) { const int pz = F.lane + 64 * j; const f32x4 a = *(const f32x4*)(H2 + (size_t)t * DM + 8 * pz), b = *(const f32x4*)(H2 + (size_t)t * DM + 8 * pz + 4);
            v[j][0] = a.x; v[j][1] = a.y; v[j][2] = a.z; v[j][3] = a.w; v[j][4] = b.x; v[j][5] = b.y; v[j][6] = b.z; v[j][7] = b.w; }
#pragma unroll
        for (int k = 0; k < 4; ++k)
#pragma unroll
            for (int j = 0; j < 4; ++j) { float f[8]; unpack8(*((const v4u*)(YR + (size_t)sl[k] * DM) + F.lane + 64 * j), f);
#pragma unroll
                for (int i = 0; i < 8; ++i) v[j][i] += f[i]; }
#pragma unroll
        for (int j = 0; j < 4; ++j)
#pragma unroll
            for (int i = 0; i < 8; ++i) ss += v[j][i] * v[j][i];
        const float rstd = 1.0f / sqrtf(wave_sum(ss) * (1.0f / 2048.0f) + EPSF);
#pragma unroll
        for (int j = 0; j < 4; ++j) { const int pz = F.lane + 64 * j; const f32x4 w0 = *(const f32x4*)(F.final_norm_w + 8 * pz), w1 = *(const f32x4*)(F.final_norm_w + 8 * pz + 4);
            *(f32x4*)(F.out + (size_t)t * DM + 8 * pz) = (f32x4){v[j][0] * rstd * w0.x, v[j][1] * rstd * w0.y, v[j][2] * rstd * w0.z, v[j][3] * rstd * w0.w};
            *(f32x4*)(F.out + (size_t)t * DM + 8 * pz + 4) = (f32x4){v[j][4] * rstd * w1.x, v[j][5] * rstd * w1.y, v[j][6] * rstd * w1.z, v[j][7] * rstd * w1.w}; }
    }
}

struct Args { const float* in[21]; float* out; unsigned char* ws; int ph_lo, ph_hi, li, pad; };
__global__ void __launch_bounds__(NWAVES * 64, 2) hymba_fwd(Args args) {
    extern __shared__ __attribute__((aligned(16))) unsigned char lds[];
    Frame F;
    F.lds = (LAS unsigned char*)lds; F.MISC = (volatile LAS unsigned*)(F.lds + MISC_OFF);
    F.tid = threadIdx.x; F.lane = F.tid & 63; F.wave = __builtin_amdgcn_readfirstlane(F.tid >> 6); F.G = gridDim.x; F.bid = blockIdx.x;
    F.ws = args.ws; F.ctl = (gu32*)(args.ws + WS_CTL); F.out = args.out;
    F.x = args.in[0]; F.norm1_w = args.in[1]; F.w_in = args.in[2]; F.conv_w = args.in[3]; F.conv_b = args.in[4]; F.dt_bias = args.in[5]; F.a_log = args.in[6]; F.d_skip = args.in[7]; F.ssd_norm_w = args.in[8];
    F.i_bias = args.in[9]; F.f_bias = args.in[10]; F.ml_norm_w = args.in[11]; F.w_out = args.in[12]; F.norm2_w = args.in[13]; F.router_w = args.in[14]; F.router_b = args.in[15];
    F.w_gate_up = args.in[16]; F.b_gate_up = args.in[17]; F.w_down = args.in[18]; F.b_down = args.in[19]; F.final_norm_w = args.in[20];
    for (int u = F.tid; u < (LDS_BYTES - LDSCTL_OFF) / 4; u += NWAVES * 64) ((LAS unsigned*)(F.lds + LDSCTL_OFF))[u] = 0u;
    __syncthreads();
    XcdBarrier bar; bar.bar = (unsigned*)(F.ctl + CW_BAR) + args.li * XCD_BAR_WORDS; bar.x = 0; bar.st = nullptr;
    const bool use_bar = (args.ph_hi - args.ph_lo) > 1;
    if (use_bar) bar = xcd_barrier_post((unsigned*)(F.ctl + CW_BAR) + args.li * XCD_BAR_WORDS, F.MISC + 8);
    const int lo = args.ph_lo, hi = args.ph_hi;
#ifndef PHASE_MASK
#define PHASE_MASK 0x1ff
#endif
#define IN(k) (((PHASE_MASK >> (k)) & 1) && lo <= (k) && (k) < hi)
#define SEAM(k) do { if (IN(k) && IN((k) + 1)) xcd_barrier(bar); } while (0)
    if (IN(0)) { phase0(F); } SEAM(0);
    if (IN(1)) {
        pg8::Gemm g{(const pg8::bf16_t*)(F.ws + WS_XN1), (const pg8::bf16_t*)(F.ws + WS_WIN), TT, NPROJ, DM}; pg8::StaticOrder S; S.init(TT, NPROJ, F.G, F.bid);
        pg8::EpiBf16 E{(pg8::bf16_t*)(F.ws + WS_PROJ), NPROJ};
        pg8::gemm_phase<pg8::EpiBf16, pg8::StaticOrder, true, true>(F.lds, g, S, E);
        p1_small(F);
    } SEAM(1);
    if (IN(2)) { phase_conv(F); } SEAM(2);
    if (IN(3)) { phase_mixer(F); } SEAM(3);
    if (IN(4)) {
        pg8::Gemm g{(const pg8::bf16_t*)(F.ws + WS_YMIX), (const pg8::bf16_t*)(F.ws + WS_WOUT), TT, DM, 4096}; pg8::StaticOrder S; S.init(TT, DM, F.G, F.bid);
        pg8::EpiResNorm E{(float*)(F.ws + WS_H2), F.x, DM, (const float*)(F.ws + WS_SSQ), (PG8_LAS float*)(F.lds + RING_BYTES), EPSF};
        pg8::gemm_phase<pg8::EpiResNorm, pg8::StaticOrder, true, true>(F.lds, g, S, E);
    } SEAM(4);
    if (IN(5)) { phase5(F); } SEAM(5);
    if (IN(6)) {
        const int nM = build_moe_tab(F);
        const LAS int* tinfo = (const LAS int*)(F.lds + TAB_OFF + 320); LAS unsigned short* rt = (LAS unsigned short*)(F.lds + ROWTAB_OFF);
        pg8::Gemm g{(const pg8::bf16_t*)(F.ws + WS_XN2), (const pg8::bf16_t*)(F.ws + WS_WGU), nM * 256, 4096, DM};
        pg8::MoeOrder S{nM, 16, 4, nM * 16, F.G, F.bid, (const PG8_LAS unsigned char*)(F.lds + TAB_OFF), (const PG8_LAS unsigned short*)rt};
        { const int* TOKL = (const int*)(F.ws + WS_XG);
          for (int i = 0; i < 18; ++i) { pg8::Unit u; if (!S.next(i, u)) break; const int e = u.pn >> 4, rank = (u.pm - tinfo[40 + e]) * 256 + (F.tid & 255);
              if (F.tid < 256) rt[i * 256 + F.tid] = (unsigned short)(rank < tinfo[72 + e] ? TOKL[(size_t)e * TT + rank] : 0); }
          __syncthreads(); }
        pg8::EpiSwiglu E{(unsigned char*)(F.ws + WS_ACT), F.b_gate_up};
        pg8::gemm_phase<pg8::EpiSwiglu, pg8::MoeOrder, true, true, true, true>(F.lds, g, S, E);
    } SEAM(6);
    if (IN(7)) {
        const int nM = build_moe_tab(F);
        pg8::Gemm g{(const pg8::bf16_t*)(F.ws + WS_ACT), (const pg8::bf16_t*)(F.ws + WS_WD), nM * 256, 2048, DM};
        pg8::MoeOrder S{nM, 8, 3, nM * 8, F.G, F.bid, (const PG8_LAS unsigned char*)(F.lds + TAB_OFF), nullptr};
        pg8::EpiDown E{(pg8::bf16_t*)(F.ws + WS_YR), F.b_down, (const float*)(F.ws + WS_XG + 4 * MiB), (const PG8_LAS int*)(F.lds + TAB_OFF + 320)};
        pg8::gemm_phase<pg8::EpiDown, pg8::MoeOrder, true, true, true>(F.lds, g, S, E);
    } SEAM(7);
    if (IN(8)) { phase8(F); }
#undef IN
#undef SEAM
}

extern "C" void kernel_launch(void* const* d_in, const int* in_sizes, int n_in, void* d_out, int out_size, void* d_ws, size_t ws_size, hipStream_t stream) {
    static int grid = 0;
    if (grid == 0) {
        if (n_in != 21 || out_size != TT * DM || ws_size < WS_END) { fprintf(stderr, "kernel_launch: unexpected problem (n_in %d, out %d, ws %zu); nothing launched\n", n_in, out_size, ws_size); grid = -1; return; }
        int dev = 0, cus = 0, per_cu = 0;
        if (hipGetDevice(&dev) != hipSuccess || hipDeviceGetAttribute(&cus, hipDeviceAttributeMultiprocessorCount, dev) != hipSuccess) { grid = -1; return; }
        if (hipFuncSetAttribute((const void*)hymba_fwd, hipFuncAttributeMaxDynamicSharedMemorySize, LDS_BYTES) != hipSuccess) { fprintf(stderr, "kernel_launch: hipFuncSetAttribute failed\n"); grid = -1; return; }
        if (hipOccupancyMaxActiveBlocksPerMultiprocessor(&per_cu, (const void*)hymba_fwd, NWAVES * 64, LDS_BYTES) != hipSuccess || per_cu < 1) { fprintf(stderr, "kernel_launch: occupancy query says %d blocks per CU\n", per_cu); }
        (void)hipGetLastError();
        grid = cus;
    }
    if (grid < 0) return;
    (void)hipMemsetAsync((char*)d_ws + WS_CTL, 0, CTL_ZERO_BYTES, stream);
    Args a{};
    for (int i = 0; i < 21; ++i) a.in[i] = (const float*)d_in[i];
    a.out = (float*)d_out; a.ws = (unsigned char*)d_ws; a.pad = 0;
#if MK_PER_PHASE
    for (int li = 0; li < N_PHASES; ++li) { a.ph_lo = li; a.ph_hi = li + 1; a.li = li; hipLaunchKernelGGL(hymba_fwd, dim3(grid), dim3(NWAVES * 64), LDS_BYTES, stream, a); }
#else
    a.ph_lo = 0; a.ph_hi = N_PHASES; a.li = 0;
    hipLaunchKernelGGL(hymba_fwd, dim3(grid), dim3(NWAVES * 64), LDS_BYTES, stream, a);
#endif
}
```

```cpp
#include <hip/hip_runtime.h>
#include <cstdio>
#include <cstdint>
namespace pg8 {
#define PG8_LAS __attribute__((address_space(3)))
typedef unsigned short bf16_t;
typedef short bf16x8 __attribute__((ext_vector_type(8)));
typedef float f32x4 __attribute__((ext_vector_type(4)));
typedef unsigned u32x4 __attribute__((ext_vector_type(4)));
constexpr int BM = 256, BK = 64, HALF = 128, HTB = HALF * BK * 2  , STAGE_BYTES = 8 * HTB, NXCD = 8, WGM = 8;

__host__ __device__ __forceinline__ int lds_byte(int r, int c) { const int st = (r >> 4) * 2 + (c >> 5), rr = r & 15, cc = c & 31, ob = rr * 64 + cc * 2; return st * 1024 + (ob ^ (((ob >> 9) & 1) << 5)); }
__host__ __device__ __forceinline__ void stage_rc(int b, int& R, int& C) { const int st = b / 1024, sb = b % 1024, swz = sb ^ (((sb >> 9) & 1) << 5); R = (st >> 1) * 16 + swz / 64; C = (st & 1) * 32 + (swz % 64) / 2; }
__host__ __device__ __forceinline__ int perm32(int rho) { const int n = rho >> 4, i = rho & 15; return 8 * (i >> 2) + 4 * n + (i & 3); }

struct Unit { int pm, pn, par; };
struct Gemm { const bf16_t* A; const bf16_t* Bt; int M, N, K; };

struct StaticOrder {
    int nM, nN, nwg, G, c;
    __host__ __device__ void init(int M, int N, int G_, int c_) { nM = M / BM; nN = N / BM; nwg = nM * nN; G = G_; c = c_; }
    __host__ __device__ bool next(int i, Unit& u) const {
        const long L = (long)i * G + c; if (L >= nwg) return false;
        int wgid = (int)L; { const int q = nwg / NXCD, r = nwg % NXCD, xcd = wgid % NXCD, off = wgid / NXCD; wgid = (xcd < r ? xcd * (q + 1) : r * (q + 1) + (xcd - r) * q) + off; }
        const int nig = WGM * nN, gid = wgid / nig, fm = gid * WGM, gsz = (nM - fm) < WGM ? (nM - fm) : WGM;
        u.pm = fm + ((wgid % nig) % gsz); u.pn = (wgid % nig) / gsz; return true;
    }
    __device__ __forceinline__ const PG8_LAS unsigned short* rowp(int) const { return nullptr; }
    __device__ __forceinline__ void a_ready(const Unit&) const {}
    __device__ __forceinline__ void done(const Unit&) const {}
};


__device__ __forceinline__ unsigned cvt_pk_bf16(float lo, float hi) { unsigned r; asm volatile("v_cvt_pk_bf16_f32 %0, %1, %2" : "=v"(r) : "v"(lo), "v"(hi)); return r; }
typedef unsigned u32x2 __attribute__((ext_vector_type(2)));

struct EpiBf16 {
    static constexpr bool PERM = true, AFTER_DRAIN = false;
    bf16_t* O; int ldc;
    __device__ __forceinline__ void operator()(const f32x4 (&acc)[2][2][4][2], const Unit& u, int wr, int wc, int fr, int fq) const {
        const int row0 = u.pm * BM + wr * 64 + fr; const int col0 = u.pn * BM + wc * 32 + 8 * fq;
#pragma unroll
        for (int ai = 0; ai < 2; ++ai)
#pragma unroll
            for (int m = 0; m < 4; ++m) { bf16_t* rowp = O + (size_t)(row0 + ai * HALF + m * 16) * ldc + col0;
#pragma unroll
                for (int bj = 0; bj < 2; ++bj) { const f32x4 v0 = acc[ai][bj][m][0], v1 = acc[ai][bj][m][1];
                    u32x4 w; w.x = cvt_pk_bf16(v0[0], v0[1]); w.y = cvt_pk_bf16(v0[2], v0[3]); w.z = cvt_pk_bf16(v1[0], v1[1]); w.w = cvt_pk_bf16(v1[2], v1[3]);
                    *(u32x4*)(rowp + bj * HALF) = w; } }
    }
};
struct EpiResNorm {
    static constexpr bool PERM = false, AFTER_DRAIN = false, KSCALE = true;
    float* C; const float* base; int ldc; const float* ssq; PG8_LAS float* tabl; float eps;
    __device__ __forceinline__ void build(const Unit& u, int tid) const {
        const int row = tid & 255, part = tid >> 8; const size_t t = (size_t)u.pm * BM + row; float rs[7];
        if (part == 0) { const f32x4* p = (const f32x4*)(ssq + t * 32);
#pragma unroll
            for (int g = 0; g < 4; ++g) { const f32x4 a = p[2 * g], b = p[2 * g + 1]; rs[g] = 1.0f / sqrtf(((a.x + a.y) + (a.z + a.w) + (b.x + b.y) + (b.z + b.w)) * (1.0f / 512.0f) + eps); }
            const f32x4* q = (const f32x4*)(ssq + (size_t)16384 * 32 + t * 32);
#pragma unroll
            for (int h = 0; h < 3; ++h) { const f32x4 a = q[h]; rs[4 + h] = 1.0f / sqrtf(((a.x + a.y) + (a.z + a.w)) * (1.0f / 256.0f) + eps); }
        } else { const f32x4* q = (const f32x4*)(ssq + (size_t)16384 * 32 + t * 32);
#pragma unroll
            for (int h = 0; h < 6; ++h) { const f32x4 a = q[2 + h]; rs[h] = 1.0f / sqrtf(((a.x + a.y) + (a.z + a.w)) * (1.0f / 256.0f) + eps); }
            rs[6] = 1.0f; }
        PG8_LAS float* d = tabl + row * 12 + 6 * part;
#pragma unroll
        for (int s = 0; s < 6; ++s) d[s] = (part == 1 && s == 5) ? rs[5] : rs[s] / rs[s + 1];
    }
    __device__ __forceinline__ void kscale(f32x4 (&acc)[2][2][4][2], int t, int nt, int wr, int fr) const {
        const int kt = t + 1; const bool segend = kt < 32 ? ((kt & 7) == 7) : ((kt & 3) == 3);
        if (segend && kt != nt - 1) { const int sg = kt < 32 ? (kt >> 3) : 4 + ((kt - 32) >> 2);
#pragma unroll
            for (int ai = 0; ai < 2; ++ai)
#pragma unroll
                for (int m = 0; m < 4; ++m) { const float r = tabl[(ai * HALF + wr * 64 + m * 16 + fr) * 12 + sg];
#pragma unroll
                    for (int bj = 0; bj < 2; ++bj)
#pragma unroll
                        for (int n = 0; n < 2; ++n) acc[ai][bj][m][n] = acc[ai][bj][m][n] * r; } }
    }
    __device__ __forceinline__ void operator()(const f32x4 (&acc)[2][2][4][2], const Unit& u, int wr, int wc, int fr, int fq) const {
        const int row0 = u.pm * BM + wr * 64 + fr, col0 = u.pn * BM + wc * 32 + 4 * fq;
#pragma unroll
        for (int ai = 0; ai < 2; ++ai)
#pragma unroll
            for (int m = 0; m < 4; ++m) { const size_t off = (size_t)(row0 + ai * HALF + m * 16) * ldc + col0; const float r = tabl[(ai * HALF + wr * 64 + m * 16 + fr) * 12 + 11];
#pragma unroll
                for (int bj = 0; bj < 2; ++bj)
#pragma unroll
                    for (int n = 0; n < 2; ++n) *(f32x4*)(C + off + bj * HALF + n * 16) = acc[ai][bj][m][n] * r + *(const f32x4*)(base + off + bj * HALF + n * 16); }
    }
};
struct EpiResF32 {
    static constexpr bool PERM = false, AFTER_DRAIN = false;
    float* C; const float* base; int ldc;
    __device__ __forceinline__ void operator()(const f32x4 (&acc)[2][2][4][2], const Unit& u, int wr, int wc, int fr, int fq) const {
        const int row0 = u.pm * BM + wr * 64 + fr, col0 = u.pn * BM + wc * 32 + 4 * fq;
#pragma unroll
        for (int ai = 0; ai < 2; ++ai)
#pragma unroll
            for (int m = 0; m < 4; ++m) { const size_t off = (size_t)(row0 + ai * HALF + m * 16) * ldc + col0;
#pragma unroll
                for (int bj = 0; bj < 2; ++bj)
#pragma unroll
                    for (int n = 0; n < 2; ++n) *(f32x4*)(C + off + bj * HALF + n * 16) = acc[ai][bj][m][n] + *(const f32x4*)(base + off + bj * HALF + n * 16); }
    }
};
__device__ __forceinline__ float swiglu1(float a, float b) {
    const float glu = fminf(a, 7.0f), lin = fminf(fmaxf(b, -7.0f), 7.0f);
    return glu * __builtin_amdgcn_rcpf(1.0f + __expf(-1.702f * glu)) * (lin + 1.0f);
}
struct EpiSwiglu {
    static constexpr bool PERM = true, AFTER_DRAIN = false, PREFETCH = true;
    unsigned char* O; const float* bias; PG8_LAS float* slot;
    __device__ __forceinline__ void prefetch(const Unit& u, int wid, int lane) const {
        if (wid == 0) { const int e = u.pn >> 4, pnl = u.pn & 15;
            __builtin_amdgcn_global_load_lds((const unsigned*)(bias + (size_t)e * 4096 + pnl * BM + 4 * lane), (PG8_LAS unsigned*)(slot + u.par * 256), 16, 0, 0); }
    }
    __device__ __forceinline__ void operator()(const f32x4 (&acc)[2][2][4][2], const Unit& u, int wr, int wc, int fr, int fq) const {
        const int pnl = u.pn & 15;
        const int row0 = u.pm * BM + wr * 64 + fr; const int hcol0 = pnl * BM + wc * 32 + 8 * fq;
        const PG8_LAS float* bp = slot + u.par * 256 + wc * 32 + 8 * fq;
        f32x4 bv[2][2];
#pragma unroll
        for (int bj = 0; bj < 2; ++bj)
#pragma unroll
            for (int n = 0; n < 2; ++n) bv[bj][n] = *(const PG8_LAS f32x4*)(bp + bj * HALF + 4 * n);
#pragma unroll
        for (int ai = 0; ai < 2; ++ai)
#pragma unroll
            for (int m = 0; m < 4; ++m) { unsigned char* rowp = O + (size_t)(row0 + ai * HALF + m * 16) * 2048 + (hcol0 >> 1);
#pragma unroll
                for (int bj = 0; bj < 2; ++bj) { const f32x4 v0 = acc[ai][bj][m][0] + bv[bj][0], v1 = acc[ai][bj][m][1] + bv[bj][1];
                    int w = __builtin_amdgcn_cvt_pk_fp8_f32(swiglu1(v0[0], v0[1]), swiglu1(v0[2], v0[3]), 0, false);
                    w = __builtin_amdgcn_cvt_pk_fp8_f32(swiglu1(v1[0], v1[1]), swiglu1(v1[2], v1[3]), w, true);
                    *(int*)(rowp + bj * 64) = w; } }
    }
};
struct EpiDown {
    static constexpr bool PERM = true, AFTER_DRAIN = false, PREFETCH = true;
    bf16_t* O; const float* bias; const float* gatel; const PG8_LAS int* tinfo; PG8_LAS float* slot;
    __device__ __forceinline__ void prefetch(const Unit& u, int wid, int lane) const {
        const int e = u.pn >> 3, pnl = u.pn & 7;
        if (wid == 0) __builtin_amdgcn_global_load_lds((const unsigned*)(bias + (size_t)e * 2048 + pnl * BM + 4 * lane), (PG8_LAS unsigned*)(slot + u.par * 512), 16, 0, 0);
        if (wid == 1) __builtin_amdgcn_global_load_lds((const unsigned*)(gatel + (size_t)e * 16384 + (size_t)(u.pm - tinfo[40 + e]) * BM + 4 * lane), (PG8_LAS unsigned*)(slot + u.par * 512 + 256), 16, 0, 0);
    }
    __device__ __forceinline__ void operator()(const f32x4 (&acc)[2][2][4][2], const Unit& u, int wr, int wc, int fr, int fq) const {
        const int pnl = u.pn & 7;
        const int row0 = u.pm * BM + wr * 64 + fr; const int col0 = pnl * BM + wc * 32 + 8 * fq;
        const PG8_LAS float* bp = slot + u.par * 512 + wc * 32 + 8 * fq; const PG8_LAS float* gp = slot + u.par * 512 + 256 + wr * 64 + fr;
        f32x4 bv[2][2];
#pragma unroll
        for (int bj = 0; bj < 2; ++bj)
#pragma unroll
            for (int n = 0; n < 2; ++n) bv[bj][n] = *(const PG8_LAS f32x4*)(bp + bj * HALF + 4 * n);
#pragma unroll
        for (int ai = 0; ai < 2; ++ai)
#pragma unroll
            for (int m = 0; m < 4; ++m) { const int row = row0 + ai * HALF + m * 16; const float gt = gp[ai * HALF + m * 16]; bf16_t* rowp = O + (size_t)row * 2048 + col0;
#pragma unroll
                for (int bj = 0; bj < 2; ++bj) { const f32x4 v0 = (acc[ai][bj][m][0] + bv[bj][0]) * gt, v1 = (acc[ai][bj][m][1] + bv[bj][1]) * gt;
                    u32x4 w; w.x = cvt_pk_bf16(v0[0], v0[1]); w.y = cvt_pk_bf16(v0[2], v0[3]); w.z = cvt_pk_bf16(v1[0], v1[1]); w.w = cvt_pk_bf16(v1[2], v1[3]);
                    *(u32x4*)(rowp + bj * HALF) = w; } }
    }
};
struct MoeOrder {
    int nM, nN, nsh, nwg, G, c; const PG8_LAS unsigned char* tab; const PG8_LAS unsigned short* rt;
    __device__ __forceinline__ const PG8_LAS unsigned short* rowp(int ui) const { return rt + ui * 256; }
    __device__ __forceinline__ bool next(int i, Unit& u) const {
        const long L = (long)i * G + c; if (L >= nwg) return false;
        int wgid = (int)L; { const int q = nwg / NXCD, r = nwg % NXCD, xcd = wgid % NXCD, off = wgid / NXCD; wgid = (xcd < r ? xcd * (q + 1) : r * (q + 1) + (xcd - r) * q) + off; }
        const int nig = WGM * nN, gid = wgid / nig, fm = gid * WGM, gsz = (nM - fm) < WGM ? (nM - fm) : WGM;
        const int pm = fm + ((wgid % nig) % gsz), pnl = (wgid % nig) / gsz;
        u.pm = pm; u.pn = ((int)tab[pm] << nsh) + pnl; return true;
    }
    __device__ __forceinline__ void a_ready(const Unit&) const {}
    __device__ __forceinline__ void done(const Unit&) const {}
};
template <class E, class = void> struct epi_pref { static constexpr bool value = false; };
template <class E> struct epi_pref<E, decltype((void)E::PREFETCH)> { static constexpr bool value = E::PREFETCH; };
template <class E, class = void> struct epi_kscale { static constexpr bool value = false; };
template <class E> struct epi_kscale<E, decltype((void)E::KSCALE)> { static constexpr bool value = E::KSCALE; };
typedef int v8i32 __attribute__((ext_vector_type(8)));
__device__ __forceinline__ v8i32 pg8_cat(const bf16x8 lo, const bf16x8 hi) { typedef int v4i32 __attribute__((ext_vector_type(4))); const v4i32 a = __builtin_bit_cast(v4i32, lo), b = __builtin_bit_cast(v4i32, hi); return __builtin_shufflevector(a, b, 0, 1, 2, 3, 4, 5, 6, 7); }
template <class Epi, class Sched, bool ALIGN_EPI = false, bool SP2 = false, bool F8 = false, bool GA = false>
__device__ __forceinline__ void gemm_phase(PG8_LAS unsigned char* lds, const Gemm g, const Sched& S, const Epi& E) {
    const int tid = threadIdx.x, wid = __builtin_amdgcn_readfirstlane(tid >> 6), lane = tid & 63, wr = wid >> 2, wc = wid & 3, fr = lane & 15, fq = lane >> 4;
    const int K = g.K, KB = F8 ? K : 2 * K, nt = KB / 128;
    unsigned voffA[2], voffB[2]; int gaR[2]; unsigned gaC[2]; static_assert(!GA || SP2, "gathered A needs the SP2 loop");
#pragma unroll
    for (int i = 0; i < 2; ++i) { int R, C; stage_rc(tid * 16 + i * 8192, R, C); const int Rb = Epi::PERM ? ((R & ~31) + perm32(R & 31)) : R;
        voffA[i] = (unsigned)(R * KB + C * 2); voffB[i] = (unsigned)(Rb * KB + C * 2); gaR[i] = R; gaC[i] = (unsigned)(C * 2); }
    const size_t kstep = (size_t)(BK * 2);
    const size_t hstep = (size_t)HALF * KB;
    const size_t tstep = 2 * hstep;
    const unsigned ldsw = (unsigned)wid * 1024u;
    int aoffk[2], boffk[2];
#pragma unroll
    for (int h = 0; h < 2; ++h) { aoffk[h] = lds_byte(wr * 64 + fr, fq * 8) + h * 1024; boffk[h] = lds_byte(wc * 32 + fr, fq * 8) + h * 1024; }
#define PG8_SA(b, h) (((b) * 2 + (h)) * HTB)
#define PG8_SB(b, h) ((4 + (b) * 2 + (h)) * HTB)
#define PG8_STAGE(bufoff, gbase, voff) do { _Pragma("unroll") for (int _i = 0; _i < 2; ++_i) \
        __builtin_amdgcn_global_load_lds((const unsigned*)((const char*)(gbase) + (voff)[_i]), (PG8_LAS unsigned*)(lds + (bufoff) + ldsw + _i * 8192), 16, 0, 0); } while (0)
#define PG8_STAGE_A(bufoff, kptr, h, usenext) do { if constexpr (GA) { _Pragma("unroll") for (int _i = 0; _i < 2; ++_i) { const unsigned _o = (usenext) ? gn[h][_i] : gc[h][_i]; \
            __builtin_amdgcn_global_load_lds((const unsigned*)((const char*)(kptr) + _o), (PG8_LAS unsigned*)(lds + (bufoff) + ldsw + _i * 8192), 16, 0, 0); } } \
        else { PG8_STAGE(bufoff, (kptr) + (h) * hstep, voffA); } } while (0)
#define PG8_GROWS(dst, ui_) do { const PG8_LAS unsigned short* _rt = S.rowp(ui_); _Pragma("unroll") for (int _h = 0; _h < 2; ++_h) _Pragma("unroll") for (int _i = 0; _i < 2; ++_i) dst[_h][_i] = (unsigned)_rt[gaR[_i] + 128 * _h] * (unsigned)KB + gaC[_i]; } while (0)
#define PG8_LDA(dst, b, h) do { if constexpr (F8) { _Pragma("unroll") for (int m = 0; m < 4; ++m) dst##8[m] = pg8_cat(*(const PG8_LAS bf16x8*)(lds + PG8_SA(b, h) + aoffk[0] + m * 2048), *(const PG8_LAS bf16x8*)(lds + PG8_SA(b, h) + aoffk[1] + m * 2048)); } \
        else { _Pragma("unroll") for (int m = 0; m < 4; ++m) _Pragma("unroll") for (int k = 0; k < 2; ++k) dst[m][k] = *(const PG8_LAS bf16x8*)(lds + PG8_SA(b, h) + aoffk[k] + m * 2048); } } while (0)
#define PG8_LDB(dst, b, h) do { if constexpr (F8) { _Pragma("unroll") for (int n = 0; n < 2; ++n) dst##8[n] = pg8_cat(*(const PG8_LAS bf16x8*)(lds + PG8_SB(b, h) + boffk[0] + n * 2048), *(const PG8_LAS bf16x8*)(lds + PG8_SB(b, h) + boffk[1] + n * 2048)); } \
        else { _Pragma("unroll") for (int n = 0; n < 2; ++n) _Pragma("unroll") for (int k = 0; k < 2; ++k) dst[n][k] = *(const PG8_LAS bf16x8*)(lds + PG8_SB(b, h) + boffk[k] + n * 2048); } } while (0)
#define PG8_MMA(ai, bj, At, Bt) do { __builtin_amdgcn_s_setprio(1); \
        if constexpr (F8) { _Pragma("unroll") for (int m = 0; m < 4; ++m) _Pragma("unroll") for (int n = 0; n < 2; ++n) \
            asm volatile("v_mfma_scale_f32_16x16x128_f8f6f4 %0, %1, %2, %0, %3, %4 op_sel_hi:[0,0,0]" : "+v"(acc[ai][bj][m][n]) : "v"(Bt##8[n]), "v"(At##8[m]), "v"(sc_w), "v"(sc_a)); } \
        else { _Pragma("unroll") for (int m = 0; m < 4; ++m) _Pragma("unroll") for (int n = 0; n < 2; ++n) _Pragma("unroll") for (int k = 0; k < 2; ++k) \
            acc[ai][bj][m][n] = __builtin_amdgcn_mfma_f32_16x16x32_bf16(Bt[n][k], At[m][k], acc[ai][bj][m][n], 0, 0, 0); } \
        __builtin_amdgcn_s_setprio(0); } while (0)
#define PG8_WAIT_V(n) asm volatile("s_waitcnt vmcnt(" #n ")" ::: "memory")
#define PG8_WAIT_L(n) asm volatile("s_waitcnt lgkmcnt(" #n ")" ::: "memory")
#define PG8_BAR __builtin_amdgcn_s_barrier()
#define PG8_SCHED __builtin_amdgcn_sched_barrier(0)
    Unit cur, nxt; int ui = 0;
    if (!S.next(0, cur)) return;
    cur.par = 0;
    f32x4 acc[2][2][4][2];
#pragma unroll
    for (int a = 0; a < 2; ++a)
#pragma unroll
        for (int b = 0; b < 2; ++b)
#pragma unroll
            for (int m = 0; m < 4; ++m)
#pragma unroll
                for (int n = 0; n < 2; ++n) acc[a][b][m][n] = (f32x4){0.f, 0.f, 0.f, 0.f};
    const int sc_w = 0x79797979, sc_a = 0x7f7f7f7f;
    bf16x8 At[4][2], B0[2][2], B1[2][2]; v8i32 At8[4], B08[2], B18[2];
    const char* cA = (const char*)g.A + (GA ? (size_t)0 : (size_t)cur.pm * tstep); const char* cB = (const char*)g.Bt + (size_t)cur.pn * tstep;
    unsigned gc[2][2] = {{0u, 0u}, {0u, 0u}}, gn[2][2] = {{0u, 0u}, {0u, 0u}};
    if constexpr (GA) { PG8_GROWS(gc, 0); }
    if constexpr (epi_kscale<Epi>::value) { E.build(cur, tid); asm volatile("s_waitcnt lgkmcnt(0)" ::: "memory"); PG8_BAR; asm volatile("" ::: "memory"); }
    S.a_ready(cur);
    if constexpr (SP2) {
        PG8_STAGE(PG8_SB(0, 0), cB, voffB); PG8_STAGE(PG8_SB(0, 1), cB + hstep, voffB); PG8_STAGE_A(PG8_SA(0, 0), cA, 0, false); PG8_STAGE_A(PG8_SA(0, 1), cA, 1, false);
        if (wr == 1) PG8_BAR;
        PG8_WAIT_V(2); PG8_BAR;
        PG8_STAGE(PG8_SB(1, 0), cB + kstep, voffB); PG8_STAGE_A(PG8_SA(1, 0), cA + kstep, 0, false); PG8_STAGE(PG8_SB(1, 1), cB + hstep + kstep, voffB);
        PG8_WAIT_V(6); PG8_BAR;
    } else {
        PG8_STAGE(PG8_SB(0, 0), cB, voffB); PG8_STAGE(PG8_SA(0, 0), cA, voffA); PG8_STAGE(PG8_SB(0, 1), cB + hstep, voffB); PG8_STAGE(PG8_SA(0, 1), cA + hstep, voffA);
        if (wr == 1) PG8_BAR;
        PG8_WAIT_V(4); PG8_BAR;
        PG8_STAGE(PG8_SB(1, 0), cB + kstep, voffB); PG8_STAGE(PG8_SA(1, 0), cA + kstep, voffA); PG8_STAGE(PG8_SB(1, 1), cB + hstep + kstep, voffB);
        PG8_WAIT_V(6); PG8_BAR;
    }
    for (;;) {
        const bool has_next = S.next(ui + 1, nxt); nxt.par = (ui + 1) & 1;
        const char* nA = (has_next && !GA) ? (const char*)g.A + (size_t)nxt.pm * tstep : cA; const char* nB = has_next ? (const char*)g.Bt + (size_t)nxt.pn * tstep : cB;
        if constexpr (GA) { if (has_next) { PG8_GROWS(gn, ui + 1); } else {
#pragma unroll
            for (int _h = 0; _h < 2; ++_h) { gn[_h][0] = gc[_h][0]; gn[_h][1] = gc[_h][1]; } } }
        for (int t = 0; t < nt; t += 2) {
            const bool last = (t == nt - 2);
            const char* a1 = cA + (size_t)(t + 1) * kstep;
            const char* a2 = last ? nA : cA + (size_t)(t + 2) * kstep; const char* b2 = last ? nB : cB + (size_t)(t + 2) * kstep;
            const char* a3 = a2 + kstep; const char* b3 = b2 + kstep;
            if (last && has_next) S.a_ready(nxt);
            if constexpr (epi_pref<Epi>::value) { if (t == 0) E.prefetch(cur, wid, lane); }
            if constexpr (SP2) {
            PG8_LDB(B0, 0, 0); PG8_LDB(B1, 0, 1); PG8_SCHED; PG8_LDA(At, 0, 0); PG8_STAGE_A(PG8_SA(1, 1), a1, 1, false);
            PG8_WAIT_V(8); PG8_WAIT_L(0); PG8_BAR; PG8_MMA(0, 0, At, B0); PG8_MMA(0, 1, At, B1); PG8_BAR; PG8_SCHED;
            PG8_LDA(At, 0, 1); PG8_STAGE(PG8_SB(0, 0), b2, voffB); PG8_STAGE(PG8_SB(0, 1), b2 + hstep, voffB); PG8_STAGE_A(PG8_SA(0, 0), a2, 0, last);
            PG8_WAIT_V(8); PG8_WAIT_L(0); PG8_BAR; PG8_MMA(1, 0, At, B0); PG8_MMA(1, 1, At, B1); PG8_BAR; PG8_SCHED;
            PG8_LDB(B0, 1, 0); PG8_LDB(B1, 1, 1); PG8_SCHED; PG8_LDA(At, 1, 0); PG8_STAGE_A(PG8_SA(0, 1), a2, 1, last);
            PG8_WAIT_V(8); PG8_WAIT_L(0); PG8_BAR; PG8_MMA(0, 0, At, B0); PG8_MMA(0, 1, At, B1); PG8_BAR; PG8_SCHED;
            PG8_LDA(At, 1, 1); PG8_STAGE(PG8_SB(1, 0), b3, voffB); PG8_STAGE(PG8_SB(1, 1), b3 + hstep, voffB); PG8_STAGE_A(PG8_SA(1, 0), a3, 0, last);
            PG8_WAIT_V(8); PG8_WAIT_L(0); PG8_BAR; PG8_MMA(1, 0, At, B0); PG8_MMA(1, 1, At, B1); PG8_BAR; PG8_SCHED;
            if constexpr (epi_kscale<Epi>::value) { E.kscale(acc, t, nt, wr, fr); PG8_SCHED; }
            } else {
            PG8_LDB(B0, 0, 0); PG8_SCHED; PG8_LDA(At, 0, 0); PG8_STAGE(PG8_SA(1, 1), a1 + hstep, voffA);
            PG8_WAIT_L(8); PG8_BAR; PG8_WAIT_L(0); PG8_MMA(0, 0, At, B0); PG8_BAR; PG8_SCHED;
            PG8_LDB(B1, 0, 1); PG8_STAGE(PG8_SB(0, 0), b2, voffB);
            PG8_BAR; PG8_WAIT_L(0); PG8_MMA(0, 1, At, B1); PG8_BAR;
            PG8_LDA(At, 0, 1); PG8_STAGE(PG8_SA(0, 0), a2, voffA);
            PG8_BAR; PG8_WAIT_L(0); PG8_MMA(1, 0, At, B0); PG8_BAR; PG8_SCHED;
            PG8_STAGE(PG8_SB(0, 1), b2 + hstep, voffB);
            PG8_WAIT_V(6); PG8_BAR; PG8_MMA(1, 1, At, B1); PG8_BAR;
            PG8_LDB(B0, 1, 0); PG8_SCHED; PG8_LDA(At, 1, 0); PG8_STAGE(PG8_SA(0, 1), a2 + hstep, voffA);
            PG8_WAIT_L(8); PG8_BAR; PG8_WAIT_L(0); PG8_MMA(0, 0, At, B0); PG8_BAR; PG8_SCHED;
            PG8_LDB(B1, 1, 1); PG8_STAGE(PG8_SB(1, 0), b3, voffB);
            PG8_BAR; PG8_WAIT_L(0); PG8_MMA(0, 1, At, B1); PG8_BAR;
            PG8_LDA(At, 1, 1); PG8_STAGE(PG8_SA(1, 0), a3, voffA);
            PG8_BAR; PG8_WAIT_L(0); PG8_MMA(1, 0, At, B0); PG8_BAR; PG8_SCHED;
            PG8_STAGE(PG8_SB(1, 1), b3 + hstep, voffB);
            PG8_WAIT_V(6); PG8_BAR; PG8_MMA(1, 1, At, B1); PG8_BAR;
            }
        }
        if constexpr (ALIGN_EPI) { if (wr == 0) PG8_BAR; }
        if constexpr (F8) asm volatile("s_nop 15\n\ts_nop 15" ::: "memory");
        if constexpr (!Epi::AFTER_DRAIN) { E(acc, cur, wr, wc, fr, fq); S.done(cur); }
        if (!has_next) break;
#pragma unroll
        for (int a = 0; a < 2; ++a)
#pragma unroll
            for (int b = 0; b < 2; ++b)
#pragma unroll
                for (int m = 0; m < 4; ++m)
#pragma unroll
                    for (int n = 0; n < 2; ++n) acc[a][b][m][n] = (f32x4){0.f, 0.f, 0.f, 0.f};
        if constexpr (epi_kscale<Epi>::value) { static_assert(!epi_kscale<Epi>::value || (ALIGN_EPI && SP2), "K-segment rescale needs aligned epilogues");
            asm volatile("s_waitcnt lgkmcnt(0)" ::: "memory"); PG8_BAR; asm volatile("" ::: "memory");
            E.build(nxt, tid); asm volatile("s_waitcnt lgkmcnt(0)" ::: "memory"); PG8_BAR; asm volatile("" ::: "memory"); }
        cur = nxt; cA = nA; cB = nB; ++ui;
        if constexpr (GA) {
#pragma unroll
            for (int _h = 0; _h < 2; ++_h) { gc[_h][0] = gn[_h][0]; gc[_h][1] = gn[_h][1]; } }
        if constexpr (ALIGN_EPI) { if (wr == 1) PG8_BAR; }
    }
    PG8_WAIT_V(0);
    if constexpr (!ALIGN_EPI) { if (wr == 0) PG8_BAR; }
    PG8_BAR;
    if constexpr (Epi::AFTER_DRAIN) { E.fused(acc, cur, wr, wc, fr, fq, lds, wid, lane); S.done(cur); }
#undef PG8_SA
#undef PG8_SB
#undef PG8_STAGE
#undef PG8_STAGE_A
#undef PG8_GROWS
#undef PG8_LDA
#undef PG8_LDB
#undef PG8_MMA
#undef PG8_WAIT_V
#undef PG8_WAIT_L
#undef PG8_BAR
#undef PG8_SCHED
}
}

constexpr int NWAVES = 8;
constexpr int TT = 16384, DM = 2048, SEQ = 2048;
constexpr int NPROJ = 11264;
constexpr int PC_Z = 0, PC_XBC = 2048, PC_Q = 5120, PC_K = 6144, PC_V = 7168, PC_O = 9216;
constexpr int WIN_LD = 11312;
constexpr int NSLOT = 65536 + 32 * 256;
constexpr float EPSF = 1e-5f;
#ifndef HSYNC_ON
#define HSYNC_ON 0
#endif
#define HWAIT() do { if (HSYNC_ON) asm volatile("s_waitcnt vmcnt(0) lgkmcnt(0)\n\ts_nop 15\n\ts_nop 15" ::: "memory"); } while (0)
#define HSYNC() do { if (HSYNC_ON) { HWAIT(); __syncthreads(); } } while (0)
#ifndef MK_PER_PHASE
#define MK_PER_PHASE 0
#endif
constexpr int N_PHASES = 9;

constexpr size_t MiB = 1u << 20;
constexpr size_t WS_CTL = 0, CTL_ZERO_BYTES = 1 * MiB;
constexpr size_t WS_WIN = 2 * MiB, WS_WSM = 46 * MiB, WS_WRT = 47 * MiB, WS_WOUT = 48 * MiB, WS_WGU = 64 * MiB, WS_WD = 576 * MiB;
constexpr size_t WS_XN1 = 832 * MiB, WS_PROJ = 896 * MiB, WS_SMALL = 1248 * MiB, WS_SSQ = 1252 * MiB, WS_YMIX = 1256 * MiB, WS_H2 = 1384 * MiB, WS_XN2 = 1512 * MiB;
constexpr size_t WS_ROUTE = 1576 * MiB, WS_XG = 1578 * MiB, WS_ACT = 1866 * MiB, WS_YR = 2154 * MiB, WS_XC = 2442 * MiB, WS_END = 2538 * MiB;
constexpr int CW_BAR = 4096;
constexpr int CW_CNT = 65536;

constexpr int RING_BYTES = 131072;
constexpr int LDS_BYTES = 147456;
constexpr int LDSCTL_OFF = LDS_BYTES - 1024, MISC_OFF = LDSCTL_OFF;
constexpr int TAB_OFF = LDSCTL_OFF + 64;
constexpr int EPIV_OFF = RING_BYTES + 9216;
constexpr int ROWTAB_OFF = RING_BYTES;

#define GAS __attribute__((address_space(1)))
#define LAS __attribute__((address_space(3)))
typedef unsigned short bf16;
typedef unsigned v4u __attribute__((ext_vector_type(4)));
typedef unsigned v2u __attribute__((ext_vector_type(2)));
typedef float f32x4 __attribute__((ext_vector_type(4)));
typedef float f32x2 __attribute__((ext_vector_type(2)));
typedef short bf16x8 __attribute__((ext_vector_type(8)));
typedef GAS unsigned gu32;
#define RLX_AGENT __ATOMIC_RELAXED, __HIP_MEMORY_SCOPE_AGENT
#define LDS_WAIT() asm volatile("s_waitcnt lgkmcnt(0)" ::: "memory")
#define VM_WAIT() asm volatile("s_waitcnt vmcnt(0)" ::: "memory")
__device__ __forceinline__ unsigned f2bf(float f) { unsigned u = __builtin_bit_cast(unsigned, f); return (u + 0x7fffu + ((u >> 16) & 1u)) >> 16; }
__device__ __forceinline__ unsigned pk2(float lo, float hi) { return f2bf(lo) | (f2bf(hi) << 16); }
__device__ __forceinline__ float bflo(unsigned w) { return __builtin_bit_cast(float, w << 16); }
__device__ __forceinline__ float bfhi(unsigned w) { return __builtin_bit_cast(float, w & 0xffff0000u); }
__device__ __forceinline__ float wave_sum(float v) {
#pragma unroll
    for (int o = 1; o < 64; o <<= 1) v += __shfl_xor(v, o);
    return v;
}
__device__ __forceinline__ float softplusf(float x) { return x > 20.f ? x : log1pf(expf(x)); }
__device__ __forceinline__ float logsigf(float x) { return fminf(x, 0.f) - log1pf(expf(-fabsf(x))); }
__device__ __forceinline__ float siluf(float v) { return v * __builtin_amdgcn_rcpf(1.0f + __expf(-v)); }

#define XB_TMO      128
#define XB_XCNT(j)  (256  + 64 * (j))
#define XB_XSUB(j)  (1280 + 64 * (j))
#define XB_XGEN(j)  (2304 + 64 * (j))
#define XB_TOP      3328
#define XB_TOPGEN   3392
#define XCD_BAR_WORDS 3456
#define XB_SPIN_CAP (1u << 18)

__device__ __forceinline__ unsigned xb_ld(unsigned* p)              { return __hip_atomic_load(p, __ATOMIC_RELAXED, __HIP_MEMORY_SCOPE_AGENT); }
__device__ __forceinline__ unsigned xb_add(unsigned* p, unsigned v) { return __hip_atomic_fetch_add(p, v, __ATOMIC_RELAXED, __HIP_MEMORY_SCOPE_AGENT); }
__device__ __forceinline__ unsigned xb_xcc_id() { return (unsigned)__builtin_amdgcn_s_getreg((3 << 11) | 20) & 0xFu; }
#define XB_SPIN(cond, bar) do { unsigned _sp = 0; while (cond) { __builtin_amdgcn_s_sleep(1); \
    if ((++_sp & 255u) == 0u) { if (xb_ld(&(bar)[XB_TMO])) break; if (_sp > XB_SPIN_CAP) { atomicAdd(&(bar)[XB_TMO], 1u); break; } } } } while (0)

struct XcdBarrier {
    unsigned* bar; unsigned x;
    volatile LAS unsigned* st;
};

__device__ __forceinline__ XcdBarrier xcd_barrier_post(unsigned* bar, volatile LAS unsigned* st) {
    XcdBarrier b; b.bar = bar; b.x = xb_xcc_id(); b.st = st;
    if (threadIdx.x == 0) (void)xb_add(&bar[XB_XCNT(b.x)], 1u);
    return b;
}
__device__ __forceinline__ void xcd_barrier_complete(unsigned* bar, unsigned x, unsigned& nloc, unsigned& nx) {
    const unsigned G = gridDim.x * gridDim.y * gridDim.z;
    unsigned sum, cnt, mine, sp = 0u;
    for (;;) {
        sum = 0u; cnt = 0u; mine = 0u;
#pragma unroll
        for (unsigned j = 0; j < 16; ++j) { const unsigned c = xb_ld(&bar[XB_XCNT(j)]); sum += c; cnt += (c > 0u) ? 1u : 0u; mine = (j == x) ? c : mine; }
        if (sum == G) break;
        __builtin_amdgcn_s_sleep(1);
        if ((++sp & 255u) == 0u) { if (xb_ld(&bar[XB_TMO])) break; if (sp > XB_SPIN_CAP) { atomicAdd(&bar[XB_TMO], 1u); break; } }
    }
    nloc = mine > 0u ? mine : 1u; nx = cnt > 0u ? cnt : 1u;
}

__device__ __forceinline__ void xcd_barrier(const XcdBarrier& b) {
    asm volatile("s_waitcnt vmcnt(0)" ::: "memory");
    __syncthreads();
    if (threadIdx.x == 0) {
        unsigned* bar = b.bar;
        __builtin_amdgcn_s_waitcnt(0);
        unsigned nloc = b.st[0], nx = b.st[1];
        if (nloc == 0u) { xcd_barrier_complete(bar, b.x, nloc, nx); b.st[0] = nloc; b.st[1] = nx; }
        const unsigned old = xb_add(&bar[XB_XSUB(b.x)], 1u);
        const unsigned gen = old / nloc;
        if (old + 1u == (gen + 1u) * nloc) {
            __builtin_amdgcn_fence(__ATOMIC_RELEASE, "agent");
            asm volatile("s_waitcnt vmcnt(0)" ::: "memory");
            const unsigned og = xb_add(&bar[XB_TOP], 1u);
            const unsigned tg = og / nx;
            if (og + 1u == (tg + 1u) * nx) xb_add(&bar[XB_TOPGEN], 1u);
            else XB_SPIN(xb_ld(&bar[XB_TOPGEN]) == tg, bar);
            __builtin_amdgcn_fence(__ATOMIC_ACQUIRE, "agent");
            xb_add(&bar[XB_XGEN(b.x)], 1u);
            asm volatile("s_waitcnt vmcnt(0)" ::: "memory");
        } else {
            XB_SPIN(xb_ld(&bar[XB_XGEN(b.x)]) == gen, bar);
            __builtin_amdgcn_fence(__ATOMIC_ACQUIRE, "agent");
            asm volatile("s_waitcnt vmcnt(0)" ::: "memory");
        }
    }
    __syncthreads();
}

struct Frame {
    LAS unsigned char* lds;
    volatile LAS unsigned* MISC;
    gu32* ctl;
    int tid, lane, wave, G, bid;
    const float *x, *norm1_w, *w_in, *conv_w, *conv_b, *dt_bias, *a_log, *d_skip, *ssd_norm_w, *i_bias, *f_bias, *ml_norm_w, *w_out, *norm2_w, *router_w, *router_b, *w_gate_up, *b_gate_up, *w_down, *b_down, *final_norm_w;
    float* out; unsigned char* ws;
};

__device__ __forceinline__ void p0_transpose_item(const float* W, int ldw, int K, bf16* WT, int dst_row0, int src_col0, int k0, LAS float* scr, int lane) {
#pragma unroll 8
    for (int i = 0; i < 32; ++i) { const int kk = 2 * i + (lane >> 5); scr[kk * 33 + (lane & 31)] = W[(size_t)(k0 + kk) * ldw + src_col0 + (lane & 31)]; }
    LDS_WAIT(); asm volatile("" ::: "memory");
    const int c = lane & 7;
#pragma unroll
    for (int j = 0; j < 4; ++j) { const int n = (lane >> 3) + 8 * j; const LAS float* s = scr + (8 * c) * 33 + n;
        v4u o; o.x = pk2(s[0 * 33], s[1 * 33]); o.y = pk2(s[2 * 33], s[3 * 33]); o.z = pk2(s[4 * 33], s[5 * 33]); o.w = pk2(s[6 * 33], s[7 * 33]);
        *(v4u*)(WT + (size_t)(dst_row0 + n) * K + k0 + 8 * c) = o; }
    LDS_WAIT(); asm volatile("" ::: "memory");
}
__device__ __forceinline__ void p0_transpose_item_f8(const float* W, int ldw, int K, unsigned char* WT, int dst_row0, int src_col0, int k0, LAS float* scr, int lane) {
#pragma unroll 8
    for (int i = 0; i < 32; ++i) { const int kk = 2 * i + (lane >> 5); scr[kk * 33 + (lane & 31)] = W[(size_t)(k0 + kk) * ldw + src_col0 + (lane & 31)] * 64.0f; }
    LDS_WAIT(); asm volatile("" ::: "memory");
    const int c = lane & 3;
#pragma unroll
    for (int j = 0; j < 2; ++j) { const int n = (lane >> 2) + 16 * j; const LAS float* s = scr + (16 * c) * 33 + n; int o[4];
#pragma unroll
        for (int q = 0; q < 4; ++q) { int w = __builtin_amdgcn_cvt_pk_fp8_f32(s[(4 * q) * 33], s[(4 * q + 1) * 33], 0, false); o[q] = __builtin_amdgcn_cvt_pk_fp8_f32(s[(4 * q + 2) * 33], s[(4 * q + 3) * 33], w, true); }
        *(v4u*)(WT + (size_t)(dst_row0 + n) * K + k0 + 16 * c) = (v4u){(unsigned)o[0], (unsigned)o[1], (unsigned)o[2], (unsigned)o[3]}; }
    LDS_WAIT(); asm volatile("" ::: "memory");
}
template <bool F8> __device__ __forceinline__ void p0_transpose128(const float* W, int ldw, int K, void* WTv, int dst_row0, int src_col0, int k0, LAS float* scr, int lane) {
    const float* src = W + (size_t)(k0 + (lane >> 3)) * ldw + src_col0 + 4 * (lane & 7);
    f32x4 v[16];
#pragma unroll
    for (int i = 0; i < 16; ++i) v[i] = *(const f32x4*)(src + (size_t)(8 * i) * ldw);
#pragma unroll
    for (int i = 0; i < 16; ++i) { LAS float* d = scr + (8 * i + (lane >> 3)) * 33 + 4 * (lane & 7); d[0] = v[i].x; d[1] = v[i].y; d[2] = v[i].z; d[3] = v[i].w; }
    LDS_WAIT(); asm volatile("" ::: "memory");
    const int n = lane & 31, hf = lane >> 5; const LAS float* s = scr + (64 * hf) * 33 + n;
    if (F8) { unsigned char* dst = (unsigned char*)WTv + (size_t)(dst_row0 + n) * K + k0 + 64 * hf;
#pragma unroll
        for (int j = 0; j < 4; ++j) { int o[4];
#pragma unroll
            for (int q = 0; q < 4; ++q) { const LAS float* p = s + (16 * j + 4 * q) * 33; int w = __builtin_amdgcn_cvt_pk_fp8_f32(p[0] * 64.0f, p[33] * 64.0f, 0, false); o[q] = __builtin_amdgcn_cvt_pk_fp8_f32(p[66] * 64.0f, p[99] * 64.0f, w, true); }
            *(v4u*)(dst + 16 * j) = (v4u){(unsigned)o[0], (unsigned)o[1], (unsigned)o[2], (unsigned)o[3]}; }
    } else { bf16* dst = (bf16*)WTv + (size_t)(dst_row0 + n) * K + k0 + 64 * hf;
#pragma unroll
        for (int j = 0; j < 8; ++j) { const LAS float* p = s + (8 * j) * 33;
            *(v4u*)(dst + 8 * j) = (v4u){pk2(p[0], p[33]), pk2(p[66], p[99]), pk2(p[132], p[165]), pk2(p[198], p[231])}; }
    }
    LDS_WAIT(); asm volatile("" ::: "memory");
}
__device__ __forceinline__ void rms_row_to_bf16(const float* xrow, const float* w, bf16* orow, int lane) {
    const f32x4* xr = (const f32x4*)xrow + lane; const f32x4* wr = (const f32x4*)w + lane;
    f32x4 v[8]; float s = 0.f;
#pragma unroll
    for (int j = 0; j < 8; ++j) { v[j] = xr[64 * j]; s += (v[j].x * v[j].x + v[j].y * v[j].y) + (v[j].z * v[j].z + v[j].w * v[j].w); }
    const float rstd = 1.0f / sqrtf(wave_sum(s) * (1.0f / 2048.0f) + EPSF);
    v2u* o8 = (v2u*)orow + lane;
#pragma unroll
    for (int j = 0; j < 8; ++j) { const f32x4 ww = wr[64 * j]; v2u o; o.x = pk2(v[j].x * rstd * ww.x, v[j].y * rstd * ww.y); o.y = pk2(v[j].z * rstd * ww.z, v[j].w * rstd * ww.w); o8[64 * j] = o; }
}
__device__ __forceinline__ void p0_moe_weights_coop(Frame& F) {
    LAS float* tile = (LAS float*)F.lds;
    unsigned char* WguT = (unsigned char*)(F.ws + WS_WGU); unsigned char* WdT = (unsigned char*)(F.ws + WS_WD);
    constexpr int I_GU = 32 * 256, I_D = 32 * 128, NI = I_GU + I_D;
    const int lrow = 32 * F.wave + (F.lane >> 5), lcol = 4 * (F.lane & 31);
    const int on = F.tid & 127, okq = F.tid >> 7;
    f32x4 v[16];
    auto item = [&](int r, const float*& W, unsigned char*& WT, int& ldw, int& n0, int& k0) {
        if (r < I_GU) { const int e = r >> 8, rr = r & 255, kb = rr >> 5, nb = rr & 31; W = F.w_gate_up + (size_t)e * 2048 * 4096; WT = WguT + (size_t)e * 4096 * 2048; ldw = 4096; n0 = nb * 128; k0 = kb * 256; }
        else { r -= I_GU; const int e = r >> 7, rr = r & 127, kb = rr >> 4, nb = rr & 15; W = F.w_down + (size_t)e * 2048 * 2048; WT = WdT + (size_t)e * 2048 * 2048; ldw = 2048; n0 = nb * 128; k0 = kb * 256; } };
    int it = F.bid; if (it >= NI) return;
    const float* W; unsigned char* WT; int ldw, n0, k0; item(it, W, WT, ldw, n0, k0);
#pragma unroll
    for (int i = 0; i < 16; ++i) v[i] = *(const f32x4*)(W + (size_t)(k0 + lrow + 2 * i) * ldw + n0 + lcol);
    for (;;) {
#pragma unroll
        for (int i = 0; i < 16; ++i) *(LAS f32x4*)(tile + (lrow + 2 * i) * 132 + lcol) = v[i];
        __syncthreads();
        unsigned char* dst = WT + (size_t)(n0 + on) * 2048 + k0 + 64 * okq;
        const int nit = it + F.G; const bool more = nit < NI;
        if (more) { item(nit, W, WT, ldw, n0, k0);
#pragma unroll
            for (int i = 0; i < 16; ++i) v[i] = *(const f32x4*)(W + (size_t)(k0 + lrow + 2 * i) * ldw + n0 + lcol); }
        const LAS float* sp = tile + (64 * okq) * 132 + on;
#pragma unroll
        for (int j = 0; j < 4; ++j) { int o[4];
#pragma unroll
            for (int q = 0; q < 4; ++q) { const LAS float* p = sp + (16 * j + 4 * q) * 132; int w_ = __builtin_amdgcn_cvt_pk_fp8_f32(p[0] * 64.0f, p[132] * 64.0f, 0, false); o[q] = __builtin_amdgcn_cvt_pk_fp8_f32(p[264] * 64.0f, p[396] * 64.0f, w_, true); }
            *(v4u*)(dst + 16 * j) = (v4u){(unsigned)o[0], (unsigned)o[1], (unsigned)o[2], (unsigned)o[3]}; }
        __syncthreads();
        if (!more) break; it = nit;
    }
}
__device__ __forceinline__ void phase0(Frame& F) {
    LAS float* scr = (LAS float*)(F.lds + F.wave * 16896);
    const int gw = F.bid * NWAVES + F.wave, NGW = F.G * NWAVES;
    bf16* WinT = (bf16*)(F.ws + WS_WIN); bf16* WsT = (bf16*)(F.ws + WS_WSM); float* Wrt = (float*)(F.ws + WS_WRT); bf16* WoutT = (bf16*)(F.ws + WS_WOUT);
    bf16* XN1 = (bf16*)(F.ws + WS_XN1);
    p0_moe_weights_coop(F);
    constexpr int I_IN = 16 * 352, I_OUT = 32 * 64, NITEMS = I_IN + I_OUT;
    for (int it = gw; it < NITEMS; it += NGW) {
        int r = it;
        if (r < I_IN) { const int kb = r / 352, nb = r % 352, n0 = nb * 32; p0_transpose128<false>(F.w_in, WIN_LD, 2048, WinT, n0, n0 + (n0 >= 5120 ? 32 : 0), kb * 128, scr, F.lane); continue; } r -= I_IN;
        { const int kb = r >> 6, nb = r & 63; p0_transpose128<false>(F.w_out, 2048, 4096, WoutT, nb * 32, nb * 32, kb * 128, scr, F.lane); }
    }
    for (int i = gw * 64 + F.lane; i < 64 * 2048; i += NGW * 64) { const int j = i >> 11, k = i & 2047;
        const int col = j < 32 ? 5120 + j : (j < 40 ? 11296 + (j - 32) : 11304 + (j - 40));
        WsT[i] = (bf16)(j < 48 ? f2bf(F.w_in[(size_t)k * WIN_LD + col]) : 0u); }
    for (int i = gw * 64 + F.lane; i < 2048 * 32; i += NGW * 64) Wrt[i] = F.norm2_w[i >> 5] * F.router_w[i];
    for (int m = gw; m < TT; m += NGW) rms_row_to_bf16(F.x + (size_t)m * DM, F.norm1_w, XN1 + (size_t)m * DM, F.lane);
}

__device__ __forceinline__ void p1_small(Frame& F) {
    const bf16* XN1 = (const bf16*)(F.ws + WS_XN1); const bf16* WsT = (const bf16*)(F.ws + WS_WSM); float* SMALL = (float*)(F.ws + WS_SMALL);
    const int gw = F.bid * NWAVES + F.wave, NGW = F.G * NWAVES, fr = F.lane & 15, fq = F.lane >> 4;
    for (int task = gw; task < TT / 16; task += NGW) {
        const int t0 = task * 16;
        f32x4 acc[4];
#pragma unroll
        for (int n = 0; n < 4; ++n) acc[n] = (f32x4){0.f, 0.f, 0.f, 0.f};
        const bf16* arow = XN1 + (size_t)(t0 + fr) * DM + 8 * fq; const bf16* brow = WsT + (size_t)fr * DM + 8 * fq;
#pragma unroll 16
        for (int ks = 0; ks < 64; ++ks) {
            const bf16x8 a = *(const bf16x8*)(arow + 32 * ks);
#pragma unroll
            for (int n = 0; n < 4; ++n) { const bf16x8 b = *(const bf16x8*)(brow + (size_t)n * 16 * DM + 32 * ks); acc[n] = __builtin_amdgcn_mfma_f32_16x16x32_bf16(a, b, acc[n], 0, 0, 0); }
        }
#pragma unroll
        for (int n = 0; n < 4; ++n)
#pragma unroll
            for (int r = 0; r < 4; ++r) SMALL[(size_t)(t0 + 4 * fq + r) * 64 + n * 16 + fr] = acc[n][r];
    }
}

__device__ __forceinline__ void unpack8(const v4u r, float (&f)[8]) { f[0] = bflo(r.x); f[1] = bfhi(r.x); f[2] = bflo(r.y); f[3] = bfhi(r.y); f[4] = bflo(r.z); f[5] = bfhi(r.z); f[6] = bflo(r.w); f[7] = bfhi(r.w); }

__device__ __forceinline__ void phase_conv(Frame& F) {
    const bf16* PROJ = (const bf16*)(F.ws + WS_PROJ); bf16* XC = (bf16*)(F.ws + WS_XC);
    constexpr int TB = 16, NCG = 384, NIT = (TT / TB) * NCG;
    for (int it = F.bid * (NWAVES * 64) + F.tid; it < NIT; it += F.G * NWAVES * 64) {
        const int cg = it % NCG, tb = it / NCG, ch = cg * 8, t0 = tb * TB; const bool seq0 = (t0 % SEQ) == 0;
        float w[4][8], bs[8];
#pragma unroll
        for (int j = 0; j < 4; ++j) { const f32x4 a = *(const f32x4*)(F.conv_w + j * 3072 + ch), b = *(const f32x4*)(F.conv_w + j * 3072 + ch + 4);
            w[j][0] = a.x; w[j][1] = a.y; w[j][2] = a.z; w[j][3] = a.w; w[j][4] = b.x; w[j][5] = b.y; w[j][6] = b.z; w[j][7] = b.w; }
        { const f32x4 a = *(const f32x4*)(F.conv_b + ch), b = *(const f32x4*)(F.conv_b + ch + 4); bs[0] = a.x; bs[1] = a.y; bs[2] = a.z; bs[3] = a.w; bs[4] = b.x; bs[5] = b.y; bs[6] = b.z; bs[7] = b.w; }
        const bf16* src = PROJ + (size_t)t0 * NPROJ + PC_XBC + ch;
        float r0[8], r1[8], r2[8], r3[8];
        if (seq0) {
#pragma unroll
            for (int i = 0; i < 8; ++i) { r0[i] = 0.f; r1[i] = 0.f; r2[i] = 0.f; }
        } else { unpack8(*(const v4u*)(src - 3 * (size_t)NPROJ), r0); unpack8(*(const v4u*)(src - 2 * (size_t)NPROJ), r1); unpack8(*(const v4u*)(src - (size_t)NPROJ), r2); }
        v4u rw[TB];
#pragma unroll
        for (int l = 0; l < TB; ++l) rw[l] = *(const v4u*)(src + (size_t)l * NPROJ);
#pragma unroll
        for (int l = 0; l < TB; ++l) {
            unpack8(rw[l], r3);
            float o[8];
#pragma unroll
            for (int i = 0; i < 8; ++i) { const float v = bs[i] + w[0][i] * r0[i] + w[1][i] * r1[i] + w[2][i] * r2[i] + w[3][i] * r3[i]; o[i] = siluf(v); r0[i] = r1[i]; r1[i] = r2[i]; r2[i] = r3[i]; }
            v4u ov; ov.x = pk2(o[0], o[1]); ov.y = pk2(o[2], o[3]); ov.z = pk2(o[4], o[5]); ov.w = pk2(o[6], o[7]);
            *(v4u*)(XC + (size_t)(t0 + l) * 3072 + ch) = ov;
        }
    }
}

constexpr int MX_PITCH = 272;
static_assert(true, "");
constexpr int MX_QM = 0, MX_KM = 34816, MX_KW = 69632, MX_VT = 104448, MX_SI = 121856, MX_VEC = 139264, MX_VECB = 3072, MX_NVEC = MX_VEC + 2 * MX_VECB, MX_SCAL = MX_NVEC + 512, MX_END = MX_SCAL + 64;
__device__ __forceinline__ unsigned cvt_pk_bf16_nop(float lo, float hi) { unsigned r; asm volatile("v_cvt_pk_bf16_f32 %0, %1, %2\n\ts_nop 1" : "=v"(r) : "v"(lo), "v"(hi)); return r; }
__device__ __forceinline__ int mx_sw(int row, int tbyte) { return row * MX_PITCH + ((((tbyte >> 4) ^ (row >> 3)) & 15) << 4) + (tbyte & 15); }
__device__ __forceinline__ bf16x8 lds_frag(const LAS unsigned char* img, int row, int kbyte) { return *(const LAS bf16x8*)(img + row * MX_PITCH + kbyte); }
static_assert(MX_END + 256 <= LDSCTL_OFF, "mixer LDS map");
template <bool ML> __device__ __forceinline__ void mixer_unit(Frame& F, int unit) {
    const bf16* PROJ = (const bf16*)(F.ws + WS_PROJ); const bf16* XC = (const bf16*)(F.ws + WS_XC); const float* SMALL = (const float*)(F.ws + WS_SMALL);
    bf16* YMIX = (bf16*)(F.ws + WS_YMIX); float* SSQ = (float*)(F.ws + WS_SSQ);
    const int w = F.wave, fr = F.lane & 15, fq = F.lane >> 4, tid = F.tid;
    const int b = unit >> 5, tok0 = b * SEQ, hd = unit & 31, grp = hd >> 3, mh = (unit & 31) >> 2, vq = unit & 3;
    const float qs = 0.08838834764831845f;
    LAS unsigned char* QM = F.lds + MX_QM; LAS unsigned char* KM = F.lds + MX_KM; LAS unsigned char* KW = F.lds + MX_KW; LAS unsigned char* VT = F.lds + MX_VT; LAS unsigned char* SI = F.lds + MX_SI;
    LAS float* exch = (LAS float*)(F.lds + MX_VEC + (w >> 2) * MX_VECB + 1024) + (w & 3) * 32;
    LAS float* nvec = (LAS float*)(F.lds + MX_NVEC); LAS float* scal = (LAS float*)(F.lds + MX_SCAL);
    const int fr3 = fr >> 3;
    int vtb[2];
#pragma unroll
    for (int p = 0; p < 2; ++p) vtb[p] = fr * MX_PITCH + ((fq ^ ((2 * p) | fr3)) << 4);
    int vpb[2][2];
#pragma unroll
    for (int p = 0; p < 2; ++p)
#pragma unroll
        for (int h = 0; h < 2; ++h) vpb[p][h] = fr * MX_PITCH + (((((fq >> 1) | (2 * h)) ^ ((2 * p) | fr3))) << 4) + 8 * (fq & 1);
    const int kwb = (16 * w + fr) * MX_PITCH + ((fq ^ ((2 * (w & 1)) | fr3)) << 4), kwh = w >> 1;

    const bf16* qsrc; const bf16* ksrc; const bf16* vsrc; int ld;
    if (ML) { qsrc = PROJ + PC_Q + mh * 128; ksrc = PROJ + PC_K + mh * 128; vsrc = PROJ + PC_V + mh * 256 + vq * 64; ld = NPROJ; }
    else { qsrc = XC + 2560 + grp * 128; ksrc = XC + 2048 + grp * 128; vsrc = XC + hd * 64; ld = 3072; }
    const float c_a = ML ? 0.f : -expf(F.a_log[hd]), c_dtb = ML ? 0.f : F.dt_bias[hd], c_D = ML ? 0.f : F.d_skip[hd], c_ib = ML ? F.i_bias[mh] : 0.f, c_fb = ML ? F.f_bias[mh] : 0.f;
    float mprev = 0.f;
    f32x4 sacc[4]; float nreg = 0.f;
#pragma unroll
    for (int j = 0; j < 4; ++j) sacc[j] = (f32x4){0.f, 0.f, 0.f, 0.f};
    v4u pq[4], pk[4], pv[2];
    float vA0 = 0.f, vA1 = 0.f, vB0 = 0.f, vB1 = 0.f, vC0 = 0.f, vC1 = 0.f, vD0 = 0.f, vD1 = 0.f, vE0 = 0.f, vE1 = 0.f, vG0 = 0.f, vG1 = 0.f, vSA = 0.f, vSG = 0.f;
    float sl0 = 0.f, sl1 = 0.f, sl2 = 0.f, sl3 = 0.f;
#define MX_SCAN_L(c) do { if (w == 0) { const size_t tt = (size_t)(tok0 + 128 * (c) + 2 * F.lane); \
        if (!ML) { sl0 = SMALL[tt * 64 + hd]; sl1 = SMALL[(tt + 1) * 64 + hd]; } \
        else { sl0 = SMALL[tt * 64 + 32 + mh]; sl1 = SMALL[(tt + 1) * 64 + 32 + mh]; sl2 = SMALL[tt * 64 + 40 + mh]; sl3 = SMALL[(tt + 1) * 64 + 40 + mh]; } } } while (0)
#define MX_SOFTPLUS(x) ((x) > 20.f ? (x) : __logf(1.0f + __expf(x)))
#define MX_LOGSIG(x) (fminf((x), 0.f) - __logf(1.0f + __expf(-fabsf(x))))
#define MX_SCAN_A(c) do { if (w == 0) { \
        if (!ML) { const float d0 = MX_SOFTPLUS(sl0 + c_dtb), d1 = MX_SOFTPLUS(sl1 + c_dtb); \
            const float x0 = d0 * c_a, x1 = d1 * c_a; float incl = x0 + x1; \
            _Pragma("unroll") for (int d = 1; d < 64; d <<= 1) { const float t_ = __shfl_up(incl, d); if (F.lane >= d) incl += t_; } \
            const float cum1 = incl, cum0 = incl - x1, tot = __shfl(incl, 63); \
            vA0 = -cum0; vA1 = -cum1; vB0 = -cum0; vB1 = -cum1; vC0 = d0; vC1 = d1; vD0 = __expf(cum0); vD1 = __expf(cum1); vE0 = d0 * __expf(tot - cum0); vE1 = d1 * __expf(tot - cum1); vSA = __expf(tot); vSG = 1.0f; \
        } else { const float li0 = sl0 + c_ib, li1 = sl1 + c_ib; \
            const float x0 = MX_LOGSIG(sl2 + c_fb), x1 = MX_LOGSIG(sl3 + c_fb); float incl = x0 + x1; \
            _Pragma("unroll") for (int d = 1; d < 64; d <<= 1) { const float t_ = __shfl_up(incl, d); if (F.lane >= d) incl += t_; } \
            const float cum1 = incl, cum0 = incl - x1, btot = __shfl(incl, 63); \
            const float dd0 = li0 - cum0, dd1 = li1 - cum1; float im = fmaxf(dd0, dd1); \
            _Pragma("unroll") for (int d = 1; d < 64; d <<= 1) { const float t_ = __shfl_up(im, d); if (F.lane >= d) im = fmaxf(im, t_); } \
            float pm = __shfl_up(im, 1); if (F.lane == 0) pm = -3.0e38f; const float pmax0 = fmaxf(pm, dd0), pmax1 = im, pm127 = __shfl(im, 63); \
            const float M0 = fmaxf(mprev, pmax0), M1 = fmaxf(mprev, pmax1); \
            vA0 = dd0; vA1 = dd1; vB0 = M0; vB1 = M1; vD0 = qs * __expf(mprev - M0); vD1 = qs * __expf(mprev - M1); vG0 = __expf(-(cum0 + M0)); vG1 = __expf(-(cum1 + M1)); \
            const float mloc = btot + pm127, mnew = fmaxf(btot + mprev, mloc); \
            vSA = __expf(btot + mprev - mnew); vSG = __expf(mloc - mnew); vE0 = __expf(dd0 - pm127) * vSG; vE1 = __expf(dd1 - pm127) * vSG; mprev = mnew; } } } while (0)
#define MX_SCAN_B(c) do { if (w == 0) { \
        LAS float* vb = (LAS float*)(F.lds + MX_VEC + ((c) & 1) * MX_VECB); const int l0 = 2 * F.lane; \
        *(LAS f32x2*)(vb + l0) = (f32x2){vA0, vA1}; *(LAS f32x2*)(vb + 128 + l0) = (f32x2){vB0, vB1}; if (!ML) *(LAS f32x2*)(vb + 256 + l0) = (f32x2){vC0, vC1}; \
        *(LAS f32x2*)(vb + 384 + l0) = (f32x2){vD0, vD1}; *(LAS f32x2*)(vb + 512 + l0) = (f32x2){vE0, vE1}; if (ML) *(LAS f32x2*)(vb + 640 + l0) = (f32x2){vG0, vG1}; \
        if (F.lane == 0) { scal[2 * ((c) & 1)] = vSA; scal[2 * ((c) & 1) + 1] = vSG; } } } while (0)
#define MX_SCAN(c) do { MX_SCAN_L(c); MX_SCAN_A(c); MX_SCAN_B(c); } while (0)
#define MX_PREFETCH(c) do { const size_t tb_ = (size_t)(tok0 + 128 * (c)); \
        _Pragma("unroll") for (int i = 0; i < 2; ++i) { const int pid = tid + 512 * i, a2 = pid >> 4, k8 = pid & 15; \
            pq[2 * i] = *(const v4u*)(qsrc + (tb_ + 2 * a2) * ld + 8 * k8); pq[2 * i + 1] = *(const v4u*)(qsrc + (tb_ + 2 * a2 + 1) * ld + 8 * k8); \
            pk[2 * i] = *(const v4u*)(ksrc + (tb_ + 2 * a2) * ld + 8 * k8); pk[2 * i + 1] = *(const v4u*)(ksrc + (tb_ + 2 * a2 + 1) * ld + 8 * k8); } \
        { const int a2 = tid >> 3, v8 = tid & 7; pv[0] = *(const v4u*)(vsrc + (tb_ + 2 * a2) * ld + 8 * v8); pv[1] = *(const v4u*)(vsrc + (tb_ + 2 * a2 + 1) * ld + 8 * v8); } } while (0)
#define MX_WRITE(c) do { const LAS float* vb = (const LAS float*)(F.lds + MX_VEC + ((c) & 1) * MX_VECB); \
        _Pragma("unroll") for (int i = 0; i < 2; ++i) { const int pid = tid + 512 * i, a2 = pid >> 4, k8 = pid & 15, l = 2 * a2; \
            *(LAS v4u*)(QM + l * MX_PITCH + 16 * k8) = pq[2 * i]; *(LAS v4u*)(QM + (l + 1) * MX_PITCH + 16 * k8) = pq[2 * i + 1]; \
            *(LAS v4u*)(KM + l * MX_PITCH + 16 * k8) = pk[2 * i]; *(LAS v4u*)(KM + (l + 1) * MX_PITCH + 16 * k8) = pk[2 * i + 1]; \
            float f0[8], f1[8]; unpack8(pk[2 * i], f0); unpack8(pk[2 * i + 1], f1); const f32x2 wl = *(const LAS f32x2*)(vb + 512 + l); \
            _Pragma("unroll") for (int e = 0; e < 8; ++e) *(LAS unsigned*)(KW + mx_sw(8 * k8 + e, 2 * l)) = pg8::cvt_pk_bf16(f0[e] * wl.x, f1[e] * wl.y); } \
        { const int a2 = tid >> 3, v8 = tid & 7, l = 2 * a2; const v4u r0 = pv[0], r1 = pv[1]; LAS unsigned char* vp_ = VT + mx_sw(8 * v8, 2 * l); \
            *(LAS unsigned*)(vp_ + 0 * MX_PITCH) = (r0.x & 0xffffu) | (r1.x << 16); *(LAS unsigned*)(vp_ + 1 * MX_PITCH) = (r0.x >> 16) | (r1.x & 0xffff0000u); \
            *(LAS unsigned*)(vp_ + 2 * MX_PITCH) = (r0.y & 0xffffu) | (r1.y << 16); *(LAS unsigned*)(vp_ + 3 * MX_PITCH) = (r0.y >> 16) | (r1.y & 0xffff0000u); \
            *(LAS unsigned*)(vp_ + 4 * MX_PITCH) = (r0.z & 0xffffu) | (r1.z << 16); *(LAS unsigned*)(vp_ + 5 * MX_PITCH) = (r0.z >> 16) | (r1.z & 0xffff0000u); \
            *(LAS unsigned*)(vp_ + 6 * MX_PITCH) = (r0.w & 0xffffu) | (r1.w << 16); *(LAS unsigned*)(vp_ + 7 * MX_PITCH) = (r0.w >> 16) | (r1.w & 0xffff0000u); } \
        _Pragma("unroll") for (int j = 0; j < 4; ++j) { v2u sv; sv.x = pg8::cvt_pk_bf16(sacc[j][0], sacc[j][1]); sv.y = pg8::cvt_pk_bf16(sacc[j][2], sacc[j][3]); *(LAS v2u*)(SI + (16 * j + fr) * MX_PITCH + (16 * w + 4 * fq) * 2) = sv; } \
        if (ML && fq == 0) nvec[16 * w + fr] = nreg; } while (0)
    const int gcol = (ML ? PC_O + mh * 256 + vq * 64 : PC_Z + hd * 64) + 16 * (F.lane & 3);
    LAS float* nwl = (LAS float*)(F.lds + MX_END);
    if (tid < 64) nwl[tid] = ML ? F.ml_norm_w[mh * 256 + vq * 64 + tid] : F.ssd_norm_w[hd * 64 + tid];
    v4u zc0 = (v4u){0u, 0u, 0u, 0u}, zc1 = zc0;
    { const bf16* zp = PROJ + (size_t)(tok0 + 16 * w + (F.lane >> 2)) * NPROJ + gcol; zc0 = *(const v4u*)zp; zc1 = *(const v4u*)(zp + 8); }
    MX_SCAN(0);
    MX_PREFETCH(0);
    __syncthreads();
    MX_WRITE(0);
    __syncthreads();
    for (int c = 0; c < SEQ / 128; ++c) {
        const LAS float* vb = (const LAS float*)(F.lds + MX_VEC + (c & 1) * MX_VECB);
        const bool more = (c + 1 < SEQ / 128);
        if (more) { MX_SCAN_L(c + 1); MX_PREFETCH(c + 1); }
        bf16x8 qf[4];
#pragma unroll
        for (int ks = 0; ks < 4; ++ks) qf[ks] = lds_frag(QM, 16 * w + fr, 64 * ks + 16 * fq);
        const float mlv = vb[128 + 16 * w + fr];
        float dsum = 0.f;
        f32x4 y1[4];
#pragma unroll
        for (int j = 0; j < 4; ++j) y1[j] = (f32x4){0.f, 0.f, 0.f, 0.f};
        const f32x4 rs4 = *(const LAS f32x4*)(vb + 384 + 16 * w + 4 * fq);
#pragma unroll
        for (int ks = 0; ks < 4; ++ks) { bf16x8 sf[4];
#pragma unroll
            for (int j = 0; j < 4; ++j) sf[j] = lds_frag(SI, 16 * j + fr, 64 * ks + 16 * fq);
#pragma unroll
            for (int j = 0; j < 4; ++j) y1[j] = __builtin_amdgcn_mfma_f32_16x16x32_bf16(qf[ks], sf[j], y1[j], 0, 0, 0); }
#pragma unroll
        for (int j = 0; j < 4; ++j) y1[j] = y1[j] * rs4;
        __builtin_amdgcn_sched_barrier(0);
#pragma unroll 1
        for (int k2 = 0; 2 * k2 <= w; ++k2) {
            unsigned pw[4];
#pragma unroll
            for (int h = 0; h < 2; ++h) {
                const int si = 2 * k2 + h;
                f32x4 acc = (f32x4){0.f, 0.f, 0.f, 0.f};
#pragma unroll
                for (int ks = 0; ks < 4; ++ks) acc = __builtin_amdgcn_mfma_f32_16x16x32_bf16(lds_frag(KM, 16 * si + fr, 64 * ks + 16 * fq), qf[ks], acc, 0, 0, 0);
                const f32x4 e4 = *(const LAS f32x4*)(vb + 16 * si + 4 * fq); f32x4 x4 = (f32x4){qs, qs, qs, qs}; if (!ML) x4 = *(const LAS f32x4*)(vb + 256 + 16 * si + 4 * fq);
                float p[4];
#pragma unroll
                for (int r = 0; r < 4; ++r) { const float v = acc[r] * __expf(e4[r] - mlv) * x4[r]; const bool ok = (si < w) || (si == w && 4 * fq + r <= fr); p[r] = ok ? v : 0.f; }
                if (ML) dsum += (p[0] + p[1]) + (p[2] + p[3]);
                pw[2 * h] = cvt_pk_bf16_nop(p[0], p[1]); pw[2 * h + 1] = cvt_pk_bf16_nop(p[2], p[3]);
            }
            HWAIT();
            const v4u pwv = (v4u){pw[0], pw[1], pw[2], pw[3]}; const bf16x8 pf = __builtin_bit_cast(bf16x8, pwv);
#pragma unroll
            for (int j = 0; j < 4; ++j) { const int ho = j * 16 * MX_PITCH + ((k2 ^ (j >> 1)) << 6); const v2u lo = *(const LAS v2u*)(VT + vpb[j & 1][0] + ho), hi = *(const LAS v2u*)(VT + vpb[j & 1][1] + ho); const v4u vw = (v4u){lo.x, lo.y, hi.x, hi.y};
                y1[j] = __builtin_amdgcn_mfma_f32_16x16x32_bf16(pf, __builtin_bit_cast(bf16x8, vw), y1[j], 0, 0, 0); }
            HWAIT();
        }
        HSYNC();
        __builtin_amdgcn_sched_barrier(0);
        __builtin_amdgcn_sched_barrier(0);
        if (ML) {
            dsum += __shfl_xor(dsum, 16); dsum += __shfl_xor(dsum, 32);
            float d2 = 0.f;
#pragma unroll
            for (int ks = 0; ks < 4; ++ks) { float qv[8]; unpack8(__builtin_bit_cast(v4u, qf[ks]), qv); const f32x4 n0 = *(const LAS f32x4*)(nvec + 32 * ks + 8 * fq), n1 = *(const LAS f32x4*)(nvec + 32 * ks + 8 * fq + 4);
                d2 += qv[0] * n0.x + qv[1] * n0.y + qv[2] * n0.z + qv[3] * n0.w + qv[4] * n1.x + qv[5] * n1.y + qv[6] * n1.z + qv[7] * n1.w; }
            d2 += __shfl_xor(d2, 16); d2 += __shfl_xor(d2, 32);
            if (fq == 0) { exch[fr] = dsum; exch[16 + fr] = d2; }
        }
        HSYNC();
        __builtin_amdgcn_sched_barrier(0);
        LAS float* stg = (LAS float*)(QM + 16 * w * MX_PITCH);
        if (ML) { const f32x4 fl4 = *(const LAS f32x4*)(vb + 640 + 16 * w + 4 * fq); const f32x4 dA = *(const LAS f32x4*)(exch + 4 * fq), dB = *(const LAS f32x4*)(exch + 16 + 4 * fq);
#pragma unroll
            for (int r = 0; r < 4; ++r) { const float den = fmaxf(fabsf(dA[r] + rs4[r] * dB[r]), fl4[r]); const float inv = __builtin_amdgcn_rcpf(den);
#pragma unroll
                for (int j = 0; j < 4; ++j) stg[(4 * fq + r) * 68 + 16 * j + fr] = y1[j][r] * inv; }
        } else {
#pragma unroll
            for (int j = 0; j < 4; ++j) { const v2u xw = *(const LAS v2u*)(VT + mx_sw(16 * j + fr, 32 * w + 8 * fq)); const float xs[4] = {bflo(xw.x), bfhi(xw.x), bflo(xw.y), bfhi(xw.y)};
#pragma unroll
                for (int r = 0; r < 4; ++r) stg[(4 * fq + r) * 68 + 16 * j + fr] = y1[j][r] + c_D * xs[r]; }
        }
        {   const int erow = F.lane >> 2, ecs = F.lane & 3; const size_t trow = (size_t)(tok0 + 128 * c + 16 * w + erow);
            float yv[16];
#pragma unroll
            for (int i = 0; i < 4; ++i) { const f32x4 t4 = *(const LAS f32x4*)(stg + erow * 68 + 16 * ecs + 4 * i); yv[4 * i] = t4.x; yv[4 * i + 1] = t4.y; yv[4 * i + 2] = t4.z; yv[4 * i + 3] = t4.w; }
            float zf[16]; { float t8[8]; unpack8(zc0, t8);
#pragma unroll
                for (int i = 0; i < 8; ++i) zf[i] = t8[i]; unpack8(zc1, t8);
#pragma unroll
                for (int i = 0; i < 8; ++i) zf[8 + i] = t8[i]; }
            if (!ML) {
#pragma unroll
                for (int i = 0; i < 16; ++i) yv[i] = yv[i] * zf[i] * __builtin_amdgcn_rcpf(1.0f + __expf(-zf[i])); }
            float ss = 0.f;
#pragma unroll
            for (int i = 0; i < 16; ++i) ss += yv[i] * yv[i];
            ss += __shfl_xor(ss, 1); ss += __shfl_xor(ss, 2);
            if (ecs == 0) SSQ[(ML ? (size_t)TT * 32 : 0) + trow * 32 + (ML ? mh * 4 + vq : hd)] = ss;
#pragma unroll
            for (int i = 0; i < 4; ++i) { const f32x4 w4 = *(const LAS f32x4*)(nwl + 16 * ecs + 4 * i);
                yv[4 * i] *= w4.x; yv[4 * i + 1] *= w4.y; yv[4 * i + 2] *= w4.z; yv[4 * i + 3] *= w4.w; }
            if (ML) {
#pragma unroll
                for (int i = 0; i < 16; ++i) yv[i] *= __builtin_amdgcn_rcpf(1.0f + __expf(-zf[i])); }
            bf16* yp = YMIX + trow * 4096 + (ML ? 2048 + mh * 256 + vq * 64 : hd * 64) + 16 * ecs;
            *(v4u*)yp = (v4u){pg8::cvt_pk_bf16(yv[0], yv[1]), pg8::cvt_pk_bf16(yv[2], yv[3]), pg8::cvt_pk_bf16(yv[4], yv[5]), pg8::cvt_pk_bf16(yv[6], yv[7])};
            *(v4u*)(yp + 8) = (v4u){pg8::cvt_pk_bf16(yv[8], yv[9]), pg8::cvt_pk_bf16(yv[10], yv[11]), pg8::cvt_pk_bf16(yv[12], yv[13]), pg8::cvt_pk_bf16(yv[14], yv[15])};
            if (more) { const bf16* zp = PROJ + (size_t)(tok0 + 128 * (c + 1) + 16 * w + (F.lane >> 2)) * NPROJ + gcol; zc0 = *(const v4u*)zp; zc1 = *(const v4u*)(zp + 8); }
        }
        __builtin_amdgcn_sched_barrier(0);
        const float sa = scal[2 * (c & 1)];
#pragma unroll
        for (int j = 0; j < 4; ++j) sacc[j] = sacc[j] * sa;
        float nsum = 0.f;
#pragma unroll
        for (int ks = 0; ks < 4; ++ks) { const bf16x8 kf = *(const LAS bf16x8*)(KW + kwb + ((ks ^ kwh) << 6)); bf16x8 vf[4];
#pragma unroll
            for (int j = 0; j < 4; ++j) vf[j] = *(const LAS bf16x8*)(VT + vtb[j & 1] + j * 16 * MX_PITCH + ((ks ^ (j >> 1)) << 6));
            if (ML) { float kv[8]; unpack8(__builtin_bit_cast(v4u, kf), kv); nsum += ((kv[0] + kv[1]) + (kv[2] + kv[3])) + ((kv[4] + kv[5]) + (kv[6] + kv[7])); }
#pragma unroll
            for (int j = 0; j < 4; ++j) sacc[j] = __builtin_amdgcn_mfma_f32_16x16x32_bf16(kf, vf[j], sacc[j], 0, 0, 0); }
        if (ML) { nsum += __shfl_xor(nsum, 16); nsum += __shfl_xor(nsum, 32); nreg = nreg * sa + nsum; }
        if (more) { MX_SCAN_A(c + 1); }
        __syncthreads();
        if (more) { MX_SCAN_B(c + 1); }
        __syncthreads();
        if (more) { MX_WRITE(c + 1); }
        __syncthreads();
    }
#undef MX_SCAN
#undef MX_SCAN_A
#undef MX_SCAN_L
#undef MX_SOFTPLUS
#undef MX_LOGSIG
#undef MX_SCAN_B
#undef MX_PREFETCH
#undef MX_WRITE
}
__device__ __forceinline__ void phase_mixer(Frame& F) {
    for (int unit = F.bid; unit < 256; unit += F.G) { mixer_unit<false>(F, unit); mixer_unit<true>(F, unit); }
}

__device__ __forceinline__ void phase3(Frame& F) {
    const bf16* PROJ = (const bf16*)(F.ws + WS_PROJ); bf16* YMIX = (bf16*)(F.ws + WS_YMIX); const float* SSQ = (const float*)(F.ws + WS_SSQ);
    const int gw = F.bid * NWAVES + F.wave, NGW = F.G * NWAVES;
    for (int t = gw; t < TT; t += NGW) {
        bf16* yrow = YMIX + (size_t)t * 4096;
#pragma unroll
        for (int j = 0; j < 8; ++j) {
            const int c0 = (j * 64 + F.lane) * 8;
            float y[8]; unpack8(*(const v4u*)(yrow + c0), y);
            float o[8];
            if (j < 4) {
                const int g = c0 >> 9; const f32x4 s0 = *(const f32x4*)(SSQ + (size_t)t * 32 + g * 8), s1 = *(const f32x4*)(SSQ + (size_t)t * 32 + g * 8 + 4);
                const float ms = ((s0.x + s0.y) + (s0.z + s0.w) + (s1.x + s1.y) + (s1.z + s1.w)) * (1.0f / 512.0f);
                const float rs = 1.0f / sqrtf(ms + EPSF);
                const f32x4 w0 = *(const f32x4*)(F.ssd_norm_w + c0), w1 = *(const f32x4*)(F.ssd_norm_w + c0 + 4);
                o[0] = y[0] * rs * w0.x; o[1] = y[1] * rs * w0.y; o[2] = y[2] * rs * w0.z; o[3] = y[3] * rs * w0.w;
                o[4] = y[4] * rs * w1.x; o[5] = y[5] * rs * w1.y; o[6] = y[6] * rs * w1.z; o[7] = y[7] * rs * w1.w;
            } else {
                const int cc = c0 - 2048, h = cc >> 8; const f32x4 s0 = *(const f32x4*)(SSQ + (size_t)TT * 32 + (size_t)t * 32 + h * 4);
                const float ms = ((s0.x + s0.y) + (s0.z + s0.w)) * (1.0f / 256.0f);
                const float rs = 1.0f / sqrtf(ms + EPSF);
                const f32x4 w0 = *(const f32x4*)(F.ml_norm_w + cc), w1 = *(const f32x4*)(F.ml_norm_w + cc + 4);
                float og[8]; unpack8(*(const v4u*)(PROJ + (size_t)t * NPROJ + PC_O + cc), og);
                const float wv[8] = {w0.x, w0.y, w0.z, w0.w, w1.x, w1.y, w1.z, w1.w};
#pragma unroll
                for (int i = 0; i < 8; ++i) o[i] = y[i] * rs * wv[i] * __builtin_amdgcn_rcpf(1.0f + __expf(-og[i]));
            }
            v4u ov; ov.x = pk2(o[0], o[1]); ov.y = pk2(o[2], o[3]); ov.z = pk2(o[4], o[5]); ov.w = pk2(o[6], o[7]);
            *(v4u*)(yrow + c0) = ov;
        }
    }
}

__device__ __forceinline__ void phase5(Frame& F) {
    const float* H2 = (const float*)(F.ws + WS_H2); const float* Wrt = (const float*)(F.ws + WS_WRT); bf16* XN2 = (bf16*)(F.ws + WS_XN2);
    int* EIDX = (int*)(F.ws + WS_ROUTE); int* RANK = EIDX + TT * 4;
    int* TOKL = (int*)(F.ws + WS_XG); float* GATEL = (float*)(F.ws + WS_XG + 4 * MiB);
    LAS float* xT = (LAS float*)(F.lds + F.wave * 8192); LAS float* lg = (LAS float*)(F.lds + 65536 + F.wave * 1024);
    LAS int* cntl = (LAS int*)(F.lds + 73728); LAS int* baseg = cntl + 32;
    const int gw = F.bid * NWAVES + F.wave, NGW = F.G * NWAVES, ntask = TT / 8, iters = (ntask + NGW - 1) / NGW;
    for (int itx = 0; itx < iters; ++itx) {
        const int task = itx * NGW + gw; const bool valid = task < ntask; const int t0 = task * 8;
        if (F.tid < 32) cntl[F.tid] = 0;
        __syncthreads();
        float rstd[8]; int me[4] = {0, 0, 0, 0}, mr[4] = {0, 0, 0, 0}; float mg[4] = {0.f, 0.f, 0.f, 0.f};
#pragma unroll
        for (int k = 0; k < 8; ++k) rstd[k] = 0.f;
        float acc[8], ssq[8];
#pragma unroll
        for (int k = 0; k < 8; ++k) { acc[k] = 0.f; ssq[k] = 0.f; }
        const int e = F.lane & 31, dh = F.lane >> 5;
        LAS float* wl = (LAS float*)(F.lds + 81920);
        for (int dc = 0; dc < 8; ++dc) {
            __syncthreads();
#pragma unroll
            for (int q = 0; q < 4; ++q) ((LAS f32x4*)wl)[F.tid + 512 * q] = ((const f32x4*)(Wrt + (size_t)dc * 256 * 32))[F.tid + 512 * q];
            if (valid) {
                f32x4 xk[8];
#pragma unroll
                for (int k = 0; k < 8; ++k) { xk[k] = *(const f32x4*)(H2 + (size_t)(t0 + k) * DM + dc * 256 + 4 * F.lane); ssq[k] += (xk[k].x * xk[k].x + xk[k].y * xk[k].y) + (xk[k].z * xk[k].z + xk[k].w * xk[k].w); }
#pragma unroll
                for (int jj = 0; jj < 4; ++jj) { LAS float* dp = xT + (jj * 64 + F.lane) * 8;
                    *(LAS f32x4*)dp = (f32x4){xk[0][jj], xk[1][jj], xk[2][jj], xk[3][jj]}; *(LAS f32x4*)(dp + 4) = (f32x4){xk[4][jj], xk[5][jj], xk[6][jj], xk[7][jj]}; }
            }
            __syncthreads();
            if (valid) {
                const LAS float* xp = xT + dh * 128 * 8;
#pragma unroll 8
                for (int i = 0; i < 128; ++i) { const float w = wl[(4 * (i & 63) + 2 * dh + (i >> 6)) * 32 + e];     const f32x4 xa = *(const LAS f32x4*)(xp + i * 8), xb = *(const LAS f32x4*)(xp + i * 8 + 4);
                    acc[0] += w * xa.x; acc[1] += w * xa.y; acc[2] += w * xa.z; acc[3] += w * xa.w; acc[4] += w * xb.x; acc[5] += w * xb.y; acc[6] += w * xb.z; acc[7] += w * xb.w; }
            }
        }
        if (valid) {
            const float rb = F.router_b[e];
#pragma unroll
            for (int k = 0; k < 8; ++k) { rstd[k] = 1.0f / sqrtf(wave_sum(ssq[k]) * (1.0f / 2048.0f) + EPSF);
                const float v = (acc[k] + __shfl_xor(acc[k], 32)) * rstd[k] + rb; if (F.lane < 32) lg[k * 32 + e] = v; }
            LDS_WAIT(); asm volatile("" ::: "memory");
            if (F.lane < 8) {
                const LAS float* lp = lg + F.lane * 32; float bv[4]; int bi[4] = {-1, -1, -1, -1};
#pragma unroll
                for (int p = 0; p < 4; ++p) { float best = -3.0e38f; int bidx = 0;
                    for (int q = 0; q < 32; ++q) { const float v = lp[q]; const bool taken = (q == bi[0]) | (q == bi[1]) | (q == bi[2]) | (q == bi[3]); if (!taken && v > best) { best = v; bidx = q; } }
                    bv[p] = best; bi[p] = bidx; }
                const float p1 = expf(bv[1] - bv[0]), p2 = expf(bv[2] - bv[0]), p3 = expf(bv[3] - bv[0]); const float inv = 1.0f / (1.0f + p1 + p2 + p3);
                mg[0] = inv; mg[1] = p1 * inv; mg[2] = p2 * inv; mg[3] = p3 * inv;
#pragma unroll
                for (int p = 0; p < 4; ++p) { me[p] = bi[p]; mr[p] = __hip_atomic_fetch_add(cntl + bi[p], 1, __ATOMIC_RELAXED, __HIP_MEMORY_SCOPE_WORKGROUP); }
            }
        }
        __syncthreads();
        if (F.tid < 32) { const int c = cntl[F.tid]; int gb = 0; if (c > 0) gb = (int)__hip_atomic_fetch_add((unsigned*)(F.ctl + CW_CNT + 64 * F.tid), (unsigned)c, RLX_AGENT); baseg[F.tid] = gb; }
        __syncthreads();
        if (valid) {
            if (F.lane < 8) { const size_t t = (size_t)(t0 + F.lane);
#pragma unroll
                for (int p = 0; p < 4; ++p) { const int rk = baseg[me[p]] + mr[p]; EIDX[t * 4 + p] = me[p]; RANK[t * 4 + p] = rk; TOKL[(size_t)me[p] * TT + rk] = (int)t; GATEL[(size_t)me[p] * TT + rk] = mg[p]; } }
#pragma unroll
            for (int k = 0; k < 8; ++k) { const f32x4* xr = (const f32x4*)(H2 + (size_t)(t0 + k) * DM) + F.lane; const f32x4* wr = (const f32x4*)F.norm2_w + F.lane; int* o4 = (int*)((unsigned char*)XN2 + (size_t)(t0 + k) * DM) + F.lane;
#pragma unroll
                for (int j = 0; j < 8; ++j) { const f32x4 v = xr[64 * j], ww = wr[64 * j]; int o = __builtin_amdgcn_cvt_pk_fp8_f32(v.x * rstd[k] * ww.x, v.y * rstd[k] * ww.y, 0, false); o = __builtin_amdgcn_cvt_pk_fp8_f32(v.z * rstd[k] * ww.z, v.w * rstd[k] * ww.w, o, true); o4[64 * j] = o; } }
        }
        __syncthreads();
    }
}
__device__ __forceinline__ int build_moe_tab(Frame& F) {
    LAS unsigned char* tab = (LAS unsigned char*)(F.lds + TAB_OFF); LAS int* tinfo = (LAS int*)(F.lds + TAB_OFF + 320);
    if (F.tid < 32) { const int c = (int)__hip_atomic_load((unsigned*)(F.ctl + CW_CNT + 64 * F.tid), RLX_AGENT); tinfo[4 + F.tid] = (c + 255) >> 8; tinfo[72 + F.tid] = c; }
    __syncthreads();
    if (F.tid == 0) { int a = 0; for (int e = 0; e < 32; ++e) { const int n = tinfo[4 + e]; tinfo[40 + e] = a; for (int j = 0; j < n; ++j) tab[a + j] = (unsigned char)e; a += n; } tinfo[0] = a; }
    __syncthreads();
    return tinfo[0];
}
__device__ __forceinline__ void phase8(Frame& F) {
    const float* H2 = (const float*)(F.ws + WS_H2); const bf16* YR = (const bf16*)(F.ws + WS_YR);
    const int* EIDX = (const int*)(F.ws + WS_ROUTE); const int* RANK = EIDX + TT * 4; (void)build_moe_tab(F); const LAS int* tinfo = (const LAS int*)(F.lds + TAB_OFF + 320);
    const int gw = F.bid * NWAVES + F.wave, NGW = F.G * NWAVES;
    for (int t = gw; t < TT; t += NGW) {
        int slot = 0; if (F.lane < 4) slot = 256 * tinfo[40 + EIDX[(size_t)t * 4 + F.lane]] + RANK[(size_t)t * 4 + F.lane];
        int sl[4]; sl[0] = __shfl(slot, 0); sl[1] = __shfl(slot, 1); sl[2] = __shfl(slot, 2); sl[3] = __shfl(slot, 3);
        float v[4][8]; float ss = 0.f;
#pragma unroll
        for (int j = 0; j < 4; ++j) { const int pz = F.lane + 64 * j; const f32x4 a = *(const f32x4*)(H2 + (size_t)t * DM + 8 * pz), b = *(const f32x4*)(H2 + (size_t)t * DM + 8 * pz + 4);
            v[j][0] = a.x; v[j][1] = a.y; v[j][2] = a.z; v[j][3] = a.w; v[j][4] = b.x; v[j][5] = b.y; v[j][6] = b.z; v[j][7] = b.w; }
#pragma unroll
        for (int k = 0; k < 4; ++k)
#pragma unroll
            for (int j = 0; j < 4; ++j) { float f[8]; unpack8(*((const v4u*)(YR + (size_t)sl[k] * DM) + F.lane + 64 * j), f);
#pragma unroll
                for (int i = 0; i < 8; ++i) v[j][i] += f[i]; }
#pragma unroll
        for (int j = 0; j < 4; ++j)
#pragma unroll
            for (int i = 0; i < 8; ++i) ss += v[j][i] * v[j][i];
        const float rstd = 1.0f / sqrtf(wave_sum(ss) * (1.0f / 2048.0f) + EPSF);
#pragma unroll
        for (int j = 0; j < 4; ++j) { const int pz = F.lane + 64 * j; const f32x4 w0 = *(const f32x4*)(F.final_norm_w + 8 * pz), w1 = *(const f32x4*)(F.final_norm_w + 8 * pz + 4);
            *(f32x4*)(F.out + (size_t)t * DM + 8 * pz) = (f32x4){v[j][0] * rstd * w0.x, v[j][1] * rstd * w0.y, v[j][2] * rstd * w0.z, v[j][3] * rstd * w0.w};
            *(f32x4*)(F.out + (size_t)t * DM + 8 * pz + 4) = (f32x4){v[j][4] * rstd * w1.x, v[j][5] * rstd * w1.y, v[j][6] * rstd * w1.z, v[j][7] * rstd * w1.w}; }
    }
}

struct Args { const float* in[21]; float* out; unsigned char* ws; int ph_lo, ph_hi, li, pad; };
__global__ void __launch_bounds__(NWAVES * 64, 2) hymba_fwd(Args args) {
    extern __shared__ __attribute__((aligned(16))) unsigned char lds[];
    Frame F;
    F.lds = (LAS unsigned char*)lds; F.MISC = (volatile LAS unsigned*)(F.lds + MISC_OFF);
    F.tid = threadIdx.x; F.lane = F.tid & 63; F.wave = __builtin_amdgcn_readfirstlane(F.tid >> 6); F.G = gridDim.x; F.bid = blockIdx.x;
    F.ws = args.ws; F.ctl = (gu32*)(args.ws + WS_CTL); F.out = args.out;
    F.x = args.in[0]; F.norm1_w = args.in[1]; F.w_in = args.in[2]; F.conv_w = args.in[3]; F.conv_b = args.in[4]; F.dt_bias = args.in[5]; F.a_log = args.in[6]; F.d_skip = args.in[7]; F.ssd_norm_w = args.in[8];
    F.i_bias = args.in[9]; F.f_bias = args.in[10]; F.ml_norm_w = args.in[11]; F.w_out = args.in[12]; F.norm2_w = args.in[13]; F.router_w = args.in[14]; F.router_b = args.in[15];
    F.w_gate_up = args.in[16]; F.b_gate_up = args.in[17]; F.w_down = args.in[18]; F.b_down = args.in[19]; F.final_norm_w = args.in[20];
    for (int u = F.tid; u < (LDS_BYTES - LDSCTL_OFF) / 4; u += NWAVES * 64) ((LAS unsigned*)(F.lds + LDSCTL_OFF))[u] = 0u;
    __syncthreads();
    XcdBarrier bar; bar.bar = (unsigned*)(F.ctl + CW_BAR) + args.li * XCD_BAR_WORDS; bar.x = 0; bar.st = nullptr;
    const bool use_bar = (args.ph_hi - args.ph_lo) > 1;
    if (use_bar) bar = xcd_barrier_post((unsigned*)(F.ctl + CW_BAR) + args.li * XCD_BAR_WORDS, F.MISC + 8);
    const int lo = args.ph_lo, hi = args.ph_hi;
#ifndef PHASE_MASK
#define PHASE_MASK 0x1ff
#endif
#define IN(k) (((PHASE_MASK >> (k)) & 1) && lo <= (k) && (k) < hi)
#define SEAM(k) do { if (IN(k) && IN((k) + 1)) xcd_barrier(bar); } while (0)
    if (IN(0)) { phase0(F); } SEAM(0);
    if (IN(1)) {
        pg8::Gemm g{(const pg8::bf16_t*)(F.ws + WS_XN1), (const pg8::bf16_t*)(F.ws + WS_WIN), TT, NPROJ, DM}; pg8::StaticOrder S; S.init(TT, NPROJ, F.G, F.bid);
        pg8::EpiBf16 E{(pg8::bf16_t*)(F.ws + WS_PROJ), NPROJ};
        pg8::gemm_phase<pg8::EpiBf16, pg8::StaticOrder, true, true>(F.lds, g, S, E);
        p1_small(F);
    } SEAM(1);
    if (IN(2)) { phase_conv(F); } SEAM(2);
    if (IN(3)) { phase_mixer(F); } SEAM(3);
    if (IN(4)) {
        pg8::Gemm g{(const pg8::bf16_t*)(F.ws + WS_YMIX), (const pg8::bf16_t*)(F.ws + WS_WOUT), TT, DM, 4096}; pg8::StaticOrder S; S.init(TT, DM, F.G, F.bid);
        pg8::EpiResNorm E{(float*)(F.ws + WS_H2), F.x, DM, (const float*)(F.ws + WS_SSQ), (PG8_LAS float*)(F.lds + RING_BYTES), EPSF};
        pg8::gemm_phase<pg8::EpiResNorm, pg8::StaticOrder, true, true>(F.lds, g, S, E);
    } SEAM(4);
    if (IN(5)) { phase5(F); } SEAM(5);
    if (IN(6)) {
        const int nM = build_moe_tab(F);
        const LAS int* tinfo = (const LAS int*)(F.lds + TAB_OFF + 320); LAS unsigned short* rt = (LAS unsigned short*)(F.lds + ROWTAB_OFF);
        pg8::Gemm g{(const pg8::bf16_t*)(F.ws + WS_XN2), (const pg8::bf16_t*)(F.ws + WS_WGU), nM * 256, 4096, DM};
        pg8::MoeOrder S{nM, 16, 4, nM * 16, F.G, F.bid, (const PG8_LAS unsigned char*)(F.lds + TAB_OFF), (const PG8_LAS unsigned short*)rt};
        { const int* TOKL = (const int*)(F.ws + WS_XG);
          for (int i = 0; i < 18; ++i) { pg8::Unit u; if (!S.next(i, u)) break; const int e = u.pn >> 4, rank = (u.pm - tinfo[40 + e]) * 256 + (F.tid & 255);
              if (F.tid < 256) rt[i * 256 + F.tid] = (unsigned short)(rank < tinfo[72 + e] ? TOKL[(size_t)e * TT + rank] : 0); }
          __syncthreads(); }
        pg8::EpiSwiglu E{(unsigned char*)(F.ws + WS_ACT), F.b_gate_up, (PG8_LAS float*)(F.lds + EPIV_OFF)};
        pg8::gemm_phase<pg8::EpiSwiglu, pg8::MoeOrder, true, true, true, true>(F.lds, g, S, E);
    } SEAM(6);
    if (IN(7)) {
        const int nM = build_moe_tab(F);
        pg8::Gemm g{(const pg8::bf16_t*)(F.ws + WS_ACT), (const pg8::bf16_t*)(F.ws + WS_WD), nM * 256, 2048, DM};
        pg8::MoeOrder S{nM, 8, 3, nM * 8, F.G, F.bid, (const PG8_LAS unsigned char*)(F.lds + TAB_OFF), nullptr};
        pg8::EpiDown E{(pg8::bf16_t*)(F.ws + WS_YR), F.b_down, (const float*)(F.ws + WS_XG + 4 * MiB), (const PG8_LAS int*)(F.lds + TAB_OFF + 320), (PG8_LAS float*)(F.lds + EPIV_OFF)};
        pg8::gemm_phase<pg8::EpiDown, pg8::MoeOrder, true, true, true>(F.lds, g, S, E);
    } SEAM(7);
    if (IN(8)) { phase8(F); }
#undef IN
#undef SEAM
}

extern "C" void kernel_launch(void* const* d_in, const int* in_sizes, int n_in, void* d_out, int out_size, void* d_ws, size_t ws_size, hipStream_t stream) {
    static int grid = 0;
    if (grid == 0) {
        if (n_in != 21 || out_size != TT * DM || ws_size < WS_END) { fprintf(stderr, "kernel_launch: unexpected problem (n_in %d, out %d, ws %zu); nothing launched\n", n_in, out_size, ws_size); grid = -1; return; }
        int dev = 0, cus = 0, per_cu = 0;
        if (hipGetDevice(&dev) != hipSuccess || hipDeviceGetAttribute(&cus, hipDeviceAttributeMultiprocessorCount, dev) != hipSuccess) { grid = -1; return; }
        if (hipFuncSetAttribute((const void*)hymba_fwd, hipFuncAttributeMaxDynamicSharedMemorySize, LDS_BYTES) != hipSuccess) { fprintf(stderr, "kernel_launch: hipFuncSetAttribute failed\n"); grid = -1; return; }
        if (hipOccupancyMaxActiveBlocksPerMultiprocessor(&per_cu, (const void*)hymba_fwd, NWAVES * 64, LDS_BYTES) != hipSuccess || per_cu < 1) { fprintf(stderr, "kernel_launch: occupancy query says %d blocks per CU\n", per_cu); }
        (void)hipGetLastError();
        grid = cus;
    }
    if (grid < 0) return;
    (void)hipMemsetAsync((char*)d_ws + WS_CTL, 0, CTL_ZERO_BYTES, stream);
    Args a{};
    for (int i = 0; i < 21; ++i) a.in[i] = (const float*)d_in[i];
    a.out = (float*)d_out; a.ws = (unsigned char*)d_ws; a.pad = 0;
#if MK_PER_PHASE
    for (int li = 0; li < N_PHASES; ++li) { a.ph_lo = li; a.ph_hi = li + 1; a.li = li; hipLaunchKernelGGL(hymba_fwd, dim3(grid), dim3(NWAVES * 64), LDS_BYTES, stream, a); }
#else
    a.ph_lo = 0; a.ph_hi = N_PHASES; a.li = 0;
    hipLaunchKernelGGL(hymba_fwd, dim3(grid), dim3(NWAVES * 64), LDS_BYTES, stream, a);
#endif
}
```

```cpp
#include <hip/hip_runtime.h>
#include <cstdio>
#include <cstdint>
namespace pg8 {
#define PG8_LAS __attribute__((address_space(3)))
typedef unsigned short bf16_t;
typedef short bf16x8 __attribute__((ext_vector_type(8)));
typedef float f32x4 __attribute__((ext_vector_type(4)));
typedef unsigned u32x4 __attribute__((ext_vector_type(4)));
constexpr int BM = 256, BK = 64, HALF = 128, HTB = HALF * BK * 2  , STAGE_BYTES = 8 * HTB, NXCD = 8, WGM = 8;

__host__ __device__ __forceinline__ int lds_byte(int r, int c) { const int st = (r >> 4) * 2 + (c >> 5), rr = r & 15, cc = c & 31, ob = rr * 64 + cc * 2; return st * 1024 + (ob ^ (((ob >> 9) & 1) << 5)); }
__host__ __device__ __forceinline__ void stage_rc(int b, int& R, int& C) { const int st = b / 1024, sb = b % 1024, swz = sb ^ (((sb >> 9) & 1) << 5); R = (st >> 1) * 16 + swz / 64; C = (st & 1) * 32 + (swz % 64) / 2; }
__host__ __device__ __forceinline__ int perm32(int rho) { const int n = rho >> 4, i = rho & 15; return 8 * (i >> 2) + 4 * n + (i & 3); }

struct Unit { int pm, pn, par; };
struct Gemm { const bf16_t* A; const bf16_t* Bt; int M, N, K; };

struct StaticOrder {
    int nM, nN, nwg, G, c;
    __host__ __device__ void init(int M, int N, int G_, int c_) { nM = M / BM; nN = N / BM; nwg = nM * nN; G = G_; c = c_; }
    __host__ __device__ bool next(int i, Unit& u) const {
        const long L = (long)i * G + c; if (L >= nwg) return false;
        int wgid = (int)L; { const int q = nwg / NXCD, r = nwg % NXCD, xcd = wgid % NXCD, off = wgid / NXCD; wgid = (xcd < r ? xcd * (q + 1) : r * (q + 1) + (xcd - r) * q) + off; }
        const int nig = WGM * nN, gid = wgid / nig, fm = gid * WGM, gsz = (nM - fm) < WGM ? (nM - fm) : WGM;
        u.pm = fm + ((wgid % nig) % gsz); u.pn = (wgid % nig) / gsz; return true;
    }
    __device__ __forceinline__ const PG8_LAS unsigned short* rowp(int) const { return nullptr; }
    __device__ __forceinline__ void a_ready(const Unit&) const {}
    __device__ __forceinline__ void done(const Unit&) const {}
};


__device__ __forceinline__ unsigned cvt_pk_bf16(float lo, float hi) { unsigned r; asm volatile("v_cvt_pk_bf16_f32 %0, %1, %2" : "=v"(r) : "v"(lo), "v"(hi)); return r; }
typedef unsigned u32x2 __attribute__((ext_vector_type(2)));

struct EpiBf16 {
    static constexpr bool PERM = true, AFTER_DRAIN = false;
    bf16_t* O; int ldc;
    __device__ __forceinline__ void operator()(const f32x4 (&acc)[2][2][4][2], const Unit& u, int wr, int wc, int fr, int fq) const {
        const int row0 = u.pm * BM + wr * 64 + fr; const int col0 = u.pn * BM + wc * 32 + 8 * fq;
#pragma unroll
        for (int ai = 0; ai < 2; ++ai)
#pragma unroll
            for (int m = 0; m < 4; ++m) { bf16_t* rowp = O + (size_t)(row0 + ai * HALF + m * 16) * ldc + col0;
#pragma unroll
                for (int bj = 0; bj < 2; ++bj) { const f32x4 v0 = acc[ai][bj][m][0], v1 = acc[ai][bj][m][1];
                    u32x4 w; w.x = cvt_pk_bf16(v0[0], v0[1]); w.y = cvt_pk_bf16(v0[2], v0[3]); w.z = cvt_pk_bf16(v1[0], v1[1]); w.w = cvt_pk_bf16(v1[2], v1[3]);
                    *(u32x4*)(rowp + bj * HALF) = w; } }
    }
};
struct EpiResNorm {
    static constexpr bool PERM = false, AFTER_DRAIN = false, KSCALE = true;
    float* C; const float* base; int ldc; const float* ssq; PG8_LAS float* tabl; float eps;
    __device__ __forceinline__ void build(const Unit& u, int tid) const {
        const int row = tid & 255, part = tid >> 8; const size_t t = (size_t)u.pm * BM + row; float rs[7];
        if (part == 0) { const f32x4* p = (const f32x4*)(ssq + t * 32);
#pragma unroll
            for (int g = 0; g < 4; ++g) { const f32x4 a = p[2 * g], b = p[2 * g + 1]; rs[g] = 1.0f / sqrtf(((a.x + a.y) + (a.z + a.w) + (b.x + b.y) + (b.z + b.w)) * (1.0f / 512.0f) + eps); }
            const f32x4* q = (const f32x4*)(ssq + (size_t)16384 * 32 + t * 32);
#pragma unroll
            for (int h = 0; h < 3; ++h) { const f32x4 a = q[h]; rs[4 + h] = 1.0f / sqrtf(((a.x + a.y) + (a.z + a.w)) * (1.0f / 256.0f) + eps); }
        } else { const f32x4* q = (const f32x4*)(ssq + (size_t)16384 * 32 + t * 32);
#pragma unroll
            for (int h = 0; h < 6; ++h) { const f32x4 a = q[2 + h]; rs[h] = 1.0f / sqrtf(((a.x + a.y) + (a.z + a.w)) * (1.0f / 256.0f) + eps); }
            rs[6] = 1.0f; }
        PG8_LAS float* d = tabl + row * 12 + 6 * part;
#pragma unroll
        for (int s = 0; s < 6; ++s) d[s] = (part == 1 && s == 5) ? rs[5] : rs[s] / rs[s + 1];
    }
    __device__ __forceinline__ void kscale(f32x4 (&acc)[2][2][4][2], int t, int nt, int wr, int fr) const {
        const int kt = t + 1; const bool segend = kt < 32 ? ((kt & 7) == 7) : ((kt & 3) == 3);
        if (segend && kt != nt - 1) { const int sg = kt < 32 ? (kt >> 3) : 4 + ((kt - 32) >> 2);
#pragma unroll
            for (int ai = 0; ai < 2; ++ai)
#pragma unroll
                for (int m = 0; m < 4; ++m) { const float r = tabl[(ai * HALF + wr * 64 + m * 16 + fr) * 12 + sg];
#pragma unroll
                    for (int bj = 0; bj < 2; ++bj)
#pragma unroll
                        for (int n = 0; n < 2; ++n) acc[ai][bj][m][n] = acc[ai][bj][m][n] * r; } }
    }
    __device__ __forceinline__ void operator()(const f32x4 (&acc)[2][2][4][2], const Unit& u, int wr, int wc, int fr, int fq) const {
        const int row0 = u.pm * BM + wr * 64 + fr, col0 = u.pn * BM + wc * 32 + 4 * fq;
#pragma unroll
        for (int ai = 0; ai < 2; ++ai)
#pragma unroll
            for (int m = 0; m < 4; ++m) { const size_t off = (size_t)(row0 + ai * HALF + m * 16) * ldc + col0; const float r = tabl[(ai * HALF + wr * 64 + m * 16 + fr) * 12 + 11];
#pragma unroll
                for (int bj = 0; bj < 2; ++bj)
#pragma unroll
                    for (int n = 0; n < 2; ++n) *(f32x4*)(C + off + bj * HALF + n * 16) = acc[ai][bj][m][n] * r + *(const f32x4*)(base + off + bj * HALF + n * 16); }
    }
};
struct EpiResF32 {
    static constexpr bool PERM = false, AFTER_DRAIN = false;
    float* C; const float* base; int ldc;
    __device__ __forceinline__ void operator()(const f32x4 (&acc)[2][2][4][2], const Unit& u, int wr, int wc, int fr, int fq) const {
        const int row0 = u.pm * BM + wr * 64 + fr, col0 = u.pn * BM + wc * 32 + 4 * fq;
#pragma unroll
        for (int ai = 0; ai < 2; ++ai)
#pragma unroll
            for (int m = 0; m < 4; ++m) { const size_t off = (size_t)(row0 + ai * HALF + m * 16) * ldc + col0;
#pragma unroll
                for (int bj = 0; bj < 2; ++bj)
#pragma unroll
                    for (int n = 0; n < 2; ++n) *(f32x4*)(C + off + bj * HALF + n * 16) = acc[ai][bj][m][n] + *(const f32x4*)(base + off + bj * HALF + n * 16); }
    }
};
__device__ __forceinline__ float swiglu1(float a, float b) {
    const float glu = fminf(a, 7.0f), lin = fminf(fmaxf(b, -7.0f), 7.0f);
    return glu * __builtin_amdgcn_rcpf(1.0f + __expf(-1.702f * glu)) * (lin + 1.0f);
}
struct EpiSwiglu {
    static constexpr bool PERM = true, AFTER_DRAIN = false, PREFETCH = true;
    unsigned char* O; const float* bias; PG8_LAS float* slot;
    __device__ __forceinline__ void prefetch(const Unit& u, int wid, int lane) const {
        if (wid == 0) { const int e = u.pn >> 4, pnl = u.pn & 15;
            __builtin_amdgcn_global_load_lds((const unsigned*)(bias + (size_t)e * 4096 + pnl * BM + 4 * lane), (PG8_LAS unsigned*)(slot + u.par * 256), 16, 0, 0); }
    }
    __device__ __forceinline__ void operator()(const f32x4 (&acc)[2][2][4][2], const Unit& u, int wr, int wc, int fr, int fq) const {
        const int pnl = u.pn & 15;
        const int row0 = u.pm * BM + wr * 64 + fr; const int hcol0 = pnl * BM + wc * 32 + 8 * fq;
        const PG8_LAS float* bp = slot + u.par * 256 + wc * 32 + 8 * fq;
        f32x4 bv[2][2];
#pragma unroll
        for (int bj = 0; bj < 2; ++bj)
#pragma unroll
            for (int n = 0; n < 2; ++n) bv[bj][n] = *(const PG8_LAS f32x4*)(bp + bj * HALF + 4 * n);
#pragma unroll
        for (int ai = 0; ai < 2; ++ai)
#pragma unroll
            for (int m = 0; m < 4; ++m) { unsigned char* rowp = O + (size_t)(row0 + ai * HALF + m * 16) * 2048 + (hcol0 >> 1);
#pragma unroll
                for (int bj = 0; bj < 2; ++bj) { const f32x4 v0 = acc[ai][bj][m][0] + bv[bj][0], v1 = acc[ai][bj][m][1] + bv[bj][1];
                    int w = __builtin_amdgcn_cvt_pk_fp8_f32(swiglu1(v0[0], v0[1]), swiglu1(v0[2], v0[3]), 0, false);
                    w = __builtin_amdgcn_cvt_pk_fp8_f32(swiglu1(v1[0], v1[1]), swiglu1(v1[2], v1[3]), w, true);
                    *(int*)(rowp + bj * 64) = w; } }
    }
};
struct EpiDown {
    static constexpr bool PERM = true, AFTER_DRAIN = false, PREFETCH = true;
    bf16_t* O; const float* bias; const float* gatel; const PG8_LAS int* tinfo; PG8_LAS float* slot;
    __device__ __forceinline__ void prefetch(const Unit& u, int wid, int lane) const {
        const int e = u.pn >> 3, pnl = u.pn & 7;
        if (wid == 0) __builtin_amdgcn_global_load_lds((const unsigned*)(bias + (size_t)e * 2048 + pnl * BM + 4 * lane), (PG8_LAS unsigned*)(slot + u.par * 512), 16, 0, 0);
        if (wid == 1) __builtin_amdgcn_global_load_lds((const unsigned*)(gatel + (size_t)e * 16384 + (size_t)(u.pm - tinfo[40 + e]) * BM + 4 * lane), (PG8_LAS unsigned*)(slot + u.par * 512 + 256), 16, 0, 0);
    }
    __device__ __forceinline__ void operator()(const f32x4 (&acc)[2][2][4][2], const Unit& u, int wr, int wc, int fr, int fq) const {
        const int pnl = u.pn & 7;
        const int row0 = u.pm * BM + wr * 64 + fr; const int col0 = pnl * BM + wc * 32 + 8 * fq;
        const PG8_LAS float* bp = slot + u.par * 512 + wc * 32 + 8 * fq; const PG8_LAS float* gp = slot + u.par * 512 + 256 + wr * 64 + fr;
        f32x4 bv[2][2];
#pragma unroll
        for (int bj = 0; bj < 2; ++bj)
#pragma unroll
            for (int n = 0; n < 2; ++n) bv[bj][n] = *(const PG8_LAS f32x4*)(bp + bj * HALF + 4 * n);
#pragma unroll
        for (int ai = 0; ai < 2; ++ai)
#pragma unroll
            for (int m = 0; m < 4; ++m) { const int row = row0 + ai * HALF + m * 16; const float gt = gp[ai * HALF + m * 16] * 16.0f; unsigned char* rowp = (unsigned char*)O + (size_t)row * 2048 + col0;
#pragma unroll
                for (int bj = 0; bj < 2; ++bj) { const f32x4 v0 = (acc[ai][bj][m][0] + bv[bj][0]) * gt, v1 = (acc[ai][bj][m][1] + bv[bj][1]) * gt;
                    int w0 = __builtin_amdgcn_cvt_pk_fp8_f32(v0[0], v0[1], 0, false); w0 = __builtin_amdgcn_cvt_pk_fp8_f32(v0[2], v0[3], w0, true);
                    int w1 = __builtin_amdgcn_cvt_pk_fp8_f32(v1[0], v1[1], 0, false); w1 = __builtin_amdgcn_cvt_pk_fp8_f32(v1[2], v1[3], w1, true);
                    *(u32x2*)(rowp + bj * HALF) = (u32x2){(unsigned)w0, (unsigned)w1}; } }
    }
};
struct MoeOrder {
    int nM, nN, nsh, nwg, G, c; const PG8_LAS unsigned char* tab; const PG8_LAS unsigned short* rt;
    __device__ __forceinline__ const PG8_LAS unsigned short* rowp(int ui) const { return rt + ui * 256; }
    __device__ __forceinline__ bool next(int i, Unit& u) const {
        const long L = (long)i * G + c; if (L >= nwg) return false;
        int wgid = (int)L; { const int q = nwg / NXCD, r = nwg % NXCD, xcd = wgid % NXCD, off = wgid / NXCD; wgid = (xcd < r ? xcd * (q + 1) : r * (q + 1) + (xcd - r) * q) + off; }
        const int nig = WGM * nN, gid = wgid / nig, fm = gid * WGM, gsz = (nM - fm) < WGM ? (nM - fm) : WGM;
        const int pm = fm + ((wgid % nig) % gsz), pnl = (wgid % nig) / gsz;
        u.pm = pm; u.pn = ((int)tab[pm] << nsh) + pnl; return true;
    }
    __device__ __forceinline__ void a_ready(const Unit&) const {}
    __device__ __forceinline__ void done(const Unit&) const {}
};
template <class E, class = void> struct epi_pref { static constexpr bool value = false; };
template <class E> struct epi_pref<E, decltype((void)E::PREFETCH)> { static constexpr bool value = E::PREFETCH; };
template <class E, class = void> struct epi_kscale { static constexpr bool value = false; };
template <class E> struct epi_kscale<E, decltype((void)E::KSCALE)> { static constexpr bool value = E::KSCALE; };
typedef int v8i32 __attribute__((ext_vector_type(8)));
__device__ __forceinline__ v8i32 pg8_cat(const bf16x8 lo, const bf16x8 hi) { typedef int v4i32 __attribute__((ext_vector_type(4))); const v4i32 a = __builtin_bit_cast(v4i32, lo), b = __builtin_bit_cast(v4i32, hi); return __builtin_shufflevector(a, b, 0, 1, 2, 3, 4, 5, 6, 7); }
template <class Epi, class Sched, bool ALIGN_EPI = false, bool SP2 = false, bool F8 = false, bool GA = false>
__device__ __forceinline__ void gemm_phase(PG8_LAS unsigned char* lds, const Gemm g, const Sched& S, const Epi& E) {
    const int tid = threadIdx.x, wid = __builtin_amdgcn_readfirstlane(tid >> 6), lane = tid & 63, wr = wid >> 2, wc = wid & 3, fr = lane & 15, fq = lane >> 4;
    const int K = g.K, KB = F8 ? K : 2 * K, nt = KB / 128;
    unsigned voffA[2], voffB[2]; int gaR[2]; unsigned gaC[2]; static_assert(!GA || SP2, "gathered A needs the SP2 loop");
#pragma unroll
    for (int i = 0; i < 2; ++i) { int R, C; stage_rc(tid * 16 + i * 8192, R, C); const int Rb = Epi::PERM ? ((R & ~31) + perm32(R & 31)) : R;
        voffA[i] = (unsigned)(R * KB + C * 2); voffB[i] = (unsigned)(Rb * KB + C * 2); gaR[i] = R; gaC[i] = (unsigned)(C * 2); }
    const size_t kstep = (size_t)(BK * 2);
    const size_t hstep = (size_t)HALF * KB;
    const size_t tstep = 2 * hstep;
    const unsigned ldsw = (unsigned)wid * 1024u;
    int aoffk[2], boffk[2];
#pragma unroll
    for (int h = 0; h < 2; ++h) { aoffk[h] = lds_byte(wr * 64 + fr, fq * 8) + h * 1024; boffk[h] = lds_byte(wc * 32 + fr, fq * 8) + h * 1024; }
#define PG8_SA(b, h) (((b) * 2 + (h)) * HTB)
#define PG8_SB(b, h) ((4 + (b) * 2 + (h)) * HTB)
#define PG8_STAGE(bufoff, gbase, voff) do { _Pragma("unroll") for (int _i = 0; _i < 2; ++_i) \
        __builtin_amdgcn_global_load_lds((const unsigned*)((const char*)(gbase) + (voff)[_i]), (PG8_LAS unsigned*)(lds + (bufoff) + ldsw + _i * 8192), 16, 0, 0); } while (0)
#define PG8_STAGE_A(bufoff, kptr, h, usenext) do { if constexpr (GA) { _Pragma("unroll") for (int _i = 0; _i < 2; ++_i) { const unsigned _o = (usenext) ? gn[h][_i] : gc[h][_i]; \
            __builtin_amdgcn_global_load_lds((const unsigned*)((const char*)(kptr) + _o), (PG8_LAS unsigned*)(lds + (bufoff) + ldsw + _i * 8192), 16, 0, 0); } } \
        else { PG8_STAGE(bufoff, (kptr) + (h) * hstep, voffA); } } while (0)
#define PG8_GROWS(dst, ui_) do { const PG8_LAS unsigned short* _rt = S.rowp(ui_); _Pragma("unroll") for (int _h = 0; _h < 2; ++_h) _Pragma("unroll") for (int _i = 0; _i < 2; ++_i) dst[_h][_i] = (unsigned)_rt[gaR[_i] + 128 * _h] * (unsigned)KB + gaC[_i]; } while (0)
#define PG8_LDA(dst, b, h) do { if constexpr (F8) { _Pragma("unroll") for (int m = 0; m < 4; ++m) dst##8[m] = pg8_cat(*(const PG8_LAS bf16x8*)(lds + PG8_SA(b, h) + aoffk[0] + m * 2048), *(const PG8_LAS bf16x8*)(lds + PG8_SA(b, h) + aoffk[1] + m * 2048)); } \
        else { _Pragma("unroll") for (int m = 0; m < 4; ++m) _Pragma("unroll") for (int k = 0; k < 2; ++k) dst[m][k] = *(const PG8_LAS bf16x8*)(lds + PG8_SA(b, h) + aoffk[k] + m * 2048); } } while (0)
#define PG8_LDB(dst, b, h) do { if constexpr (F8) { _Pragma("unroll") for (int n = 0; n < 2; ++n) dst##8[n] = pg8_cat(*(const PG8_LAS bf16x8*)(lds + PG8_SB(b, h) + boffk[0] + n * 2048), *(const PG8_LAS bf16x8*)(lds + PG8_SB(b, h) + boffk[1] + n * 2048)); } \
        else { _Pragma("unroll") for (int n = 0; n < 2; ++n) _Pragma("unroll") for (int k = 0; k < 2; ++k) dst[n][k] = *(const PG8_LAS bf16x8*)(lds + PG8_SB(b, h) + boffk[k] + n * 2048); } } while (0)
#define PG8_MMA(ai, bj, At, Bt) do { __builtin_amdgcn_s_setprio(1); \
        if constexpr (F8) { _Pragma("unroll") for (int m = 0; m < 4; ++m) _Pragma("unroll") for (int n = 0; n < 2; ++n) \
            asm volatile("v_mfma_scale_f32_16x16x128_f8f6f4 %0, %1, %2, %0, %3, %4 op_sel_hi:[0,0,0]" : "+v"(acc[ai][bj][m][n]) : "v"(Bt##8[n]), "v"(At##8[m]), "v"(sc_w), "v"(sc_a)); } \
        else { _Pragma("unroll") for (int m = 0; m < 4; ++m) _Pragma("unroll") for (int n = 0; n < 2; ++n) _Pragma("unroll") for (int k = 0; k < 2; ++k) \
            acc[ai][bj][m][n] = __builtin_amdgcn_mfma_f32_16x16x32_bf16(Bt[n][k], At[m][k], acc[ai][bj][m][n], 0, 0, 0); } \
        __builtin_amdgcn_s_setprio(0); } while (0)
#define PG8_WAIT_V(n) asm volatile("s_waitcnt vmcnt(" #n ")" ::: "memory")
#define PG8_WAIT_L(n) asm volatile("s_waitcnt lgkmcnt(" #n ")" ::: "memory")
#define PG8_BAR __builtin_amdgcn_s_barrier()
#define PG8_SCHED __builtin_amdgcn_sched_barrier(0)
    Unit cur, nxt; int ui = 0;
    if (!S.next(0, cur)) return;
    cur.par = 0;
    f32x4 acc[2][2][4][2];
#pragma unroll
    for (int a = 0; a < 2; ++a)
#pragma unroll
        for (int b = 0; b < 2; ++b)
#pragma unroll
            for (int m = 0; m < 4; ++m)
#pragma unroll
                for (int n = 0; n < 2; ++n) acc[a][b][m][n] = (f32x4){0.f, 0.f, 0.f, 0.f};
    const int sc_w = 0x79797979, sc_a = 0x7f7f7f7f;
    bf16x8 At[4][2], B0[2][2], B1[2][2]; v8i32 At8[4], B08[2], B18[2];
    const char* cA = (const char*)g.A + (GA ? (size_t)0 : (size_t)cur.pm * tstep); const char* cB = (const char*)g.Bt + (size_t)cur.pn * tstep;
    unsigned gc[2][2] = {{0u, 0u}, {0u, 0u}}, gn[2][2] = {{0u, 0u}, {0u, 0u}};
    if constexpr (GA) { PG8_GROWS(gc, 0); }
    if constexpr (epi_kscale<Epi>::value) { E.build(cur, tid); asm volatile("s_waitcnt lgkmcnt(0)" ::: "memory"); PG8_BAR; asm volatile("" ::: "memory"); }
    S.a_ready(cur);
    if constexpr (SP2) {
        PG8_STAGE(PG8_SB(0, 0), cB, voffB); PG8_STAGE(PG8_SB(0, 1), cB + hstep, voffB); PG8_STAGE_A(PG8_SA(0, 0), cA, 0, false); PG8_STAGE_A(PG8_SA(0, 1), cA, 1, false);
        if (wr == 1) PG8_BAR;
        PG8_WAIT_V(2); PG8_BAR;
        PG8_STAGE(PG8_SB(1, 0), cB + kstep, voffB); PG8_STAGE_A(PG8_SA(1, 0), cA + kstep, 0, false); PG8_STAGE(PG8_SB(1, 1), cB + hstep + kstep, voffB);
        PG8_WAIT_V(6); PG8_BAR;
    } else {
        PG8_STAGE(PG8_SB(0, 0), cB, voffB); PG8_STAGE(PG8_SA(0, 0), cA, voffA); PG8_STAGE(PG8_SB(0, 1), cB + hstep, voffB); PG8_STAGE(PG8_SA(0, 1), cA + hstep, voffA);
        if (wr == 1) PG8_BAR;
        PG8_WAIT_V(4); PG8_BAR;
        PG8_STAGE(PG8_SB(1, 0), cB + kstep, voffB); PG8_STAGE(PG8_SA(1, 0), cA + kstep, voffA); PG8_STAGE(PG8_SB(1, 1), cB + hstep + kstep, voffB);
        PG8_WAIT_V(6); PG8_BAR;
    }
    for (;;) {
        const bool has_next = S.next(ui + 1, nxt); nxt.par = (ui + 1) & 1;
        const char* nA = (has_next && !GA) ? (const char*)g.A + (size_t)nxt.pm * tstep : cA; const char* nB = has_next ? (const char*)g.Bt + (size_t)nxt.pn * tstep : cB;
        if constexpr (GA) { if (has_next) { PG8_GROWS(gn, ui + 1); } else {
#pragma unroll
            for (int _h = 0; _h < 2; ++_h) { gn[_h][0] = gc[_h][0]; gn[_h][1] = gc[_h][1]; } } }
        for (int t = 0; t < nt; t += 2) {
            const bool last = (t == nt - 2);
            const char* a1 = cA + (size_t)(t + 1) * kstep;
            const char* a2 = last ? nA : cA + (size_t)(t + 2) * kstep; const char* b2 = last ? nB : cB + (size_t)(t + 2) * kstep;
            const char* a3 = a2 + kstep; const char* b3 = b2 + kstep;
            if (last && has_next) S.a_ready(nxt);
            if constexpr (epi_pref<Epi>::value) { if (t == 0) E.prefetch(cur, wid, lane); }
            if constexpr (SP2) {
            PG8_LDB(B0, 0, 0); PG8_LDB(B1, 0, 1); PG8_SCHED; PG8_LDA(At, 0, 0); PG8_STAGE_A(PG8_SA(1, 1), a1, 1, false);
            PG8_WAIT_V(8); PG8_WAIT_L(0); PG8_BAR; PG8_MMA(0, 0, At, B0); PG8_MMA(0, 1, At, B1); PG8_BAR; PG8_SCHED;
            PG8_LDA(At, 0, 1); PG8_STAGE(PG8_SB(0, 0), b2, voffB); PG8_STAGE(PG8_SB(0, 1), b2 + hstep, voffB); PG8_STAGE_A(PG8_SA(0, 0), a2, 0, last);
            PG8_WAIT_V(8); PG8_WAIT_L(0); PG8_BAR; PG8_MMA(1, 0, At, B0); PG8_MMA(1, 1, At, B1); PG8_BAR; PG8_SCHED;
            PG8_LDB(B0, 1, 0); PG8_LDB(B1, 1, 1); PG8_SCHED; PG8_LDA(At, 1, 0); PG8_STAGE_A(PG8_SA(0, 1), a2, 1, last);
            PG8_WAIT_V(8); PG8_WAIT_L(0); PG8_BAR; PG8_MMA(0, 0, At, B0); PG8_MMA(0, 1, At, B1); PG8_BAR; PG8_SCHED;
            PG8_LDA(At, 1, 1); PG8_STAGE(PG8_SB(1, 0), b3, voffB); PG8_STAGE(PG8_SB(1, 1), b3 + hstep, voffB); PG8_STAGE_A(PG8_SA(1, 0), a3, 0, last);
            PG8_WAIT_V(8); PG8_WAIT_L(0); PG8_BAR; PG8_MMA(1, 0, At, B0); PG8_MMA(1, 1, At, B1); PG8_BAR; PG8_SCHED;
            if constexpr (epi_kscale<Epi>::value) { E.kscale(acc, t, nt, wr, fr); PG8_SCHED; }
            } else {
            PG8_LDB(B0, 0, 0); PG8_SCHED; PG8_LDA(At, 0, 0); PG8_STAGE(PG8_SA(1, 1), a1 + hstep, voffA);
            PG8_WAIT_L(8); PG8_BAR; PG8_WAIT_L(0); PG8_MMA(0, 0, At, B0); PG8_BAR; PG8_SCHED;
            PG8_LDB(B1, 0, 1); PG8_STAGE(PG8_SB(0, 0), b2, voffB);
            PG8_BAR; PG8_WAIT_L(0); PG8_MMA(0, 1, At, B1); PG8_BAR;
            PG8_LDA(At, 0, 1); PG8_STAGE(PG8_SA(0, 0), a2, voffA);
            PG8_BAR; PG8_WAIT_L(0); PG8_MMA(1, 0, At, B0); PG8_BAR; PG8_SCHED;
            PG8_STAGE(PG8_SB(0, 1), b2 + hstep, voffB);
            PG8_WAIT_V(6); PG8_BAR; PG8_MMA(1, 1, At, B1); PG8_BAR;
            PG8_LDB(B0, 1, 0); PG8_SCHED; PG8_LDA(At, 1, 0); PG8_STAGE(PG8_SA(0, 1), a2 + hstep, voffA);
            PG8_WAIT_L(8); PG8_BAR; PG8_WAIT_L(0); PG8_MMA(0, 0, At, B0); PG8_BAR; PG8_SCHED;
            PG8_LDB(B1, 1, 1); PG8_STAGE(PG8_SB(1, 0), b3, voffB);
            PG8_BAR; PG8_WAIT_L(0); PG8_MMA(0, 1, At, B1); PG8_BAR;
            PG8_LDA(At, 1, 1); PG8_STAGE(PG8_SA(1, 0), a3, voffA);
            PG8_BAR; PG8_WAIT_L(0); PG8_MMA(1, 0, At, B0); PG8_BAR; PG8_SCHED;
            PG8_STAGE(PG8_SB(1, 1), b3 + hstep, voffB);
            PG8_WAIT_V(6); PG8_BAR; PG8_MMA(1, 1, At, B1); PG8_BAR;
            }
        }
        if constexpr (ALIGN_EPI) { if (wr == 0) PG8_BAR; }
        if constexpr (F8) asm volatile("s_nop 15\n\ts_nop 15" ::: "memory");
        if constexpr (!Epi::AFTER_DRAIN) { E(acc, cur, wr, wc, fr, fq); S.done(cur); }
        if (!has_next) break;
#pragma unroll
        for (int a = 0; a < 2; ++a)
#pragma unroll
            for (int b = 0; b < 2; ++b)
#pragma unroll
                for (int m = 0; m < 4; ++m)
#pragma unroll
                    for (int n = 0; n < 2; ++n) acc[a][b][m][n] = (f32x4){0.f, 0.f, 0.f, 0.f};
        if constexpr (epi_kscale<Epi>::value) { static_assert(!epi_kscale<Epi>::value || (ALIGN_EPI && SP2), "K-segment rescale needs aligned epilogues");
            asm volatile("s_waitcnt lgkmcnt(0)" ::: "memory"); PG8_BAR; asm volatile("" ::: "memory");
            E.build(nxt, tid); asm volatile("s_waitcnt lgkmcnt(0)" ::: "memory"); PG8_BAR; asm volatile("" ::: "memory"); }
        cur = nxt; cA = nA; cB = nB; ++ui;
        if constexpr (GA) {
#pragma unroll
            for (int _h = 0; _h < 2; ++_h) { gc[_h][0] = gn[_h][0]; gc[_h][1] = gn[_h][1]; } }
        if constexpr (ALIGN_EPI) { if (wr == 1) PG8_BAR; }
    }
    PG8_WAIT_V(0);
    if constexpr (!ALIGN_EPI) { if (wr == 0) PG8_BAR; }
    PG8_BAR;
    if constexpr (Epi::AFTER_DRAIN) { E.fused(acc, cur, wr, wc, fr, fq, lds, wid, lane); S.done(cur); }
#undef PG8_SA
#undef PG8_SB
#undef PG8_STAGE
#undef PG8_STAGE_A
#undef PG8_GROWS
#undef PG8_LDA
#undef PG8_LDB
#undef PG8_MMA
#undef PG8_WAIT_V
#undef PG8_WAIT_L
#undef PG8_BAR
#undef PG8_SCHED
}
}

constexpr int NWAVES = 8;
constexpr int TT = 16384, DM = 2048, SEQ = 2048;
constexpr int NPROJ = 11264;
constexpr int PC_Z = 0, PC_XBC = 2048, PC_Q = 5120, PC_K = 6144, PC_V = 7168, PC_O = 9216;
constexpr int WIN_LD = 11312;
constexpr int NSLOT = 65536 + 32 * 256;
constexpr float EPSF = 1e-5f;
#ifndef HSYNC_ON
#define HSYNC_ON 0
#endif
#define HWAIT() do { if (HSYNC_ON) asm volatile("s_waitcnt vmcnt(0) lgkmcnt(0)\n\ts_nop 15\n\ts_nop 15" ::: "memory"); } while (0)
#define HSYNC() do { if (HSYNC_ON) { HWAIT(); __syncthreads(); } } while (0)
#ifndef MK_PER_PHASE
#define MK_PER_PHASE 0
#endif
constexpr int N_PHASES = 9;

constexpr size_t MiB = 1u << 20;
constexpr size_t WS_CTL = 0, CTL_ZERO_BYTES = 1 * MiB;
constexpr size_t WS_WIN = 2 * MiB, WS_WSM = 46 * MiB, WS_WRT = 47 * MiB, WS_WOUT = 48 * MiB, WS_WGU = 64 * MiB, WS_WD = 576 * MiB;
constexpr size_t WS_XN1 = 832 * MiB, WS_PROJ = 896 * MiB, WS_SMALL = 1248 * MiB, WS_SSQ = 1252 * MiB, WS_YMIX = 1256 * MiB, WS_H2 = 1384 * MiB, WS_XN2 = 1512 * MiB;
constexpr size_t WS_ROUTE = 1576 * MiB, WS_XG = 1578 * MiB, WS_ACT = 1866 * MiB, WS_YR = 2154 * MiB, WS_XC = 2442 * MiB, WS_END = 2538 * MiB;
constexpr int CW_BAR = 4096;
constexpr int CW_CNT = 65536;

constexpr int RING_BYTES = 131072;
constexpr int LDS_BYTES = 147456;
constexpr int LDSCTL_OFF = LDS_BYTES - 1024, MISC_OFF = LDSCTL_OFF;
constexpr int TAB_OFF = LDSCTL_OFF + 64;
constexpr int EPIV_OFF = RING_BYTES + 9216;
constexpr int ROWTAB_OFF = RING_BYTES;

#define GAS __attribute__((address_space(1)))
#define LAS __attribute__((address_space(3)))
typedef unsigned short bf16;
typedef unsigned v4u __attribute__((ext_vector_type(4)));
typedef unsigned v2u __attribute__((ext_vector_type(2)));
typedef float f32x4 __attribute__((ext_vector_type(4)));
typedef float f32x2 __attribute__((ext_vector_type(2)));
typedef short bf16x8 __attribute__((ext_vector_type(8)));
typedef GAS unsigned gu32;
#define RLX_AGENT __ATOMIC_RELAXED, __HIP_MEMORY_SCOPE_AGENT
#define LDS_WAIT() asm volatile("s_waitcnt lgkmcnt(0)" ::: "memory")
#define VM_WAIT() asm volatile("s_waitcnt vmcnt(0)" ::: "memory")
__device__ __forceinline__ unsigned f2bf(float f) { unsigned u = __builtin_bit_cast(unsigned, f); return (u + 0x7fffu + ((u >> 16) & 1u)) >> 16; }
__device__ __forceinline__ unsigned pk2(float lo, float hi) { return f2bf(lo) | (f2bf(hi) << 16); }
__device__ __forceinline__ float bflo(unsigned w) { return __builtin_bit_cast(float, w << 16); }
__device__ __forceinline__ float bfhi(unsigned w) { return __builtin_bit_cast(float, w & 0xffff0000u); }
__device__ __forceinline__ float wave_sum(float v) {
#pragma unroll
    for (int o = 1; o < 64; o <<= 1) v += __shfl_xor(v, o);
    return v;
}
__device__ __forceinline__ float softplusf(float x) { return x > 20.f ? x : log1pf(expf(x)); }
__device__ __forceinline__ float logsigf(float x) { return fminf(x, 0.f) - log1pf(expf(-fabsf(x))); }
__device__ __forceinline__ float siluf(float v) { return v * __builtin_amdgcn_rcpf(1.0f + __expf(-v)); }

#define XB_TMO      128
#define XB_XCNT(j)  (256  + 64 * (j))
#define XB_XSUB(j)  (1280 + 64 * (j))
#define XB_XGEN(j)  (2304 + 64 * (j))
#define XB_TOP      3328
#define XB_TOPGEN   3392
#define XCD_BAR_WORDS 3456
#define XB_SPIN_CAP (1u << 18)

__device__ __forceinline__ unsigned xb_ld(unsigned* p)              { return __hip_atomic_load(p, __ATOMIC_RELAXED, __HIP_MEMORY_SCOPE_AGENT); }
__device__ __forceinline__ unsigned xb_add(unsigned* p, unsigned v) { return __hip_atomic_fetch_add(p, v, __ATOMIC_RELAXED, __HIP_MEMORY_SCOPE_AGENT); }
__device__ __forceinline__ unsigned xb_xcc_id() { return (unsigned)__builtin_amdgcn_s_getreg((3 << 11) | 20) & 0xFu; }
#define XB_SPIN(cond, bar) do { unsigned _sp = 0; while (cond) { __builtin_amdgcn_s_sleep(1); \
    if ((++_sp & 255u) == 0u) { if (xb_ld(&(bar)[XB_TMO])) break; if (_sp > XB_SPIN_CAP) { atomicAdd(&(bar)[XB_TMO], 1u); break; } } } } while (0)

struct XcdBarrier {
    unsigned* bar; unsigned x;
    volatile LAS unsigned* st;
};

__device__ __forceinline__ XcdBarrier xcd_barrier_post(unsigned* bar, volatile LAS unsigned* st) {
    XcdBarrier b; b.bar = bar; b.x = xb_xcc_id(); b.st = st;
    if (threadIdx.x == 0) (void)xb_add(&bar[XB_XCNT(b.x)], 1u);
    return b;
}
__device__ __forceinline__ void xcd_barrier_complete(unsigned* bar, unsigned x, unsigned& nloc, unsigned& nx) {
    const unsigned G = gridDim.x * gridDim.y * gridDim.z;
    unsigned sum, cnt, mine, sp = 0u;
    for (;;) {
        sum = 0u; cnt = 0u; mine = 0u;
#pragma unroll
        for (unsigned j = 0; j < 16; ++j) { const unsigned c = xb_ld(&bar[XB_XCNT(j)]); sum += c; cnt += (c > 0u) ? 1u : 0u; mine = (j == x) ? c : mine; }
        if (sum == G) break;
        __builtin_amdgcn_s_sleep(1);
        if ((++sp & 255u) == 0u) { if (xb_ld(&bar[XB_TMO])) break; if (sp > XB_SPIN_CAP) { atomicAdd(&bar[XB_TMO], 1u); break; } }
    }
    nloc = mine > 0u ? mine : 1u; nx = cnt > 0u ? cnt : 1u;
}

__device__ __forceinline__ void xcd_barrier(const XcdBarrier& b) {
    asm volatile("s_waitcnt vmcnt(0)" ::: "memory");
    __syncthreads();
    if (threadIdx.x == 0) {
        unsigned* bar = b.bar;
        __builtin_amdgcn_s_waitcnt(0);
        unsigned nloc = b.st[0], nx = b.st[1];
        if (nloc == 0u) { xcd_barrier_complete(bar, b.x, nloc, nx); b.st[0] = nloc; b.st[1] = nx; }
        const unsigned old = xb_add(&bar[XB_XSUB(b.x)], 1u);
        const unsigned gen = old / nloc;
        if (old + 1u == (gen + 1u) * nloc) {
            __builtin_amdgcn_fence(__ATOMIC_RELEASE, "agent");
            asm volatile("s_waitcnt vmcnt(0)" ::: "memory");
            const unsigned og = xb_add(&bar[XB_TOP], 1u);
            const unsigned tg = og / nx;
            if (og + 1u == (tg + 1u) * nx) xb_add(&bar[XB_TOPGEN], 1u);
            else XB_SPIN(xb_ld(&bar[XB_TOPGEN]) == tg, bar);
            __builtin_amdgcn_fence(__ATOMIC_ACQUIRE, "agent");
            xb_add(&bar[XB_XGEN(b.x)], 1u);
            asm volatile("s_waitcnt vmcnt(0)" ::: "memory");
        } else {
            XB_SPIN(xb_ld(&bar[XB_XGEN(b.x)]) == gen, bar);
            __builtin_amdgcn_fence(__ATOMIC_ACQUIRE, "agent");
            asm volatile("s_waitcnt vmcnt(0)" ::: "memory");
        }
    }
    __syncthreads();
}

struct Frame {
    LAS unsigned char* lds;
    volatile LAS unsigned* MISC;
    gu32* ctl;
    int tid, lane, wave, G, bid;
    const float *x, *norm1_w, *w_in, *conv_w, *conv_b, *dt_bias, *a_log, *d_skip, *ssd_norm_w, *i_bias, *f_bias, *ml_norm_w, *w_out, *norm2_w, *router_w, *router_b, *w_gate_up, *b_gate_up, *w_down, *b_down, *final_norm_w;
    float* out; unsigned char* ws;
};

__device__ __forceinline__ void p0_transpose_item(const float* W, int ldw, int K, bf16* WT, int dst_row0, int src_col0, int k0, LAS float* scr, int lane) {
#pragma unroll 8
    for (int i = 0; i < 32; ++i) { const int kk = 2 * i + (lane >> 5); scr[kk * 33 + (lane & 31)] = W[(size_t)(k0 + kk) * ldw + src_col0 + (lane & 31)]; }
    LDS_WAIT(); asm volatile("" ::: "memory");
    const int c = lane & 7;
#pragma unroll
    for (int j = 0; j < 4; ++j) { const int n = (lane >> 3) + 8 * j; const LAS float* s = scr + (8 * c) * 33 + n;
        v4u o; o.x = pk2(s[0 * 33], s[1 * 33]); o.y = pk2(s[2 * 33], s[3 * 33]); o.z = pk2(s[4 * 33], s[5 * 33]); o.w = pk2(s[6 * 33], s[7 * 33]);
        *(v4u*)(WT + (size_t)(dst_row0 + n) * K + k0 + 8 * c) = o; }
    LDS_WAIT(); asm volatile("" ::: "memory");
}
__device__ __forceinline__ void p0_transpose_item_f8(const float* W, int ldw, int K, unsigned char* WT, int dst_row0, int src_col0, int k0, LAS float* scr, int lane) {
#pragma unroll 8
    for (int i = 0; i < 32; ++i) { const int kk = 2 * i + (lane >> 5); scr[kk * 33 + (lane & 31)] = W[(size_t)(k0 + kk) * ldw + src_col0 + (lane & 31)] * 64.0f; }
    LDS_WAIT(); asm volatile("" ::: "memory");
    const int c = lane & 3;
#pragma unroll
    for (int j = 0; j < 2; ++j) { const int n = (lane >> 2) + 16 * j; const LAS float* s = scr + (16 * c) * 33 + n; int o[4];
#pragma unroll
        for (int q = 0; q < 4; ++q) { int w = __builtin_amdgcn_cvt_pk_fp8_f32(s[(4 * q) * 33], s[(4 * q + 1) * 33], 0, false); o[q] = __builtin_amdgcn_cvt_pk_fp8_f32(s[(4 * q + 2) * 33], s[(4 * q + 3) * 33], w, true); }
        *(v4u*)(WT + (size_t)(dst_row0 + n) * K + k0 + 16 * c) = (v4u){(unsigned)o[0], (unsigned)o[1], (unsigned)o[2], (unsigned)o[3]}; }
    LDS_WAIT(); asm volatile("" ::: "memory");
}
template <bool F8> __device__ __forceinline__ void p0_transpose128(const float* W, int ldw, int K, void* WTv, int dst_row0, int src_col0, int k0, LAS float* scr, int lane) {
    const float* src = W + (size_t)(k0 + (lane >> 3)) * ldw + src_col0 + 4 * (lane & 7);
    f32x4 v[16];
#pragma unroll
    for (int i = 0; i < 16; ++i) v[i] = *(const f32x4*)(src + (size_t)(8 * i) * ldw);
#pragma unroll
    for (int i = 0; i < 16; ++i) { LAS float* d = scr + (8 * i + (lane >> 3)) * 33 + 4 * (lane & 7); d[0] = v[i].x; d[1] = v[i].y; d[2] = v[i].z; d[3] = v[i].w; }
    LDS_WAIT(); asm volatile("" ::: "memory");
    const int n = lane & 31, hf = lane >> 5; const LAS float* s = scr + (64 * hf) * 33 + n;
    if (F8) { unsigned char* dst = (unsigned char*)WTv + (size_t)(dst_row0 + n) * K + k0 + 64 * hf;
#pragma unroll
        for (int j = 0; j < 4; ++j) { int o[4];
#pragma unroll
            for (int q = 0; q < 4; ++q) { const LAS float* p = s + (16 * j + 4 * q) * 33; int w = __builtin_amdgcn_cvt_pk_fp8_f32(p[0] * 64.0f, p[33] * 64.0f, 0, false); o[q] = __builtin_amdgcn_cvt_pk_fp8_f32(p[66] * 64.0f, p[99] * 64.0f, w, true); }
            *(v4u*)(dst + 16 * j) = (v4u){(unsigned)o[0], (unsigned)o[1], (unsigned)o[2], (unsigned)o[3]}; }
    } else { bf16* dst = (bf16*)WTv + (size_t)(dst_row0 + n) * K + k0 + 64 * hf;
#pragma unroll
        for (int j = 0; j < 8; ++j) { const LAS float* p = s + (8 * j) * 33;
            *(v4u*)(dst + 8 * j) = (v4u){pk2(p[0], p[33]), pk2(p[66], p[99]), pk2(p[132], p[165]), pk2(p[198], p[231])}; }
    }
    LDS_WAIT(); asm volatile("" ::: "memory");
}
__device__ __forceinline__ void rms_row_to_bf16(const float* xrow, const float* w, bf16* orow, int lane) {
    const f32x4* xr = (const f32x4*)xrow + lane; const f32x4* wr = (const f32x4*)w + lane;
    f32x4 v[8]; float s = 0.f;
#pragma unroll
    for (int j = 0; j < 8; ++j) { v[j] = xr[64 * j]; s += (v[j].x * v[j].x + v[j].y * v[j].y) + (v[j].z * v[j].z + v[j].w * v[j].w); }
    const float rstd = 1.0f / sqrtf(wave_sum(s) * (1.0f / 2048.0f) + EPSF);
    v2u* o8 = (v2u*)orow + lane;
#pragma unroll
    for (int j = 0; j < 8; ++j) { const f32x4 ww = wr[64 * j]; v2u o; o.x = pk2(v[j].x * rstd * ww.x, v[j].y * rstd * ww.y); o.y = pk2(v[j].z * rstd * ww.z, v[j].w * rstd * ww.w); o8[64 * j] = o; }
}
__device__ __forceinline__ void p0_moe_weights_coop(Frame& F) {
    LAS float* tile = (LAS float*)F.lds;
    unsigned char* WguT = (unsigned char*)(F.ws + WS_WGU); unsigned char* WdT = (unsigned char*)(F.ws + WS_WD);
    constexpr int I_GU = 32 * 256, I_D = 32 * 128, NI = I_GU + I_D;
    const int lrow = 32 * F.wave + (F.lane >> 5), lcol = 4 * (F.lane & 31);
    const int on = F.tid & 127, okq = F.tid >> 7;
    f32x4 v[16];
    auto item = [&](int r, const float*& W, unsigned char*& WT, int& ldw, int& n0, int& k0) {
        if (r < I_GU) { const int e = r >> 8, rr = r & 255, kb = rr >> 5, nb = rr & 31; W = F.w_gate_up + (size_t)e * 2048 * 4096; WT = WguT + (size_t)e * 4096 * 2048; ldw = 4096; n0 = nb * 128; k0 = kb * 256; }
        else { r -= I_GU; const int e = r >> 7, rr = r & 127, kb = rr >> 4, nb = rr & 15; W = F.w_down + (size_t)e * 2048 * 2048; WT = WdT + (size_t)e * 2048 * 2048; ldw = 2048; n0 = nb * 128; k0 = kb * 256; } };
    int it = F.bid; if (it >= NI) return;
    const float* W; unsigned char* WT; int ldw, n0, k0; item(it, W, WT, ldw, n0, k0);
#pragma unroll
    for (int i = 0; i < 16; ++i) v[i] = *(const f32x4*)(W + (size_t)(k0 + lrow + 2 * i) * ldw + n0 + lcol);
    for (;;) {
#pragma unroll
        for (int i = 0; i < 16; ++i) *(LAS f32x4*)(tile + (lrow + 2 * i) * 132 + lcol) = v[i];
        __syncthreads();
        unsigned char* dst = WT + (size_t)(n0 + on) * 2048 + k0 + 64 * okq;
        const int nit = it + F.G; const bool more = nit < NI;
        if (more) { item(nit, W, WT, ldw, n0, k0);
#pragma unroll
            for (int i = 0; i < 16; ++i) v[i] = *(const f32x4*)(W + (size_t)(k0 + lrow + 2 * i) * ldw + n0 + lcol); }
        const LAS float* sp = tile + (64 * okq) * 132 + on;
#pragma unroll
        for (int j = 0; j < 4; ++j) { int o[4];
#pragma unroll
            for (int q = 0; q < 4; ++q) { const LAS float* p = sp + (16 * j + 4 * q) * 132; int w_ = __builtin_amdgcn_cvt_pk_fp8_f32(p[0] * 64.0f, p[132] * 64.0f, 0, false); o[q] = __builtin_amdgcn_cvt_pk_fp8_f32(p[264] * 64.0f, p[396] * 64.0f, w_, true); }
            *(v4u*)(dst + 16 * j) = (v4u){(unsigned)o[0], (unsigned)o[1], (unsigned)o[2], (unsigned)o[3]}; }
        __syncthreads();
        if (!more) break; it = nit;
    }
}
__device__ __forceinline__ void phase0(Frame& F) {
    LAS float* scr = (LAS float*)(F.lds + F.wave * 16896);
    const int gw = F.bid * NWAVES + F.wave, NGW = F.G * NWAVES;
    bf16* WinT = (bf16*)(F.ws + WS_WIN); bf16* WsT = (bf16*)(F.ws + WS_WSM); float* Wrt = (float*)(F.ws + WS_WRT); bf16* WoutT = (bf16*)(F.ws + WS_WOUT);
    bf16* XN1 = (bf16*)(F.ws + WS_XN1);
    p0_moe_weights_coop(F);
    constexpr int I_IN = 16 * 352, I_OUT = 32 * 64, NITEMS = I_IN + I_OUT;
    for (int it = gw; it < NITEMS; it += NGW) {
        int r = it;
        if (r < I_IN) { const int kb = r / 352, nb = r % 352, n0 = nb * 32; p0_transpose128<false>(F.w_in, WIN_LD, 2048, WinT, n0, n0 + (n0 >= 5120 ? 32 : 0), kb * 128, scr, F.lane); continue; } r -= I_IN;
        { const int kb = r >> 6, nb = r & 63; p0_transpose128<false>(F.w_out, 2048, 4096, WoutT, nb * 32, nb * 32, kb * 128, scr, F.lane); }
    }
    for (int i = gw * 64 + F.lane; i < 64 * 2048; i += NGW * 64) { const int j = i >> 11, k = i & 2047;
        const int col = j < 32 ? 5120 + j : (j < 40 ? 11296 + (j - 32) : 11304 + (j - 40));
        WsT[i] = (bf16)(j < 48 ? f2bf(F.w_in[(size_t)k * WIN_LD + col]) : 0u); }
    for (int i = gw * 64 + F.lane; i < 2048 * 32; i += NGW * 64) Wrt[i] = F.norm2_w[i >> 5] * F.router_w[i];
    for (int m = gw; m < TT; m += NGW) rms_row_to_bf16(F.x + (size_t)m * DM, F.norm1_w, XN1 + (size_t)m * DM, F.lane);
}

__device__ __forceinline__ void p1_small(Frame& F) {
    const bf16* XN1 = (const bf16*)(F.ws + WS_XN1); const bf16* WsT = (const bf16*)(F.ws + WS_WSM); float* SMALL = (float*)(F.ws + WS_SMALL);
    const int gw = F.bid * NWAVES + F.wave, NGW = F.G * NWAVES, fr = F.lane & 15, fq = F.lane >> 4;
    for (int task = gw; task < TT / 16; task += NGW) {
        const int t0 = task * 16;
        f32x4 acc[4];
#pragma unroll
        for (int n = 0; n < 4; ++n) acc[n] = (f32x4){0.f, 0.f, 0.f, 0.f};
        const bf16* arow = XN1 + (size_t)(t0 + fr) * DM + 8 * fq; const bf16* brow = WsT + (size_t)fr * DM + 8 * fq;
#pragma unroll 16
        for (int ks = 0; ks < 64; ++ks) {
            const bf16x8 a = *(const bf16x8*)(arow + 32 * ks);
#pragma unroll
            for (int n = 0; n < 4; ++n) { const bf16x8 b = *(const bf16x8*)(brow + (size_t)n * 16 * DM + 32 * ks); acc[n] = __builtin_amdgcn_mfma_f32_16x16x32_bf16(a, b, acc[n], 0, 0, 0); }
        }
#pragma unroll
        for (int n = 0; n < 4; ++n)
#pragma unroll
            for (int r = 0; r < 4; ++r) SMALL[(size_t)(t0 + 4 * fq + r) * 64 + n * 16 + fr] = acc[n][r];
    }
}

__device__ __forceinline__ void unpack8(const v4u r, float (&f)[8]) { f[0] = bflo(r.x); f[1] = bfhi(r.x); f[2] = bflo(r.y); f[3] = bfhi(r.y); f[4] = bflo(r.z); f[5] = bfhi(r.z); f[6] = bflo(r.w); f[7] = bfhi(r.w); }

__device__ __forceinline__ void phase_conv(Frame& F) {
    const bf16* PROJ = (const bf16*)(F.ws + WS_PROJ); bf16* XC = (bf16*)(F.ws + WS_XC);
    constexpr int TB = 16, NCG = 384, NIT = (TT / TB) * NCG;
    for (int it = F.bid * (NWAVES * 64) + F.tid; it < NIT; it += F.G * NWAVES * 64) {
        const int cg = it % NCG, tb = it / NCG, ch = cg * 8, t0 = tb * TB; const bool seq0 = (t0 % SEQ) == 0;
        float w[4][8], bs[8];
#pragma unroll
        for (int j = 0; j < 4; ++j) { const f32x4 a = *(const f32x4*)(F.conv_w + j * 3072 + ch), b = *(const f32x4*)(F.conv_w + j * 3072 + ch + 4);
            w[j][0] = a.x; w[j][1] = a.y; w[j][2] = a.z; w[j][3] = a.w; w[j][4] = b.x; w[j][5] = b.y; w[j][6] = b.z; w[j][7] = b.w; }
        { const f32x4 a = *(const f32x4*)(F.conv_b + ch), b = *(const f32x4*)(F.conv_b + ch + 4); bs[0] = a.x; bs[1] = a.y; bs[2] = a.z; bs[3] = a.w; bs[4] = b.x; bs[5] = b.y; bs[6] = b.z; bs[7] = b.w; }
        const bf16* src = PROJ + (size_t)t0 * NPROJ + PC_XBC + ch;
        float r0[8], r1[8], r2[8], r3[8];
        if (seq0) {
#pragma unroll
            for (int i = 0; i < 8; ++i) { r0[i] = 0.f; r1[i] = 0.f; r2[i] = 0.f; }
        } else { unpack8(*(const v4u*)(src - 3 * (size_t)NPROJ), r0); unpack8(*(const v4u*)(src - 2 * (size_t)NPROJ), r1); unpack8(*(const v4u*)(src - (size_t)NPROJ), r2); }
        v4u rw[TB];
#pragma unroll
        for (int l = 0; l < TB; ++l) rw[l] = *(const v4u*)(src + (size_t)l * NPROJ);
#pragma unroll
        for (int l = 0; l < TB; ++l) {
            unpack8(rw[l], r3);
            float o[8];
#pragma unroll
            for (int i = 0; i < 8; ++i) { const float v = bs[i] + w[0][i] * r0[i] + w[1][i] * r1[i] + w[2][i] * r2[i] + w[3][i] * r3[i]; o[i] = siluf(v); r0[i] = r1[i]; r1[i] = r2[i]; r2[i] = r3[i]; }
            v4u ov; ov.x = pk2(o[0], o[1]); ov.y = pk2(o[2], o[3]); ov.z = pk2(o[4], o[5]); ov.w = pk2(o[6], o[7]);
            *(v4u*)(XC + (size_t)(t0 + l) * 3072 + ch) = ov;
        }
    }
}

constexpr int MX_PITCH = 272;
static_assert(true, "");
constexpr int MX_QM = 0, MX_KM = 34816, MX_KW = 69632, MX_VT = 104448, MX_SI = 121856, MX_VEC = 139264, MX_VECB = 3072, MX_NVEC = MX_VEC + 2 * MX_VECB, MX_SCAL = MX_NVEC + 512, MX_END = MX_SCAL + 64;
__device__ __forceinline__ unsigned cvt_pk_bf16_nop(float lo, float hi) { unsigned r; asm volatile("v_cvt_pk_bf16_f32 %0, %1, %2\n\ts_nop 1" : "=v"(r) : "v"(lo), "v"(hi)); return r; }
__device__ __forceinline__ int mx_sw(int row, int tbyte) { return row * MX_PITCH + ((((tbyte >> 4) ^ (row >> 3)) & 15) << 4) + (tbyte & 15); }
__device__ __forceinline__ bf16x8 lds_frag(const LAS unsigned char* img, int row, int kbyte) { return *(const LAS bf16x8*)(img + row * MX_PITCH + kbyte); }
static_assert(MX_END + 256 <= LDSCTL_OFF, "mixer LDS map");
template <bool ML> __device__ __forceinline__ void mixer_unit(Frame& F, int unit) {
    const bf16* PROJ = (const bf16*)(F.ws + WS_PROJ); const bf16* XC = (const bf16*)(F.ws + WS_XC); const float* SMALL = (const float*)(F.ws + WS_SMALL);
    bf16* YMIX = (bf16*)(F.ws + WS_YMIX); float* SSQ = (float*)(F.ws + WS_SSQ);
    const int w = F.wave, fr = F.lane & 15, fq = F.lane >> 4, tid = F.tid;
    const int b = unit >> 5, tok0 = b * SEQ, hd = unit & 31, grp = hd >> 3, mh = (unit & 31) >> 2, vq = unit & 3;
    const float qs = 0.08838834764831845f;
    LAS unsigned char* QM = F.lds + MX_QM; LAS unsigned char* KM = F.lds + MX_KM; LAS unsigned char* KW = F.lds + MX_KW; LAS unsigned char* VT = F.lds + MX_VT; LAS unsigned char* SI = F.lds + MX_SI;
    LAS float* exch = (LAS float*)(F.lds + MX_VEC + (w >> 2) * MX_VECB + 1024) + (w & 3) * 32;
    LAS float* nvec = (LAS float*)(F.lds + MX_NVEC); LAS float* scal = (LAS float*)(F.lds + MX_SCAL);
    const int fr3 = fr >> 3;
    int vtb[2];
#pragma unroll
    for (int p = 0; p < 2; ++p) vtb[p] = fr * MX_PITCH + ((fq ^ ((2 * p) | fr3)) << 4);
    int vpb[2][2];
#pragma unroll
    for (int p = 0; p < 2; ++p)
#pragma unroll
        for (int h = 0; h < 2; ++h) vpb[p][h] = fr * MX_PITCH + (((((fq >> 1) | (2 * h)) ^ ((2 * p) | fr3))) << 4) + 8 * (fq & 1);
    const int kwb = (16 * w + fr) * MX_PITCH + ((fq ^ ((2 * (w & 1)) | fr3)) << 4), kwh = w >> 1;

    const bf16* qsrc; const bf16* ksrc; const bf16* vsrc; int ld;
    if (ML) { qsrc = PROJ + PC_Q + mh * 128; ksrc = PROJ + PC_K + mh * 128; vsrc = PROJ + PC_V + mh * 256 + vq * 64; ld = NPROJ; }
    else { qsrc = XC + 2560 + grp * 128; ksrc = XC + 2048 + grp * 128; vsrc = XC + hd * 64; ld = 3072; }
    const float c_a = ML ? 0.f : -expf(F.a_log[hd]), c_dtb = ML ? 0.f : F.dt_bias[hd], c_D = ML ? 0.f : F.d_skip[hd], c_ib = ML ? F.i_bias[mh] : 0.f, c_fb = ML ? F.f_bias[mh] : 0.f;
    float mprev = 0.f;
    f32x4 sacc[4]; float nreg = 0.f;
#pragma unroll
    for (int j = 0; j < 4; ++j) sacc[j] = (f32x4){0.f, 0.f, 0.f, 0.f};
    v4u pq[4], pk[4], pv[2];
    float vA0 = 0.f, vA1 = 0.f, vB0 = 0.f, vB1 = 0.f, vC0 = 0.f, vC1 = 0.f, vD0 = 0.f, vD1 = 0.f, vE0 = 0.f, vE1 = 0.f, vG0 = 0.f, vG1 = 0.f, vSA = 0.f, vSG = 0.f;
    float sl0 = 0.f, sl1 = 0.f, sl2 = 0.f, sl3 = 0.f;
#define MX_SCAN_L(c) do { if (w == 0) { const size_t tt = (size_t)(tok0 + 128 * (c) + 2 * F.lane); \
        if (!ML) { sl0 = SMALL[tt * 64 + hd]; sl1 = SMALL[(tt + 1) * 64 + hd]; } \
        else { sl0 = SMALL[tt * 64 + 32 + mh]; sl1 = SMALL[(tt + 1) * 64 + 32 + mh]; sl2 = SMALL[tt * 64 + 40 + mh]; sl3 = SMALL[(tt + 1) * 64 + 40 + mh]; } } } while (0)
#define MX_SOFTPLUS(x) ((x) > 20.f ? (x) : __logf(1.0f + __expf(x)))
#define MX_LOGSIG(x) (fminf((x), 0.f) - __logf(1.0f + __expf(-fabsf(x))))
#define MX_SCAN_A(c) do { if (w == 0) { \
        if (!ML) { const float d0 = MX_SOFTPLUS(sl0 + c_dtb), d1 = MX_SOFTPLUS(sl1 + c_dtb); \
            const float x0 = d0 * c_a, x1 = d1 * c_a; float incl = x0 + x1; \
            _Pragma("unroll") for (int d = 1; d < 64; d <<= 1) { const float t_ = __shfl_up(incl, d); if (F.lane >= d) incl += t_; } \
            const float cum1 = incl, cum0 = incl - x1, tot = __shfl(incl, 63); \
            vA0 = -cum0; vA1 = -cum1; vB0 = -cum0; vB1 = -cum1; vC0 = d0; vC1 = d1; vD0 = __expf(cum0); vD1 = __expf(cum1); vE0 = d0 * __expf(tot - cum0); vE1 = d1 * __expf(tot - cum1); vSA = __expf(tot); vSG = 1.0f; \
        } else { const float li0 = sl0 + c_ib, li1 = sl1 + c_ib; \
            const float x0 = MX_LOGSIG(sl2 + c_fb), x1 = MX_LOGSIG(sl3 + c_fb); float incl = x0 + x1; \
            _Pragma("unroll") for (int d = 1; d < 64; d <<= 1) { const float t_ = __shfl_up(incl, d); if (F.lane >= d) incl += t_; } \
            const float cum1 = incl, cum0 = incl - x1, btot = __shfl(incl, 63); \
            const float dd0 = li0 - cum0, dd1 = li1 - cum1; float im = fmaxf(dd0, dd1); \
            _Pragma("unroll") for (int d = 1; d < 64; d <<= 1) { const float t_ = __shfl_up(im, d); if (F.lane >= d) im = fmaxf(im, t_); } \
            float pm = __shfl_up(im, 1); if (F.lane == 0) pm = -3.0e38f; const float pmax0 = fmaxf(pm, dd0), pmax1 = im, pm127 = __shfl(im, 63); \
            const float M0 = fmaxf(mprev, pmax0), M1 = fmaxf(mprev, pmax1); \
            vA0 = dd0; vA1 = dd1; vB0 = M0; vB1 = M1; vD0 = qs * __expf(mprev - M0); vD1 = qs * __expf(mprev - M1); vG0 = __expf(-(cum0 + M0)); vG1 = __expf(-(cum1 + M1)); \
            const float mloc = btot + pm127, mnew = fmaxf(btot + mprev, mloc); \
            vSA = __expf(btot + mprev - mnew); vSG = __expf(mloc - mnew); vE0 = __expf(dd0 - pm127) * vSG; vE1 = __expf(dd1 - pm127) * vSG; mprev = mnew; } } } while (0)
#define MX_SCAN_B(c) do { if (w == 0) { \
        LAS float* vb = (LAS float*)(F.lds + MX_VEC + ((c) & 1) * MX_VECB); const int l0 = 2 * F.lane; \
        *(LAS f32x2*)(vb + l0) = (f32x2){vA0, vA1}; *(LAS f32x2*)(vb + 128 + l0) = (f32x2){vB0, vB1}; if (!ML) *(LAS f32x2*)(vb + 256 + l0) = (f32x2){vC0, vC1}; \
        *(LAS f32x2*)(vb + 384 + l0) = (f32x2){vD0, vD1}; *(LAS f32x2*)(vb + 512 + l0) = (f32x2){vE0, vE1}; if (ML) *(LAS f32x2*)(vb + 640 + l0) = (f32x2){vG0, vG1}; \
        if (F.lane == 0) { scal[2 * ((c) & 1)] = vSA; scal[2 * ((c) & 1) + 1] = vSG; } } } while (0)
#define MX_SCAN(c) do { MX_SCAN_L(c); MX_SCAN_A(c); MX_SCAN_B(c); } while (0)
#define MX_PREFETCH(c) do { const size_t tb_ = (size_t)(tok0 + 128 * (c)); \
        _Pragma("unroll") for (int i = 0; i < 2; ++i) { const int pid = tid + 512 * i, a2 = pid >> 4, k8 = pid & 15; \
            pq[2 * i] = *(const v4u*)(qsrc + (tb_ + 2 * a2) * ld + 8 * k8); pq[2 * i + 1] = *(const v4u*)(qsrc + (tb_ + 2 * a2 + 1) * ld + 8 * k8); \
            pk[2 * i] = *(const v4u*)(ksrc + (tb_ + 2 * a2) * ld + 8 * k8); pk[2 * i + 1] = *(const v4u*)(ksrc + (tb_ + 2 * a2 + 1) * ld + 8 * k8); } \
        { const int a2 = tid >> 3, v8 = tid & 7; pv[0] = *(const v4u*)(vsrc + (tb_ + 2 * a2) * ld + 8 * v8); pv[1] = *(const v4u*)(vsrc + (tb_ + 2 * a2 + 1) * ld + 8 * v8); } } while (0)
#define MX_WRITE(c) do { const LAS float* vb = (const LAS float*)(F.lds + MX_VEC + ((c) & 1) * MX_VECB); \
        _Pragma("unroll") for (int i = 0; i < 2; ++i) { const int pid = tid + 512 * i, a2 = pid >> 4, k8 = pid & 15, l = 2 * a2; \
            *(LAS v4u*)(QM + l * MX_PITCH + 16 * k8) = pq[2 * i]; *(LAS v4u*)(QM + (l + 1) * MX_PITCH + 16 * k8) = pq[2 * i + 1]; \
            *(LAS v4u*)(KM + l * MX_PITCH + 16 * k8) = pk[2 * i]; *(LAS v4u*)(KM + (l + 1) * MX_PITCH + 16 * k8) = pk[2 * i + 1]; \
            float f0[8], f1[8]; unpack8(pk[2 * i], f0); unpack8(pk[2 * i + 1], f1); const f32x2 wl = *(const LAS f32x2*)(vb + 512 + l); \
            _Pragma("unroll") for (int e = 0; e < 8; ++e) *(LAS unsigned*)(KW + mx_sw(8 * k8 + e, 2 * l)) = pg8::cvt_pk_bf16(f0[e] * wl.x, f1[e] * wl.y); } \
        { const int a2 = tid >> 3, v8 = tid & 7, l = 2 * a2; const v4u r0 = pv[0], r1 = pv[1]; LAS unsigned char* vp_ = VT + mx_sw(8 * v8, 2 * l); \
            *(LAS unsigned*)(vp_ + 0 * MX_PITCH) = (r0.x & 0xffffu) | (r1.x << 16); *(LAS unsigned*)(vp_ + 1 * MX_PITCH) = (r0.x >> 16) | (r1.x & 0xffff0000u); \
            *(LAS unsigned*)(vp_ + 2 * MX_PITCH) = (r0.y & 0xffffu) | (r1.y << 16); *(LAS unsigned*)(vp_ + 3 * MX_PITCH) = (r0.y >> 16) | (r1.y & 0xffff0000u); \
            *(LAS unsigned*)(vp_ + 4 * MX_PITCH) = (r0.z & 0xffffu) | (r1.z << 16); *(LAS unsigned*)(vp_ + 5 * MX_PITCH) = (r0.z >> 16) | (r1.z & 0xffff0000u); \
            *(LAS unsigned*)(vp_ + 6 * MX_PITCH) = (r0.w & 0xffffu) | (r1.w << 16); *(LAS unsigned*)(vp_ + 7 * MX_PITCH) = (r0.w >> 16) | (r1.w & 0xffff0000u); } \
        _Pragma("unroll") for (int j = 0; j < 4; ++j) { v2u sv; sv.x = pg8::cvt_pk_bf16(sacc[j][0], sacc[j][1]); sv.y = pg8::cvt_pk_bf16(sacc[j][2], sacc[j][3]); *(LAS v2u*)(SI + (16 * j + fr) * MX_PITCH + (16 * w + 4 * fq) * 2) = sv; } \
        if (ML && fq == 0) nvec[16 * w + fr] = nreg; } while (0)
    const int gcol = (ML ? PC_O + mh * 256 + vq * 64 : PC_Z + hd * 64) + 16 * (F.lane & 3);
    LAS float* nwl = (LAS float*)(F.lds + MX_END);
    if (tid < 64) nwl[tid] = ML ? F.ml_norm_w[mh * 256 + vq * 64 + tid] : F.ssd_norm_w[hd * 64 + tid];
    v4u zc0 = (v4u){0u, 0u, 0u, 0u}, zc1 = zc0;
    { const bf16* zp = PROJ + (size_t)(tok0 + 16 * w + (F.lane >> 2)) * NPROJ + gcol; zc0 = *(const v4u*)zp; zc1 = *(const v4u*)(zp + 8); }
    MX_SCAN(0);
    MX_PREFETCH(0);
    __syncthreads();
    MX_WRITE(0);
    __syncthreads();
    for (int c = 0; c < SEQ / 128; ++c) {
        const LAS float* vb = (const LAS float*)(F.lds + MX_VEC + (c & 1) * MX_VECB);
        const bool more = (c + 1 < SEQ / 128);
        if (more) { MX_SCAN_L(c + 1); MX_PREFETCH(c + 1); }
        bf16x8 qf[4];
#pragma unroll
        for (int ks = 0; ks < 4; ++ks) qf[ks] = lds_frag(QM, 16 * w + fr, 64 * ks + 16 * fq);
        const float mlv = vb[128 + 16 * w + fr];
        float dsum = 0.f;
        f32x4 y1[4];
#pragma unroll
        for (int j = 0; j < 4; ++j) y1[j] = (f32x4){0.f, 0.f, 0.f, 0.f};
        const f32x4 rs4 = *(const LAS f32x4*)(vb + 384 + 16 * w + 4 * fq);
#pragma unroll
        for (int ks = 0; ks < 4; ++ks) { bf16x8 sf[4];
#pragma unroll
            for (int j = 0; j < 4; ++j) sf[j] = lds_frag(SI, 16 * j + fr, 64 * ks + 16 * fq);
#pragma unroll
            for (int j = 0; j < 4; ++j) y1[j] = __builtin_amdgcn_mfma_f32_16x16x32_bf16(qf[ks], sf[j], y1[j], 0, 0, 0); }
#pragma unroll
        for (int j = 0; j < 4; ++j) y1[j] = y1[j] * rs4;
        __builtin_amdgcn_sched_barrier(0);
#pragma unroll 1
        for (int k2 = 0; 2 * k2 <= w; ++k2) {
            unsigned pw[4];
#pragma unroll
            for (int h = 0; h < 2; ++h) {
                const int si = 2 * k2 + h;
                f32x4 acc = (f32x4){0.f, 0.f, 0.f, 0.f};
#pragma unroll
                for (int ks = 0; ks < 4; ++ks) acc = __builtin_amdgcn_mfma_f32_16x16x32_bf16(lds_frag(KM, 16 * si + fr, 64 * ks + 16 * fq), qf[ks], acc, 0, 0, 0);
                const f32x4 e4 = *(const LAS f32x4*)(vb + 16 * si + 4 * fq); f32x4 x4 = (f32x4){qs, qs, qs, qs}; if (!ML) x4 = *(const LAS f32x4*)(vb + 256 + 16 * si + 4 * fq);
                float p[4];
#pragma unroll
                for (int r = 0; r < 4; ++r) { const float v = acc[r] * __expf(e4[r] - mlv) * x4[r]; const bool ok = (si < w) || (si == w && 4 * fq + r <= fr); p[r] = ok ? v : 0.f; }
                if (ML) dsum += (p[0] + p[1]) + (p[2] + p[3]);
                pw[2 * h] = cvt_pk_bf16_nop(p[0], p[1]); pw[2 * h + 1] = cvt_pk_bf16_nop(p[2], p[3]);
            }
            HWAIT();
            const v4u pwv = (v4u){pw[0], pw[1], pw[2], pw[3]}; const bf16x8 pf = __builtin_bit_cast(bf16x8, pwv);
#pragma unroll
            for (int j = 0; j < 4; ++j) { const int ho = j * 16 * MX_PITCH + ((k2 ^ (j >> 1)) << 6); const v2u lo = *(const LAS v2u*)(VT + vpb[j & 1][0] + ho), hi = *(const LAS v2u*)(VT + vpb[j & 1][1] + ho); const v4u vw = (v4u){lo.x, lo.y, hi.x, hi.y};
                y1[j] = __builtin_amdgcn_mfma_f32_16x16x32_bf16(pf, __builtin_bit_cast(bf16x8, vw), y1[j], 0, 0, 0); }
            HWAIT();
        }
        HSYNC();
        __builtin_amdgcn_sched_barrier(0);
        __builtin_amdgcn_sched_barrier(0);
        if (ML) {
            dsum += __shfl_xor(dsum, 16); dsum += __shfl_xor(dsum, 32);
            float d2 = 0.f;
#pragma unroll
            for (int ks = 0; ks < 4; ++ks) { float qv[8]; unpack8(__builtin_bit_cast(v4u, qf[ks]), qv); const f32x4 n0 = *(const LAS f32x4*)(nvec + 32 * ks + 8 * fq), n1 = *(const LAS f32x4*)(nvec + 32 * ks + 8 * fq + 4);
                d2 += qv[0] * n0.x + qv[1] * n0.y + qv[2] * n0.z + qv[3] * n0.w + qv[4] * n1.x + qv[5] * n1.y + qv[6] * n1.z + qv[7] * n1.w; }
            d2 += __shfl_xor(d2, 16); d2 += __shfl_xor(d2, 32);
            if (fq == 0) { exch[fr] = dsum; exch[16 + fr] = d2; }
        }
        HSYNC();
        __builtin_amdgcn_sched_barrier(0);
        LAS float* stg = (LAS float*)(QM + 16 * w * MX_PITCH);
        if (ML) { const f32x4 fl4 = *(const LAS f32x4*)(vb + 640 + 16 * w + 4 * fq); const f32x4 dA = *(const LAS f32x4*)(exch + 4 * fq), dB = *(const LAS f32x4*)(exch + 16 + 4 * fq);
#pragma unroll
            for (int r = 0; r < 4; ++r) { const float den = fmaxf(fabsf(dA[r] + rs4[r] * dB[r]), fl4[r]); const float inv = __builtin_amdgcn_rcpf(den);
#pragma unroll
                for (int j = 0; j < 4; ++j) stg[(4 * fq + r) * 68 + 16 * j + fr] = y1[j][r] * inv; }
        } else {
#pragma unroll
            for (int j = 0; j < 4; ++j) { const v2u xw = *(const LAS v2u*)(VT + mx_sw(16 * j + fr, 32 * w + 8 * fq)); const float xs[4] = {bflo(xw.x), bfhi(xw.x), bflo(xw.y), bfhi(xw.y)};
#pragma unroll
                for (int r = 0; r < 4; ++r) stg[(4 * fq + r) * 68 + 16 * j + fr] = y1[j][r] + c_D * xs[r]; }
        }
        {   const int erow = F.lane >> 2, ecs = F.lane & 3; const size_t trow = (size_t)(tok0 + 128 * c + 16 * w + erow);
            float yv[16];
#pragma unroll
            for (int i = 0; i < 4; ++i) { const f32x4 t4 = *(const LAS f32x4*)(stg + erow * 68 + 16 * ecs + 4 * i); yv[4 * i] = t4.x; yv[4 * i + 1] = t4.y; yv[4 * i + 2] = t4.z; yv[4 * i + 3] = t4.w; }
            float zf[16]; { float t8[8]; unpack8(zc0, t8);
#pragma unroll
                for (int i = 0; i < 8; ++i) zf[i] = t8[i]; unpack8(zc1, t8);
#pragma unroll
                for (int i = 0; i < 8; ++i) zf[8 + i] = t8[i]; }
            if (!ML) {
#pragma unroll
                for (int i = 0; i < 16; ++i) yv[i] = yv[i] * zf[i] * __builtin_amdgcn_rcpf(1.0f + __expf(-zf[i])); }
            float ss = 0.f;
#pragma unroll
            for (int i = 0; i < 16; ++i) ss += yv[i] * yv[i];
            ss += __shfl_xor(ss, 1); ss += __shfl_xor(ss, 2);
            if (ecs == 0) SSQ[(ML ? (size_t)TT * 32 : 0) + trow * 32 + (ML ? mh * 4 + vq : hd)] = ss;
#pragma unroll
            for (int i = 0; i < 4; ++i) { const f32x4 w4 = *(const LAS f32x4*)(nwl + 16 * ecs + 4 * i);
                yv[4 * i] *= w4.x; yv[4 * i + 1] *= w4.y; yv[4 * i + 2] *= w4.z; yv[4 * i + 3] *= w4.w; }
            if (ML) {
#pragma unroll
                for (int i = 0; i < 16; ++i) yv[i] *= __builtin_amdgcn_rcpf(1.0f + __expf(-zf[i])); }
            bf16* yp = YMIX + trow * 4096 + (ML ? 2048 + mh * 256 + vq * 64 : hd * 64) + 16 * ecs;
            *(v4u*)yp = (v4u){pg8::cvt_pk_bf16(yv[0], yv[1]), pg8::cvt_pk_bf16(yv[2], yv[3]), pg8::cvt_pk_bf16(yv[4], yv[5]), pg8::cvt_pk_bf16(yv[6], yv[7])};
            *(v4u*)(yp + 8) = (v4u){pg8::cvt_pk_bf16(yv[8], yv[9]), pg8::cvt_pk_bf16(yv[10], yv[11]), pg8::cvt_pk_bf16(yv[12], yv[13]), pg8::cvt_pk_bf16(yv[14], yv[15])};
            if (more) { const bf16* zp = PROJ + (size_t)(tok0 + 128 * (c + 1) + 16 * w + (F.lane >> 2)) * NPROJ + gcol; zc0 = *(const v4u*)zp; zc1 = *(const v4u*)(zp + 8); }
        }
        __builtin_amdgcn_sched_barrier(0);
        const float sa = scal[2 * (c & 1)];
#pragma unroll
        for (int j = 0; j < 4; ++j) sacc[j] = sacc[j] * sa;
        float nsum = 0.f;
#pragma unroll
        for (int ks = 0; ks < 4; ++ks) { const bf16x8 kf = *(const LAS bf16x8*)(KW + kwb + ((ks ^ kwh) << 6)); bf16x8 vf[4];
#pragma unroll
            for (int j = 0; j < 4; ++j) vf[j] = *(const LAS bf16x8*)(VT + vtb[j & 1] + j * 16 * MX_PITCH + ((ks ^ (j >> 1)) << 6));
            if (ML) { float kv[8]; unpack8(__builtin_bit_cast(v4u, kf), kv); nsum += ((kv[0] + kv[1]) + (kv[2] + kv[3])) + ((kv[4] + kv[5]) + (kv[6] + kv[7])); }
#pragma unroll
            for (int j = 0; j < 4; ++j) sacc[j] = __builtin_amdgcn_mfma_f32_16x16x32_bf16(kf, vf[j], sacc[j], 0, 0, 0); }
        if (ML) { nsum += __shfl_xor(nsum, 16); nsum += __shfl_xor(nsum, 32); nreg = nreg * sa + nsum; }
        if (more) { MX_SCAN_A(c + 1); }
        __syncthreads();
        if (more) { MX_SCAN_B(c + 1); }
        __syncthreads();
        if (more) { MX_WRITE(c + 1); }
        __syncthreads();
    }
#undef MX_SCAN
#undef MX_SCAN_A
#undef MX_SCAN_L
#undef MX_SOFTPLUS
#undef MX_LOGSIG
#undef MX_SCAN_B
#undef MX_PREFETCH
#undef MX_WRITE
}
__device__ __forceinline__ void phase_mixer(Frame& F) {
    for (int unit = F.bid; unit < 256; unit += F.G) { mixer_unit<false>(F, unit); mixer_unit<true>(F, unit); }
}

__device__ __forceinline__ void phase3(Frame& F) {
    const bf16* PROJ = (const bf16*)(F.ws + WS_PROJ); bf16* YMIX = (bf16*)(F.ws + WS_YMIX); const float* SSQ = (const float*)(F.ws + WS_SSQ);
    const int gw = F.bid * NWAVES + F.wave, NGW = F.G * NWAVES;
    for (int t = gw; t < TT; t += NGW) {
        bf16* yrow = YMIX + (size_t)t * 4096;
#pragma unroll
        for (int j = 0; j < 8; ++j) {
            const int c0 = (j * 64 + F.lane) * 8;
            float y[8]; unpack8(*(const v4u*)(yrow + c0), y);
            float o[8];
            if (j < 4) {
                const int g = c0 >> 9; const f32x4 s0 = *(const f32x4*)(SSQ + (size_t)t * 32 + g * 8), s1 = *(const f32x4*)(SSQ + (size_t)t * 32 + g * 8 + 4);
                const float ms = ((s0.x + s0.y) + (s0.z + s0.w) + (s1.x + s1.y) + (s1.z + s1.w)) * (1.0f / 512.0f);
                const float rs = 1.0f / sqrtf(ms + EPSF);
                const f32x4 w0 = *(const f32x4*)(F.ssd_norm_w + c0), w1 = *(const f32x4*)(F.ssd_norm_w + c0 + 4);
                o[0] = y[0] * rs * w0.x; o[1] = y[1] * rs * w0.y; o[2] = y[2] * rs * w0.z; o[3] = y[3] * rs * w0.w;
                o[4] = y[4] * rs * w1.x; o[5] = y[5] * rs * w1.y; o[6] = y[6] * rs * w1.z; o[7] = y[7] * rs * w1.w;
            } else {
                const int cc = c0 - 2048, h = cc >> 8; const f32x4 s0 = *(const f32x4*)(SSQ + (size_t)TT * 32 + (size_t)t * 32 + h * 4);
                const float ms = ((s0.x + s0.y) + (s0.z + s0.w)) * (1.0f / 256.0f);
                const float rs = 1.0f / sqrtf(ms + EPSF);
                const f32x4 w0 = *(const f32x4*)(F.ml_norm_w + cc), w1 = *(const f32x4*)(F.ml_norm_w + cc + 4);
                float og[8]; unpack8(*(const v4u*)(PROJ + (size_t)t * NPROJ + PC_O + cc), og);
                const float wv[8] = {w0.x, w0.y, w0.z, w0.w, w1.x, w1.y, w1.z, w1.w};
#pragma unroll
                for (int i = 0; i < 8; ++i) o[i] = y[i] * rs * wv[i] * __builtin_amdgcn_rcpf(1.0f + __expf(-og[i]));
            }
            v4u ov; ov.x = pk2(o[0], o[1]); ov.y = pk2(o[2], o[3]); ov.z = pk2(o[4], o[5]); ov.w = pk2(o[6], o[7]);
            *(v4u*)(yrow + c0) = ov;
        }
    }
}

__device__ __forceinline__ void phase5(Frame& F) {
    const float* H2 = (const float*)(F.ws + WS_H2); const float* Wrt = (const float*)(F.ws + WS_WRT); bf16* XN2 = (bf16*)(F.ws + WS_XN2);
    int* EIDX = (int*)(F.ws + WS_ROUTE); int* RANK = EIDX + TT * 4;
    int* TOKL = (int*)(F.ws + WS_XG); float* GATEL = (float*)(F.ws + WS_XG + 4 * MiB);
    LAS float* xT = (LAS float*)(F.lds + F.wave * 8192); LAS float* lg = (LAS float*)(F.lds + 65536 + F.wave * 1024);
    LAS int* cntl = (LAS int*)(F.lds + 73728); LAS int* baseg = cntl + 32;
    const int gw = F.bid * NWAVES + F.wave, NGW = F.G * NWAVES, ntask = TT / 8, iters = (ntask + NGW - 1) / NGW;
    for (int itx = 0; itx < iters; ++itx) {
        const int task = itx * NGW + gw; const bool valid = task < ntask; const int t0 = task * 8;
        if (F.tid < 32) cntl[F.tid] = 0;
        __syncthreads();
        float rstd[8]; int me[4] = {0, 0, 0, 0}, mr[4] = {0, 0, 0, 0}; float mg[4] = {0.f, 0.f, 0.f, 0.f};
#pragma unroll
        for (int k = 0; k < 8; ++k) rstd[k] = 0.f;
        float acc[8], ssq[8];
#pragma unroll
        for (int k = 0; k < 8; ++k) { acc[k] = 0.f; ssq[k] = 0.f; }
        const int e = F.lane & 31, dh = F.lane >> 5;
        LAS float* wl = (LAS float*)(F.lds + 81920);
        for (int dc = 0; dc < 8; ++dc) {
            __syncthreads();
#pragma unroll
            for (int q = 0; q < 4; ++q) ((LAS f32x4*)wl)[F.tid + 512 * q] = ((const f32x4*)(Wrt + (size_t)dc * 256 * 32))[F.tid + 512 * q];
            if (valid) {
                f32x4 xk[8];
#pragma unroll
                for (int k = 0; k < 8; ++k) { xk[k] = *(const f32x4*)(H2 + (size_t)(t0 + k) * DM + dc * 256 + 4 * F.lane); ssq[k] += (xk[k].x * xk[k].x + xk[k].y * xk[k].y) + (xk[k].z * xk[k].z + xk[k].w * xk[k].w); }
#pragma unroll
                for (int jj = 0; jj < 4; ++jj) { LAS float* dp = xT + (jj * 64 + F.lane) * 8;
                    *(LAS f32x4*)dp = (f32x4){xk[0][jj], xk[1][jj], xk[2][jj], xk[3][jj]}; *(LAS f32x4*)(dp + 4) = (f32x4){xk[4][jj], xk[5][jj], xk[6][jj], xk[7][jj]}; }
            }
            __syncthreads();
            if (valid) {
                const LAS float* xp = xT + dh * 128 * 8;
#pragma unroll 8
                for (int i = 0; i < 128; ++i) { const float w = wl[(4 * (i & 63) + 2 * dh + (i >> 6)) * 32 + e];     const f32x4 xa = *(const LAS f32x4*)(xp + i * 8), xb = *(const LAS f32x4*)(xp + i * 8 + 4);
                    acc[0] += w * xa.x; acc[1] += w * xa.y; acc[2] += w * xa.z; acc[3] += w * xa.w; acc[4] += w * xb.x; acc[5] += w * xb.y; acc[6] += w * xb.z; acc[7] += w * xb.w; }
            }
        }
        if (valid) {
            const float rb = F.router_b[e];
#pragma unroll
            for (int k = 0; k < 8; ++k) { rstd[k] = 1.0f / sqrtf(wave_sum(ssq[k]) * (1.0f / 2048.0f) + EPSF);
                const float v = (acc[k] + __shfl_xor(acc[k], 32)) * rstd[k] + rb; if (F.lane < 32) lg[k * 32 + e] = v; }
            LDS_WAIT(); asm volatile("" ::: "memory");
            if (F.lane < 8) {
                const LAS float* lp = lg + F.lane * 32; float bv[4]; int bi[4] = {-1, -1, -1, -1};
#pragma unroll
                for (int p = 0; p < 4; ++p) { float best = -3.0e38f; int bidx = 0;
                    for (int q = 0; q < 32; ++q) { const float v = lp[q]; const bool taken = (q == bi[0]) | (q == bi[1]) | (q == bi[2]) | (q == bi[3]); if (!taken && v > best) { best = v; bidx = q; } }
                    bv[p] = best; bi[p] = bidx; }
                const float p1 = expf(bv[1] - bv[0]), p2 = expf(bv[2] - bv[0]), p3 = expf(bv[3] - bv[0]); const float inv = 1.0f / (1.0f + p1 + p2 + p3);
                mg[0] = inv; mg[1] = p1 * inv; mg[2] = p2 * inv; mg[3] = p3 * inv;
#pragma unroll
                for (int p = 0; p < 4; ++p) { me[p] = bi[p]; mr[p] = __hip_atomic_fetch_add(cntl + bi[p], 1, __ATOMIC_RELAXED, __HIP_MEMORY_SCOPE_WORKGROUP); }
            }
        }
        __syncthreads();
        if (F.tid < 32) { const int c = cntl[F.tid]; int gb = 0; if (c > 0) gb = (int)__hip_atomic_fetch_add((unsigned*)(F.ctl + CW_CNT + 64 * F.tid), (unsigned)c, RLX_AGENT); baseg[F.tid] = gb; }
        __syncthreads();
        if (valid) {
            if (F.lane < 8) { const size_t t = (size_t)(t0 + F.lane);
#pragma unroll
                for (int p = 0; p < 4; ++p) { const int rk = baseg[me[p]] + mr[p]; EIDX[t * 4 + p] = me[p]; RANK[t * 4 + p] = rk; TOKL[(size_t)me[p] * TT + rk] = (int)t; GATEL[(size_t)me[p] * TT + rk] = mg[p]; } }
#pragma unroll
            for (int k = 0; k < 8; ++k) { const f32x4* xr = (const f32x4*)(H2 + (size_t)(t0 + k) * DM) + F.lane; const f32x4* wr = (const f32x4*)F.norm2_w + F.lane; int* o4 = (int*)((unsigned char*)XN2 + (size_t)(t0 + k) * DM) + F.lane;
#pragma unroll
                for (int j = 0; j < 8; ++j) { const f32x4 v = xr[64 * j], ww = wr[64 * j]; int o = __builtin_amdgcn_cvt_pk_fp8_f32(v.x * rstd[k] * ww.x, v.y * rstd[k] * ww.y, 0, false); o = __builtin_amdgcn_cvt_pk_fp8_f32(v.z * rstd[k] * ww.z, v.w * rstd[k] * ww.w, o, true); o4[64 * j] = o; } }
        }
        __syncthreads();
    }
}
__device__ __forceinline__ int build_moe_tab(Frame& F) {
    LAS unsigned char* tab = (LAS unsigned char*)(F.lds + TAB_OFF); LAS int* tinfo = (LAS int*)(F.lds + TAB_OFF + 320);
    if (F.tid < 32) { const int c = (int)__hip_atomic_load((unsigned*)(F.ctl + CW_CNT + 64 * F.tid), RLX_AGENT); tinfo[4 + F.tid] = (c + 255) >> 8; tinfo[72 + F.tid] = c; }
    __syncthreads();
    if (F.tid == 0) { int a = 0; for (int e = 0; e < 32; ++e) { const int n = tinfo[4 + e]; tinfo[40 + e] = a; for (int j = 0; j < n; ++j) tab[a + j] = (unsigned char)e; a += n; } tinfo[0] = a; }
    __syncthreads();
    return tinfo[0];
}
__device__ __forceinline__ void phase8(Frame& F) {
    const float* H2 = (const float*)(F.ws + WS_H2); const bf16* YR = (const bf16*)(F.ws + WS_YR);
    const int* EIDX = (const int*)(F.ws + WS_ROUTE); const int* RANK = EIDX + TT * 4; (void)build_moe_tab(F); const LAS int* tinfo = (const LAS int*)(F.lds + TAB_OFF + 320);
    const int gw = F.bid * NWAVES + F.wave, NGW = F.G * NWAVES;
    for (int t = gw; t < TT; t += NGW) {
        int slot = 0; if (F.lane < 4) slot = 256 * tinfo[40 + EIDX[(size_t)t * 4 + F.lane]] + RANK[(size_t)t * 4 + F.lane];
        int sl[4]; sl[0] = __shfl(slot, 0); sl[1] = __shfl(slot, 1); sl[2] = __shfl(slot, 2); sl[3] = __shfl(slot, 3);
        float v[4][8]; float ss = 0.f;
#pragma unroll
        for (int j = 0; j < 4; ++j) { const int pz = F.lane + 64 * j; const f32x4 a = *(const f32x4*)(H2 + (size_t)t * DM + 8 * pz), b = *(const f32x4*)(H2 + (size_t)t * DM + 8 * pz + 4);
            v[j][0] = a.x; v[j][1] = a.y; v[j][2] = a.z; v[j][3] = a.w; v[j][4] = b.x; v[j][5] = b.y; v[j][6] = b.z; v[j][7] = b.w; }
#pragma unroll
        for (int k = 0; k < 4; ++k)
#pragma unroll
            for (int j = 0; j < 4; ++j) { const v2u q = *((const v2u*)((const unsigned char*)YR + (size_t)sl[k] * DM) + F.lane + 64 * j);
                const f32x2 a0 = __builtin_amdgcn_cvt_pk_f32_fp8((int)q.x, false), a1 = __builtin_amdgcn_cvt_pk_f32_fp8((int)q.x, true), a2 = __builtin_amdgcn_cvt_pk_f32_fp8((int)q.y, false), a3 = __builtin_amdgcn_cvt_pk_f32_fp8((int)q.y, true);
                v[j][0] += a0.x * 0.0625f; v[j][1] += a0.y * 0.0625f; v[j][2] += a1.x * 0.0625f; v[j][3] += a1.y * 0.0625f; v[j][4] += a2.x * 0.0625f; v[j][5] += a2.y * 0.0625f; v[j][6] += a3.x * 0.0625f; v[j][7] += a3.y * 0.0625f; }
#pragma unroll
        for (int j = 0; j < 4; ++j)
#pragma unroll
            for (int i = 0; i < 8; ++i) ss += v[j][i] * v[j][i];
        const float rstd = 1.0f / sqrtf(wave_sum(ss) * (1.0f / 2048.0f) + EPSF);
#pragma unroll
        for (int j = 0; j < 4; ++j) { const int pz = F.lane + 64 * j; const f32x4 w0 = *(const f32x4*)(F.final_norm_w + 8 * pz), w1 = *(const f32x4*)(F.final_norm_w + 8 * pz + 4);
            *(f32x4*)(F.out + (size_t)t * DM + 8 * pz) = (f32x4){v[j][0] * rstd * w0.x, v[j][1] * rstd * w0.y, v[j][2] * rstd * w0.z, v[j][3] * rstd * w0.w};
            *(f32x4*)(F.out + (size_t)t * DM + 8 * pz + 4) = (f32x4){v[j][4] * rstd * w1.x, v[j][5] * rstd * w1.y, v[j][6] * rstd * w1.z, v[j][7] * rstd * w1.w}; }
    }
}

struct Args { const float* in[21]; float* out; unsigned char* ws; int ph_lo, ph_hi, li, pad; };
__global__ void __launch_bounds__(NWAVES * 64, 2) hymba_fwd(Args args) {
    extern __shared__ __attribute__((aligned(16))) unsigned char lds[];
    Frame F;
    F.lds = (LAS unsigned char*)lds; F.MISC = (volatile LAS unsigned*)(F.lds + MISC_OFF);
    F.tid = threadIdx.x; F.lane = F.tid & 63; F.wave = __builtin_amdgcn_readfirstlane(F.tid >> 6); F.G = gridDim.x; F.bid = blockIdx.x;
    F.ws = args.ws; F.ctl = (gu32*)(args.ws + WS_CTL); F.out = args.out;
    F.x = args.in[0]; F.norm1_w = args.in[1]; F.w_in = args.in[2]; F.conv_w = args.in[3]; F.conv_b = args.in[4]; F.dt_bias = args.in[5]; F.a_log = args.in[6]; F.d_skip = args.in[7]; F.ssd_norm_w = args.in[8];
    F.i_bias = args.in[9]; F.f_bias = args.in[10]; F.ml_norm_w = args.in[11]; F.w_out = args.in[12]; F.norm2_w = args.in[13]; F.router_w = args.in[14]; F.router_b = args.in[15];
    F.w_gate_up = args.in[16]; F.b_gate_up = args.in[17]; F.w_down = args.in[18]; F.b_down = args.in[19]; F.final_norm_w = args.in[20];
    for (int u = F.tid; u < (LDS_BYTES - LDSCTL_OFF) / 4; u += NWAVES * 64) ((LAS unsigned*)(F.lds + LDSCTL_OFF))[u] = 0u;
    __syncthreads();
    XcdBarrier bar; bar.bar = (unsigned*)(F.ctl + CW_BAR) + args.li * XCD_BAR_WORDS; bar.x = 0; bar.st = nullptr;
    const bool use_bar = (args.ph_hi - args.ph_lo) > 1;
    if (use_bar) bar = xcd_barrier_post((unsigned*)(F.ctl + CW_BAR) + args.li * XCD_BAR_WORDS, F.MISC + 8);
    const int lo = args.ph_lo, hi = args.ph_hi;
#ifndef PHASE_MASK
#define PHASE_MASK 0x1ff
#endif
#define IN(k) (((PHASE_MASK >> (k)) & 1) && lo <= (k) && (k) < hi)
#define SEAM(k) do { if (IN(k) && IN((k) + 1)) xcd_barrier(bar); } while (0)
    if (IN(0)) { phase0(F); } SEAM(0);
    if (IN(1)) {
        pg8::Gemm g{(const pg8::bf16_t*)(F.ws + WS_XN1), (const pg8::bf16_t*)(F.ws + WS_WIN), TT, NPROJ, DM}; pg8::StaticOrder S; S.init(TT, NPROJ, F.G, F.bid);
        pg8::EpiBf16 E{(pg8::bf16_t*)(F.ws + WS_PROJ), NPROJ};
        pg8::gemm_phase<pg8::EpiBf16, pg8::StaticOrder, true, true>(F.lds, g, S, E);
        p1_small(F);
    } SEAM(1);
    if (IN(2)) { phase_conv(F); } SEAM(2);
    if (IN(3)) { phase_mixer(F); } SEAM(3);
    if (IN(4)) {
        pg8::Gemm g{(const pg8::bf16_t*)(F.ws + WS_YMIX), (const pg8::bf16_t*)(F.ws + WS_WOUT), TT, DM, 4096}; pg8::StaticOrder S; S.init(TT, DM, F.G, F.bid);
        pg8::EpiResNorm E{(float*)(F.ws + WS_H2), F.x, DM, (const float*)(F.ws + WS_SSQ), (PG8_LAS float*)(F.lds + RING_BYTES), EPSF};
        pg8::gemm_phase<pg8::EpiResNorm, pg8::StaticOrder, true, true>(F.lds, g, S, E);
    } SEAM(4);
    if (IN(5)) { phase5(F); } SEAM(5);
    if (IN(6)) {
        const int nM = build_moe_tab(F);
        const LAS int* tinfo = (const LAS int*)(F.lds + TAB_OFF + 320); LAS unsigned short* rt = (LAS unsigned short*)(F.lds + ROWTAB_OFF);
        pg8::Gemm g{(const pg8::bf16_t*)(F.ws + WS_XN2), (const pg8::bf16_t*)(F.ws + WS_WGU), nM * 256, 4096, DM};
        pg8::MoeOrder S{nM, 16, 4, nM * 16, F.G, F.bid, (const PG8_LAS unsigned char*)(F.lds + TAB_OFF), (const PG8_LAS unsigned short*)rt};
        { const int* TOKL = (const int*)(F.ws + WS_XG);
          for (int i = 0; i < 18; ++i) { pg8::Unit u; if (!S.next(i, u)) break; const int e = u.pn >> 4, rank = (u.pm - tinfo[40 + e]) * 256 + (F.tid & 255);
              if (F.tid < 256) rt[i * 256 + F.tid] = (unsigned short)(rank < tinfo[72 + e] ? TOKL[(size_t)e * TT + rank] : 0); }
          __syncthreads(); }
        pg8::EpiSwiglu E{(unsigned char*)(F.ws + WS_ACT), F.b_gate_up, (PG8_LAS float*)(F.lds + EPIV_OFF)};
        pg8::gemm_phase<pg8::EpiSwiglu, pg8::MoeOrder, true, true, true, true>(F.lds, g, S, E);
    } SEAM(6);
    if (IN(7)) {
        const int nM = build_moe_tab(F);
        pg8::Gemm g{(const pg8::bf16_t*)(F.ws + WS_ACT), (const pg8::bf16_t*)(F.ws + WS_WD), nM * 256, 2048, DM};
        pg8::MoeOrder S{nM, 8, 3, nM * 8, F.G, F.bid, (const PG8_LAS unsigned char*)(F.lds + TAB_OFF), nullptr};
        pg8::EpiDown E{(pg8::bf16_t*)(F.ws + WS_YR), F.b_down, (const float*)(F.ws + WS_XG + 4 * MiB), (const PG8_LAS int*)(F.lds + TAB_OFF + 320), (PG8_LAS float*)(F.lds + EPIV_OFF)};
        pg8::gemm_phase<pg8::EpiDown, pg8::MoeOrder, true, true, true>(F.lds, g, S, E);
    } SEAM(7);
    if (IN(8)) { phase8(F); }
#undef IN
#undef SEAM
}

extern "C" void kernel_launch(void* const* d_in, const int* in_sizes, int n_in, void* d_out, int out_size, void* d_ws, size_t ws_size, hipStream_t stream) {
    static int grid = 0;
    if (grid == 0) {
        if (n_in != 21 || out_size != TT * DM || ws_size < WS_END) { fprintf(stderr, "kernel_launch: unexpected problem (n_in %d, out %d, ws %zu); nothing launched\n", n_in, out_size, ws_size); grid = -1; return; }
        int dev = 0, cus = 0, per_cu = 0;
        if (hipGetDevice(&dev) != hipSuccess || hipDeviceGetAttribute(&cus, hipDeviceAttributeMultiprocessorCount, dev) != hipSuccess) { grid = -1; return; }
        if (hipFuncSetAttribute((const void*)hymba_fwd, hipFuncAttributeMaxDynamicSharedMemorySize, LDS_BYTES) != hipSuccess) { fprintf(stderr, "kernel_launch: hipFuncSetAttribute failed\n"); grid = -1; return; }
        if (hipOccupancyMaxActiveBlocksPerMultiprocessor(&per_cu, (const void*)hymba_fwd, NWAVES * 64, LDS_BYTES) != hipSuccess || per_cu < 1) { fprintf(stderr, "kernel_launch: occupancy query says %d blocks per CU\n", per_cu); }
        (void)hipGetLastError();
        grid = cus;
    }
    if (grid < 0) return;
    (void)hipMemsetAsync((char*)d_ws + WS_CTL, 0, CTL_ZERO_BYTES, stream);
    Args a{};
    for (int i = 0; i < 21; ++i) a.in[i] = (const float*)d_in[i];
    a.out = (float*)d_out; a.ws = (unsigned char*)d_ws; a.pad = 0;
#if MK_PER_PHASE
    for (int li = 0; li < N_PHASES; ++li) { a.ph_lo = li; a.ph_hi = li + 1; a.li = li; hipLaunchKernelGGL(hymba_fwd, dim3(grid), dim3(NWAVES * 64), LDS_BYTES, stream, a); }
#else
    a.ph_lo = 0; a.ph_hi = N_PHASES; a.li = 0;
    hipLaunchKernelGGL(hymba_fwd, dim3(grid), dim3(NWAVES * 64), LDS_BYTES, stream, a);
#endif
}
```

```cpp
#include <hip/hip_runtime.h>
#include <cstdio>
#include <cstdint>
namespace pg8 {
#define PG8_LAS __attribute__((address_space(3)))
typedef unsigned short bf16_t;
typedef short bf16x8 __attribute__((ext_vector_type(8)));
typedef float f32x4 __attribute__((ext_vector_type(4)));
typedef unsigned u32x4 __attribute__((ext_vector_type(4)));
constexpr int BM = 256, BK = 64, HALF = 128, HTB = HALF * BK * 2  , STAGE_BYTES = 8 * HTB, NXCD = 8, WGM = 8;

__host__ __device__ __forceinline__ int lds_byte(int r, int c) { const int st = (r >> 4) * 2 + (c >> 5), rr = r & 15, cc = c & 31, ob = rr * 64 + cc * 2; return st * 1024 + (ob ^ (((ob >> 9) & 1) << 5)); }
__host__ __device__ __forceinline__ void stage_rc(int b, int& R, int& C) { const int st = b / 1024, sb = b % 1024, swz = sb ^ (((sb >> 9) & 1) << 5); R = (st >> 1) * 16 + swz / 64; C = (st & 1) * 32 + (swz % 64) / 2; }
__host__ __device__ __forceinline__ int perm32(int rho) { const int n = rho >> 4, i = rho & 15; return 8 * (i >> 2) + 4 * n + (i & 3); }

struct Unit { int pm, pn, par; };
struct Gemm { const bf16_t* A; const bf16_t* Bt; int M, N, K; };

struct StaticOrder {
    int nM, nN, nwg, G, c;
    __host__ __device__ void init(int M, int N, int G_, int c_) { nM = M / BM; nN = N / BM; nwg = nM * nN; G = G_; c = c_; }
    __host__ __device__ bool next(int i, Unit& u) const {
        const long L = (long)i * G + c; if (L >= nwg) return false;
        int wgid = (int)L; { const int q = nwg / NXCD, r = nwg % NXCD, xcd = wgid % NXCD, off = wgid / NXCD; wgid = (xcd < r ? xcd * (q + 1) : r * (q + 1) + (xcd - r) * q) + off; }
        const int nig = WGM * nN, gid = wgid / nig, fm = gid * WGM, gsz = (nM - fm) < WGM ? (nM - fm) : WGM;
        u.pm = fm + ((wgid % nig) % gsz); u.pn = (wgid % nig) / gsz; return true;
    }
    __device__ __forceinline__ const PG8_LAS unsigned short* rowp(int) const { return nullptr; }
    __device__ __forceinline__ void a_ready(const Unit&) const {}
    __device__ __forceinline__ void done(const Unit&) const {}
};


__device__ __forceinline__ unsigned cvt_pk_bf16(float lo, float hi) { unsigned r; asm volatile("v_cvt_pk_bf16_f32 %0, %1, %2" : "=v"(r) : "v"(lo), "v"(hi)); return r; }
typedef unsigned u32x2 __attribute__((ext_vector_type(2)));

struct EpiBf16 {
    static constexpr bool PERM = true, AFTER_DRAIN = false;
    bf16_t* O; int ldc;
    __device__ __forceinline__ void operator()(const f32x4 (&acc)[2][2][4][2], const Unit& u, int wr, int wc, int fr, int fq) const {
        const int row0 = u.pm * BM + wr * 64 + fr; const int col0 = u.pn * BM + wc * 32 + 8 * fq;
#pragma unroll
        for (int ai = 0; ai < 2; ++ai)
#pragma unroll
            for (int m = 0; m < 4; ++m) { bf16_t* rowp = O + (size_t)(row0 + ai * HALF + m * 16) * ldc + col0;
#pragma unroll
                for (int bj = 0; bj < 2; ++bj) { const f32x4 v0 = acc[ai][bj][m][0], v1 = acc[ai][bj][m][1];
                    u32x4 w; w.x = cvt_pk_bf16(v0[0], v0[1]); w.y = cvt_pk_bf16(v0[2], v0[3]); w.z = cvt_pk_bf16(v1[0], v1[1]); w.w = cvt_pk_bf16(v1[2], v1[3]);
                    *(u32x4*)(rowp + bj * HALF) = w; } }
    }
};
struct EpiResNorm {
    static constexpr bool PERM = true, AFTER_DRAIN = false, KSCALE = true;
    bf16_t* C; const float* base; int ldc; const float* ssq; PG8_LAS float* tabl; float eps;
    __device__ __forceinline__ void build(const Unit& u, int tid) const {
        const int row = tid & 255, part = tid >> 8; const size_t t = (size_t)u.pm * BM + row; float rs[7];
        if (part == 0) { const f32x4* p = (const f32x4*)(ssq + t * 32);
#pragma unroll
            for (int g = 0; g < 4; ++g) { const f32x4 a = p[2 * g], b = p[2 * g + 1]; rs[g] = 1.0f / sqrtf(((a.x + a.y) + (a.z + a.w) + (b.x + b.y) + (b.z + b.w)) * (1.0f / 512.0f) + eps); }
            const f32x4* q = (const f32x4*)(ssq + (size_t)16384 * 32 + t * 32);
#pragma unroll
            for (int h = 0; h < 3; ++h) { const f32x4 a = q[h]; rs[4 + h] = 1.0f / sqrtf(((a.x + a.y) + (a.z + a.w)) * (1.0f / 256.0f) + eps); }
        } else { const f32x4* q = (const f32x4*)(ssq + (size_t)16384 * 32 + t * 32);
#pragma unroll
            for (int h = 0; h < 6; ++h) { const f32x4 a = q[2 + h]; rs[h] = 1.0f / sqrtf(((a.x + a.y) + (a.z + a.w)) * (1.0f / 256.0f) + eps); }
            rs[6] = 1.0f; }
        PG8_LAS float* d = tabl + row * 12 + 6 * part;
#pragma unroll
        for (int s = 0; s < 6; ++s) d[s] = (part == 1 && s == 5) ? rs[5] : rs[s] / rs[s + 1];
    }
    __device__ __forceinline__ void kscale(f32x4 (&acc)[2][2][4][2], int t, int nt, int wr, int fr) const {
        const int kt = t + 1; const bool segend = kt < 32 ? ((kt & 7) == 7) : ((kt & 3) == 3);
        if (segend && kt != nt - 1) { const int sg = kt < 32 ? (kt >> 3) : 4 + ((kt - 32) >> 2);
#pragma unroll
            for (int ai = 0; ai < 2; ++ai)
#pragma unroll
                for (int m = 0; m < 4; ++m) { const float r = tabl[(ai * HALF + wr * 64 + m * 16 + fr) * 12 + sg];
#pragma unroll
                    for (int bj = 0; bj < 2; ++bj)
#pragma unroll
                        for (int n = 0; n < 2; ++n) acc[ai][bj][m][n] = acc[ai][bj][m][n] * r; } }
    }
    __device__ __forceinline__ void operator()(const f32x4 (&acc)[2][2][4][2], const Unit& u, int wr, int wc, int fr, int fq) const {
        const int row0 = u.pm * BM + wr * 64 + fr, col0 = u.pn * BM + wc * 32 + 8 * fq;
#pragma unroll
        for (int ai = 0; ai < 2; ++ai)
#pragma unroll
            for (int m = 0; m < 4; ++m) { const size_t off = (size_t)(row0 + ai * HALF + m * 16) * ldc + col0; const float r = tabl[(ai * HALF + wr * 64 + m * 16 + fr) * 12 + 11];
#pragma unroll
                for (int bj = 0; bj < 2; ++bj) { const f32x4 v0 = acc[ai][bj][m][0] * r + *(const f32x4*)(base + off + bj * HALF), v1 = acc[ai][bj][m][1] * r + *(const f32x4*)(base + off + bj * HALF + 4);
                    u32x4 w; w.x = cvt_pk_bf16(v0[0], v0[1]); w.y = cvt_pk_bf16(v0[2], v0[3]); w.z = cvt_pk_bf16(v1[0], v1[1]); w.w = cvt_pk_bf16(v1[2], v1[3]);
                    *(u32x4*)(C + off + bj * HALF) = w; } }
    }
};
struct EpiResF32 {
    static constexpr bool PERM = false, AFTER_DRAIN = false;
    float* C; const float* base; int ldc;
    __device__ __forceinline__ void operator()(const f32x4 (&acc)[2][2][4][2], const Unit& u, int wr, int wc, int fr, int fq) const {
        const int row0 = u.pm * BM + wr * 64 + fr, col0 = u.pn * BM + wc * 32 + 4 * fq;
#pragma unroll
        for (int ai = 0; ai < 2; ++ai)
#pragma unroll
            for (int m = 0; m < 4; ++m) { const size_t off = (size_t)(row0 + ai * HALF + m * 16) * ldc + col0;
#pragma unroll
                for (int bj = 0; bj < 2; ++bj)
#pragma unroll
                    for (int n = 0; n < 2; ++n) *(f32x4*)(C + off + bj * HALF + n * 16) = acc[ai][bj][m][n] + *(const f32x4*)(base + off + bj * HALF + n * 16); }
    }
};
__device__ __forceinline__ float swiglu1(float a, float b) {
    const float glu = fminf(a, 7.0f), lin = fminf(fmaxf(b, -7.0f), 7.0f);
    return glu * __builtin_amdgcn_rcpf(1.0f + __expf(-1.702f * glu)) * (lin + 1.0f);
}
struct EpiSwiglu {
    static constexpr bool PERM = true, AFTER_DRAIN = false, PREFETCH = true;
    unsigned char* O; const float* bias; PG8_LAS float* slot;
    __device__ __forceinline__ void prefetch(const Unit& u, int wid, int lane) const {
        if (wid == 0) { const int e = u.pn >> 4, pnl = u.pn & 15;
            __builtin_amdgcn_global_load_lds((const unsigned*)(bias + (size_t)e * 4096 + pnl * BM + 4 * lane), (PG8_LAS unsigned*)(slot + u.par * 256), 16, 0, 0); }
    }
    __device__ __forceinline__ void operator()(const f32x4 (&acc)[2][2][4][2], const Unit& u, int wr, int wc, int fr, int fq) const {
        const int pnl = u.pn & 15;
        const int row0 = u.pm * BM + wr * 64 + fr; const int hcol0 = pnl * BM + wc * 32 + 8 * fq;
        const PG8_LAS float* bp = slot + u.par * 256 + wc * 32 + 8 * fq;
        f32x4 bv[2][2];
#pragma unroll
        for (int bj = 0; bj < 2; ++bj)
#pragma unroll
            for (int n = 0; n < 2; ++n) bv[bj][n] = *(const PG8_LAS f32x4*)(bp + bj * HALF + 4 * n);
#pragma unroll
        for (int ai = 0; ai < 2; ++ai)
#pragma unroll
            for (int m = 0; m < 4; ++m) { unsigned char* rowp = O + (size_t)(row0 + ai * HALF + m * 16) * 2048 + (hcol0 >> 1);
#pragma unroll
                for (int bj = 0; bj < 2; ++bj) { const f32x4 v0 = acc[ai][bj][m][0] + bv[bj][0], v1 = acc[ai][bj][m][1] + bv[bj][1];
                    int w = __builtin_amdgcn_cvt_pk_fp8_f32(swiglu1(v0[0], v0[1]), swiglu1(v0[2], v0[3]), 0, false);
                    w = __builtin_amdgcn_cvt_pk_fp8_f32(swiglu1(v1[0], v1[1]), swiglu1(v1[2], v1[3]), w, true);
                    *(int*)(rowp + bj * 64) = w; } }
    }
};
struct EpiDown {
    static constexpr bool PERM = true, AFTER_DRAIN = false, PREFETCH = true;
    bf16_t* O; const float* bias; const float* gatel; const PG8_LAS int* tinfo; PG8_LAS float* slot;
    __device__ __forceinline__ void prefetch(const Unit& u, int wid, int lane) const {
        const int e = u.pn >> 3, pnl = u.pn & 7;
        if (wid == 0) __builtin_amdgcn_global_load_lds((const unsigned*)(bias + (size_t)e * 2048 + pnl * BM + 4 * lane), (PG8_LAS unsigned*)(slot + u.par * 512), 16, 0, 0);
        if (wid == 1) __builtin_amdgcn_global_load_lds((const unsigned*)(gatel + (size_t)e * 16384 + (size_t)(u.pm - tinfo[40 + e]) * BM + 4 * lane), (PG8_LAS unsigned*)(slot + u.par * 512 + 256), 16, 0, 0);
    }
    __device__ __forceinline__ void operator()(const f32x4 (&acc)[2][2][4][2], const Unit& u, int wr, int wc, int fr, int fq) const {
        const int pnl = u.pn & 7;
        const int row0 = u.pm * BM + wr * 64 + fr; const int col0 = pnl * BM + wc * 32 + 8 * fq;
        const PG8_LAS float* bp = slot + u.par * 512 + wc * 32 + 8 * fq; const PG8_LAS float* gp = slot + u.par * 512 + 256 + wr * 64 + fr;
        f32x4 bv[2][2];
#pragma unroll
        for (int bj = 0; bj < 2; ++bj)
#pragma unroll
            for (int n = 0; n < 2; ++n) bv[bj][n] = *(const PG8_LAS f32x4*)(bp + bj * HALF + 4 * n);
#pragma unroll
        for (int ai = 0; ai < 2; ++ai)
#pragma unroll
            for (int m = 0; m < 4; ++m) { const int row = row0 + ai * HALF + m * 16; const float gt = gp[ai * HALF + m * 16] * 16.0f; unsigned char* rowp = (unsigned char*)O + (size_t)row * 2048 + col0;
#pragma unroll
                for (int bj = 0; bj < 2; ++bj) { const f32x4 v0 = (acc[ai][bj][m][0] + bv[bj][0]) * gt, v1 = (acc[ai][bj][m][1] + bv[bj][1]) * gt;
                    int w0 = __builtin_amdgcn_cvt_pk_fp8_f32(v0[0], v0[1], 0, false); w0 = __builtin_amdgcn_cvt_pk_fp8_f32(v0[2], v0[3], w0, true);
                    int w1 = __builtin_amdgcn_cvt_pk_fp8_f32(v1[0], v1[1], 0, false); w1 = __builtin_amdgcn_cvt_pk_fp8_f32(v1[2], v1[3], w1, true);
                    *(u32x2*)(rowp + bj * HALF) = (u32x2){(unsigned)w0, (unsigned)w1}; } }
    }
};
struct MoeOrder {
    int nM, nN, nsh, nwg, G, c; const PG8_LAS unsigned char* tab; const PG8_LAS unsigned short* rt;
    __device__ __forceinline__ const PG8_LAS unsigned short* rowp(int ui) const { return rt + ui * 256; }
    __device__ __forceinline__ bool next(int i, Unit& u) const {
        const long L = (long)i * G + c; if (L >= nwg) return false;
        int wgid = (int)L; { const int q = nwg / NXCD, r = nwg % NXCD, xcd = wgid % NXCD, off = wgid / NXCD; wgid = (xcd < r ? xcd * (q + 1) : r * (q + 1) + (xcd - r) * q) + off; }
        const int nig = WGM * nN, gid = wgid / nig, fm = gid * WGM, gsz = (nM - fm) < WGM ? (nM - fm) : WGM;
        const int pm = fm + ((wgid % nig) % gsz), pnl = (wgid % nig) / gsz;
        u.pm = pm; u.pn = ((int)tab[pm] << nsh) + pnl; return true;
    }
    __device__ __forceinline__ void a_ready(const Unit&) const {}
    __device__ __forceinline__ void done(const Unit&) const {}
};
template <class E, class = void> struct epi_pref { static constexpr bool value = false; };
template <class E> struct epi_pref<E, decltype((void)E::PREFETCH)> { static constexpr bool value = E::PREFETCH; };
template <class E, class = void> struct epi_kscale { static constexpr bool value = false; };
template <class E> struct epi_kscale<E, decltype((void)E::KSCALE)> { static constexpr bool value = E::KSCALE; };
typedef int v8i32 __attribute__((ext_vector_type(8)));
__device__ __forceinline__ v8i32 pg8_cat(const bf16x8 lo, const bf16x8 hi) { typedef int v4i32 __attribute__((ext_vector_type(4))); const v4i32 a = __builtin_bit_cast(v4i32, lo), b = __builtin_bit_cast(v4i32, hi); return __builtin_shufflevector(a, b, 0, 1, 2, 3, 4, 5, 6, 7); }
template <class Epi, class Sched, bool ALIGN_EPI = false, bool SP2 = false, bool F8 = false, bool GA = false>
__device__ __forceinline__ void gemm_phase(PG8_LAS unsigned char* lds, const Gemm g, const Sched& S, const Epi& E) {
    const int tid = threadIdx.x, wid = __builtin_amdgcn_readfirstlane(tid >> 6), lane = tid & 63, wr = wid >> 2, wc = wid & 3, fr = lane & 15, fq = lane >> 4;
    const int K = g.K, KB = F8 ? K : 2 * K, nt = KB / 128;
    unsigned voffA[2], voffB[2]; int gaR[2]; unsigned gaC[2]; static_assert(!GA || SP2, "gathered A needs the SP2 loop");
#pragma unroll
    for (int i = 0; i < 2; ++i) { int R, C; stage_rc(tid * 16 + i * 8192, R, C); const int Rb = Epi::PERM ? ((R & ~31) + perm32(R & 31)) : R;
        voffA[i] = (unsigned)(R * KB + C * 2); voffB[i] = (unsigned)(Rb * KB + C * 2); gaR[i] = R; gaC[i] = (unsigned)(C * 2); }
    const size_t kstep = (size_t)(BK * 2);
    const size_t hstep = (size_t)HALF * KB;
    const size_t tstep = 2 * hstep;
    const unsigned ldsw = (unsigned)wid * 1024u;
    int aoffk[2], boffk[2];
#pragma unroll
    for (int h = 0; h < 2; ++h) { aoffk[h] = lds_byte(wr * 64 + fr, fq * 8) + h * 1024; boffk[h] = lds_byte(wc * 32 + fr, fq * 8) + h * 1024; }
#define PG8_SA(b, h) (((b) * 2 + (h)) * HTB)
#define PG8_SB(b, h) ((4 + (b) * 2 + (h)) * HTB)
#define PG8_STAGE(bufoff, gbase, voff) do { _Pragma("unroll") for (int _i = 0; _i < 2; ++_i) \
        __builtin_amdgcn_global_load_lds((const unsigned*)((const char*)(gbase) + (voff)[_i]), (PG8_LAS unsigned*)(lds + (bufoff) + ldsw + _i * 8192), 16, 0, 0); } while (0)
#define PG8_STAGE_A(bufoff, kptr, h, usenext) do { if constexpr (GA) { _Pragma("unroll") for (int _i = 0; _i < 2; ++_i) { const unsigned _o = (usenext) ? gn[h][_i] : gc[h][_i]; \
            __builtin_amdgcn_global_load_lds((const unsigned*)((const char*)(kptr) + _o), (PG8_LAS unsigned*)(lds + (bufoff) + ldsw + _i * 8192), 16, 0, 0); } } \
        else { PG8_STAGE(bufoff, (kptr) + (h) * hstep, voffA); } } while (0)
#define PG8_GROWS(dst, ui_) do { const PG8_LAS unsigned short* _rt = S.rowp(ui_); _Pragma("unroll") for (int _h = 0; _h < 2; ++_h) _Pragma("unroll") for (int _i = 0; _i < 2; ++_i) dst[_h][_i] = (unsigned)_rt[gaR[_i] + 128 * _h] * (unsigned)KB + gaC[_i]; } while (0)
#define PG8_LDA(dst, b, h) do { if constexpr (F8) { _Pragma("unroll") for (int m = 0; m < 4; ++m) dst##8[m] = pg8_cat(*(const PG8_LAS bf16x8*)(lds + PG8_SA(b, h) + aoffk[0] + m * 2048), *(const PG8_LAS bf16x8*)(lds + PG8_SA(b, h) + aoffk[1] + m * 2048)); } \
        else { _Pragma("unroll") for (int m = 0; m < 4; ++m) _Pragma("unroll") for (int k = 0; k < 2; ++k) dst[m][k] = *(const PG8_LAS bf16x8*)(lds + PG8_SA(b, h) + aoffk[k] + m * 2048); } } while (0)
#define PG8_LDB(dst, b, h) do { if constexpr (F8) { _Pragma("unroll") for (int n = 0; n < 2; ++n) dst##8[n] = pg8_cat(*(const PG8_LAS bf16x8*)(lds + PG8_SB(b, h) + boffk[0] + n * 2048), *(const PG8_LAS bf16x8*)(lds + PG8_SB(b, h) + boffk[1] + n * 2048)); } \
        else { _Pragma("unroll") for (int n = 0; n < 2; ++n) _Pragma("unroll") for (int k = 0; k < 2; ++k) dst[n][k] = *(const PG8_LAS bf16x8*)(lds + PG8_SB(b, h) + boffk[k] + n * 2048); } } while (0)
#define PG8_MMA(ai, bj, At, Bt) do { __builtin_amdgcn_s_setprio(1); \
        if constexpr (F8) { _Pragma("unroll") for (int m = 0; m < 4; ++m) _Pragma("unroll") for (int n = 0; n < 2; ++n) \
            asm volatile("v_mfma_scale_f32_16x16x128_f8f6f4 %0, %1, %2, %0, %3, %4 op_sel_hi:[0,0,0]" : "+v"(acc[ai][bj][m][n]) : "v"(Bt##8[n]), "v"(At##8[m]), "v"(sc_w), "v"(sc_a)); } \
        else { _Pragma("unroll") for (int m = 0; m < 4; ++m) _Pragma("unroll") for (int n = 0; n < 2; ++n) _Pragma("unroll") for (int k = 0; k < 2; ++k) \
            acc[ai][bj][m][n] = __builtin_amdgcn_mfma_f32_16x16x32_bf16(Bt[n][k], At[m][k], acc[ai][bj][m][n], 0, 0, 0); } \
        __builtin_amdgcn_s_setprio(0); } while (0)
#define PG8_WAIT_V(n) asm volatile("s_waitcnt vmcnt(" #n ")" ::: "memory")
#define PG8_WAIT_L(n) asm volatile("s_waitcnt lgkmcnt(" #n ")" ::: "memory")
#define PG8_BAR __builtin_amdgcn_s_barrier()
#define PG8_SCHED __builtin_amdgcn_sched_barrier(0)
    Unit cur, nxt; int ui = 0;
    if (!S.next(0, cur)) return;
    cur.par = 0;
    f32x4 acc[2][2][4][2];
#pragma unroll
    for (int a = 0; a < 2; ++a)
#pragma unroll
        for (int b = 0; b < 2; ++b)
#pragma unroll
            for (int m = 0; m < 4; ++m)
#pragma unroll
                for (int n = 0; n < 2; ++n) acc[a][b][m][n] = (f32x4){0.f, 0.f, 0.f, 0.f};
    const int sc_w = 0x79797979, sc_a = 0x7f7f7f7f;
    bf16x8 At[4][2], B0[2][2], B1[2][2]; v8i32 At8[4], B08[2], B18[2];
    const char* cA = (const char*)g.A + (GA ? (size_t)0 : (size_t)cur.pm * tstep); const char* cB = (const char*)g.Bt + (size_t)cur.pn * tstep;
    unsigned gc[2][2] = {{0u, 0u}, {0u, 0u}}, gn[2][2] = {{0u, 0u}, {0u, 0u}};
    if constexpr (GA) { PG8_GROWS(gc, 0); }
    if constexpr (epi_kscale<Epi>::value) { E.build(cur, tid); asm volatile("s_waitcnt lgkmcnt(0)" ::: "memory"); PG8_BAR; asm volatile("" ::: "memory"); }
    S.a_ready(cur);
    if constexpr (SP2) {
        PG8_STAGE(PG8_SB(0, 0), cB, voffB); PG8_STAGE(PG8_SB(0, 1), cB + hstep, voffB); PG8_STAGE_A(PG8_SA(0, 0), cA, 0, false); PG8_STAGE_A(PG8_SA(0, 1), cA, 1, false);
        if (wr == 1) PG8_BAR;
        PG8_WAIT_V(2); PG8_BAR;
        PG8_STAGE(PG8_SB(1, 0), cB + kstep, voffB); PG8_STAGE_A(PG8_SA(1, 0), cA + kstep, 0, false); PG8_STAGE(PG8_SB(1, 1), cB + hstep + kstep, voffB);
        PG8_WAIT_V(6); PG8_BAR;
    } else {
        PG8_STAGE(PG8_SB(0, 0), cB, voffB); PG8_STAGE(PG8_SA(0, 0), cA, voffA); PG8_STAGE(PG8_SB(0, 1), cB + hstep, voffB); PG8_STAGE(PG8_SA(0, 1), cA + hstep, voffA);
        if (wr == 1) PG8_BAR;
        PG8_WAIT_V(4); PG8_BAR;
        PG8_STAGE(PG8_SB(1, 0), cB + kstep, voffB); PG8_STAGE(PG8_SA(1, 0), cA + kstep, voffA); PG8_STAGE(PG8_SB(1, 1), cB + hstep + kstep, voffB);
        PG8_WAIT_V(6); PG8_BAR;
    }
    for (;;) {
        const bool has_next = S.next(ui + 1, nxt); nxt.par = (ui + 1) & 1;
        const char* nA = (has_next && !GA) ? (const char*)g.A + (size_t)nxt.pm * tstep : cA; const char* nB = has_next ? (const char*)g.Bt + (size_t)nxt.pn * tstep : cB;
        if constexpr (GA) { if (has_next) { PG8_GROWS(gn, ui + 1); } else {
#pragma unroll
            for (int _h = 0; _h < 2; ++_h) { gn[_h][0] = gc[_h][0]; gn[_h][1] = gc[_h][1]; } } }
        for (int t = 0; t < nt; t += 2) {
            const bool last = (t == nt - 2);
            const char* a1 = cA + (size_t)(t + 1) * kstep;
            const char* a2 = last ? nA : cA + (size_t)(t + 2) * kstep; const char* b2 = last ? nB : cB + (size_t)(t + 2) * kstep;
            const char* a3 = a2 + kstep; const char* b3 = b2 + kstep;
            if (last && has_next) S.a_ready(nxt);
            if constexpr (epi_pref<Epi>::value) { if (t == 0) E.prefetch(cur, wid, lane); }
            if constexpr (SP2) {
            PG8_LDB(B0, 0, 0); PG8_LDB(B1, 0, 1); PG8_SCHED; PG8_LDA(At, 0, 0); PG8_STAGE_A(PG8_SA(1, 1), a1, 1, false);
            PG8_WAIT_V(8); PG8_WAIT_L(0); PG8_BAR; PG8_MMA(0, 0, At, B0); PG8_MMA(0, 1, At, B1); PG8_BAR; PG8_SCHED;
            PG8_LDA(At, 0, 1); PG8_STAGE(PG8_SB(0, 0), b2, voffB); PG8_STAGE(PG8_SB(0, 1), b2 + hstep, voffB); PG8_STAGE_A(PG8_SA(0, 0), a2, 0, last);
            PG8_WAIT_V(8); PG8_WAIT_L(0); PG8_BAR; PG8_MMA(1, 0, At, B0); PG8_MMA(1, 1, At, B1); PG8_BAR; PG8_SCHED;
            PG8_LDB(B0, 1, 0); PG8_LDB(B1, 1, 1); PG8_SCHED; PG8_LDA(At, 1, 0); PG8_STAGE_A(PG8_SA(0, 1), a2, 1, last);
            PG8_WAIT_V(8); PG8_WAIT_L(0); PG8_BAR; PG8_MMA(0, 0, At, B0); PG8_MMA(0, 1, At, B1); PG8_BAR; PG8_SCHED;
            PG8_LDA(At, 1, 1); PG8_STAGE(PG8_SB(1, 0), b3, voffB); PG8_STAGE(PG8_SB(1, 1), b3 + hstep, voffB); PG8_STAGE_A(PG8_SA(1, 0), a3, 0, last);
            PG8_WAIT_V(8); PG8_WAIT_L(0); PG8_BAR; PG8_MMA(1, 0, At, B0); PG8_MMA(1, 1, At, B1); PG8_BAR; PG8_SCHED;
            if constexpr (epi_kscale<Epi>::value) { E.kscale(acc, t, nt, wr, fr); PG8_SCHED; }
            } else {
            PG8_LDB(B0, 0, 0); PG8_SCHED; PG8_LDA(At, 0, 0); PG8_STAGE(PG8_SA(1, 1), a1 + hstep, voffA);
            PG8_WAIT_L(8); PG8_BAR; PG8_WAIT_L(0); PG8_MMA(0, 0, At, B0); PG8_BAR; PG8_SCHED;
            PG8_LDB(B1, 0, 1); PG8_STAGE(PG8_SB(0, 0), b2, voffB);
            PG8_BAR; PG8_WAIT_L(0); PG8_MMA(0, 1, At, B1); PG8_BAR;
            PG8_LDA(At, 0, 1); PG8_STAGE(PG8_SA(0, 0), a2, voffA);
            PG8_BAR; PG8_WAIT_L(0); PG8_MMA(1, 0, At, B0); PG8_BAR; PG8_SCHED;
            PG8_STAGE(PG8_SB(0, 1), b2 + hstep, voffB);
            PG8_WAIT_V(6); PG8_BAR; PG8_MMA(1, 1, At, B1); PG8_BAR;
            PG8_LDB(B0, 1, 0); PG8_SCHED; PG8_LDA(At, 1, 0); PG8_STAGE(PG8_SA(0, 1), a2 + hstep, voffA);
            PG8_WAIT_L(8); PG8_BAR; PG8_WAIT_L(0); PG8_MMA(0, 0, At, B0); PG8_BAR; PG8_SCHED;
            PG8_LDB(B1, 1, 1); PG8_STAGE(PG8_SB(1, 0), b3, voffB);
            PG8_BAR; PG8_WAIT_L(0); PG8_MMA(0, 1, At, B1); PG8_BAR;
            PG8_LDA(At, 1, 1); PG8_STAGE(PG8_SA(1, 0), a3, voffA);
            PG8_BAR; PG8_WAIT_L(0); PG8_MMA(1, 0, At, B0); PG8_BAR; PG8_SCHED;
            PG8_STAGE(PG8_SB(1, 1), b3 + hstep, voffB);
            PG8_WAIT_V(6); PG8_BAR; PG8_MMA(1, 1, At, B1); PG8_BAR;
            }
        }
        if constexpr (ALIGN_EPI) { if (wr == 0) PG8_BAR; }
        if constexpr (F8) asm volatile("s_nop 15\n\ts_nop 15" ::: "memory");
        if constexpr (!Epi::AFTER_DRAIN) { E(acc, cur, wr, wc, fr, fq); S.done(cur); }
        if (!has_next) break;
#pragma unroll
        for (int a = 0; a < 2; ++a)
#pragma unroll
            for (int b = 0; b < 2; ++b)
#pragma unroll
                for (int m = 0; m < 4; ++m)
#pragma unroll
                    for (int n = 0; n < 2; ++n) acc[a][b][m][n] = (f32x4){0.f, 0.f, 0.f, 0.f};
        if constexpr (epi_kscale<Epi>::value) { static_assert(!epi_kscale<Epi>::value || (ALIGN_EPI && SP2), "K-segment rescale needs aligned epilogues");
            asm volatile("s_waitcnt lgkmcnt(0)" ::: "memory"); PG8_BAR; asm volatile("" ::: "memory");
            E.build(nxt, tid); asm volatile("s_waitcnt lgkmcnt(0)" ::: "memory"); PG8_BAR; asm volatile("" ::: "memory"); }
        cur = nxt; cA = nA; cB = nB; ++ui;
        if constexpr (GA) {
#pragma unroll
            for (int _h = 0; _h < 2; ++_h) { gc[_h][0] = gn[_h][0]; gc[_h][1] = gn[_h][1]; } }
        if constexpr (ALIGN_EPI) { if (wr == 1) PG8_BAR; }
    }
    PG8_WAIT_V(0);
    if constexpr (!ALIGN_EPI) { if (wr == 0) PG8_BAR; }
    PG8_BAR;
    if constexpr (Epi::AFTER_DRAIN) { E.fused(acc, cur, wr, wc, fr, fq, lds, wid, lane); S.done(cur); }
#undef PG8_SA
#undef PG8_SB
#undef PG8_STAGE
#undef PG8_STAGE_A
#undef PG8_GROWS
#undef PG8_LDA
#undef PG8_LDB
#undef PG8_MMA
#undef PG8_WAIT_V
#undef PG8_WAIT_L
#undef PG8_BAR
#undef PG8_SCHED
}
}

constexpr int NWAVES = 8;
constexpr int TT = 16384, DM = 2048, SEQ = 2048;
constexpr int NPROJ = 11264;
constexpr int PC_Z = 0, PC_XBC = 2048, PC_Q = 5120, PC_K = 6144, PC_V = 7168, PC_O = 9216;
constexpr int WIN_LD = 11312;
constexpr int NSLOT = 65536 + 32 * 256;
constexpr float EPSF = 1e-5f;
#ifndef HSYNC_ON
#define HSYNC_ON 0
#endif
#define HWAIT() do { if (HSYNC_ON) asm volatile("s_waitcnt vmcnt(0) lgkmcnt(0)\n\ts_nop 15\n\ts_nop 15" ::: "memory"); } while (0)
#define HSYNC() do { if (HSYNC_ON) { HWAIT(); __syncthreads(); } } while (0)
#ifndef MK_PER_PHASE
#define MK_PER_PHASE 0
#endif
constexpr int N_PHASES = 9;

constexpr size_t MiB = 1u << 20;
constexpr size_t WS_CTL = 0, CTL_ZERO_BYTES = 1 * MiB;
constexpr size_t WS_WIN = 2 * MiB, WS_WSM = 46 * MiB, WS_WRT = 47 * MiB, WS_WOUT = 48 * MiB, WS_WGU = 64 * MiB, WS_WD = 576 * MiB;
constexpr size_t WS_XN1 = 832 * MiB, WS_PROJ = 896 * MiB, WS_SMALL = 1248 * MiB, WS_SSQ = 1252 * MiB, WS_YMIX = 1256 * MiB, WS_H2 = 1384 * MiB, WS_XN2 = 1512 * MiB;
constexpr size_t WS_ROUTE = 1576 * MiB, WS_XG = 1578 * MiB, WS_ACT = 1866 * MiB, WS_YR = 2154 * MiB, WS_XC = 2442 * MiB, WS_END = 2538 * MiB;
constexpr int CW_BAR = 4096;
constexpr int CW_CNT = 65536;

constexpr int RING_BYTES = 131072;
constexpr int LDS_BYTES = 147456;
constexpr int LDSCTL_OFF = LDS_BYTES - 1024, MISC_OFF = LDSCTL_OFF;
constexpr int TAB_OFF = LDSCTL_OFF + 64;
constexpr int EPIV_OFF = RING_BYTES + 9216;
constexpr int ROWTAB_OFF = RING_BYTES;

#define GAS __attribute__((address_space(1)))
#define LAS __attribute__((address_space(3)))
typedef unsigned short bf16;
typedef unsigned v4u __attribute__((ext_vector_type(4)));
typedef unsigned v2u __attribute__((ext_vector_type(2)));
typedef float f32x4 __attribute__((ext_vector_type(4)));
typedef float f32x2 __attribute__((ext_vector_type(2)));
typedef short bf16x8 __attribute__((ext_vector_type(8)));
typedef GAS unsigned gu32;
#define RLX_AGENT __ATOMIC_RELAXED, __HIP_MEMORY_SCOPE_AGENT
#define LDS_WAIT() asm volatile("s_waitcnt lgkmcnt(0)" ::: "memory")
#define VM_WAIT() asm volatile("s_waitcnt vmcnt(0)" ::: "memory")
__device__ __forceinline__ unsigned f2bf(float f) { unsigned u = __builtin_bit_cast(unsigned, f); return (u + 0x7fffu + ((u >> 16) & 1u)) >> 16; }
__device__ __forceinline__ unsigned pk2(float lo, float hi) { return f2bf(lo) | (f2bf(hi) << 16); }
__device__ __forceinline__ float bflo(unsigned w) { return __builtin_bit_cast(float, w << 16); }
__device__ __forceinline__ float bfhi(unsigned w) { return __builtin_bit_cast(float, w & 0xffff0000u); }
__device__ __forceinline__ float wave_sum(float v) {
#pragma unroll
    for (int o = 1; o < 64; o <<= 1) v += __shfl_xor(v, o);
    return v;
}
__device__ __forceinline__ float softplusf(float x) { return x > 20.f ? x : log1pf(expf(x)); }
__device__ __forceinline__ float logsigf(float x) { return fminf(x, 0.f) - log1pf(expf(-fabsf(x))); }
__device__ __forceinline__ float siluf(float v) { return v * __builtin_amdgcn_rcpf(1.0f + __expf(-v)); }

#define XB_TMO      128
#define XB_XCNT(j)  (256  + 64 * (j))
#define XB_XSUB(j)  (1280 + 64 * (j))
#define XB_XGEN(j)  (2304 + 64 * (j))
#define XB_TOP      3328
#define XB_TOPGEN   3392
#define XCD_BAR_WORDS 3456
#define XB_SPIN_CAP (1u << 18)

__device__ __forceinline__ unsigned xb_ld(unsigned* p)              { return __hip_atomic_load(p, __ATOMIC_RELAXED, __HIP_MEMORY_SCOPE_AGENT); }
__device__ __forceinline__ unsigned xb_add(unsigned* p, unsigned v) { return __hip_atomic_fetch_add(p, v, __ATOMIC_RELAXED, __HIP_MEMORY_SCOPE_AGENT); }
__device__ __forceinline__ unsigned xb_xcc_id() { return (unsigned)__builtin_amdgcn_s_getreg((3 << 11) | 20) & 0xFu; }
#define XB_SPIN(cond, bar) do { unsigned _sp = 0; while (cond) { __builtin_amdgcn_s_sleep(1); \
    if ((++_sp & 255u) == 0u) { if (xb_ld(&(bar)[XB_TMO])) break; if (_sp > XB_SPIN_CAP) { atomicAdd(&(bar)[XB_TMO], 1u); break; } } } } while (0)

struct XcdBarrier {
    unsigned* bar; unsigned x;
    volatile LAS unsigned* st;
};

__device__ __forceinline__ XcdBarrier xcd_barrier_post(unsigned* bar, volatile LAS unsigned* st) {
    XcdBarrier b; b.bar = bar; b.x = xb_xcc_id(); b.st = st;
    if (threadIdx.x == 0) (void)xb_add(&bar[XB_XCNT(b.x)], 1u);
    return b;
}
__device__ __forceinline__ void xcd_barrier_complete(unsigned* bar, unsigned x, unsigned& nloc, unsigned& nx) {
    const unsigned G = gridDim.x * gridDim.y * gridDim.z;
    unsigned sum, cnt, mine, sp = 0u;
    for (;;) {
        sum = 0u; cnt = 0u; mine = 0u;
#pragma unroll
        for (unsigned j = 0; j < 16; ++j) { const unsigned c = xb_ld(&bar[XB_XCNT(j)]); sum += c; cnt += (c > 0u) ? 1u : 0u; mine = (j == x) ? c : mine; }
        if (sum == G) break;
        __builtin_amdgcn_s_sleep(1);
        if ((++sp & 255u) == 0u) { if (xb_ld(&bar[XB_TMO])) break; if (sp > XB_SPIN_CAP) { atomicAdd(&bar[XB_TMO], 1u); break; } }
    }
    nloc = mine > 0u ? mine : 1u; nx = cnt > 0u ? cnt : 1u;
}

__device__ __forceinline__ void xcd_barrier(const XcdBarrier& b) {
    asm volatile("s_waitcnt vmcnt(0)" ::: "memory");
    __syncthreads();
    if (threadIdx.x == 0) {
        unsigned* bar = b.bar;
        __builtin_amdgcn_s_waitcnt(0);
        unsigned nloc = b.st[0], nx = b.st[1];
        if (nloc == 0u) { xcd_barrier_complete(bar, b.x, nloc, nx); b.st[0] = nloc; b.st[1] = nx; }
        const unsigned old = xb_add(&bar[XB_XSUB(b.x)], 1u);
        const unsigned gen = old / nloc;
        if (old + 1u == (gen + 1u) * nloc) {
            __builtin_amdgcn_fence(__ATOMIC_RELEASE, "agent");
            asm volatile("s_waitcnt vmcnt(0)" ::: "memory");
            const unsigned og = xb_add(&bar[XB_TOP], 1u);
            const unsigned tg = og / nx;
            if (og + 1u == (tg + 1u) * nx) xb_add(&bar[XB_TOPGEN], 1u);
            else XB_SPIN(xb_ld(&bar[XB_TOPGEN]) == tg, bar);
            __builtin_amdgcn_fence(__ATOMIC_ACQUIRE, "agent");
            xb_add(&bar[XB_XGEN(b.x)], 1u);
            asm volatile("s_waitcnt vmcnt(0)" ::: "memory");
        } else {
            XB_SPIN(xb_ld(&bar[XB_XGEN(b.x)]) == gen, bar);
            __builtin_amdgcn_fence(__ATOMIC_ACQUIRE, "agent");
            asm volatile("s_waitcnt vmcnt(0)" ::: "memory");
        }
    }
    __syncthreads();
}

struct Frame {
    LAS unsigned char* lds;
    volatile LAS unsigned* MISC;
    gu32* ctl;
    int tid, lane, wave, G, bid;
    const float *x, *norm1_w, *w_in, *conv_w, *conv_b, *dt_bias, *a_log, *d_skip, *ssd_norm_w, *i_bias, *f_bias, *ml_norm_w, *w_out, *norm2_w, *router_w, *router_b, *w_gate_up, *b_gate_up, *w_down, *b_down, *final_norm_w;
    float* out; unsigned char* ws;
};

__device__ __forceinline__ void p0_transpose_item(const float* W, int ldw, int K, bf16* WT, int dst_row0, int src_col0, int k0, LAS float* scr, int lane) {
#pragma unroll 8
    for (int i = 0; i < 32; ++i) { const int kk = 2 * i + (lane >> 5); scr[kk * 33 + (lane & 31)] = W[(size_t)(k0 + kk) * ldw + src_col0 + (lane & 31)]; }
    LDS_WAIT(); asm volatile("" ::: "memory");
    const int c = lane & 7;
#pragma unroll
    for (int j = 0; j < 4; ++j) { const int n = (lane >> 3) + 8 * j; const LAS float* s = scr + (8 * c) * 33 + n;
        v4u o; o.x = pk2(s[0 * 33], s[1 * 33]); o.y = pk2(s[2 * 33], s[3 * 33]); o.z = pk2(s[4 * 33], s[5 * 33]); o.w = pk2(s[6 * 33], s[7 * 33]);
        *(v4u*)(WT + (size_t)(dst_row0 + n) * K + k0 + 8 * c) = o; }
    LDS_WAIT(); asm volatile("" ::: "memory");
}
__device__ __forceinline__ void p0_transpose_item_f8(const float* W, int ldw, int K, unsigned char* WT, int dst_row0, int src_col0, int k0, LAS float* scr, int lane) {
#pragma unroll 8
    for (int i = 0; i < 32; ++i) { const int kk = 2 * i + (lane >> 5); scr[kk * 33 + (lane & 31)] = W[(size_t)(k0 + kk) * ldw + src_col0 + (lane & 31)] * 64.0f; }
    LDS_WAIT(); asm volatile("" ::: "memory");
    const int c = lane & 3;
#pragma unroll
    for (int j = 0; j < 2; ++j) { const int n = (lane >> 2) + 16 * j; const LAS float* s = scr + (16 * c) * 33 + n; int o[4];
#pragma unroll
        for (int q = 0; q < 4; ++q) { int w = __builtin_amdgcn_cvt_pk_fp8_f32(s[(4 * q) * 33], s[(4 * q + 1) * 33], 0, false); o[q] = __builtin_amdgcn_cvt_pk_fp8_f32(s[(4 * q + 2) * 33], s[(4 * q + 3) * 33], w, true); }
        *(v4u*)(WT + (size_t)(dst_row0 + n) * K + k0 + 16 * c) = (v4u){(unsigned)o[0], (unsigned)o[1], (unsigned)o[2], (unsigned)o[3]}; }
    LDS_WAIT(); asm volatile("" ::: "memory");
}
template <bool F8> __device__ __forceinline__ void p0_transpose128(const float* W, int ldw, int K, void* WTv, int dst_row0, int src_col0, int k0, LAS float* scr, int lane) {
    const float* src = W + (size_t)(k0 + (lane >> 3)) * ldw + src_col0 + 4 * (lane & 7);
    f32x4 v[16];
#pragma unroll
    for (int i = 0; i < 16; ++i) v[i] = *(const f32x4*)(src + (size_t)(8 * i) * ldw);
#pragma unroll
    for (int i = 0; i < 16; ++i) { LAS float* d = scr + (8 * i + (lane >> 3)) * 33 + 4 * (lane & 7); d[0] = v[i].x; d[1] = v[i].y; d[2] = v[i].z; d[3] = v[i].w; }
    LDS_WAIT(); asm volatile("" ::: "memory");
    const int n = lane & 31, hf = lane >> 5; const LAS float* s = scr + (64 * hf) * 33 + n;
    if (F8) { unsigned char* dst = (unsigned char*)WTv + (size_t)(dst_row0 + n) * K + k0 + 64 * hf;
#pragma unroll
        for (int j = 0; j < 4; ++j) { int o[4];
#pragma unroll
            for (int q = 0; q < 4; ++q) { const LAS float* p = s + (16 * j + 4 * q) * 33; int w = __builtin_amdgcn_cvt_pk_fp8_f32(p[0] * 64.0f, p[33] * 64.0f, 0, false); o[q] = __builtin_amdgcn_cvt_pk_fp8_f32(p[66] * 64.0f, p[99] * 64.0f, w, true); }
            *(v4u*)(dst + 16 * j) = (v4u){(unsigned)o[0], (unsigned)o[1], (unsigned)o[2], (unsigned)o[3]}; }
    } else { bf16* dst = (bf16*)WTv + (size_t)(dst_row0 + n) * K + k0 + 64 * hf;
#pragma unroll
        for (int j = 0; j < 8; ++j) { const LAS float* p = s + (8 * j) * 33;
            *(v4u*)(dst + 8 * j) = (v4u){pk2(p[0], p[33]), pk2(p[66], p[99]), pk2(p[132], p[165]), pk2(p[198], p[231])}; }
    }
    LDS_WAIT(); asm volatile("" ::: "memory");
}
__device__ __forceinline__ void rms_row_to_bf16(const float* xrow, const float* w, bf16* orow, int lane) {
    const f32x4* xr = (const f32x4*)xrow + lane; const f32x4* wr = (const f32x4*)w + lane;
    f32x4 v[8]; float s = 0.f;
#pragma unroll
    for (int j = 0; j < 8; ++j) { v[j] = xr[64 * j]; s += (v[j].x * v[j].x + v[j].y * v[j].y) + (v[j].z * v[j].z + v[j].w * v[j].w); }
    const float rstd = 1.0f / sqrtf(wave_sum(s) * (1.0f / 2048.0f) + EPSF);
    v2u* o8 = (v2u*)orow + lane;
#pragma unroll
    for (int j = 0; j < 8; ++j) { const f32x4 ww = wr[64 * j]; v2u o; o.x = pk2(v[j].x * rstd * ww.x, v[j].y * rstd * ww.y); o.y = pk2(v[j].z * rstd * ww.z, v[j].w * rstd * ww.w); o8[64 * j] = o; }
}
__device__ __forceinline__ void p0_moe_weights_coop(Frame& F) {
    LAS float* tile = (LAS float*)F.lds;
    unsigned char* WguT = (unsigned char*)(F.ws + WS_WGU); unsigned char* WdT = (unsigned char*)(F.ws + WS_WD);
    constexpr int I_GU = 32 * 256, I_D = 32 * 128, NI = I_GU + I_D;
    const int lrow = 32 * F.wave + (F.lane >> 5), lcol = 4 * (F.lane & 31);
    const int on = F.tid & 127, okq = F.tid >> 7;
    f32x4 v[16];
    auto item = [&](int r, const float*& W, unsigned char*& WT, int& ldw, int& n0, int& k0) {
        if (r < I_GU) { const int e = r >> 8, rr = r & 255, kb = rr >> 5, nb = rr & 31; W = F.w_gate_up + (size_t)e * 2048 * 4096; WT = WguT + (size_t)e * 4096 * 2048; ldw = 4096; n0 = nb * 128; k0 = kb * 256; }
        else { r -= I_GU; const int e = r >> 7, rr = r & 127, kb = rr >> 4, nb = rr & 15; W = F.w_down + (size_t)e * 2048 * 2048; WT = WdT + (size_t)e * 2048 * 2048; ldw = 2048; n0 = nb * 128; k0 = kb * 256; } };
    int it = F.bid; if (it >= NI) return;
    const float* W; unsigned char* WT; int ldw, n0, k0; item(it, W, WT, ldw, n0, k0);
#pragma unroll
    for (int i = 0; i < 16; ++i) v[i] = *(const f32x4*)(W + (size_t)(k0 + lrow + 2 * i) * ldw + n0 + lcol);
    for (;;) {
#pragma unroll
        for (int i = 0; i < 16; ++i) *(LAS f32x4*)(tile + (lrow + 2 * i) * 132 + lcol) = v[i];
        __syncthreads();
        unsigned char* dst = WT + (size_t)(n0 + on) * 2048 + k0 + 64 * okq;
        const int nit = it + F.G; const bool more = nit < NI;
        if (more) { item(nit, W, WT, ldw, n0, k0);
#pragma unroll
            for (int i = 0; i < 16; ++i) v[i] = *(const f32x4*)(W + (size_t)(k0 + lrow + 2 * i) * ldw + n0 + lcol); }
        const LAS float* sp = tile + (64 * okq) * 132 + on;
#pragma unroll
        for (int j = 0; j < 4; ++j) { int o[4];
#pragma unroll
            for (int q = 0; q < 4; ++q) { const LAS float* p = sp + (16 * j + 4 * q) * 132; int w_ = __builtin_amdgcn_cvt_pk_fp8_f32(p[0] * 64.0f, p[132] * 64.0f, 0, false); o[q] = __builtin_amdgcn_cvt_pk_fp8_f32(p[264] * 64.0f, p[396] * 64.0f, w_, true); }
            *(v4u*)(dst + 16 * j) = (v4u){(unsigned)o[0], (unsigned)o[1], (unsigned)o[2], (unsigned)o[3]}; }
        __syncthreads();
        if (!more) break; it = nit;
    }
}
__device__ __forceinline__ void phase0(Frame& F) {
    LAS float* scr = (LAS float*)(F.lds + F.wave * 16896);
    const int gw = F.bid * NWAVES + F.wave, NGW = F.G * NWAVES;
    bf16* WinT = (bf16*)(F.ws + WS_WIN); bf16* WsT = (bf16*)(F.ws + WS_WSM); float* Wrt = (float*)(F.ws + WS_WRT); bf16* WoutT = (bf16*)(F.ws + WS_WOUT);
    bf16* XN1 = (bf16*)(F.ws + WS_XN1);
    p0_moe_weights_coop(F);
    constexpr int I_IN = 16 * 352, I_OUT = 32 * 64, NITEMS = I_IN + I_OUT;
    for (int it = gw; it < NITEMS; it += NGW) {
        int r = it;
        if (r < I_IN) { const int kb = r / 352, nb = r % 352, n0 = nb * 32; p0_transpose128<false>(F.w_in, WIN_LD, 2048, WinT, n0, n0 + (n0 >= 5120 ? 32 : 0), kb * 128, scr, F.lane); continue; } r -= I_IN;
        { const int kb = r >> 6, nb = r & 63; p0_transpose128<false>(F.w_out, 2048, 4096, WoutT, nb * 32, nb * 32, kb * 128, scr, F.lane); }
    }
    for (int i = gw * 64 + F.lane; i < 64 * 2048; i += NGW * 64) { const int j = i >> 11, k = i & 2047;
        const int col = j < 32 ? 5120 + j : (j < 40 ? 11296 + (j - 32) : 11304 + (j - 40));
        WsT[i] = (bf16)(j < 48 ? f2bf(F.w_in[(size_t)k * WIN_LD + col]) : 0u); }
    for (int i = gw * 64 + F.lane; i < 2048 * 32; i += NGW * 64) Wrt[i] = F.norm2_w[i >> 5] * F.router_w[i];
    for (int m = gw; m < TT; m += NGW) rms_row_to_bf16(F.x + (size_t)m * DM, F.norm1_w, XN1 + (size_t)m * DM, F.lane);
}

__device__ __forceinline__ void p1_small(Frame& F) {
    const bf16* XN1 = (const bf16*)(F.ws + WS_XN1); const bf16* WsT = (const bf16*)(F.ws + WS_WSM); float* SMALL = (float*)(F.ws + WS_SMALL);
    const int gw = F.bid * NWAVES + F.wave, NGW = F.G * NWAVES, fr = F.lane & 15, fq = F.lane >> 4;
    for (int task = gw; task < TT / 16; task += NGW) {
        const int t0 = task * 16;
        f32x4 acc[4];
#pragma unroll
        for (int n = 0; n < 4; ++n) acc[n] = (f32x4){0.f, 0.f, 0.f, 0.f};
        const bf16* arow = XN1 + (size_t)(t0 + fr) * DM + 8 * fq; const bf16* brow = WsT + (size_t)fr * DM + 8 * fq;
#pragma unroll 16
        for (int ks = 0; ks < 64; ++ks) {
            const bf16x8 a = *(const bf16x8*)(arow + 32 * ks);
#pragma unroll
            for (int n = 0; n < 4; ++n) { const bf16x8 b = *(const bf16x8*)(brow + (size_t)n * 16 * DM + 32 * ks); acc[n] = __builtin_amdgcn_mfma_f32_16x16x32_bf16(a, b, acc[n], 0, 0, 0); }
        }
#pragma unroll
        for (int n = 0; n < 4; ++n)
#pragma unroll
            for (int r = 0; r < 4; ++r) SMALL[(size_t)(t0 + 4 * fq + r) * 64 + n * 16 + fr] = acc[n][r];
    }
}

__device__ __forceinline__ void unpack8(const v4u r, float (&f)[8]) { f[0] = bflo(r.x); f[1] = bfhi(r.x); f[2] = bflo(r.y); f[3] = bfhi(r.y); f[4] = bflo(r.z); f[5] = bfhi(r.z); f[6] = bflo(r.w); f[7] = bfhi(r.w); }

__device__ __forceinline__ void phase_conv(Frame& F) {
    const bf16* PROJ = (const bf16*)(F.ws + WS_PROJ); bf16* XC = (bf16*)(F.ws + WS_XC);
    constexpr int TB = 16, NCG = 384, NIT = (TT / TB) * NCG;
    for (int it = F.bid * (NWAVES * 64) + F.tid; it < NIT; it += F.G * NWAVES * 64) {
        const int cg = it % NCG, tb = it / NCG, ch = cg * 8, t0 = tb * TB; const bool seq0 = (t0 % SEQ) == 0;
        float w[4][8], bs[8];
#pragma unroll
        for (int j = 0; j < 4; ++j) { const f32x4 a = *(const f32x4*)(F.conv_w + j * 3072 + ch), b = *(const f32x4*)(F.conv_w + j * 3072 + ch + 4);
            w[j][0] = a.x; w[j][1] = a.y; w[j][2] = a.z; w[j][3] = a.w; w[j][4] = b.x; w[j][5] = b.y; w[j][6] = b.z; w[j][7] = b.w; }
        { const f32x4 a = *(const f32x4*)(F.conv_b + ch), b = *(const f32x4*)(F.conv_b + ch + 4); bs[0] = a.x; bs[1] = a.y; bs[2] = a.z; bs[3] = a.w; bs[4] = b.x; bs[5] = b.y; bs[6] = b.z; bs[7] = b.w; }
        const bf16* src = PROJ + (size_t)t0 * NPROJ + PC_XBC + ch;
        float r0[8], r1[8], r2[8], r3[8];
        if (seq0) {
#pragma unroll
            for (int i = 0; i < 8; ++i) { r0[i] = 0.f; r1[i] = 0.f; r2[i] = 0.f; }
        } else { unpack8(*(const v4u*)(src - 3 * (size_t)NPROJ), r0); unpack8(*(const v4u*)(src - 2 * (size_t)NPROJ), r1); unpack8(*(const v4u*)(src - (size_t)NPROJ), r2); }
        v4u rw[TB];
#pragma unroll
        for (int l = 0; l < TB; ++l) rw[l] = *(const v4u*)(src + (size_t)l * NPROJ);
#pragma unroll
        for (int l = 0; l < TB; ++l) {
            unpack8(rw[l], r3);
            float o[8];
#pragma unroll
            for (int i = 0; i < 8; ++i) { const float v = bs[i] + w[0][i] * r0[i] + w[1][i] * r1[i] + w[2][i] * r2[i] + w[3][i] * r3[i]; o[i] = siluf(v); r0[i] = r1[i]; r1[i] = r2[i]; r2[i] = r3[i]; }
            v4u ov; ov.x = pk2(o[0], o[1]); ov.y = pk2(o[2], o[3]); ov.z = pk2(o[4], o[5]); ov.w = pk2(o[6], o[7]);
            *(v4u*)(XC + (size_t)(t0 + l) * 3072 + ch) = ov;
        }
    }
}

constexpr int MX_PITCH = 272;
static_assert(true, "");
constexpr int MX_QM = 0, MX_KM = 34816, MX_KW = 69632, MX_VT = 104448, MX_SI = 121856, MX_VEC = 139264, MX_VECB = 3072, MX_NVEC = MX_VEC + 2 * MX_VECB, MX_SCAL = MX_NVEC + 512, MX_END = MX_SCAL + 64;
__device__ __forceinline__ unsigned cvt_pk_bf16_nop(float lo, float hi) { unsigned r; asm volatile("v_cvt_pk_bf16_f32 %0, %1, %2\n\ts_nop 1" : "=v"(r) : "v"(lo), "v"(hi)); return r; }
__device__ __forceinline__ int mx_sw(int row, int tbyte) { return row * MX_PITCH + ((((tbyte >> 4) ^ (row >> 3)) & 15) << 4) + (tbyte & 15); }
__device__ __forceinline__ bf16x8 lds_frag(const LAS unsigned char* img, int row, int kbyte) { return *(const LAS bf16x8*)(img + row * MX_PITCH + kbyte); }
static_assert(MX_END + 256 <= LDSCTL_OFF, "mixer LDS map");
template <bool ML> __device__ __forceinline__ void mixer_unit(Frame& F, int unit) {
    const bf16* PROJ = (const bf16*)(F.ws + WS_PROJ); const bf16* XC = (const bf16*)(F.ws + WS_XC); const float* SMALL = (const float*)(F.ws + WS_SMALL);
    bf16* YMIX = (bf16*)(F.ws + WS_YMIX); float* SSQ = (float*)(F.ws + WS_SSQ);
    const int w = F.wave, fr = F.lane & 15, fq = F.lane >> 4, tid = F.tid;
    const int b = unit >> 5, tok0 = b * SEQ, hd = unit & 31, grp = hd >> 3, mh = (unit & 31) >> 2, vq = unit & 3;
    const float qs = 0.08838834764831845f;
    LAS unsigned char* QM = F.lds + MX_QM; LAS unsigned char* KM = F.lds + MX_KM; LAS unsigned char* KW = F.lds + MX_KW; LAS unsigned char* VT = F.lds + MX_VT; LAS unsigned char* SI = F.lds + MX_SI;
    LAS float* exch = (LAS float*)(F.lds + MX_VEC + (w >> 2) * MX_VECB + 1024) + (w & 3) * 32;
    LAS float* nvec = (LAS float*)(F.lds + MX_NVEC); LAS float* scal = (LAS float*)(F.lds + MX_SCAL);
    const int fr3 = fr >> 3;
    int vtb[2];
#pragma unroll
    for (int p = 0; p < 2; ++p) vtb[p] = fr * MX_PITCH + ((fq ^ ((2 * p) | fr3)) << 4);
    int vpb[2][2];
#pragma unroll
    for (int p = 0; p < 2; ++p)
#pragma unroll
        for (int h = 0; h < 2; ++h) vpb[p][h] = fr * MX_PITCH + (((((fq >> 1) | (2 * h)) ^ ((2 * p) | fr3))) << 4) + 8 * (fq & 1);
    const int kwb = (16 * w + fr) * MX_PITCH + ((fq ^ ((2 * (w & 1)) | fr3)) << 4), kwh = w >> 1;

    const bf16* qsrc; const bf16* ksrc; const bf16* vsrc; int ld;
    if (ML) { qsrc = PROJ + PC_Q + mh * 128; ksrc = PROJ + PC_K + mh * 128; vsrc = PROJ + PC_V + mh * 256 + vq * 64; ld = NPROJ; }
    else { qsrc = XC + 2560 + grp * 128; ksrc = XC + 2048 + grp * 128; vsrc = XC + hd * 64; ld = 3072; }
    const float c_a = ML ? 0.f : -expf(F.a_log[hd]), c_dtb = ML ? 0.f : F.dt_bias[hd], c_D = ML ? 0.f : F.d_skip[hd], c_ib = ML ? F.i_bias[mh] : 0.f, c_fb = ML ? F.f_bias[mh] : 0.f;
    float mprev = 0.f;
    f32x4 sacc[4]; float nreg = 0.f;
#pragma unroll
    for (int j = 0; j < 4; ++j) sacc[j] = (f32x4){0.f, 0.f, 0.f, 0.f};
    v4u pq[4], pk[4], pv[2];
    float vA0 = 0.f, vA1 = 0.f, vB0 = 0.f, vB1 = 0.f, vC0 = 0.f, vC1 = 0.f, vD0 = 0.f, vD1 = 0.f, vE0 = 0.f, vE1 = 0.f, vG0 = 0.f, vG1 = 0.f, vSA = 0.f, vSG = 0.f;
    float sl0 = 0.f, sl1 = 0.f, sl2 = 0.f, sl3 = 0.f;
#define MX_SCAN_L(c) do { if (w == 0) { const size_t tt = (size_t)(tok0 + 128 * (c) + 2 * F.lane); \
        if (!ML) { sl0 = SMALL[tt * 64 + hd]; sl1 = SMALL[(tt + 1) * 64 + hd]; } \
        else { sl0 = SMALL[tt * 64 + 32 + mh]; sl1 = SMALL[(tt + 1) * 64 + 32 + mh]; sl2 = SMALL[tt * 64 + 40 + mh]; sl3 = SMALL[(tt + 1) * 64 + 40 + mh]; } } } while (0)
#define MX_SOFTPLUS(x) ((x) > 20.f ? (x) : __logf(1.0f + __expf(x)))
#define MX_LOGSIG(x) (fminf((x), 0.f) - __logf(1.0f + __expf(-fabsf(x))))
#define MX_SCAN_A(c) do { if (w == 0) { \
        if (!ML) { const float d0 = MX_SOFTPLUS(sl0 + c_dtb), d1 = MX_SOFTPLUS(sl1 + c_dtb); \
            const float x0 = d0 * c_a, x1 = d1 * c_a; float incl = x0 + x1; \
            _Pragma("unroll") for (int d = 1; d < 64; d <<= 1) { const float t_ = __shfl_up(incl, d); if (F.lane >= d) incl += t_; } \
            const float cum1 = incl, cum0 = incl - x1, tot = __shfl(incl, 63); \
            vA0 = -cum0; vA1 = -cum1; vB0 = -cum0; vB1 = -cum1; vC0 = d0; vC1 = d1; vD0 = __expf(cum0); vD1 = __expf(cum1); vE0 = d0 * __expf(tot - cum0); vE1 = d1 * __expf(tot - cum1); vSA = __expf(tot); vSG = 1.0f; \
        } else { const float li0 = sl0 + c_ib, li1 = sl1 + c_ib; \
            const float x0 = MX_LOGSIG(sl2 + c_fb), x1 = MX_LOGSIG(sl3 + c_fb); float incl = x0 + x1; \
            _Pragma("unroll") for (int d = 1; d < 64; d <<= 1) { const float t_ = __shfl_up(incl, d); if (F.lane >= d) incl += t_; } \
            const float cum1 = incl, cum0 = incl - x1, btot = __shfl(incl, 63); \
            const float dd0 = li0 - cum0, dd1 = li1 - cum1; float im = fmaxf(dd0, dd1); \
            _Pragma("unroll") for (int d = 1; d < 64; d <<= 1) { const float t_ = __shfl_up(im, d); if (F.lane >= d) im = fmaxf(im, t_); } \
            float pm = __shfl_up(im, 1); if (F.lane == 0) pm = -3.0e38f; const float pmax0 = fmaxf(pm, dd0), pmax1 = im, pm127 = __shfl(im, 63); \
            const float M0 = fmaxf(mprev, pmax0), M1 = fmaxf(mprev, pmax1); \
            vA0 = dd0; vA1 = dd1; vB0 = M0; vB1 = M1; vD0 = qs * __expf(mprev - M0); vD1 = qs * __expf(mprev - M1); vG0 = __expf(-(cum0 + M0)); vG1 = __expf(-(cum1 + M1)); \
            const float mloc = btot + pm127, mnew = fmaxf(btot + mprev, mloc); \
            vSA = __expf(btot + mprev - mnew); vSG = __expf(mloc - mnew); vE0 = __expf(dd0 - pm127) * vSG; vE1 = __expf(dd1 - pm127) * vSG; mprev = mnew; } } } while (0)
#define MX_SCAN_B(c) do { if (w == 0) { \
        LAS float* vb = (LAS float*)(F.lds + MX_VEC + ((c) & 1) * MX_VECB); const int l0 = 2 * F.lane; \
        *(LAS f32x2*)(vb + l0) = (f32x2){vA0, vA1}; *(LAS f32x2*)(vb + 128 + l0) = (f32x2){vB0, vB1}; if (!ML) *(LAS f32x2*)(vb + 256 + l0) = (f32x2){vC0, vC1}; \
        *(LAS f32x2*)(vb + 384 + l0) = (f32x2){vD0, vD1}; *(LAS f32x2*)(vb + 512 + l0) = (f32x2){vE0, vE1}; if (ML) *(LAS f32x2*)(vb + 640 + l0) = (f32x2){vG0, vG1}; \
        if (F.lane == 0) { scal[2 * ((c) & 1)] = vSA; scal[2 * ((c) & 1) + 1] = vSG; } } } while (0)
#define MX_SCAN(c) do { MX_SCAN_L(c); MX_SCAN_A(c); MX_SCAN_B(c); } while (0)
#define MX_PREFETCH(c) do { const size_t tb_ = (size_t)(tok0 + 128 * (c)); \
        _Pragma("unroll") for (int i = 0; i < 2; ++i) { const int pid = tid + 512 * i, a2 = pid >> 4, k8 = pid & 15; \
            pq[2 * i] = *(const v4u*)(qsrc + (tb_ + 2 * a2) * ld + 8 * k8); pq[2 * i + 1] = *(const v4u*)(qsrc + (tb_ + 2 * a2 + 1) * ld + 8 * k8); \
            pk[2 * i] = *(const v4u*)(ksrc + (tb_ + 2 * a2) * ld + 8 * k8); pk[2 * i + 1] = *(const v4u*)(ksrc + (tb_ + 2 * a2 + 1) * ld + 8 * k8); } \
        { const int a2 = tid >> 3, v8 = tid & 7; pv[0] = *(const v4u*)(vsrc + (tb_ + 2 * a2) * ld + 8 * v8); pv[1] = *(const v4u*)(vsrc + (tb_ + 2 * a2 + 1) * ld + 8 * v8); } } while (0)
#define MX_WRITE(c) do { const LAS float* vb = (const LAS float*)(F.lds + MX_VEC + ((c) & 1) * MX_VECB); \
        _Pragma("unroll") for (int i = 0; i < 2; ++i) { const int pid = tid + 512 * i, a2 = pid >> 4, k8 = pid & 15, l = 2 * a2; \
            *(LAS v4u*)(QM + l * MX_PITCH + 16 * k8) = pq[2 * i]; *(LAS v4u*)(QM + (l + 1) * MX_PITCH + 16 * k8) = pq[2 * i + 1]; \
            *(LAS v4u*)(KM + l * MX_PITCH + 16 * k8) = pk[2 * i]; *(LAS v4u*)(KM + (l + 1) * MX_PITCH + 16 * k8) = pk[2 * i + 1]; \
            float f0[8], f1[8]; unpack8(pk[2 * i], f0); unpack8(pk[2 * i + 1], f1); const f32x2 wl = *(const LAS f32x2*)(vb + 512 + l); \
            _Pragma("unroll") for (int e = 0; e < 8; ++e) *(LAS unsigned*)(KW + mx_sw(8 * k8 + e, 2 * l)) = pg8::cvt_pk_bf16(f0[e] * wl.x, f1[e] * wl.y); } \
        { const int a2 = tid >> 3, v8 = tid & 7, l = 2 * a2; const v4u r0 = pv[0], r1 = pv[1]; LAS unsigned char* vp_ = VT + mx_sw(8 * v8, 2 * l); \
            *(LAS unsigned*)(vp_ + 0 * MX_PITCH) = (r0.x & 0xffffu) | (r1.x << 16); *(LAS unsigned*)(vp_ + 1 * MX_PITCH) = (r0.x >> 16) | (r1.x & 0xffff0000u); \
            *(LAS unsigned*)(vp_ + 2 * MX_PITCH) = (r0.y & 0xffffu) | (r1.y << 16); *(LAS unsigned*)(vp_ + 3 * MX_PITCH) = (r0.y >> 16) | (r1.y & 0xffff0000u); \
            *(LAS unsigned*)(vp_ + 4 * MX_PITCH) = (r0.z & 0xffffu) | (r1.z << 16); *(LAS unsigned*)(vp_ + 5 * MX_PITCH) = (r0.z >> 16) | (r1.z & 0xffff0000u); \
            *(LAS unsigned*)(vp_ + 6 * MX_PITCH) = (r0.w & 0xffffu) | (r1.w << 16); *(LAS unsigned*)(vp_ + 7 * MX_PITCH) = (r0.w >> 16) | (r1.w & 0xffff0000u); } \
        _Pragma("unroll") for (int j = 0; j < 4; ++j) { v2u sv; sv.x = pg8::cvt_pk_bf16(sacc[j][0], sacc[j][1]); sv.y = pg8::cvt_pk_bf16(sacc[j][2], sacc[j][3]); *(LAS v2u*)(SI + (16 * j + fr) * MX_PITCH + (16 * w + 4 * fq) * 2) = sv; } \
        if (ML && fq == 0) nvec[16 * w + fr] = nreg; } while (0)
    const int gcol = (ML ? PC_O + mh * 256 + vq * 64 : PC_Z + hd * 64) + 16 * (F.lane & 3);
    LAS float* nwl = (LAS float*)(F.lds + MX_END);
    if (tid < 64) nwl[tid] = ML ? F.ml_norm_w[mh * 256 + vq * 64 + tid] : F.ssd_norm_w[hd * 64 + tid];
    v4u zc0 = (v4u){0u, 0u, 0u, 0u}, zc1 = zc0;
    { const bf16* zp = PROJ + (size_t)(tok0 + 16 * w + (F.lane >> 2)) * NPROJ + gcol; zc0 = *(const v4u*)zp; zc1 = *(const v4u*)(zp + 8); }
    MX_SCAN(0);
    MX_PREFETCH(0);
    __syncthreads();
    MX_WRITE(0);
    __syncthreads();
    for (int c = 0; c < SEQ / 128; ++c) {
        const LAS float* vb = (const LAS float*)(F.lds + MX_VEC + (c & 1) * MX_VECB);
        const bool more = (c + 1 < SEQ / 128);
        if (more) { MX_SCAN_L(c + 1); MX_PREFETCH(c + 1); }
        bf16x8 qf[4];
#pragma unroll
        for (int ks = 0; ks < 4; ++ks) qf[ks] = lds_frag(QM, 16 * w + fr, 64 * ks + 16 * fq);
        const float mlv = vb[128 + 16 * w + fr];
        float dsum = 0.f;
        f32x4 y1[4];
#pragma unroll
        for (int j = 0; j < 4; ++j) y1[j] = (f32x4){0.f, 0.f, 0.f, 0.f};
        const f32x4 rs4 = *(const LAS f32x4*)(vb + 384 + 16 * w + 4 * fq);
#pragma unroll
        for (int ks = 0; ks < 4; ++ks) { bf16x8 sf[4];
#pragma unroll
            for (int j = 0; j < 4; ++j) sf[j] = lds_frag(SI, 16 * j + fr, 64 * ks + 16 * fq);
#pragma unroll
            for (int j = 0; j < 4; ++j) y1[j] = __builtin_amdgcn_mfma_f32_16x16x32_bf16(qf[ks], sf[j], y1[j], 0, 0, 0); }
#pragma unroll
        for (int j = 0; j < 4; ++j) y1[j] = y1[j] * rs4;
        __builtin_amdgcn_sched_barrier(0);
#pragma unroll 1
        for (int k2 = 0; 2 * k2 <= w; ++k2) {
            unsigned pw[4];
#pragma unroll
            for (int h = 0; h < 2; ++h) {
                const int si = 2 * k2 + h;
                f32x4 acc = (f32x4){0.f, 0.f, 0.f, 0.f};
#pragma unroll
                for (int ks = 0; ks < 4; ++ks) acc = __builtin_amdgcn_mfma_f32_16x16x32_bf16(lds_frag(KM, 16 * si + fr, 64 * ks + 16 * fq), qf[ks], acc, 0, 0, 0);
                const f32x4 e4 = *(const LAS f32x4*)(vb + 16 * si + 4 * fq); f32x4 x4 = (f32x4){qs, qs, qs, qs}; if (!ML) x4 = *(const LAS f32x4*)(vb + 256 + 16 * si + 4 * fq);
                float p[4];
#pragma unroll
                for (int r = 0; r < 4; ++r) { const float v = acc[r] * __expf(e4[r] - mlv) * x4[r]; const bool ok = (si < w) || (si == w && 4 * fq + r <= fr); p[r] = ok ? v : 0.f; }
                if (ML) dsum += (p[0] + p[1]) + (p[2] + p[3]);
                pw[2 * h] = cvt_pk_bf16_nop(p[0], p[1]); pw[2 * h + 1] = cvt_pk_bf16_nop(p[2], p[3]);
            }
            HWAIT();
            const v4u pwv = (v4u){pw[0], pw[1], pw[2], pw[3]}; const bf16x8 pf = __builtin_bit_cast(bf16x8, pwv);
#pragma unroll
            for (int j = 0; j < 4; ++j) { const int ho = j * 16 * MX_PITCH + ((k2 ^ (j >> 1)) << 6); const v2u lo = *(const LAS v2u*)(VT + vpb[j & 1][0] + ho), hi = *(const LAS v2u*)(VT + vpb[j & 1][1] + ho); const v4u vw = (v4u){lo.x, lo.y, hi.x, hi.y};
                y1[j] = __builtin_amdgcn_mfma_f32_16x16x32_bf16(pf, __builtin_bit_cast(bf16x8, vw), y1[j], 0, 0, 0); }
            HWAIT();
        }
        HSYNC();
        __builtin_amdgcn_sched_barrier(0);
        __builtin_amdgcn_sched_barrier(0);
        if (ML) {
            dsum += __shfl_xor(dsum, 16); dsum += __shfl_xor(dsum, 32);
            float d2 = 0.f;
#pragma unroll
            for (int ks = 0; ks < 4; ++ks) { float qv[8]; unpack8(__builtin_bit_cast(v4u, qf[ks]), qv); const f32x4 n0 = *(const LAS f32x4*)(nvec + 32 * ks + 8 * fq), n1 = *(const LAS f32x4*)(nvec + 32 * ks + 8 * fq + 4);
                d2 += qv[0] * n0.x + qv[1] * n0.y + qv[2] * n0.z + qv[3] * n0.w + qv[4] * n1.x + qv[5] * n1.y + qv[6] * n1.z + qv[7] * n1.w; }
            d2 += __shfl_xor(d2, 16); d2 += __shfl_xor(d2, 32);
            if (fq == 0) { exch[fr] = dsum; exch[16 + fr] = d2; }
        }
        HSYNC();
        __builtin_amdgcn_sched_barrier(0);
        LAS float* stg = (LAS float*)(QM + 16 * w * MX_PITCH);
        if (ML) { const f32x4 fl4 = *(const LAS f32x4*)(vb + 640 + 16 * w + 4 * fq); const f32x4 dA = *(const LAS f32x4*)(exch + 4 * fq), dB = *(const LAS f32x4*)(exch + 16 + 4 * fq);
#pragma unroll
            for (int r = 0; r < 4; ++r) { const float den = fmaxf(fabsf(dA[r] + rs4[r] * dB[r]), fl4[r]); const float inv = __builtin_amdgcn_rcpf(den);
#pragma unroll
                for (int j = 0; j < 4; ++j) stg[(4 * fq + r) * 68 + 16 * j + fr] = y1[j][r] * inv; }
        } else {
#pragma unroll
            for (int j = 0; j < 4; ++j) { const v2u xw = *(const LAS v2u*)(VT + mx_sw(16 * j + fr, 32 * w + 8 * fq)); const float xs[4] = {bflo(xw.x), bfhi(xw.x), bflo(xw.y), bfhi(xw.y)};
#pragma unroll
                for (int r = 0; r < 4; ++r) stg[(4 * fq + r) * 68 + 16 * j + fr] = y1[j][r] + c_D * xs[r]; }
        }
        {   const int erow = F.lane >> 2, ecs = F.lane & 3; const size_t trow = (size_t)(tok0 + 128 * c + 16 * w + erow);
            float yv[16];
#pragma unroll
            for (int i = 0; i < 4; ++i) { const f32x4 t4 = *(const LAS f32x4*)(stg + erow * 68 + 16 * ecs + 4 * i); yv[4 * i] = t4.x; yv[4 * i + 1] = t4.y; yv[4 * i + 2] = t4.z; yv[4 * i + 3] = t4.w; }
            float zf[16]; { float t8[8]; unpack8(zc0, t8);
#pragma unroll
                for (int i = 0; i < 8; ++i) zf[i] = t8[i]; unpack8(zc1, t8);
#pragma unroll
                for (int i = 0; i < 8; ++i) zf[8 + i] = t8[i]; }
            if (!ML) {
#pragma unroll
                for (int i = 0; i < 16; ++i) yv[i] = yv[i] * zf[i] * __builtin_amdgcn_rcpf(1.0f + __expf(-zf[i])); }
            float ss = 0.f;
#pragma unroll
            for (int i = 0; i < 16; ++i) ss += yv[i] * yv[i];
            ss += __shfl_xor(ss, 1); ss += __shfl_xor(ss, 2);
            if (ecs == 0) SSQ[(ML ? (size_t)TT * 32 : 0) + trow * 32 + (ML ? mh * 4 + vq : hd)] = ss;
#pragma unroll
            for (int i = 0; i < 4; ++i) { const f32x4 w4 = *(const LAS f32x4*)(nwl + 16 * ecs + 4 * i);
                yv[4 * i] *= w4.x; yv[4 * i + 1] *= w4.y; yv[4 * i + 2] *= w4.z; yv[4 * i + 3] *= w4.w; }
            if (ML) {
#pragma unroll
                for (int i = 0; i < 16; ++i) yv[i] *= __builtin_amdgcn_rcpf(1.0f + __expf(-zf[i])); }
            bf16* yp = YMIX + trow * 4096 + (ML ? 2048 + mh * 256 + vq * 64 : hd * 64) + 16 * ecs;
            *(v4u*)yp = (v4u){pg8::cvt_pk_bf16(yv[0], yv[1]), pg8::cvt_pk_bf16(yv[2], yv[3]), pg8::cvt_pk_bf16(yv[4], yv[5]), pg8::cvt_pk_bf16(yv[6], yv[7])};
            *(v4u*)(yp + 8) = (v4u){pg8::cvt_pk_bf16(yv[8], yv[9]), pg8::cvt_pk_bf16(yv[10], yv[11]), pg8::cvt_pk_bf16(yv[12], yv[13]), pg8::cvt_pk_bf16(yv[14], yv[15])};
            if (more) { const bf16* zp = PROJ + (size_t)(tok0 + 128 * (c + 1) + 16 * w + (F.lane >> 2)) * NPROJ + gcol; zc0 = *(const v4u*)zp; zc1 = *(const v4u*)(zp + 8); }
        }
        __builtin_amdgcn_sched_barrier(0);
        const float sa = scal[2 * (c & 1)];
#pragma unroll
        for (int j = 0; j < 4; ++j) sacc[j] = sacc[j] * sa;
        float nsum = 0.f;
#pragma unroll
        for (int ks = 0; ks < 4; ++ks) { const bf16x8 kf = *(const LAS bf16x8*)(KW + kwb + ((ks ^ kwh) << 6)); bf16x8 vf[4];
#pragma unroll
            for (int j = 0; j < 4; ++j) vf[j] = *(const LAS bf16x8*)(VT + vtb[j & 1] + j * 16 * MX_PITCH + ((ks ^ (j >> 1)) << 6));
            if (ML) { float kv[8]; unpack8(__builtin_bit_cast(v4u, kf), kv); nsum += ((kv[0] + kv[1]) + (kv[2] + kv[3])) + ((kv[4] + kv[5]) + (kv[6] + kv[7])); }
#pragma unroll
            for (int j = 0; j < 4; ++j) sacc[j] = __builtin_amdgcn_mfma_f32_16x16x32_bf16(kf, vf[j], sacc[j], 0, 0, 0); }
        if (ML) { nsum += __shfl_xor(nsum, 16); nsum += __shfl_xor(nsum, 32); nreg = nreg * sa + nsum; }
        if (more) { MX_SCAN_A(c + 1); }
        __syncthreads();
        if (more) { MX_SCAN_B(c + 1); }
        __syncthreads();
        if (more) { MX_WRITE(c + 1); }
        __syncthreads();
    }
#undef MX_SCAN
#undef MX_SCAN_A
#undef MX_SCAN_L
#undef MX_SOFTPLUS
#undef MX_LOGSIG
#undef MX_SCAN_B
#undef MX_PREFETCH
#undef MX_WRITE
}
__device__ __forceinline__ void phase_mixer(Frame& F) {
    for (int unit = F.bid; unit < 256; unit += F.G) { mixer_unit<false>(F, unit); mixer_unit<true>(F, unit); }
}

__device__ __forceinline__ void phase3(Frame& F) {
    const bf16* PROJ = (const bf16*)(F.ws + WS_PROJ); bf16* YMIX = (bf16*)(F.ws + WS_YMIX); const float* SSQ = (const float*)(F.ws + WS_SSQ);
    const int gw = F.bid * NWAVES + F.wave, NGW = F.G * NWAVES;
    for (int t = gw; t < TT; t += NGW) {
        bf16* yrow = YMIX + (size_t)t * 4096;
#pragma unroll
        for (int j = 0; j < 8; ++j) {
            const int c0 = (j * 64 + F.lane) * 8;
            float y[8]; unpack8(*(const v4u*)(yrow + c0), y);
            float o[8];
            if (j < 4) {
                const int g = c0 >> 9; const f32x4 s0 = *(const f32x4*)(SSQ + (size_t)t * 32 + g * 8), s1 = *(const f32x4*)(SSQ + (size_t)t * 32 + g * 8 + 4);
                const float ms = ((s0.x + s0.y) + (s0.z + s0.w) + (s1.x + s1.y) + (s1.z + s1.w)) * (1.0f / 512.0f);
                const float rs = 1.0f / sqrtf(ms + EPSF);
                const f32x4 w0 = *(const f32x4*)(F.ssd_norm_w + c0), w1 = *(const f32x4*)(F.ssd_norm_w + c0 + 4);
                o[0] = y[0] * rs * w0.x; o[1] = y[1] * rs * w0.y; o[2] = y[2] * rs * w0.z; o[3] = y[3] * rs * w0.w;
                o[4] = y[4] * rs * w1.x; o[5] = y[5] * rs * w1.y; o[6] = y[6] * rs * w1.z; o[7] = y[7] * rs * w1.w;
            } else {
                const int cc = c0 - 2048, h = cc >> 8; const f32x4 s0 = *(const f32x4*)(SSQ + (size_t)TT * 32 + (size_t)t * 32 + h * 4);
                const float ms = ((s0.x + s0.y) + (s0.z + s0.w)) * (1.0f / 256.0f);
                const float rs = 1.0f / sqrtf(ms + EPSF);
                const f32x4 w0 = *(const f32x4*)(F.ml_norm_w + cc), w1 = *(const f32x4*)(F.ml_norm_w + cc + 4);
                float og[8]; unpack8(*(const v4u*)(PROJ + (size_t)t * NPROJ + PC_O + cc), og);
                const float wv[8] = {w0.x, w0.y, w0.z, w0.w, w1.x, w1.y, w1.z, w1.w};
#pragma unroll
                for (int i = 0; i < 8; ++i) o[i] = y[i] * rs * wv[i] * __builtin_amdgcn_rcpf(1.0f + __expf(-og[i]));
            }
            v4u ov; ov.x = pk2(o[0], o[1]); ov.y = pk2(o[2], o[3]); ov.z = pk2(o[4], o[5]); ov.w = pk2(o[6], o[7]);
            *(v4u*)(yrow + c0) = ov;
        }
    }
}

__device__ __forceinline__ void phase5(Frame& F) {
    const bf16* H2 = (const bf16*)(F.ws + WS_H2); const float* Wrt = (const float*)(F.ws + WS_WRT); bf16* XN2 = (bf16*)(F.ws + WS_XN2);
    int* EIDX = (int*)(F.ws + WS_ROUTE); int* RANK = EIDX + TT * 4;
    int* TOKL = (int*)(F.ws + WS_XG); float* GATEL = (float*)(F.ws + WS_XG + 4 * MiB);
    LAS float* xT = (LAS float*)(F.lds + F.wave * 8192); LAS float* lg = (LAS float*)(F.lds + 65536 + F.wave * 1024);
    LAS int* cntl = (LAS int*)(F.lds + 73728); LAS int* baseg = cntl + 32;
    const int gw = F.bid * NWAVES + F.wave, NGW = F.G * NWAVES, ntask = TT / 8, iters = (ntask + NGW - 1) / NGW;
    for (int itx = 0; itx < iters; ++itx) {
        const int task = itx * NGW + gw; const bool valid = task < ntask; const int t0 = task * 8;
        if (F.tid < 32) cntl[F.tid] = 0;
        __syncthreads();
        float rstd[8]; int me[4] = {0, 0, 0, 0}, mr[4] = {0, 0, 0, 0}; float mg[4] = {0.f, 0.f, 0.f, 0.f};
#pragma unroll
        for (int k = 0; k < 8; ++k) rstd[k] = 0.f;
        float acc[8], ssq[8];
#pragma unroll
        for (int k = 0; k < 8; ++k) { acc[k] = 0.f; ssq[k] = 0.f; }
        const int e = F.lane & 31, dh = F.lane >> 5;
        LAS float* wl = (LAS float*)(F.lds + 81920);
        for (int dc = 0; dc < 8; ++dc) {
            __syncthreads();
#pragma unroll
            for (int q = 0; q < 4; ++q) ((LAS f32x4*)wl)[F.tid + 512 * q] = ((const f32x4*)(Wrt + (size_t)dc * 256 * 32))[F.tid + 512 * q];
            if (valid) {
                f32x4 xk[8];
#pragma unroll
                for (int k = 0; k < 8; ++k) { { const v2u q_ = *(const v2u*)(H2 + (size_t)(t0 + k) * DM + dc * 256 + 4 * F.lane); xk[k] = (f32x4){bflo(q_.x), bfhi(q_.x), bflo(q_.y), bfhi(q_.y)}; } ssq[k] += (xk[k].x * xk[k].x + xk[k].y * xk[k].y) + (xk[k].z * xk[k].z + xk[k].w * xk[k].w); }
#pragma unroll
                for (int jj = 0; jj < 4; ++jj) { LAS float* dp = xT + (jj * 64 + F.lane) * 8;
                    *(LAS f32x4*)dp = (f32x4){xk[0][jj], xk[1][jj], xk[2][jj], xk[3][jj]}; *(LAS f32x4*)(dp + 4) = (f32x4){xk[4][jj], xk[5][jj], xk[6][jj], xk[7][jj]}; }
            }
            __syncthreads();
            if (valid) {
                const LAS float* xp = xT + dh * 128 * 8;
#pragma unroll 8
                for (int i = 0; i < 128; ++i) { const float w = wl[(4 * (i & 63) + 2 * dh + (i >> 6)) * 32 + e];     const f32x4 xa = *(const LAS f32x4*)(xp + i * 8), xb = *(const LAS f32x4*)(xp + i * 8 + 4);
                    acc[0] += w * xa.x; acc[1] += w * xa.y; acc[2] += w * xa.z; acc[3] += w * xa.w; acc[4] += w * xb.x; acc[5] += w * xb.y; acc[6] += w * xb.z; acc[7] += w * xb.w; }
            }
        }
        if (valid) {
            const float rb = F.router_b[e];
#pragma unroll
            for (int k = 0; k < 8; ++k) { rstd[k] = 1.0f / sqrtf(wave_sum(ssq[k]) * (1.0f / 2048.0f) + EPSF);
                const float v = (acc[k] + __shfl_xor(acc[k], 32)) * rstd[k] + rb; if (F.lane < 32) lg[k * 32 + e] = v; }
            LDS_WAIT(); asm volatile("" ::: "memory");
            if (F.lane < 8) {
                const LAS float* lp = lg + F.lane * 32; float bv[4]; int bi[4] = {-1, -1, -1, -1};
#pragma unroll
                for (int p = 0; p < 4; ++p) { float best = -3.0e38f; int bidx = 0;
                    for (int q = 0; q < 32; ++q) { const float v = lp[q]; const bool taken = (q == bi[0]) | (q == bi[1]) | (q == bi[2]) | (q == bi[3]); if (!taken && v > best) { best = v; bidx = q; } }
                    bv[p] = best; bi[p] = bidx; }
                const float p1 = expf(bv[1] - bv[0]), p2 = expf(bv[2] - bv[0]), p3 = expf(bv[3] - bv[0]); const float inv = 1.0f / (1.0f + p1 + p2 + p3);
                mg[0] = inv; mg[1] = p1 * inv; mg[2] = p2 * inv; mg[3] = p3 * inv;
#pragma unroll
                for (int p = 0; p < 4; ++p) { me[p] = bi[p]; mr[p] = __hip_atomic_fetch_add(cntl + bi[p], 1, __ATOMIC_RELAXED, __HIP_MEMORY_SCOPE_WORKGROUP); }
            }
        }
        __syncthreads();
        if (F.tid < 32) { const int c = cntl[F.tid]; int gb = 0; if (c > 0) gb = (int)__hip_atomic_fetch_add((unsigned*)(F.ctl + CW_CNT + 64 * F.tid), (unsigned)c, RLX_AGENT); baseg[F.tid] = gb; }
        __syncthreads();
        if (valid) {
            if (F.lane < 8) { const size_t t = (size_t)(t0 + F.lane);
#pragma unroll
                for (int p = 0; p < 4; ++p) { const int rk = baseg[me[p]] + mr[p]; EIDX[t * 4 + p] = me[p]; RANK[t * 4 + p] = rk; TOKL[(size_t)me[p] * TT + rk] = (int)t; GATEL[(size_t)me[p] * TT + rk] = mg[p]; } }
#pragma unroll
            for (int k = 0; k < 8; ++k) { const v2u* xr = (const v2u*)(H2 + (size_t)(t0 + k) * DM) + F.lane; const f32x4* wr = (const f32x4*)F.norm2_w + F.lane; int* o4 = (int*)((unsigned char*)XN2 + (size_t)(t0 + k) * DM) + F.lane;
#pragma unroll
                for (int j = 0; j < 8; ++j) { const v2u q_ = xr[64 * j]; const f32x4 v = (f32x4){bflo(q_.x), bfhi(q_.x), bflo(q_.y), bfhi(q_.y)}, ww = wr[64 * j]; int o = __builtin_amdgcn_cvt_pk_fp8_f32(v.x * rstd[k] * ww.x, v.y * rstd[k] * ww.y, 0, false); o = __builtin_amdgcn_cvt_pk_fp8_f32(v.z * rstd[k] * ww.z, v.w * rstd[k] * ww.w, o, true); o4[64 * j] = o; } }
        }
        __syncthreads();
    }
}
__device__ __forceinline__ int build_moe_tab(Frame& F) {
    LAS unsigned char* tab = (LAS unsigned char*)(F.lds + TAB_OFF); LAS int* tinfo = (LAS int*)(F.lds + TAB_OFF + 320);
    if (F.tid < 32) { const int c = (int)__hip_atomic_load((unsigned*)(F.ctl + CW_CNT + 64 * F.tid), RLX_AGENT); tinfo[4 + F.tid] = (c + 255) >> 8; tinfo[72 + F.tid] = c; }
    __syncthreads();
    if (F.tid == 0) { int a = 0; for (int e = 0; e < 32; ++e) { const int n = tinfo[4 + e]; tinfo[40 + e] = a; for (int j = 0; j < n; ++j) tab[a + j] = (unsigned char)e; a += n; } tinfo[0] = a; }
    __syncthreads();
    return tinfo[0];
}
__device__ __forceinline__ void phase8(Frame& F) {
    const bf16* H2 = (const bf16*)(F.ws + WS_H2); const bf16* YR = (const bf16*)(F.ws + WS_YR);
    const int* EIDX = (const int*)(F.ws + WS_ROUTE); const int* RANK = EIDX + TT * 4; (void)build_moe_tab(F); const LAS int* tinfo = (const LAS int*)(F.lds + TAB_OFF + 320);
    const int gw = F.bid * NWAVES + F.wave, NGW = F.G * NWAVES;
    for (int t = gw; t < TT; t += NGW) {
        int slot = 0; if (F.lane < 4) slot = 256 * tinfo[40 + EIDX[(size_t)t * 4 + F.lane]] + RANK[(size_t)t * 4 + F.lane];
        int sl[4]; sl[0] = __shfl(slot, 0); sl[1] = __shfl(slot, 1); sl[2] = __shfl(slot, 2); sl[3] = __shfl(slot, 3);
        float v[4][8]; float ss = 0.f;
#pragma unroll
        for (int j = 0; j < 4; ++j) { const int pz = F.lane + 64 * j; unpack8(*(const v4u*)(H2 + (size_t)t * DM + 8 * pz), v[j]); }
#pragma unroll
        for (int k = 0; k < 4; ++k)
#pragma unroll
            for (int j = 0; j < 4; ++j) { const v2u q = *((const v2u*)((const unsigned char*)YR + (size_t)sl[k] * DM) + F.lane + 64 * j);
                const f32x2 a0 = __builtin_amdgcn_cvt_pk_f32_fp8((int)q.x, false), a1 = __builtin_amdgcn_cvt_pk_f32_fp8((int)q.x, true), a2 = __builtin_amdgcn_cvt_pk_f32_fp8((int)q.y, false), a3 = __builtin_amdgcn_cvt_pk_f32_fp8((int)q.y, true);
                v[j][0] += a0.x * 0.0625f; v[j][1] += a0.y * 0.0625f; v[j][2] += a1.x * 0.0625f; v[j][3] += a1.y * 0.0625f; v[j][4] += a2.x * 0.0625f; v[j][5] += a2.y * 0.0625f; v[j][6] += a3.x * 0.0625f; v[j][7] += a3.y * 0.0625f; }
#pragma unroll
        for (int j = 0; j < 4; ++j)
#pragma unroll
            for (int i = 0; i < 8; ++i) ss += v[j][i] * v[j][i];
        const float rstd = 1.0f / sqrtf(wave_sum(ss) * (1.0f / 2048.0f) + EPSF);
#pragma unroll
        for (int j = 0; j < 4; ++j) { const int pz = F.lane + 64 * j; const f32x4 w0 = *(const f32x4*)(F.final_norm_w + 8 * pz), w1 = *(const f32x4*)(F.final_norm_w + 8 * pz + 4);
            *(f32x4*)(F.out + (size_t)t * DM + 8 * pz) = (f32x4){v[j][0] * rstd * w0.x, v[j][1] * rstd * w0.y, v[j][2] * rstd * w0.z, v[j][3] * rstd * w0.w};
            *(f32x4*)(F.out + (size_t)t * DM + 8 * pz + 4) = (f32x4){v[j][4] * rstd * w1.x, v[j][5] * rstd * w1.y, v[j][6] * rstd * w1.z, v[j][7] * rstd * w1.w}; }
    }
}

struct Args { const float* in[21]; float* out; unsigned char* ws; int ph_lo, ph_hi, li, pad; };
__global__ void __launch_bounds__(NWAVES * 64, 2) hymba_fwd(Args args) {
    extern __shared__ __attribute__((aligned(16))) unsigned char lds[];
    Frame F;
    F.lds = (LAS unsigned char*)lds; F.MISC = (volatile LAS unsigned*)(F.lds + MISC_OFF);
    F.tid = threadIdx.x; F.lane = F.tid & 63; F.wave = __builtin_amdgcn_readfirstlane(F.tid >> 6); F.G = gridDim.x; F.bid = blockIdx.x;
    F.ws = args.ws; F.ctl = (gu32*)(args.ws + WS_CTL); F.out = args.out;
    F.x = args.in[0]; F.norm1_w = args.in[1]; F.w_in = args.in[2]; F.conv_w = args.in[3]; F.conv_b = args.in[4]; F.dt_bias = args.in[5]; F.a_log = args.in[6]; F.d_skip = args.in[7]; F.ssd_norm_w = args.in[8];
    F.i_bias = args.in[9]; F.f_bias = args.in[10]; F.ml_norm_w = args.in[11]; F.w_out = args.in[12]; F.norm2_w = args.in[13]; F.router_w = args.in[14]; F.router_b = args.in[15];
    F.w_gate_up = args.in[16]; F.b_gate_up = args.in[17]; F.w_down = args.in[18]; F.b_down = args.in[19]; F.final_norm_w = args.in[20];
    for (int u = F.tid; u < (LDS_BYTES - LDSCTL_OFF) / 4; u += NWAVES * 64) ((LAS unsigned*)(F.lds + LDSCTL_OFF))[u] = 0u;
    __syncthreads();
    XcdBarrier bar; bar.bar = (unsigned*)(F.ctl + CW_BAR) + args.li * XCD_BAR_WORDS; bar.x = 0; bar.st = nullptr;
    const bool use_bar = (args.ph_hi - args.ph_lo) > 1;
    if (use_bar) bar = xcd_barrier_post((unsigned*)(F.ctl + CW_BAR) + args.li * XCD_BAR_WORDS, F.MISC + 8);
    const int lo = args.ph_lo, hi = args.ph_hi;
#ifndef PHASE_MASK
#define PHASE_MASK 0x1ff
#endif
#define IN(k) (((PHASE_MASK >> (k)) & 1) && lo <= (k) && (k) < hi)
#define SEAM(k) do { if (IN(k) && IN((k) + 1)) xcd_barrier(bar); } while (0)
    if (IN(0)) { phase0(F); } SEAM(0);
    if (IN(1)) {
        pg8::Gemm g{(const pg8::bf16_t*)(F.ws + WS_XN1), (const pg8::bf16_t*)(F.ws + WS_WIN), TT, NPROJ, DM}; pg8::StaticOrder S; S.init(TT, NPROJ, F.G, F.bid);
        pg8::EpiBf16 E{(pg8::bf16_t*)(F.ws + WS_PROJ), NPROJ};
        pg8::gemm_phase<pg8::EpiBf16, pg8::StaticOrder, true, true>(F.lds, g, S, E);
        p1_small(F);
    } SEAM(1);
    if (IN(2)) { phase_conv(F); } SEAM(2);
    if (IN(3)) { phase_mixer(F); } SEAM(3);
    if (IN(4)) {
        pg8::Gemm g{(const pg8::bf16_t*)(F.ws + WS_YMIX), (const pg8::bf16_t*)(F.ws + WS_WOUT), TT, DM, 4096}; pg8::StaticOrder S; S.init(TT, DM, F.G, F.bid);
        pg8::EpiResNorm E{(pg8::bf16_t*)(F.ws + WS_H2), F.x, DM, (const float*)(F.ws + WS_SSQ), (PG8_LAS float*)(F.lds + RING_BYTES), EPSF};
        pg8::gemm_phase<pg8::EpiResNorm, pg8::StaticOrder, true, true>(F.lds, g, S, E);
    } SEAM(4);
    if (IN(5)) { phase5(F); } SEAM(5);
    if (IN(6)) {
        const int nM = build_moe_tab(F);
        const LAS int* tinfo = (const LAS int*)(F.lds + TAB_OFF + 320); LAS unsigned short* rt = (LAS unsigned short*)(F.lds + ROWTAB_OFF);
        pg8::Gemm g{(const pg8::bf16_t*)(F.ws + WS_XN2), (const pg8::bf16_t*)(F.ws + WS_WGU), nM * 256, 4096, DM};
        pg8::MoeOrder S{nM, 16, 4, nM * 16, F.G, F.bid, (const PG8_LAS unsigned char*)(F.lds + TAB_OFF), (const PG8_LAS unsigned short*)rt};
        { const int* TOKL = (const int*)(F.ws + WS_XG);
          for (int i = 0; i < 18; ++i) { pg8::Unit u; if (!S.next(i, u)) break; const int e = u.pn >> 4, rank = (u.pm - tinfo[40 + e]) * 256 + (F.tid & 255);
              if (F.tid < 256) rt[i * 256 + F.tid] = (unsigned short)(rank < tinfo[72 + e] ? TOKL[(size_t)e * TT + rank] : 0); }
          __syncthreads(); }
        pg8::EpiSwiglu E{(unsigned char*)(F.ws + WS_ACT), F.b_gate_up, (PG8_LAS float*)(F.lds + EPIV_OFF)};
        pg8::gemm_phase<pg8::EpiSwiglu, pg8::MoeOrder, true, true, true, true>(F.lds, g, S, E);
    } SEAM(6);
    if (IN(7)) {
        const int nM = build_moe_tab(F);
        pg8::Gemm g{(const pg8::bf16_t*)(F.ws + WS_ACT), (const pg8::bf16_t*)(F.ws + WS_WD), nM * 256, 2048, DM};
        pg8::MoeOrder S{nM, 8, 3, nM * 8, F.G, F.bid, (const PG8_LAS unsigned char*)(F.lds + TAB_OFF), nullptr};
        pg8::EpiDown E{(pg8::bf16_t*)(F.ws + WS_YR), F.b_down, (const float*)(F.ws + WS_XG + 4 * MiB), (const PG8_LAS int*)(F.lds + TAB_OFF + 320), (PG8_LAS float*)(F.lds + EPIV_OFF)};
        pg8::gemm_phase<pg8::EpiDown, pg8::MoeOrder, true, true, true>(F.lds, g, S, E);
    } SEAM(7);
    if (IN(8)) { phase8(F); }
#undef IN
#undef SEAM
}

extern "C" void kernel_launch(void* const* d_in, const int* in_sizes, int n_in, void* d_out, int out_size, void* d_ws, size_t ws_size, hipStream_t stream) {
    static int grid = 0;
    if (grid == 0) {
        if (n_in != 21 || out_size != TT * DM || ws_size < WS_END) { fprintf(stderr, "kernel_launch: unexpected problem (n_in %d, out %d, ws %zu); nothing launched\n", n_in, out_size, ws_size); grid = -1; return; }
        int dev = 0, cus = 0, per_cu = 0;
        if (hipGetDevice(&dev) != hipSuccess || hipDeviceGetAttribute(&cus, hipDeviceAttributeMultiprocessorCount, dev) != hipSuccess) { grid = -1; return; }
        if (hipFuncSetAttribute((const void*)hymba_fwd, hipFuncAttributeMaxDynamicSharedMemorySize, LDS_BYTES) != hipSuccess) { fprintf(stderr, "kernel_launch: hipFuncSetAttribute failed\n"); grid = -1; return; }
        if (hipOccupancyMaxActiveBlocksPerMultiprocessor(&per_cu, (const void*)hymba_fwd, NWAVES * 64, LDS_BYTES) != hipSuccess || per_cu < 1) { fprintf(stderr, "kernel_launch: occupancy query says %d blocks per CU\n", per_cu); }
        (void)hipGetLastError();
        grid = cus;
    }
    if (grid < 0) return;
    (void)hipMemsetAsync((char*)d_ws + WS_CTL, 0, CTL_ZERO_BYTES, stream);
    Args a{};
    for (int i = 0; i < 21; ++i) a.in[i] = (const float*)d_in[i];
    a.out = (float*)d_out; a.ws = (unsigned char*)d_ws; a.pad = 0;
#if MK_PER_PHASE
    for (int li = 0; li < N_PHASES; ++li) { a.ph_lo = li; a.ph_hi = li + 1; a.li = li; hipLaunchKernelGGL(hymba_fwd, dim3(grid), dim3(NWAVES * 64), LDS_BYTES, stream, a); }
#else
    a.ph_lo = 0; a.ph_hi = N_PHASES; a.li = 0;
    hipLaunchKernelGGL(hymba_fwd, dim3(grid), dim3(NWAVES * 64), LDS_BYTES, stream, a);
#endif
}
```

```cpp
#include <hip/hip_runtime.h>
#include <cstdio>
#include <cstdint>
namespace pg8 {
#define PG8_LAS __attribute__((address_space(3)))
typedef unsigned short bf16_t;
typedef short bf16x8 __attribute__((ext_vector_type(8)));
typedef float f32x4 __attribute__((ext_vector_type(4)));
typedef unsigned u32x4 __attribute__((ext_vector_type(4)));
constexpr int BM = 256, BK = 64, HALF = 128, HTB = HALF * BK * 2  , STAGE_BYTES = 8 * HTB, NXCD = 8, WGM = 4;

__host__ __device__ __forceinline__ int lds_byte(int r, int c) { const int st = (r >> 4) * 2 + (c >> 5), rr = r & 15, cc = c & 31, ob = rr * 64 + cc * 2; return st * 1024 + (ob ^ (((ob >> 9) & 1) << 5)); }
__host__ __device__ __forceinline__ void stage_rc(int b, int& R, int& C) { const int st = b / 1024, sb = b % 1024, swz = sb ^ (((sb >> 9) & 1) << 5); R = (st >> 1) * 16 + swz / 64; C = (st & 1) * 32 + (swz % 64) / 2; }
__host__ __device__ __forceinline__ int perm32(int rho) { const int n = rho >> 4, i = rho & 15; return 8 * (i >> 2) + 4 * n + (i & 3); }

struct Unit { int pm, pn, par; };
struct Gemm { const bf16_t* A; const bf16_t* Bt; int M, N, K; };

struct StaticOrder {
    int nM, nN, nwg, G, c;
    __host__ __device__ void init(int M, int N, int G_, int c_) { nM = M / BM; nN = N / BM; nwg = nM * nN; G = G_; c = c_; }
    __host__ __device__ bool next(int i, Unit& u) const {
        const long L = (long)i * G + c; if (L >= nwg) return false;
        int wgid = (int)L; { const int q = nwg / NXCD, r = nwg % NXCD, xcd = wgid % NXCD, off = wgid / NXCD; wgid = (xcd < r ? xcd * (q + 1) : r * (q + 1) + (xcd - r) * q) + off; }
        const int nig = WGM * nN, gid = wgid / nig, fm = gid * WGM, gsz = (nM - fm) < WGM ? (nM - fm) : WGM;
        u.pm = fm + ((wgid % nig) % gsz); u.pn = (wgid % nig) / gsz; return true;
    }
    __device__ __forceinline__ const PG8_LAS unsigned short* rowp(int) const { return nullptr; }
    __device__ __forceinline__ void a_ready(const Unit&) const {}
    __device__ __forceinline__ void done(const Unit&) const {}
};


__device__ __forceinline__ unsigned cvt_pk_bf16(float lo, float hi) { unsigned r; asm volatile("v_cvt_pk_bf16_f32 %0, %1, %2" : "=v"(r) : "v"(lo), "v"(hi)); return r; }
typedef unsigned u32x2 __attribute__((ext_vector_type(2)));

struct EpiBf16 {
    static constexpr bool PERM = true, AFTER_DRAIN = false;
    bf16_t* O; int ldc;
    __device__ __forceinline__ void operator()(const f32x4 (&acc)[2][2][4][2], const Unit& u, int wr, int wc, int fr, int fq) const {
        const int row0 = u.pm * BM + wr * 64 + fr; const int col0 = u.pn * BM + wc * 32 + 8 * fq;
#pragma unroll
        for (int ai = 0; ai < 2; ++ai)
#pragma unroll
            for (int m = 0; m < 4; ++m) { bf16_t* rowp = O + (size_t)(row0 + ai * HALF + m * 16) * ldc + col0;
#pragma unroll
                for (int bj = 0; bj < 2; ++bj) { const f32x4 v0 = acc[ai][bj][m][0], v1 = acc[ai][bj][m][1];
                    u32x4 w; w.x = cvt_pk_bf16(v0[0], v0[1]); w.y = cvt_pk_bf16(v0[2], v0[3]); w.z = cvt_pk_bf16(v1[0], v1[1]); w.w = cvt_pk_bf16(v1[2], v1[3]);
                    *(u32x4*)(rowp + bj * HALF) = w; } }
    }
};
struct EpiResNorm {
    static constexpr bool PERM = true, AFTER_DRAIN = false, KSCALE = true;
    bf16_t* C; const float* base; int ldc; const float* ssq; PG8_LAS float* tabl; float eps;
    __device__ __forceinline__ void build(const Unit& u, int tid) const {
        const int row = tid & 255, part = tid >> 8; const size_t t = (size_t)u.pm * BM + row; float rs[7];
        if (part == 0) { const f32x4* p = (const f32x4*)(ssq + t * 32);
#pragma unroll
            for (int g = 0; g < 4; ++g) { const f32x4 a = p[2 * g], b = p[2 * g + 1]; rs[g] = 1.0f / sqrtf(((a.x + a.y) + (a.z + a.w) + (b.x + b.y) + (b.z + b.w)) * (1.0f / 512.0f) + eps); }
            const f32x4* q = (const f32x4*)(ssq + (size_t)16384 * 32 + t * 32);
#pragma unroll
            for (int h = 0; h < 3; ++h) { const f32x4 a = q[h]; rs[4 + h] = 1.0f / sqrtf(((a.x + a.y) + (a.z + a.w)) * (1.0f / 256.0f) + eps); }
        } else { const f32x4* q = (const f32x4*)(ssq + (size_t)16384 * 32 + t * 32);
#pragma unroll
            for (int h = 0; h < 6; ++h) { const f32x4 a = q[2 + h]; rs[h] = 1.0f / sqrtf(((a.x + a.y) + (a.z + a.w)) * (1.0f / 256.0f) + eps); }
            rs[6] = 1.0f; }
        PG8_LAS float* d = tabl + row * 12 + 6 * part;
#pragma unroll
        for (int s = 0; s < 6; ++s) d[s] = (part == 1 && s == 5) ? rs[5] : rs[s] / rs[s + 1];
    }
    __device__ __forceinline__ void kscale(f32x4 (&acc)[2][2][4][2], int t, int nt, int wr, int fr) const {
        const int kt = t + 1; const bool segend = kt < 32 ? ((kt & 7) == 7) : ((kt & 3) == 3);
        if (segend && kt != nt - 1) { const int sg = kt < 32 ? (kt >> 3) : 4 + ((kt - 32) >> 2);
#pragma unroll
            for (int ai = 0; ai < 2; ++ai)
#pragma unroll
                for (int m = 0; m < 4; ++m) { const float r = tabl[(ai * HALF + wr * 64 + m * 16 + fr) * 12 + sg];
#pragma unroll
                    for (int bj = 0; bj < 2; ++bj)
#pragma unroll
                        for (int n = 0; n < 2; ++n) acc[ai][bj][m][n] = acc[ai][bj][m][n] * r; } }
    }
    __device__ __forceinline__ void operator()(const f32x4 (&acc)[2][2][4][2], const Unit& u, int wr, int wc, int fr, int fq) const {
        const int row0 = u.pm * BM + wr * 64 + fr, col0 = u.pn * BM + wc * 32 + 8 * fq;
#pragma unroll
        for (int ai = 0; ai < 2; ++ai)
#pragma unroll
            for (int m = 0; m < 4; ++m) { const size_t off = (size_t)(row0 + ai * HALF + m * 16) * ldc + col0; const float r = tabl[(ai * HALF + wr * 64 + m * 16 + fr) * 12 + 11];
#pragma unroll
                for (int bj = 0; bj < 2; ++bj) { const f32x4 v0 = acc[ai][bj][m][0] * r + *(const f32x4*)(base + off + bj * HALF), v1 = acc[ai][bj][m][1] * r + *(const f32x4*)(base + off + bj * HALF + 4);
                    u32x4 w; w.x = cvt_pk_bf16(v0[0], v0[1]); w.y = cvt_pk_bf16(v0[2], v0[3]); w.z = cvt_pk_bf16(v1[0], v1[1]); w.w = cvt_pk_bf16(v1[2], v1[3]);
                    *(u32x4*)(C + off + bj * HALF) = w; } }
    }
};
struct EpiResF32 {
    static constexpr bool PERM = false, AFTER_DRAIN = false;
    float* C; const float* base; int ldc;
    __device__ __forceinline__ void operator()(const f32x4 (&acc)[2][2][4][2], const Unit& u, int wr, int wc, int fr, int fq) const {
        const int row0 = u.pm * BM + wr * 64 + fr, col0 = u.pn * BM + wc * 32 + 4 * fq;
#pragma unroll
        for (int ai = 0; ai < 2; ++ai)
#pragma unroll
            for (int m = 0; m < 4; ++m) { const size_t off = (size_t)(row0 + ai * HALF + m * 16) * ldc + col0;
#pragma unroll
                for (int bj = 0; bj < 2; ++bj)
#pragma unroll
                    for (int n = 0; n < 2; ++n) *(f32x4*)(C + off + bj * HALF + n * 16) = acc[ai][bj][m][n] + *(const f32x4*)(base + off + bj * HALF + n * 16); }
    }
};
__device__ __forceinline__ float swiglu1(float a, float b) {
    const float glu = fminf(a, 7.0f), lin = fminf(fmaxf(b, -7.0f), 7.0f);
    return glu * __builtin_amdgcn_rcpf(1.0f + __expf(-1.702f * glu)) * (lin + 1.0f);
}
struct EpiSwiglu {
    static constexpr bool PERM = true, AFTER_DRAIN = false, PREFETCH = true;
    unsigned char* O; const float* bias; PG8_LAS float* slot;
    __device__ __forceinline__ void prefetch(const Unit& u, int wid, int lane) const {
        if (wid == 0) { const int e = u.pn >> 4, pnl = u.pn & 15;
            __builtin_amdgcn_global_load_lds((const unsigned*)(bias + (size_t)e * 4096 + pnl * BM + 4 * lane), (PG8_LAS unsigned*)(slot + u.par * 256), 16, 0, 0); }
    }
    __device__ __forceinline__ void operator()(const f32x4 (&acc)[2][2][4][2], const Unit& u, int wr, int wc, int fr, int fq) const {
        const int pnl = u.pn & 15;
        const int row0 = u.pm * BM + wr * 64 + fr; const int hcol0 = pnl * BM + wc * 32 + 8 * fq;
        const PG8_LAS float* bp = slot + u.par * 256 + wc * 32 + 8 * fq;
        f32x4 bv[2][2];
#pragma unroll
        for (int bj = 0; bj < 2; ++bj)
#pragma unroll
            for (int n = 0; n < 2; ++n) bv[bj][n] = *(const PG8_LAS f32x4*)(bp + bj * HALF + 4 * n);
#pragma unroll
        for (int ai = 0; ai < 2; ++ai)
#pragma unroll
            for (int m = 0; m < 4; ++m) { unsigned char* rowp = O + (size_t)(row0 + ai * HALF + m * 16) * 2048 + (hcol0 >> 1);
#pragma unroll
                for (int bj = 0; bj < 2; ++bj) { const f32x4 v0 = acc[ai][bj][m][0] + bv[bj][0], v1 = acc[ai][bj][m][1] + bv[bj][1];
                    int w = __builtin_amdgcn_cvt_pk_fp8_f32(swiglu1(v0[0], v0[1]), swiglu1(v0[2], v0[3]), 0, false);
                    w = __builtin_amdgcn_cvt_pk_fp8_f32(swiglu1(v1[0], v1[1]), swiglu1(v1[2], v1[3]), w, true);
                    *(int*)(rowp + bj * 64) = w; } }
    }
};
struct EpiDown {
    static constexpr bool PERM = true, AFTER_DRAIN = false, PREFETCH = true;
    bf16_t* O; const float* bias; const float* gatel; const PG8_LAS int* tinfo; PG8_LAS float* slot;
    __device__ __forceinline__ void prefetch(const Unit& u, int wid, int lane) const {
        const int e = u.pn >> 3, pnl = u.pn & 7;
        if (wid == 0) __builtin_amdgcn_global_load_lds((const unsigned*)(bias + (size_t)e * 2048 + pnl * BM + 4 * lane), (PG8_LAS unsigned*)(slot + u.par * 512), 16, 0, 0);
        if (wid == 1) __builtin_amdgcn_global_load_lds((const unsigned*)(gatel + (size_t)e * 16384 + (size_t)(u.pm - tinfo[40 + e]) * BM + 4 * lane), (PG8_LAS unsigned*)(slot + u.par * 512 + 256), 16, 0, 0);
    }
    __device__ __forceinline__ void operator()(const f32x4 (&acc)[2][2][4][2], const Unit& u, int wr, int wc, int fr, int fq) const {
        const int pnl = u.pn & 7;
        const int row0 = u.pm * BM + wr * 64 + fr; const int col0 = pnl * BM + wc * 32 + 8 * fq;
        const PG8_LAS float* bp = slot + u.par * 512 + wc * 32 + 8 * fq; const PG8_LAS float* gp = slot + u.par * 512 + 256 + wr * 64 + fr;
        f32x4 bv[2][2];
#pragma unroll
        for (int bj = 0; bj < 2; ++bj)
#pragma unroll
            for (int n = 0; n < 2; ++n) bv[bj][n] = *(const PG8_LAS f32x4*)(bp + bj * HALF + 4 * n);
#pragma unroll
        for (int ai = 0; ai < 2; ++ai)
#pragma unroll
            for (int m = 0; m < 4; ++m) { const int row = row0 + ai * HALF + m * 16; const float gt = gp[ai * HALF + m * 16] * 16.0f; unsigned char* rowp = (unsigned char*)O + (size_t)row * 2048 + col0;
#pragma unroll
                for (int bj = 0; bj < 2; ++bj) { const f32x4 v0 = (acc[ai][bj][m][0] + bv[bj][0]) * gt, v1 = (acc[ai][bj][m][1] + bv[bj][1]) * gt;
                    int w0 = __builtin_amdgcn_cvt_pk_fp8_f32(v0[0], v0[1], 0, false); w0 = __builtin_amdgcn_cvt_pk_fp8_f32(v0[2], v0[3], w0, true);
                    int w1 = __builtin_amdgcn_cvt_pk_fp8_f32(v1[0], v1[1], 0, false); w1 = __builtin_amdgcn_cvt_pk_fp8_f32(v1[2], v1[3], w1, true);
                    *(u32x2*)(rowp + bj * HALF) = (u32x2){(unsigned)w0, (unsigned)w1}; } }
    }
};
struct MoeOrder {
    int nM, nN, nsh, nwg, G, c; const PG8_LAS unsigned char* tab; const PG8_LAS unsigned short* rt;
    __device__ __forceinline__ const PG8_LAS unsigned short* rowp(int ui) const { return rt + ui * 256; }
    __device__ __forceinline__ bool next(int i, Unit& u) const {
        const long L = (long)i * G + c; if (L >= nwg) return false;
        int wgid = (int)L; { const int q = nwg / NXCD, r = nwg % NXCD, xcd = wgid % NXCD, off = wgid / NXCD; wgid = (xcd < r ? xcd * (q + 1) : r * (q + 1) + (xcd - r) * q) + off; }
        const int nig = WGM * nN, gid = wgid / nig, fm = gid * WGM, gsz = (nM - fm) < WGM ? (nM - fm) : WGM;
        const int pm = fm + ((wgid % nig) % gsz), pnl = (wgid % nig) / gsz;
        u.pm = pm; u.pn = ((int)tab[pm] << nsh) + pnl; return true;
    }
    __device__ __forceinline__ void a_ready(const Unit&) const {}
    __device__ __forceinline__ void done(const Unit&) const {}
};
template <class E, class = void> struct epi_pref { static constexpr bool value = false; };
template <class E> struct epi_pref<E, decltype((void)E::PREFETCH)> { static constexpr bool value = E::PREFETCH; };
template <class E, class = void> struct epi_kscale { static constexpr bool value = false; };
template <class E> struct epi_kscale<E, decltype((void)E::KSCALE)> { static constexpr bool value = E::KSCALE; };
typedef int v8i32 __attribute__((ext_vector_type(8)));
__device__ __forceinline__ v8i32 pg8_cat(const bf16x8 lo, const bf16x8 hi) { typedef int v4i32 __attribute__((ext_vector_type(4))); const v4i32 a = __builtin_bit_cast(v4i32, lo), b = __builtin_bit_cast(v4i32, hi); return __builtin_shufflevector(a, b, 0, 1, 2, 3, 4, 5, 6, 7); }
template <class Epi, class Sched, bool ALIGN_EPI = false, bool SP2 = false, bool F8 = false, bool GA = false>
__device__ __forceinline__ void gemm_phase(PG8_LAS unsigned char* lds, const Gemm g, const Sched& S, const Epi& E) {
    const int tid = threadIdx.x, wid = __builtin_amdgcn_readfirstlane(tid >> 6), lane = tid & 63, wr = wid >> 2, wc = wid & 3, fr = lane & 15, fq = lane >> 4;
    const int K = g.K, KB = F8 ? K : 2 * K, nt = KB / 128;
    unsigned voffA[2], voffB[2]; int gaR[2]; unsigned gaC[2]; static_assert(!GA || SP2, "gathered A needs the SP2 loop");
#pragma unroll
    for (int i = 0; i < 2; ++i) { int R, C; stage_rc(tid * 16 + i * 8192, R, C); const int Rb = Epi::PERM ? ((R & ~31) + perm32(R & 31)) : R;
        voffA[i] = (unsigned)(R * KB + C * 2); voffB[i] = (unsigned)(Rb * KB + C * 2); gaR[i] = R; gaC[i] = (unsigned)(C * 2); }
    const size_t kstep = (size_t)(BK * 2);
    const size_t hstep = (size_t)HALF * KB;
    const size_t tstep = 2 * hstep;
    const unsigned ldsw = (unsigned)wid * 1024u;
    int aoffk[2], boffk[2];
#pragma unroll
    for (int h = 0; h < 2; ++h) { aoffk[h] = lds_byte(wr * 64 + fr, fq * 8) + h * 1024; boffk[h] = lds_byte(wc * 32 + fr, fq * 8) + h * 1024; }
#define PG8_SA(b, h) (((b) * 2 + (h)) * HTB)
#define PG8_SB(b, h) ((4 + (b) * 2 + (h)) * HTB)
#define PG8_STAGE(bufoff, gbase, voff) do { _Pragma("unroll") for (int _i = 0; _i < 2; ++_i) \
        __builtin_amdgcn_global_load_lds((const unsigned*)((const char*)(gbase) + (voff)[_i]), (PG8_LAS unsigned*)(lds + (bufoff) + ldsw + _i * 8192), 16, 0, 0); } while (0)
#define PG8_STAGE_A(bufoff, kptr, h, usenext) do { if constexpr (GA) { _Pragma("unroll") for (int _i = 0; _i < 2; ++_i) { const unsigned _o = (usenext) ? gn[h][_i] : gc[h][_i]; \
            __builtin_amdgcn_global_load_lds((const unsigned*)((const char*)(kptr) + _o), (PG8_LAS unsigned*)(lds + (bufoff) + ldsw + _i * 8192), 16, 0, 0); } } \
        else { PG8_STAGE(bufoff, (kptr) + (h) * hstep, voffA); } } while (0)
#define PG8_GROWS(dst, ui_) do { const PG8_LAS unsigned short* _rt = S.rowp(ui_); _Pragma("unroll") for (int _h = 0; _h < 2; ++_h) _Pragma("unroll") for (int _i = 0; _i < 2; ++_i) dst[_h][_i] = (unsigned)_rt[gaR[_i] + 128 * _h] * (unsigned)KB + gaC[_i]; } while (0)
#define PG8_LDA(dst, b, h) do { if constexpr (F8) { _Pragma("unroll") for (int m = 0; m < 4; ++m) dst##8[m] = pg8_cat(*(const PG8_LAS bf16x8*)(lds + PG8_SA(b, h) + aoffk[0] + m * 2048), *(const PG8_LAS bf16x8*)(lds + PG8_SA(b, h) + aoffk[1] + m * 2048)); } \
        else { _Pragma("unroll") for (int m = 0; m < 4; ++m) _Pragma("unroll") for (int k = 0; k < 2; ++k) dst[m][k] = *(const PG8_LAS bf16x8*)(lds + PG8_SA(b, h) + aoffk[k] + m * 2048); } } while (0)
#define PG8_LDB(dst, b, h) do { if constexpr (F8) { _Pragma("unroll") for (int n = 0; n < 2; ++n) dst##8[n] = pg8_cat(*(const PG8_LAS bf16x8*)(lds + PG8_SB(b, h) + boffk[0] + n * 2048), *(const PG8_LAS bf16x8*)(lds + PG8_SB(b, h) + boffk[1] + n * 2048)); } \
        else { _Pragma("unroll") for (int n = 0; n < 2; ++n) _Pragma("unroll") for (int k = 0; k < 2; ++k) dst[n][k] = *(const PG8_LAS bf16x8*)(lds + PG8_SB(b, h) + boffk[k] + n * 2048); } } while (0)
#define PG8_MMA(ai, bj, At, Bt) do { __builtin_amdgcn_s_setprio(1); \
        if constexpr (F8) { _Pragma("unroll") for (int m = 0; m < 4; ++m) _Pragma("unroll") for (int n = 0; n < 2; ++n) \
            asm volatile("v_mfma_scale_f32_16x16x128_f8f6f4 %0, %1, %2, %0, %3, %4 op_sel_hi:[0,0,0]" : "+v"(acc[ai][bj][m][n]) : "v"(Bt##8[n]), "v"(At##8[m]), "v"(sc_w), "v"(sc_a)); } \
        else { _Pragma("unroll") for (int m = 0; m < 4; ++m) _Pragma("unroll") for (int n = 0; n < 2; ++n) _Pragma("unroll") for (int k = 0; k < 2; ++k) \
            acc[ai][bj][m][n] = __builtin_amdgcn_mfma_f32_16x16x32_bf16(Bt[n][k], At[m][k], acc[ai][bj][m][n], 0, 0, 0); } \
        __builtin_amdgcn_s_setprio(0); } while (0)
#define PG8_WAIT_V(n) asm volatile("s_waitcnt vmcnt(" #n ")" ::: "memory")
#define PG8_WAIT_L(n) asm volatile("s_waitcnt lgkmcnt(" #n ")" ::: "memory")
#define PG8_BAR __builtin_amdgcn_s_barrier()
#define PG8_SCHED __builtin_amdgcn_sched_barrier(0)
    Unit cur, nxt; int ui = 0;
    if (!S.next(0, cur)) return;
    cur.par = 0;
    f32x4 acc[2][2][4][2];
#pragma unroll
    for (int a = 0; a < 2; ++a)
#pragma unroll
        for (int b = 0; b < 2; ++b)
#pragma unroll
            for (int m = 0; m < 4; ++m)
#pragma unroll
                for (int n = 0; n < 2; ++n) acc[a][b][m][n] = (f32x4){0.f, 0.f, 0.f, 0.f};
    const int sc_w = 0x79797979, sc_a = 0x7f7f7f7f;
    bf16x8 At[4][2], B0[2][2], B1[2][2]; v8i32 At8[4], B08[2], B18[2];
    const char* cA = (const char*)g.A + (GA ? (size_t)0 : (size_t)cur.pm * tstep); const char* cB = (const char*)g.Bt + (size_t)cur.pn * tstep;
    unsigned gc[2][2] = {{0u, 0u}, {0u, 0u}}, gn[2][2] = {{0u, 0u}, {0u, 0u}};
    if constexpr (GA) { PG8_GROWS(gc, 0); }
    if constexpr (epi_kscale<Epi>::value) { E.build(cur, tid); asm volatile("s_waitcnt lgkmcnt(0)" ::: "memory"); PG8_BAR; asm volatile("" ::: "memory"); }
    S.a_ready(cur);
    if constexpr (SP2) {
        PG8_STAGE(PG8_SB(0, 0), cB, voffB); PG8_STAGE(PG8_SB(0, 1), cB + hstep, voffB); PG8_STAGE_A(PG8_SA(0, 0), cA, 0, false); PG8_STAGE_A(PG8_SA(0, 1), cA, 1, false);
        if (wr == 1) PG8_BAR;
        PG8_WAIT_V(2); PG8_BAR;
        PG8_STAGE(PG8_SB(1, 0), cB + kstep, voffB); PG8_STAGE_A(PG8_SA(1, 0), cA + kstep, 0, false); PG8_STAGE(PG8_SB(1, 1), cB + hstep + kstep, voffB);
        PG8_WAIT_V(6); PG8_BAR;
    } else {
        PG8_STAGE(PG8_SB(0, 0), cB, voffB); PG8_STAGE(PG8_SA(0, 0), cA, voffA); PG8_STAGE(PG8_SB(0, 1), cB + hstep, voffB); PG8_STAGE(PG8_SA(0, 1), cA + hstep, voffA);
        if (wr == 1) PG8_BAR;
        PG8_WAIT_V(4); PG8_BAR;
        PG8_STAGE(PG8_SB(1, 0), cB + kstep, voffB); PG8_STAGE(PG8_SA(1, 0), cA + kstep, voffA); PG8_STAGE(PG8_SB(1, 1), cB + hstep + kstep, voffB);
        PG8_WAIT_V(6); PG8_BAR;
    }
    for (;;) {
        const bool has_next = S.next(ui + 1, nxt); nxt.par = (ui + 1) & 1;
        const char* nA = (has_next && !GA) ? (const char*)g.A + (size_t)nxt.pm * tstep : cA; const char* nB = has_next ? (const char*)g.Bt + (size_t)nxt.pn * tstep : cB;
        if constexpr (GA) { if (has_next) { PG8_GROWS(gn, ui + 1); } else {
#pragma unroll
            for (int _h = 0; _h < 2; ++_h) { gn[_h][0] = gc[_h][0]; gn[_h][1] = gc[_h][1]; } } }
        for (int t = 0; t < nt; t += 2) {
            const bool last = (t == nt - 2);
            const char* a1 = cA + (size_t)(t + 1) * kstep;
            const char* a2 = last ? nA : cA + (size_t)(t + 2) * kstep; const char* b2 = last ? nB : cB + (size_t)(t + 2) * kstep;
            const char* a3 = a2 + kstep; const char* b3 = b2 + kstep;
            if (last && has_next) S.a_ready(nxt);
            if constexpr (epi_pref<Epi>::value) { if (t == 0) E.prefetch(cur, wid, lane); }
            if constexpr (SP2) {
            PG8_LDB(B0, 0, 0); PG8_LDB(B1, 0, 1); PG8_SCHED; PG8_LDA(At, 0, 0); PG8_STAGE_A(PG8_SA(1, 1), a1, 1, false);
            PG8_WAIT_V(8); PG8_WAIT_L(0); PG8_BAR; PG8_MMA(0, 0, At, B0); PG8_MMA(0, 1, At, B1); PG8_BAR; PG8_SCHED;
            PG8_LDA(At, 0, 1); PG8_STAGE(PG8_SB(0, 0), b2, voffB); PG8_STAGE(PG8_SB(0, 1), b2 + hstep, voffB); PG8_STAGE_A(PG8_SA(0, 0), a2, 0, last);
            PG8_WAIT_V(8); PG8_WAIT_L(0); PG8_BAR; PG8_MMA(1, 0, At, B0); PG8_MMA(1, 1, At, B1); PG8_BAR; PG8_SCHED;
            PG8_LDB(B0, 1, 0); PG8_LDB(B1, 1, 1); PG8_SCHED; PG8_LDA(At, 1, 0); PG8_STAGE_A(PG8_SA(0, 1), a2, 1, last);
            PG8_WAIT_V(8); PG8_WAIT_L(0); PG8_BAR; PG8_MMA(0, 0, At, B0); PG8_MMA(0, 1, At, B1); PG8_BAR; PG8_SCHED;
            PG8_LDA(At, 1, 1); PG8_STAGE(PG8_SB(1, 0), b3, voffB); PG8_STAGE(PG8_SB(1, 1), b3 + hstep, voffB); PG8_STAGE_A(PG8_SA(1, 0), a3, 0, last);
            PG8_WAIT_V(8); PG8_WAIT_L(0); PG8_BAR; PG8_MMA(1, 0, At, B0); PG8_MMA(1, 1, At, B1); PG8_BAR; PG8_SCHED;
            if constexpr (epi_kscale<Epi>::value) { E.kscale(acc, t, nt, wr, fr); PG8_SCHED; }
            } else {
            PG8_LDB(B0, 0, 0); PG8_SCHED; PG8_LDA(At, 0, 0); PG8_STAGE(PG8_SA(1, 1), a1 + hstep, voffA);
            PG8_WAIT_L(8); PG8_BAR; PG8_WAIT_L(0); PG8_MMA(0, 0, At, B0); PG8_BAR; PG8_SCHED;
            PG8_LDB(B1, 0, 1); PG8_STAGE(PG8_SB(0, 0), b2, voffB);
            PG8_BAR; PG8_WAIT_L(0); PG8_MMA(0, 1, At, B1); PG8_BAR;
            PG8_LDA(At, 0, 1); PG8_STAGE(PG8_SA(0, 0), a2, voffA);
            PG8_BAR; PG8_WAIT_L(0); PG8_MMA(1, 0, At, B0); PG8_BAR; PG8_SCHED;
            PG8_STAGE(PG8_SB(0, 1), b2 + hstep, voffB);
            PG8_WAIT_V(6); PG8_BAR; PG8_MMA(1, 1, At, B1); PG8_BAR;
            PG8_LDB(B0, 1, 0); PG8_SCHED; PG8_LDA(At, 1, 0); PG8_STAGE(PG8_SA(0, 1), a2 + hstep, voffA);
            PG8_WAIT_L(8); PG8_BAR; PG8_WAIT_L(0); PG8_MMA(0, 0, At, B0); PG8_BAR; PG8_SCHED;
            PG8_LDB(B1, 1, 1); PG8_STAGE(PG8_SB(1, 0), b3, voffB);
            PG8_BAR; PG8_WAIT_L(0); PG8_MMA(0, 1, At, B1); PG8_BAR;
            PG8_LDA(At, 1, 1); PG8_STAGE(PG8_SA(1, 0), a3, voffA);
            PG8_BAR; PG8_WAIT_L(0); PG8_MMA(1, 0, At, B0); PG8_BAR; PG8_SCHED;
            PG8_STAGE(PG8_SB(1, 1), b3 + hstep, voffB);
            PG8_WAIT_V(6); PG8_BAR; PG8_MMA(1, 1, At, B1); PG8_BAR;
            }
        }
        if constexpr (ALIGN_EPI) { if (wr == 0) PG8_BAR; }
        if constexpr (F8) asm volatile("s_nop 15\n\ts_nop 15" ::: "memory");
        if constexpr (!Epi::AFTER_DRAIN) { E(acc, cur, wr, wc, fr, fq); S.done(cur); }
        if (!has_next) break;
#pragma unroll
        for (int a = 0; a < 2; ++a)
#pragma unroll
            for (int b = 0; b < 2; ++b)
#pragma unroll
                for (int m = 0; m < 4; ++m)
#pragma unroll
                    for (int n = 0; n < 2; ++n) acc[a][b][m][n] = (f32x4){0.f, 0.f, 0.f, 0.f};
        if constexpr (epi_kscale<Epi>::value) { static_assert(!epi_kscale<Epi>::value || (ALIGN_EPI && SP2), "K-segment rescale needs aligned epilogues");
            asm volatile("s_waitcnt lgkmcnt(0)" ::: "memory"); PG8_BAR; asm volatile("" ::: "memory");
            E.build(nxt, tid); asm volatile("s_waitcnt lgkmcnt(0)" ::: "memory"); PG8_BAR; asm volatile("" ::: "memory"); }
        cur = nxt; cA = nA; cB = nB; ++ui;
        if constexpr (GA) {
#pragma unroll
            for (int _h = 0; _h < 2; ++_h) { gc[_h][0] = gn[_h][0]; gc[_h][1] = gn[_h][1]; } }
        if constexpr (ALIGN_EPI) { if (wr == 1) PG8_BAR; }
    }
    PG8_WAIT_V(0);
    if constexpr (!ALIGN_EPI) { if (wr == 0) PG8_BAR; }
    PG8_BAR;
    if constexpr (Epi::AFTER_DRAIN) { E.fused(acc, cur, wr, wc, fr, fq, lds, wid, lane); S.done(cur); }
#undef PG8_SA
#undef PG8_SB
#undef PG8_STAGE
#undef PG8_STAGE_A
#undef PG8_GROWS
#undef PG8_LDA
#undef PG8_LDB
#undef PG8_MMA
#undef PG8_WAIT_V
#undef PG8_WAIT_L
#undef PG8_BAR
#undef PG8_SCHED
}
}

constexpr int NWAVES = 8;
constexpr int TT = 16384, DM = 2048, SEQ = 2048;
constexpr int NPROJ = 11264;
constexpr int PC_Z = 0, PC_XBC = 2048, PC_Q = 5120, PC_K = 6144, PC_V = 7168, PC_O = 9216;
constexpr int WIN_LD = 11312;
constexpr int NSLOT = 65536 + 32 * 256;
constexpr float EPSF = 1e-5f;
#ifndef HSYNC_ON
#define HSYNC_ON 0
#endif
#define HWAIT() do { if (HSYNC_ON) asm volatile("s_waitcnt vmcnt(0) lgkmcnt(0)\n\ts_nop 15\n\ts_nop 15" ::: "memory"); } while (0)
#define HSYNC() do { if (HSYNC_ON) { HWAIT(); __syncthreads(); } } while (0)
#ifndef MK_PER_PHASE
#define MK_PER_PHASE 0
#endif
constexpr int N_PHASES = 9;

constexpr size_t MiB = 1u << 20;
constexpr size_t WS_CTL = 0, CTL_ZERO_BYTES = 1 * MiB;
constexpr size_t WS_WIN = 2 * MiB, WS_WSM = 46 * MiB, WS_WRT = 47 * MiB, WS_WOUT = 48 * MiB, WS_WGU = 64 * MiB, WS_WD = 576 * MiB;
constexpr size_t WS_XN1 = 832 * MiB, WS_PROJ = 896 * MiB, WS_SMALL = 1248 * MiB, WS_SSQ = 1252 * MiB, WS_YMIX = 1256 * MiB, WS_H2 = 1384 * MiB, WS_XN2 = 1512 * MiB;
constexpr size_t WS_ROUTE = 1576 * MiB, WS_XG = 1578 * MiB, WS_ACT = 1866 * MiB, WS_YR = 2154 * MiB, WS_XC = 2442 * MiB, WS_END = 2538 * MiB;
constexpr int CW_BAR = 4096;
constexpr int CW_CNT = 65536;

constexpr int RING_BYTES = 131072;
constexpr int LDS_BYTES = 147456;
constexpr int LDSCTL_OFF = LDS_BYTES - 1024, MISC_OFF = LDSCTL_OFF;
constexpr int TAB_OFF = LDSCTL_OFF + 64;
constexpr int EPIV_OFF = RING_BYTES + 9216;
constexpr int ROWTAB_OFF = RING_BYTES;

#define GAS __attribute__((address_space(1)))
#define LAS __attribute__((address_space(3)))
typedef unsigned short bf16;
typedef unsigned v4u __attribute__((ext_vector_type(4)));
typedef unsigned v2u __attribute__((ext_vector_type(2)));
typedef float f32x4 __attribute__((ext_vector_type(4)));
typedef float f32x2 __attribute__((ext_vector_type(2)));
typedef short bf16x8 __attribute__((ext_vector_type(8)));
typedef GAS unsigned gu32;
#define RLX_AGENT __ATOMIC_RELAXED, __HIP_MEMORY_SCOPE_AGENT
#define LDS_WAIT() asm volatile("s_waitcnt lgkmcnt(0)" ::: "memory")
#define VM_WAIT() asm volatile("s_waitcnt vmcnt(0)" ::: "memory")
__device__ __forceinline__ unsigned f2bf(float f) { unsigned u = __builtin_bit_cast(unsigned, f); return (u + 0x7fffu + ((u >> 16) & 1u)) >> 16; }
__device__ __forceinline__ unsigned pk2(float lo, float hi) { return f2bf(lo) | (f2bf(hi) << 16); }
__device__ __forceinline__ float bflo(unsigned w) { return __builtin_bit_cast(float, w << 16); }
__device__ __forceinline__ float bfhi(unsigned w) { return __builtin_bit_cast(float, w & 0xffff0000u); }
__device__ __forceinline__ float wave_sum(float v) {
#pragma unroll
    for (int o = 1; o < 64; o <<= 1) v += __shfl_xor(v, o);
    return v;
}
__device__ __forceinline__ float softplusf(float x) { return x > 20.f ? x : log1pf(expf(x)); }
__device__ __forceinline__ float logsigf(float x) { return fminf(x, 0.f) - log1pf(expf(-fabsf(x))); }
__device__ __forceinline__ float siluf(float v) { return v * __builtin_amdgcn_rcpf(1.0f + __expf(-v)); }

#define XB_TMO      128
#define XB_XCNT(j)  (256  + 64 * (j))
#define XB_XSUB(j)  (1280 + 64 * (j))
#define XB_XGEN(j)  (2304 + 64 * (j))
#define XB_TOP      3328
#define XB_TOPGEN   3392
#define XCD_BAR_WORDS 3456
#define XB_SPIN_CAP (1u << 18)

__device__ __forceinline__ unsigned xb_ld(unsigned* p)              { return __hip_atomic_load(p, __ATOMIC_RELAXED, __HIP_MEMORY_SCOPE_AGENT); }
__device__ __forceinline__ unsigned xb_add(unsigned* p, unsigned v) { return __hip_atomic_fetch_add(p, v, __ATOMIC_RELAXED, __HIP_MEMORY_SCOPE_AGENT); }
__device__ __forceinline__ unsigned xb_xcc_id() { return (unsigned)__builtin_amdgcn_s_getreg((3 << 11) | 20) & 0xFu; }
#define XB_SPIN(cond, bar) do { unsigned _sp = 0; while (cond) { __builtin_amdgcn_s_sleep(1); \
    if ((++_sp & 255u) == 0u) { if (xb_ld(&(bar)[XB_TMO])) break; if (_sp > XB_SPIN_CAP) { atomicAdd(&(bar)[XB_TMO], 1u); break; } } } } while (0)

struct XcdBarrier {
    unsigned* bar; unsigned x;
    volatile LAS unsigned* st;
};

__device__ __forceinline__ XcdBarrier xcd_barrier_post(unsigned* bar, volatile LAS unsigned* st) {
    XcdBarrier b; b.bar = bar; b.x = xb_xcc_id(); b.st = st;
    if (threadIdx.x == 0) (void)xb_add(&bar[XB_XCNT(b.x)], 1u);
    return b;
}
__device__ __forceinline__ void xcd_barrier_complete(unsigned* bar, unsigned x, unsigned& nloc, unsigned& nx) {
    const unsigned G = gridDim.x * gridDim.y * gridDim.z;
    unsigned sum, cnt, mine, sp = 0u;
    for (;;) {
        sum = 0u; cnt = 0u; mine = 0u;
#pragma unroll
        for (unsigned j = 0; j < 16; ++j) { const unsigned c = xb_ld(&bar[XB_XCNT(j)]); sum += c; cnt += (c > 0u) ? 1u : 0u; mine = (j == x) ? c : mine; }
        if (sum == G) break;
        __builtin_amdgcn_s_sleep(1);
        if ((++sp & 255u) == 0u) { if (xb_ld(&bar[XB_TMO])) break; if (sp > XB_SPIN_CAP) { atomicAdd(&bar[XB_TMO], 1u); break; } }
    }
    nloc = mine > 0u ? mine : 1u; nx = cnt > 0u ? cnt : 1u;
}

__device__ __forceinline__ void xcd_barrier(const XcdBarrier& b) {
    asm volatile("s_waitcnt vmcnt(0)" ::: "memory");
    __syncthreads();
    if (threadIdx.x == 0) {
        unsigned* bar = b.bar;
        __builtin_amdgcn_s_waitcnt(0);
        unsigned nloc = b.st[0], nx = b.st[1];
        if (nloc == 0u) { xcd_barrier_complete(bar, b.x, nloc, nx); b.st[0] = nloc; b.st[1] = nx; }
        const unsigned old = xb_add(&bar[XB_XSUB(b.x)], 1u);
        const unsigned gen = old / nloc;
        if (old + 1u == (gen + 1u) * nloc) {
            __builtin_amdgcn_fence(__ATOMIC_RELEASE, "agent");
            asm volatile("s_waitcnt vmcnt(0)" ::: "memory");
            const unsigned og = xb_add(&bar[XB_TOP], 1u);
            const unsigned tg = og / nx;
            if (og + 1u == (tg + 1u) * nx) xb_add(&bar[XB_TOPGEN], 1u);
            else XB_SPIN(xb_ld(&bar[XB_TOPGEN]) == tg, bar);
            __builtin_amdgcn_fence(__ATOMIC_ACQUIRE, "agent");
            xb_add(&bar[XB_XGEN(b.x)], 1u);
            asm volatile("s_waitcnt vmcnt(0)" ::: "memory");
        } else {
            XB_SPIN(xb_ld(&bar[XB_XGEN(b.x)]) == gen, bar);
            __builtin_amdgcn_fence(__ATOMIC_ACQUIRE, "agent");
            asm volatile("s_waitcnt vmcnt(0)" ::: "memory");
        }
    }
    __syncthreads();
}

struct Frame {
    LAS unsigned char* lds;
    volatile LAS unsigned* MISC;
    gu32* ctl;
    int tid, lane, wave, G, bid;
    const float *x, *norm1_w, *w_in, *conv_w, *conv_b, *dt_bias, *a_log, *d_skip, *ssd_norm_w, *i_bias, *f_bias, *ml_norm_w, *w_out, *norm2_w, *router_w, *router_b, *w_gate_up, *b_gate_up, *w_down, *b_down, *final_norm_w;
    float* out; unsigned char* ws;
};

__device__ __forceinline__ void p0_transpose_item(const float* W, int ldw, int K, bf16* WT, int dst_row0, int src_col0, int k0, LAS float* scr, int lane) {
#pragma unroll 8
    for (int i = 0; i < 32; ++i) { const int kk = 2 * i + (lane >> 5); scr[kk * 33 + (lane & 31)] = W[(size_t)(k0 + kk) * ldw + src_col0 + (lane & 31)]; }
    LDS_WAIT(); asm volatile("" ::: "memory");
    const int c = lane & 7;
#pragma unroll
    for (int j = 0; j < 4; ++j) { const int n = (lane >> 3) + 8 * j; const LAS float* s = scr + (8 * c) * 33 + n;
        v4u o; o.x = pk2(s[0 * 33], s[1 * 33]); o.y = pk2(s[2 * 33], s[3 * 33]); o.z = pk2(s[4 * 33], s[5 * 33]); o.w = pk2(s[6 * 33], s[7 * 33]);
        *(v4u*)(WT + (size_t)(dst_row0 + n) * K + k0 + 8 * c) = o; }
    LDS_WAIT(); asm volatile("" ::: "memory");
}
__device__ __forceinline__ void p0_transpose_item_f8(const float* W, int ldw, int K, unsigned char* WT, int dst_row0, int src_col0, int k0, LAS float* scr, int lane) {
#pragma unroll 8
    for (int i = 0; i < 32; ++i) { const int kk = 2 * i + (lane >> 5); scr[kk * 33 + (lane & 31)] = W[(size_t)(k0 + kk) * ldw + src_col0 + (lane & 31)] * 64.0f; }
    LDS_WAIT(); asm volatile("" ::: "memory");
    const int c = lane & 3;
#pragma unroll
    for (int j = 0; j < 2; ++j) { const int n = (lane >> 2) + 16 * j; const LAS float* s = scr + (16 * c) * 33 + n; int o[4];
#pragma unroll
        for (int q = 0; q < 4; ++q) { int w = __builtin_amdgcn_cvt_pk_fp8_f32(s[(4 * q) * 33], s[(4 * q + 1) * 33], 0, false); o[q] = __builtin_amdgcn_cvt_pk_fp8_f32(s[(4 * q + 2) * 33], s[(4 * q + 3) * 33], w, true); }
        *(v4u*)(WT + (size_t)(dst_row0 + n) * K + k0 + 16 * c) = (v4u){(unsigned)o[0], (unsigned)o[1], (unsigned)o[2], (unsigned)o[3]}; }
    LDS_WAIT(); asm volatile("" ::: "memory");
}
template <bool F8> __device__ __forceinline__ void p0_transpose128(const float* W, int ldw, int K, void* WTv, int dst_row0, int src_col0, int k0, LAS float* scr, int lane) {
    const float* src = W + (size_t)(k0 + (lane >> 3)) * ldw + src_col0 + 4 * (lane & 7);
    f32x4 v[16];
#pragma unroll
    for (int i = 0; i < 16; ++i) v[i] = *(const f32x4*)(src + (size_t)(8 * i) * ldw);
#pragma unroll
    for (int i = 0; i < 16; ++i) { LAS float* d = scr + (8 * i + (lane >> 3)) * 33 + 4 * (lane & 7); d[0] = v[i].x; d[1] = v[i].y; d[2] = v[i].z; d[3] = v[i].w; }
    LDS_WAIT(); asm volatile("" ::: "memory");
    const int n = lane & 31, hf = lane >> 5; const LAS float* s = scr + (64 * hf) * 33 + n;
    if (F8) { unsigned char* dst = (unsigned char*)WTv + (size_t)(dst_row0 + n) * K + k0 + 64 * hf;
#pragma unroll
        for (int j = 0; j < 4; ++j) { int o[4];
#pragma unroll
            for (int q = 0; q < 4; ++q) { const LAS float* p = s + (16 * j + 4 * q) * 33; int w = __builtin_amdgcn_cvt_pk_fp8_f32(p[0] * 64.0f, p[33] * 64.0f, 0, false); o[q] = __builtin_amdgcn_cvt_pk_fp8_f32(p[66] * 64.0f, p[99] * 64.0f, w, true); }
            *(v4u*)(dst + 16 * j) = (v4u){(unsigned)o[0], (unsigned)o[1], (unsigned)o[2], (unsigned)o[3]}; }
    } else { bf16* dst = (bf16*)WTv + (size_t)(dst_row0 + n) * K + k0 + 64 * hf;
#pragma unroll
        for (int j = 0; j < 8; ++j) { const LAS float* p = s + (8 * j) * 33;
            *(v4u*)(dst + 8 * j) = (v4u){pk2(p[0], p[33]), pk2(p[66], p[99]), pk2(p[132], p[165]), pk2(p[198], p[231])}; }
    }
    LDS_WAIT(); asm volatile("" ::: "memory");
}
__device__ __forceinline__ void rms_row_to_bf16(const float* xrow, const float* w, bf16* orow, int lane) {
    const f32x4* xr = (const f32x4*)xrow + lane; const f32x4* wr = (const f32x4*)w + lane;
    f32x4 v[8]; float s = 0.f;
#pragma unroll
    for (int j = 0; j < 8; ++j) { v[j] = xr[64 * j]; s += (v[j].x * v[j].x + v[j].y * v[j].y) + (v[j].z * v[j].z + v[j].w * v[j].w); }
    const float rstd = 1.0f / sqrtf(wave_sum(s) * (1.0f / 2048.0f) + EPSF);
    v2u* o8 = (v2u*)orow + lane;
#pragma unroll
    for (int j = 0; j < 8; ++j) { const f32x4 ww = wr[64 * j]; v2u o; o.x = pk2(v[j].x * rstd * ww.x, v[j].y * rstd * ww.y); o.y = pk2(v[j].z * rstd * ww.z, v[j].w * rstd * ww.w); o8[64 * j] = o; }
}
__device__ __forceinline__ void p0_moe_weights_coop(Frame& F) {
    LAS float* tile = (LAS float*)F.lds;
    unsigned char* WguT = (unsigned char*)(F.ws + WS_WGU); unsigned char* WdT = (unsigned char*)(F.ws + WS_WD);
    constexpr int I_GU = 32 * 256, I_D = 32 * 128, NI = I_GU + I_D;
    const int lrow = 32 * F.wave + (F.lane >> 5), lcol = 4 * (F.lane & 31);
    const int on = F.tid & 127, okq = F.tid >> 7;
    f32x4 v[16];
    auto item = [&](int r, const float*& W, unsigned char*& WT, int& ldw, int& n0, int& k0) {
        if (r < I_GU) { const int e = r >> 8, rr = r & 255, kb = rr >> 5, nb = rr & 31; W = F.w_gate_up + (size_t)e * 2048 * 4096; WT = WguT + (size_t)e * 4096 * 2048; ldw = 4096; n0 = nb * 128; k0 = kb * 256; }
        else { r -= I_GU; const int e = r >> 7, rr = r & 127, kb = rr >> 4, nb = rr & 15; W = F.w_down + (size_t)e * 2048 * 2048; WT = WdT + (size_t)e * 2048 * 2048; ldw = 2048; n0 = nb * 128; k0 = kb * 256; } };
    int it = F.bid; if (it >= NI) return;
    const float* W; unsigned char* WT; int ldw, n0, k0; item(it, W, WT, ldw, n0, k0);
#pragma unroll
    for (int i = 0; i < 16; ++i) v[i] = *(const f32x4*)(W + (size_t)(k0 + lrow + 2 * i) * ldw + n0 + lcol);
    for (;;) {
#pragma unroll
        for (int i = 0; i < 16; ++i) *(LAS f32x4*)(tile + (lrow + 2 * i) * 132 + lcol) = v[i];
        __syncthreads();
        unsigned char* dst = WT + (size_t)(n0 + on) * 2048 + k0 + 64 * okq;
        const int nit = it + F.G; const bool more = nit < NI;
        if (more) { item(nit, W, WT, ldw, n0, k0);
#pragma unroll
            for (int i = 0; i < 16; ++i) v[i] = *(const f32x4*)(W + (size_t)(k0 + lrow + 2 * i) * ldw + n0 + lcol); }
        const LAS float* sp = tile + (64 * okq) * 132 + on;
#pragma unroll
        for (int j = 0; j < 4; ++j) { int o[4];
#pragma unroll
            for (int q = 0; q < 4; ++q) { const LAS float* p = sp + (16 * j + 4 * q) * 132; int w_ = __builtin_amdgcn_cvt_pk_fp8_f32(p[0] * 64.0f, p[132] * 64.0f, 0, false); o[q] = __builtin_amdgcn_cvt_pk_fp8_f32(p[264] * 64.0f, p[396] * 64.0f, w_, true); }
            *(v4u*)(dst + 16 * j) = (v4u){(unsigned)o[0], (unsigned)o[1], (unsigned)o[2], (unsigned)o[3]}; }
        __syncthreads();
        if (!more) break; it = nit;
    }
}
__device__ __forceinline__ void phase0(Frame& F) {
    LAS float* scr = (LAS float*)(F.lds + F.wave * 16896);
    const int gw = F.bid * NWAVES + F.wave, NGW = F.G * NWAVES;
    bf16* WinT = (bf16*)(F.ws + WS_WIN); bf16* WsT = (bf16*)(F.ws + WS_WSM); float* Wrt = (float*)(F.ws + WS_WRT); bf16* WoutT = (bf16*)(F.ws + WS_WOUT);
    bf16* XN1 = (bf16*)(F.ws + WS_XN1);
    p0_moe_weights_coop(F);
    constexpr int I_IN = 16 * 352, I_OUT = 32 * 64, NITEMS = I_IN + I_OUT;
    for (int it = gw; it < NITEMS; it += NGW) {
        int r = it;
        if (r < I_IN) { const int kb = r / 352, nb = r % 352, n0 = nb * 32; p0_transpose128<false>(F.w_in, WIN_LD, 2048, WinT, n0, n0 + (n0 >= 5120 ? 32 : 0), kb * 128, scr, F.lane); continue; } r -= I_IN;
        { const int kb = r >> 6, nb = r & 63; p0_transpose128<false>(F.w_out, 2048, 4096, WoutT, nb * 32, nb * 32, kb * 128, scr, F.lane); }
    }
    for (int i = gw * 64 + F.lane; i < 64 * 2048; i += NGW * 64) { const int j = i >> 11, k = i & 2047;
        const int col = j < 32 ? 5120 + j : (j < 40 ? 11296 + (j - 32) : 11304 + (j - 40));
        WsT[i] = (bf16)(j < 48 ? f2bf(F.w_in[(size_t)k * WIN_LD + col]) : 0u); }
    for (int i = gw * 64 + F.lane; i < 2048 * 32; i += NGW * 64) Wrt[i] = F.norm2_w[i >> 5] * F.router_w[i];
    for (int m = gw; m < TT; m += NGW) rms_row_to_bf16(F.x + (size_t)m * DM, F.norm1_w, XN1 + (size_t)m * DM, F.lane);
}

__device__ __forceinline__ void p1_small(Frame& F) {
    const bf16* XN1 = (const bf16*)(F.ws + WS_XN1); const bf16* WsT = (const bf16*)(F.ws + WS_WSM); float* SMALL = (float*)(F.ws + WS_SMALL);
    const int gw = F.bid * NWAVES + F.wave, NGW = F.G * NWAVES, fr = F.lane & 15, fq = F.lane >> 4;
    for (int task = gw; task < TT / 16; task += NGW) {
        const int t0 = task * 16;
        f32x4 acc[4];
#pragma unroll
        for (int n = 0; n < 4; ++n) acc[n] = (f32x4){0.f, 0.f, 0.f, 0.f};
        const bf16* arow = XN1 + (size_t)(t0 + fr) * DM + 8 * fq; const bf16* brow = WsT + (size_t)fr * DM + 8 * fq;
#pragma unroll 16
        for (int ks = 0; ks < 64; ++ks) {
            const bf16x8 a = *(const bf16x8*)(arow + 32 * ks);
#pragma unroll
            for (int n = 0; n < 4; ++n) { const bf16x8 b = *(const bf16x8*)(brow + (size_t)n * 16 * DM + 32 * ks); acc[n] = __builtin_amdgcn_mfma_f32_16x16x32_bf16(a, b, acc[n], 0, 0, 0); }
        }
#pragma unroll
        for (int n = 0; n < 4; ++n)
#pragma unroll
            for (int r = 0; r < 4; ++r) SMALL[(size_t)(t0 + 4 * fq + r) * 64 + n * 16 + fr] = acc[n][r];
    }
}

__device__ __forceinline__ void unpack8(const v4u r, float (&f)[8]) { f[0] = bflo(r.x); f[1] = bfhi(r.x); f[2] = bflo(r.y); f[3] = bfhi(r.y); f[4] = bflo(r.z); f[5] = bfhi(r.z); f[6] = bflo(r.w); f[7] = bfhi(r.w); }

__device__ __forceinline__ void phase_conv(Frame& F) {
    const bf16* PROJ = (const bf16*)(F.ws + WS_PROJ); bf16* XC = (bf16*)(F.ws + WS_XC);
    constexpr int TB = 16, NCG = 384, NIT = (TT / TB) * NCG;
    for (int it = F.bid * (NWAVES * 64) + F.tid; it < NIT; it += F.G * NWAVES * 64) {
        const int cg = it % NCG, tb = it / NCG, ch = cg * 8, t0 = tb * TB; const bool seq0 = (t0 % SEQ) == 0;
        float w[4][8], bs[8];
#pragma unroll
        for (int j = 0; j < 4; ++j) { const f32x4 a = *(const f32x4*)(F.conv_w + j * 3072 + ch), b = *(const f32x4*)(F.conv_w + j * 3072 + ch + 4);
            w[j][0] = a.x; w[j][1] = a.y; w[j][2] = a.z; w[j][3] = a.w; w[j][4] = b.x; w[j][5] = b.y; w[j][6] = b.z; w[j][7] = b.w; }
        { const f32x4 a = *(const f32x4*)(F.conv_b + ch), b = *(const f32x4*)(F.conv_b + ch + 4); bs[0] = a.x; bs[1] = a.y; bs[2] = a.z; bs[3] = a.w; bs[4] = b.x; bs[5] = b.y; bs[6] = b.z; bs[7] = b.w; }
        const bf16* src = PROJ + (size_t)t0 * NPROJ + PC_XBC + ch;
        float r0[8], r1[8], r2[8], r3[8];
        if (seq0) {
#pragma unroll
            for (int i = 0; i < 8; ++i) { r0[i] = 0.f; r1[i] = 0.f; r2[i] = 0.f; }
        } else { unpack8(*(const v4u*)(src - 3 * (size_t)NPROJ), r0); unpack8(*(const v4u*)(src - 2 * (size_t)NPROJ), r1); unpack8(*(const v4u*)(src - (size_t)NPROJ), r2); }
        v4u rw[TB];
#pragma unroll
        for (int l = 0; l < TB; ++l) rw[l] = *(const v4u*)(src + (size_t)l * NPROJ);
#pragma unroll
        for (int l = 0; l < TB; ++l) {
            unpack8(rw[l], r3);
            float o[8];
#pragma unroll
            for (int i = 0; i < 8; ++i) { const float v = bs[i] + w[0][i] * r0[i] + w[1][i] * r1[i] + w[2][i] * r2[i] + w[3][i] * r3[i]; o[i] = siluf(v); r0[i] = r1[i]; r1[i] = r2[i]; r2[i] = r3[i]; }
            v4u ov; ov.x = pk2(o[0], o[1]); ov.y = pk2(o[2], o[3]); ov.z = pk2(o[4], o[5]); ov.w = pk2(o[6], o[7]);
            *(v4u*)(XC + (size_t)(t0 + l) * 3072 + ch) = ov;
        }
    }
}

constexpr int MX_PITCH = 272;
static_assert(true, "");
constexpr int MX_QM = 0, MX_KM = 34816, MX_KW = 69632, MX_VT = 104448, MX_SI = 121856, MX_VEC = 139264, MX_VECB = 3072, MX_NVEC = MX_VEC + 2 * MX_VECB, MX_SCAL = MX_NVEC + 512, MX_END = MX_SCAL + 64;
__device__ __forceinline__ unsigned cvt_pk_bf16_nop(float lo, float hi) { unsigned r; asm volatile("v_cvt_pk_bf16_f32 %0, %1, %2\n\ts_nop 1" : "=v"(r) : "v"(lo), "v"(hi)); return r; }
__device__ __forceinline__ int mx_sw(int row, int tbyte) { return row * MX_PITCH + ((((tbyte >> 4) ^ (row >> 3)) & 15) << 4) + (tbyte & 15); }
__device__ __forceinline__ bf16x8 lds_frag(const LAS unsigned char* img, int row, int kbyte) { return *(const LAS bf16x8*)(img + row * MX_PITCH + kbyte); }
static_assert(MX_END + 256 <= LDSCTL_OFF, "mixer LDS map");
template <bool ML> __device__ __forceinline__ void mixer_unit(Frame& F, int unit) {
    const bf16* PROJ = (const bf16*)(F.ws + WS_PROJ); const bf16* XC = (const bf16*)(F.ws + WS_XC); const float* SMALL = (const float*)(F.ws + WS_SMALL);
    bf16* YMIX = (bf16*)(F.ws + WS_YMIX); float* SSQ = (float*)(F.ws + WS_SSQ);
    const int w = F.wave, fr = F.lane & 15, fq = F.lane >> 4, tid = F.tid;
    const int b = unit >> 5, tok0 = b * SEQ, hd = unit & 31, grp = hd >> 3, mh = (unit & 31) >> 2, vq = unit & 3;
    const float qs = 0.08838834764831845f;
    LAS unsigned char* QM = F.lds + MX_QM; LAS unsigned char* KM = F.lds + MX_KM; LAS unsigned char* KW = F.lds + MX_KW; LAS unsigned char* VT = F.lds + MX_VT; LAS unsigned char* SI = F.lds + MX_SI;
    LAS float* exch = (LAS float*)(F.lds + MX_VEC + (w >> 2) * MX_VECB + 1024) + (w & 3) * 32;
    LAS float* nvec = (LAS float*)(F.lds + MX_NVEC); LAS float* scal = (LAS float*)(F.lds + MX_SCAL);
    const int fr3 = fr >> 3;
    int vtb[2];
#pragma unroll
    for (int p = 0; p < 2; ++p) vtb[p] = fr * MX_PITCH + ((fq ^ ((2 * p) | fr3)) << 4);
    int vpb[2][2];
#pragma unroll
    for (int p = 0; p < 2; ++p)
#pragma unroll
        for (int h = 0; h < 2; ++h) vpb[p][h] = fr * MX_PITCH + (((((fq >> 1) | (2 * h)) ^ ((2 * p) | fr3))) << 4) + 8 * (fq & 1);
    const int kwb = (16 * w + fr) * MX_PITCH + ((fq ^ ((2 * (w & 1)) | fr3)) << 4), kwh = w >> 1;

    const bf16* qsrc; const bf16* ksrc; const bf16* vsrc; int ld;
    if (ML) { qsrc = PROJ + PC_Q + mh * 128; ksrc = PROJ + PC_K + mh * 128; vsrc = PROJ + PC_V + mh * 256 + vq * 64; ld = NPROJ; }
    else { qsrc = XC + 2560 + grp * 128; ksrc = XC + 2048 + grp * 128; vsrc = XC + hd * 64; ld = 3072; }
    const float c_a = ML ? 0.f : -expf(F.a_log[hd]), c_dtb = ML ? 0.f : F.dt_bias[hd], c_D = ML ? 0.f : F.d_skip[hd], c_ib = ML ? F.i_bias[mh] : 0.f, c_fb = ML ? F.f_bias[mh] : 0.f;
    float mprev = 0.f;
    f32x4 sacc[4]; float nreg = 0.f;
#pragma unroll
    for (int j = 0; j < 4; ++j) sacc[j] = (f32x4){0.f, 0.f, 0.f, 0.f};
    v4u pq[4], pk[4], pv[2];
    float vA0 = 0.f, vA1 = 0.f, vB0 = 0.f, vB1 = 0.f, vC0 = 0.f, vC1 = 0.f, vD0 = 0.f, vD1 = 0.f, vE0 = 0.f, vE1 = 0.f, vG0 = 0.f, vG1 = 0.f, vSA = 0.f, vSG = 0.f;
    float sl0 = 0.f, sl1 = 0.f, sl2 = 0.f, sl3 = 0.f;
#define MX_SCAN_L(c) do { if (w == 0) { const size_t tt = (size_t)(tok0 + 128 * (c) + 2 * F.lane); \
        if (!ML) { sl0 = SMALL[tt * 64 + hd]; sl1 = SMALL[(tt + 1) * 64 + hd]; } \
        else { sl0 = SMALL[tt * 64 + 32 + mh]; sl1 = SMALL[(tt + 1) * 64 + 32 + mh]; sl2 = SMALL[tt * 64 + 40 + mh]; sl3 = SMALL[(tt + 1) * 64 + 40 + mh]; } } } while (0)
#define MX_SOFTPLUS(x) ((x) > 20.f ? (x) : __logf(1.0f + __expf(x)))
#define MX_LOGSIG(x) (fminf((x), 0.f) - __logf(1.0f + __expf(-fabsf(x))))
#define MX_SCAN_A(c) do { if (w == 0) { \
        if (!ML) { const float d0 = MX_SOFTPLUS(sl0 + c_dtb), d1 = MX_SOFTPLUS(sl1 + c_dtb); \
            const float x0 = d0 * c_a, x1 = d1 * c_a; float incl = x0 + x1; \
            _Pragma("unroll") for (int d = 1; d < 64; d <<= 1) { const float t_ = __shfl_up(incl, d); if (F.lane >= d) incl += t_; } \
            const float cum1 = incl, cum0 = incl - x1, tot = __shfl(incl, 63); \
            vA0 = -cum0; vA1 = -cum1; vB0 = -cum0; vB1 = -cum1; vC0 = d0; vC1 = d1; vD0 = __expf(cum0); vD1 = __expf(cum1); vE0 = d0 * __expf(tot - cum0); vE1 = d1 * __expf(tot - cum1); vSA = __expf(tot); vSG = 1.0f; \
        } else { const float li0 = sl0 + c_ib, li1 = sl1 + c_ib; \
            const float x0 = MX_LOGSIG(sl2 + c_fb), x1 = MX_LOGSIG(sl3 + c_fb); float incl = x0 + x1; \
            _Pragma("unroll") for (int d = 1; d < 64; d <<= 1) { const float t_ = __shfl_up(incl, d); if (F.lane >= d) incl += t_; } \
            const float cum1 = incl, cum0 = incl - x1, btot = __shfl(incl, 63); \
            const float dd0 = li0 - cum0, dd1 = li1 - cum1; float im = fmaxf(dd0, dd1); \
            _Pragma("unroll") for (int d = 1; d < 64; d <<= 1) { const float t_ = __shfl_up(im, d); if (F.lane >= d) im = fmaxf(im, t_); } \
            float pm = __shfl_up(im, 1); if (F.lane == 0) pm = -3.0e38f; const float pmax0 = fmaxf(pm, dd0), pmax1 = im, pm127 = __shfl(im, 63); \
            const float M0 = fmaxf(mprev, pmax0), M1 = fmaxf(mprev, pmax1); \
            vA0 = dd0; vA1 = dd1; vB0 = M0; vB1 = M1; vD0 = qs * __expf(mprev - M0); vD1 = qs * __expf(mprev - M1); vG0 = __expf(-(cum0 + M0)); vG1 = __expf(-(cum1 + M1)); \
            const float mloc = btot + pm127, mnew = fmaxf(btot + mprev, mloc); \
            vSA = __expf(btot + mprev - mnew); vSG = __expf(mloc - mnew); vE0 = __expf(dd0 - pm127) * vSG; vE1 = __expf(dd1 - pm127) * vSG; mprev = mnew; } } } while (0)
#define MX_SCAN_B(c) do { if (w == 0) { \
        LAS float* vb = (LAS float*)(F.lds + MX_VEC + ((c) & 1) * MX_VECB); const int l0 = 2 * F.lane; \
        *(LAS f32x2*)(vb + l0) = (f32x2){vA0, vA1}; *(LAS f32x2*)(vb + 128 + l0) = (f32x2){vB0, vB1}; if (!ML) *(LAS f32x2*)(vb + 256 + l0) = (f32x2){vC0, vC1}; \
        *(LAS f32x2*)(vb + 384 + l0) = (f32x2){vD0, vD1}; *(LAS f32x2*)(vb + 512 + l0) = (f32x2){vE0, vE1}; if (ML) *(LAS f32x2*)(vb + 640 + l0) = (f32x2){vG0, vG1}; \
        if (F.lane == 0) { scal[2 * ((c) & 1)] = vSA; scal[2 * ((c) & 1) + 1] = vSG; } } } while (0)
#define MX_SCAN(c) do { MX_SCAN_L(c); MX_SCAN_A(c); MX_SCAN_B(c); } while (0)
#define MX_PREFETCH(c) do { const size_t tb_ = (size_t)(tok0 + 128 * (c)); \
        _Pragma("unroll") for (int i = 0; i < 2; ++i) { const int pid = tid + 512 * i, a2 = pid >> 4, k8 = pid & 15; \
            pq[2 * i] = *(const v4u*)(qsrc + (tb_ + 2 * a2) * ld + 8 * k8); pq[2 * i + 1] = *(const v4u*)(qsrc + (tb_ + 2 * a2 + 1) * ld + 8 * k8); \
            pk[2 * i] = *(const v4u*)(ksrc + (tb_ + 2 * a2) * ld + 8 * k8); pk[2 * i + 1] = *(const v4u*)(ksrc + (tb_ + 2 * a2 + 1) * ld + 8 * k8); } \
        { const int a2 = tid >> 3, v8 = tid & 7; pv[0] = *(const v4u*)(vsrc + (tb_ + 2 * a2) * ld + 8 * v8); pv[1] = *(const v4u*)(vsrc + (tb_ + 2 * a2 + 1) * ld + 8 * v8); } } while (0)
#define MX_WRITE(c) do { const LAS float* vb = (const LAS float*)(F.lds + MX_VEC + ((c) & 1) * MX_VECB); \
        _Pragma("unroll") for (int i = 0; i < 2; ++i) { const int pid = tid + 512 * i, a2 = pid >> 4, k8 = pid & 15, l = 2 * a2; \
            *(LAS v4u*)(QM + l * MX_PITCH + 16 * k8) = pq[2 * i]; *(LAS v4u*)(QM + (l + 1) * MX_PITCH + 16 * k8) = pq[2 * i + 1]; \
            *(LAS v4u*)(KM + l * MX_PITCH + 16 * k8) = pk[2 * i]; *(LAS v4u*)(KM + (l + 1) * MX_PITCH + 16 * k8) = pk[2 * i + 1]; \
            float f0[8], f1[8]; unpack8(pk[2 * i], f0); unpack8(pk[2 * i + 1], f1); const f32x2 wl = *(const LAS f32x2*)(vb + 512 + l); \
            _Pragma("unroll") for (int e = 0; e < 8; ++e) *(LAS unsigned*)(KW + mx_sw(8 * k8 + e, 2 * l)) = pg8::cvt_pk_bf16(f0[e] * wl.x, f1[e] * wl.y); } \
        { const int a2 = tid >> 3, v8 = tid & 7, l = 2 * a2; const v4u r0 = pv[0], r1 = pv[1]; LAS unsigned char* vp_ = VT + mx_sw(8 * v8, 2 * l); \
            *(LAS unsigned*)(vp_ + 0 * MX_PITCH) = (r0.x & 0xffffu) | (r1.x << 16); *(LAS unsigned*)(vp_ + 1 * MX_PITCH) = (r0.x >> 16) | (r1.x & 0xffff0000u); \
            *(LAS unsigned*)(vp_ + 2 * MX_PITCH) = (r0.y & 0xffffu) | (r1.y << 16); *(LAS unsigned*)(vp_ + 3 * MX_PITCH) = (r0.y >> 16) | (r1.y & 0xffff0000u); \
            *(LAS unsigned*)(vp_ + 4 * MX_PITCH) = (r0.z & 0xffffu) | (r1.z << 16); *(LAS unsigned*)(vp_ + 5 * MX_PITCH) = (r0.z >> 16) | (r1.z & 0xffff0000u); \
            *(LAS unsigned*)(vp_ + 6 * MX_PITCH) = (r0.w & 0xffffu) | (r1.w << 16); *(LAS unsigned*)(vp_ + 7 * MX_PITCH) = (r0.w >> 16) | (r1.w & 0xffff0000u); } \
        _Pragma("unroll") for (int j = 0; j < 4; ++j) { v2u sv; sv.x = pg8::cvt_pk_bf16(sacc[j][0], sacc[j][1]); sv.y = pg8::cvt_pk_bf16(sacc[j][2], sacc[j][3]); *(LAS v2u*)(SI + (16 * j + fr) * MX_PITCH + (16 * w + 4 * fq) * 2) = sv; } \
        if (ML && fq == 0) nvec[16 * w + fr] = nreg; } while (0)
    const int gcol = (ML ? PC_O + mh * 256 + vq * 64 : PC_Z + hd * 64) + 16 * (F.lane & 3);
    LAS float* nwl = (LAS float*)(F.lds + MX_END);
    if (tid < 64) nwl[tid] = ML ? F.ml_norm_w[mh * 256 + vq * 64 + tid] : F.ssd_norm_w[hd * 64 + tid];
    v4u zc0 = (v4u){0u, 0u, 0u, 0u}, zc1 = zc0;
    { const bf16* zp = PROJ + (size_t)(tok0 + 16 * w + (F.lane >> 2)) * NPROJ + gcol; zc0 = *(const v4u*)zp; zc1 = *(const v4u*)(zp + 8); }
    MX_SCAN(0);
    MX_PREFETCH(0);
    __syncthreads();
    MX_WRITE(0);
    __syncthreads();
    for (int c = 0; c < SEQ / 128; ++c) {
        const LAS float* vb = (const LAS float*)(F.lds + MX_VEC + (c & 1) * MX_VECB);
        const bool more = (c + 1 < SEQ / 128);
        if (more) { MX_SCAN_L(c + 1); MX_PREFETCH(c + 1); }
        bf16x8 qf[4];
#pragma unroll
        for (int ks = 0; ks < 4; ++ks) qf[ks] = lds_frag(QM, 16 * w + fr, 64 * ks + 16 * fq);
        const float mlv = vb[128 + 16 * w + fr];
        float dsum = 0.f;
        f32x4 y1[4];
#pragma unroll
        for (int j = 0; j < 4; ++j) y1[j] = (f32x4){0.f, 0.f, 0.f, 0.f};
        const f32x4 rs4 = *(const LAS f32x4*)(vb + 384 + 16 * w + 4 * fq);
#pragma unroll
        for (int ks = 0; ks < 4; ++ks) { bf16x8 sf[4];
#pragma unroll
            for (int j = 0; j < 4; ++j) sf[j] = lds_frag(SI, 16 * j + fr, 64 * ks + 16 * fq);
#pragma unroll
            for (int j = 0; j < 4; ++j) y1[j] = __builtin_amdgcn_mfma_f32_16x16x32_bf16(qf[ks], sf[j], y1[j], 0, 0, 0); }
#pragma unroll
        for (int j = 0; j < 4; ++j) y1[j] = y1[j] * rs4;
        __builtin_amdgcn_sched_barrier(0);
#pragma unroll 1
        for (int k2 = 0; 2 * k2 <= w; ++k2) {
            unsigned pw[4];
#pragma unroll
            for (int h = 0; h < 2; ++h) {
                const int si = 2 * k2 + h;
                f32x4 acc = (f32x4){0.f, 0.f, 0.f, 0.f};
#pragma unroll
                for (int ks = 0; ks < 4; ++ks) acc = __builtin_amdgcn_mfma_f32_16x16x32_bf16(lds_frag(KM, 16 * si + fr, 64 * ks + 16 * fq), qf[ks], acc, 0, 0, 0);
                const f32x4 e4 = *(const LAS f32x4*)(vb + 16 * si + 4 * fq); f32x4 x4 = (f32x4){qs, qs, qs, qs}; if (!ML) x4 = *(const LAS f32x4*)(vb + 256 + 16 * si + 4 * fq);
                float p[4];
#pragma unroll
                for (int r = 0; r < 4; ++r) { const float v = acc[r] * __expf(e4[r] - mlv) * x4[r]; const bool ok = (si < w) || (si == w && 4 * fq + r <= fr); p[r] = ok ? v : 0.f; }
                if (ML) dsum += (p[0] + p[1]) + (p[2] + p[3]);
                pw[2 * h] = cvt_pk_bf16_nop(p[0], p[1]); pw[2 * h + 1] = cvt_pk_bf16_nop(p[2], p[3]);
            }
            HWAIT();
            const v4u pwv = (v4u){pw[0], pw[1], pw[2], pw[3]}; const bf16x8 pf = __builtin_bit_cast(bf16x8, pwv);
#pragma unroll
            for (int j = 0; j < 4; ++j) { const int ho = j * 16 * MX_PITCH + ((k2 ^ (j >> 1)) << 6); const v2u lo = *(const LAS v2u*)(VT + vpb[j & 1][0] + ho), hi = *(const LAS v2u*)(VT + vpb[j & 1][1] + ho); const v4u vw = (v4u){lo.x, lo.y, hi.x, hi.y};
                y1[j] = __builtin_amdgcn_mfma_f32_16x16x32_bf16(pf, __builtin_bit_cast(bf16x8, vw), y1[j], 0, 0, 0); }
            HWAIT();
        }
        HSYNC();
        __builtin_amdgcn_sched_barrier(0);
        __builtin_amdgcn_sched_barrier(0);
        if (ML) {
            dsum += __shfl_xor(dsum, 16); dsum += __shfl_xor(dsum, 32);
            float d2 = 0.f;
#pragma unroll
            for (int ks = 0; ks < 4; ++ks) { float qv[8]; unpack8(__builtin_bit_cast(v4u, qf[ks]), qv); const f32x4 n0 = *(const LAS f32x4*)(nvec + 32 * ks + 8 * fq), n1 = *(const LAS f32x4*)(nvec + 32 * ks + 8 * fq + 4);
                d2 += qv[0] * n0.x + qv[1] * n0.y + qv[2] * n0.z + qv[3] * n0.w + qv[4] * n1.x + qv[5] * n1.y + qv[6] * n1.z + qv[7] * n1.w; }
            d2 += __shfl_xor(d2, 16); d2 += __shfl_xor(d2, 32);
            if (fq == 0) { exch[fr] = dsum; exch[16 + fr] = d2; }
        }
        HSYNC();
        __builtin_amdgcn_sched_barrier(0);
        LAS float* stg = (LAS float*)(QM + 16 * w * MX_PITCH);
        if (ML) { const f32x4 fl4 = *(const LAS f32x4*)(vb + 640 + 16 * w + 4 * fq); const f32x4 dA = *(const LAS f32x4*)(exch + 4 * fq), dB = *(const LAS f32x4*)(exch + 16 + 4 * fq);
#pragma unroll
            for (int r = 0; r < 4; ++r) { const float den = fmaxf(fabsf(dA[r] + rs4[r] * dB[r]), fl4[r]); const float inv = __builtin_amdgcn_rcpf(den);
#pragma unroll
                for (int j = 0; j < 4; ++j) stg[(4 * fq + r) * 68 + 16 * j + fr] = y1[j][r] * inv; }
        } else {
#pragma unroll
            for (int j = 0; j < 4; ++j) { const v2u xw = *(const LAS v2u*)(VT + mx_sw(16 * j + fr, 32 * w + 8 * fq)); const float xs[4] = {bflo(xw.x), bfhi(xw.x), bflo(xw.y), bfhi(xw.y)};
#pragma unroll
                for (int r = 0; r < 4; ++r) stg[(4 * fq + r) * 68 + 16 * j + fr] = y1[j][r] + c_D * xs[r]; }
        }
        {   const int erow = F.lane >> 2, ecs = F.lane & 3; const size_t trow = (size_t)(tok0 + 128 * c + 16 * w + erow);
            float yv[16];
#pragma unroll
            for (int i = 0; i < 4; ++i) { const f32x4 t4 = *(const LAS f32x4*)(stg + erow * 68 + 16 * ecs + 4 * i); yv[4 * i] = t4.x; yv[4 * i + 1] = t4.y; yv[4 * i + 2] = t4.z; yv[4 * i + 3] = t4.w; }
            float zf[16]; { float t8[8]; unpack8(zc0, t8);
#pragma unroll
                for (int i = 0; i < 8; ++i) zf[i] = t8[i]; unpack8(zc1, t8);
#pragma unroll
                for (int i = 0; i < 8; ++i) zf[8 + i] = t8[i]; }
            if (!ML) {
#pragma unroll
                for (int i = 0; i < 16; ++i) yv[i] = yv[i] * zf[i] * __builtin_amdgcn_rcpf(1.0f + __expf(-zf[i])); }
            float ss = 0.f;
#pragma unroll
            for (int i = 0; i < 16; ++i) ss += yv[i] * yv[i];
            ss += __shfl_xor(ss, 1); ss += __shfl_xor(ss, 2);
            if (ecs == 0) SSQ[(ML ? (size_t)TT * 32 : 0) + trow * 32 + (ML ? mh * 4 + vq : hd)] = ss;
#pragma unroll
            for (int i = 0; i < 4; ++i) { const f32x4 w4 = *(const LAS f32x4*)(nwl + 16 * ecs + 4 * i);
                yv[4 * i] *= w4.x; yv[4 * i + 1] *= w4.y; yv[4 * i + 2] *= w4.z; yv[4 * i + 3] *= w4.w; }
            if (ML) {
#pragma unroll
                for (int i = 0; i < 16; ++i) yv[i] *= __builtin_amdgcn_rcpf(1.0f + __expf(-zf[i])); }
            bf16* yp = YMIX + trow * 4096 + (ML ? 2048 + mh * 256 + vq * 64 : hd * 64) + 16 * ecs;
            *(v4u*)yp = (v4u){pg8::cvt_pk_bf16(yv[0], yv[1]), pg8::cvt_pk_bf16(yv[2], yv[3]), pg8::cvt_pk_bf16(yv[4], yv[5]), pg8::cvt_pk_bf16(yv[6], yv[7])};
            *(v4u*)(yp + 8) = (v4u){pg8::cvt_pk_bf16(yv[8], yv[9]), pg8::cvt_pk_bf16(yv[10], yv[11]), pg8::cvt_pk_bf16(yv[12], yv[13]), pg8::cvt_pk_bf16(yv[14], yv[15])};
            if (more) { const bf16* zp = PROJ + (size_t)(tok0 + 128 * (c + 1) + 16 * w + (F.lane >> 2)) * NPROJ + gcol; zc0 = *(const v4u*)zp; zc1 = *(const v4u*)(zp + 8); }
        }
        __builtin_amdgcn_sched_barrier(0);
        const float sa = scal[2 * (c & 1)];
#pragma unroll
        for (int j = 0; j < 4; ++j) sacc[j] = sacc[j] * sa;
        float nsum = 0.f;
#pragma unroll
        for (int ks = 0; ks < 4; ++ks) { const bf16x8 kf = *(const LAS bf16x8*)(KW + kwb + ((ks ^ kwh) << 6)); bf16x8 vf[4];
#pragma unroll
            for (int j = 0; j < 4; ++j) vf[j] = *(const LAS bf16x8*)(VT + vtb[j & 1] + j * 16 * MX_PITCH + ((ks ^ (j >> 1)) << 6));
            if (ML) { float kv[8]; unpack8(__builtin_bit_cast(v4u, kf), kv); nsum += ((kv[0] + kv[1]) + (kv[2] + kv[3])) + ((kv[4] + kv[5]) + (kv[6] + kv[7])); }
#pragma unroll
            for (int j = 0; j < 4; ++j) sacc[j] = __builtin_amdgcn_mfma_f32_16x16x32_bf16(kf, vf[j], sacc[j], 0, 0, 0); }
        if (ML) { nsum += __shfl_xor(nsum, 16); nsum += __shfl_xor(nsum, 32); nreg = nreg * sa + nsum; }
        if (more) { MX_SCAN_A(c + 1); }
        __syncthreads();
        if (more) { MX_SCAN_B(c + 1); }
        __syncthreads();
        if (more) { MX_WRITE(c + 1); }
        __syncthreads();
    }
#undef MX_SCAN
#undef MX_SCAN_A
#undef MX_SCAN_L
#undef MX_SOFTPLUS
#undef MX_LOGSIG
#undef MX_SCAN_B
#undef MX_PREFETCH
#undef MX_WRITE
}
__device__ __forceinline__ void phase_mixer(Frame& F) {
    for (int unit = F.bid; unit < 256; unit += F.G) { mixer_unit<false>(F, unit); mixer_unit<true>(F, unit); }
}

__device__ __forceinline__ void phase3(Frame& F) {
    const bf16* PROJ = (const bf16*)(F.ws + WS_PROJ); bf16* YMIX = (bf16*)(F.ws + WS_YMIX); const float* SSQ = (const float*)(F.ws + WS_SSQ);
    const int gw = F.bid * NWAVES + F.wave, NGW = F.G * NWAVES;
    for (int t = gw; t < TT; t += NGW) {
        bf16* yrow = YMIX + (size_t)t * 4096;
#pragma unroll
        for (int j = 0; j < 8; ++j) {
            const int c0 = (j * 64 + F.lane) * 8;
            float y[8]; unpack8(*(const v4u*)(yrow + c0), y);
            float o[8];
            if (j < 4) {
                const int g = c0 >> 9; const f32x4 s0 = *(const f32x4*)(SSQ + (size_t)t * 32 + g * 8), s1 = *(const f32x4*)(SSQ + (size_t)t * 32 + g * 8 + 4);
                const float ms = ((s0.x + s0.y) + (s0.z + s0.w) + (s1.x + s1.y) + (s1.z + s1.w)) * (1.0f / 512.0f);
                const float rs = 1.0f / sqrtf(ms + EPSF);
                const f32x4 w0 = *(const f32x4*)(F.ssd_norm_w + c0), w1 = *(const f32x4*)(F.ssd_norm_w + c0 + 4);
                o[0] = y[0] * rs * w0.x; o[1] = y[1] * rs * w0.y; o[2] = y[2] * rs * w0.z; o[3] = y[3] * rs * w0.w;
                o[4] = y[4] * rs * w1.x; o[5] = y[5] * rs * w1.y; o[6] = y[6] * rs * w1.z; o[7] = y[7] * rs * w1.w;
            } else {
                const int cc = c0 - 2048, h = cc >> 8; const f32x4 s0 = *(const f32x4*)(SSQ + (size_t)TT * 32 + (size_t)t * 32 + h * 4);
                const float ms = ((s0.x + s0.y) + (s0.z + s0.w)) * (1.0f / 256.0f);
                const float rs = 1.0f / sqrtf(ms + EPSF);
                const f32x4 w0 = *(const f32x4*)(F.ml_norm_w + cc), w1 = *(const f32x4*)(F.ml_norm_w + cc + 4);
                float og[8]; unpack8(*(const v4u*)(PROJ + (size_t)t * NPROJ + PC_O + cc), og);
                const float wv[8] = {w0.x, w0.y, w0.z, w0.w, w1.x, w1.y, w1.z, w1.w};
#pragma unroll
                for (int i = 0; i < 8; ++i) o[i] = y[i] * rs * wv[i] * __builtin_amdgcn_rcpf(1.0f + __expf(-og[i]));
            }
            v4u ov; ov.x = pk2(o[0], o[1]); ov.y = pk2(o[2], o[3]); ov.z = pk2(o[4], o[5]); ov.w = pk2(o[6], o[7]);
            *(v4u*)(yrow + c0) = ov;
        }
    }
}

__device__ __forceinline__ void phase5(Frame& F) {
    const bf16* H2 = (const bf16*)(F.ws + WS_H2); const float* Wrt = (const float*)(F.ws + WS_WRT); bf16* XN2 = (bf16*)(F.ws + WS_XN2);
    int* EIDX = (int*)(F.ws + WS_ROUTE); int* RANK = EIDX + TT * 4;
    int* TOKL = (int*)(F.ws + WS_XG); float* GATEL = (float*)(F.ws + WS_XG + 4 * MiB);
    LAS float* xT = (LAS float*)(F.lds + F.wave * 8192); LAS float* lg = (LAS float*)(F.lds + 65536 + F.wave * 1024);
    LAS int* cntl = (LAS int*)(F.lds + 73728); LAS int* baseg = cntl + 32;
    const int gw = F.bid * NWAVES + F.wave, NGW = F.G * NWAVES, ntask = TT / 8, iters = (ntask + NGW - 1) / NGW;
    for (int itx = 0; itx < iters; ++itx) {
        const int task = itx * NGW + gw; const bool valid = task < ntask; const int t0 = task * 8;
        if (F.tid < 32) cntl[F.tid] = 0;
        __syncthreads();
        float rstd[8]; int me[4] = {0, 0, 0, 0}, mr[4] = {0, 0, 0, 0}; float mg[4] = {0.f, 0.f, 0.f, 0.f};
#pragma unroll
        for (int k = 0; k < 8; ++k) rstd[k] = 0.f;
        float acc[8], ssq[8];
#pragma unroll
        for (int k = 0; k < 8; ++k) { acc[k] = 0.f; ssq[k] = 0.f; }
        const int e = F.lane & 31, dh = F.lane >> 5;
        LAS float* wl = (LAS float*)(F.lds + 81920);
        for (int dc = 0; dc < 8; ++dc) {
            __syncthreads();
#pragma unroll
            for (int q = 0; q < 4; ++q) ((LAS f32x4*)wl)[F.tid + 512 * q] = ((const f32x4*)(Wrt + (size_t)dc * 256 * 32))[F.tid + 512 * q];
            if (valid) {
                f32x4 xk[8];
#pragma unroll
                for (int k = 0; k < 8; ++k) { { const v2u q_ = *(const v2u*)(H2 + (size_t)(t0 + k) * DM + dc * 256 + 4 * F.lane); xk[k] = (f32x4){bflo(q_.x), bfhi(q_.x), bflo(q_.y), bfhi(q_.y)}; } ssq[k] += (xk[k].x * xk[k].x + xk[k].y * xk[k].y) + (xk[k].z * xk[k].z + xk[k].w * xk[k].w); }
#pragma unroll
                for (int jj = 0; jj < 4; ++jj) { LAS float* dp = xT + (jj * 64 + F.lane) * 8;
                    *(LAS f32x4*)dp = (f32x4){xk[0][jj], xk[1][jj], xk[2][jj], xk[3][jj]}; *(LAS f32x4*)(dp + 4) = (f32x4){xk[4][jj], xk[5][jj], xk[6][jj], xk[7][jj]}; }
            }
            __syncthreads();
            if (valid) {
                const LAS float* xp = xT + dh * 128 * 8;
#pragma unroll 8
                for (int i = 0; i < 128; ++i) { const float w = wl[(4 * (i & 63) + 2 * dh + (i >> 6)) * 32 + e];     const f32x4 xa = *(const LAS f32x4*)(xp + i * 8), xb = *(const LAS f32x4*)(xp + i * 8 + 4);
                    acc[0] += w * xa.x; acc[1] += w * xa.y; acc[2] += w * xa.z; acc[3] += w * xa.w; acc[4] += w * xb.x; acc[5] += w * xb.y; acc[6] += w * xb.z; acc[7] += w * xb.w; }
            }
        }
        if (valid) {
            const float rb = F.router_b[e];
#pragma unroll
            for (int k = 0; k < 8; ++k) { rstd[k] = 1.0f / sqrtf(wave_sum(ssq[k]) * (1.0f / 2048.0f) + EPSF);
                const float v = (acc[k] + __shfl_xor(acc[k], 32)) * rstd[k] + rb; if (F.lane < 32) lg[k * 32 + e] = v; }
            LDS_WAIT(); asm volatile("" ::: "memory");
            if (F.lane < 8) {
                const LAS float* lp = lg + F.lane * 32; float bv[4]; int bi[4] = {-1, -1, -1, -1};
#pragma unroll
                for (int p = 0; p < 4; ++p) { float best = -3.0e38f; int bidx = 0;
                    for (int q = 0; q < 32; ++q) { const float v = lp[q]; const bool taken = (q == bi[0]) | (q == bi[1]) | (q == bi[2]) | (q == bi[3]); if (!taken && v > best) { best = v; bidx = q; } }
                    bv[p] = best; bi[p] = bidx; }
                const float p1 = expf(bv[1] - bv[0]), p2 = expf(bv[2] - bv[0]), p3 = expf(bv[3] - bv[0]); const float inv = 1.0f / (1.0f + p1 + p2 + p3);
                mg[0] = inv; mg[1] = p1 * inv; mg[2] = p2 * inv; mg[3] = p3 * inv;
#pragma unroll
                for (int p = 0; p < 4; ++p) { me[p] = bi[p]; mr[p] = __hip_atomic_fetch_add(cntl + bi[p], 1, __ATOMIC_RELAXED, __HIP_MEMORY_SCOPE_WORKGROUP); }
            }
        }
        __syncthreads();
        if (F.tid < 32) { const int c = cntl[F.tid]; int gb = 0; if (c > 0) gb = (int)__hip_atomic_fetch_add((unsigned*)(F.ctl + CW_CNT + 64 * F.tid), (unsigned)c, RLX_AGENT); baseg[F.tid] = gb; }
        __syncthreads();
        if (valid) {
            if (F.lane < 8) { const size_t t = (size_t)(t0 + F.lane);
#pragma unroll
                for (int p = 0; p < 4; ++p) { const int rk = baseg[me[p]] + mr[p]; EIDX[t * 4 + p] = me[p]; RANK[t * 4 + p] = rk; TOKL[(size_t)me[p] * TT + rk] = (int)t; GATEL[(size_t)me[p] * TT + rk] = mg[p]; } }
#pragma unroll
            for (int k = 0; k < 8; ++k) { const v2u* xr = (const v2u*)(H2 + (size_t)(t0 + k) * DM) + F.lane; const f32x4* wr = (const f32x4*)F.norm2_w + F.lane; int* o4 = (int*)((unsigned char*)XN2 + (size_t)(t0 + k) * DM) + F.lane;
#pragma unroll
                for (int j = 0; j < 8; ++j) { const v2u q_ = xr[64 * j]; const f32x4 v = (f32x4){bflo(q_.x), bfhi(q_.x), bflo(q_.y), bfhi(q_.y)}, ww = wr[64 * j]; int o = __builtin_amdgcn_cvt_pk_fp8_f32(v.x * rstd[k] * ww.x, v.y * rstd[k] * ww.y, 0, false); o = __builtin_amdgcn_cvt_pk_fp8_f32(v.z * rstd[k] * ww.z, v.w * rstd[k] * ww.w, o, true); o4[64 * j] = o; } }
        }
        __syncthreads();
    }
}
__device__ __forceinline__ int build_moe_tab(Frame& F) {
    LAS unsigned char* tab = (LAS unsigned char*)(F.lds + TAB_OFF); LAS int* tinfo = (LAS int*)(F.lds + TAB_OFF + 320);
    if (F.tid < 32) { const int c = (int)__hip_atomic_load((unsigned*)(F.ctl + CW_CNT + 64 * F.tid), RLX_AGENT); tinfo[4 + F.tid] = (c + 255) >> 8; tinfo[72 + F.tid] = c; }
    __syncthreads();
    if (F.tid == 0) { int a = 0; for (int e = 0; e < 32; ++e) { const int n = tinfo[4 + e]; tinfo[40 + e] = a; for (int j = 0; j < n; ++j) tab[a + j] = (unsigned char)e; a += n; } tinfo[0] = a; }
    __syncthreads();
    return tinfo[0];
}
__device__ __forceinline__ void phase8(Frame& F) {
    const bf16* H2 = (const bf16*)(F.ws + WS_H2); const bf16* YR = (const bf16*)(F.ws + WS_YR);
    const int* EIDX = (const int*)(F.ws + WS_ROUTE); const int* RANK = EIDX + TT * 4; (void)build_moe_tab(F); const LAS int* tinfo = (const LAS int*)(F.lds + TAB_OFF + 320);
    const int gw = F.bid * NWAVES + F.wave, NGW = F.G * NWAVES;
    for (int t = gw; t < TT; t += NGW) {
        int slot = 0; if (F.lane < 4) slot = 256 * tinfo[40 + EIDX[(size_t)t * 4 + F.lane]] + RANK[(size_t)t * 4 + F.lane];
        int sl[4]; sl[0] = __shfl(slot, 0); sl[1] = __shfl(slot, 1); sl[2] = __shfl(slot, 2); sl[3] = __shfl(slot, 3);
        float v[4][8]; float ss = 0.f;
#pragma unroll
        for (int j = 0; j < 4; ++j) { const int pz = F.lane + 64 * j; unpack8(*(const v4u*)(H2 + (size_t)t * DM + 8 * pz), v[j]); }
#pragma unroll
        for (int k = 0; k < 4; ++k)
#pragma unroll
            for (int j = 0; j < 4; ++j) { const v2u q = *((const v2u*)((const unsigned char*)YR + (size_t)sl[k] * DM) + F.lane + 64 * j);
                const f32x2 a0 = __builtin_amdgcn_cvt_pk_f32_fp8((int)q.x, false), a1 = __builtin_amdgcn_cvt_pk_f32_fp8((int)q.x, true), a2 = __builtin_amdgcn_cvt_pk_f32_fp8((int)q.y, false), a3 = __builtin_amdgcn_cvt_pk_f32_fp8((int)q.y, true);
                v[j][0] += a0.x * 0.0625f; v[j][1] += a0.y * 0.0625f; v[j][2] += a1.x * 0.0625f; v[j][3] += a1.y * 0.0625f; v[j][4] += a2.x * 0.0625f; v[j][5] += a2.y * 0.0625f; v[j][6] += a3.x * 0.0625f; v[j][7] += a3.y * 0.0625f; }
#pragma unroll
        for (int j = 0; j < 4; ++j)
#pragma unroll
            for (int i = 0; i < 8; ++i) ss += v[j][i] * v[j][i];
        const float rstd = 1.0f / sqrtf(wave_sum(ss) * (1.0f / 2048.0f) + EPSF);
#pragma unroll
        for (int j = 0; j < 4; ++j) { const int pz = F.lane + 64 * j; const f32x4 w0 = *(const f32x4*)(F.final_norm_w + 8 * pz), w1 = *(const f32x4*)(F.final_norm_w + 8 * pz + 4);
            *(f32x4*)(F.out + (size_t)t * DM + 8 * pz) = (f32x4){v[j][0] * rstd * w0.x, v[j][1] * rstd * w0.y, v[j][2] * rstd * w0.z, v[j][3] * rstd * w0.w};
            *(f32x4*)(F.out + (size_t)t * DM + 8 * pz + 4) = (f32x4){v[j][4] * rstd * w1.x, v[j][5] * rstd * w1.y, v[j][6] * rstd * w1.z, v[j][7] * rstd * w1.w}; }
    }
}

struct Args { const float* in[21]; float* out; unsigned char* ws; int ph_lo, ph_hi, li, pad; };
__global__ void __launch_bounds__(NWAVES * 64, 2) hymba_fwd(Args args) {
    extern __shared__ __attribute__((aligned(16))) unsigned char lds[];
    Frame F;
    F.lds = (LAS unsigned char*)lds; F.MISC = (volatile LAS unsigned*)(F.lds + MISC_OFF);
    F.tid = threadIdx.x; F.lane = F.tid & 63; F.wave = __builtin_amdgcn_readfirstlane(F.tid >> 6); F.G = gridDim.x; F.bid = blockIdx.x;
    F.ws = args.ws; F.ctl = (gu32*)(args.ws + WS_CTL); F.out = args.out;
    F.x = args.in[0]; F.norm1_w = args.in[1]; F.w_in = args.in[2]; F.conv_w = args.in[3]; F.conv_b = args.in[4]; F.dt_bias = args.in[5]; F.a_log = args.in[6]; F.d_skip = args.in[7]; F.ssd_norm_w = args.in[8];
    F.i_bias = args.in[9]; F.f_bias = args.in[10]; F.ml_norm_w = args.in[11]; F.w_out = args.in[12]; F.norm2_w = args.in[13]; F.router_w = args.in[14]; F.router_b = args.in[15];
    F.w_gate_up = args.in[16]; F.b_gate_up = args.in[17]; F.w_down = args.in[18]; F.b_down = args.in[19]; F.final_norm_w = args.in[20];
    for (int u = F.tid; u < (LDS_BYTES - LDSCTL_OFF) / 4; u += NWAVES * 64) ((LAS unsigned*)(F.lds + LDSCTL_OFF))[u] = 0u;
    __syncthreads();
    XcdBarrier bar; bar.bar = (unsigned*)(F.ctl + CW_BAR) + args.li * XCD_BAR_WORDS; bar.x = 0; bar.st = nullptr;
    const bool use_bar = (args.ph_hi - args.ph_lo) > 1;
    if (use_bar) bar = xcd_barrier_post((unsigned*)(F.ctl + CW_BAR) + args.li * XCD_BAR_WORDS, F.MISC + 8);
    const int lo = args.ph_lo, hi = args.ph_hi;
#ifndef PHASE_MASK
#define PHASE_MASK 0x1ff
#endif
#define IN(k) (((PHASE_MASK >> (k)) & 1) && lo <= (k) && (k) < hi)
#define SEAM(k) do { if (IN(k) && IN((k) + 1)) xcd_barrier(bar); } while (0)
    if (IN(0)) { phase0(F); } SEAM(0);
    if (IN(1)) {
        pg8::Gemm g{(const pg8::bf16_t*)(F.ws + WS_XN1), (const pg8::bf16_t*)(F.ws + WS_WIN), TT, NPROJ, DM}; pg8::StaticOrder S; S.init(TT, NPROJ, F.G, F.bid);
        pg8::EpiBf16 E{(pg8::bf16_t*)(F.ws + WS_PROJ), NPROJ};
        pg8::gemm_phase<pg8::EpiBf16, pg8::StaticOrder, true, true>(F.lds, g, S, E);
        p1_small(F);
    } SEAM(1);
    if (IN(2)) { phase_conv(F); } SEAM(2);
    if (IN(3)) { phase_mixer(F); } SEAM(3);
    if (IN(4)) {
        pg8::Gemm g{(const pg8::bf16_t*)(F.ws + WS_YMIX), (const pg8::bf16_t*)(F.ws + WS_WOUT), TT, DM, 4096}; pg8::StaticOrder S; S.init(TT, DM, F.G, F.bid);
        pg8::EpiResNorm E{(pg8::bf16_t*)(F.ws + WS_H2), F.x, DM, (const float*)(F.ws + WS_SSQ), (PG8_LAS float*)(F.lds + RING_BYTES), EPSF};
        pg8::gemm_phase<pg8::EpiResNorm, pg8::StaticOrder, true, true>(F.lds, g, S, E);
    } SEAM(4);
    if (IN(5)) { phase5(F); } SEAM(5);
    if (IN(6)) {
        const int nM = build_moe_tab(F);
        const LAS int* tinfo = (const LAS int*)(F.lds + TAB_OFF + 320); LAS unsigned short* rt = (LAS unsigned short*)(F.lds + ROWTAB_OFF);
        pg8::Gemm g{(const pg8::bf16_t*)(F.ws + WS_XN2), (const pg8::bf16_t*)(F.ws + WS_WGU), nM * 256, 4096, DM};
        pg8::MoeOrder S{nM, 16, 4, nM * 16, F.G, F.bid, (const PG8_LAS unsigned char*)(F.lds + TAB_OFF), (const PG8_LAS unsigned short*)rt};
        { const int* TOKL = (const int*)(F.ws + WS_XG);
          for (int i = 0; i < 18; ++i) { pg8::Unit u; if (!S.next(i, u)) break; const int e = u.pn >> 4, rank = (u.pm - tinfo[40 + e]) * 256 + (F.tid & 255);
              if (F.tid < 256) rt[i * 256 + F.tid] = (unsigned short)(rank < tinfo[72 + e] ? TOKL[(size_t)e * TT + rank] : 0); }
          __syncthreads(); }
        pg8::EpiSwiglu E{(unsigned char*)(F.ws + WS_ACT), F.b_gate_up, (PG8_LAS float*)(F.lds + EPIV_OFF)};
        pg8::gemm_phase<pg8::EpiSwiglu, pg8::MoeOrder, true, true, true, true>(F.lds, g, S, E);
    } SEAM(6);
    if (IN(7)) {
        const int nM = build_moe_tab(F);
        pg8::Gemm g{(const pg8::bf16_t*)(F.ws + WS_ACT), (const pg8::bf16_t*)(F.ws + WS_WD), nM * 256, 2048, DM};
        pg8::MoeOrder S{nM, 8, 3, nM * 8, F.G, F.bid, (const PG8_LAS unsigned char*)(F.lds + TAB_OFF), nullptr};
        pg8::EpiDown E{(pg8::bf16_t*)(F.ws + WS_YR), F.b_down, (const float*)(F.ws + WS_XG + 4 * MiB), (const PG8_LAS int*)(F.lds + TAB_OFF + 320), (PG8_LAS float*)(F.lds + EPIV_OFF)};
        pg8::gemm_phase<pg8::EpiDown, pg8::MoeOrder, true, true, true>(F.lds, g, S, E);
    } SEAM(7);
    if (IN(8)) { phase8(F); }
#undef IN
#undef SEAM
}

extern "C" void kernel_launch(void* const* d_in, const int* in_sizes, int n_in, void* d_out, int out_size, void* d_ws, size_t ws_size, hipStream_t stream) {
    static int grid = 0;
    if (grid == 0) {
        if (n_in != 21 || out_size != TT * DM || ws_size < WS_END) { fprintf(stderr, "kernel_launch: unexpected problem (n_in %d, out %d, ws %zu); nothing launched\n", n_in, out_size, ws_size); grid = -1; return; }
        int dev = 0, cus = 0, per_cu = 0;
        if (hipGetDevice(&dev) != hipSuccess || hipDeviceGetAttribute(&cus, hipDeviceAttributeMultiprocessorCount, dev) != hipSuccess) { grid = -1; return; }
        if (hipFuncSetAttribute((const void*)hymba_fwd, hipFuncAttributeMaxDynamicSharedMemorySize, LDS_BYTES) != hipSuccess) { fprintf(stderr, "kernel_launch: hipFuncSetAttribute failed\n"); grid = -1; return; }
        if (hipOccupancyMaxActiveBlocksPerMultiprocessor(&per_cu, (const void*)hymba_fwd, NWAVES * 64, LDS_BYTES) != hipSuccess || per_cu < 1) { fprintf(stderr, "kernel_launch: occupancy query says %d blocks per CU\n", per_cu); }
        (void)hipGetLastError();
        grid = cus;
    }
    if (grid < 0) return;
    (void)hipMemsetAsync((char*)d_ws + WS_CTL, 0, CTL_ZERO_BYTES, stream);
    Args a{};
    for (int i = 0; i < 21; ++i) a.in[i] = (const float*)d_in[i];
    a.out = (float*)d_out; a.ws = (unsigned char*)d_ws; a.pad = 0;
#if MK_PER_PHASE
    for (int li = 0; li < N_PHASES; ++li) { a.ph_lo = li; a.ph_hi = li + 1; a.li = li; hipLaunchKernelGGL(hymba_fwd, dim3(grid), dim3(NWAVES * 64), LDS_BYTES, stream, a); }
#else
    a.ph_lo = 0; a.ph_hi = N_PHASES; a.li = 0;
    hipLaunchKernelGGL(hymba_fwd, dim3(grid), dim3(NWAVES * 64), LDS_BYTES, stream, a);
#endif
}
```

```cpp
#include <hip/hip_runtime.h>
#include <cstdio>
#include <cstdint>
namespace pg8 {
#define PG8_LAS __attribute__((address_space(3)))
typedef unsigned short bf16_t;
typedef short bf16x8 __attribute__((ext_vector_type(8)));
typedef float f32x4 __attribute__((ext_vector_type(4)));
typedef unsigned u32x4 __attribute__((ext_vector_type(4)));
constexpr int BM = 256, BK = 64, HALF = 128, HTB = HALF * BK * 2  , STAGE_BYTES = 8 * HTB, NXCD = 8, WGM = 4;

__host__ __device__ __forceinline__ int lds_byte(int r, int c) { const int st = (r >> 4) * 2 + (c >> 5), rr = r & 15, cc = c & 31, ob = rr * 64 + cc * 2; return st * 1024 + (ob ^ (((ob >> 9) & 1) << 5)); }
__host__ __device__ __forceinline__ void stage_rc(int b, int& R, int& C) { const int st = b / 1024, sb = b % 1024, swz = sb ^ (((sb >> 9) & 1) << 5); R = (st >> 1) * 16 + swz / 64; C = (st & 1) * 32 + (swz % 64) / 2; }
__host__ __device__ __forceinline__ int perm32(int rho) { const int n = rho >> 4, i = rho & 15; return 8 * (i >> 2) + 4 * n + (i & 3); }

struct Unit { int pm, pn, par; };
struct Gemm { const bf16_t* A; const bf16_t* Bt; int M, N, K; };

struct StaticOrder {
    int nM, nN, nwg, G, c;
    __host__ __device__ void init(int M, int N, int G_, int c_) { nM = M / BM; nN = N / BM; nwg = nM * nN; G = G_; c = c_; }
    __host__ __device__ bool next(int i, Unit& u) const {
        const long L = (long)i * G + c; if (L >= nwg) return false;
        int wgid = (int)L; { const int q = nwg / NXCD, r = nwg % NXCD, xcd = wgid % NXCD, off = wgid / NXCD; wgid = (xcd < r ? xcd * (q + 1) : r * (q + 1) + (xcd - r) * q) + off; }
        const int nig = WGM * nN, gid = wgid / nig, fm = gid * WGM, gsz = (nM - fm) < WGM ? (nM - fm) : WGM;
        u.pm = fm + ((wgid % nig) % gsz); u.pn = (wgid % nig) / gsz; return true;
    }
    __device__ __forceinline__ const PG8_LAS unsigned short* rowp(int) const { return nullptr; }
    __device__ __forceinline__ void a_ready(const Unit&) const {}
    __device__ __forceinline__ void done(const Unit&) const {}
};


__device__ __forceinline__ unsigned cvt_pk_bf16(float lo, float hi) { unsigned r; asm volatile("v_cvt_pk_bf16_f32 %0, %1, %2" : "=v"(r) : "v"(lo), "v"(hi)); return r; }
typedef unsigned u32x2 __attribute__((ext_vector_type(2)));

struct EpiBf16 {
    static constexpr bool PERM = true, AFTER_DRAIN = false;
    bf16_t* O; int ldc;
    __device__ __forceinline__ void operator()(const f32x4 (&acc)[2][2][4][2], const Unit& u, int wr, int wc, int fr, int fq) const {
        const int row0 = u.pm * BM + wr * 64 + fr; const int col0 = u.pn * BM + wc * 32 + 8 * fq;
#pragma unroll
        for (int ai = 0; ai < 2; ++ai)
#pragma unroll
            for (int m = 0; m < 4; ++m) { bf16_t* rowp = O + (size_t)(row0 + ai * HALF + m * 16) * ldc + col0;
#pragma unroll
                for (int bj = 0; bj < 2; ++bj) { const f32x4 v0 = acc[ai][bj][m][0], v1 = acc[ai][bj][m][1];
                    u32x4 w; w.x = cvt_pk_bf16(v0[0], v0[1]); w.y = cvt_pk_bf16(v0[2], v0[3]); w.z = cvt_pk_bf16(v1[0], v1[1]); w.w = cvt_pk_bf16(v1[2], v1[3]);
                    *(u32x4*)(rowp + bj * HALF) = w; } }
    }
};
struct EpiResNorm {
    static constexpr bool PERM = true, AFTER_DRAIN = false, KSCALE = true;
    bf16_t* C; const float* base; int ldc; const float* ssq; PG8_LAS float* tabl; float eps;
    __device__ __forceinline__ void build(const Unit& u, int tid) const {
        const int row = tid & 255, part = tid >> 8; const size_t t = (size_t)u.pm * BM + row; float rs[7];
        if (part == 0) { const f32x4* p = (const f32x4*)(ssq + t * 32);
#pragma unroll
            for (int g = 0; g < 4; ++g) { const f32x4 a = p[2 * g], b = p[2 * g + 1]; rs[g] = 1.0f / sqrtf(((a.x + a.y) + (a.z + a.w) + (b.x + b.y) + (b.z + b.w)) * (1.0f / 512.0f) + eps); }
            const f32x4* q = (const f32x4*)(ssq + (size_t)16384 * 32 + t * 32);
#pragma unroll
            for (int h = 0; h < 3; ++h) { const f32x4 a = q[h]; rs[4 + h] = 1.0f / sqrtf(((a.x + a.y) + (a.z + a.w)) * (1.0f / 256.0f) + eps); }
        } else { const f32x4* q = (const f32x4*)(ssq + (size_t)16384 * 32 + t * 32);
#pragma unroll
            for (int h = 0; h < 6; ++h) { const f32x4 a = q[2 + h]; rs[h] = 1.0f / sqrtf(((a.x + a.y) + (a.z + a.w)) * (1.0f / 256.0f) + eps); }
            rs[6] = 1.0f; }
        PG8_LAS float* d = tabl + row * 12 + 6 * part;
#pragma unroll
        for (int s = 0; s < 6; ++s) d[s] = (part == 1 && s == 5) ? rs[5] : rs[s] / rs[s + 1];
    }
    __device__ __forceinline__ void kscale(f32x4 (&acc)[2][2][4][2], int t, int nt, int wr, int fr) const {
        const int kt = t + 1; const bool segend = kt < 32 ? ((kt & 7) == 7) : ((kt & 3) == 3);
        if (segend && kt != nt - 1) { const int sg = kt < 32 ? (kt >> 3) : 4 + ((kt - 32) >> 2);
#pragma unroll
            for (int ai = 0; ai < 2; ++ai)
#pragma unroll
                for (int m = 0; m < 4; ++m) { const float r = tabl[(ai * HALF + wr * 64 + m * 16 + fr) * 12 + sg];
#pragma unroll
                    for (int bj = 0; bj < 2; ++bj)
#pragma unroll
                        for (int n = 0; n < 2; ++n) acc[ai][bj][m][n] = acc[ai][bj][m][n] * r; } }
    }
    __device__ __forceinline__ void operator()(const f32x4 (&acc)[2][2][4][2], const Unit& u, int wr, int wc, int fr, int fq) const {
        const int row0 = u.pm * BM + wr * 64 + fr, col0 = u.pn * BM + wc * 32 + 8 * fq;
#pragma unroll
        for (int ai = 0; ai < 2; ++ai)
#pragma unroll
            for (int m = 0; m < 4; ++m) { const size_t off = (size_t)(row0 + ai * HALF + m * 16) * ldc + col0; const float r = tabl[(ai * HALF + wr * 64 + m * 16 + fr) * 12 + 11];
#pragma unroll
                for (int bj = 0; bj < 2; ++bj) { const f32x4 v0 = acc[ai][bj][m][0] * r + *(const f32x4*)(base + off + bj * HALF), v1 = acc[ai][bj][m][1] * r + *(const f32x4*)(base + off + bj * HALF + 4);
                    u32x4 w; w.x = cvt_pk_bf16(v0[0], v0[1]); w.y = cvt_pk_bf16(v0[2], v0[3]); w.z = cvt_pk_bf16(v1[0], v1[1]); w.w = cvt_pk_bf16(v1[2], v1[3]);
                    *(u32x4*)(C + off + bj * HALF) = w; } }
    }
};
struct EpiResF32 {
    static constexpr bool PERM = false, AFTER_DRAIN = false;
    float* C; const float* base; int ldc;
    __device__ __forceinline__ void operator()(const f32x4 (&acc)[2][2][4][2], const Unit& u, int wr, int wc, int fr, int fq) const {
        const int row0 = u.pm * BM + wr * 64 + fr, col0 = u.pn * BM + wc * 32 + 4 * fq;
#pragma unroll
        for (int ai = 0; ai < 2; ++ai)
#pragma unroll
            for (int m = 0; m < 4; ++m) { const size_t off = (size_t)(row0 + ai * HALF + m * 16) * ldc + col0;
#pragma unroll
                for (int bj = 0; bj < 2; ++bj)
#pragma unroll
                    for (int n = 0; n < 2; ++n) *(f32x4*)(C + off + bj * HALF + n * 16) = acc[ai][bj][m][n] + *(const f32x4*)(base + off + bj * HALF + n * 16); }
    }
};
__device__ __forceinline__ float swiglu1(float a, float b) {
    const float glu = fminf(a, 7.0f), lin = fminf(fmaxf(b, -7.0f), 7.0f);
    return glu * __builtin_amdgcn_rcpf(1.0f + __expf(-1.702f * glu)) * (lin + 1.0f);
}
struct EpiSwiglu {
    static constexpr bool PERM = true, AFTER_DRAIN = false, PREFETCH = true, BMAP = true;
    unsigned char* O; const float* bias; PG8_LAS float* slot;
    __device__ __forceinline__ void prefetch(const Unit& u, int wid, int lane) const {
        if (wid == 0) { const int e = u.pn >> 4, pnl = u.pn & 15;
            __builtin_amdgcn_global_load_lds((const unsigned*)(bias + (size_t)e * 4096 + pnl * BM + 4 * lane), (PG8_LAS unsigned*)(slot + u.par * 256), 16, 0, 0); }
    }
    __device__ __forceinline__ void operator()(const f32x4 (&acc)[2][2][4][2], const Unit& u, int wr, int wc, int fr, int fq) const {
        const int pnl = u.pn & 15;
        const int row0 = u.pm * BM + wr * 64 + fr; const int hb0 = pnl * HALF + wc * 32 + 8 * fq;
        const PG8_LAS float* bp = slot + u.par * 256 + wc * 64 + 16 * fq;
        f32x4 bv[2][2];
#pragma unroll
        for (int bj = 0; bj < 2; ++bj)
#pragma unroll
            for (int n = 0; n < 2; ++n) bv[bj][n] = *(const PG8_LAS f32x4*)(bp + 8 * bj + 4 * n);
#pragma unroll
        for (int ai = 0; ai < 2; ++ai)
#pragma unroll
            for (int m = 0; m < 4; ++m) { unsigned char* rowp = O + (size_t)(row0 + ai * HALF + m * 16) * 2048 + hb0; int w2[2];
#pragma unroll
                for (int bj = 0; bj < 2; ++bj) { const f32x4 v0 = acc[ai][bj][m][0] + bv[bj][0], v1 = acc[ai][bj][m][1] + bv[bj][1];
                    int w = __builtin_amdgcn_cvt_pk_fp8_f32(swiglu1(v0[0], v0[1]), swiglu1(v0[2], v0[3]), 0, false);
                    w2[bj] = __builtin_amdgcn_cvt_pk_fp8_f32(swiglu1(v1[0], v1[1]), swiglu1(v1[2], v1[3]), w, true); }
                typedef int v2i32 __attribute__((ext_vector_type(2)));
                *(v2i32*)rowp = (v2i32){w2[0], w2[1]}; }
    }
};
struct EpiDown {
    static constexpr bool PERM = true, AFTER_DRAIN = false, PREFETCH = true;
    bf16_t* O; const float* bias; const float* gatel; const PG8_LAS int* tinfo; PG8_LAS float* slot;
    __device__ __forceinline__ void prefetch(const Unit& u, int wid, int lane) const {
        const int e = u.pn >> 3, pnl = u.pn & 7;
        if (wid == 0) __builtin_amdgcn_global_load_lds((const unsigned*)(bias + (size_t)e * 2048 + pnl * BM + 4 * lane), (PG8_LAS unsigned*)(slot + u.par * 512), 16, 0, 0);
        if (wid == 1) __builtin_amdgcn_global_load_lds((const unsigned*)(gatel + (size_t)e * 16384 + (size_t)(u.pm - tinfo[40 + e]) * BM + 4 * lane), (PG8_LAS unsigned*)(slot + u.par * 512 + 256), 16, 0, 0);
    }
    __device__ __forceinline__ void operator()(const f32x4 (&acc)[2][2][4][2], const Unit& u, int wr, int wc, int fr, int fq) const {
        const int pnl = u.pn & 7;
        const int row0 = u.pm * BM + wr * 64 + fr; const int col0 = pnl * BM + wc * 32 + 8 * fq;
        const PG8_LAS float* bp = slot + u.par * 512 + wc * 32 + 8 * fq; const PG8_LAS float* gp = slot + u.par * 512 + 256 + wr * 64 + fr;
        f32x4 bv[2][2];
#pragma unroll
        for (int bj = 0; bj < 2; ++bj)
#pragma unroll
            for (int n = 0; n < 2; ++n) bv[bj][n] = *(const PG8_LAS f32x4*)(bp + bj * HALF + 4 * n);
#pragma unroll
        for (int ai = 0; ai < 2; ++ai)
#pragma unroll
            for (int m = 0; m < 4; ++m) { const int row = row0 + ai * HALF + m * 16; const float gt = gp[ai * HALF + m * 16] * 16.0f; unsigned char* rowp = (unsigned char*)O + (size_t)row * 2048 + col0;
#pragma unroll
                for (int bj = 0; bj < 2; ++bj) { const f32x4 v0 = (acc[ai][bj][m][0] + bv[bj][0]) * gt, v1 = (acc[ai][bj][m][1] + bv[bj][1]) * gt;
                    int w0 = __builtin_amdgcn_cvt_pk_fp8_f32(v0[0], v0[1], 0, false); w0 = __builtin_amdgcn_cvt_pk_fp8_f32(v0[2], v0[3], w0, true);
                    int w1 = __builtin_amdgcn_cvt_pk_fp8_f32(v1[0], v1[1], 0, false); w1 = __builtin_amdgcn_cvt_pk_fp8_f32(v1[2], v1[3], w1, true);
                    *(u32x2*)(rowp + bj * HALF) = (u32x2){(unsigned)w0, (unsigned)w1}; } }
    }
};
struct MoeOrder {
    int nM, nN, nsh, nwg, G, c; const PG8_LAS unsigned char* tab; const PG8_LAS unsigned short* rt;
    __device__ __forceinline__ const PG8_LAS unsigned short* rowp(int ui) const { return rt + ui * 256; }
    __device__ __forceinline__ bool next(int i, Unit& u) const {
        const long L = (long)i * G + c; if (L >= nwg) return false;
        int wgid = (int)L; { const int q = nwg / NXCD, r = nwg % NXCD, xcd = wgid % NXCD, off = wgid / NXCD; wgid = (xcd < r ? xcd * (q + 1) : r * (q + 1) + (xcd - r) * q) + off; }
        const int nig = WGM * nN, gid = wgid / nig, fm = gid * WGM, gsz = (nM - fm) < WGM ? (nM - fm) : WGM;
        const int pm = fm + ((wgid % nig) % gsz), pnl = (wgid % nig) / gsz;
        u.pm = pm; u.pn = ((int)tab[pm] << nsh) + pnl; return true;
    }
    __device__ __forceinline__ void a_ready(const Unit&) const {}
    __device__ __forceinline__ void done(const Unit&) const {}
};
template <class E, class = void> struct epi_pref { static constexpr bool value = false; };
template <class E> struct epi_pref<E, decltype((void)E::PREFETCH)> { static constexpr bool value = E::PREFETCH; };
template <class E, class = void> struct epi_bmap { static constexpr bool value = false; };
template <class E> struct epi_bmap<E, decltype((void)E::BMAP)> { static constexpr bool value = E::BMAP; };
template <class E, class = void> struct epi_kscale { static constexpr bool value = false; };
template <class E> struct epi_kscale<E, decltype((void)E::KSCALE)> { static constexpr bool value = E::KSCALE; };
typedef int v8i32 __attribute__((ext_vector_type(8)));
__device__ __forceinline__ v8i32 pg8_cat(const bf16x8 lo, const bf16x8 hi) { typedef int v4i32 __attribute__((ext_vector_type(4))); const v4i32 a = __builtin_bit_cast(v4i32, lo), b = __builtin_bit_cast(v4i32, hi); return __builtin_shufflevector(a, b, 0, 1, 2, 3, 4, 5, 6, 7); }
template <class Epi, class Sched, bool ALIGN_EPI = false, bool SP2 = false, bool F8 = false, bool GA = false>
__device__ __forceinline__ void gemm_phase(PG8_LAS unsigned char* lds, const Gemm g, const Sched& S, const Epi& E) {
    const int tid = threadIdx.x, wid = __builtin_amdgcn_readfirstlane(tid >> 6), lane = tid & 63, wr = wid >> 2, wc = wid & 3, fr = lane & 15, fq = lane >> 4;
    const int K = g.K, KB = F8 ? K : 2 * K, nt = KB / 128;
    unsigned voffA[2], voffB[2]; int gaR[2]; unsigned gaC[2]; static_assert(!GA || SP2, "gathered A needs the SP2 loop");
#pragma unroll
    for (int i = 0; i < 2; ++i) { int R, C; stage_rc(tid * 16 + i * 8192, R, C);
        const int Rb = epi_bmap<Epi>::value ? (64 * (R >> 5) + 16 * ((R >> 2) & 3) + 4 * ((R >> 4) & 1) + (R & 3)) : (Epi::PERM ? ((R & ~31) + perm32(R & 31)) : R);
        voffA[i] = (unsigned)(R * KB + C * 2); voffB[i] = (unsigned)(Rb * KB + C * 2); gaR[i] = R; gaC[i] = (unsigned)(C * 2); }
    const size_t kstep = (size_t)(BK * 2);
    const size_t hstep = (size_t)HALF * KB;
    const size_t hstepB = epi_bmap<Epi>::value ? (size_t)8 * KB : hstep;
    const size_t tstep = 2 * hstep;
    const unsigned ldsw = (unsigned)wid * 1024u;
    int aoffk[2], boffk[2];
#pragma unroll
    for (int h = 0; h < 2; ++h) { aoffk[h] = lds_byte(wr * 64 + fr, fq * 8) + h * 1024; boffk[h] = lds_byte(wc * 32 + fr, fq * 8) + h * 1024; }
#define PG8_SA(b, h) (((b) * 2 + (h)) * HTB)
#define PG8_SB(b, h) ((4 + (b) * 2 + (h)) * HTB)
#define PG8_STAGE(bufoff, gbase, voff) do { _Pragma("unroll") for (int _i = 0; _i < 2; ++_i) \
        __builtin_amdgcn_global_load_lds((const unsigned*)((const char*)(gbase) + (voff)[_i]), (PG8_LAS unsigned*)(lds + (bufoff) + ldsw + _i * 8192), 16, 0, 0); } while (0)
#define PG8_STAGE_A(bufoff, kptr, h, usenext) do { if constexpr (GA) { _Pragma("unroll") for (int _i = 0; _i < 2; ++_i) { const unsigned _o = (usenext) ? gn[h][_i] : gc[h][_i]; \
            __builtin_amdgcn_global_load_lds((const unsigned*)((const char*)(kptr) + _o), (PG8_LAS unsigned*)(lds + (bufoff) + ldsw + _i * 8192), 16, 0, 0); } } \
        else { PG8_STAGE(bufoff, (kptr) + (h) * hstep, voffA); } } while (0)
#define PG8_GROWS(dst, ui_) do { const PG8_LAS unsigned short* _rt = S.rowp(ui_); _Pragma("unroll") for (int _h = 0; _h < 2; ++_h) _Pragma("unroll") for (int _i = 0; _i < 2; ++_i) dst[_h][_i] = (unsigned)_rt[gaR[_i] + 128 * _h] * (unsigned)KB + gaC[_i]; } while (0)
#define PG8_LDA(dst, b, h) do { if constexpr (F8) { _Pragma("unroll") for (int m = 0; m < 4; ++m) dst##8[m] = pg8_cat(*(const PG8_LAS bf16x8*)(lds + PG8_SA(b, h) + aoffk[0] + m * 2048), *(const PG8_LAS bf16x8*)(lds + PG8_SA(b, h) + aoffk[1] + m * 2048)); } \
        else { _Pragma("unroll") for (int m = 0; m < 4; ++m) _Pragma("unroll") for (int k = 0; k < 2; ++k) dst[m][k] = *(const PG8_LAS bf16x8*)(lds + PG8_SA(b, h) + aoffk[k] + m * 2048); } } while (0)
#define PG8_LDB(dst, b, h) do { if constexpr (F8) { _Pragma("unroll") for (int n = 0; n < 2; ++n) dst##8[n] = pg8_cat(*(const PG8_LAS bf16x8*)(lds + PG8_SB(b, h) + boffk[0] + n * 2048), *(const PG8_LAS bf16x8*)(lds + PG8_SB(b, h) + boffk[1] + n * 2048)); } \
        else { _Pragma("unroll") for (int n = 0; n < 2; ++n) _Pragma("unroll") for (int k = 0; k < 2; ++k) dst[n][k] = *(const PG8_LAS bf16x8*)(lds + PG8_SB(b, h) + boffk[k] + n * 2048); } } while (0)
#define PG8_MMA(ai, bj, At, Bt) do { __builtin_amdgcn_s_setprio(1); \
        if constexpr (F8) { _Pragma("unroll") for (int m = 0; m < 4; ++m) _Pragma("unroll") for (int n = 0; n < 2; ++n) \
            asm volatile("v_mfma_scale_f32_16x16x128_f8f6f4 %0, %1, %2, %0, %3, %4 op_sel_hi:[0,0,0]" : "+v"(acc[ai][bj][m][n]) : "v"(Bt##8[n]), "v"(At##8[m]), "v"(sc_w), "v"(sc_a)); } \
        else { _Pragma("unroll") for (int m = 0; m < 4; ++m) _Pragma("unroll") for (int n = 0; n < 2; ++n) _Pragma("unroll") for (int k = 0; k < 2; ++k) \
            acc[ai][bj][m][n] = __builtin_amdgcn_mfma_f32_16x16x32_bf16(Bt[n][k], At[m][k], acc[ai][bj][m][n], 0, 0, 0); } \
        __builtin_amdgcn_s_setprio(0); } while (0)
#define PG8_WAIT_V(n) asm volatile("s_waitcnt vmcnt(" #n ")" ::: "memory")
#define PG8_WAIT_L(n) asm volatile("s_waitcnt lgkmcnt(" #n ")" ::: "memory")
#define PG8_BAR __builtin_amdgcn_s_barrier()
#define PG8_SCHED __builtin_amdgcn_sched_barrier(0)
    Unit cur, nxt; int ui = 0;
    if (!S.next(0, cur)) return;
    cur.par = 0;
    f32x4 acc[2][2][4][2];
#pragma unroll
    for (int a = 0; a < 2; ++a)
#pragma unroll
        for (int b = 0; b < 2; ++b)
#pragma unroll
            for (int m = 0; m < 4; ++m)
#pragma unroll
                for (int n = 0; n < 2; ++n) acc[a][b][m][n] = (f32x4){0.f, 0.f, 0.f, 0.f};
    const int sc_w = 0x79797979, sc_a = 0x7f7f7f7f;
    bf16x8 At[4][2], B0[2][2], B1[2][2]; v8i32 At8[4], B08[2], B18[2];
    const char* cA = (const char*)g.A + (GA ? (size_t)0 : (size_t)cur.pm * tstep); const char* cB = (const char*)g.Bt + (size_t)cur.pn * tstep;
    unsigned gc[2][2] = {{0u, 0u}, {0u, 0u}}, gn[2][2] = {{0u, 0u}, {0u, 0u}};
    if constexpr (GA) { PG8_GROWS(gc, 0); }
    if constexpr (epi_kscale<Epi>::value) { E.build(cur, tid); asm volatile("s_waitcnt lgkmcnt(0)" ::: "memory"); PG8_BAR; asm volatile("" ::: "memory"); }
    S.a_ready(cur);
    if constexpr (SP2) {
        PG8_STAGE(PG8_SB(0, 0), cB, voffB); PG8_STAGE(PG8_SB(0, 1), cB + hstepB, voffB); PG8_STAGE_A(PG8_SA(0, 0), cA, 0, false); PG8_STAGE_A(PG8_SA(0, 1), cA, 1, false);
        if (wr == 1) PG8_BAR;
        PG8_WAIT_V(2); PG8_BAR;
        PG8_STAGE(PG8_SB(1, 0), cB + kstep, voffB); PG8_STAGE_A(PG8_SA(1, 0), cA + kstep, 0, false); PG8_STAGE(PG8_SB(1, 1), cB + hstepB + kstep, voffB);
        PG8_WAIT_V(6); PG8_BAR;
    } else {
        PG8_STAGE(PG8_SB(0, 0), cB, voffB); PG8_STAGE(PG8_SA(0, 0), cA, voffA); PG8_STAGE(PG8_SB(0, 1), cB + hstepB, voffB); PG8_STAGE(PG8_SA(0, 1), cA + hstep, voffA);
        if (wr == 1) PG8_BAR;
        PG8_WAIT_V(4); PG8_BAR;
        PG8_STAGE(PG8_SB(1, 0), cB + kstep, voffB); PG8_STAGE(PG8_SA(1, 0), cA + kstep, voffA); PG8_STAGE(PG8_SB(1, 1), cB + hstepB + kstep, voffB);
        PG8_WAIT_V(6); PG8_BAR;
    }
    for (;;) {
        const bool has_next = S.next(ui + 1, nxt); nxt.par = (ui + 1) & 1;
        const char* nA = (has_next && !GA) ? (const char*)g.A + (size_t)nxt.pm * tstep : cA; const char* nB = has_next ? (const char*)g.Bt + (size_t)nxt.pn * tstep : cB;
        if constexpr (GA) { if (has_next) { PG8_GROWS(gn, ui + 1); } else {
#pragma unroll
            for (int _h = 0; _h < 2; ++_h) { gn[_h][0] = gc[_h][0]; gn[_h][1] = gc[_h][1]; } } }
        for (int t = 0; t < nt; t += 2) {
            const bool last = (t == nt - 2);
            const char* a1 = cA + (size_t)(t + 1) * kstep;
            const char* a2 = last ? nA : cA + (size_t)(t + 2) * kstep; const char* b2 = last ? nB : cB + (size_t)(t + 2) * kstep;
            const char* a3 = a2 + kstep; const char* b3 = b2 + kstep;
            if (last && has_next) S.a_ready(nxt);
            if constexpr (epi_pref<Epi>::value) { if (t == 0) E.prefetch(cur, wid, lane); }
            if constexpr (SP2) {
            PG8_LDB(B0, 0, 0); PG8_LDB(B1, 0, 1); PG8_SCHED; PG8_LDA(At, 0, 0); PG8_STAGE_A(PG8_SA(1, 1), a1, 1, false);
            PG8_WAIT_V(8); PG8_WAIT_L(0); PG8_BAR; PG8_MMA(0, 0, At, B0); PG8_MMA(0, 1, At, B1); PG8_BAR; PG8_SCHED;
            PG8_LDA(At, 0, 1); PG8_STAGE(PG8_SB(0, 0), b2, voffB); PG8_STAGE(PG8_SB(0, 1), b2 + hstepB, voffB); PG8_STAGE_A(PG8_SA(0, 0), a2, 0, last);
            PG8_WAIT_V(8); PG8_WAIT_L(0); PG8_BAR; PG8_MMA(1, 0, At, B0); PG8_MMA(1, 1, At, B1); PG8_BAR; PG8_SCHED;
            PG8_LDB(B0, 1, 0); PG8_LDB(B1, 1, 1); PG8_SCHED; PG8_LDA(At, 1, 0); PG8_STAGE_A(PG8_SA(0, 1), a2, 1, last);
            PG8_WAIT_V(8); PG8_WAIT_L(0); PG8_BAR; PG8_MMA(0, 0, At, B0); PG8_MMA(0, 1, At, B1); PG8_BAR; PG8_SCHED;
            PG8_LDA(At, 1, 1); PG8_STAGE(PG8_SB(1, 0), b3, voffB); PG8_STAGE(PG8_SB(1, 1), b3 + hstepB, voffB); PG8_STAGE_A(PG8_SA(1, 0), a3, 0, last);
            PG8_WAIT_V(8); PG8_WAIT_L(0); PG8_BAR; PG8_MMA(1, 0, At, B0); PG8_MMA(1, 1, At, B1); PG8_BAR; PG8_SCHED;
            if constexpr (epi_kscale<Epi>::value) { E.kscale(acc, t, nt, wr, fr); PG8_SCHED; }
            } else {
            PG8_LDB(B0, 0, 0); PG8_SCHED; PG8_LDA(At, 0, 0); PG8_STAGE(PG8_SA(1, 1), a1 + hstep, voffA);
            PG8_WAIT_L(8); PG8_BAR; PG8_WAIT_L(0); PG8_MMA(0, 0, At, B0); PG8_BAR; PG8_SCHED;
            PG8_LDB(B1, 0, 1); PG8_STAGE(PG8_SB(0, 0), b2, voffB);
            PG8_BAR; PG8_WAIT_L(0); PG8_MMA(0, 1, At, B1); PG8_BAR;
            PG8_LDA(At, 0, 1); PG8_STAGE(PG8_SA(0, 0), a2, voffA);
            PG8_BAR; PG8_WAIT_L(0); PG8_MMA(1, 0, At, B0); PG8_BAR; PG8_SCHED;
            PG8_STAGE(PG8_SB(0, 1), b2 + hstepB, voffB);
            PG8_WAIT_V(6); PG8_BAR; PG8_MMA(1, 1, At, B1); PG8_BAR;
            PG8_LDB(B0, 1, 0); PG8_SCHED; PG8_LDA(At, 1, 0); PG8_STAGE(PG8_SA(0, 1), a2 + hstep, voffA);
            PG8_WAIT_L(8); PG8_BAR; PG8_WAIT_L(0); PG8_MMA(0, 0, At, B0); PG8_BAR; PG8_SCHED;
            PG8_LDB(B1, 1, 1); PG8_STAGE(PG8_SB(1, 0), b3, voffB);
            PG8_BAR; PG8_WAIT_L(0); PG8_MMA(0, 1, At, B1); PG8_BAR;
            PG8_LDA(At, 1, 1); PG8_STAGE(PG8_SA(1, 0), a3, voffA);
            PG8_BAR; PG8_WAIT_L(0); PG8_MMA(1, 0, At, B0); PG8_BAR; PG8_SCHED;
            PG8_STAGE(PG8_SB(1, 1), b3 + hstepB, voffB);
            PG8_WAIT_V(6); PG8_BAR; PG8_MMA(1, 1, At, B1); PG8_BAR;
            }
        }
        if constexpr (ALIGN_EPI) { if (wr == 0) PG8_BAR; }
        if constexpr (F8) asm volatile("s_nop 15\n\ts_nop 15" ::: "memory");
        if constexpr (!Epi::AFTER_DRAIN) { E(acc, cur, wr, wc, fr, fq); S.done(cur); }
        if (!has_next) break;
#pragma unroll
        for (int a = 0; a < 2; ++a)
#pragma unroll
            for (int b = 0; b < 2; ++b)
#pragma unroll
                for (int m = 0; m < 4; ++m)
#pragma unroll
                    for (int n = 0; n < 2; ++n) acc[a][b][m][n] = (f32x4){0.f, 0.f, 0.f, 0.f};
        if constexpr (epi_kscale<Epi>::value) { static_assert(!epi_kscale<Epi>::value || (ALIGN_EPI && SP2), "K-segment rescale needs aligned epilogues");
            asm volatile("s_waitcnt lgkmcnt(0)" ::: "memory"); PG8_BAR; asm volatile("" ::: "memory");
            E.build(nxt, tid); asm volatile("s_waitcnt lgkmcnt(0)" ::: "memory"); PG8_BAR; asm volatile("" ::: "memory"); }
        cur = nxt; cA = nA; cB = nB; ++ui;
        if constexpr (GA) {
#pragma unroll
            for (int _h = 0; _h < 2; ++_h) { gc[_h][0] = gn[_h][0]; gc[_h][1] = gn[_h][1]; } }
        if constexpr (ALIGN_EPI) { if (wr == 1) PG8_BAR; }
    }
    PG8_WAIT_V(0);
    if constexpr (!ALIGN_EPI) { if (wr == 0) PG8_BAR; }
    PG8_BAR;
    if constexpr (Epi::AFTER_DRAIN) { E.fused(acc, cur, wr, wc, fr, fq, lds, wid, lane); S.done(cur); }
#undef PG8_SA
#undef PG8_SB
#undef PG8_STAGE
#undef PG8_STAGE_A
#undef PG8_GROWS
#undef PG8_LDA
#undef PG8_LDB
#undef PG8_MMA
#undef PG8_WAIT_V
#undef PG8_WAIT_L
#undef PG8_BAR
#undef PG8_SCHED
}
}

constexpr int NWAVES = 8;
constexpr int TT = 16384, DM = 2048, SEQ = 2048;
constexpr int NPROJ = 11264;
constexpr int PC_Z = 0, PC_XBC = 2048, PC_Q = 5120, PC_K = 6144, PC_V = 7168, PC_O = 9216;
constexpr int WIN_LD = 11312;
constexpr int NSLOT = 65536 + 32 * 256;
constexpr float EPSF = 1e-5f;
#ifndef HSYNC_ON
#define HSYNC_ON 0
#endif
#define HWAIT() do { if (HSYNC_ON) asm volatile("s_waitcnt vmcnt(0) lgkmcnt(0)\n\ts_nop 15\n\ts_nop 15" ::: "memory"); } while (0)
#define HSYNC() do { if (HSYNC_ON) { HWAIT(); __syncthreads(); } } while (0)
#ifndef MK_PER_PHASE
#define MK_PER_PHASE 0
#endif
constexpr int N_PHASES = 9;

constexpr size_t MiB = 1u << 20;
constexpr size_t WS_CTL = 0, CTL_ZERO_BYTES = 1 * MiB;
constexpr size_t WS_WIN = 2 * MiB, WS_WSM = 46 * MiB, WS_WRT = 47 * MiB, WS_WOUT = 48 * MiB, WS_WGU = 64 * MiB, WS_WD = 576 * MiB;
constexpr size_t WS_XN1 = 832 * MiB, WS_PROJ = 896 * MiB, WS_SMALL = 1248 * MiB, WS_SSQ = 1252 * MiB, WS_YMIX = 1256 * MiB, WS_H2 = 1384 * MiB, WS_XN2 = 1512 * MiB;
constexpr size_t WS_ROUTE = 1576 * MiB, WS_XG = 1578 * MiB, WS_ACT = 1866 * MiB, WS_YR = 2154 * MiB, WS_XC = 2442 * MiB, WS_END = 2538 * MiB;
constexpr int CW_BAR = 4096;
constexpr int CW_CONV = 131072;
constexpr int CW_CNT = 65536;

constexpr int RING_BYTES = 131072;
constexpr int LDS_BYTES = 147456;
constexpr int LDSCTL_OFF = LDS_BYTES - 1024, MISC_OFF = LDSCTL_OFF;
constexpr int TAB_OFF = LDSCTL_OFF + 64;
constexpr int EPIV_OFF = RING_BYTES + 9216;
constexpr int ROWTAB_OFF = RING_BYTES;

#define GAS __attribute__((address_space(1)))
#define LAS __attribute__((address_space(3)))
typedef unsigned short bf16;
typedef unsigned v4u __attribute__((ext_vector_type(4)));
typedef unsigned v2u __attribute__((ext_vector_type(2)));
typedef float f32x4 __attribute__((ext_vector_type(4)));
typedef float f32x2 __attribute__((ext_vector_type(2)));
typedef short bf16x8 __attribute__((ext_vector_type(8)));
typedef GAS unsigned gu32;
#define RLX_AGENT __ATOMIC_RELAXED, __HIP_MEMORY_SCOPE_AGENT
#define LDS_WAIT() asm volatile("s_waitcnt lgkmcnt(0)" ::: "memory")
#define VM_WAIT() asm volatile("s_waitcnt vmcnt(0)" ::: "memory")
__device__ __forceinline__ unsigned f2bf(float f) { unsigned u = __builtin_bit_cast(unsigned, f); return (u + 0x7fffu + ((u >> 16) & 1u)) >> 16; }
__device__ __forceinline__ unsigned pk2(float lo, float hi) { return f2bf(lo) | (f2bf(hi) << 16); }
__device__ __forceinline__ float bflo(unsigned w) { return __builtin_bit_cast(float, w << 16); }
__device__ __forceinline__ float bfhi(unsigned w) { return __builtin_bit_cast(float, w & 0xffff0000u); }
__device__ __forceinline__ float wave_sum(float v) {
#pragma unroll
    for (int o = 1; o < 64; o <<= 1) v += __shfl_xor(v, o);
    return v;
}
__device__ __forceinline__ float softplusf(float x) { return x > 20.f ? x : log1pf(expf(x)); }
__device__ __forceinline__ float logsigf(float x) { return fminf(x, 0.f) - log1pf(expf(-fabsf(x))); }
__device__ __forceinline__ float siluf(float v) { return v * __builtin_amdgcn_rcpf(1.0f + __expf(-v)); }

#define XB_TMO      128
#define XB_XCNT(j)  (256  + 64 * (j))
#define XB_XSUB(j)  (1280 + 64 * (j))
#define XB_XGEN(j)  (2304 + 64 * (j))
#define XB_TOP      3328
#define XB_TOPGEN   3392
#define XCD_BAR_WORDS 3456
#define XB_SPIN_CAP (1u << 18)

__device__ __forceinline__ unsigned xb_ld(unsigned* p)              { return __hip_atomic_load(p, __ATOMIC_RELAXED, __HIP_MEMORY_SCOPE_AGENT); }
__device__ __forceinline__ unsigned xb_add(unsigned* p, unsigned v) { return __hip_atomic_fetch_add(p, v, __ATOMIC_RELAXED, __HIP_MEMORY_SCOPE_AGENT); }
__device__ __forceinline__ unsigned xb_xcc_id() { return (unsigned)__builtin_amdgcn_s_getreg((3 << 11) | 20) & 0xFu; }
#define XB_SPIN(cond, bar) do { unsigned _sp = 0; while (cond) { __builtin_amdgcn_s_sleep(1); \
    if ((++_sp & 255u) == 0u) { if (xb_ld(&(bar)[XB_TMO])) break; if (_sp > XB_SPIN_CAP) { atomicAdd(&(bar)[XB_TMO], 1u); break; } } } } while (0)

struct XcdBarrier {
    unsigned* bar; unsigned x;
    volatile LAS unsigned* st;
};

__device__ __forceinline__ XcdBarrier xcd_barrier_post(unsigned* bar, volatile LAS unsigned* st) {
    XcdBarrier b; b.bar = bar; b.x = xb_xcc_id(); b.st = st;
    if (threadIdx.x == 0) (void)xb_add(&bar[XB_XCNT(b.x)], 1u);
    return b;
}
__device__ __forceinline__ void xcd_barrier_complete(unsigned* bar, unsigned x, unsigned& nloc, unsigned& nx) {
    const unsigned G = gridDim.x * gridDim.y * gridDim.z;
    unsigned sum, cnt, mine, sp = 0u;
    for (;;) {
        sum = 0u; cnt = 0u; mine = 0u;
#pragma unroll
        for (unsigned j = 0; j < 16; ++j) { const unsigned c = xb_ld(&bar[XB_XCNT(j)]); sum += c; cnt += (c > 0u) ? 1u : 0u; mine = (j == x) ? c : mine; }
        if (sum == G) break;
        __builtin_amdgcn_s_sleep(1);
        if ((++sp & 255u) == 0u) { if (xb_ld(&bar[XB_TMO])) break; if (sp > XB_SPIN_CAP) { atomicAdd(&bar[XB_TMO], 1u); break; } }
    }
    nloc = mine > 0u ? mine : 1u; nx = cnt > 0u ? cnt : 1u;
}

__device__ __forceinline__ void xcd_barrier(const XcdBarrier& b) {
    asm volatile("s_waitcnt vmcnt(0)" ::: "memory");
    __syncthreads();
    if (threadIdx.x == 0) {
        unsigned* bar = b.bar;
        __builtin_amdgcn_s_waitcnt(0);
        unsigned nloc = b.st[0], nx = b.st[1];
        if (nloc == 0u) { xcd_barrier_complete(bar, b.x, nloc, nx); b.st[0] = nloc; b.st[1] = nx; }
        const unsigned old = xb_add(&bar[XB_XSUB(b.x)], 1u);
        const unsigned gen = old / nloc;
        if (old + 1u == (gen + 1u) * nloc) {
            __builtin_amdgcn_fence(__ATOMIC_RELEASE, "agent");
            asm volatile("s_waitcnt vmcnt(0)" ::: "memory");
            const unsigned og = xb_add(&bar[XB_TOP], 1u);
            const unsigned tg = og / nx;
            if (og + 1u == (tg + 1u) * nx) xb_add(&bar[XB_TOPGEN], 1u);
            else XB_SPIN(xb_ld(&bar[XB_TOPGEN]) == tg, bar);
            __builtin_amdgcn_fence(__ATOMIC_ACQUIRE, "agent");
            xb_add(&bar[XB_XGEN(b.x)], 1u);
            asm volatile("s_waitcnt vmcnt(0)" ::: "memory");
        } else {
            XB_SPIN(xb_ld(&bar[XB_XGEN(b.x)]) == gen, bar);
            __builtin_amdgcn_fence(__ATOMIC_ACQUIRE, "agent");
            asm volatile("s_waitcnt vmcnt(0)" ::: "memory");
        }
    }
    __syncthreads();
}

struct Frame {
    LAS unsigned char* lds;
    volatile LAS unsigned* MISC;
    gu32* ctl;
    int tid, lane, wave, G, bid;
    const float *x, *norm1_w, *w_in, *conv_w, *conv_b, *dt_bias, *a_log, *d_skip, *ssd_norm_w, *i_bias, *f_bias, *ml_norm_w, *w_out, *norm2_w, *router_w, *router_b, *w_gate_up, *b_gate_up, *w_down, *b_down, *final_norm_w;
    float* out; unsigned char* ws;
};

__device__ __forceinline__ void p0_transpose_item(const float* W, int ldw, int K, bf16* WT, int dst_row0, int src_col0, int k0, LAS float* scr, int lane) {
#pragma unroll 8
    for (int i = 0; i < 32; ++i) { const int kk = 2 * i + (lane >> 5); scr[kk * 33 + (lane & 31)] = W[(size_t)(k0 + kk) * ldw + src_col0 + (lane & 31)]; }
    LDS_WAIT(); asm volatile("" ::: "memory");
    const int c = lane & 7;
#pragma unroll
    for (int j = 0; j < 4; ++j) { const int n = (lane >> 3) + 8 * j; const LAS float* s = scr + (8 * c) * 33 + n;
        v4u o; o.x = pk2(s[0 * 33], s[1 * 33]); o.y = pk2(s[2 * 33], s[3 * 33]); o.z = pk2(s[4 * 33], s[5 * 33]); o.w = pk2(s[6 * 33], s[7 * 33]);
        *(v4u*)(WT + (size_t)(dst_row0 + n) * K + k0 + 8 * c) = o; }
    LDS_WAIT(); asm volatile("" ::: "memory");
}
__device__ __forceinline__ void p0_transpose_item_f8(const float* W, int ldw, int K, unsigned char* WT, int dst_row0, int src_col0, int k0, LAS float* scr, int lane) {
#pragma unroll 8
    for (int i = 0; i < 32; ++i) { const int kk = 2 * i + (lane >> 5); scr[kk * 33 + (lane & 31)] = W[(size_t)(k0 + kk) * ldw + src_col0 + (lane & 31)] * 64.0f; }
    LDS_WAIT(); asm volatile("" ::: "memory");
    const int c = lane & 3;
#pragma unroll
    for (int j = 0; j < 2; ++j) { const int n = (lane >> 2) + 16 * j; const LAS float* s = scr + (16 * c) * 33 + n; int o[4];
#pragma unroll
        for (int q = 0; q < 4; ++q) { int w = __builtin_amdgcn_cvt_pk_fp8_f32(s[(4 * q) * 33], s[(4 * q + 1) * 33], 0, false); o[q] = __builtin_amdgcn_cvt_pk_fp8_f32(s[(4 * q + 2) * 33], s[(4 * q + 3) * 33], w, true); }
        *(v4u*)(WT + (size_t)(dst_row0 + n) * K + k0 + 16 * c) = (v4u){(unsigned)o[0], (unsigned)o[1], (unsigned)o[2], (unsigned)o[3]}; }
    LDS_WAIT(); asm volatile("" ::: "memory");
}
template <bool F8> __device__ __forceinline__ void p0_transpose128(const float* W, int ldw, int K, void* WTv, int dst_row0, int src_col0, int k0, LAS float* scr, int lane) {
    const float* src = W + (size_t)(k0 + (lane >> 3)) * ldw + src_col0 + 4 * (lane & 7);
    f32x4 v[16];
#pragma unroll
    for (int i = 0; i < 16; ++i) v[i] = *(const f32x4*)(src + (size_t)(8 * i) * ldw);
#pragma unroll
    for (int i = 0; i < 16; ++i) { LAS float* d = scr + (8 * i + (lane >> 3)) * 33 + 4 * (lane & 7); d[0] = v[i].x; d[1] = v[i].y; d[2] = v[i].z; d[3] = v[i].w; }
    LDS_WAIT(); asm volatile("" ::: "memory");
    const int n = lane & 31, hf = lane >> 5; const LAS float* s = scr + (64 * hf) * 33 + n;
    if (F8) { unsigned char* dst = (unsigned char*)WTv + (size_t)(dst_row0 + n) * K + k0 + 64 * hf;
#pragma unroll
        for (int j = 0; j < 4; ++j) { int o[4];
#pragma unroll
            for (int q = 0; q < 4; ++q) { const LAS float* p = s + (16 * j + 4 * q) * 33; int w = __builtin_amdgcn_cvt_pk_fp8_f32(p[0] * 64.0f, p[33] * 64.0f, 0, false); o[q] = __builtin_amdgcn_cvt_pk_fp8_f32(p[66] * 64.0f, p[99] * 64.0f, w, true); }
            *(v4u*)(dst + 16 * j) = (v4u){(unsigned)o[0], (unsigned)o[1], (unsigned)o[2], (unsigned)o[3]}; }
    } else { bf16* dst = (bf16*)WTv + (size_t)dst_row0 * K + k0;
#pragma unroll
        for (int j = 0; j < 8; ++j) { const int q_ = lane + 64 * j, n_ = q_ >> 4, p_ = q_ & 15; const LAS float* p = scr + (8 * p_) * 33 + n_;
            *(v4u*)(dst + (size_t)n_ * K + 8 * p_) = (v4u){pk2(p[0], p[33]), pk2(p[66], p[99]), pk2(p[132], p[165]), pk2(p[198], p[231])}; }
    }
    LDS_WAIT(); asm volatile("" ::: "memory");
}
__device__ __forceinline__ void rms_row_to_bf16(const float* xrow, const float* w, bf16* orow, int lane) {
    const f32x4* xr = (const f32x4*)xrow + lane; const f32x4* wr = (const f32x4*)w + lane;
    f32x4 v[8]; float s = 0.f;
#pragma unroll
    for (int j = 0; j < 8; ++j) { v[j] = xr[64 * j]; s += (v[j].x * v[j].x + v[j].y * v[j].y) + (v[j].z * v[j].z + v[j].w * v[j].w); }
    const float rstd = 1.0f / sqrtf(wave_sum(s) * (1.0f / 2048.0f) + EPSF);
    v2u* o8 = (v2u*)orow + lane;
#pragma unroll
    for (int j = 0; j < 8; ++j) { const f32x4 ww = wr[64 * j]; v2u o; o.x = pk2(v[j].x * rstd * ww.x, v[j].y * rstd * ww.y); o.y = pk2(v[j].z * rstd * ww.z, v[j].w * rstd * ww.w); o8[64 * j] = o; }
}
struct P0Item { const float* src; unsigned char* dst; int ldw; };
__device__ __forceinline__ void p0_moe_weights_coop(Frame& F, const int first, const int base) {
    LAS int* slot = (LAS int*)(F.lds + 139264); unsigned* cnt = (unsigned*)(F.ctl + CW_CONV);
    unsigned char* WguT = (unsigned char*)(F.ws + WS_WGU); unsigned char* WdT = (unsigned char*)(F.ws + WS_WD);
    constexpr int I_GU = 32 * 256, I_D = 32 * 128, NI = I_GU + I_D, NP = NI / 2;
    const int lrow = 32 * F.wave + 16 * (F.lane >> 5), lcol = 4 * (F.lane & 31);
    const int wchunk = 2 * F.wave + (F.lane >> 5);
    auto item = [&](int r) { P0Item it;
        if (r < I_GU) { const int e = r >> 8, rr = r & 255, kb = rr >> 5, nb = rr & 31; it.ldw = 4096; it.src = F.w_gate_up + (size_t)e * 2048 * 4096 + (size_t)(kb * 256 + lrow) * 4096 + nb * 128 + lcol; it.dst = WguT + (size_t)e * 4096 * 2048 + (size_t)(nb * 128) * 2048 + kb * 256; }
        else { r -= I_GU; const int e = r >> 7, rr = r & 127, kb = rr >> 4, nb = rr & 15; it.ldw = 2048; it.src = F.w_down + (size_t)e * 2048 * 2048 + (size_t)(kb * 256 + lrow) * 2048 + nb * 128 + lcol; it.dst = WdT + (size_t)e * 2048 * 2048 + (size_t)(nb * 128) * 2048 + kb * 256; }
        return it; };
#define P0_LOAD(v, itm) do { _Pragma("unroll") for (int i = 0; i < 16; ++i) v[i] = *(const f32x4*)((itm).src + (size_t)i * (itm).ldw); } while (0)
#define P0_PACK(v, buf) do { _Pragma("unroll") for (int j = 0; j < 4; ++j) { const int n_ = lcol + j; LAS unsigned char* wp_ = (buf) + n_ * 256 + ((wchunk ^ ((n_ >> 2) & 15)) << 4); \
            _Pragma("unroll") for (int q = 0; q < 4; ++q) { \
            int w_ = __builtin_amdgcn_cvt_pk_fp8_f32(v[4 * q][j] * 64.0f, v[4 * q + 1][j] * 64.0f, 0, false); w_ = __builtin_amdgcn_cvt_pk_fp8_f32(v[4 * q + 2][j] * 64.0f, v[4 * q + 3][j] * 64.0f, w_, true); \
            *(LAS int*)(wp_ + 4 * q) = w_; } } } while (0)
#define P0_OUT(buf, dstp) do { _Pragma("unroll") for (int j = 0; j < 4; ++j) { const int q_ = F.tid + 512 * j, n_ = q_ >> 4, p_ = q_ & 15; \
            *(v4u*)((dstp) + (size_t)n_ * 2048 + 16 * p_) = *(const LAS v4u*)((buf) + n_ * 256 + ((p_ ^ ((n_ >> 2) & 15)) << 4)); } } while (0)
    f32x4 va[16], vb[16];
    int pr = first;
    if (pr < 0) { if (F.tid == 0) slot[0] = base + (int)__hip_atomic_fetch_add(cnt, 1u, RLX_AGENT); __syncthreads(); pr = slot[0]; __syncthreads(); }
    if (pr >= NP) return;
    int pre = NP; if (F.tid == 0) pre = base + (int)__hip_atomic_fetch_add(cnt, 1u, RLX_AGENT);
    P0Item ia = item(2 * pr), ib = item(2 * pr + 1);
    P0_LOAD(va, ia); P0_LOAD(vb, ib);
    LAS unsigned char* b0 = F.lds; LAS unsigned char* b1 = F.lds + 32768;
    for (;;) {
        unsigned char* dst = ia.dst; P0_PACK(va, b0);
        if (F.tid == 0) slot[0] = pre;
        __syncthreads();
        const int npr = slot[0]; const bool more = npr < NP;
        if (more) { if (F.tid == 0) pre = base + (int)__hip_atomic_fetch_add(cnt, 1u, RLX_AGENT); ia = item(2 * npr); P0_LOAD(va, ia); }
        P0_OUT(b0, dst);
        dst = ib.dst; P0_PACK(vb, b1);
        if (more) { ib = item(2 * npr + 1); P0_LOAD(vb, ib); }
        __syncthreads();
        P0_OUT(b1, dst);
        if (!more) break;
    }
    __syncthreads();
#undef P0_LOAD
#undef P0_PACK
#undef P0_OUT
}
__device__ __forceinline__ void phase0(Frame& F) {
    LAS float* scr = (LAS float*)(F.lds + F.wave * 16896);
    const int gw = F.bid * NWAVES + F.wave, NGW = F.G * NWAVES;
    bf16* WinT = (bf16*)(F.ws + WS_WIN); bf16* WsT = (bf16*)(F.ws + WS_WSM); bf16* Wrt = (bf16*)(F.ws + WS_WRT); bf16* WoutT = (bf16*)(F.ws + WS_WOUT);
    bf16* XN1 = (bf16*)(F.ws + WS_XN1);
    constexpr int I_IN = 16 * 352, I_OUT = 32 * 64, NITEMS = I_IN + I_OUT;
    for (int it = gw; it < NITEMS; it += NGW) {
        int r = it;
        if (r < I_IN) { const int kb = r / 352, nb = r % 352, n0 = nb * 32; p0_transpose128<false>(F.w_in, WIN_LD, 2048, WinT, n0, n0 + (n0 >= 5120 ? 32 : 0), kb * 128, scr, F.lane); continue; } r -= I_IN;
        { const int kb = r >> 6, nb = r & 63; p0_transpose128<false>(F.w_out, 2048, 4096, WoutT, nb * 32, nb * 32, kb * 128, scr, F.lane); }
    }
    for (int i = gw * 64 + F.lane; i < 64 * 2048; i += NGW * 64) { const int j = i >> 11, k = i & 2047;
        const int col = j < 32 ? 5120 + j : (j < 40 ? 11296 + (j - 32) : 11304 + (j - 40));
        WsT[i] = (bf16)(j < 48 ? f2bf(F.w_in[(size_t)k * WIN_LD + col]) : 0u); }
    for (int i = gw * 64 + F.lane; i < 2048 * 32; i += NGW * 64) { const int d = i >> 5, e = i & 31; const float wv = F.norm2_w[d] * F.router_w[i]; const unsigned hi = f2bf(wv);
        Wrt[(size_t)e * 2048 + d] = (bf16)hi; Wrt[(size_t)(32 + e) * 2048 + d] = (bf16)f2bf(wv - bflo(hi)); }
    for (int m = gw; m < TT; m += NGW) rms_row_to_bf16(F.x + (size_t)m * DM, F.norm1_w, XN1 + (size_t)m * DM, F.lane);
}

__device__ __forceinline__ void p1_small(Frame& F) {
    const bf16* XN1 = (const bf16*)(F.ws + WS_XN1); const bf16* WsT = (const bf16*)(F.ws + WS_WSM); float* SMALL = (float*)(F.ws + WS_SMALL);
    constexpr int RP = 528;
    LAS unsigned char* xA = F.lds + F.wave * (8 * RP); LAS unsigned char* wl0 = F.lds + 40960;
    const int gw = F.bid * NWAVES + F.wave, NGW = F.G * NWAVES, ntask = TT / 8, iters = (ntask + NGW - 1) / NGW;
    const int fr = F.lane & 15, fq = F.lane >> 4, wrow = F.tid >> 3, wpc = F.tid & 7, xrow = F.lane >> 5, xpc = F.lane & 31;
    for (int itx = 0; itx < iters; ++itx) {
        const int task = itx * NGW + gw; const bool valid = task < ntask; const int t0 = valid ? task * 8 : 0;
        f32x4 acc[4];
#pragma unroll
        for (int n = 0; n < 4; ++n) acc[n] = (f32x4){0.f, 0.f, 0.f, 0.f};
        v4u wreg[4], xreg[4];
#pragma unroll
        for (int q = 0; q < 4; ++q) { wreg[q] = *(const v4u*)(WsT + (size_t)wrow * DM + 8 * (wpc + 8 * q)); xreg[q] = *(const v4u*)(XN1 + (size_t)(t0 + xrow + 2 * q) * DM + 8 * xpc); }
        for (int dc = 0; dc < 8; ++dc) {
            LAS unsigned char* wl = wl0 + (dc & 1) * (64 * RP);
#pragma unroll
            for (int q = 0; q < 4; ++q) { *(LAS v4u*)(wl + wrow * RP + 16 * (wpc + 8 * q)) = wreg[q]; *(LAS v4u*)(xA + (xrow + 2 * q) * RP + 16 * xpc) = xreg[q]; }
            if (dc < 7) {
#pragma unroll
                for (int q = 0; q < 4; ++q) { wreg[q] = *(const v4u*)(WsT + (size_t)wrow * DM + (dc + 1) * 256 + 8 * (wpc + 8 * q)); xreg[q] = *(const v4u*)(XN1 + (size_t)(t0 + xrow + 2 * q) * DM + (dc + 1) * 256 + 8 * xpc); } }
            __syncthreads();
#pragma unroll
            for (int ks = 0; ks < 8; ++ks) { const bf16x8 a = *(const LAS bf16x8*)(xA + (fr & 7) * RP + 64 * ks + 16 * fq);
#pragma unroll
                for (int n = 0; n < 4; ++n) { const bf16x8 bb = *(const LAS bf16x8*)(wl + (16 * n + fr) * RP + 64 * ks + 16 * fq); acc[n] = __builtin_amdgcn_mfma_f32_16x16x32_bf16(a, bb, acc[n], 0, 0, 0); } }
        }
        if (valid && fq < 2) {
#pragma unroll
            for (int n = 0; n < 4; ++n)
#pragma unroll
                for (int r = 0; r < 4; ++r) SMALL[(size_t)(t0 + 4 * fq + r) * 64 + n * 16 + fr] = acc[n][r];
        }
        __syncthreads();
    }
}

__device__ __forceinline__ void unpack8(const v4u r, float (&f)[8]) { f[0] = bflo(r.x); f[1] = bfhi(r.x); f[2] = bflo(r.y); f[3] = bfhi(r.y); f[4] = bflo(r.z); f[5] = bfhi(r.z); f[6] = bflo(r.w); f[7] = bfhi(r.w); }

__device__ __forceinline__ void phase_conv(Frame& F) {
    const bf16* PROJ = (const bf16*)(F.ws + WS_PROJ); bf16* XC = (bf16*)(F.ws + WS_XC);
    constexpr int TB = 16, NCG = 384, NIT = (TT / TB) * NCG;
    for (int it = F.bid * (NWAVES * 64) + F.tid; it < NIT; it += F.G * NWAVES * 64) {
        const int cg = it % NCG, tb = it / NCG, ch = cg * 8, t0 = tb * TB; const bool seq0 = (t0 % SEQ) == 0;
        float w[4][8], bs[8];
#pragma unroll
        for (int j = 0; j < 4; ++j) { const f32x4 a = *(const f32x4*)(F.conv_w + j * 3072 + ch), b = *(const f32x4*)(F.conv_w + j * 3072 + ch + 4);
            w[j][0] = a.x; w[j][1] = a.y; w[j][2] = a.z; w[j][3] = a.w; w[j][4] = b.x; w[j][5] = b.y; w[j][6] = b.z; w[j][7] = b.w; }
        { const f32x4 a = *(const f32x4*)(F.conv_b + ch), b = *(const f32x4*)(F.conv_b + ch + 4); bs[0] = a.x; bs[1] = a.y; bs[2] = a.z; bs[3] = a.w; bs[4] = b.x; bs[5] = b.y; bs[6] = b.z; bs[7] = b.w; }
        const bf16* src = PROJ + (size_t)t0 * NPROJ + PC_XBC + ch;
        float r0[8], r1[8], r2[8], r3[8];
        if (seq0) {
#pragma unroll
            for (int i = 0; i < 8; ++i) { r0[i] = 0.f; r1[i] = 0.f; r2[i] = 0.f; }
        } else { unpack8(*(const v4u*)(src - 3 * (size_t)NPROJ), r0); unpack8(*(const v4u*)(src - 2 * (size_t)NPROJ), r1); unpack8(*(const v4u*)(src - (size_t)NPROJ), r2); }
        v4u rw[TB];
#pragma unroll
        for (int l = 0; l < TB; ++l) rw[l] = *(const v4u*)(src + (size_t)l * NPROJ);
#pragma unroll
        for (int l = 0; l < TB; ++l) {
            unpack8(rw[l], r3);
            float o[8];
#pragma unroll
            for (int i = 0; i < 8; ++i) { const float v = bs[i] + w[0][i] * r0[i] + w[1][i] * r1[i] + w[2][i] * r2[i] + w[3][i] * r3[i]; o[i] = siluf(v); r0[i] = r1[i]; r1[i] = r2[i]; r2[i] = r3[i]; }
            v4u ov; ov.x = pk2(o[0], o[1]); ov.y = pk2(o[2], o[3]); ov.z = pk2(o[4], o[5]); ov.w = pk2(o[6], o[7]);
            *(v4u*)(XC + (size_t)(t0 + l) * 3072 + ch) = ov;
        }
    }
}

constexpr int MX_PITCH = 272;
static_assert(true, "");
constexpr int MX_QM = 0, MX_KM = 34816, MX_KW = 69632, MX_VT = 104448, MX_SI = 121856, MX_VEC = 139264, MX_VECB = 3072, MX_NVEC = MX_VEC + 2 * MX_VECB, MX_SCAL = MX_NVEC + 512, MX_END = MX_SCAL + 64;
__device__ __forceinline__ unsigned cvt_pk_bf16_nop(float lo, float hi) { unsigned r; asm volatile("v_cvt_pk_bf16_f32 %0, %1, %2\n\ts_nop 1" : "=v"(r) : "v"(lo), "v"(hi)); return r; }
__device__ __forceinline__ int mx_sw(int row, int tbyte) { return row * MX_PITCH + ((((tbyte >> 4) ^ (row >> 3)) & 15) << 4) + (tbyte & 15); }
__device__ __forceinline__ bf16x8 lds_frag(const LAS unsigned char* img, int row, int kbyte) { return *(const LAS bf16x8*)(img + row * MX_PITCH + kbyte); }
static_assert(MX_END + 256 <= LDSCTL_OFF, "mixer LDS map");
template <bool ML> __device__ __forceinline__ void mixer_unit(Frame& F, int unit) {
    const bf16* PROJ = (const bf16*)(F.ws + WS_PROJ); const bf16* XC = (const bf16*)(F.ws + WS_XC); const float* SMALL = (const float*)(F.ws + WS_SMALL);
    bf16* YMIX = (bf16*)(F.ws + WS_YMIX); float* SSQ = (float*)(F.ws + WS_SSQ);
    const int w = F.wave, fr = F.lane & 15, fq = F.lane >> 4, tid = F.tid;
    const int b = unit >> 5, tok0 = b * SEQ, hd = unit & 31, grp = hd >> 3, mh = (unit & 31) >> 2, vq = unit & 3;
    const float qs = 0.08838834764831845f;
    LAS unsigned char* QM = F.lds + MX_QM; LAS unsigned char* KM = F.lds + MX_KM; LAS unsigned char* KW = F.lds + MX_KW; LAS unsigned char* VT = F.lds + MX_VT; LAS unsigned char* SI = F.lds + MX_SI;
    LAS float* exch = (LAS float*)(F.lds + MX_VEC + (w >> 2) * MX_VECB + 1024) + (w & 3) * 32;
    LAS float* nvec = (LAS float*)(F.lds + MX_NVEC); LAS float* scal = (LAS float*)(F.lds + MX_SCAL);
    const int fr3 = fr >> 3;
    int vtb[2];
#pragma unroll
    for (int p = 0; p < 2; ++p) vtb[p] = fr * MX_PITCH + ((fq ^ ((2 * p) | fr3)) << 4);
    int vpb[2][2];
#pragma unroll
    for (int p = 0; p < 2; ++p)
#pragma unroll
        for (int h = 0; h < 2; ++h) vpb[p][h] = fr * MX_PITCH + (((((fq >> 1) | (2 * h)) ^ ((2 * p) | fr3))) << 4) + 8 * (fq & 1);
    const int kwb = (16 * w + fr) * MX_PITCH + ((fq ^ ((2 * (w & 1)) | fr3)) << 4), kwh = w >> 1;

    const bf16* qsrc; const bf16* ksrc; const bf16* vsrc; int ld;
    if (ML) { qsrc = PROJ + PC_Q + mh * 128; ksrc = PROJ + PC_K + mh * 128; vsrc = PROJ + PC_V + mh * 256 + vq * 64; ld = NPROJ; }
    else { qsrc = XC + 2560 + grp * 128; ksrc = XC + 2048 + grp * 128; vsrc = XC + hd * 64; ld = 3072; }
    const float c_a = ML ? 0.f : -expf(F.a_log[hd]), c_dtb = ML ? 0.f : F.dt_bias[hd], c_D = ML ? 0.f : F.d_skip[hd], c_ib = ML ? F.i_bias[mh] : 0.f, c_fb = ML ? F.f_bias[mh] : 0.f;
    float mprev = 0.f;
    f32x4 sacc[4]; float nreg = 0.f;
#pragma unroll
    for (int j = 0; j < 4; ++j) sacc[j] = (f32x4){0.f, 0.f, 0.f, 0.f};
    v4u pq[4], pk[4], pv[2];
    float vA0 = 0.f, vA1 = 0.f, vB0 = 0.f, vB1 = 0.f, vC0 = 0.f, vC1 = 0.f, vD0 = 0.f, vD1 = 0.f, vE0 = 0.f, vE1 = 0.f, vG0 = 0.f, vG1 = 0.f, vSA = 0.f, vSG = 0.f;
    float sl0 = 0.f, sl1 = 0.f, sl2 = 0.f, sl3 = 0.f;
#define MX_SCAN_L(c) do { if (w == 0) { const size_t tt = (size_t)(tok0 + 128 * (c) + 2 * F.lane); \
        if (!ML) { sl0 = SMALL[tt * 64 + hd]; sl1 = SMALL[(tt + 1) * 64 + hd]; } \
        else { sl0 = SMALL[tt * 64 + 32 + mh]; sl1 = SMALL[(tt + 1) * 64 + 32 + mh]; sl2 = SMALL[tt * 64 + 40 + mh]; sl3 = SMALL[(tt + 1) * 64 + 40 + mh]; } } } while (0)
#define MX_SOFTPLUS(x) ((x) > 20.f ? (x) : __logf(1.0f + __expf(x)))
#define MX_LOGSIG(x) (fminf((x), 0.f) - __logf(1.0f + __expf(-fabsf(x))))
#define MX_SCAN_A(c) do { if (w == 0) { \
        if (!ML) { const float d0 = MX_SOFTPLUS(sl0 + c_dtb), d1 = MX_SOFTPLUS(sl1 + c_dtb); \
            const float x0 = d0 * c_a, x1 = d1 * c_a; float incl = x0 + x1; \
            _Pragma("unroll") for (int d = 1; d < 64; d <<= 1) { const float t_ = __shfl_up(incl, d); if (F.lane >= d) incl += t_; } \
            const float cum1 = incl, cum0 = incl - x1, tot = __shfl(incl, 63); \
            vA0 = -cum0; vA1 = -cum1; vB0 = -cum0; vB1 = -cum1; vC0 = d0; vC1 = d1; vD0 = __expf(cum0); vD1 = __expf(cum1); vE0 = d0 * __expf(tot - cum0); vE1 = d1 * __expf(tot - cum1); vSA = __expf(tot); vSG = 1.0f; \
        } else { const float li0 = sl0 + c_ib, li1 = sl1 + c_ib; \
            const float x0 = MX_LOGSIG(sl2 + c_fb), x1 = MX_LOGSIG(sl3 + c_fb); float incl = x0 + x1; \
            _Pragma("unroll") for (int d = 1; d < 64; d <<= 1) { const float t_ = __shfl_up(incl, d); if (F.lane >= d) incl += t_; } \
            const float cum1 = incl, cum0 = incl - x1, btot = __shfl(incl, 63); \
            const float dd0 = li0 - cum0, dd1 = li1 - cum1; float im = fmaxf(dd0, dd1); \
            _Pragma("unroll") for (int d = 1; d < 64; d <<= 1) { const float t_ = __shfl_up(im, d); if (F.lane >= d) im = fmaxf(im, t_); } \
            float pm = __shfl_up(im, 1); if (F.lane == 0) pm = -3.0e38f; const float pmax0 = fmaxf(pm, dd0), pmax1 = im, pm127 = __shfl(im, 63); \
            const float M0 = fmaxf(mprev, pmax0), M1 = fmaxf(mprev, pmax1); \
            vA0 = dd0; vA1 = dd1; vB0 = M0; vB1 = M1; vD0 = qs * __expf(mprev - M0); vD1 = qs * __expf(mprev - M1); vG0 = __expf(-(cum0 + M0)); vG1 = __expf(-(cum1 + M1)); \
            const float mloc = btot + pm127, mnew = fmaxf(btot + mprev, mloc); \
            vSA = __expf(btot + mprev - mnew); vSG = __expf(mloc - mnew); vE0 = __expf(dd0 - pm127) * vSG; vE1 = __expf(dd1 - pm127) * vSG; mprev = mnew; } } } while (0)
#define MX_SCAN_B(c) do { if (w == 0) { \
        LAS float* vb = (LAS float*)(F.lds + MX_VEC + ((c) & 1) * MX_VECB); const int l0 = 2 * F.lane; \
        *(LAS f32x2*)(vb + l0) = (f32x2){vA0, vA1}; *(LAS f32x2*)(vb + 128 + l0) = (f32x2){vB0, vB1}; if (!ML) *(LAS f32x2*)(vb + 256 + l0) = (f32x2){vC0, vC1}; \
        *(LAS f32x2*)(vb + 384 + l0) = (f32x2){vD0, vD1}; *(LAS f32x2*)(vb + 512 + l0) = (f32x2){vE0, vE1}; if (ML) *(LAS f32x2*)(vb + 640 + l0) = (f32x2){vG0, vG1}; \
        if (F.lane == 0) { scal[2 * ((c) & 1)] = vSA; scal[2 * ((c) & 1) + 1] = vSG; } } } while (0)
#define MX_PREFETCH(c) do { const size_t tb_ = (size_t)(tok0 + 128 * (c)); \
        _Pragma("unroll") for (int i = 0; i < 2; ++i) { const int pid = tid + 512 * i, a2 = pid >> 4, k8 = pid & 15; \
            pq[2 * i] = *(const v4u*)(qsrc + (tb_ + 2 * a2) * ld + 8 * k8); pq[2 * i + 1] = *(const v4u*)(qsrc + (tb_ + 2 * a2 + 1) * ld + 8 * k8); \
            pk[2 * i] = *(const v4u*)(ksrc + (tb_ + 2 * a2) * ld + 8 * k8); pk[2 * i + 1] = *(const v4u*)(ksrc + (tb_ + 2 * a2 + 1) * ld + 8 * k8); } \
        { const int a2 = tid >> 3, v8 = tid & 7; pv[0] = *(const v4u*)(vsrc + (tb_ + 2 * a2) * ld + 8 * v8); pv[1] = *(const v4u*)(vsrc + (tb_ + 2 * a2 + 1) * ld + 8 * v8); } } while (0)
#define MX_WRITE(c) do { const LAS float* vb = (const LAS float*)(F.lds + MX_VEC + ((c) & 1) * MX_VECB); \
        _Pragma("unroll") for (int i = 0; i < 2; ++i) { const int pid = tid + 512 * i, a2 = pid >> 4, k8 = pid & 15, l = 2 * a2; \
            *(LAS v4u*)(QM + l * MX_PITCH + 16 * k8) = pq[2 * i]; *(LAS v4u*)(QM + (l + 1) * MX_PITCH + 16 * k8) = pq[2 * i + 1]; \
            *(LAS v4u*)(KM + l * MX_PITCH + 16 * k8) = pk[2 * i]; *(LAS v4u*)(KM + (l + 1) * MX_PITCH + 16 * k8) = pk[2 * i + 1]; \
            float f0[8], f1[8]; unpack8(pk[2 * i], f0); unpack8(pk[2 * i + 1], f1); const f32x2 wl = *(const LAS f32x2*)(vb + 512 + l); \
            _Pragma("unroll") for (int e = 0; e < 8; ++e) *(LAS unsigned*)(KW + mx_sw(8 * k8 + e, 2 * l)) = pg8::cvt_pk_bf16(f0[e] * wl.x, f1[e] * wl.y); } \
        { const int a2 = tid >> 3, v8 = tid & 7, l = 2 * a2; const v4u r0 = pv[0], r1 = pv[1]; LAS unsigned char* vp_ = VT + mx_sw(8 * v8, 2 * l); \
            *(LAS unsigned*)(vp_ + 0 * MX_PITCH) = (r0.x & 0xffffu) | (r1.x << 16); *(LAS unsigned*)(vp_ + 1 * MX_PITCH) = (r0.x >> 16) | (r1.x & 0xffff0000u); \
            *(LAS unsigned*)(vp_ + 2 * MX_PITCH) = (r0.y & 0xffffu) | (r1.y << 16); *(LAS unsigned*)(vp_ + 3 * MX_PITCH) = (r0.y >> 16) | (r1.y & 0xffff0000u); \
            *(LAS unsigned*)(vp_ + 4 * MX_PITCH) = (r0.z & 0xffffu) | (r1.z << 16); *(LAS unsigned*)(vp_ + 5 * MX_PITCH) = (r0.z >> 16) | (r1.z & 0xffff0000u); \
            *(LAS unsigned*)(vp_ + 6 * MX_PITCH) = (r0.w & 0xffffu) | (r1.w << 16); *(LAS unsigned*)(vp_ + 7 * MX_PITCH) = (r0.w >> 16) | (r1.w & 0xffff0000u); } \
        _Pragma("unroll") for (int j = 0; j < 4; ++j) { v2u sv; sv.x = pg8::cvt_pk_bf16(sacc[j][0], sacc[j][1]); sv.y = pg8::cvt_pk_bf16(sacc[j][2], sacc[j][3]); *(LAS v2u*)(SI + (16 * j + fr) * MX_PITCH + (16 * w + 4 * fq) * 2) = sv; } \
        if (ML && fq == 0) nvec[16 * w + fr] = nreg; } while (0)
    const int gcol = (ML ? PC_O + mh * 256 + vq * 64 : PC_Z + hd * 64) + 16 * (F.lane & 3);
    LAS float* nwl = (LAS float*)(F.lds + MX_END);
    if (tid < 64) nwl[tid] = ML ? F.ml_norm_w[mh * 256 + vq * 64 + tid] : F.ssd_norm_w[hd * 64 + tid];
    v4u zc0 = (v4u){0u, 0u, 0u, 0u}, zc1 = zc0;
    { const bf16* zp = PROJ + (size_t)(tok0 + 16 * w + (F.lane >> 2)) * NPROJ + gcol; zc0 = *(const v4u*)zp; zc1 = *(const v4u*)(zp + 8); }
    MX_SCAN_L(0); MX_PREFETCH(0);
    MX_SCAN_A(0); MX_SCAN_B(0);
    __syncthreads();
    MX_WRITE(0);
    __syncthreads();
    for (int c = 0; c < SEQ / 128; ++c) {
        const LAS float* vb = (const LAS float*)(F.lds + MX_VEC + (c & 1) * MX_VECB);
        const bool more = (c + 1 < SEQ / 128);
        if (more) { MX_SCAN_L(c + 1); MX_PREFETCH(c + 1); }
        bf16x8 qf[4];
#pragma unroll
        for (int ks = 0; ks < 4; ++ks) qf[ks] = lds_frag(QM, 16 * w + fr, 64 * ks + 16 * fq);
        const float mlv = vb[128 + 16 * w + fr];
        float dsum = 0.f;
        f32x4 y1[4];
#pragma unroll
        for (int j = 0; j < 4; ++j) y1[j] = (f32x4){0.f, 0.f, 0.f, 0.f};
        const f32x4 rs4 = *(const LAS f32x4*)(vb + 384 + 16 * w + 4 * fq);
#pragma unroll
        for (int ks = 0; ks < 4; ++ks) { bf16x8 sf[4];
#pragma unroll
            for (int j = 0; j < 4; ++j) sf[j] = lds_frag(SI, 16 * j + fr, 64 * ks + 16 * fq);
#pragma unroll
            for (int j = 0; j < 4; ++j) y1[j] = __builtin_amdgcn_mfma_f32_16x16x32_bf16(qf[ks], sf[j], y1[j], 0, 0, 0); }
#pragma unroll
        for (int j = 0; j < 4; ++j) y1[j] = y1[j] * rs4;
        __builtin_amdgcn_sched_barrier(0);
#pragma unroll 1
        for (int k2 = 0; 2 * k2 <= w; ++k2) {
            unsigned pw[4];
#pragma unroll
            for (int h = 0; h < 2; ++h) {
                const int si = 2 * k2 + h;
                f32x4 acc = (f32x4){0.f, 0.f, 0.f, 0.f};
#pragma unroll
                for (int ks = 0; ks < 4; ++ks) acc = __builtin_amdgcn_mfma_f32_16x16x32_bf16(lds_frag(KM, 16 * si + fr, 64 * ks + 16 * fq), qf[ks], acc, 0, 0, 0);
                const f32x4 e4 = *(const LAS f32x4*)(vb + 16 * si + 4 * fq); f32x4 x4 = (f32x4){qs, qs, qs, qs}; if (!ML) x4 = *(const LAS f32x4*)(vb + 256 + 16 * si + 4 * fq);
                float p[4];
#pragma unroll
                for (int r = 0; r < 4; ++r) { const float v = acc[r] * __expf(e4[r] - mlv) * x4[r]; const bool ok = (si < w) || (si == w && 4 * fq + r <= fr); p[r] = ok ? v : 0.f; }
                if (ML) dsum += (p[0] + p[1]) + (p[2] + p[3]);
                pw[2 * h] = cvt_pk_bf16_nop(p[0], p[1]); pw[2 * h + 1] = cvt_pk_bf16_nop(p[2], p[3]);
            }
            HWAIT();
            const v4u pwv = (v4u){pw[0], pw[1], pw[2], pw[3]}; const bf16x8 pf = __builtin_bit_cast(bf16x8, pwv);
#pragma unroll
            for (int j = 0; j < 4; ++j) { const int ho = j * 16 * MX_PITCH + ((k2 ^ (j >> 1)) << 6); const v2u lo = *(const LAS v2u*)(VT + vpb[j & 1][0] + ho), hi = *(const LAS v2u*)(VT + vpb[j & 1][1] + ho); const v4u vw = (v4u){lo.x, lo.y, hi.x, hi.y};
                y1[j] = __builtin_amdgcn_mfma_f32_16x16x32_bf16(pf, __builtin_bit_cast(bf16x8, vw), y1[j], 0, 0, 0); }
            HWAIT();
        }
        HSYNC();
        __builtin_amdgcn_sched_barrier(0);
        __builtin_amdgcn_sched_barrier(0);
        if (ML) {
            dsum += __shfl_xor(dsum, 16); dsum += __shfl_xor(dsum, 32);
            float d2 = 0.f;
#pragma unroll
            for (int ks = 0; ks < 4; ++ks) { float qv[8]; unpack8(__builtin_bit_cast(v4u, qf[ks]), qv); const f32x4 n0 = *(const LAS f32x4*)(nvec + 32 * ks + 8 * fq), n1 = *(const LAS f32x4*)(nvec + 32 * ks + 8 * fq + 4);
                d2 += qv[0] * n0.x + qv[1] * n0.y + qv[2] * n0.z + qv[3] * n0.w + qv[4] * n1.x + qv[5] * n1.y + qv[6] * n1.z + qv[7] * n1.w; }
            d2 += __shfl_xor(d2, 16); d2 += __shfl_xor(d2, 32);
            if (fq == 0) { exch[fr] = dsum; exch[16 + fr] = d2; }
        }
        HSYNC();
        __builtin_amdgcn_sched_barrier(0);
        LAS float* stg = (LAS float*)(QM + 16 * w * MX_PITCH);
        if (ML) { const f32x4 fl4 = *(const LAS f32x4*)(vb + 640 + 16 * w + 4 * fq); const f32x4 dA = *(const LAS f32x4*)(exch + 4 * fq), dB = *(const LAS f32x4*)(exch + 16 + 4 * fq);
#pragma unroll
            for (int r = 0; r < 4; ++r) { const float den = fmaxf(fabsf(dA[r] + rs4[r] * dB[r]), fl4[r]); const float inv = __builtin_amdgcn_rcpf(den);
#pragma unroll
                for (int j = 0; j < 4; ++j) stg[(4 * fq + r) * 68 + 16 * j + fr] = y1[j][r] * inv; }
        } else {
#pragma unroll
            for (int j = 0; j < 4; ++j) { const v2u xw = *(const LAS v2u*)(VT + mx_sw(16 * j + fr, 32 * w + 8 * fq)); const float xs[4] = {bflo(xw.x), bfhi(xw.x), bflo(xw.y), bfhi(xw.y)};
#pragma unroll
                for (int r = 0; r < 4; ++r) stg[(4 * fq + r) * 68 + 16 * j + fr] = y1[j][r] + c_D * xs[r]; }
        }
        {   const int erow = F.lane >> 2, ecs = F.lane & 3; const size_t trow = (size_t)(tok0 + 128 * c + 16 * w + erow);
            float yv[16];
#pragma unroll
            for (int i = 0; i < 4; ++i) { const f32x4 t4 = *(const LAS f32x4*)(stg + erow * 68 + 16 * ecs + 4 * i); yv[4 * i] = t4.x; yv[4 * i + 1] = t4.y; yv[4 * i + 2] = t4.z; yv[4 * i + 3] = t4.w; }
            float zf[16]; { float t8[8]; unpack8(zc0, t8);
#pragma unroll
                for (int i = 0; i < 8; ++i) zf[i] = t8[i]; unpack8(zc1, t8);
#pragma unroll
                for (int i = 0; i < 8; ++i) zf[8 + i] = t8[i]; }
            if (!ML) {
#pragma unroll
                for (int i = 0; i < 16; ++i) yv[i] = yv[i] * zf[i] * __builtin_amdgcn_rcpf(1.0f + __expf(-zf[i])); }
            float ss = 0.f;
#pragma unroll
            for (int i = 0; i < 16; ++i) ss += yv[i] * yv[i];
            ss += __shfl_xor(ss, 1); ss += __shfl_xor(ss, 2);
            if (ecs == 0) SSQ[(ML ? (size_t)TT * 32 : 0) + trow * 32 + (ML ? mh * 4 + vq : hd)] = ss;
#pragma unroll
            for (int i = 0; i < 4; ++i) { const f32x4 w4 = *(const LAS f32x4*)(nwl + 16 * ecs + 4 * i);
                yv[4 * i] *= w4.x; yv[4 * i + 1] *= w4.y; yv[4 * i + 2] *= w4.z; yv[4 * i + 3] *= w4.w; }
            if (ML) {
#pragma unroll
                for (int i = 0; i < 16; ++i) yv[i] *= __builtin_amdgcn_rcpf(1.0f + __expf(-zf[i])); }
            bf16* yp = YMIX + trow * 4096 + (ML ? 2048 + mh * 256 + vq * 64 : hd * 64) + 16 * ecs;
            *(v4u*)yp = (v4u){pg8::cvt_pk_bf16(yv[0], yv[1]), pg8::cvt_pk_bf16(yv[2], yv[3]), pg8::cvt_pk_bf16(yv[4], yv[5]), pg8::cvt_pk_bf16(yv[6], yv[7])};
            *(v4u*)(yp + 8) = (v4u){pg8::cvt_pk_bf16(yv[8], yv[9]), pg8::cvt_pk_bf16(yv[10], yv[11]), pg8::cvt_pk_bf16(yv[12], yv[13]), pg8::cvt_pk_bf16(yv[14], yv[15])};
            if (more) { const bf16* zp = PROJ + (size_t)(tok0 + 128 * (c + 1) + 16 * w + (F.lane >> 2)) * NPROJ + gcol; zc0 = *(const v4u*)zp; zc1 = *(const v4u*)(zp + 8); }
        }
        __builtin_amdgcn_sched_barrier(0);
        const float sa = scal[2 * (c & 1)];
#pragma unroll
        for (int j = 0; j < 4; ++j) sacc[j] = sacc[j] * sa;
        float nsum = 0.f;
#pragma unroll
        for (int ks = 0; ks < 4; ++ks) { const bf16x8 kf = *(const LAS bf16x8*)(KW + kwb + ((ks ^ kwh) << 6)); bf16x8 vf[4];
#pragma unroll
            for (int j = 0; j < 4; ++j) vf[j] = *(const LAS bf16x8*)(VT + vtb[j & 1] + j * 16 * MX_PITCH + ((ks ^ (j >> 1)) << 6));
            if (ML) { float kv[8]; unpack8(__builtin_bit_cast(v4u, kf), kv); nsum += ((kv[0] + kv[1]) + (kv[2] + kv[3])) + ((kv[4] + kv[5]) + (kv[6] + kv[7])); }
#pragma unroll
            for (int j = 0; j < 4; ++j) sacc[j] = __builtin_amdgcn_mfma_f32_16x16x32_bf16(kf, vf[j], sacc[j], 0, 0, 0); }
        if (ML) { nsum += __shfl_xor(nsum, 16); nsum += __shfl_xor(nsum, 32); nreg = nreg * sa + nsum; }
        if (more) { MX_SCAN_A(c + 1); }
        __syncthreads();
        if (more) { MX_SCAN_B(c + 1); }
        __syncthreads();
        if (more) { MX_WRITE(c + 1); }
        __syncthreads();
    }
#undef MX_SCAN_A
#undef MX_SCAN_L
#undef MX_SOFTPLUS
#undef MX_LOGSIG
#undef MX_SCAN_B
#undef MX_PREFETCH
#undef MX_WRITE
}
__device__ __forceinline__ void phase_mixer(Frame& F) {
    int role, idx, nrole;
    if ((F.G & 15) == 0) { role = (F.bid >> 3) & 1; idx = (F.bid >> 4) * 8 + (F.bid & 7); nrole = F.G >> 1; }
    else { role = F.bid & 1; idx = F.bid >> 1; nrole = role ? (F.G >> 1) : ((F.G + 1) >> 1); }
    int first = idx;
    if (role == 0) { for (int unit = idx; unit < 256; unit += nrole) { mixer_unit<false>(F, unit); mixer_unit<true>(F, unit); } first = -1; __syncthreads(); }
    p0_moe_weights_coop(F, first, F.G >> 1);
}

__device__ __forceinline__ void phase3(Frame& F) {
    const bf16* PROJ = (const bf16*)(F.ws + WS_PROJ); bf16* YMIX = (bf16*)(F.ws + WS_YMIX); const float* SSQ = (const float*)(F.ws + WS_SSQ);
    const int gw = F.bid * NWAVES + F.wave, NGW = F.G * NWAVES;
    for (int t = gw; t < TT; t += NGW) {
        bf16* yrow = YMIX + (size_t)t * 4096;
#pragma unroll
        for (int j = 0; j < 8; ++j) {
            const int c0 = (j * 64 + F.lane) * 8;
            float y[8]; unpack8(*(const v4u*)(yrow + c0), y);
            float o[8];
            if (j < 4) {
                const int g = c0 >> 9; const f32x4 s0 = *(const f32x4*)(SSQ + (size_t)t * 32 + g * 8), s1 = *(const f32x4*)(SSQ + (size_t)t * 32 + g * 8 + 4);
                const float ms = ((s0.x + s0.y) + (s0.z + s0.w) + (s1.x + s1.y) + (s1.z + s1.w)) * (1.0f / 512.0f);
                const float rs = 1.0f / sqrtf(ms + EPSF);
                const f32x4 w0 = *(const f32x4*)(F.ssd_norm_w + c0), w1 = *(const f32x4*)(F.ssd_norm_w + c0 + 4);
                o[0] = y[0] * rs * w0.x; o[1] = y[1] * rs * w0.y; o[2] = y[2] * rs * w0.z; o[3] = y[3] * rs * w0.w;
                o[4] = y[4] * rs * w1.x; o[5] = y[5] * rs * w1.y; o[6] = y[6] * rs * w1.z; o[7] = y[7] * rs * w1.w;
            } else {
                const int cc = c0 - 2048, h = cc >> 8; const f32x4 s0 = *(const f32x4*)(SSQ + (size_t)TT * 32 + (size_t)t * 32 + h * 4);
                const float ms = ((s0.x + s0.y) + (s0.z + s0.w)) * (1.0f / 256.0f);
                const float rs = 1.0f / sqrtf(ms + EPSF);
                const f32x4 w0 = *(const f32x4*)(F.ml_norm_w + cc), w1 = *(const f32x4*)(F.ml_norm_w + cc + 4);
                float og[8]; unpack8(*(const v4u*)(PROJ + (size_t)t * NPROJ + PC_O + cc), og);
                const float wv[8] = {w0.x, w0.y, w0.z, w0.w, w1.x, w1.y, w1.z, w1.w};
#pragma unroll
                for (int i = 0; i < 8; ++i) o[i] = y[i] * rs * wv[i] * __builtin_amdgcn_rcpf(1.0f + __expf(-og[i]));
            }
            v4u ov; ov.x = pk2(o[0], o[1]); ov.y = pk2(o[2], o[3]); ov.z = pk2(o[4], o[5]); ov.w = pk2(o[6], o[7]);
            *(v4u*)(yrow + c0) = ov;
        }
    }
}

__device__ __forceinline__ void phase5(Frame& F) {
    const bf16* H2 = (const bf16*)(F.ws + WS_H2); const bf16* WrtT = (const bf16*)(F.ws + WS_WRT); bf16* XN2 = (bf16*)(F.ws + WS_XN2);
    int* EIDX = (int*)(F.ws + WS_ROUTE); int* RANK = EIDX + TT * 4;
    int* TOKL = (int*)(F.ws + WS_XG); float* GATEL = (float*)(F.ws + WS_XG + 4 * MiB);
    constexpr int RP = 528;
    LAS unsigned char* xA = F.lds + F.wave * (8 * RP);
    LAS unsigned char* wl0 = F.lds + 40960;
    LAS float* lg = (LAS float*)(F.lds + 110592 + F.wave * 1024);
    LAS int* cntl = (LAS int*)(F.lds + 118784); LAS int* baseg = cntl + 32;
    const int gw = F.bid * NWAVES + F.wave, NGW = F.G * NWAVES, ntask = TT / 8, iters = (ntask + NGW - 1) / NGW;
    const int fr = F.lane & 15, fq = F.lane >> 4;
    const int wrow = F.tid >> 3, wpc = F.tid & 7;
    const int xrow = F.lane >> 5, xpc = F.lane & 31;
    for (int itx = 0; itx < iters; ++itx) {
        const int task = itx * NGW + gw; const bool valid = task < ntask; const int t0 = valid ? task * 8 : 0;
        if (F.tid < 32) cntl[F.tid] = 0;
        float rstd[8]; int me[4] = {0, 0, 0, 0}, mr[4] = {0, 0, 0, 0}; float mg[4] = {0.f, 0.f, 0.f, 0.f};
        f32x4 acc[4];
#pragma unroll
        for (int n = 0; n < 4; ++n) acc[n] = (f32x4){0.f, 0.f, 0.f, 0.f};
        float ssl[4] = {0.f, 0.f, 0.f, 0.f};
        v4u wreg[4], xreg[4];
#pragma unroll
        for (int q = 0; q < 4; ++q) { wreg[q] = *(const v4u*)(WrtT + (size_t)wrow * DM + 8 * (wpc + 8 * q)); xreg[q] = *(const v4u*)(H2 + (size_t)(t0 + xrow + 2 * q) * DM + 8 * xpc); }
        for (int dc = 0; dc < 8; ++dc) {
            LAS unsigned char* wl = wl0 + (dc & 1) * (64 * RP);
#pragma unroll
            for (int q = 0; q < 4; ++q) { *(LAS v4u*)(wl + wrow * RP + 16 * (wpc + 8 * q)) = wreg[q]; *(LAS v4u*)(xA + (xrow + 2 * q) * RP + 16 * xpc) = xreg[q];
                float f[8]; unpack8(xreg[q], f); ssl[q] += ((f[0] * f[0] + f[1] * f[1]) + (f[2] * f[2] + f[3] * f[3])) + ((f[4] * f[4] + f[5] * f[5]) + (f[6] * f[6] + f[7] * f[7])); }
            if (dc < 7) {
#pragma unroll
                for (int q = 0; q < 4; ++q) { wreg[q] = *(const v4u*)(WrtT + (size_t)wrow * DM + (dc + 1) * 256 + 8 * (wpc + 8 * q)); xreg[q] = *(const v4u*)(H2 + (size_t)(t0 + xrow + 2 * q) * DM + (dc + 1) * 256 + 8 * xpc); } }
            __syncthreads();
#pragma unroll
            for (int ks = 0; ks < 8; ++ks) { const bf16x8 a = *(const LAS bf16x8*)(xA + (fr & 7) * RP + 64 * ks + 16 * fq);
#pragma unroll
                for (int n = 0; n < 4; ++n) { const bf16x8 bb = *(const LAS bf16x8*)(wl + (16 * n + fr) * RP + 64 * ks + 16 * fq); acc[n] = __builtin_amdgcn_mfma_f32_16x16x32_bf16(a, bb, acc[n], 0, 0, 0); } }
        }
#pragma unroll
        for (int q = 0; q < 4; ++q) { float v = ssl[q]; v += __shfl_xor(v, 1); v += __shfl_xor(v, 2); v += __shfl_xor(v, 4); v += __shfl_xor(v, 8); v += __shfl_xor(v, 16); ssl[q] = v; }
#pragma unroll
        for (int k = 0; k < 8; ++k) { const float v = __shfl(ssl[k >> 1], 32 * (k & 1)); rstd[k] = 1.0f / sqrtf(v * (1.0f / 2048.0f) + EPSF); }
        if (valid) {
            if (fq < 2) {
#pragma unroll
                for (int n = 0; n < 2; ++n) { const float rb = F.router_b[16 * n + fr];
#pragma unroll
                    for (int r = 0; r < 4; ++r) { const float rs = fq == 0 ? rstd[r] : rstd[4 + r]; lg[(4 * fq + r) * 32 + 16 * n + fr] = (acc[n][r] + acc[n + 2][r]) * rs + rb; } }
            }
            LDS_WAIT(); asm volatile("" ::: "memory");
            if (F.lane < 8) {
                const LAS float* lp = lg + F.lane * 32; float bv[4]; int bi[4] = {-1, -1, -1, -1};
#pragma unroll
                for (int p = 0; p < 4; ++p) { float best = -3.0e38f; int bidx = 0;
                    for (int q = 0; q < 32; ++q) { const float v = lp[q]; const bool taken = (q == bi[0]) | (q == bi[1]) | (q == bi[2]) | (q == bi[3]); if (!taken && v > best) { best = v; bidx = q; } }
                    bv[p] = best; bi[p] = bidx; }
                const float p1 = expf(bv[1] - bv[0]), p2 = expf(bv[2] - bv[0]), p3 = expf(bv[3] - bv[0]); const float inv = 1.0f / (1.0f + p1 + p2 + p3);
                mg[0] = inv; mg[1] = p1 * inv; mg[2] = p2 * inv; mg[3] = p3 * inv;
#pragma unroll
                for (int p = 0; p < 4; ++p) { me[p] = bi[p]; mr[p] = __hip_atomic_fetch_add(cntl + bi[p], 1, __ATOMIC_RELAXED, __HIP_MEMORY_SCOPE_WORKGROUP); }
            }
        }
        __syncthreads();
        if (F.tid < 32) { const int c = cntl[F.tid]; int gb = 0; if (c > 0) gb = (int)__hip_atomic_fetch_add((unsigned*)(F.ctl + CW_CNT + 64 * F.tid), (unsigned)c, RLX_AGENT); baseg[F.tid] = gb; }
        __syncthreads();
        if (valid) {
            if (F.lane < 8) { const size_t t = (size_t)(t0 + F.lane);
#pragma unroll
                for (int p = 0; p < 4; ++p) { const int rk = baseg[me[p]] + mr[p]; EIDX[t * 4 + p] = me[p]; RANK[t * 4 + p] = rk; TOKL[(size_t)me[p] * TT + rk] = (int)t; GATEL[(size_t)me[p] * TT + rk] = mg[p]; } }
#pragma unroll
            for (int k = 0; k < 8; ++k) { const v2u* xr = (const v2u*)(H2 + (size_t)(t0 + k) * DM) + F.lane; const f32x4* wr = (const f32x4*)F.norm2_w + F.lane; int* o4 = (int*)((unsigned char*)XN2 + (size_t)(t0 + k) * DM) + F.lane;
#pragma unroll
                for (int j = 0; j < 8; ++j) { const v2u q_ = xr[64 * j]; const f32x4 v = (f32x4){bflo(q_.x), bfhi(q_.x), bflo(q_.y), bfhi(q_.y)}, ww = wr[64 * j]; int o = __builtin_amdgcn_cvt_pk_fp8_f32(v.x * rstd[k] * ww.x, v.y * rstd[k] * ww.y, 0, false); o = __builtin_amdgcn_cvt_pk_fp8_f32(v.z * rstd[k] * ww.z, v.w * rstd[k] * ww.w, o, true); o4[64 * j] = o; } }
        }
        __syncthreads();
    }
}
__device__ __forceinline__ int build_moe_tab(Frame& F) {
    LAS unsigned char* tab = (LAS unsigned char*)(F.lds + TAB_OFF); LAS int* tinfo = (LAS int*)(F.lds + TAB_OFF + 320);
    if (F.tid < 64) {
        const int e = F.lane & 31; const int c = (int)__hip_atomic_load((unsigned*)(F.ctl + CW_CNT + 64 * e), RLX_AGENT); const int n = (c + 255) >> 8;
        int incl = n;
#pragma unroll
        for (int d = 1; d < 32; d <<= 1) { const int t_ = __shfl_up(incl, d); if (e >= d) incl += t_; }
        const int first = incl - n;
        if (F.lane < 32) { tinfo[4 + e] = n; tinfo[72 + e] = c; tinfo[40 + e] = first; for (int j = 0; j < n; ++j) tab[first + j] = (unsigned char)e; if (e == 31) tinfo[0] = incl; }
    }
    __syncthreads();
    return tinfo[0];
}
__device__ __forceinline__ void phase8(Frame& F) {
    const bf16* H2 = (const bf16*)(F.ws + WS_H2); const bf16* YR = (const bf16*)(F.ws + WS_YR);
    const int* EIDX = (const int*)(F.ws + WS_ROUTE); const int* RANK = EIDX + TT * 4; (void)build_moe_tab(F); const LAS int* tinfo = (const LAS int*)(F.lds + TAB_OFF + 320);
    const int gw = F.bid * NWAVES + F.wave, NGW = F.G * NWAVES;
    for (int t = gw; t < TT; t += NGW) {
        int slot = 0; if (F.lane < 4) slot = 256 * tinfo[40 + EIDX[(size_t)t * 4 + F.lane]] + RANK[(size_t)t * 4 + F.lane];
        int sl[4]; sl[0] = __shfl(slot, 0); sl[1] = __shfl(slot, 1); sl[2] = __shfl(slot, 2); sl[3] = __shfl(slot, 3);
        float v[4][8]; float ss = 0.f;
#pragma unroll
        for (int j = 0; j < 4; ++j) { const int pz = F.lane + 64 * j; unpack8(*(const v4u*)(H2 + (size_t)t * DM + 8 * pz), v[j]); }
#pragma unroll
        for (int k = 0; k < 4; ++k)
#pragma unroll
            for (int j = 0; j < 4; ++j) { const v2u q = *((const v2u*)((const unsigned char*)YR + (size_t)sl[k] * DM) + F.lane + 64 * j);
                const f32x2 a0 = __builtin_amdgcn_cvt_pk_f32_fp8((int)q.x, false), a1 = __builtin_amdgcn_cvt_pk_f32_fp8((int)q.x, true), a2 = __builtin_amdgcn_cvt_pk_f32_fp8((int)q.y, false), a3 = __builtin_amdgcn_cvt_pk_f32_fp8((int)q.y, true);
                v[j][0] += a0.x * 0.0625f; v[j][1] += a0.y * 0.0625f; v[j][2] += a1.x * 0.0625f; v[j][3] += a1.y * 0.0625f; v[j][4] += a2.x * 0.0625f; v[j][5] += a2.y * 0.0625f; v[j][6] += a3.x * 0.0625f; v[j][7] += a3.y * 0.0625f; }
#pragma unroll
        for (int j = 0; j < 4; ++j)
#pragma unroll
            for (int i = 0; i < 8; ++i) ss += v[j][i] * v[j][i];
        const float rstd = 1.0f / sqrtf(wave_sum(ss) * (1.0f / 2048.0f) + EPSF);
#pragma unroll
        for (int j = 0; j < 4; ++j) { const int pz = F.lane + 64 * j; const f32x4 w0 = *(const f32x4*)(F.final_norm_w + 8 * pz), w1 = *(const f32x4*)(F.final_norm_w + 8 * pz + 4);
            *(f32x4*)(F.out + (size_t)t * DM + 8 * pz) = (f32x4){v[j][0] * rstd * w0.x, v[j][1] * rstd * w0.y, v[j][2] * rstd * w0.z, v[j][3] * rstd * w0.w};
            *(f32x4*)(F.out + (size_t)t * DM + 8 * pz + 4) = (f32x4){v[j][4] * rstd * w1.x, v[j][5] * rstd * w1.y, v[j][6] * rstd * w1.z, v[j][7] * rstd * w1.w}; }
    }
}

struct Args { const float* in[21]; float* out; unsigned char* ws; int ph_lo, ph_hi, li, pad; };
__global__ void __launch_bounds__(NWAVES * 64, 2) hymba_fwd(Args args) {
    extern __shared__ __attribute__((aligned(16))) unsigned char lds[];
    Frame F;
    F.lds = (LAS unsigned char*)lds; F.MISC = (volatile LAS unsigned*)(F.lds + MISC_OFF);
    F.tid = threadIdx.x; F.lane = F.tid & 63; F.wave = __builtin_amdgcn_readfirstlane(F.tid >> 6); F.G = gridDim.x; F.bid = blockIdx.x;
    F.ws = args.ws; F.ctl = (gu32*)(args.ws + WS_CTL); F.out = args.out;
    F.x = args.in[0]; F.norm1_w = args.in[1]; F.w_in = args.in[2]; F.conv_w = args.in[3]; F.conv_b = args.in[4]; F.dt_bias = args.in[5]; F.a_log = args.in[6]; F.d_skip = args.in[7]; F.ssd_norm_w = args.in[8];
    F.i_bias = args.in[9]; F.f_bias = args.in[10]; F.ml_norm_w = args.in[11]; F.w_out = args.in[12]; F.norm2_w = args.in[13]; F.router_w = args.in[14]; F.router_b = args.in[15];
    F.w_gate_up = args.in[16]; F.b_gate_up = args.in[17]; F.w_down = args.in[18]; F.b_down = args.in[19]; F.final_norm_w = args.in[20];
    for (int u = F.tid; u < (LDS_BYTES - LDSCTL_OFF) / 4; u += NWAVES * 64) ((LAS unsigned*)(F.lds + LDSCTL_OFF))[u] = 0u;
    __syncthreads();
    XcdBarrier bar; bar.bar = (unsigned*)(F.ctl + CW_BAR) + args.li * XCD_BAR_WORDS; bar.x = 0; bar.st = nullptr;
    const bool use_bar = (args.ph_hi - args.ph_lo) > 1;
    if (use_bar) bar = xcd_barrier_post((unsigned*)(F.ctl + CW_BAR) + args.li * XCD_BAR_WORDS, F.MISC + 8);
    const int lo = args.ph_lo, hi = args.ph_hi;
#ifndef PHASE_MASK
#define PHASE_MASK 0x1ff
#endif
#define IN(k) (((PHASE_MASK >> (k)) & 1) && lo <= (k) && (k) < hi)
#define SEAM(k) do { if (IN(k) && IN((k) + 1)) xcd_barrier(bar); } while (0)
    if (IN(0)) { phase0(F); } SEAM(0);
    if (IN(1)) {
        pg8::Gemm g{(const pg8::bf16_t*)(F.ws + WS_XN1), (const pg8::bf16_t*)(F.ws + WS_WIN), TT, NPROJ, DM}; pg8::StaticOrder S; S.init(TT, NPROJ, F.G, F.bid);
        pg8::EpiBf16 E{(pg8::bf16_t*)(F.ws + WS_PROJ), NPROJ};
        pg8::gemm_phase<pg8::EpiBf16, pg8::StaticOrder, true, true>(F.lds, g, S, E);
        p1_small(F);
    } SEAM(1);
    if (IN(2)) { phase_conv(F); } SEAM(2);
    if (IN(3)) { phase_mixer(F); } SEAM(3);
    if (IN(4)) {
        pg8::Gemm g{(const pg8::bf16_t*)(F.ws + WS_YMIX), (const pg8::bf16_t*)(F.ws + WS_WOUT), TT, DM, 4096}; pg8::StaticOrder S; S.init(TT, DM, F.G, F.bid);
        pg8::EpiResNorm E{(pg8::bf16_t*)(F.ws + WS_H2), F.x, DM, (const float*)(F.ws + WS_SSQ), (PG8_LAS float*)(F.lds + RING_BYTES), EPSF};
        pg8::gemm_phase<pg8::EpiResNorm, pg8::StaticOrder, true, true>(F.lds, g, S, E);
    } SEAM(4);
    if (IN(5)) { phase5(F); } SEAM(5);
    if (IN(6)) {
        const int nM = build_moe_tab(F);
        const LAS int* tinfo = (const LAS int*)(F.lds + TAB_OFF + 320); LAS unsigned short* rt = (LAS unsigned short*)(F.lds + ROWTAB_OFF);
        pg8::Gemm g{(const pg8::bf16_t*)(F.ws + WS_XN2), (const pg8::bf16_t*)(F.ws + WS_WGU), nM * 256, 4096, DM};
        pg8::MoeOrder S{nM, 16, 4, nM * 16, F.G, F.bid, (const PG8_LAS unsigned char*)(F.lds + TAB_OFF), (const PG8_LAS unsigned short*)rt};
        { const int* TOKL = (const int*)(F.ws + WS_XG); const int hsel = F.tid >> 8, r256 = F.tid & 255;
          int tk[9];
#pragma unroll
          for (int ii = 0; ii < 9; ++ii) { pg8::Unit u; tk[ii] = -1; if (S.next(2 * ii + hsel, u)) { const int e = u.pn >> 4, rank = (u.pm - tinfo[40 + e]) * 256 + r256; tk[ii] = rank < tinfo[72 + e] ? TOKL[(size_t)e * TT + rank] : 0; } }
#pragma unroll
          for (int ii = 0; ii < 9; ++ii) if (tk[ii] >= 0) rt[(2 * ii + hsel) * 256 + r256] = (unsigned short)tk[ii];
          __syncthreads(); }
        pg8::EpiSwiglu E{(unsigned char*)(F.ws + WS_ACT), F.b_gate_up, (PG8_LAS float*)(F.lds + EPIV_OFF)};
        pg8::gemm_phase<pg8::EpiSwiglu, pg8::MoeOrder, true, true, true, true>(F.lds, g, S, E);
    } SEAM(6);
    if (IN(7)) {
        const int nM = build_moe_tab(F);
        pg8::Gemm g{(const pg8::bf16_t*)(F.ws + WS_ACT), (const pg8::bf16_t*)(F.ws + WS_WD), nM * 256, 2048, DM};
        pg8::MoeOrder S{nM, 8, 3, nM * 8, F.G, F.bid, (const PG8_LAS unsigned char*)(F.lds + TAB_OFF), nullptr};
        pg8::EpiDown E{(pg8::bf16_t*)(F.ws + WS_YR), F.b_down, (const float*)(F.ws + WS_XG + 4 * MiB), (const PG8_LAS int*)(F.lds + TAB_OFF + 320), (PG8_LAS float*)(F.lds + EPIV_OFF)};
        pg8::gemm_phase<pg8::EpiDown, pg8::MoeOrder, true, true, true>(F.lds, g, S, E);
    } SEAM(7);
    if (IN(8)) { phase8(F); }
#undef IN
#undef SEAM
}

extern "C" void kernel_launch(void* const* d_in, const int* in_sizes, int n_in, void* d_out, int out_size, void* d_ws, size_t ws_size, hipStream_t stream) {
    static int grid = 0;
    if (grid == 0) {
        if (n_in != 21 || out_size != TT * DM || ws_size < WS_END) { fprintf(stderr, "kernel_launch: unexpected problem (n_in %d, out %d, ws %zu); nothing launched\n", n_in, out_size, ws_size); grid = -1; return; }
        int dev = 0, cus = 0, per_cu = 0;
        if (hipGetDevice(&dev) != hipSuccess || hipDeviceGetAttribute(&cus, hipDeviceAttributeMultiprocessorCount, dev) != hipSuccess) { grid = -1; return; }
        if (hipFuncSetAttribute((const void*)hymba_fwd, hipFuncAttributeMaxDynamicSharedMemorySize, LDS_BYTES) != hipSuccess) { fprintf(stderr, "kernel_launch: hipFuncSetAttribute failed\n"); grid = -1; return; }
        if (hipOccupancyMaxActiveBlocksPerMultiprocessor(&per_cu, (const void*)hymba_fwd, NWAVES * 64, LDS_BYTES) != hipSuccess || per_cu < 1) { fprintf(stderr, "kernel_launch: occupancy query says %d blocks per CU\n", per_cu); }
        (void)hipGetLastError();
        grid = cus;
    }
    if (grid < 0) return;
    (void)hipMemsetAsync((char*)d_ws + WS_CTL, 0, CTL_ZERO_BYTES, stream);
    Args a{};
    for (int i = 0; i < 21; ++i) a.in[i] = (const float*)d_in[i];
    a.out = (float*)d_out; a.ws = (unsigned char*)d_ws; a.pad = 0;
#if MK_PER_PHASE
    for (int li = 0; li < N_PHASES; ++li) { a.ph_lo = li; a.ph_hi = li + 1; a.li = li; hipLaunchKernelGGL(hymba_fwd, dim3(grid), dim3(NWAVES * 64), LDS_BYTES, stream, a); }
#else
    a.ph_lo = 0; a.ph_hi = N_PHASES; a.li = 0;
    hipLaunchKernelGGL(hymba_fwd, dim3(grid), dim3(NWAVES * 64), LDS_BYTES, stream, a);
#endif
}
```

```cpp
#include <hip/hip_runtime.h>
#include <cstdio>
#include <cstdint>
namespace pg8 {
#define PG8_LAS __attribute__((address_space(3)))
typedef unsigned short bf16_t;
typedef short bf16x8 __attribute__((ext_vector_type(8)));
typedef float f32x4 __attribute__((ext_vector_type(4)));
typedef unsigned u32x4 __attribute__((ext_vector_type(4)));
constexpr int BM = 256, BK = 64, HALF = 128, HTB = HALF * BK * 2  , STAGE_BYTES = 8 * HTB, NXCD = 8, WGM = 4;

__host__ __device__ __forceinline__ int lds_byte(int r, int c) { const int st = (r >> 4) * 2 + (c >> 5), rr = r & 15, cc = c & 31, ob = rr * 64 + cc * 2; return st * 1024 + (ob ^ (((ob >> 9) & 1) << 5)); }
__host__ __device__ __forceinline__ void stage_rc(int b, int& R, int& C) { const int st = b / 1024, sb = b % 1024, swz = sb ^ (((sb >> 9) & 1) << 5); R = (st >> 1) * 16 + swz / 64; C = (st & 1) * 32 + (swz % 64) / 2; }
__host__ __device__ __forceinline__ int perm32(int rho) { const int n = rho >> 4, i = rho & 15; return 8 * (i >> 2) + 4 * n + (i & 3); }

struct Unit { int pm, pn, par; };
struct Gemm { const bf16_t* A; const bf16_t* Bt; int M, N, K; };

struct StaticOrder {
    int nM, nN, nwg, G, c;
    __host__ __device__ void init(int M, int N, int G_, int c_) { nM = M / BM; nN = N / BM; nwg = nM * nN; G = G_; c = c_; }
    __host__ __device__ bool next(int i, Unit& u) const {
        const long L = (long)i * G + c; if (L >= nwg) return false;
        int wgid = (int)L; { const int q = nwg / NXCD, r = nwg % NXCD, xcd = wgid % NXCD, off = wgid / NXCD; wgid = (xcd < r ? xcd * (q + 1) : r * (q + 1) + (xcd - r) * q) + off; }
        const int nig = WGM * nN, gid = wgid / nig, fm = gid * WGM, gsz = (nM - fm) < WGM ? (nM - fm) : WGM;
        u.pm = fm + ((wgid % nig) % gsz); u.pn = (wgid % nig) / gsz; return true;
    }
    __device__ __forceinline__ const PG8_LAS unsigned short* rowp(int) const { return nullptr; }
    __device__ __forceinline__ void a_ready(const Unit&) const {}
    __device__ __forceinline__ void done(const Unit&) const {}
};


__device__ __forceinline__ unsigned cvt_pk_bf16(float lo, float hi) { unsigned r; asm volatile("v_cvt_pk_bf16_f32 %0, %1, %2" : "=v"(r) : "v"(lo), "v"(hi)); return r; }
typedef unsigned u32x2 __attribute__((ext_vector_type(2)));

struct EpiBf16 {
    static constexpr bool PERM = true, AFTER_DRAIN = false;
    bf16_t* O; int ldc;
    __device__ __forceinline__ void operator()(const f32x4 (&acc)[2][2][4][2], const Unit& u, int wr, int wc, int fr, int fq) const {
        const int row0 = u.pm * BM + wr * 64 + fr; const int col0 = u.pn * BM + wc * 32 + 8 * fq;
#pragma unroll
        for (int ai = 0; ai < 2; ++ai)
#pragma unroll
            for (int m = 0; m < 4; ++m) { bf16_t* rowp = O + (size_t)(row0 + ai * HALF + m * 16) * ldc + col0;
#pragma unroll
                for (int bj = 0; bj < 2; ++bj) { const f32x4 v0 = acc[ai][bj][m][0], v1 = acc[ai][bj][m][1];
                    u32x4 w; w.x = cvt_pk_bf16(v0[0], v0[1]); w.y = cvt_pk_bf16(v0[2], v0[3]); w.z = cvt_pk_bf16(v1[0], v1[1]); w.w = cvt_pk_bf16(v1[2], v1[3]);
                    *(u32x4*)(rowp + bj * HALF) = w; } }
    }
};
struct EpiResNorm {
    static constexpr bool PERM = true, AFTER_DRAIN = false, KSCALE = true;
    bf16_t* C; const float* base; int ldc; const float* ssq; PG8_LAS float* tabl; float eps;
    __device__ __forceinline__ void build(const Unit& u, int tid) const {
        const int row = tid & 255, part = tid >> 8; const size_t t = (size_t)u.pm * BM + row; float rs[7];
        if (part == 0) { const f32x4* p = (const f32x4*)(ssq + t * 32);
#pragma unroll
            for (int g = 0; g < 4; ++g) { const f32x4 a = p[2 * g], b = p[2 * g + 1]; rs[g] = 1.0f / sqrtf(((a.x + a.y) + (a.z + a.w) + (b.x + b.y) + (b.z + b.w)) * (1.0f / 512.0f) + eps); }
            const f32x4* q = (const f32x4*)(ssq + (size_t)16384 * 32 + t * 32);
#pragma unroll
            for (int h = 0; h < 3; ++h) { const f32x4 a = q[h]; rs[4 + h] = 1.0f / sqrtf(((a.x + a.y) + (a.z + a.w)) * (1.0f / 256.0f) + eps); }
        } else { const f32x4* q = (const f32x4*)(ssq + (size_t)16384 * 32 + t * 32);
#pragma unroll
            for (int h = 0; h < 6; ++h) { const f32x4 a = q[2 + h]; rs[h] = 1.0f / sqrtf(((a.x + a.y) + (a.z + a.w)) * (1.0f / 256.0f) + eps); }
            rs[6] = 1.0f; }
        PG8_LAS float* d = tabl + row * 12 + 6 * part;
#pragma unroll
        for (int s = 0; s < 6; ++s) d[s] = (part == 1 && s == 5) ? rs[5] : rs[s] / rs[s + 1];
    }
    __device__ __forceinline__ void kscale(f32x4 (&acc)[2][2][4][2], int t, int nt, int wr, int fr) const {
        const int kt = t + 1; const bool segend = kt < 32 ? ((kt & 7) == 7) : ((kt & 3) == 3);
        if (segend && kt != nt - 1) { const int sg = kt < 32 ? (kt >> 3) : 4 + ((kt - 32) >> 2);
#pragma unroll
            for (int ai = 0; ai < 2; ++ai)
#pragma unroll
                for (int m = 0; m < 4; ++m) { const float r = tabl[(ai * HALF + wr * 64 + m * 16 + fr) * 12 + sg];
#pragma unroll
                    for (int bj = 0; bj < 2; ++bj)
#pragma unroll
                        for (int n = 0; n < 2; ++n) acc[ai][bj][m][n] = acc[ai][bj][m][n] * r; } }
    }
    __device__ __forceinline__ void operator()(const f32x4 (&acc)[2][2][4][2], const Unit& u, int wr, int wc, int fr, int fq) const {
        const int row0 = u.pm * BM + wr * 64 + fr, col0 = u.pn * BM + wc * 32 + 8 * fq;
#pragma unroll
        for (int ai = 0; ai < 2; ++ai)
#pragma unroll
            for (int m = 0; m < 4; ++m) { const size_t off = (size_t)(row0 + ai * HALF + m * 16) * ldc + col0; const float r = tabl[(ai * HALF + wr * 64 + m * 16 + fr) * 12 + 11];
#pragma unroll
                for (int bj = 0; bj < 2; ++bj) { const f32x4 v0 = acc[ai][bj][m][0] * r + *(const f32x4*)(base + off + bj * HALF), v1 = acc[ai][bj][m][1] * r + *(const f32x4*)(base + off + bj * HALF + 4);
                    u32x4 w; w.x = cvt_pk_bf16(v0[0], v0[1]); w.y = cvt_pk_bf16(v0[2], v0[3]); w.z = cvt_pk_bf16(v1[0], v1[1]); w.w = cvt_pk_bf16(v1[2], v1[3]);
                    *(u32x4*)(C + off + bj * HALF) = w; } }
    }
};
struct EpiResF32 {
    static constexpr bool PERM = false, AFTER_DRAIN = false;
    float* C; const float* base; int ldc;
    __device__ __forceinline__ void operator()(const f32x4 (&acc)[2][2][4][2], const Unit& u, int wr, int wc, int fr, int fq) const {
        const int row0 = u.pm * BM + wr * 64 + fr, col0 = u.pn * BM + wc * 32 + 4 * fq;
#pragma unroll
        for (int ai = 0; ai < 2; ++ai)
#pragma unroll
            for (int m = 0; m < 4; ++m) { const size_t off = (size_t)(row0 + ai * HALF + m * 16) * ldc + col0;
#pragma unroll
                for (int bj = 0; bj < 2; ++bj)
#pragma unroll
                    for (int n = 0; n < 2; ++n) *(f32x4*)(C + off + bj * HALF + n * 16) = acc[ai][bj][m][n] + *(const f32x4*)(base + off + bj * HALF + n * 16); }
    }
};
__device__ __forceinline__ float swiglu1(float a, float b) {
    const float glu = fminf(a, 7.0f), lin = fminf(fmaxf(b, -7.0f), 7.0f);
    return glu * __builtin_amdgcn_rcpf(1.0f + __expf(-1.702f * glu)) * (lin + 1.0f);
}
struct EpiSwiglu {
    static constexpr bool PERM = true, AFTER_DRAIN = false, PREFETCH = true, BMAP = true;
    unsigned char* O; const float* bias; PG8_LAS float* slot;
    __device__ __forceinline__ void prefetch(const Unit& u, int wid, int lane) const {
        if (wid == 0) { const int e = u.pn >> 4, pnl = u.pn & 15;
            __builtin_amdgcn_global_load_lds((const unsigned*)(bias + (size_t)e * 4096 + pnl * BM + 4 * lane), (PG8_LAS unsigned*)(slot + u.par * 256), 16, 0, 0); }
    }
    __device__ __forceinline__ void operator()(const f32x4 (&acc)[2][2][4][2], const Unit& u, int wr, int wc, int fr, int fq) const {
        const int pnl = u.pn & 15;
        const int row0 = u.pm * BM + wr * 64 + fr; const int hb0 = pnl * HALF + wc * 32 + 8 * fq;
        const PG8_LAS float* bp = slot + u.par * 256 + wc * 64 + 16 * fq;
        f32x4 bv[2][2];
#pragma unroll
        for (int bj = 0; bj < 2; ++bj)
#pragma unroll
            for (int n = 0; n < 2; ++n) bv[bj][n] = *(const PG8_LAS f32x4*)(bp + 8 * bj + 4 * n);
#pragma unroll
        for (int ai = 0; ai < 2; ++ai)
#pragma unroll
            for (int m = 0; m < 4; ++m) { unsigned char* rowp = O + (size_t)(row0 + ai * HALF + m * 16) * 2048 + hb0; int w2[2];
#pragma unroll
                for (int bj = 0; bj < 2; ++bj) { const f32x4 v0 = acc[ai][bj][m][0] + bv[bj][0], v1 = acc[ai][bj][m][1] + bv[bj][1];
                    int w = __builtin_amdgcn_cvt_pk_fp8_f32(swiglu1(v0[0], v0[1]), swiglu1(v0[2], v0[3]), 0, false);
                    w2[bj] = __builtin_amdgcn_cvt_pk_fp8_f32(swiglu1(v1[0], v1[1]), swiglu1(v1[2], v1[3]), w, true); }
                typedef int v2i32 __attribute__((ext_vector_type(2)));
                *(v2i32*)rowp = (v2i32){w2[0], w2[1]}; }
    }
};
struct EpiDown {
    static constexpr bool PERM = true, AFTER_DRAIN = false, PREFETCH = true, BMAP = true;
    bf16_t* O; const float* bias; const float* gatel; const PG8_LAS int* tinfo; PG8_LAS float* slot;
    __device__ __forceinline__ void prefetch(const Unit& u, int wid, int lane) const {
        const int e = u.pn >> 3, pnl = u.pn & 7;
        if (wid == 0) __builtin_amdgcn_global_load_lds((const unsigned*)(bias + (size_t)e * 2048 + pnl * BM + 4 * lane), (PG8_LAS unsigned*)(slot + u.par * 512), 16, 0, 0);
        if (wid == 1) __builtin_amdgcn_global_load_lds((const unsigned*)(gatel + (size_t)e * 16384 + (size_t)(u.pm - tinfo[40 + e]) * BM + 4 * lane), (PG8_LAS unsigned*)(slot + u.par * 512 + 256), 16, 0, 0);
    }
    __device__ __forceinline__ void operator()(const f32x4 (&acc)[2][2][4][2], const Unit& u, int wr, int wc, int fr, int fq) const {
        const int pnl = u.pn & 7;
        const int row0 = u.pm * BM + wr * 64 + fr; const int col0 = pnl * BM + wc * 64 + 16 * fq;
        const PG8_LAS float* bp = slot + u.par * 512 + wc * 64 + 16 * fq; const PG8_LAS float* gp = slot + u.par * 512 + 256 + wr * 64 + fr;
        f32x4 bv[2][2];
#pragma unroll
        for (int bj = 0; bj < 2; ++bj)
#pragma unroll
            for (int n = 0; n < 2; ++n) bv[bj][n] = *(const PG8_LAS f32x4*)(bp + 8 * bj + 4 * n);
#pragma unroll
        for (int ai = 0; ai < 2; ++ai)
#pragma unroll
            for (int m = 0; m < 4; ++m) { const int row = row0 + ai * HALF + m * 16; const float gt = gp[ai * HALF + m * 16] * 16.0f; unsigned char* rowp = (unsigned char*)O + (size_t)row * 2048 + col0;
                unsigned w4[4];
#pragma unroll
                for (int bj = 0; bj < 2; ++bj) { const f32x4 v0 = (acc[ai][bj][m][0] + bv[bj][0]) * gt, v1 = (acc[ai][bj][m][1] + bv[bj][1]) * gt;
                    int w0 = __builtin_amdgcn_cvt_pk_fp8_f32(v0[0], v0[1], 0, false); w0 = __builtin_amdgcn_cvt_pk_fp8_f32(v0[2], v0[3], w0, true);
                    int w1 = __builtin_amdgcn_cvt_pk_fp8_f32(v1[0], v1[1], 0, false); w1 = __builtin_amdgcn_cvt_pk_fp8_f32(v1[2], v1[3], w1, true);
                    w4[2 * bj] = (unsigned)w0; w4[2 * bj + 1] = (unsigned)w1; }
                *(u32x4*)rowp = (u32x4){w4[0], w4[1], w4[2], w4[3]}; }
    }
};
struct MoeOrder {
    int nM, nN, nsh, nwg, G, c; const PG8_LAS unsigned char* tab; const PG8_LAS unsigned short* rt;
    __device__ __forceinline__ const PG8_LAS unsigned short* rowp(int ui) const { return rt + ui * 256; }
    __device__ __forceinline__ bool next(int i, Unit& u) const {
        const long L = (long)i * G + c; if (L >= nwg) return false;
        int wgid = (int)L; { const int q = nwg / NXCD, r = nwg % NXCD, xcd = wgid % NXCD, off = wgid / NXCD; wgid = (xcd < r ? xcd * (q + 1) : r * (q + 1) + (xcd - r) * q) + off; }
        const int nig = WGM * nN, gid = wgid / nig, fm = gid * WGM, gsz = (nM - fm) < WGM ? (nM - fm) : WGM;
        const int pm = fm + ((wgid % nig) % gsz), pnl = (wgid % nig) / gsz;
        u.pm = pm; u.pn = ((int)tab[pm] << nsh) + pnl; return true;
    }
    __device__ __forceinline__ void a_ready(const Unit&) const {}
    __device__ __forceinline__ void done(const Unit&) const {}
};
template <class E, class = void> struct epi_pref { static constexpr bool value = false; };
template <class E> struct epi_pref<E, decltype((void)E::PREFETCH)> { static constexpr bool value = E::PREFETCH; };
template <class E, class = void> struct epi_bmap { static constexpr bool value = false; };
template <class E> struct epi_bmap<E, decltype((void)E::BMAP)> { static constexpr bool value = E::BMAP; };
template <class E, class = void> struct epi_kscale { static constexpr bool value = false; };
template <class E> struct epi_kscale<E, decltype((void)E::KSCALE)> { static constexpr bool value = E::KSCALE; };
typedef int v8i32 __attribute__((ext_vector_type(8)));
__device__ __forceinline__ v8i32 pg8_cat(const bf16x8 lo, const bf16x8 hi) { typedef int v4i32 __attribute__((ext_vector_type(4))); const v4i32 a = __builtin_bit_cast(v4i32, lo), b = __builtin_bit_cast(v4i32, hi); return __builtin_shufflevector(a, b, 0, 1, 2, 3, 4, 5, 6, 7); }
template <class Epi, class Sched, bool ALIGN_EPI = false, bool SP2 = false, bool F8 = false, bool GA = false>
__device__ __forceinline__ void gemm_phase(PG8_LAS unsigned char* lds, const Gemm g, const Sched& S, const Epi& E) {
    const int tid = threadIdx.x, wid = __builtin_amdgcn_readfirstlane(tid >> 6), lane = tid & 63, wr = wid >> 2, wc = wid & 3, fr = lane & 15, fq = lane >> 4;
    const int K = g.K, KB = F8 ? K : 2 * K, nt = KB / 128;
    unsigned voffA[2], voffB[2]; int gaR[2]; unsigned gaC[2]; static_assert(!GA || SP2, "gathered A needs the SP2 loop");
#pragma unroll
    for (int i = 0; i < 2; ++i) { int R, C; stage_rc(tid * 16 + i * 8192, R, C);
        const int Rb = epi_bmap<Epi>::value ? (64 * (R >> 5) + 16 * ((R >> 2) & 3) + 4 * ((R >> 4) & 1) + (R & 3)) : (Epi::PERM ? ((R & ~31) + perm32(R & 31)) : R);
        voffA[i] = (unsigned)(R * KB + C * 2); voffB[i] = (unsigned)(Rb * KB + C * 2); gaR[i] = R; gaC[i] = (unsigned)(C * 2); }
    const size_t kstep = (size_t)(BK * 2);
    const size_t hstep = (size_t)HALF * KB;
    const size_t hstepB = epi_bmap<Epi>::value ? (size_t)8 * KB : hstep;
    const size_t tstep = 2 * hstep;
    const unsigned ldsw = (unsigned)wid * 1024u;
    int aoffk[2], boffk[2];
#pragma unroll
    for (int h = 0; h < 2; ++h) { aoffk[h] = lds_byte(wr * 64 + fr, fq * 8) + h * 1024; boffk[h] = lds_byte(wc * 32 + fr, fq * 8) + h * 1024; }
#define PG8_SA(b, h) (((b) * 2 + (h)) * HTB)
#define PG8_SB(b, h) ((4 + (b) * 2 + (h)) * HTB)
#define PG8_STAGE(bufoff, gbase, voff) do { _Pragma("unroll") for (int _i = 0; _i < 2; ++_i) \
        __builtin_amdgcn_global_load_lds((const unsigned*)((const char*)(gbase) + (voff)[_i]), (PG8_LAS unsigned*)(lds + (bufoff) + ldsw + _i * 8192), 16, 0, 0); } while (0)
#define PG8_STAGE_A(bufoff, kptr, h, usenext) do { if constexpr (GA) { _Pragma("unroll") for (int _i = 0; _i < 2; ++_i) { const unsigned _o = (usenext) ? gn[h][_i] : gc[h][_i]; \
            __builtin_amdgcn_global_load_lds((const unsigned*)((const char*)(kptr) + _o), (PG8_LAS unsigned*)(lds + (bufoff) + ldsw + _i * 8192), 16, 0, 0); } } \
        else { PG8_STAGE(bufoff, (kptr) + (h) * hstep, voffA); } } while (0)
#define PG8_GROWS(dst, ui_) do { const PG8_LAS unsigned short* _rt = S.rowp(ui_); _Pragma("unroll") for (int _h = 0; _h < 2; ++_h) _Pragma("unroll") for (int _i = 0; _i < 2; ++_i) dst[_h][_i] = (unsigned)_rt[gaR[_i] + 128 * _h] * (unsigned)KB + gaC[_i]; } while (0)
#define PG8_LDA(dst, b, h) do { if constexpr (F8) { _Pragma("unroll") for (int m = 0; m < 4; ++m) dst##8[m] = pg8_cat(*(const PG8_LAS bf16x8*)(lds + PG8_SA(b, h) + aoffk[0] + m * 2048), *(const PG8_LAS bf16x8*)(lds + PG8_SA(b, h) + aoffk[1] + m * 2048)); } \
        else { _Pragma("unroll") for (int m = 0; m < 4; ++m) _Pragma("unroll") for (int k = 0; k < 2; ++k) dst[m][k] = *(const PG8_LAS bf16x8*)(lds + PG8_SA(b, h) + aoffk[k] + m * 2048); } } while (0)
#define PG8_LDB(dst, b, h) do { if constexpr (F8) { _Pragma("unroll") for (int n = 0; n < 2; ++n) dst##8[n] = pg8_cat(*(const PG8_LAS bf16x8*)(lds + PG8_SB(b, h) + boffk[0] + n * 2048), *(const PG8_LAS bf16x8*)(lds + PG8_SB(b, h) + boffk[1] + n * 2048)); } \
        else { _Pragma("unroll") for (int n = 0; n < 2; ++n) _Pragma("unroll") for (int k = 0; k < 2; ++k) dst[n][k] = *(const PG8_LAS bf16x8*)(lds + PG8_SB(b, h) + boffk[k] + n * 2048); } } while (0)
#define PG8_MMA(ai, bj, At, Bt) do { __builtin_amdgcn_s_setprio(1); \
        if constexpr (F8) { _Pragma("unroll") for (int m = 0; m < 4; ++m) _Pragma("unroll") for (int n = 0; n < 2; ++n) \
            asm volatile("v_mfma_scale_f32_16x16x128_f8f6f4 %0, %1, %2, %0, %3, %4 op_sel_hi:[0,0,0]" : "+v"(acc[ai][bj][m][n]) : "v"(Bt##8[n]), "v"(At##8[m]), "v"(sc_w), "v"(sc_a)); } \
        else { _Pragma("unroll") for (int m = 0; m < 4; ++m) _Pragma("unroll") for (int n = 0; n < 2; ++n) _Pragma("unroll") for (int k = 0; k < 2; ++k) \
            acc[ai][bj][m][n] = __builtin_amdgcn_mfma_f32_16x16x32_bf16(Bt[n][k], At[m][k], acc[ai][bj][m][n], 0, 0, 0); } \
        __builtin_amdgcn_s_setprio(0); } while (0)
#define PG8_WAIT_V(n) asm volatile("s_waitcnt vmcnt(" #n ")" ::: "memory")
#define PG8_WAIT_L(n) asm volatile("s_waitcnt lgkmcnt(" #n ")" ::: "memory")
#define PG8_BAR __builtin_amdgcn_s_barrier()
#define PG8_SCHED __builtin_amdgcn_sched_barrier(0)
    Unit cur, nxt; int ui = 0;
    if (!S.next(0, cur)) return;
    cur.par = 0;
    f32x4 acc[2][2][4][2];
#pragma unroll
    for (int a = 0; a < 2; ++a)
#pragma unroll
        for (int b = 0; b < 2; ++b)
#pragma unroll
            for (int m = 0; m < 4; ++m)
#pragma unroll
                for (int n = 0; n < 2; ++n) acc[a][b][m][n] = (f32x4){0.f, 0.f, 0.f, 0.f};
    const int sc_w = 0x79797979, sc_a = 0x7f7f7f7f;
    bf16x8 At[4][2], B0[2][2], B1[2][2]; v8i32 At8[4], B08[2], B18[2];
    const char* cA = (const char*)g.A + (GA ? (size_t)0 : (size_t)cur.pm * tstep); const char* cB = (const char*)g.Bt + (size_t)cur.pn * tstep;
    unsigned gc[2][2] = {{0u, 0u}, {0u, 0u}}, gn[2][2] = {{0u, 0u}, {0u, 0u}};
    if constexpr (GA) { PG8_GROWS(gc, 0); }
    if constexpr (epi_kscale<Epi>::value) { E.build(cur, tid); asm volatile("s_waitcnt lgkmcnt(0)" ::: "memory"); PG8_BAR; asm volatile("" ::: "memory"); }
    S.a_ready(cur);
    if constexpr (SP2) {
        PG8_STAGE(PG8_SB(0, 0), cB, voffB); PG8_STAGE(PG8_SB(0, 1), cB + hstepB, voffB); PG8_STAGE_A(PG8_SA(0, 0), cA, 0, false); PG8_STAGE_A(PG8_SA(0, 1), cA, 1, false);
        if (wr == 1) PG8_BAR;
        PG8_WAIT_V(2); PG8_BAR;
        PG8_STAGE(PG8_SB(1, 0), cB + kstep, voffB); PG8_STAGE_A(PG8_SA(1, 0), cA + kstep, 0, false); PG8_STAGE(PG8_SB(1, 1), cB + hstepB + kstep, voffB);
        PG8_WAIT_V(6); PG8_BAR;
    } else {
        PG8_STAGE(PG8_SB(0, 0), cB, voffB); PG8_STAGE(PG8_SA(0, 0), cA, voffA); PG8_STAGE(PG8_SB(0, 1), cB + hstepB, voffB); PG8_STAGE(PG8_SA(0, 1), cA + hstep, voffA);
        if (wr == 1) PG8_BAR;
        PG8_WAIT_V(4); PG8_BAR;
        PG8_STAGE(PG8_SB(1, 0), cB + kstep, voffB); PG8_STAGE(PG8_SA(1, 0), cA + kstep, voffA); PG8_STAGE(PG8_SB(1, 1), cB + hstepB + kstep, voffB);
        PG8_WAIT_V(6); PG8_BAR;
    }
    for (;;) {
        const bool has_next = S.next(ui + 1, nxt); nxt.par = (ui + 1) & 1;
        const char* nA = (has_next && !GA) ? (const char*)g.A + (size_t)nxt.pm * tstep : cA; const char* nB = has_next ? (const char*)g.Bt + (size_t)nxt.pn * tstep : cB;
        if constexpr (GA) { if (has_next) { PG8_GROWS(gn, ui + 1); } else {
#pragma unroll
            for (int _h = 0; _h < 2; ++_h) { gn[_h][0] = gc[_h][0]; gn[_h][1] = gc[_h][1]; } } }
        for (int t = 0; t < nt; t += 2) {
            const bool last = (t == nt - 2);
            const char* a1 = cA + (size_t)(t + 1) * kstep;
            const char* a2 = last ? nA : cA + (size_t)(t + 2) * kstep; const char* b2 = last ? nB : cB + (size_t)(t + 2) * kstep;
            const char* a3 = a2 + kstep; const char* b3 = b2 + kstep;
            if (last && has_next) S.a_ready(nxt);
            if constexpr (epi_pref<Epi>::value) { if (t == 0) E.prefetch(cur, wid, lane); }
            if constexpr (SP2) {
            PG8_LDB(B0, 0, 0); PG8_LDB(B1, 0, 1); PG8_SCHED; PG8_LDA(At, 0, 0); PG8_STAGE_A(PG8_SA(1, 1), a1, 1, false);
            PG8_WAIT_V(8); PG8_WAIT_L(0); PG8_BAR; PG8_MMA(0, 0, At, B0); PG8_MMA(0, 1, At, B1); PG8_BAR; PG8_SCHED;
            PG8_LDA(At, 0, 1); PG8_STAGE(PG8_SB(0, 0), b2, voffB); PG8_STAGE(PG8_SB(0, 1), b2 + hstepB, voffB); PG8_STAGE_A(PG8_SA(0, 0), a2, 0, last);
            PG8_WAIT_V(8); PG8_WAIT_L(0); PG8_BAR; PG8_MMA(1, 0, At, B0); PG8_MMA(1, 1, At, B1); PG8_BAR; PG8_SCHED;
            PG8_LDB(B0, 1, 0); PG8_LDB(B1, 1, 1); PG8_SCHED; PG8_LDA(At, 1, 0); PG8_STAGE_A(PG8_SA(0, 1), a2, 1, last);
            PG8_WAIT_V(8); PG8_WAIT_L(0); PG8_BAR; PG8_MMA(0, 0, At, B0); PG8_MMA(0, 1, At, B1); PG8_BAR; PG8_SCHED;
            PG8_LDA(At, 1, 1); PG8_STAGE(PG8_SB(1, 0), b3, voffB); PG8_STAGE(PG8_SB(1, 1), b3 + hstepB, voffB); PG8_STAGE_A(PG8_SA(1, 0), a3, 0, last);
            PG8_WAIT_V(8); PG8_WAIT_L(0); PG8_BAR; PG8_MMA(1, 0, At, B0); PG8_MMA(1, 1, At, B1); PG8_BAR; PG8_SCHED;
            if constexpr (epi_kscale<Epi>::value) { E.kscale(acc, t, nt, wr, fr); PG8_SCHED; }
            } else {
            PG8_LDB(B0, 0, 0); PG8_SCHED; PG8_LDA(At, 0, 0); PG8_STAGE(PG8_SA(1, 1), a1 + hstep, voffA);
            PG8_WAIT_L(8); PG8_BAR; PG8_WAIT_L(0); PG8_MMA(0, 0, At, B0); PG8_BAR; PG8_SCHED;
            PG8_LDB(B1, 0, 1); PG8_STAGE(PG8_SB(0, 0), b2, voffB);
            PG8_BAR; PG8_WAIT_L(0); PG8_MMA(0, 1, At, B1); PG8_BAR;
            PG8_LDA(At, 0, 1); PG8_STAGE(PG8_SA(0, 0), a2, voffA);
            PG8_BAR; PG8_WAIT_L(0); PG8_MMA(1, 0, At, B0); PG8_BAR; PG8_SCHED;
            PG8_STAGE(PG8_SB(0, 1), b2 + hstepB, voffB);
            PG8_WAIT_V(6); PG8_BAR; PG8_MMA(1, 1, At, B1); PG8_BAR;
            PG8_LDB(B0, 1, 0); PG8_SCHED; PG8_LDA(At, 1, 0); PG8_STAGE(PG8_SA(0, 1), a2 + hstep, voffA);
            PG8_WAIT_L(8); PG8_BAR; PG8_WAIT_L(0); PG8_MMA(0, 0, At, B0); PG8_BAR; PG8_SCHED;
            PG8_LDB(B1, 1, 1); PG8_STAGE(PG8_SB(1, 0), b3, voffB);
            PG8_BAR; PG8_WAIT_L(0); PG8_MMA(0, 1, At, B1); PG8_BAR;
            PG8_LDA(At, 1, 1); PG8_STAGE(PG8_SA(1, 0), a3, voffA);
            PG8_BAR; PG8_WAIT_L(0); PG8_MMA(1, 0, At, B0); PG8_BAR; PG8_SCHED;
            PG8_STAGE(PG8_SB(1, 1), b3 + hstepB, voffB);
            PG8_WAIT_V(6); PG8_BAR; PG8_MMA(1, 1, At, B1); PG8_BAR;
            }
        }
        if constexpr (ALIGN_EPI) { if (wr == 0) PG8_BAR; }
        if constexpr (F8) asm volatile("s_nop 15\n\ts_nop 15" ::: "memory");
        if constexpr (!Epi::AFTER_DRAIN) { E(acc, cur, wr, wc, fr, fq); S.done(cur); }
        if (!has_next) break;
#pragma unroll
        for (int a = 0; a < 2; ++a)
#pragma unroll
            for (int b = 0; b < 2; ++b)
#pragma unroll
                for (int m = 0; m < 4; ++m)
#pragma unroll
                    for (int n = 0; n < 2; ++n) acc[a][b][m][n] = (f32x4){0.f, 0.f, 0.f, 0.f};
        if constexpr (epi_kscale<Epi>::value) { static_assert(!epi_kscale<Epi>::value || (ALIGN_EPI && SP2), "K-segment rescale needs aligned epilogues");
            asm volatile("s_waitcnt lgkmcnt(0)" ::: "memory"); PG8_BAR; asm volatile("" ::: "memory");
            E.build(nxt, tid); asm volatile("s_waitcnt lgkmcnt(0)" ::: "memory"); PG8_BAR; asm volatile("" ::: "memory"); }
        cur = nxt; cA = nA; cB = nB; ++ui;
        if constexpr (GA) {
#pragma unroll
            for (int _h = 0; _h < 2; ++_h) { gc[_h][0] = gn[_h][0]; gc[_h][1] = gn[_h][1]; } }
        if constexpr (ALIGN_EPI) { if (wr == 1) PG8_BAR; }
    }
    PG8_WAIT_V(0);
    if constexpr (!ALIGN_EPI) { if (wr == 0) PG8_BAR; }
    PG8_BAR;
    if constexpr (Epi::AFTER_DRAIN) { E.fused(acc, cur, wr, wc, fr, fq, lds, wid, lane); S.done(cur); }
#undef PG8_SA
#undef PG8_SB
#undef PG8_STAGE
#undef PG8_STAGE_A
#undef PG8_GROWS
#undef PG8_LDA
#undef PG8_LDB
#undef PG8_MMA
#undef PG8_WAIT_V
#undef PG8_WAIT_L
#undef PG8_BAR
#undef PG8_SCHED
}
}

constexpr int NWAVES = 8;
constexpr int TT = 16384, DM = 2048, SEQ = 2048;
constexpr int NPROJ = 11264;
constexpr int PC_Z = 0, PC_XBC = 2048, PC_Q = 5120, PC_K = 6144, PC_V = 7168, PC_O = 9216;
constexpr int WIN_LD = 11312;
constexpr int NSLOT = 65536 + 32 * 256;
constexpr float EPSF = 1e-5f;
#ifndef HSYNC_ON
#define HSYNC_ON 0
#endif
#define HWAIT() do { if (HSYNC_ON) asm volatile("s_waitcnt vmcnt(0) lgkmcnt(0)\n\ts_nop 15\n\ts_nop 15" ::: "memory"); } while (0)
#define HSYNC() do { if (HSYNC_ON) { HWAIT(); __syncthreads(); } } while (0)
#ifndef MK_PER_PHASE
#define MK_PER_PHASE 0
#endif
constexpr int N_PHASES = 9;

constexpr size_t MiB = 1u << 20;
constexpr size_t WS_CTL = 0, CTL_ZERO_BYTES = 1 * MiB;
constexpr size_t WS_WIN = 2 * MiB, WS_WSM = 46 * MiB, WS_WRT = 47 * MiB, WS_WOUT = 48 * MiB, WS_WGU = 64 * MiB, WS_WD = 576 * MiB;
constexpr size_t WS_XN1 = 832 * MiB, WS_PROJ = 896 * MiB, WS_SMALL = 1248 * MiB, WS_SSQ = 1252 * MiB, WS_YMIX = 1256 * MiB, WS_H2 = 1384 * MiB, WS_XN2 = 1512 * MiB;
constexpr size_t WS_ROUTE = 1576 * MiB, WS_XG = 1578 * MiB, WS_ACT = 1866 * MiB, WS_YR = 2154 * MiB, WS_XC = 2442 * MiB, WS_END = 2538 * MiB;
constexpr int CW_BAR = 4096;
constexpr int CW_CONV = 131072;
constexpr int CW_CNT = 65536;

constexpr int RING_BYTES = 131072;
constexpr int LDS_BYTES = 147456;
constexpr int LDSCTL_OFF = LDS_BYTES - 1024, MISC_OFF = LDSCTL_OFF;
constexpr int TAB_OFF = LDSCTL_OFF + 64;
constexpr int EPIV_OFF = RING_BYTES + 9216;
constexpr int ROWTAB_OFF = RING_BYTES;

#define GAS __attribute__((address_space(1)))
#define LAS __attribute__((address_space(3)))
typedef unsigned short bf16;
typedef unsigned v4u __attribute__((ext_vector_type(4)));
typedef unsigned v2u __attribute__((ext_vector_type(2)));
typedef float f32x4 __attribute__((ext_vector_type(4)));
typedef float f32x2 __attribute__((ext_vector_type(2)));
typedef short bf16x8 __attribute__((ext_vector_type(8)));
typedef GAS unsigned gu32;
#define RLX_AGENT __ATOMIC_RELAXED, __HIP_MEMORY_SCOPE_AGENT
#define LDS_WAIT() asm volatile("s_waitcnt lgkmcnt(0)" ::: "memory")
#define VM_WAIT() asm volatile("s_waitcnt vmcnt(0)" ::: "memory")
__device__ __forceinline__ unsigned f2bf(float f) { unsigned u = __builtin_bit_cast(unsigned, f); return (u + 0x7fffu + ((u >> 16) & 1u)) >> 16; }
__device__ __forceinline__ unsigned pk2(float lo, float hi) { return f2bf(lo) | (f2bf(hi) << 16); }
__device__ __forceinline__ float bflo(unsigned w) { return __builtin_bit_cast(float, w << 16); }
__device__ __forceinline__ float bfhi(unsigned w) { return __builtin_bit_cast(float, w & 0xffff0000u); }
__device__ __forceinline__ float wave_sum(float v) {
#pragma unroll
    for (int o = 1; o < 64; o <<= 1) v += __shfl_xor(v, o);
    return v;
}
__device__ __forceinline__ float softplusf(float x) { return x > 20.f ? x : log1pf(expf(x)); }
__device__ __forceinline__ float logsigf(float x) { return fminf(x, 0.f) - log1pf(expf(-fabsf(x))); }
__device__ __forceinline__ float siluf(float v) { return v * __builtin_amdgcn_rcpf(1.0f + __expf(-v)); }

#define XB_TMO      128
#define XB_XCNT(j)  (256  + 64 * (j))
#define XB_XSUB(j)  (1280 + 64 * (j))
#define XB_XGEN(j)  (2304 + 64 * (j))
#define XB_TOP      3328
#define XB_TOPGEN   3392
#define XCD_BAR_WORDS 3456
#define XB_SPIN_CAP (1u << 18)

__device__ __forceinline__ unsigned xb_ld(unsigned* p)              { return __hip_atomic_load(p, __ATOMIC_RELAXED, __HIP_MEMORY_SCOPE_AGENT); }
__device__ __forceinline__ unsigned xb_add(unsigned* p, unsigned v) { return __hip_atomic_fetch_add(p, v, __ATOMIC_RELAXED, __HIP_MEMORY_SCOPE_AGENT); }
__device__ __forceinline__ unsigned xb_xcc_id() { return (unsigned)__builtin_amdgcn_s_getreg((3 << 11) | 20) & 0xFu; }
#define XB_SPIN(cond, bar) do { unsigned _sp = 0; while (cond) { __builtin_amdgcn_s_sleep(1); \
    if ((++_sp & 255u) == 0u) { if (xb_ld(&(bar)[XB_TMO])) break; if (_sp > XB_SPIN_CAP) { atomicAdd(&(bar)[XB_TMO], 1u); break; } } } } while (0)

struct XcdBarrier {
    unsigned* bar; unsigned x;
    volatile LAS unsigned* st;
};

__device__ __forceinline__ XcdBarrier xcd_barrier_post(unsigned* bar, volatile LAS unsigned* st) {
    XcdBarrier b; b.bar = bar; b.x = xb_xcc_id(); b.st = st;
    if (threadIdx.x == 0) (void)xb_add(&bar[XB_XCNT(b.x)], 1u);
    return b;
}
__device__ __forceinline__ void xcd_barrier_complete(unsigned* bar, unsigned x, unsigned& nloc, unsigned& nx) {
    const unsigned G = gridDim.x * gridDim.y * gridDim.z;
    unsigned sum, cnt, mine, sp = 0u;
    for (;;) {
        sum = 0u; cnt = 0u; mine = 0u;
#pragma unroll
        for (unsigned j = 0; j < 16; ++j) { const unsigned c = xb_ld(&bar[XB_XCNT(j)]); sum += c; cnt += (c > 0u) ? 1u : 0u; mine = (j == x) ? c : mine; }
        if (sum == G) break;
        __builtin_amdgcn_s_sleep(1);
        if ((++sp & 255u) == 0u) { if (xb_ld(&bar[XB_TMO])) break; if (sp > XB_SPIN_CAP) { atomicAdd(&bar[XB_TMO], 1u); break; } }
    }
    nloc = mine > 0u ? mine : 1u; nx = cnt > 0u ? cnt : 1u;
}

__device__ __forceinline__ void xcd_barrier(const XcdBarrier& b) {
    asm volatile("s_waitcnt vmcnt(0)" ::: "memory");
    __syncthreads();
    if (threadIdx.x == 0) {
        unsigned* bar = b.bar;
        __builtin_amdgcn_s_waitcnt(0);
        unsigned nloc = b.st[0], nx = b.st[1];
        if (nloc == 0u) { xcd_barrier_complete(bar, b.x, nloc, nx); b.st[0] = nloc; b.st[1] = nx; }
        const unsigned old = xb_add(&bar[XB_XSUB(b.x)], 1u);
        const unsigned gen = old / nloc;
        if (old + 1u == (gen + 1u) * nloc) {
            __builtin_amdgcn_fence(__ATOMIC_RELEASE, "agent");
            asm volatile("s_waitcnt vmcnt(0)" ::: "memory");
            const unsigned og = xb_add(&bar[XB_TOP], 1u);
            const unsigned tg = og / nx;
            if (og + 1u == (tg + 1u) * nx) xb_add(&bar[XB_TOPGEN], 1u);
            else XB_SPIN(xb_ld(&bar[XB_TOPGEN]) == tg, bar);
            __builtin_amdgcn_fence(__ATOMIC_ACQUIRE, "agent");
            xb_add(&bar[XB_XGEN(b.x)], 1u);
            asm volatile("s_waitcnt vmcnt(0)" ::: "memory");
        } else {
            XB_SPIN(xb_ld(&bar[XB_XGEN(b.x)]) == gen, bar);
            __builtin_amdgcn_fence(__ATOMIC_ACQUIRE, "agent");
            asm volatile("s_waitcnt vmcnt(0)" ::: "memory");
        }
    }
    __syncthreads();
}

struct Frame {
    LAS unsigned char* lds;
    volatile LAS unsigned* MISC;
    gu32* ctl;
    int tid, lane, wave, G, bid;
    const float *x, *norm1_w, *w_in, *conv_w, *conv_b, *dt_bias, *a_log, *d_skip, *ssd_norm_w, *i_bias, *f_bias, *ml_norm_w, *w_out, *norm2_w, *router_w, *router_b, *w_gate_up, *b_gate_up, *w_down, *b_down, *final_norm_w;
    float* out; unsigned char* ws;
};

__device__ __forceinline__ void p0_transpose_item(const float* W, int ldw, int K, bf16* WT, int dst_row0, int src_col0, int k0, LAS float* scr, int lane) {
#pragma unroll 8
    for (int i = 0; i < 32; ++i) { const int kk = 2 * i + (lane >> 5); scr[kk * 33 + (lane & 31)] = W[(size_t)(k0 + kk) * ldw + src_col0 + (lane & 31)]; }
    LDS_WAIT(); asm volatile("" ::: "memory");
    const int c = lane & 7;
#pragma unroll
    for (int j = 0; j < 4; ++j) { const int n = (lane >> 3) + 8 * j; const LAS float* s = scr + (8 * c) * 33 + n;
        v4u o; o.x = pk2(s[0 * 33], s[1 * 33]); o.y = pk2(s[2 * 33], s[3 * 33]); o.z = pk2(s[4 * 33], s[5 * 33]); o.w = pk2(s[6 * 33], s[7 * 33]);
        *(v4u*)(WT + (size_t)(dst_row0 + n) * K + k0 + 8 * c) = o; }
    LDS_WAIT(); asm volatile("" ::: "memory");
}
__device__ __forceinline__ void p0_transpose_item_f8(const float* W, int ldw, int K, unsigned char* WT, int dst_row0, int src_col0, int k0, LAS float* scr, int lane) {
#pragma unroll 8
    for (int i = 0; i < 32; ++i) { const int kk = 2 * i + (lane >> 5); scr[kk * 33 + (lane & 31)] = W[(size_t)(k0 + kk) * ldw + src_col0 + (lane & 31)] * 64.0f; }
    LDS_WAIT(); asm volatile("" ::: "memory");
    const int c = lane & 3;
#pragma unroll
    for (int j = 0; j < 2; ++j) { const int n = (lane >> 2) + 16 * j; const LAS float* s = scr + (16 * c) * 33 + n; int o[4];
#pragma unroll
        for (int q = 0; q < 4; ++q) { int w = __builtin_amdgcn_cvt_pk_fp8_f32(s[(4 * q) * 33], s[(4 * q + 1) * 33], 0, false); o[q] = __builtin_amdgcn_cvt_pk_fp8_f32(s[(4 * q + 2) * 33], s[(4 * q + 3) * 33], w, true); }
        *(v4u*)(WT + (size_t)(dst_row0 + n) * K + k0 + 16 * c) = (v4u){(unsigned)o[0], (unsigned)o[1], (unsigned)o[2], (unsigned)o[3]}; }
    LDS_WAIT(); asm volatile("" ::: "memory");
}
template <bool F8> __device__ __forceinline__ void p0_transpose128(const float* W, int ldw, int K, void* WTv, int dst_row0, int src_col0, int k0, LAS float* scr, int lane) {
    const float* src = W + (size_t)(k0 + (lane >> 3)) * ldw + src_col0 + 4 * (lane & 7);
    f32x4 v[16];
#pragma unroll
    for (int i = 0; i < 16; ++i) v[i] = *(const f32x4*)(src + (size_t)(8 * i) * ldw);
#pragma unroll
    for (int i = 0; i < 16; ++i) { LAS float* d = scr + (8 * i + (lane >> 3)) * 33 + 4 * (lane & 7); d[0] = v[i].x; d[1] = v[i].y; d[2] = v[i].z; d[3] = v[i].w; }
    LDS_WAIT(); asm volatile("" ::: "memory");
    const int n = lane & 31, hf = lane >> 5; const LAS float* s = scr + (64 * hf) * 33 + n;
    if (F8) { unsigned char* dst = (unsigned char*)WTv + (size_t)(dst_row0 + n) * K + k0 + 64 * hf;
#pragma unroll
        for (int j = 0; j < 4; ++j) { int o[4];
#pragma unroll
            for (int q = 0; q < 4; ++q) { const LAS float* p = s + (16 * j + 4 * q) * 33; int w = __builtin_amdgcn_cvt_pk_fp8_f32(p[0] * 64.0f, p[33] * 64.0f, 0, false); o[q] = __builtin_amdgcn_cvt_pk_fp8_f32(p[66] * 64.0f, p[99] * 64.0f, w, true); }
            *(v4u*)(dst + 16 * j) = (v4u){(unsigned)o[0], (unsigned)o[1], (unsigned)o[2], (unsigned)o[3]}; }
    } else { bf16* dst = (bf16*)WTv + (size_t)dst_row0 * K + k0;
#pragma unroll
        for (int j = 0; j < 8; ++j) { const int q_ = lane + 64 * j, n_ = q_ >> 4, p_ = q_ & 15; const LAS float* p = scr + (8 * p_) * 33 + n_;
            *(v4u*)(dst + (size_t)n_ * K + 8 * p_) = (v4u){pk2(p[0], p[33]), pk2(p[66], p[99]), pk2(p[132], p[165]), pk2(p[198], p[231])}; }
    }
    LDS_WAIT(); asm volatile("" ::: "memory");
}
__device__ __forceinline__ void rms_row_to_bf16(const float* xrow, const float* w, bf16* orow, int lane) {
    const f32x4* xr = (const f32x4*)xrow + lane; const f32x4* wr = (const f32x4*)w + lane;
    f32x4 v[8]; float s = 0.f;
#pragma unroll
    for (int j = 0; j < 8; ++j) { v[j] = xr[64 * j]; s += (v[j].x * v[j].x + v[j].y * v[j].y) + (v[j].z * v[j].z + v[j].w * v[j].w); }
    const float rstd = 1.0f / sqrtf(wave_sum(s) * (1.0f / 2048.0f) + EPSF);
    v2u* o8 = (v2u*)orow + lane;
#pragma unroll
    for (int j = 0; j < 8; ++j) { const f32x4 ww = wr[64 * j]; v2u o; o.x = pk2(v[j].x * rstd * ww.x, v[j].y * rstd * ww.y); o.y = pk2(v[j].z * rstd * ww.z, v[j].w * rstd * ww.w); o8[64 * j] = o; }
}
__device__ __forceinline__ void p0_moe_weights_coop(Frame& F, const int first, const int base) {
    LAS float* tile = (LAS float*)F.lds; LAS int* slot = (LAS int*)(F.lds + 139264);
    unsigned* cnt = (unsigned*)(F.ctl + CW_CONV);
    unsigned char* WguT = (unsigned char*)(F.ws + WS_WGU); unsigned char* WdT = (unsigned char*)(F.ws + WS_WD);
    constexpr int I_GU = 32 * 256, I_D = 32 * 128, NI = I_GU + I_D;
    const int lrow = 32 * F.wave + (F.lane >> 5), lcol = 4 * (F.lane & 31);
    const int cgl = F.lane & 31;
    f32x4 v[16];
    auto item = [&](int r, const float*& W, unsigned char*& WT, int& ldw, int& n0, int& k0) {
        if (r < I_GU) { const int e = r >> 8, rr = r & 255, kb = rr >> 5, nb = rr & 31; W = F.w_gate_up + (size_t)e * 2048 * 4096; WT = WguT + (size_t)e * 4096 * 2048; ldw = 4096; n0 = nb * 128; k0 = kb * 256; }
        else { r -= I_GU; const int e = r >> 7, rr = r & 127, kb = rr >> 4, nb = rr & 15; W = F.w_down + (size_t)e * 2048 * 2048; WT = WdT + (size_t)e * 2048 * 2048; ldw = 2048; n0 = nb * 128; k0 = kb * 256; } };
    int it = first;
    if (it < 0) { if (F.tid == 0) slot[0] = base + (int)__hip_atomic_fetch_add(cnt, 1u, RLX_AGENT); __syncthreads(); it = slot[0]; __syncthreads(); }
    if (it >= NI) return;
    int pre = NI; if (F.tid == 0) pre = base + (int)__hip_atomic_fetch_add(cnt, 1u, RLX_AGENT);
    const float* W; unsigned char* WT; int ldw, n0, k0; item(it, W, WT, ldw, n0, k0);
#pragma unroll
    for (int i = 0; i < 16; ++i) v[i] = *(const f32x4*)(W + (size_t)(k0 + lrow + 2 * i) * ldw + n0 + lcol);
    for (;;) {
#pragma unroll
        for (int i = 0; i < 16; ++i) *(LAS f32x4*)(tile + (lrow + 2 * i) * 128 + ((cgl ^ ((2 * F.wave + (i >> 3)) & 15)) << 2)) = v[i];
        if (F.tid == 0) slot[0] = pre;
        __syncthreads();
        unsigned char* const dbase = WT + (size_t)n0 * 2048 + k0;
        const int nit = slot[0]; const bool more = nit < NI;
        if (more) { if (F.tid == 0) pre = base + (int)__hip_atomic_fetch_add(cnt, 1u, RLX_AGENT);
            item(nit, W, WT, ldw, n0, k0);
#pragma unroll
            for (int i = 0; i < 16; ++i) v[i] = *(const f32x4*)(W + (size_t)(k0 + lrow + 2 * i) * ldw + n0 + lcol); }
#pragma unroll
        for (int j = 0; j < 4; ++j) { const int q_ = F.tid + 512 * j, n_ = q_ >> 4, p_ = q_ & 15; const LAS float* sp = tile + (16 * p_) * 128 + ((((n_ >> 2) ^ p_) << 2) | (n_ & 3)); int o[4];
#pragma unroll
            for (int q = 0; q < 4; ++q) { const LAS float* p = sp + (4 * q) * 128; int w_ = __builtin_amdgcn_cvt_pk_fp8_f32(p[0] * 64.0f, p[128] * 64.0f, 0, false); o[q] = __builtin_amdgcn_cvt_pk_fp8_f32(p[256] * 64.0f, p[384] * 64.0f, w_, true); }
            *(v4u*)(dbase + (size_t)n_ * 2048 + 16 * p_) = (v4u){(unsigned)o[0], (unsigned)o[1], (unsigned)o[2], (unsigned)o[3]}; }
        __syncthreads();
        if (!more) break; it = nit;
    }
}
__device__ __forceinline__ void phase0(Frame& F) {
    LAS float* scr = (LAS float*)(F.lds + F.wave * 16896);
    const int gw = F.bid * NWAVES + F.wave, NGW = F.G * NWAVES;
    bf16* WinT = (bf16*)(F.ws + WS_WIN); bf16* WsT = (bf16*)(F.ws + WS_WSM); bf16* Wrt = (bf16*)(F.ws + WS_WRT); bf16* WoutT = (bf16*)(F.ws + WS_WOUT);
    bf16* XN1 = (bf16*)(F.ws + WS_XN1);
    constexpr int I_IN = 16 * 352, I_OUT = 32 * 64, NITEMS = I_IN + I_OUT;
    for (int it = gw; it < NITEMS; it += NGW) {
        int r = it;
        if (r < I_IN) { const int kb = r / 352, nb = r % 352, n0 = nb * 32; p0_transpose128<false>(F.w_in, WIN_LD, 2048, WinT, n0, n0 + (n0 >= 5120 ? 32 : 0), kb * 128, scr, F.lane); continue; } r -= I_IN;
        { const int kb = r >> 6, nb = r & 63; p0_transpose128<false>(F.w_out, 2048, 4096, WoutT, nb * 32, nb * 32, kb * 128, scr, F.lane); }
    }
    for (int i = gw * 64 + F.lane; i < 64 * 2048; i += NGW * 64) { const int j = i >> 11, k = i & 2047;
        const int col = j < 32 ? 5120 + j : (j < 40 ? 11296 + (j - 32) : 11304 + (j - 40));
        WsT[i] = (bf16)(j < 48 ? f2bf(F.w_in[(size_t)k * WIN_LD + col]) : 0u); }
    for (int i = gw * 64 + F.lane; i < 2048 * 32; i += NGW * 64) { const int d = i >> 5, e = i & 31; const float wv = F.norm2_w[d] * F.router_w[i]; const unsigned hi = f2bf(wv);
        Wrt[(size_t)e * 2048 + d] = (bf16)hi; Wrt[(size_t)(32 + e) * 2048 + d] = (bf16)f2bf(wv - bflo(hi)); }
    for (int m = gw; m < TT; m += NGW) rms_row_to_bf16(F.x + (size_t)m * DM, F.norm1_w, XN1 + (size_t)m * DM, F.lane);
}

__device__ __forceinline__ void p1_small(Frame& F) {
    const bf16* XN1 = (const bf16*)(F.ws + WS_XN1); const bf16* WsT = (const bf16*)(F.ws + WS_WSM); float* SMALL = (float*)(F.ws + WS_SMALL);
    constexpr int RP = 528;
    LAS unsigned char* xA = F.lds + F.wave * (8 * RP); LAS unsigned char* wl0 = F.lds + 40960;
    const int gw = F.bid * NWAVES + F.wave, NGW = F.G * NWAVES, ntask = TT / 8, iters = (ntask + NGW - 1) / NGW;
    const int fr = F.lane & 15, fq = F.lane >> 4, wrow = F.tid >> 3, wpc = F.tid & 7, xrow = F.lane >> 5, xpc = F.lane & 31;
    for (int itx = 0; itx < iters; ++itx) {
        const int task = itx * NGW + gw; const bool valid = task < ntask; const int t0 = valid ? task * 8 : 0;
        f32x4 acc[4];
#pragma unroll
        for (int n = 0; n < 4; ++n) acc[n] = (f32x4){0.f, 0.f, 0.f, 0.f};
        v4u wreg[4], xreg[4];
#pragma unroll
        for (int q = 0; q < 4; ++q) { wreg[q] = *(const v4u*)(WsT + (size_t)wrow * DM + 8 * (wpc + 8 * q)); xreg[q] = *(const v4u*)(XN1 + (size_t)(t0 + xrow + 2 * q) * DM + 8 * xpc); }
        for (int dc = 0; dc < 8; ++dc) {
            LAS unsigned char* wl = wl0 + (dc & 1) * (64 * RP);
#pragma unroll
            for (int q = 0; q < 4; ++q) { *(LAS v4u*)(wl + wrow * RP + 16 * (wpc + 8 * q)) = wreg[q]; *(LAS v4u*)(xA + (xrow + 2 * q) * RP + 16 * xpc) = xreg[q]; }
            if (dc < 7) {
#pragma unroll
                for (int q = 0; q < 4; ++q) { wreg[q] = *(const v4u*)(WsT + (size_t)wrow * DM + (dc + 1) * 256 + 8 * (wpc + 8 * q)); xreg[q] = *(const v4u*)(XN1 + (size_t)(t0 + xrow + 2 * q) * DM + (dc + 1) * 256 + 8 * xpc); } }
            __syncthreads();
#pragma unroll
            for (int ks = 0; ks < 8; ++ks) { const bf16x8 a = *(const LAS bf16x8*)(xA + (fr & 7) * RP + 64 * ks + 16 * fq);
#pragma unroll
                for (int n = 0; n < 4; ++n) { const bf16x8 bb = *(const LAS bf16x8*)(wl + (16 * n + fr) * RP + 64 * ks + 16 * fq); acc[n] = __builtin_amdgcn_mfma_f32_16x16x32_bf16(a, bb, acc[n], 0, 0, 0); } }
        }
        if (valid && fq < 2) {
#pragma unroll
            for (int n = 0; n < 4; ++n)
#pragma unroll
                for (int r = 0; r < 4; ++r) SMALL[(size_t)(t0 + 4 * fq + r) * 64 + n * 16 + fr] = acc[n][r];
        }
        __syncthreads();
    }
}

__device__ __forceinline__ void unpack8(const v4u r, float (&f)[8]) { f[0] = bflo(r.x); f[1] = bfhi(r.x); f[2] = bflo(r.y); f[3] = bfhi(r.y); f[4] = bflo(r.z); f[5] = bfhi(r.z); f[6] = bflo(r.w); f[7] = bfhi(r.w); }

__device__ __forceinline__ void phase_conv(Frame& F) {
    const bf16* PROJ = (const bf16*)(F.ws + WS_PROJ); bf16* XC = (bf16*)(F.ws + WS_XC);
    constexpr int TB = 16, NCG = 384, NIT = (TT / TB) * NCG;
    for (int it = F.bid * (NWAVES * 64) + F.tid; it < NIT; it += F.G * NWAVES * 64) {
        const int cg = it % NCG, tb = it / NCG, ch = cg * 8, t0 = tb * TB; const bool seq0 = (t0 % SEQ) == 0;
        float w[4][8], bs[8];
#pragma unroll
        for (int j = 0; j < 4; ++j) { const f32x4 a = *(const f32x4*)(F.conv_w + j * 3072 + ch), b = *(const f32x4*)(F.conv_w + j * 3072 + ch + 4);
            w[j][0] = a.x; w[j][1] = a.y; w[j][2] = a.z; w[j][3] = a.w; w[j][4] = b.x; w[j][5] = b.y; w[j][6] = b.z; w[j][7] = b.w; }
        { const f32x4 a = *(const f32x4*)(F.conv_b + ch), b = *(const f32x4*)(F.conv_b + ch + 4); bs[0] = a.x; bs[1] = a.y; bs[2] = a.z; bs[3] = a.w; bs[4] = b.x; bs[5] = b.y; bs[6] = b.z; bs[7] = b.w; }
        const bf16* src = PROJ + (size_t)t0 * NPROJ + PC_XBC + ch;
        float r0[8], r1[8], r2[8], r3[8];
        if (seq0) {
#pragma unroll
            for (int i = 0; i < 8; ++i) { r0[i] = 0.f; r1[i] = 0.f; r2[i] = 0.f; }
        } else { unpack8(*(const v4u*)(src - 3 * (size_t)NPROJ), r0); unpack8(*(const v4u*)(src - 2 * (size_t)NPROJ), r1); unpack8(*(const v4u*)(src - (size_t)NPROJ), r2); }
        v4u rw[TB];
#pragma unroll
        for (int l = 0; l < TB; ++l) rw[l] = *(const v4u*)(src + (size_t)l * NPROJ);
#pragma unroll
        for (int l = 0; l < TB; ++l) {
            unpack8(rw[l], r3);
            float o[8];
#pragma unroll
            for (int i = 0; i < 8; ++i) { const float v = bs[i] + w[0][i] * r0[i] + w[1][i] * r1[i] + w[2][i] * r2[i] + w[3][i] * r3[i]; o[i] = siluf(v); r0[i] = r1[i]; r1[i] = r2[i]; r2[i] = r3[i]; }
            v4u ov; ov.x = pk2(o[0], o[1]); ov.y = pk2(o[2], o[3]); ov.z = pk2(o[4], o[5]); ov.w = pk2(o[6], o[7]);
            *(v4u*)(XC + (size_t)(t0 + l) * 3072 + ch) = ov;
        }
    }
}

constexpr int MX_PITCH = 272;
static_assert(true, "");
constexpr int MX_QM = 0, MX_KM = 34816, MX_KW = 69632, MX_VT = 104448, MX_SI = 121856, MX_VEC = 139264, MX_VECB = 3072, MX_NVEC = MX_VEC + 2 * MX_VECB, MX_SCAL = MX_NVEC + 512, MX_END = MX_SCAL + 64;
__device__ __forceinline__ unsigned cvt_pk_bf16_nop(float lo, float hi) { unsigned r; asm volatile("v_cvt_pk_bf16_f32 %0, %1, %2\n\ts_nop 1" : "=v"(r) : "v"(lo), "v"(hi)); return r; }
__device__ __forceinline__ int mx_sw(int row, int tbyte) { return row * MX_PITCH + ((((tbyte >> 4) ^ (row >> 3)) & 15) << 4) + (tbyte & 15); }
__device__ __forceinline__ bf16x8 lds_frag(const LAS unsigned char* img, int row, int kbyte) { return *(const LAS bf16x8*)(img + row * MX_PITCH + kbyte); }
static_assert(MX_END + 256 <= LDSCTL_OFF, "mixer LDS map");
template <bool ML> __device__ __forceinline__ void mixer_unit(Frame& F, int unit) {
    const bf16* PROJ = (const bf16*)(F.ws + WS_PROJ); const bf16* XC = (const bf16*)(F.ws + WS_XC); const float* SMALL = (const float*)(F.ws + WS_SMALL);
    bf16* YMIX = (bf16*)(F.ws + WS_YMIX); float* SSQ = (float*)(F.ws + WS_SSQ);
    const int w = F.wave, fr = F.lane & 15, fq = F.lane >> 4, tid = F.tid;
    const int b = unit >> 5, tok0 = b * SEQ, hd = unit & 31, grp = hd >> 3, mh = (unit & 31) >> 2, vq = unit & 3;
    const float qs = 0.08838834764831845f;
    LAS unsigned char* QM = F.lds + MX_QM; LAS unsigned char* KM = F.lds + MX_KM; LAS unsigned char* KW = F.lds + MX_KW; LAS unsigned char* VT = F.lds + MX_VT; LAS unsigned char* SI = F.lds + MX_SI;
    LAS float* exch = (LAS float*)(F.lds + MX_VEC + (w >> 2) * MX_VECB + 1024) + (w & 3) * 32;
    LAS float* nvec = (LAS float*)(F.lds + MX_NVEC); LAS float* scal = (LAS float*)(F.lds + MX_SCAL);
    const int fr3 = fr >> 3;
    int vtb[2];
#pragma unroll
    for (int p = 0; p < 2; ++p) vtb[p] = fr * MX_PITCH + ((fq ^ ((2 * p) | fr3)) << 4);
    int vpb[2][2];
#pragma unroll
    for (int p = 0; p < 2; ++p)
#pragma unroll
        for (int h = 0; h < 2; ++h) vpb[p][h] = fr * MX_PITCH + (((((fq >> 1) | (2 * h)) ^ ((2 * p) | fr3))) << 4) + 8 * (fq & 1);
    const int kwb = (16 * w + fr) * MX_PITCH + ((fq ^ ((2 * (w & 1)) | fr3)) << 4), kwh = w >> 1;

    const bf16* qsrc; const bf16* ksrc; const bf16* vsrc; int ld;
    if (ML) { qsrc = PROJ + PC_Q + mh * 128; ksrc = PROJ + PC_K + mh * 128; vsrc = PROJ + PC_V + mh * 256 + vq * 64; ld = NPROJ; }
    else { qsrc = XC + 2560 + grp * 128; ksrc = XC + 2048 + grp * 128; vsrc = XC + hd * 64; ld = 3072; }
    const float c_a = ML ? 0.f : -expf(F.a_log[hd]), c_dtb = ML ? 0.f : F.dt_bias[hd], c_D = ML ? 0.f : F.d_skip[hd], c_ib = ML ? F.i_bias[mh] : 0.f, c_fb = ML ? F.f_bias[mh] : 0.f;
    float mprev = 0.f;
    f32x4 sacc[4]; float nreg = 0.f;
#pragma unroll
    for (int j = 0; j < 4; ++j) sacc[j] = (f32x4){0.f, 0.f, 0.f, 0.f};
    v4u pq[4], pk[4], pv[2];
    float vA0 = 0.f, vA1 = 0.f, vB0 = 0.f, vB1 = 0.f, vC0 = 0.f, vC1 = 0.f, vD0 = 0.f, vD1 = 0.f, vE0 = 0.f, vE1 = 0.f, vG0 = 0.f, vG1 = 0.f, vSA = 0.f, vSG = 0.f;
    float sl0 = 0.f, sl1 = 0.f, sl2 = 0.f, sl3 = 0.f;
#define MX_SCAN_L(c) do { if (w == 0) { const size_t tt = (size_t)(tok0 + 128 * (c) + 2 * F.lane); \
        if (!ML) { sl0 = SMALL[tt * 64 + hd]; sl1 = SMALL[(tt + 1) * 64 + hd]; } \
        else { sl0 = SMALL[tt * 64 + 32 + mh]; sl1 = SMALL[(tt + 1) * 64 + 32 + mh]; sl2 = SMALL[tt * 64 + 40 + mh]; sl3 = SMALL[(tt + 1) * 64 + 40 + mh]; } } } while (0)
#define MX_SOFTPLUS(x) ((x) > 20.f ? (x) : __logf(1.0f + __expf(x)))
#define MX_LOGSIG(x) (fminf((x), 0.f) - __logf(1.0f + __expf(-fabsf(x))))
#define MX_SCAN_A(c) do { if (w == 0) { \
        if (!ML) { const float d0 = MX_SOFTPLUS(sl0 + c_dtb), d1 = MX_SOFTPLUS(sl1 + c_dtb); \
            const float x0 = d0 * c_a, x1 = d1 * c_a; float incl = x0 + x1; \
            _Pragma("unroll") for (int d = 1; d < 64; d <<= 1) { const float t_ = __shfl_up(incl, d); if (F.lane >= d) incl += t_; } \
            const float cum1 = incl, cum0 = incl - x1, tot = __shfl(incl, 63); \
            vA0 = -cum0; vA1 = -cum1; vB0 = -cum0; vB1 = -cum1; vC0 = d0; vC1 = d1; vD0 = __expf(cum0); vD1 = __expf(cum1); vE0 = d0 * __expf(tot - cum0); vE1 = d1 * __expf(tot - cum1); vSA = __expf(tot); vSG = 1.0f; \
        } else { const float li0 = sl0 + c_ib, li1 = sl1 + c_ib; \
            const float x0 = MX_LOGSIG(sl2 + c_fb), x1 = MX_LOGSIG(sl3 + c_fb); float incl = x0 + x1; \
            _Pragma("unroll") for (int d = 1; d < 64; d <<= 1) { const float t_ = __shfl_up(incl, d); if (F.lane >= d) incl += t_; } \
            const float cum1 = incl, cum0 = incl - x1, btot = __shfl(incl, 63); \
            const float dd0 = li0 - cum0, dd1 = li1 - cum1; float im = fmaxf(dd0, dd1); \
            _Pragma("unroll") for (int d = 1; d < 64; d <<= 1) { const float t_ = __shfl_up(im, d); if (F.lane >= d) im = fmaxf(im, t_); } \
            float pm = __shfl_up(im, 1); if (F.lane == 0) pm = -3.0e38f; const float pmax0 = fmaxf(pm, dd0), pmax1 = im, pm127 = __shfl(im, 63); \
            const float M0 = fmaxf(mprev, pmax0), M1 = fmaxf(mprev, pmax1); \
            vA0 = dd0; vA1 = dd1; vB0 = M0; vB1 = M1; vD0 = qs * __expf(mprev - M0); vD1 = qs * __expf(mprev - M1); vG0 = __expf(-(cum0 + M0)); vG1 = __expf(-(cum1 + M1)); \
            const float mloc = btot + pm127, mnew = fmaxf(btot + mprev, mloc); \
            vSA = __expf(btot + mprev - mnew); vSG = __expf(mloc - mnew); vE0 = __expf(dd0 - pm127) * vSG; vE1 = __expf(dd1 - pm127) * vSG; mprev = mnew; } } } while (0)
#define MX_SCAN_B(c) do { if (w == 0) { \
        LAS float* vb = (LAS float*)(F.lds + MX_VEC + ((c) & 1) * MX_VECB); const int l0 = 2 * F.lane; \
        *(LAS f32x2*)(vb + l0) = (f32x2){vA0, vA1}; *(LAS f32x2*)(vb + 128 + l0) = (f32x2){vB0, vB1}; if (!ML) *(LAS f32x2*)(vb + 256 + l0) = (f32x2){vC0, vC1}; \
        *(LAS f32x2*)(vb + 384 + l0) = (f32x2){vD0, vD1}; *(LAS f32x2*)(vb + 512 + l0) = (f32x2){vE0, vE1}; if (ML) *(LAS f32x2*)(vb + 640 + l0) = (f32x2){vG0, vG1}; \
        if (F.lane == 0) { scal[2 * ((c) & 1)] = vSA; scal[2 * ((c) & 1) + 1] = vSG; } } } while (0)
#define MX_PREFETCH(c) do { const size_t tb_ = (size_t)(tok0 + 128 * (c)); \
        _Pragma("unroll") for (int i = 0; i < 2; ++i) { const int pid = tid + 512 * i, a2 = pid >> 4, k8 = pid & 15; \
            pq[2 * i] = *(const v4u*)(qsrc + (tb_ + 2 * a2) * ld + 8 * k8); pq[2 * i + 1] = *(const v4u*)(qsrc + (tb_ + 2 * a2 + 1) * ld + 8 * k8); \
            pk[2 * i] = *(const v4u*)(ksrc + (tb_ + 2 * a2) * ld + 8 * k8); pk[2 * i + 1] = *(const v4u*)(ksrc + (tb_ + 2 * a2 + 1) * ld + 8 * k8); } \
        { const int a2 = tid >> 3, v8 = tid & 7; pv[0] = *(const v4u*)(vsrc + (tb_ + 2 * a2) * ld + 8 * v8); pv[1] = *(const v4u*)(vsrc + (tb_ + 2 * a2 + 1) * ld + 8 * v8); } } while (0)
#define MX_WRITE(c) do { const LAS float* vb = (const LAS float*)(F.lds + MX_VEC + ((c) & 1) * MX_VECB); \
        _Pragma("unroll") for (int i = 0; i < 2; ++i) { const int pid = tid + 512 * i, a2 = pid >> 4, k8 = pid & 15, l = 2 * a2; \
            *(LAS v4u*)(QM + l * MX_PITCH + 16 * k8) = pq[2 * i]; *(LAS v4u*)(QM + (l + 1) * MX_PITCH + 16 * k8) = pq[2 * i + 1]; \
            *(LAS v4u*)(KM + l * MX_PITCH + 16 * k8) = pk[2 * i]; *(LAS v4u*)(KM + (l + 1) * MX_PITCH + 16 * k8) = pk[2 * i + 1]; \
            float f0[8], f1[8]; unpack8(pk[2 * i], f0); unpack8(pk[2 * i + 1], f1); const f32x2 wl = *(const LAS f32x2*)(vb + 512 + l); \
            _Pragma("unroll") for (int e = 0; e < 8; ++e) *(LAS unsigned*)(KW + mx_sw(8 * k8 + e, 2 * l)) = pg8::cvt_pk_bf16(f0[e] * wl.x, f1[e] * wl.y); } \
        { const int a2 = tid >> 3, v8 = tid & 7, l = 2 * a2; const v4u r0 = pv[0], r1 = pv[1]; LAS unsigned char* vp_ = VT + mx_sw(8 * v8, 2 * l); \
            *(LAS unsigned*)(vp_ + 0 * MX_PITCH) = (r0.x & 0xffffu) | (r1.x << 16); *(LAS unsigned*)(vp_ + 1 * MX_PITCH) = (r0.x >> 16) | (r1.x & 0xffff0000u); \
            *(LAS unsigned*)(vp_ + 2 * MX_PITCH) = (r0.y & 0xffffu) | (r1.y << 16); *(LAS unsigned*)(vp_ + 3 * MX_PITCH) = (r0.y >> 16) | (r1.y & 0xffff0000u); \
            *(LAS unsigned*)(vp_ + 4 * MX_PITCH) = (r0.z & 0xffffu) | (r1.z << 16); *(LAS unsigned*)(vp_ + 5 * MX_PITCH) = (r0.z >> 16) | (r1.z & 0xffff0000u); \
            *(LAS unsigned*)(vp_ + 6 * MX_PITCH) = (r0.w & 0xffffu) | (r1.w << 16); *(LAS unsigned*)(vp_ + 7 * MX_PITCH) = (r0.w >> 16) | (r1.w & 0xffff0000u); } \
        _Pragma("unroll") for (int j = 0; j < 4; ++j) { v2u sv; sv.x = pg8::cvt_pk_bf16(sacc[j][0], sacc[j][1]); sv.y = pg8::cvt_pk_bf16(sacc[j][2], sacc[j][3]); *(LAS v2u*)(SI + (16 * j + fr) * MX_PITCH + (16 * w + 4 * fq) * 2) = sv; } \
        if (ML && fq == 0) nvec[16 * w + fr] = nreg; } while (0)
    const int gcol = (ML ? PC_O + mh * 256 + vq * 64 : PC_Z + hd * 64) + 16 * (F.lane & 3);
    LAS float* nwl = (LAS float*)(F.lds + MX_END);
    if (tid < 64) nwl[tid] = ML ? F.ml_norm_w[mh * 256 + vq * 64 + tid] : F.ssd_norm_w[hd * 64 + tid];
    v4u zc0 = (v4u){0u, 0u, 0u, 0u}, zc1 = zc0;
    { const bf16* zp = PROJ + (size_t)(tok0 + 16 * w + (F.lane >> 2)) * NPROJ + gcol; zc0 = *(const v4u*)zp; zc1 = *(const v4u*)(zp + 8); }
    MX_SCAN_L(0); MX_PREFETCH(0);
    MX_SCAN_A(0); MX_SCAN_B(0);
    __syncthreads();
    MX_WRITE(0);
    __syncthreads();
    for (int c = 0; c < SEQ / 128; ++c) {
        const LAS float* vb = (const LAS float*)(F.lds + MX_VEC + (c & 1) * MX_VECB);
        const bool more = (c + 1 < SEQ / 128);
        if (more) { MX_SCAN_L(c + 1); MX_PREFETCH(c + 1); }
        bf16x8 qf[4];
#pragma unroll
        for (int ks = 0; ks < 4; ++ks) qf[ks] = lds_frag(QM, 16 * w + fr, 64 * ks + 16 * fq);
        const float mlv = vb[128 + 16 * w + fr];
        float dsum = 0.f;
        f32x4 y1[4];
#pragma unroll
        for (int j = 0; j < 4; ++j) y1[j] = (f32x4){0.f, 0.f, 0.f, 0.f};
        const f32x4 rs4 = *(const LAS f32x4*)(vb + 384 + 16 * w + 4 * fq);
#pragma unroll
        for (int ks = 0; ks < 4; ++ks) { bf16x8 sf[4];
#pragma unroll
            for (int j = 0; j < 4; ++j) sf[j] = lds_frag(SI, 16 * j + fr, 64 * ks + 16 * fq);
#pragma unroll
            for (int j = 0; j < 4; ++j) y1[j] = __builtin_amdgcn_mfma_f32_16x16x32_bf16(qf[ks], sf[j], y1[j], 0, 0, 0); }
#pragma unroll
        for (int j = 0; j < 4; ++j) y1[j] = y1[j] * rs4;
        __builtin_amdgcn_sched_barrier(0);
#pragma unroll 1
        for (int k2 = 0; 2 * k2 <= w; ++k2) {
            unsigned pw[4];
#pragma unroll
            for (int h = 0; h < 2; ++h) {
                const int si = 2 * k2 + h;
                f32x4 acc = (f32x4){0.f, 0.f, 0.f, 0.f};
#pragma unroll
                for (int ks = 0; ks < 4; ++ks) acc = __builtin_amdgcn_mfma_f32_16x16x32_bf16(lds_frag(KM, 16 * si + fr, 64 * ks + 16 * fq), qf[ks], acc, 0, 0, 0);
                const f32x4 e4 = *(const LAS f32x4*)(vb + 16 * si + 4 * fq); f32x4 x4 = (f32x4){qs, qs, qs, qs}; if (!ML) x4 = *(const LAS f32x4*)(vb + 256 + 16 * si + 4 * fq);
                float p[4];
#pragma unroll
                for (int r = 0; r < 4; ++r) { const float v = acc[r] * __expf(e4[r] - mlv) * x4[r]; const bool ok = (si < w) || (si == w && 4 * fq + r <= fr); p[r] = ok ? v : 0.f; }
                if (ML) dsum += (p[0] + p[1]) + (p[2] + p[3]);
                pw[2 * h] = cvt_pk_bf16_nop(p[0], p[1]); pw[2 * h + 1] = cvt_pk_bf16_nop(p[2], p[3]);
            }
            HWAIT();
            const v4u pwv = (v4u){pw[0], pw[1], pw[2], pw[3]}; const bf16x8 pf = __builtin_bit_cast(bf16x8, pwv);
#pragma unroll
            for (int j = 0; j < 4; ++j) { const int ho = j * 16 * MX_PITCH + ((k2 ^ (j >> 1)) << 6); const v2u lo = *(const LAS v2u*)(VT + vpb[j & 1][0] + ho), hi = *(const LAS v2u*)(VT + vpb[j & 1][1] + ho); const v4u vw = (v4u){lo.x, lo.y, hi.x, hi.y};
                y1[j] = __builtin_amdgcn_mfma_f32_16x16x32_bf16(pf, __builtin_bit_cast(bf16x8, vw), y1[j], 0, 0, 0); }
            HWAIT();
        }
        HSYNC();
        __builtin_amdgcn_sched_barrier(0);
        __builtin_amdgcn_sched_barrier(0);
        if (ML) {
            dsum += __shfl_xor(dsum, 16); dsum += __shfl_xor(dsum, 32);
            float d2 = 0.f;
#pragma unroll
            for (int ks = 0; ks < 4; ++ks) { float qv[8]; unpack8(__builtin_bit_cast(v4u, qf[ks]), qv); const f32x4 n0 = *(const LAS f32x4*)(nvec + 32 * ks + 8 * fq), n1 = *(const LAS f32x4*)(nvec + 32 * ks + 8 * fq + 4);
                d2 += qv[0] * n0.x + qv[1] * n0.y + qv[2] * n0.z + qv[3] * n0.w + qv[4] * n1.x + qv[5] * n1.y + qv[6] * n1.z + qv[7] * n1.w; }
            d2 += __shfl_xor(d2, 16); d2 += __shfl_xor(d2, 32);
            if (fq == 0) { exch[fr] = dsum; exch[16 + fr] = d2; }
        }
        HSYNC();
        __builtin_amdgcn_sched_barrier(0);
        LAS float* stg = (LAS float*)(QM + 16 * w * MX_PITCH);
        if (ML) { const f32x4 fl4 = *(const LAS f32x4*)(vb + 640 + 16 * w + 4 * fq); const f32x4 dA = *(const LAS f32x4*)(exch + 4 * fq), dB = *(const LAS f32x4*)(exch + 16 + 4 * fq);
#pragma unroll
            for (int r = 0; r < 4; ++r) { const float den = fmaxf(fabsf(dA[r] + rs4[r] * dB[r]), fl4[r]); const float inv = __builtin_amdgcn_rcpf(den);
#pragma unroll
                for (int j = 0; j < 4; ++j) stg[(4 * fq + r) * 68 + 16 * j + fr] = y1[j][r] * inv; }
        } else {
#pragma unroll
            for (int j = 0; j < 4; ++j) { const v2u xw = *(const LAS v2u*)(VT + mx_sw(16 * j + fr, 32 * w + 8 * fq)); const float xs[4] = {bflo(xw.x), bfhi(xw.x), bflo(xw.y), bfhi(xw.y)};
#pragma unroll
                for (int r = 0; r < 4; ++r) stg[(4 * fq + r) * 68 + 16 * j + fr] = y1[j][r] + c_D * xs[r]; }
        }
        {   const int erow = F.lane >> 2, ecs = F.lane & 3; const size_t trow = (size_t)(tok0 + 128 * c + 16 * w + erow);
            float yv[16];
#pragma unroll
            for (int i = 0; i < 4; ++i) { const f32x4 t4 = *(const LAS f32x4*)(stg + erow * 68 + 16 * ecs + 4 * i); yv[4 * i] = t4.x; yv[4 * i + 1] = t4.y; yv[4 * i + 2] = t4.z; yv[4 * i + 3] = t4.w; }
            float zf[16]; { float t8[8]; unpack8(zc0, t8);
#pragma unroll
                for (int i = 0; i < 8; ++i) zf[i] = t8[i]; unpack8(zc1, t8);
#pragma unroll
                for (int i = 0; i < 8; ++i) zf[8 + i] = t8[i]; }
            if (!ML) {
#pragma unroll
                for (int i = 0; i < 16; ++i) yv[i] = yv[i] * zf[i] * __builtin_amdgcn_rcpf(1.0f + __expf(-zf[i])); }
            float ss = 0.f;
#pragma unroll
            for (int i = 0; i < 16; ++i) ss += yv[i] * yv[i];
            ss += __shfl_xor(ss, 1); ss += __shfl_xor(ss, 2);
            if (ecs == 0) SSQ[(ML ? (size_t)TT * 32 : 0) + trow * 32 + (ML ? mh * 4 + vq : hd)] = ss;
#pragma unroll
            for (int i = 0; i < 4; ++i) { const f32x4 w4 = *(const LAS f32x4*)(nwl + 16 * ecs + 4 * i);
                yv[4 * i] *= w4.x; yv[4 * i + 1] *= w4.y; yv[4 * i + 2] *= w4.z; yv[4 * i + 3] *= w4.w; }
            if (ML) {
#pragma unroll
                for (int i = 0; i < 16; ++i) yv[i] *= __builtin_amdgcn_rcpf(1.0f + __expf(-zf[i])); }
            bf16* yp = YMIX + trow * 4096 + (ML ? 2048 + mh * 256 + vq * 64 : hd * 64) + 16 * ecs;
            *(v4u*)yp = (v4u){pg8::cvt_pk_bf16(yv[0], yv[1]), pg8::cvt_pk_bf16(yv[2], yv[3]), pg8::cvt_pk_bf16(yv[4], yv[5]), pg8::cvt_pk_bf16(yv[6], yv[7])};
            *(v4u*)(yp + 8) = (v4u){pg8::cvt_pk_bf16(yv[8], yv[9]), pg8::cvt_pk_bf16(yv[10], yv[11]), pg8::cvt_pk_bf16(yv[12], yv[13]), pg8::cvt_pk_bf16(yv[14], yv[15])};
            if (more) { const bf16* zp = PROJ + (size_t)(tok0 + 128 * (c + 1) + 16 * w + (F.lane >> 2)) * NPROJ + gcol; zc0 = *(const v4u*)zp; zc1 = *(const v4u*)(zp + 8); }
        }
        __builtin_amdgcn_sched_barrier(0);
        const float sa = scal[2 * (c & 1)];
#pragma unroll
        for (int j = 0; j < 4; ++j) sacc[j] = sacc[j] * sa;
        float nsum = 0.f;
#pragma unroll
        for (int ks = 0; ks < 4; ++ks) { const bf16x8 kf = *(const LAS bf16x8*)(KW + kwb + ((ks ^ kwh) << 6)); bf16x8 vf[4];
#pragma unroll
            for (int j = 0; j < 4; ++j) vf[j] = *(const LAS bf16x8*)(VT + vtb[j & 1] + j * 16 * MX_PITCH + ((ks ^ (j >> 1)) << 6));
            if (ML) { float kv[8]; unpack8(__builtin_bit_cast(v4u, kf), kv); nsum += ((kv[0] + kv[1]) + (kv[2] + kv[3])) + ((kv[4] + kv[5]) + (kv[6] + kv[7])); }
#pragma unroll
            for (int j = 0; j < 4; ++j) sacc[j] = __builtin_amdgcn_mfma_f32_16x16x32_bf16(kf, vf[j], sacc[j], 0, 0, 0); }
        if (ML) { nsum += __shfl_xor(nsum, 16); nsum += __shfl_xor(nsum, 32); nreg = nreg * sa + nsum; }
        if (more) { MX_SCAN_A(c + 1); }
        __syncthreads();
        if (more) { MX_SCAN_B(c + 1); }
        __syncthreads();
        if (more) { MX_WRITE(c + 1); }
        __syncthreads();
    }
#undef MX_SCAN_A
#undef MX_SCAN_L
#undef MX_SOFTPLUS
#undef MX_LOGSIG
#undef MX_SCAN_B
#undef MX_PREFETCH
#undef MX_WRITE
}
__device__ __forceinline__ void phase_mixer(Frame& F) {
    int role, idx, nrole;
    if ((F.G & 15) == 0) { role = (F.bid >> 3) & 1; idx = (F.bid >> 4) * 8 + (F.bid & 7); nrole = F.G >> 1; }
    else { role = F.bid & 1; idx = F.bid >> 1; nrole = role ? (F.G >> 1) : ((F.G + 1) >> 1); }
    int first = idx;
    if (role == 0) { for (int unit = idx; unit < 256; unit += nrole) { mixer_unit<false>(F, unit); mixer_unit<true>(F, unit); } first = -1; __syncthreads(); }
    p0_moe_weights_coop(F, first, F.G >> 1);
}

__device__ __forceinline__ void phase3(Frame& F) {
    const bf16* PROJ = (const bf16*)(F.ws + WS_PROJ); bf16* YMIX = (bf16*)(F.ws + WS_YMIX); const float* SSQ = (const float*)(F.ws + WS_SSQ);
    const int gw = F.bid * NWAVES + F.wave, NGW = F.G * NWAVES;
    for (int t = gw; t < TT; t += NGW) {
        bf16* yrow = YMIX + (size_t)t * 4096;
#pragma unroll
        for (int j = 0; j < 8; ++j) {
            const int c0 = (j * 64 + F.lane) * 8;
            float y[8]; unpack8(*(const v4u*)(yrow + c0), y);
            float o[8];
            if (j < 4) {
                const int g = c0 >> 9; const f32x4 s0 = *(const f32x4*)(SSQ + (size_t)t * 32 + g * 8), s1 = *(const f32x4*)(SSQ + (size_t)t * 32 + g * 8 + 4);
                const float ms = ((s0.x + s0.y) + (s0.z + s0.w) + (s1.x + s1.y) + (s1.z + s1.w)) * (1.0f / 512.0f);
                const float rs = 1.0f / sqrtf(ms + EPSF);
                const f32x4 w0 = *(const f32x4*)(F.ssd_norm_w + c0), w1 = *(const f32x4*)(F.ssd_norm_w + c0 + 4);
                o[0] = y[0] * rs * w0.x; o[1] = y[1] * rs * w0.y; o[2] = y[2] * rs * w0.z; o[3] = y[3] * rs * w0.w;
                o[4] = y[4] * rs * w1.x; o[5] = y[5] * rs * w1.y; o[6] = y[6] * rs * w1.z; o[7] = y[7] * rs * w1.w;
            } else {
                const int cc = c0 - 2048, h = cc >> 8; const f32x4 s0 = *(const f32x4*)(SSQ + (size_t)TT * 32 + (size_t)t * 32 + h * 4);
                const float ms = ((s0.x + s0.y) + (s0.z + s0.w)) * (1.0f / 256.0f);
                const float rs = 1.0f / sqrtf(ms + EPSF);
                const f32x4 w0 = *(const f32x4*)(F.ml_norm_w + cc), w1 = *(const f32x4*)(F.ml_norm_w + cc + 4);
                float og[8]; unpack8(*(const v4u*)(PROJ + (size_t)t * NPROJ + PC_O + cc), og);
                const float wv[8] = {w0.x, w0.y, w0.z, w0.w, w1.x, w1.y, w1.z, w1.w};
#pragma unroll
                for (int i = 0; i < 8; ++i) o[i] = y[i] * rs * wv[i] * __builtin_amdgcn_rcpf(1.0f + __expf(-og[i]));
            }
            v4u ov; ov.x = pk2(o[0], o[1]); ov.y = pk2(o[2], o[3]); ov.z = pk2(o[4], o[5]); ov.w = pk2(o[6], o[7]);
            *(v4u*)(yrow + c0) = ov;
        }
    }
}

__device__ __forceinline__ void phase5(Frame& F) {
    const bf16* H2 = (const bf16*)(F.ws + WS_H2); const bf16* WrtT = (const bf16*)(F.ws + WS_WRT); bf16* XN2 = (bf16*)(F.ws + WS_XN2);
    int* EIDX = (int*)(F.ws + WS_ROUTE); int* RANK = EIDX + TT * 4;
    int* TOKL = (int*)(F.ws + WS_XG); float* GATEL = (float*)(F.ws + WS_XG + 4 * MiB);
    constexpr int RP = 528;
    LAS unsigned char* xA = F.lds + F.wave * (8 * RP);
    LAS unsigned char* wl0 = F.lds + 40960;
    LAS float* lg = (LAS float*)(F.lds + 110592 + F.wave * 1024);
    LAS int* cntl = (LAS int*)(F.lds + 118784); LAS int* baseg = cntl + 32;
    const int gw = F.bid * NWAVES + F.wave, NGW = F.G * NWAVES, ntask = TT / 8, iters = (ntask + NGW - 1) / NGW;
    const int fr = F.lane & 15, fq = F.lane >> 4;
    const int wrow = F.tid >> 3, wpc = F.tid & 7;
    const int xrow = F.lane >> 5, xpc = F.lane & 31;
    for (int itx = 0; itx < iters; ++itx) {
        const int task = itx * NGW + gw; const bool valid = task < ntask; const int t0 = valid ? task * 8 : 0;
        if (F.tid < 32) cntl[F.tid] = 0;
        float rstd[8]; int me[4] = {0, 0, 0, 0}, mr[4] = {0, 0, 0, 0}; float mg[4] = {0.f, 0.f, 0.f, 0.f};
        f32x4 acc[4];
#pragma unroll
        for (int n = 0; n < 4; ++n) acc[n] = (f32x4){0.f, 0.f, 0.f, 0.f};
        float ssl[4] = {0.f, 0.f, 0.f, 0.f};
        v4u wreg[4], xreg[4];
#pragma unroll
        for (int q = 0; q < 4; ++q) { wreg[q] = *(const v4u*)(WrtT + (size_t)wrow * DM + 8 * (wpc + 8 * q)); xreg[q] = *(const v4u*)(H2 + (size_t)(t0 + xrow + 2 * q) * DM + 8 * xpc); }
        for (int dc = 0; dc < 8; ++dc) {
            LAS unsigned char* wl = wl0 + (dc & 1) * (64 * RP);
#pragma unroll
            for (int q = 0; q < 4; ++q) { *(LAS v4u*)(wl + wrow * RP + 16 * (wpc + 8 * q)) = wreg[q]; *(LAS v4u*)(xA + (xrow + 2 * q) * RP + 16 * xpc) = xreg[q];
                float f[8]; unpack8(xreg[q], f); ssl[q] += ((f[0] * f[0] + f[1] * f[1]) + (f[2] * f[2] + f[3] * f[3])) + ((f[4] * f[4] + f[5] * f[5]) + (f[6] * f[6] + f[7] * f[7])); }
            if (dc < 7) {
#pragma unroll
                for (int q = 0; q < 4; ++q) { wreg[q] = *(const v4u*)(WrtT + (size_t)wrow * DM + (dc + 1) * 256 + 8 * (wpc + 8 * q)); xreg[q] = *(const v4u*)(H2 + (size_t)(t0 + xrow + 2 * q) * DM + (dc + 1) * 256 + 8 * xpc); } }
            __syncthreads();
#pragma unroll
            for (int ks = 0; ks < 8; ++ks) { const bf16x8 a = *(const LAS bf16x8*)(xA + (fr & 7) * RP + 64 * ks + 16 * fq);
#pragma unroll
                for (int n = 0; n < 4; ++n) { const bf16x8 bb = *(const LAS bf16x8*)(wl + (16 * n + fr) * RP + 64 * ks + 16 * fq); acc[n] = __builtin_amdgcn_mfma_f32_16x16x32_bf16(a, bb, acc[n], 0, 0, 0); } }
        }
#pragma unroll
        for (int q = 0; q < 4; ++q) { float v = ssl[q]; v += __shfl_xor(v, 1); v += __shfl_xor(v, 2); v += __shfl_xor(v, 4); v += __shfl_xor(v, 8); v += __shfl_xor(v, 16); ssl[q] = v; }
#pragma unroll
        for (int k = 0; k < 8; ++k) { const float v = __shfl(ssl[k >> 1], 32 * (k & 1)); rstd[k] = 1.0f / sqrtf(v * (1.0f / 2048.0f) + EPSF); }
        if (valid) {
            if (fq < 2) {
#pragma unroll
                for (int n = 0; n < 2; ++n) { const float rb = F.router_b[16 * n + fr];
#pragma unroll
                    for (int r = 0; r < 4; ++r) { const float rs = fq == 0 ? rstd[r] : rstd[4 + r]; lg[(4 * fq + r) * 32 + 16 * n + fr] = (acc[n][r] + acc[n + 2][r]) * rs + rb; } }
            }
            LDS_WAIT(); asm volatile("" ::: "memory");
            if (F.lane < 8) {
                const LAS float* lp = lg + F.lane * 32; float bv[4]; int bi[4] = {-1, -1, -1, -1};
#pragma unroll
                for (int p = 0; p < 4; ++p) { float best = -3.0e38f; int bidx = 0;
                    for (int q = 0; q < 32; ++q) { const float v = lp[q]; const bool taken = (q == bi[0]) | (q == bi[1]) | (q == bi[2]) | (q == bi[3]); if (!taken && v > best) { best = v; bidx = q; } }
                    bv[p] = best; bi[p] = bidx; }
                const float p1 = expf(bv[1] - bv[0]), p2 = expf(bv[2] - bv[0]), p3 = expf(bv[3] - bv[0]); const float inv = 1.0f / (1.0f + p1 + p2 + p3);
                mg[0] = inv; mg[1] = p1 * inv; mg[2] = p2 * inv; mg[3] = p3 * inv;
#pragma unroll
                for (int p = 0; p < 4; ++p) { me[p] = bi[p]; mr[p] = __hip_atomic_fetch_add(cntl + bi[p], 1, __ATOMIC_RELAXED, __HIP_MEMORY_SCOPE_WORKGROUP); }
            }
        }
        __syncthreads();
        if (F.tid < 32) { const int c = cntl[F.tid]; int gb = 0; if (c > 0) gb = (int)__hip_atomic_fetch_add((unsigned*)(F.ctl + CW_CNT + 64 * F.tid), (unsigned)c, RLX_AGENT); baseg[F.tid] = gb; }
        __syncthreads();
        if (valid) {
            if (F.lane < 8) { const size_t t = (size_t)(t0 + F.lane);
#pragma unroll
                for (int p = 0; p < 4; ++p) { const int rk = baseg[me[p]] + mr[p]; EIDX[t * 4 + p] = me[p]; RANK[t * 4 + p] = rk; TOKL[(size_t)me[p] * TT + rk] = (int)t; GATEL[(size_t)me[p] * TT + rk] = mg[p]; } }
#pragma unroll
            for (int k = 0; k < 8; ++k) { const v2u* xr = (const v2u*)(H2 + (size_t)(t0 + k) * DM) + F.lane; const f32x4* wr = (const f32x4*)F.norm2_w + F.lane; int* o4 = (int*)((unsigned char*)XN2 + (size_t)(t0 + k) * DM) + F.lane;
#pragma unroll
                for (int j = 0; j < 8; ++j) { const v2u q_ = xr[64 * j]; const f32x4 v = (f32x4){bflo(q_.x), bfhi(q_.x), bflo(q_.y), bfhi(q_.y)}, ww = wr[64 * j]; int o = __builtin_amdgcn_cvt_pk_fp8_f32(v.x * rstd[k] * ww.x, v.y * rstd[k] * ww.y, 0, false); o = __builtin_amdgcn_cvt_pk_fp8_f32(v.z * rstd[k] * ww.z, v.w * rstd[k] * ww.w, o, true); o4[64 * j] = o; } }
        }
        __syncthreads();
    }
}
__device__ __forceinline__ int build_moe_tab(Frame& F) {
    LAS unsigned char* tab = (LAS unsigned char*)(F.lds + TAB_OFF); LAS int* tinfo = (LAS int*)(F.lds + TAB_OFF + 320);
    if (F.tid < 64) {
        const int e = F.lane & 31; const int c = (int)__hip_atomic_load((unsigned*)(F.ctl + CW_CNT + 64 * e), RLX_AGENT); const int n = (c + 255) >> 8;
        int incl = n;
#pragma unroll
        for (int d = 1; d < 32; d <<= 1) { const int t_ = __shfl_up(incl, d); if (e >= d) incl += t_; }
        const int first = incl - n;
        if (F.lane < 32) { tinfo[4 + e] = n; tinfo[72 + e] = c; tinfo[40 + e] = first; for (int j = 0; j < n; ++j) tab[first + j] = (unsigned char)e; if (e == 31) tinfo[0] = incl; }
    }
    __syncthreads();
    return tinfo[0];
}
__device__ __forceinline__ void phase8(Frame& F) {
    const bf16* H2 = (const bf16*)(F.ws + WS_H2); const bf16* YR = (const bf16*)(F.ws + WS_YR);
    const int* EIDX = (const int*)(F.ws + WS_ROUTE); const int* RANK = EIDX + TT * 4; (void)build_moe_tab(F); const LAS int* tinfo = (const LAS int*)(F.lds + TAB_OFF + 320);
    const int gw = F.bid * NWAVES + F.wave, NGW = F.G * NWAVES;
    for (int t = gw; t < TT; t += NGW) {
        int slot = 0; if (F.lane < 4) slot = 256 * tinfo[40 + EIDX[(size_t)t * 4 + F.lane]] + RANK[(size_t)t * 4 + F.lane];
        int sl[4]; sl[0] = __shfl(slot, 0); sl[1] = __shfl(slot, 1); sl[2] = __shfl(slot, 2); sl[3] = __shfl(slot, 3);
        float v[4][8]; float ss = 0.f;
#pragma unroll
        for (int j = 0; j < 4; ++j) { const int pz = F.lane + 64 * j; unpack8(*(const v4u*)(H2 + (size_t)t * DM + 8 * pz), v[j]); }
#pragma unroll
        for (int k = 0; k < 4; ++k)
#pragma unroll
            for (int j = 0; j < 4; ++j) { const v2u q = *((const v2u*)((const unsigned char*)YR + (size_t)sl[k] * DM) + F.lane + 64 * j);
                const f32x2 a0 = __builtin_amdgcn_cvt_pk_f32_fp8((int)q.x, false), a1 = __builtin_amdgcn_cvt_pk_f32_fp8((int)q.x, true), a2 = __builtin_amdgcn_cvt_pk_f32_fp8((int)q.y, false), a3 = __builtin_amdgcn_cvt_pk_f32_fp8((int)q.y, true);
                v[j][0] += a0.x * 0.0625f; v[j][1] += a0.y * 0.0625f; v[j][2] += a1.x * 0.0625f; v[j][3] += a1.y * 0.0625f; v[j][4] += a2.x * 0.0625f; v[j][5] += a2.y * 0.0625f; v[j][6] += a3.x * 0.0625f; v[j][7] += a3.y * 0.0625f; }
#pragma unroll
        for (int j = 0; j < 4; ++j)
#pragma unroll
            for (int i = 0; i < 8; ++i) ss += v[j][i] * v[j][i];
        const float rstd = 1.0f / sqrtf(wave_sum(ss) * (1.0f / 2048.0f) + EPSF);
#pragma unroll
        for (int j = 0; j < 4; ++j) { const int pz = F.lane + 64 * j; const f32x4 w0 = *(const f32x4*)(F.final_norm_w + 8 * pz), w1 = *(const f32x4*)(F.final_norm_w + 8 * pz + 4);
            *(f32x4*)(F.out + (size_t)t * DM + 8 * pz) = (f32x4){v[j][0] * rstd * w0.x, v[j][1] * rstd * w0.y, v[j][2] * rstd * w0.z, v[j][3] * rstd * w0.w};
            *(f32x4*)(F.out + (size_t)t * DM + 8 * pz + 4) = (f32x4){v[j][4] * rstd * w1.x, v[j][5] * rstd * w1.y, v[j][6] * rstd * w1.z, v[j][7] * rstd * w1.w}; }
    }
}

struct Args { const float* in[21]; float* out; unsigned char* ws; int ph_lo, ph_hi, li, pad; };
__global__ void __launch_bounds__(NWAVES * 64, 2) hymba_fwd(Args args) {
    extern __shared__ __attribute__((aligned(16))) unsigned char lds[];
    Frame F;
    F.lds = (LAS unsigned char*)lds; F.MISC = (volatile LAS unsigned*)(F.lds + MISC_OFF);
    F.tid = threadIdx.x; F.lane = F.tid & 63; F.wave = __builtin_amdgcn_readfirstlane(F.tid >> 6); F.G = gridDim.x; F.bid = blockIdx.x;
    F.ws = args.ws; F.ctl = (gu32*)(args.ws + WS_CTL); F.out = args.out;
    F.x = args.in[0]; F.norm1_w = args.in[1]; F.w_in = args.in[2]; F.conv_w = args.in[3]; F.conv_b = args.in[4]; F.dt_bias = args.in[5]; F.a_log = args.in[6]; F.d_skip = args.in[7]; F.ssd_norm_w = args.in[8];
    F.i_bias = args.in[9]; F.f_bias = args.in[10]; F.ml_norm_w = args.in[11]; F.w_out = args.in[12]; F.norm2_w = args.in[13]; F.router_w = args.in[14]; F.router_b = args.in[15];
    F.w_gate_up = args.in[16]; F.b_gate_up = args.in[17]; F.w_down = args.in[18]; F.b_down = args.in[19]; F.final_norm_w = args.in[20];
    for (int u = F.tid; u < (LDS_BYTES - LDSCTL_OFF) / 4; u += NWAVES * 64) ((LAS unsigned*)(F.lds + LDSCTL_OFF))[u] = 0u;
    __syncthreads();
    XcdBarrier bar; bar.bar = (unsigned*)(F.ctl + CW_BAR) + args.li * XCD_BAR_WORDS; bar.x = 0; bar.st = nullptr;
    const bool use_bar = (args.ph_hi - args.ph_lo) > 1;
    if (use_bar) bar = xcd_barrier_post((unsigned*)(F.ctl + CW_BAR) + args.li * XCD_BAR_WORDS, F.MISC + 8);
    const int lo = args.ph_lo, hi = args.ph_hi;
#ifndef PHASE_MASK
#define PHASE_MASK 0x1ff
#endif
#define IN(k) (((PHASE_MASK >> (k)) & 1) && lo <= (k) && (k) < hi)
#define SEAM(k) do { if (IN(k) && IN((k) + 1)) xcd_barrier(bar); } while (0)
    if (IN(0)) { phase0(F); } SEAM(0);
    if (IN(1)) {
        pg8::Gemm g{(const pg8::bf16_t*)(F.ws + WS_XN1), (const pg8::bf16_t*)(F.ws + WS_WIN), TT, NPROJ, DM}; pg8::StaticOrder S; S.init(TT, NPROJ, F.G, F.bid);
        pg8::EpiBf16 E{(pg8::bf16_t*)(F.ws + WS_PROJ), NPROJ};
        pg8::gemm_phase<pg8::EpiBf16, pg8::StaticOrder, true, true>(F.lds, g, S, E);
        p1_small(F);
    } SEAM(1);
    if (IN(2)) { phase_conv(F); } SEAM(2);
    if (IN(3)) { phase_mixer(F); } SEAM(3);
    if (IN(4)) {
        pg8::Gemm g{(const pg8::bf16_t*)(F.ws + WS_YMIX), (const pg8::bf16_t*)(F.ws + WS_WOUT), TT, DM, 4096}; pg8::StaticOrder S; S.init(TT, DM, F.G, F.bid);
        pg8::EpiResNorm E{(pg8::bf16_t*)(F.ws + WS_H2), F.x, DM, (const float*)(F.ws + WS_SSQ), (PG8_LAS float*)(F.lds + RING_BYTES), EPSF};
        pg8::gemm_phase<pg8::EpiResNorm, pg8::StaticOrder, true, true>(F.lds, g, S, E);
    } SEAM(4);
    if (IN(5)) { phase5(F); } SEAM(5);
    if (IN(6)) {
        const int nM = build_moe_tab(F);
        const LAS int* tinfo = (const LAS int*)(F.lds + TAB_OFF + 320); LAS unsigned short* rt = (LAS unsigned short*)(F.lds + ROWTAB_OFF);
        pg8::Gemm g{(const pg8::bf16_t*)(F.ws + WS_XN2), (const pg8::bf16_t*)(F.ws + WS_WGU), nM * 256, 4096, DM};
        pg8::MoeOrder S{nM, 16, 4, nM * 16, F.G, F.bid, (const PG8_LAS unsigned char*)(F.lds + TAB_OFF), (const PG8_LAS unsigned short*)rt};
        { const int* TOKL = (const int*)(F.ws + WS_XG); const int hsel = F.tid >> 8, r256 = F.tid & 255;
          int tk[9];
#pragma unroll
          for (int ii = 0; ii < 9; ++ii) { pg8::Unit u; tk[ii] = -1; if (S.next(2 * ii + hsel, u)) { const int e = u.pn >> 4, rank = (u.pm - tinfo[40 + e]) * 256 + r256; tk[ii] = rank < tinfo[72 + e] ? TOKL[(size_t)e * TT + rank] : 0; } }
#pragma unroll
          for (int ii = 0; ii < 9; ++ii) if (tk[ii] >= 0) rt[(2 * ii + hsel) * 256 + r256] = (unsigned short)tk[ii];
          __syncthreads(); }
        pg8::EpiSwiglu E{(unsigned char*)(F.ws + WS_ACT), F.b_gate_up, (PG8_LAS float*)(F.lds + EPIV_OFF)};
        pg8::gemm_phase<pg8::EpiSwiglu, pg8::MoeOrder, true, true, true, true>(F.lds, g, S, E);
    } SEAM(6);
    if (IN(7)) {
        const int nM = build_moe_tab(F);
        pg8::Gemm g{(const pg8::bf16_t*)(F.ws + WS_ACT), (const pg8::bf16_t*)(F.ws + WS_WD), nM * 256, 2048, DM};
        pg8::MoeOrder S{nM, 8, 3, nM * 8, F.G, F.bid, (const PG8_LAS unsigned char*)(F.lds + TAB_OFF), nullptr};
        pg8::EpiDown E{(pg8::bf16_t*)(F.ws + WS_YR), F.b_down, (const float*)(F.ws + WS_XG + 4 * MiB), (const PG8_LAS int*)(F.lds + TAB_OFF + 320), (PG8_LAS float*)(F.lds + EPIV_OFF)};
        pg8::gemm_phase<pg8::EpiDown, pg8::MoeOrder, true, true, true>(F.lds, g, S, E);
    } SEAM(7);
    if (IN(8)) { phase8(F); }
#undef IN
#undef SEAM
}

extern "C" void kernel_launch(void* const* d_in, const int* in_sizes, int n_in, void* d_out, int out_size, void* d_ws, size_t ws_size, hipStream_t stream) {
    static int grid = 0;
    if (grid == 0) {
        if (n_in != 21 || out_size != TT * DM || ws_size < WS_END) { fprintf(stderr, "kernel_launch: unexpected problem (n_in %d, out %d, ws %zu); nothing launched\n", n_in, out_size, ws_size); grid = -1; return; }
        int dev = 0, cus = 0, per_cu = 0;
        if (hipGetDevice(&dev) != hipSuccess || hipDeviceGetAttribute(&cus, hipDeviceAttributeMultiprocessorCount, dev) != hipSuccess) { grid = -1; return; }
        if (hipFuncSetAttribute((const void*)hymba_fwd, hipFuncAttributeMaxDynamicSharedMemorySize, LDS_BYTES) != hipSuccess) { fprintf(stderr, "kernel_launch: hipFuncSetAttribute failed\n"); grid = -1; return; }
        if (hipOccupancyMaxActiveBlocksPerMultiprocessor(&per_cu, (const void*)hymba_fwd, NWAVES * 64, LDS_BYTES) != hipSuccess || per_cu < 1) { fprintf(stderr, "kernel_launch: occupancy query says %d blocks per CU\n", per_cu); }
        (void)hipGetLastError();
        grid = cus;
    }
    if (grid < 0) return;
    (void)hipMemsetAsync((char*)d_ws + WS_CTL, 0, CTL_ZERO_BYTES, stream);
    Args a{};
    for (int i = 0; i < 21; ++i) a.in[i] = (const float*)d_in[i];
    a.out = (float*)d_out; a.ws = (unsigned char*)d_ws; a.pad = 0;
#if MK_PER_PHASE
    for (int li = 0; li < N_PHASES; ++li) { a.ph_lo = li; a.ph_hi = li + 1; a.li = li; hipLaunchKernelGGL(hymba_fwd, dim3(grid), dim3(NWAVES * 64), LDS_BYTES, stream, a); }
#else
    a.ph_lo = 0; a.ph_hi = N_PHASES; a.li = 0;
    hipLaunchKernelGGL(hymba_fwd, dim3(grid), dim3(NWAVES * 64), LDS_BYTES, stream, a);
#endif
}
```
